# Optimizing an MI355X kernel written in HIP

```python
import math
import jax, jax.numpy as jnp
from jax import lax
import numpy as np

D_MODEL = 1024
BATCH = 8
SEQ = 2048
DEPTH = 2

GRID_W = 64
CTX_LEN = 256
HEAD_DIM = 64
A_HEADS = 8
A_KV_HEADS = 2
ROPE_THETA = 10000.0
Q_BLOCK = 128
B_HEADS = 4
WIN_ROWS_MAX = 8
WIN_COLS = 16
C_CH = 256
C_SHORT = 3
C_POS_BANDS = 16
C_POS_DIM = 2 * C_POS_BANDS + 1
C_FILTER_HIDDEN = 64
C_DECAY_TARGET = 1e-2
C_FAST_DECAY = 0.3
C_SLOW_DECAY = 1.5
A_W = A_HEADS * HEAD_DIM
A_KV_W = A_KV_HEADS * HEAD_DIM
B_W = B_HEADS * HEAD_DIM
MIX_W = A_W + B_W + C_CH
A_Q0 = 0
A_K0 = A_Q0 + A_W
A_V0 = A_K0 + A_KV_W
B_Q0 = A_V0 + A_KV_W
B_K0 = B_Q0 + B_W
B_V0 = B_K0 + B_W
C0 = B_V0 + B_W
PROJ_W = C0 + 3 * C_CH
N_EXPERTS = 64
TOP_K = 8
N_GROUPS = 8
TOPK_GROUPS = 4
EXPERT_HIDDEN = 128
SHARED_HIDDEN = 256
ROUTED_SCALE = 2.5
DN_ALPHA = (2 * DEPTH) ** 0.25
DN_BETA = (8 * DEPTH) ** -0.25
LN_EPS = 1e-6
RMS_EPS = 1e-6

kernel_name = "hybrid_dit_gqa_natten_hyena_moe"

F32 = jnp.float32


def layer_norm(x, g=None, b=None):
    xf = x.astype(F32)
    mu = jnp.mean(xf, -1, keepdims=True)
    var = jnp.mean(jnp.square(xf - mu), -1, keepdims=True)
    y = (xf - mu) * lax.rsqrt(var + LN_EPS)
    if g is not None:
        y = y * g.astype(F32) + b.astype(F32)
    return y.astype(x.dtype)


def rms_norm(x, g):
    xf = x.astype(F32)
    y = xf * lax.rsqrt(jnp.mean(jnp.square(xf), -1, keepdims=True) + RMS_EPS) * g.astype(F32)
    return y.astype(x.dtype)


def ada_modulation(cvec, w, b):
    m = jax.nn.silu(cvec) @ w + b
    return jnp.split(m, 6, axis=-1)


def modulate(x, shift, scale):
    return layer_norm(x) * (1 + scale) + shift


def to_heads(t, n):
    return t.reshape(t.shape[:-1] + (n, HEAD_DIM))


def axial_rope(n_tok):
    t = jnp.arange(n_tok)
    row = (t // GRID_W).astype(F32)
    col = (t % GRID_W).astype(F32)
    half = HEAD_DIM // 2
    inv = ROPE_THETA ** (-jnp.arange(0, half, 2, dtype=F32) / half)
    ang = jnp.concatenate([row[:, None] * inv, col[:, None] * inv], -1)
    return jnp.cos(ang), jnp.sin(ang)


def apply_rope(x, cos, sin):
    xf = x.astype(F32)
    x1, x2 = xf[..., 0::2], xf[..., 1::2]
    out = jnp.stack([x1 * cos - x2 * sin, x1 * sin + x2 * cos], -1).reshape(x.shape)
    return out.astype(x.dtype)


def dense_attention(q, k, v):
    bsz, lq, h, dh = q.shape
    g = k.shape[2]
    qg = q.reshape(bsz, lq, g, h // g, dh)
    s = jnp.einsum('bqgrd,bkgd->bgrqk', qg, k).astype(F32) * (dh ** -0.5)
    p = jax.nn.softmax(s, -1).astype(v.dtype)
    o = jnp.einsum('bgrqk,bkgd->bqgrd', p, v)
    return o.reshape(bsz, lq, h * dh)


def gqa_latent(q, k, v, k_ctx, v_ctx):
    bsz, n = q.shape[:2]
    nb = n // Q_BLOCK
    rep = A_HEADS // A_KV_HEADS
    kk = jnp.concatenate([k_ctx, k], 1)
    vv = jnp.concatenate([v_ctx, v], 1)
    qb = q.reshape(bsz, nb, Q_BLOCK, A_KV_HEADS, rep, HEAD_DIM).transpose(1, 0, 3, 4, 2, 5)
    scale = HEAD_DIM ** -0.5

    def block(qi):
        s = jnp.einsum('bgrqd,bkgd->bgrqk', qi, kk).astype(F32) * scale
        p = jax.nn.softmax(s, -1).astype(vv.dtype)
        return jnp.einsum('bgrqk,bkgd->bgrqd', p, vv)

    o = lax.map(block, qb)
    return o.transpose(1, 0, 4, 2, 3, 5).reshape(bsz, n, A_W)


def neighbourhood_attention(q, k, v, k_ctx, v_ctx, rpb):
    bsz, n = q.shape[:2]
    rows = n // GRID_W
    wr = min(WIN_ROWS_MAX, rows)
    grid = lambda t: t.reshape(bsz, rows, GRID_W, B_HEADS, HEAD_DIM)
    qg, kg, vg = grid(q), grid(k), grid(v)
    col = np.arange(GRID_W)
    col_start = np.clip(col - WIN_COLS // 2, 0, GRID_W - WIN_COLS)
    col_idx = col_start[:, None] + np.arange(WIN_COLS)[None, :]
    dc = col_idx - col[:, None] + WIN_COLS - 1
    scale = HEAD_DIM ** -0.5
    n_win = wr * WIN_COLS

    def row_block(r):
        rs = jnp.clip(r - wr // 2, 0, rows - wr)
        qr = lax.dynamic_index_in_dim(qg, r, axis=1, keepdims=False)
        kr = lax.dynamic_slice_in_dim(kg, rs, wr, axis=1)
        vr = lax.dynamic_slice_in_dim(vg, rs, wr, axis=1)
        kw = kr[:, :, col_idx]
        vw = vr[:, :, col_idx]
        dr = rs + jnp.arange(wr) - r + WIN_ROWS_MAX - 1
        bias = rpb[:, dr[None, :, None], dc[:, None, :]].astype(F32)
        s_win = jnp.einsum('bqhd,biqjhd->bhqij', qr, kw).astype(F32) * scale + bias[None]
        s_ctx = jnp.einsum('bqhd,bkhd->bhqk', qr, k_ctx).astype(F32) * scale
        s = jnp.concatenate([s_win.reshape(bsz, B_HEADS, GRID_W, n_win), s_ctx], -1)
        p = jax.nn.softmax(s, -1).astype(v.dtype)
        p_win = p[..., :n_win].reshape(bsz, B_HEADS, GRID_W, wr, WIN_COLS)
        p_ctx = p[..., n_win:]
        return (jnp.einsum('bhqij,biqjhd->bqhd', p_win, vw)
                + jnp.einsum('bhqk,bkhd->bqhd', p_ctx, v_ctx))

    o = lax.map(row_block, jnp.arange(rows))
    return o.transpose(1, 0, 2, 3, 4).reshape(bsz, n, B_W)


def short_conv(z, w, b):
    n = z.shape[1]
    p = C_SHORT // 2
    zp = jnp.pad(z, ((0, 0), (p, C_SHORT - 1 - p), (0, 0)))
    return sum(zp[:, i:i + n] * w[i] for i in range(C_SHORT)) + b


def implicit_filters(n, w1, b1, w2, b2, w3, freq):
    t = jnp.linspace(0.0, 1.0, n, dtype=F32)[:, None]
    w = 2 * math.pi * jnp.arange(n, dtype=F32)[:, None] / n
    f = jnp.linspace(1e-4, C_POS_BANDS - 1, C_POS_BANDS, dtype=F32)[None]
    z = jnp.concatenate([t, jnp.cos(f * w), -jnp.sin(f * w)], -1)
    h = jnp.sin(freq[0].astype(F32) * (z @ w1.astype(F32) + b1.astype(F32)))
    h = jnp.sin(freq[1].astype(F32) * (h @ w2.astype(F32) + b2.astype(F32)))
    h = h @ w3.astype(F32)
    lo = math.log(C_DECAY_TARGET) / C_SLOW_DECAY
    hi = math.log(C_DECAY_TARGET) / C_FAST_DECAY
    deltas = jnp.abs(jnp.linspace(lo, hi, C_CH, dtype=F32))
    decay = jnp.exp(-t * deltas[None])
    return h[:, :C_CH] * decay, h[:, C_CH:] * decay


def bidir_long_conv(u, hf, hb):
    n = u.shape[1]
    k = jnp.concatenate([hf, jnp.zeros((1, C_CH), F32), hb[1:][::-1]], 0)
    kf = jnp.fft.rfft(k, n=2 * n, axis=0)
    uf = jnp.fft.rfft(u.astype(F32), n=2 * n, axis=1)
    y = jnp.fft.irfft(uf * kf[None], n=2 * n, axis=1)[:, :n]
    return y.astype(u.dtype)


def hyena_mixer(z, conv_w, conv_b, f_w1, f_b1, f_w2, f_b2, f_w3, freq, skip):
    n = z.shape[1]
    z = short_conv(z, conv_w, conv_b)
    x0, x1, v = jnp.split(z, 3, axis=-1)
    hf, hb = implicit_filters(n, f_w1, f_b1, f_w2, f_b2, f_w3, freq)
    u = v * x1
    y = bidir_long_conv(u, hf, hb) + u * skip
    return y * x0


def moe_ffn(h, rw, rb, w1, w3, w2, sw1, sw3, sw2):
    t = h.shape[0]
    scores = jax.nn.sigmoid((h @ rw).astype(F32))
    sel = scores + rb.astype(F32)
    grp = sel.reshape(t, N_GROUPS, N_EXPERTS // N_GROUPS)
    gscore = lax.top_k(grp, 2)[0].sum(-1)
    _, gidx = lax.top_k(gscore, TOPK_GROUPS)
    gmask = jax.nn.one_hot(gidx, N_GROUPS, dtype=F32).sum(1) > 0
    emask = jnp.repeat(gmask, N_EXPERTS // N_GROUPS, axis=1)
    _, eidx = lax.top_k(jnp.where(emask, sel, -jnp.inf), TOP_K)
    wsel = jnp.take_along_axis(scores, eidx, -1)
    wsel = wsel / jnp.sum(wsel, -1, keepdims=True) * ROUTED_SCALE
    gate = jnp.sum(jax.nn.one_hot(eidx, N_EXPERTS, dtype=F32) * wsel[..., None], 1)
    a = jnp.einsum('td,edh->teh', h, w1)
    b = jnp.einsum('td,edh->teh', h, w3)
    act = (jax.nn.silu(a) * b * gate[..., None].astype(h.dtype))
    routed = jnp.einsum('teh,ehd->td', act, w2)
    shared = (jax.nn.silu(h @ sw1) * (h @ sw3)) @ sw2
    return (routed + shared).astype(h.dtype)


def moe_per_sample(h, rw, rb, w1, w3, w2, sw1, sw3, sw2):
    return lax.map(lambda hs: moe_ffn(hs, rw, rb, w1, w3, w2, sw1, sw3, sw2), h)


def setup_inputs(seed: int = 0) -> dict:
    key = jax.random.key(seed)
    ks = iter(jax.random.split(key, 40))
    nrm = lambda shape, s: jax.random.normal(next(ks), shape, F32) * s
    D = D_MODEL
    L = DEPTH
    return {
        "x": nrm((BATCH, SEQ, D), 1.0),
        "c": nrm((BATCH, D), 1.0),
        "ctx": nrm((BATCH, CTX_LEN, D), 1.0),
        "c_ctx": nrm((D,), 1.0),
        "ada_w": nrm((L, D, 6 * D), 0.5 * D ** -0.5),
        "ada_b": nrm((L, 6 * D), 0.02),
        "w_in": nrm((L, D, PROJ_W), D ** -0.5),
        "q_gain": 1.0 + nrm((L, HEAD_DIM), 0.05),
        "k_gain": 1.0 + nrm((L, HEAD_DIM), 0.05),
        "nat_rpb": nrm((L, B_HEADS, 2 * WIN_ROWS_MAX - 1, 2 * WIN_COLS - 1), 0.1),
        "hy_conv_w": nrm((L, C_SHORT, 3 * C_CH), 0.5),
        "hy_conv_b": nrm((L, 3 * C_CH), 0.02),
        "hy_f_w1": nrm((L, C_POS_DIM, C_FILTER_HIDDEN), C_POS_DIM ** -0.5),
        "hy_f_b1": nrm((L, C_FILTER_HIDDEN), 0.1),
        "hy_f_w2": nrm((L, C_FILTER_HIDDEN, C_FILTER_HIDDEN), C_FILTER_HIDDEN ** -0.5),
        "hy_f_b2": nrm((L, C_FILTER_HIDDEN), 0.1),
        "hy_f_w3": nrm((L, C_FILTER_HIDDEN, 2 * C_CH), 0.01),
        "hy_freq": 1.0 + nrm((L, 2, C_FILTER_HIDDEN), 0.1),
        "hy_skip": nrm((L, C_CH), 0.5),
        "w_out": nrm((L, MIX_W, D), DN_BETA * MIX_W ** -0.5),
        "ln1_g": 1.0 + nrm((L, D), 0.05),
        "ln1_b": nrm((L, D), 0.02),
        "router_w": nrm((L, D, N_EXPERTS), D ** -0.5),
        "router_b": nrm((L, N_EXPERTS), 0.01),
        "exp_w1": nrm((L, N_EXPERTS, D, EXPERT_HIDDEN), D ** -0.5),
        "exp_w3": nrm((L, N_EXPERTS, D, EXPERT_HIDDEN), D ** -0.5),
        "exp_w2": nrm((L, N_EXPERTS, EXPERT_HIDDEN, D), DN_BETA * EXPERT_HIDDEN ** -0.5),
        "sh_w1": nrm((L, D, SHARED_HIDDEN), D ** -0.5),
        "sh_w3": nrm((L, D, SHARED_HIDDEN), D ** -0.5),
        "sh_w2": nrm((L, SHARED_HIDDEN, D), DN_BETA * SHARED_HIDDEN ** -0.5),
        "ln2_g": 1.0 + nrm((L, D), 0.05),
        "ln2_b": nrm((L, D), 0.02),
    }


def reference(x, c, ctx, c_ctx, ada_w, ada_b, w_in, q_gain, k_gain, nat_rpb, hy_conv_w, hy_conv_b,
              hy_f_w1, hy_f_b1, hy_f_w2, hy_f_b2, hy_f_w3, hy_freq, hy_skip, w_out, ln1_g, ln1_b,
              router_w, router_b, exp_w1, exp_w3, exp_w2, sh_w1, sh_w3, sh_w2, ln2_g, ln2_b):
    n_lat = x.shape[1]
    cos, sin = axial_rope(n_lat)
    cos, sin = cos[:, None, :], sin[:, None, :]
    xc = ctx
    for l in range(DEPTH):
        last = l == DEPTH - 1
        sh1, sc1, g1, sh2, sc2, g2 = [m[:, None, :] for m in ada_modulation(c, ada_w[l], ada_b[l])]
        csh1, csc1, cg1, csh2, csc2, cg2 = ada_modulation(c_ctx, ada_w[l], ada_b[l])
        w = w_in[l]
        hy_args = (hy_conv_w[l], hy_conv_b[l], hy_f_w1[l], hy_f_b1[l], hy_f_w2[l], hy_f_b2[l],
                   hy_f_w3[l], hy_freq[l], hy_skip[l])
        moe_args = (router_w[l], router_b[l], exp_w1[l], exp_w3[l], exp_w2[l],
                    sh_w1[l], sh_w3[l], sh_w2[l])

        hc = modulate(xc, csh1, csc1)
        if last:
            pkv_a = hc @ w[:, A_K0:B_Q0]
            pkv_b = hc @ w[:, B_K0:C0]
        else:
            pc = hc @ w
            pkv_a = pc[..., A_K0:B_Q0]
            pkv_b = pc[..., B_K0:C0]
        kca = rms_norm(to_heads(pkv_a[..., :A_KV_W], A_KV_HEADS), k_gain[l])
        vca = to_heads(pkv_a[..., A_KV_W:], A_KV_HEADS)
        kcb = to_heads(pkv_b[..., :B_W], B_HEADS)
        vcb = to_heads(pkv_b[..., B_W:], B_HEADS)
        if not last:
            qca = rms_norm(to_heads(pc[..., A_Q0:A_K0], A_HEADS), q_gain[l])
            qcb = to_heads(pc[..., B_Q0:B_K0], B_HEADS)
            oc = jnp.concatenate([dense_attention(qca, kca, vca),
                                  dense_attention(qcb, kcb, vcb),
                                  hyena_mixer(pc[..., C0:], *hy_args)], -1)
            xc_mid = layer_norm(DN_ALPHA * xc + cg1 * (oc @ w_out[l]), ln1_g[l], ln1_b[l])
            hc2 = modulate(xc_mid, csh2, csc2)
            xc = layer_norm(DN_ALPHA * xc_mid + cg2 * moe_per_sample(hc2, *moe_args), ln2_g[l], ln2_b[l])

        hx = modulate(x, sh1, sc1)
        px = hx @ w
        qa = apply_rope(rms_norm(to_heads(px[..., A_Q0:A_K0], A_HEADS), q_gain[l]), cos, sin)
        ka = apply_rope(rms_norm(to_heads(px[..., A_K0:A_V0], A_KV_HEADS), k_gain[l]), cos, sin)
        va = to_heads(px[..., A_V0:B_Q0], A_KV_HEADS)
        qb = to_heads(px[..., B_Q0:B_K0], B_HEADS)
        kb = to_heads(px[..., B_K0:B_V0], B_HEADS)
        vb = to_heads(px[..., B_V0:C0], B_HEADS)
        ox = jnp.concatenate([gqa_latent(qa, ka, va, kca, vca),
                              neighbourhood_attention(qb, kb, vb, kcb, vcb, nat_rpb[l]),
                              hyena_mixer(px[..., C0:], *hy_args)], -1)
        x = layer_norm(DN_ALPHA * x + g1 * (ox @ w_out[l]), ln1_g[l], ln1_b[l])
        hx2 = modulate(x, sh2, sc2)
        x = layer_norm(DN_ALPHA * x + g2 * moe_per_sample(hx2, *moe_args), ln2_g[l], ln2_b[l])
    return x
```

```cpp
#include <hip/hip_runtime.h>
#include <hip/hip_cooperative_groups.h>
#include <stdint.h>
#include <stdio.h>
namespace cg = cooperative_groups;

#ifndef MULTI_LAUNCH
#define MULTI_LAUNCH 1
#endif

typedef unsigned short bf16_t;
typedef short bf16x8 __attribute__((ext_vector_type(8)));
typedef short s16x4 __attribute__((ext_vector_type(4)));
typedef float f32x4 __attribute__((ext_vector_type(4)));
typedef unsigned u32x4 __attribute__((ext_vector_type(4)));
typedef unsigned u32x2 __attribute__((ext_vector_type(2)));
#define DEV __device__ __forceinline__
#define LDSP(T) __attribute__((address_space(3))) T*

constexpr int D = 1024, NB = 8, SEQ = 2048, CTX = 256, NLAT = NB * SEQ, NCTX = NB * CTX, NT = NLAT + NCTX;
constexpr int PROJ = 2304, KEYS = CTX + SEQ, NEXP = 64;
constexpr float DN_ALPHA = 1.41421356237309515f;
constexpr float LOG2E = 1.44269504088896341f;
constexpr int RMAX = 4;

constexpr size_t OFF_CNT = 0;
constexpr size_t OFF_MOD = 65536;
constexpr size_t OFF_ROPE = OFF_MOD + 442368;
constexpr size_t OFF_KERNL = OFF_ROPE + 2ull * 2048 * 32 * 4;
constexpr size_t OFF_KERNC = OFF_KERNL + 2ull * 4096 * 256 * 4;
constexpr size_t OFF_TKE = OFF_KERNC + 2ull * 512 * 256 * 4;
constexpr size_t OFF_TKS = OFF_TKE + (size_t)NT * 8 * 4;
constexpr size_t OFF_TKW = OFF_TKS + (size_t)NT * 8 * 4;
constexpr size_t OFF_LIST = OFF_TKW + (size_t)NT * 8 * 4;
constexpr size_t OFF_WIN = OFF_LIST + 64ull * NT * 4;
constexpr size_t OFF_WOUT = OFF_WIN + 2ull * 2304 * 1024 * 2;
constexpr size_t OFF_SW13 = OFF_WOUT + 2ull * 1024 * 1024 * 2;
constexpr size_t OFF_SW2 = OFF_SW13 + 2ull * 512 * 1024 * 2;
constexpr size_t OFF_RW = OFF_SW2 + 2ull * 1024 * 256 * 2;
constexpr size_t OFF_W13 = OFF_RW + 2ull * 64 * 1024 * 2;
constexpr size_t OFF_W2 = OFF_W13 + 64ull * 256 * 1024 * 2;
constexpr size_t OFF_X = OFF_W2 + 64ull * 1024 * 128 * 2;
constexpr size_t OFF_H = OFF_X + (size_t)NT * 1024 * 4;
constexpr size_t OFF_R = OFF_H + (size_t)NT * 1024 * 2;
constexpr size_t OFF_QA = OFF_R;
constexpr size_t OFF_QB = OFF_QA + 8ull * NT * 64 * 2;
constexpr size_t OFF_KA = OFF_QB + 4ull * NT * 64 * 2;
constexpr size_t OFF_VA = OFF_KA + 8ull * 2 * KEYS * 64 * 2;
constexpr size_t OFF_KB = OFF_VA + 8ull * 2 * KEYS * 64 * 2;
constexpr size_t OFF_VB = OFF_KB + 8ull * 4 * KEYS * 64 * 2;
constexpr size_t OFF_ZTL = OFF_VB + 8ull * 4 * KEYS * 64 * 2;
constexpr size_t OFF_ZTC = OFF_ZTL + 8ull * 768 * 2048 * 2;
constexpr size_t OFF_OX = OFF_ZTC + 8ull * 768 * 256 * 2;
constexpr size_t R_MIN_BYTES = OFF_OX + (size_t)NT * 1024 * 2 - OFF_R;
constexpr size_t OFF_PART = OFF_R;
constexpr size_t OFF_YS = OFF_R;

struct Params {
    const float *x, *c, *ctx, *c_ctx, *ada_w, *ada_b, *w_in, *q_gain, *k_gain, *nat_rpb, *hy_conv_w, *hy_conv_b,
        *hy_f_w1, *hy_f_b1, *hy_f_w2, *hy_f_b2, *hy_f_w3, *hy_freq, *hy_skip, *w_out, *ln1_g, *ln1_b,
        *router_w, *router_b, *exp_w1, *exp_w3, *exp_w2, *sh_w1, *sh_w3, *sh_w2, *ln2_g, *ln2_b;
    float* out; unsigned char* ws;
    int cap, mode, ptype, pl, pr, pad;
};

DEV unsigned f2bf(float f) { unsigned u = __float_as_uint(f); return (u + 0x7fffu + ((u >> 16) & 1u)) >> 16; }
DEV unsigned pk2(float lo, float hi) { return f2bf(lo) | (f2bf(hi) << 16); }
DEV float bf2f(unsigned short h) { return __uint_as_float(((unsigned)h) << 16); }
DEV float wave_sum(float v) {
#pragma unroll
    for (int o = 32; o > 0; o >>= 1) v += __shfl_xor(v, o);
    return v;
}
DEV void glds16(const void* g, void* l) { __builtin_amdgcn_global_load_lds((const unsigned*)g, (unsigned*)l, 16, 0, 0); }
DEV f32x4 mfma16(bf16x8 a, bf16x8 b, f32x4 c) { return __builtin_amdgcn_mfma_f32_16x16x32_bf16(a, b, c, 0, 0, 0); }
DEV int mod_group(int row) { return row < NLAT ? (row >> 11) : 8; }

template <int MI, bool TRANS>
DEV void gemm_core(f32x4 (&acc)[MI][4], const bf16_t* a0, const bf16_t* a1, const bf16_t* b0, const bf16_t* b1, int K, char* lds) {
    const int tid = threadIdx.x, lane = tid & 63, wid = tid >> 6, fr = lane & 15, fq = lane >> 4, wr = wid >> 1, wc = wid & 1;
    char* SA = lds; char* SB = lds + 8192;
    for (int kt = 0; kt < K; kt += 32) {
        glds16(a0 + kt, SA + tid * 16);
        if (MI == 4) glds16(a1 + kt, SA + 4096 + tid * 16);
        glds16(b0 + kt, SB + tid * 16);
        glds16(b1 + kt, SB + 4096 + tid * 16);
        asm volatile("s_waitcnt vmcnt(0)" ::: "memory");
        __syncthreads();
        bf16x8 af[MI], bfr[4];
#pragma unroll
        for (int m = 0; m < MI; ++m) af[m] = *(const bf16x8*)(SA + ((wr * MI * 16 + m * 16 + fr) * 64 + fq * 16));
#pragma unroll
        for (int n = 0; n < 4; ++n) bfr[n] = *(const bf16x8*)(SB + ((wc * 64 + n * 16 + fr) * 64 + fq * 16));
#pragma unroll
        for (int m = 0; m < MI; ++m)
#pragma unroll
            for (int n = 0; n < 4; ++n) acc[m][n] = TRANS ? mfma16(bfr[n], af[m], acc[m][n]) : mfma16(af[m], bfr[n], acc[m][n]);
        __syncthreads();
    }
}
template <int MI> DEV void zero_acc(f32x4 (&acc)[MI][4]) {
#pragma unroll
    for (int m = 0; m < MI; ++m)
#pragma unroll
        for (int n = 0; n < 4; ++n) acc[m][n] = (f32x4){0.f, 0.f, 0.f, 0.f};
}

DEV void prep_mod_item(const Params& p, int it, char* lds) {
    const int l = it / 768, rem = it % 768, cch = rem / 32, kch = rem % 32, tid = threadIdx.x;
    float* sl = (float*)lds;
    for (int i = tid; i < 288; i += 256) { const int g = i / 32, k = kch * 32 + (i % 32); const float v = (g < 8) ? p.c[g * 1024 + k] : p.c_ctx[k]; sl[i] = v / (1.f + expf(-v)); }
    __syncthreads();
    const int col = cch * 256 + tid;
    float acc[9];
#pragma unroll
    for (int g = 0; g < 9; ++g) acc[g] = 0.f;
    const float* w = p.ada_w + ((size_t)l * 1024 + kch * 32) * 6144 + col;
#pragma unroll 8
    for (int kk = 0; kk < 32; ++kk) {
        const float wv = w[(size_t)kk * 6144];
#pragma unroll
        for (int g = 0; g < 9; ++g) acc[g] += sl[g * 32 + kk] * wv;
    }
    float* part = (float*)(p.ws + OFF_PART);
#pragma unroll
    for (int g = 0; g < 9; ++g) part[((size_t)(kch * 2 + l) * 9 + g) * 6144 + col] = acc[g];
    __syncthreads();
}
DEV void prep_rope_item(const Params& p, int it) {
    const int idx = it * 256 + threadIdx.x, t = idx >> 5, i = idx & 31;
    const float inv = powf(10000.f, -(float)(2 * (i & 15)) / 32.f);
    const float ang = (float)((i < 16) ? (t >> 6) : (t & 63)) * inv;
    float* rc = (float*)(p.ws + OFF_ROPE);
    rc[idx] = cosf(ang); rc[2048 * 32 + idx] = sinf(ang);
}
DEV void prep_filter_item(const Params& p, int it, char* lds) {
    const int l = it / 2304, r = it % 2304, type = r < 2048 ? 0 : 1, t = type ? r - 2048 : r, n = type ? 256 : 2048, tid = threadIdx.x;
    float* z = (float*)lds; float* h1 = z + 64; float* h2 = h1 + 64;
    const float tt = (float)t / (float)(n - 1);
    if (tid < 33) {
        float v;
        if (tid == 0) v = tt;
        else {
            const int i = (tid - 1) & 15;
            const float f = 1e-4f + (float)i * ((15.f - 1e-4f) / 15.f);
            const float w = 2.f * 3.14159265358979323846f * (float)t / (float)n;
            v = (tid <= 16) ? cosf(f * w) : -sinf(f * w);
        }
        z[tid] = v;
    }
    __syncthreads();
    if (tid < 64) {
        float s = p.hy_f_b1[l * 64 + tid];
        for (int i = 0; i < 33; ++i) s += z[i] * p.hy_f_w1[(l * 33 + i) * 64 + tid];
        h1[tid] = sinf(p.hy_freq[(l * 2 + 0) * 64 + tid] * s);
    }
    __syncthreads();
    if (tid < 64) {
        float s = p.hy_f_b2[l * 64 + tid];
        for (int i = 0; i < 64; ++i) s += h1[i] * p.hy_f_w2[(l * 64 + i) * 64 + tid];
        h2[tid] = sinf(p.hy_freq[(l * 2 + 1) * 64 + tid] * s);
    }
    __syncthreads();
    float* kern = (float*)(p.ws + (type ? OFF_KERNC + (size_t)l * 512 * 256 * 4 : OFF_KERNL + (size_t)l * 4096 * 256 * 4));
    const float lo = logf(1e-2f) / 1.5f, hi = logf(1e-2f) / 0.3f;
    for (int o = tid; o < 512; o += 256) {
        float s = 0.f;
        for (int i = 0; i < 64; ++i) s += h2[i] * p.hy_f_w3[(l * 64 + i) * 512 + o];
        const int c = o & 255;
        const float delta = fabsf(lo + (float)c * ((hi - lo) / 255.f));
        const float v = s * expf(-tt * delta);
        if (o < 256) kern[(size_t)(n - 1 + t) * 256 + c] = v;
        else if (t >= 1) kern[(size_t)(n - 1 - t) * 256 + c] = v;
    }
    __syncthreads();
}
DEV void conv_tile(const float* src, int ldsrc, int k0, int n0, bf16_t* dst, int lddst, int mapkind, char* lds) {
    float* tl = (float*)lds;
    const int tid = threadIdx.x;
    {
        const int r = tid >> 4, c4 = (tid & 15) * 4;
#pragma unroll
        for (int i = 0; i < 4; ++i) {
            const int row = r + 16 * i;
            const f32x4 v = *(const f32x4*)(src + (size_t)(k0 + row) * ldsrc + n0 + c4);
            tl[row * 65 + c4 + 0] = v[0]; tl[row * 65 + c4 + 1] = v[1]; tl[row * 65 + c4 + 2] = v[2]; tl[row * 65 + c4 + 3] = v[3];
        }
    }
    __syncthreads();
    {
        const int n = tid >> 2, kc = tid & 3, ng = n0 + n;
        int drow = ng;
        if (mapkind == 1) drow = 32 * (ng >> 4) + (ng & 15);
        else if (mapkind == 2) drow = 32 * (ng >> 4) + 16 + (ng & 15);
        unsigned w[8];
#pragma unroll
        for (int j = 0; j < 8; ++j) w[j] = pk2(tl[(kc * 16 + 2 * j) * 65 + n], tl[(kc * 16 + 2 * j + 1) * 65 + n]);
        u32x4* d = (u32x4*)(dst + (size_t)drow * lddst + k0 + kc * 16);
        d[0] = (u32x4){w[0], w[1], w[2], w[3]};
        d[1] = (u32x4){w[4], w[5], w[6], w[7]};
    }
    __syncthreads();
}
DEV void conv_fixed_item(const Params& p, int it, char* lds) {
    const int l = it / 1040; int r = it % 1040;
    unsigned char* ws = p.ws;
    if (r < 576) { conv_tile(p.w_in + (size_t)l * 1024 * PROJ, PROJ, (r / 36) * 64, (r % 36) * 64, (bf16_t*)(ws + OFF_WIN) + (size_t)l * PROJ * 1024, 1024, 0, lds); return; }
    r -= 576;
    if (r < 256) { conv_tile(p.w_out + (size_t)l * 1024 * 1024, 1024, (r / 16) * 64, (r % 16) * 64, (bf16_t*)(ws + OFF_WOUT) + (size_t)l * 1024 * 1024, 1024, 0, lds); return; }
    r -= 256;
    if (r < 64) { conv_tile(p.sh_w1 + (size_t)l * 1024 * 256, 256, (r / 4) * 64, (r % 4) * 64, (bf16_t*)(ws + OFF_SW13) + (size_t)l * 512 * 1024, 1024, 1, lds); return; }
    r -= 64;
    if (r < 64) { conv_tile(p.sh_w3 + (size_t)l * 1024 * 256, 256, (r / 4) * 64, (r % 4) * 64, (bf16_t*)(ws + OFF_SW13) + (size_t)l * 512 * 1024, 1024, 2, lds); return; }
    r -= 64;
    if (r < 64) { conv_tile(p.sh_w2 + (size_t)l * 256 * 1024, 1024, (r / 16) * 64, (r % 16) * 64, (bf16_t*)(ws + OFF_SW2) + (size_t)l * 1024 * 256, 256, 0, lds); return; }
    r -= 64;
    conv_tile(p.router_w + (size_t)l * 1024 * 64, 64, r * 64, 0, (bf16_t*)(ws + OFF_RW) + (size_t)l * 64 * 1024, 1024, 0, lds);
}
DEV void conv_expert_item(const Params& p, int l, int it, char* lds) {
    const int e = it / 96; int r = it % 96;
    unsigned char* ws = p.ws;
    const size_t eo = (size_t)(l * 64 + e) * 1024 * 128;
    if (r < 32) { conv_tile(p.exp_w1 + eo, 128, (r / 2) * 64, (r % 2) * 64, (bf16_t*)(ws + OFF_W13) + (size_t)e * 256 * 1024, 1024, 1, lds); return; }
    r -= 32;
    if (r < 32) { conv_tile(p.exp_w3 + eo, 128, (r / 2) * 64, (r % 2) * 64, (bf16_t*)(ws + OFF_W13) + (size_t)e * 256 * 1024, 1024, 2, lds); return; }
    r -= 32;
    conv_tile(p.exp_w2 + eo, 1024, (r / 16) * 64, (r % 16) * 64, (bf16_t*)(ws + OFF_W2) + (size_t)e * 1024 * 128, 128, 0, lds);
}
DEV void phase_prep(const Params& p, char* lds) {
    if (blockIdx.x == 0 && threadIdx.x < 128) ((int*)(p.ws + OFF_CNT))[threadIdx.x] = 0;
    constexpr int N0 = 1536, N1 = N0 + 256, N2 = N1 + 4608, N3 = N2 + 2080, N4 = N3 + 6144;
    for (int it = blockIdx.x; it < N4; it += gridDim.x) {
        if (it < N0) prep_mod_item(p, it, lds);
        else if (it < N1) prep_rope_item(p, it - N0);
        else if (it < N2) prep_filter_item(p, it - N1, lds);
        else if (it < N3) conv_fixed_item(p, it - N2, lds);
        else conv_expert_item(p, 0, it - N3, lds);
    }
}
DEV void phase_modfin(const Params& p) {
    const float* part = (const float*)(p.ws + OFF_PART);
    float* mod = (float*)(p.ws + OFF_MOD);
    for (int idx = blockIdx.x * 256 + threadIdx.x; idx < 2 * 9 * 6144; idx += gridDim.x * 256) {
        const int l = idx / (9 * 6144), g = (idx / 6144) % 9, col = idx % 6144;
        float s = p.ada_b[l * 6144 + col];
        for (int k = 0; k < 32; ++k) s += part[((size_t)(k * 2 + l) * 9 + g) * 6144 + col];
        mod[idx] = s;
    }
}

DEV void row_load(const float* src, f32x4 (&v)[4], int lane) {
#pragma unroll
    for (int j = 0; j < 4; ++j) v[j] = *(const f32x4*)(src + 4 * lane + 256 * j);
}
DEV void row_norm(f32x4 (&v)[4]) {
    float s = 0.f;
#pragma unroll
    for (int j = 0; j < 4; ++j) s += (v[j][0] + v[j][1]) + (v[j][2] + v[j][3]);
    const float mean = wave_sum(s) * (1.f / 1024.f);
    float q = 0.f;
#pragma unroll
    for (int j = 0; j < 4; ++j) { v[j] = v[j] - mean; q += (v[j][0] * v[j][0] + v[j][1] * v[j][1]) + (v[j][2] * v[j][2] + v[j][3] * v[j][3]); }
    const float rstd = 1.0f / sqrtf(wave_sum(q) * (1.f / 1024.f) + 1e-6f);
#pragma unroll
    for (int j = 0; j < 4; ++j) v[j] = v[j] * rstd;
}
DEV void row_store_mod_bf16(bf16_t* dst, const f32x4 (&v)[4], const float* shift, const float* scale, int lane) {
#pragma unroll
    for (int j = 0; j < 4; ++j) {
        const int c = 4 * lane + 256 * j;
        const f32x4 sh = *(const f32x4*)(shift + c), sc = *(const f32x4*)(scale + c);
        const f32x4 o = v[j] * (sc + 1.0f) + sh;
        *(u32x2*)(dst + c) = (u32x2){pk2(o[0], o[1]), pk2(o[2], o[3])};
    }
}
DEV void phase_lnmod0(const Params& p) {
    const int lane = threadIdx.x & 63, wid = threadIdx.x >> 6;
    const float* mod = (const float*)(p.ws + OFF_MOD);
    bf16_t* H = (bf16_t*)(p.ws + OFF_H);
    for (int row = blockIdx.x * 4 + wid; row < NT; row += gridDim.x * 4) {
        const float* src = row < NLAT ? p.x + (size_t)row * 1024 : p.ctx + (size_t)(row - NLAT) * 1024;
        f32x4 v[4]; row_load(src, v, lane); row_norm(v);
        const float* m = mod + (size_t)mod_group(row) * 6144;
        row_store_mod_bf16(H + (size_t)row * 1024, v, m, m + 1024, lane);
    }
}

DEV void phase_inproj(const Params& p, int l, char* lds) {
    const int tid = threadIdx.x, lane = tid & 63, wid = tid >> 6, fr = lane & 15, fq = lane >> 4, wr = wid >> 1, wc = wid & 1;
    unsigned char* ws = p.ws;
    const bf16_t* H = (const bf16_t*)(ws + OFF_H);
    const bf16_t* W = (const bf16_t*)(ws + OFF_WIN) + (size_t)l * PROJ * 1024;
    const float* ropec = (const float*)(ws + OFF_ROPE); const float* ropes = ropec + 2048 * 32;
    const int nitems = 128 * 18 + 16 * (l == 0 ? 18 : 6);
    for (int it = blockIdx.x; it < nitems; it += gridDim.x) {
        int mt, nt;
        if (it < 2304) { mt = it / 18; nt = it % 18; }
        else { const int j = it - 2304; if (l == 0) { mt = 128 + j / 18; nt = j % 18; } else { mt = 128 + j / 6; const int q = j % 6; nt = q < 2 ? 4 + q : 6 + q; } }
        const int m0 = mt * 128, n0 = nt * 128;
        const bf16_t* a0 = H + (size_t)(m0 + (tid >> 2)) * 1024 + (tid & 3) * 8;
        const bf16_t* b0 = W + (size_t)(n0 + (tid >> 2)) * 1024 + (tid & 3) * 8;
        f32x4 acc[4][4]; zero_acc<4>(acc);
        const bool latent = m0 < NLAT;
        const int b = latent ? (m0 >> 11) : ((m0 - NLAT) >> 8);
        const int tbase = latent ? (m0 & 2047) : ((m0 - NLAT) & 255);
        if (nt >= 12) {
            gemm_core<4, false>(acc, a0, a0 + 64 * 1024, b0, b0 + 64 * 1024, 1024, lds);
            bf16_t* zt = latent ? (bf16_t*)(ws + OFF_ZTL) + (size_t)b * 768 * 2048 : (bf16_t*)(ws + OFF_ZTC) + (size_t)b * 768 * 256;
            const int n = latent ? 2048 : 256;
#pragma unroll
            for (int m = 0; m < 4; ++m)
#pragma unroll
                for (int nn = 0; nn < 4; ++nn) {
                    const int ch = n0 - 1536 + wc * 64 + nn * 16 + fr, t = tbase + wr * 64 + m * 16 + 4 * fq;
                    *(u32x2*)(zt + (size_t)ch * n + t) = (u32x2){pk2(acc[m][nn][0], acc[m][nn][1]), pk2(acc[m][nn][2], acc[m][nn][3])};
                }
        } else {
            gemm_core<4, true>(acc, a0, a0 + 64 * 1024, b0, b0 + 64 * 1024, 1024, lds);
            const int col0 = n0 + wc * 64;
            int kind, hh;
            if (col0 < 512) { kind = 0; hh = col0 >> 6; } else if (col0 < 640) { kind = 1; hh = (col0 - 512) >> 6; } else if (col0 < 768) { kind = 2; hh = (col0 - 640) >> 6; }
            else if (col0 < 1024) { kind = 3; hh = (col0 - 768) >> 6; } else if (col0 < 1280) { kind = 4; hh = (col0 - 1024) >> 6; } else { kind = 5; hh = (col0 - 1280) >> 6; }
            const bool normed = (kind == 0 || kind == 1);
            const float* gain = (kind == 0 ? p.q_gain : p.k_gain) + l * 64;
#pragma unroll
            for (int m = 0; m < 4; ++m) {
                const int rloc = wr * 64 + m * 16 + fr, row = m0 + rloc, t = tbase + rloc;
                f32x4 v[4];
#pragma unroll
                for (int nn = 0; nn < 4; ++nn) v[nn] = acc[m][nn];
                if (normed) {
                    float ss = 0.f;
#pragma unroll
                    for (int nn = 0; nn < 4; ++nn) ss += (v[nn][0] * v[nn][0] + v[nn][1] * v[nn][1]) + (v[nn][2] * v[nn][2] + v[nn][3] * v[nn][3]);
                    ss += __shfl_xor(ss, 16); ss += __shfl_xor(ss, 32);
                    const float r = 1.0f / sqrtf(ss * (1.f / 64.f) + 1e-6f);
#pragma unroll
                    for (int nn = 0; nn < 4; ++nn) {
                        const f32x4 g = *(const f32x4*)(gain + nn * 16 + 4 * fq);
                        v[nn] = v[nn] * r * g;
                        if (latent) {
                            const int pi = nn * 8 + 2 * fq;
                            const float c0 = ropec[t * 32 + pi], s0 = ropes[t * 32 + pi], c1 = ropec[t * 32 + pi + 1], s1 = ropes[t * 32 + pi + 1];
                            const float x0 = v[nn][0], x1 = v[nn][1], x2 = v[nn][2], x3 = v[nn][3];
                            v[nn][0] = x0 * c0 - x1 * s0; v[nn][1] = x0 * s0 + x1 * c0;
                            v[nn][2] = x2 * c1 - x3 * s1; v[nn][3] = x2 * s1 + x3 * c1;
                        }
                    }
                }
                bf16_t* dst;
                const int key = latent ? 256 + t : t;
                if (kind == 0) dst = (bf16_t*)(ws + OFF_QA) + ((size_t)hh * NT + row) * 64;
                else if (kind == 3) dst = (bf16_t*)(ws + OFF_QB) + ((size_t)hh * NT + row) * 64;
                else if (kind == 1) dst = (bf16_t*)(ws + OFF_KA) + ((size_t)(b * 2 + hh) * KEYS + key) * 64;
                else if (kind == 2) dst = (bf16_t*)(ws + OFF_VA) + ((size_t)(b * 2 + hh) * KEYS + key) * 64;
                else if (kind == 4) dst = (bf16_t*)(ws + OFF_KB) + ((size_t)(b * 4 + hh) * KEYS + key) * 64;
                else dst = (bf16_t*)(ws + OFF_VB) + ((size_t)(b * 4 + hh) * KEYS + key) * 64;
#pragma unroll
                for (int nn = 0; nn < 4; ++nn) *(u32x2*)(dst + nn * 16 + 4 * fq) = (u32x2){pk2(v[nn][0], v[nn][1]), pk2(v[nn][2], v[nn][3])};
            }
        }
    }
}

template <int NQT, bool NA>
DEV void attn_block(const bf16_t* Qh, int qrow0, const bf16_t* Kh, const bf16_t* Vh, int ntiles, bf16_t* outp  ,
                    int na_r, int na_rs, const float* rpb_h, char* lds) {
    const int tid = threadIdx.x, lane = tid & 63, wid = tid >> 6, fr = lane & 15, fq = lane >> 4;
    char* KBUF = lds;
    char* VBUF = lds + 16384;
    float* BIAS = (float*)(lds + 32768);
    const float c1 = 0.125f * LOG2E;
    if (NA) {
        for (int i = tid; i < 15 * 32; i += 256) { const int dr = i >> 5, dc = i & 31; BIAS[i] = dc < 31 ? rpb_h[dr * 31 + dc] * LOG2E : 0.f; }
    }
    bf16x8 qf[NQT][2];
    const int qw = qrow0 + wid * 16 * NQT;
#pragma unroll
    for (int nq = 0; nq < NQT; ++nq)
#pragma unroll
        for (int ks = 0; ks < 2; ++ks) qf[nq][ks] = *(const bf16x8*)(Qh + (size_t)(qw + nq * 16 + fr) * 64 + ks * 32 + fq * 8);
    f32x4 oacc[4][NQT];
    float mrun[NQT], lsum[NQT];
#pragma unroll
    for (int nq = 0; nq < NQT; ++nq) { mrun[nq] = -1e30f; lsum[nq] = 0.f;
#pragma unroll
        for (int dt = 0; dt < 4; ++dt) oacc[dt][nq] = (f32x4){0.f, 0.f, 0.f, 0.f}; }
    const int lrow0 = tid >> 3, lch = tid & 7;
    auto key0_of = [&](int ti) -> int { if (NA) return ti < 8 ? 256 + (na_rs + ti) * 64 : (ti - 8) * 64; return ti * 64; };
    u32x4 kreg[2], vreg[2];
    auto gload = [&](int ti) {
        const int k0 = key0_of(ti);
#pragma unroll
        for (int i = 0; i < 2; ++i) {
            const int row = lrow0 + 32 * i;
            kreg[i] = *(const u32x4*)(Kh + (size_t)(k0 + row) * 64 + lch * 8);
            vreg[i] = *(const u32x4*)(Vh + (size_t)(k0 + row) * 64 + lch * 8);
        }
    };
    auto lstore = [&](int buf) {
#pragma unroll
        for (int i = 0; i < 2; ++i) {
            const int row = lrow0 + 32 * i;
            const int off = buf * 8192 + row * 128 + ((lch ^ (row & 7)) * 16);
            *(u32x4*)(KBUF + off) = kreg[i];
            *(u32x4*)(VBUF + off) = vreg[i];
        }
    };
    gload(0); lstore(0);
    __syncthreads();
    for (int ti = 0; ti < ntiles; ++ti) {
        const int buf = ti & 1;
        if (ti + 1 < ntiles) gload(ti + 1);
        const char* kb = KBUF + buf * 8192; const char* vb = VBUF + buf * 8192;
        f32x4 sacc[4][NQT];
#pragma unroll
        for (int mt = 0; mt < 4; ++mt) {
            const int row = mt * 16 + fr;
            bf16x8 kf0 = *(const bf16x8*)(kb + row * 128 + (((0 + fq) ^ (row & 7)) * 16));
            bf16x8 kf1 = *(const bf16x8*)(kb + row * 128 + (((4 + fq) ^ (row & 7)) * 16));
#pragma unroll
            for (int nq = 0; nq < NQT; ++nq) {
                f32x4 s = (f32x4){0.f, 0.f, 0.f, 0.f};
                s = mfma16(kf0, qf[nq][0], s);
                s = mfma16(kf1, qf[nq][1], s);
                sacc[mt][nq] = s;
            }
        }
        bf16x8 pf[2][NQT];
#pragma unroll
        for (int nq = 0; nq < NQT; ++nq) {
            float tv[4][4];
            if (NA && ti < 8) {
                const int qc = wid * 16 * NQT + nq * 16 + fr;
                int cs = qc - 8; cs = cs < 0 ? 0 : (cs > 48 ? 48 : cs);
                const int dr = na_rs + ti - na_r + 7;
#pragma unroll
                for (int mt = 0; mt < 4; ++mt)
#pragma unroll
                    for (int j = 0; j < 4; ++j) {
                        const int kc = mt * 16 + 4 * fq + j;
                        const bool ok = (kc >= cs) && (kc < cs + 16);
                        int dc = kc - qc + 15; dc = dc < 0 ? 0 : (dc > 30 ? 30 : dc);
                        tv[mt][j] = ok ? sacc[mt][nq][j] * c1 + BIAS[dr * 32 + dc] : -1e30f;
                    }
            } else {
#pragma unroll
                for (int mt = 0; mt < 4; ++mt)
#pragma unroll
                    for (int j = 0; j < 4; ++j) tv[mt][j] = sacc[mt][nq][j] * c1;
            }
            float tmax = -1e30f;
#pragma unroll
            for (int mt = 0; mt < 4; ++mt)
#pragma unroll
                for (int j = 0; j < 4; ++j) tmax = fmaxf(tmax, tv[mt][j]);
            tmax = fmaxf(tmax, __shfl_xor(tmax, 16)); tmax = fmaxf(tmax, __shfl_xor(tmax, 32));
            const float mnew = fmaxf(mrun[nq], tmax);
            const float alpha = exp2f(mrun[nq] - mnew);
            mrun[nq] = mnew;
            float ps = 0.f;
#pragma unroll
            for (int mt = 0; mt < 4; ++mt)
#pragma unroll
                for (int j = 0; j < 4; ++j) { const float e = exp2f(tv[mt][j] - mnew); tv[mt][j] = e; ps += e; }
            lsum[nq] = lsum[nq] * alpha + ps;
#pragma unroll
            for (int dt = 0; dt < 4; ++dt) oacc[dt][nq] = oacc[dt][nq] * alpha;
#pragma unroll
            for (int ks = 0; ks < 2; ++ks) {
                union { bf16x8 v; unsigned u[4]; } pk;
                pk.u[0] = pk2(tv[2 * ks][0], tv[2 * ks][1]); pk.u[1] = pk2(tv[2 * ks][2], tv[2 * ks][3]);
                pk.u[2] = pk2(tv[2 * ks + 1][0], tv[2 * ks + 1][1]); pk.u[3] = pk2(tv[2 * ks + 1][2], tv[2 * ks + 1][3]);
                pf[ks][nq] = pk.v;
            }
        }
        {
            const int q4 = fr >> 2, p4 = fr & 3;
#pragma unroll
            for (int ks = 0; ks < 2; ++ks)
#pragma unroll
                for (int dt = 0; dt < 4; ++dt) {
                    const int keyA = 16 * (2 * ks) + 4 * fq + q4, keyB = keyA + 16;
                    const int ch = dt * 2 + (p4 >> 1);
                    const int offA = keyA * 128 + ((ch ^ (keyA & 7)) * 16) + (p4 & 1) * 8;
                    const int offB = keyB * 128 + ((ch ^ (keyB & 7)) * 16) + (p4 & 1) * 8;
                    const s16x4 ta = __builtin_amdgcn_ds_read_tr16_b64_v4i16((LDSP(s16x4))(vb + offA));
                    const s16x4 tb = __builtin_amdgcn_ds_read_tr16_b64_v4i16((LDSP(s16x4))(vb + offB));
                    bf16x8 vf; vf[0] = ta[0]; vf[1] = ta[1]; vf[2] = ta[2]; vf[3] = ta[3]; vf[4] = tb[0]; vf[5] = tb[1]; vf[6] = tb[2]; vf[7] = tb[3];
#pragma unroll
                    for (int nq = 0; nq < NQT; ++nq) oacc[dt][nq] = mfma16(vf, pf[ks][nq], oacc[dt][nq]);
                }
        }
        if (ti + 1 < ntiles) lstore(buf ^ 1);
        __syncthreads();
    }
#pragma unroll
    for (int nq = 0; nq < NQT; ++nq) {
        float ls = lsum[nq]; ls += __shfl_xor(ls, 16); ls += __shfl_xor(ls, 32);
        const float inv = 1.0f / ls;
        bf16_t* o = outp + (size_t)(qw + nq * 16 + fr) * 1024;
#pragma unroll
        for (int dt = 0; dt < 4; ++dt) {
            const f32x4 v = oacc[dt][nq] * inv;
            *(u32x2*)(o + dt * 16 + 4 * fq) = (u32x2){pk2(v[0], v[1]), pk2(v[2], v[3])};
        }
    }
    __syncthreads();
}

DEV float hy_sconv(const bf16_t* zrow, int t, int n, float w0, float w1, float w2, float bias) {
    const float zm = t > 0 ? bf2f(zrow[t - 1]) : 0.f, z0 = bf2f(zrow[t]), zp = t + 1 < n ? bf2f(zrow[t + 1]) : 0.f;
    return w0 * zm + w1 * z0 + w2 * zp + bias;
}
template <int NJ>
DEV void hyena_item(const Params& p, int l, int type, int c, int bh, char* lds) {
    constexpr int n = 256 * NJ;
    const int tid = threadIdx.x;
    f32x4* U = (f32x4*)lds;
    float* KR = (float*)(lds + n * 16);
    const bf16_t* zt = type ? (const bf16_t*)(p.ws + OFF_ZTC) : (const bf16_t*)(p.ws + OFF_ZTL);
    const float* kern = (const float*)(p.ws + (type ? OFF_KERNC + (size_t)l * 512 * 256 * 4 : OFF_KERNL + (size_t)l * 4096 * 256 * 4));
    const float* cw = p.hy_conv_w + l * 3 * 768; const float* cb = p.hy_conv_b + l * 768;
    const float w10 = cw[256 + c], w11 = cw[768 + 256 + c], w12 = cw[1536 + 256 + c], b1 = cb[256 + c];
    const float wv0 = cw[512 + c], wv1 = cw[768 + 512 + c], wv2 = cw[1536 + 512 + c], bv = cb[512 + c];
    const float w00 = cw[c], w01 = cw[768 + c], w02 = cw[1536 + c], b0 = cb[c];
    for (int i = tid; i < 2 * n - 1; i += 256) KR[i] = kern[(size_t)i * 256 + c];
    for (int s = tid; s < n; s += 256) {
        f32x4 u;
#pragma unroll
        for (int bb = 0; bb < 4; ++bb) {
            const bf16_t* zb = zt + (size_t)(bh * 4 + bb) * 768 * n;
            const float x1 = hy_sconv(zb + (size_t)(256 + c) * n, s, n, w10, w11, w12, b1);
            const float vv = hy_sconv(zb + (size_t)(512 + c) * n, s, n, wv0, wv1, wv2, bv);
            u[bb] = vv * x1;
        }
        U[s] = u;
    }
    __syncthreads();
    f32x4 acc[NJ];
#pragma unroll
    for (int j = 0; j < NJ; ++j) acc[j] = (f32x4){0.f, 0.f, 0.f, 0.f};
    const float* kp = KR + tid + (n - 1);
    for (int s = 0; s < n; ++s) {
        const f32x4 u = U[s];
#pragma unroll
        for (int j = 0; j < NJ; ++j) acc[j] += u * kp[256 * j - s];
    }
    const float skip = p.hy_skip[l * 256 + c];
    bf16_t* ox = (bf16_t*)(p.ws + OFF_OX);
#pragma unroll
    for (int j = 0; j < NJ; ++j) {
        const int t = tid + 256 * j;
        const f32x4 u = U[t];
#pragma unroll
        for (int bb = 0; bb < 4; ++bb) {
            const int b = bh * 4 + bb;
            const bf16_t* zb = zt + (size_t)b * 768 * n;
            const float x0 = hy_sconv(zb + (size_t)c * n, t, n, w00, w01, w02, b0);
            const float y = (acc[j][bb] + u[bb] * skip) * x0;
            const int row = type ? NLAT + b * 256 + t : b * 2048 + t;
            ox[(size_t)row * 1024 + 768 + c] = (bf16_t)f2bf(y);
        }
    }
    __syncthreads();
}

DEV void phase_mix(const Params& p, int l, char* lds) {
    unsigned char* ws = p.ws;
    const bf16_t* QA = (const bf16_t*)(ws + OFF_QA); const bf16_t* QB = (const bf16_t*)(ws + OFF_QB);
    const bf16_t* KA = (const bf16_t*)(ws + OFF_KA); const bf16_t* VA = (const bf16_t*)(ws + OFF_VA);
    const bf16_t* KBp = (const bf16_t*)(ws + OFF_KB); const bf16_t* VBp = (const bf16_t*)(ws + OFF_VB);
    bf16_t* OX = (bf16_t*)(ws + OFF_OX);
    const int N0 = 512, N1 = N0 + 1024, N2 = N1 + 1024;
    const int N3 = N2 + (l == 0 ? 512 : 0), N4 = N3 + (l == 0 ? 128 : 0), N5 = N4 + (l == 0 ? 64 : 0);
    for (int it = blockIdx.x; it < N5; it += gridDim.x) {
        if (it < N0) { hyena_item<8>(p, l, 0, it >> 1, it & 1, lds); }
        else if (it < N1) {
            const int j = it - N0, b = j >> 7, h = (j >> 4) & 7, qb = j & 15;
            attn_block<2, false>(QA + (size_t)h * NT * 64, b * 2048 + qb * 128, KA + (size_t)(b * 2 + (h >> 2)) * KEYS * 64, VA + (size_t)(b * 2 + (h >> 2)) * KEYS * 64,
                                 36, OX + h * 64, 0, 0, nullptr, lds);
        } else if (it < N2) {
            const int j = it - N1, b = j >> 7, h = (j >> 5) & 3, r = j & 31;
            int rs = r - 4; rs = rs < 0 ? 0 : (rs > 24 ? 24 : rs);
            attn_block<1, true>(QB + (size_t)h * NT * 64, b * 2048 + r * 64, KBp + (size_t)(b * 4 + h) * KEYS * 64, VBp + (size_t)(b * 4 + h) * KEYS * 64,
                                12, OX + 512 + h * 64, r, rs, p.nat_rpb + (size_t)(l * 4 + h) * 15 * 31, lds);
        } else if (it < N3) { const int j = it - N2; hyena_item<1>(p, l, 1, j >> 1, j & 1, lds); }
        else if (it < N4) {
            const int j = it - N3, b = j >> 4, h = (j >> 1) & 7, qb = j & 1;
            attn_block<2, false>(QA + (size_t)h * NT * 64, NLAT + b * 256 + qb * 128, KA + (size_t)(b * 2 + (h >> 2)) * KEYS * 64, VA + (size_t)(b * 2 + (h >> 2)) * KEYS * 64,
                                 4, OX + h * 64, 0, 0, nullptr, lds);
        } else {
            const int j = it - N4, b = j >> 3, h = (j >> 1) & 3, qb = j & 1;
            attn_block<2, false>(QB + (size_t)h * NT * 64, NLAT + b * 256 + qb * 128, KBp + (size_t)(b * 4 + h) * KEYS * 64, VBp + (size_t)(b * 4 + h) * KEYS * 64,
                                 4, OX + 512 + h * 64, 0, 0, nullptr, lds);
        }
    }
}

DEV void phase_outproj(const Params& p, int l, char* lds) {
    const int tid = threadIdx.x, lane = tid & 63, wid = tid >> 6, fr = lane & 15, fq = lane >> 4, wr = wid >> 1, wc = wid & 1;
    const bf16_t* OX = (const bf16_t*)(p.ws + OFF_OX);
    const bf16_t* W = (const bf16_t*)(p.ws + OFF_WOUT) + (size_t)l * 1024 * 1024;
    const float* mod = (const float*)(p.ws + OFF_MOD) + (size_t)l * 9 * 6144;
    float* X = (float*)(p.ws + OFF_X);
    const int nitems = (l == 0 ? 144 : 128) * 8;
    for (int it = blockIdx.x; it < nitems; it += gridDim.x) {
        const int mt = it >> 3, nt = it & 7, m0 = mt * 128, n0 = nt * 128;
        const bf16_t* a0 = OX + (size_t)(m0 + (tid >> 2)) * 1024 + (tid & 3) * 8;
        const bf16_t* b0 = W + (size_t)(n0 + (tid >> 2)) * 1024 + (tid & 3) * 8;
        f32x4 acc[4][4]; zero_acc<4>(acc);
        gemm_core<4, true>(acc, a0, a0 + 64 * 1024, b0, b0 + 64 * 1024, 1024, lds);
        const float* g1 = mod + (size_t)mod_group(m0) * 6144 + 2048;
#pragma unroll
        for (int m = 0; m < 4; ++m) {
            const int row = m0 + wr * 64 + m * 16 + fr;
            const float* xin = (l == 0) ? (row < NLAT ? p.x + (size_t)row * 1024 : p.ctx + (size_t)(row - NLAT) * 1024) : X + (size_t)row * 1024;
#pragma unroll
            for (int nn = 0; nn < 4; ++nn) {
                const int col = n0 + wc * 64 + nn * 16 + 4 * fq;
                const f32x4 xv = *(const f32x4*)(xin + col), g = *(const f32x4*)(g1 + col);
                *(f32x4*)(X + (size_t)row * 1024 + col) = xv * DN_ALPHA + g * acc[m][nn];
            }
        }
    }
}

DEV void phase_ln1route(const Params& p, int l, char* lds) {
    const int tid = threadIdx.x, lane = tid & 63, wid = tid >> 6, fr = lane & 15, fq = lane >> 4;
    float* X = (float*)(p.ws + OFF_X);
    bf16_t* H = (bf16_t*)(p.ws + OFF_H);
    const bf16_t* RW = (const bf16_t*)(p.ws + OFF_RW) + (size_t)l * 64 * 1024;
    const float* mod = (const float*)(p.ws + OFF_MOD) + (size_t)l * 9 * 6144;
    int* cnt = (int*)(p.ws + OFF_CNT) + l * 64;
    int* tke = (int*)(p.ws + OFF_TKE); int* tks = (int*)(p.ws + OFF_TKS); float* tkw = (float*)(p.ws + OFF_TKW);
    int* list = (int*)(p.ws + OFF_LIST);
    float* SC = (float*)(lds + 8192);
    float* SEL = (float*)(lds + 8192 + 16384);
    const int nitems = (l == 0 ? NT : NLAT) / 64;
    for (int it = blockIdx.x; it < nitems; it += gridDim.x) {
        const int m0 = it * 64;
        const float* mg = mod + (size_t)mod_group(m0) * 6144;
        for (int i = 0; i < 16; ++i) {
            const int row = m0 + wid * 16 + i;
            f32x4 v[4]; row_load(X + (size_t)row * 1024, v, lane); row_norm(v);
#pragma unroll
            for (int j = 0; j < 4; ++j) {
                const int c = 4 * lane + 256 * j;
                v[j] = v[j] * *(const f32x4*)(p.ln1_g + l * 1024 + c) + *(const f32x4*)(p.ln1_b + l * 1024 + c);
                *(f32x4*)(X + (size_t)row * 1024 + c) = v[j];
            }
            row_norm(v);
            row_store_mod_bf16(H + (size_t)row * 1024, v, mg + 3072, mg + 4096, lane);
        }
        __syncthreads();
        f32x4 acc[4];
#pragma unroll
        for (int n = 0; n < 4; ++n) acc[n] = (f32x4){0.f, 0.f, 0.f, 0.f};
        {
            const bf16_t* a0 = H + (size_t)(m0 + (tid >> 2)) * 1024 + (tid & 3) * 8;
            const bf16_t* b0 = RW + (size_t)(tid >> 2) * 1024 + (tid & 3) * 8;
            char* SA = lds; char* SB = lds + 4096;
            for (int kt = 0; kt < 1024; kt += 32) {
                glds16(a0 + kt, SA + tid * 16);
                glds16(b0 + kt, SB + tid * 16);
                asm volatile("s_waitcnt vmcnt(0)" ::: "memory");
                __syncthreads();
                const bf16x8 af = *(const bf16x8*)(SA + ((wid * 16 + fr) * 64 + fq * 16));
#pragma unroll
                for (int n = 0; n < 4; ++n) { const bf16x8 bq = *(const bf16x8*)(SB + ((n * 16 + fr) * 64 + fq * 16)); acc[n] = mfma16(bq, af, acc[n]); }
                __syncthreads();
            }
        }
#pragma unroll
        for (int n = 0; n < 4; ++n)
#pragma unroll
            for (int j = 0; j < 4; ++j) {
                const int e = n * 16 + 4 * fq + j;
                const float s = 1.0f / (1.0f + expf(-acc[n][j]));
                SC[(wid * 16 + fr) * 64 + e] = s;
                SEL[(wid * 16 + fr) * 64 + e] = s + p.router_b[l * 64 + e];
            }
        __syncthreads();
        if (tid < 64) {
            const int row = m0 + tid;
            const float* sel = SEL + tid * 64; const float* sc = SC + tid * 64;
            float gs[8];
#pragma unroll
            for (int g = 0; g < 8; ++g) {
                float m1 = -1e30f, m2 = -1e30f;
#pragma unroll
                for (int j = 0; j < 8; ++j) { const float v = sel[g * 8 + j]; if (v > m1) { m2 = m1; m1 = v; } else if (v > m2) m2 = v; }
                gs[g] = m1 + m2;
            }
            unsigned gmask = 0;
#pragma unroll
            for (int r = 0; r < 4; ++r) {
                int best = 0; float bv = -1e30f;
#pragma unroll
                for (int g = 0; g < 8; ++g) { const bool free = !((gmask >> g) & 1u); if (free && gs[g] > bv) { bv = gs[g]; best = g; } }
                gmask |= 1u << best;
            }
            unsigned long long chosen = 0ull;
            int es[8]; float wsel[8]; float wsum = 0.f;
#pragma unroll
            for (int k = 0; k < 8; ++k) {
                int best = 0; float bv = -1e30f;
                for (int e = 0; e < 64; ++e) {
                    const bool ok = ((gmask >> (e >> 3)) & 1u) && !((chosen >> e) & 1ull);
                    const float v = sel[e];
                    if (ok && v > bv) { bv = v; best = e; }
                }
                chosen |= 1ull << best;
                es[k] = best; wsel[k] = sc[best]; wsum += wsel[k];
            }
            const float wn = 2.5f / wsum;
#pragma unroll
            for (int k = 0; k < 8; ++k) {
                const int e = es[k];
                const int slot = atomicAdd(&cnt[e], 1);
                list[(size_t)e * NT + slot] = row * 8 + k;
                tke[row * 8 + k] = e; tks[row * 8 + k] = slot; tkw[row * 8 + k] = wsel[k] * wn;
            }
        }
        __syncthreads();
    }
}

struct RoundInfo { int nrounds; int e_lo, e_hi; };
DEV RoundInfo moe_round_info(const int* cnt, int cap, int r) {
    RoundInfo ri; ri.e_lo = 0; ri.e_hi = 0;
    int round = 0, start = 0, used = 0;
    for (int e = 0; e < 64; ++e) {
        const int c = cnt[e];
        if (used + c > cap) { if (round == r) { ri.e_lo = start; ri.e_hi = e; } ++round; start = e; used = 0; }
        used += c;
    }
    if (round == r) { ri.e_lo = start; ri.e_hi = 64; }
    ri.nrounds = round + 1;
    return ri;
}

DEV void moe_routed_tile(const Params& p, int e, int s0, int cnt_e, int ysbase, char* lds) {
    const int tid = threadIdx.x, lane = tid & 63, wid = tid >> 6, fr = lane & 15, fq = lane >> 4, wr = wid >> 1, wc = wid & 1;
    const bf16_t* H = (const bf16_t*)(p.ws + OFF_H);
    const bf16_t* W13 = (const bf16_t*)(p.ws + OFF_W13) + (size_t)e * 256 * 1024;
    const bf16_t* W2 = (const bf16_t*)(p.ws + OFF_W2) + (size_t)e * 1024 * 128;
    const int* list = (const int*)(p.ws + OFF_LIST) + (size_t)e * NT;
    const float* tkw = (const float*)(p.ws + OFF_TKW);
    bf16_t* YS = (bf16_t*)(p.ws + OFF_YS);
    char* ACT = lds + 16384;
    const int nvalid = min(128, cnt_e - s0);
    const int r0 = min(tid >> 2, nvalid - 1), r1 = min((tid >> 2) + 64, nvalid - 1);
    const bf16_t* a0 = H + (size_t)(list[s0 + r0] >> 3) * 1024 + (tid & 3) * 8;
    const bf16_t* a1 = H + (size_t)(list[s0 + r1] >> 3) * 1024 + (tid & 3) * 8;
    float gw[4];
#pragma unroll
    for (int m = 0; m < 4; ++m) { const int rl = min(wr * 64 + m * 16 + fr, nvalid - 1); gw[m] = tkw[list[s0 + rl]]; }
#pragma unroll 1
    for (int np = 0; np < 2; ++np) {
        const bf16_t* b0 = W13 + (size_t)(np * 128 + (tid >> 2)) * 1024 + (tid & 3) * 8;
        f32x4 acc[4][4]; zero_acc<4>(acc);
        gemm_core<4, true>(acc, a0, a1, b0, b0 + 64 * 1024, 1024, lds);
#pragma unroll
        for (int m = 0; m < 4; ++m) {
            const int rl = wr * 64 + m * 16 + fr;
#pragma unroll
            for (int pi = 0; pi < 2; ++pi) {
                const int hid = np * 64 + wc * 32 + pi * 16 + 4 * fq;
                float o[4];
#pragma unroll
                for (int j = 0; j < 4; ++j) { const float a = acc[m][2 * pi][j], b = acc[m][2 * pi + 1][j]; o[j] = a / (1.0f + expf(-a)) * b * gw[m]; }
                *(u32x2*)(ACT + rl * 272 + hid * 2) = (u32x2){pk2(o[0], o[1]), pk2(o[2], o[3])};
            }
        }
    }
    __syncthreads();
    char* SB = lds + 8192;
#pragma unroll 1
    for (int nt = 0; nt < 8; ++nt) {
        const bf16_t* b0 = W2 + (size_t)(nt * 128 + (tid >> 2)) * 128 + (tid & 3) * 8;
        f32x4 acc[4][4]; zero_acc<4>(acc);
#pragma unroll 1
        for (int ks = 0; ks < 4; ++ks) {
            glds16(b0 + ks * 32, SB + tid * 16);
            glds16(b0 + 64 * 128 + ks * 32, SB + 4096 + tid * 16);
            asm volatile("s_waitcnt vmcnt(0)" ::: "memory");
            __syncthreads();
            bf16x8 af[4], bfr[4];
#pragma unroll
            for (int m = 0; m < 4; ++m) af[m] = *(const bf16x8*)(ACT + (wr * 64 + m * 16 + fr) * 272 + (ks * 32 + fq * 8) * 2);
#pragma unroll
            for (int n = 0; n < 4; ++n) bfr[n] = *(const bf16x8*)(SB + ((wc * 64 + n * 16 + fr) * 64 + fq * 16));
#pragma unroll
            for (int m = 0; m < 4; ++m)
#pragma unroll
                for (int n = 0; n < 4; ++n) acc[m][n] = mfma16(bfr[n], af[m], acc[m][n]);
            __syncthreads();
        }
#pragma unroll
        for (int m = 0; m < 4; ++m) {
            const int rl = wr * 64 + m * 16 + fr;
            if (rl < nvalid) {
                bf16_t* o = YS + (size_t)(ysbase + s0 + rl) * 1024 + nt * 128 + wc * 64 + 4 * fq;
#pragma unroll
                for (int n = 0; n < 4; ++n) *(u32x2*)(o + n * 16) = (u32x2){pk2(acc[m][n][0], acc[m][n][1]), pk2(acc[m][n][2], acc[m][n][3])};
            }
        }
    }
    __syncthreads();
}
DEV void moe_shared_tile(const Params& p, int l, int m0, char* lds) {
    const int tid = threadIdx.x, lane = tid & 63, wid = tid >> 6, fr = lane & 15, fq = lane >> 4, wr = wid >> 1, wc = wid & 1;
    const bf16_t* H = (const bf16_t*)(p.ws + OFF_H);
    const bf16_t* W13 = (const bf16_t*)(p.ws + OFF_SW13) + (size_t)l * 512 * 1024;
    const bf16_t* W2 = (const bf16_t*)(p.ws + OFF_SW2) + (size_t)l * 1024 * 256;
    const float* g2 = (const float*)(p.ws + OFF_MOD) + (size_t)l * 9 * 6144 + (size_t)mod_group(m0) * 6144 + 5120;
    float* X = (float*)(p.ws + OFF_X);
    char* ACT = lds + 16384;
    const bf16_t* a0 = H + (size_t)(m0 + (tid >> 2)) * 1024 + (tid & 3) * 8;
#pragma unroll 1
    for (int np = 0; np < 4; ++np) {
        const bf16_t* b0 = W13 + (size_t)(np * 128 + (tid >> 2)) * 1024 + (tid & 3) * 8;
        f32x4 acc[2][4]; zero_acc<2>(acc);
        gemm_core<2, true>(acc, a0, a0, b0, b0 + 64 * 1024, 1024, lds);
#pragma unroll
        for (int m = 0; m < 2; ++m) {
            const int rl = wr * 32 + m * 16 + fr;
#pragma unroll
            for (int pi = 0; pi < 2; ++pi) {
                const int hid = np * 64 + wc * 32 + pi * 16 + 4 * fq;
                float o[4];
#pragma unroll
                for (int j = 0; j < 4; ++j) { const float a = acc[m][2 * pi][j], b = acc[m][2 * pi + 1][j]; o[j] = a / (1.0f + expf(-a)) * b; }
                *(u32x2*)(ACT + rl * 528 + hid * 2) = (u32x2){pk2(o[0], o[1]), pk2(o[2], o[3])};
            }
        }
    }
    __syncthreads();
    char* SB = lds + 8192;
#pragma unroll 1
    for (int nt = 0; nt < 8; ++nt) {
        const bf16_t* b0 = W2 + (size_t)(nt * 128 + (tid >> 2)) * 256 + (tid & 3) * 8;
        f32x4 acc[2][4]; zero_acc<2>(acc);
#pragma unroll 1
        for (int ks = 0; ks < 8; ++ks) {
            glds16(b0 + ks * 32, SB + tid * 16);
            glds16(b0 + 64 * 256 + ks * 32, SB + 4096 + tid * 16);
            asm volatile("s_waitcnt vmcnt(0)" ::: "memory");
            __syncthreads();
            bf16x8 af[2], bfr[4];
#pragma unroll
            for (int m = 0; m < 2; ++m) af[m] = *(const bf16x8*)(ACT + (wr * 32 + m * 16 + fr) * 528 + (ks * 32 + fq * 8) * 2);
#pragma unroll
            for (int n = 0; n < 4; ++n) bfr[n] = *(const bf16x8*)(SB + ((wc * 64 + n * 16 + fr) * 64 + fq * 16));
#pragma unroll
            for (int m = 0; m < 2; ++m)
#pragma unroll
                for (int n = 0; n < 4; ++n) acc[m][n] = mfma16(bfr[n], af[m], acc[m][n]);
            __syncthreads();
        }
#pragma unroll
        for (int m = 0; m < 2; ++m) {
            const int row = m0 + wr * 32 + m * 16 + fr;
#pragma unroll
            for (int n = 0; n < 4; ++n) {
                const int col = nt * 128 + wc * 64 + n * 16 + 4 * fq;
                float* xp = X + (size_t)row * 1024 + col;
                const f32x4 xv = *(const f32x4*)xp, g = *(const f32x4*)(g2 + col);
                *(f32x4*)xp = xv * DN_ALPHA + g * acc[m][n];
            }
        }
    }
    __syncthreads();
}
DEV void phase_moe(const Params& p, int l, int r, char* lds) {
    const int* cnt = (const int*)(p.ws + OFF_CNT) + l * 64;
    const RoundInfo ri = moe_round_info(cnt, p.cap, r);
    if (r >= ri.nrounds) return;
    int* SH = (int*)(lds + 60 * 1024);
    if (threadIdx.x == 0) {
        int tp = 0, yb = 0;
        for (int e = ri.e_lo; e < ri.e_hi; ++e) { SH[e] = tp; SH[64 + e] = yb; tp += (cnt[e] + 127) >> 7; yb += cnt[e]; }
        SH[128] = tp;
    }
    __syncthreads();
    const int nrt = SH[128];
    const int nsh = (r == 0) ? (l == 0 ? NT : NLAT) / 64 : 0;
    for (int it = blockIdx.x; it < nrt + nsh; it += gridDim.x) {
        if (it < nrt) {
            int e = ri.e_lo;
            while (e + 1 < ri.e_hi && SH[e + 1] <= it) ++e;
            moe_routed_tile(p, e, (it - SH[e]) * 128, cnt[e], SH[64 + e], lds);
        } else moe_shared_tile(p, l, (it - nrt) * 64, lds);
    }
}

DEV void phase_comb(const Params& p, int l, int r, char* lds) {
    const int lane = threadIdx.x & 63, wid = threadIdx.x >> 6;
    const int* cnt = (const int*)(p.ws + OFF_CNT) + l * 64;
    const RoundInfo ri = moe_round_info(cnt, p.cap, r);
    if (r >= ri.nrounds) return;
    const bool final = (r == ri.nrounds - 1);
    int* SH = (int*)(lds + 60 * 1024);
    if (threadIdx.x == 0) { int yb = 0; for (int e = ri.e_lo; e < ri.e_hi; ++e) { SH[e] = yb; yb += cnt[e]; } }
    __syncthreads();
    float* X = (float*)(p.ws + OFF_X);
    bf16_t* H = (bf16_t*)(p.ws + OFF_H);
    const bf16_t* YS = (const bf16_t*)(p.ws + OFF_YS);
    const int* tke = (const int*)(p.ws + OFF_TKE); const int* tks = (const int*)(p.ws + OFF_TKS);
    const float* mod = (const float*)(p.ws + OFF_MOD);
    const int nrows = (l == 0) ? NT : NLAT;
    for (int row = blockIdx.x * 4 + wid; row < nrows; row += gridDim.x * 4) {
        const int g = mod_group(row);
        const float* g2 = mod + ((size_t)l * 9 + g) * 6144 + 5120;
        f32x4 v[4]; row_load(X + (size_t)row * 1024, v, lane);
        f32x4 s[4];
#pragma unroll
        for (int j = 0; j < 4; ++j) s[j] = (f32x4){0.f, 0.f, 0.f, 0.f};
        for (int k = 0; k < 8; ++k) {
            const int e = tke[row * 8 + k];
            if (e >= ri.e_lo && e < ri.e_hi) {
                const bf16_t* y = YS + (size_t)(SH[e] + tks[row * 8 + k]) * 1024;
#pragma unroll
                for (int j = 0; j < 4; ++j) {
                    const u32x2 w = *(const u32x2*)(y + 4 * lane + 256 * j);
                    s[j][0] += __uint_as_float(w[0] << 16); s[j][1] += __uint_as_float(w[0] & 0xffff0000u);
                    s[j][2] += __uint_as_float(w[1] << 16); s[j][3] += __uint_as_float(w[1] & 0xffff0000u);
                }
            }
        }
#pragma unroll
        for (int j = 0; j < 4; ++j) v[j] = v[j] + *(const f32x4*)(g2 + 4 * lane + 256 * j) * s[j];
        if (!final) {
#pragma unroll
            for (int j = 0; j < 4; ++j) *(f32x4*)(X + (size_t)row * 1024 + 4 * lane + 256 * j) = v[j];
        } else {
            row_norm(v);
            float* dst = (l == 0) ? X + (size_t)row * 1024 : p.out + (size_t)row * 1024;
#pragma unroll
            for (int j = 0; j < 4; ++j) {
                const int c = 4 * lane + 256 * j;
                v[j] = v[j] * *(const f32x4*)(p.ln2_g + l * 1024 + c) + *(const f32x4*)(p.ln2_b + l * 1024 + c);
                *(f32x4*)(dst + c) = v[j];
            }
            if (l == 0) {
                row_norm(v);
                const float* m1 = mod + ((size_t)9 + g) * 6144;
                row_store_mod_bf16(H + (size_t)row * 1024, v, m1, m1 + 1024, lane);
            }
        }
    }
    if (final && l == 0) {
        __syncthreads();
        for (int it = blockIdx.x; it < 6144; it += gridDim.x) conv_expert_item(p, 1, it, lds);
    }
}

enum { PT_PREP = 0, PT_MODFIN, PT_LNMOD0, PT_INPROJ, PT_MIX, PT_OUTPROJ, PT_LN1ROUTE, PT_MOE, PT_COMB };
constexpr int SMEM_BYTES = 62 * 1024;

DEV void run_phase(const Params& p, int type, int l, int r, char* lds) {
    switch (type) {
        case PT_PREP: phase_prep(p, lds); break;
        case PT_MODFIN: phase_modfin(p); break;
        case PT_LNMOD0: phase_lnmod0(p); break;
        case PT_INPROJ: phase_inproj(p, l, lds); break;
        case PT_MIX: phase_mix(p, l, lds); break;
        case PT_OUTPROJ: phase_outproj(p, l, lds); break;
        case PT_LN1ROUTE: phase_ln1route(p, l, lds); break;
        case PT_MOE: phase_moe(p, l, r, lds); break;
        default: phase_comb(p, l, r, lds); break;
    }
}

__global__ void __launch_bounds__(256, 2) fwd_kernel(Params p) {
    __shared__ __attribute__((aligned(16))) char smem[SMEM_BYTES];
#if MULTI_LAUNCH
    run_phase(p, p.ptype, p.pl, p.pr, smem);
#else
    cg::grid_group grid = cg::this_grid();
    int type = PT_PREP, l = 0, r = 0;
    for (;;) {
        run_phase(p, type, l, r, smem);
        if (type < PT_MOE) { ++type; r = 0; }
        else if (type == PT_MOE) type = PT_COMB;
        else {
            const int nr = moe_round_info((const int*)(p.ws + OFF_CNT) + l * 64, p.cap, 0).nrounds;
            if (r + 1 < nr) { ++r; type = PT_MOE; }
            else { if (l == 1) break; l = 1; r = 0; type = PT_INPROJ; }
        }
        grid.sync();
    }
#endif
}

extern "C" void kernel_launch(void* const* d_in, const int* in_sizes, int n_in, void* d_out, int out_size, void* d_ws, size_t ws_size, hipStream_t stream) {
    Params p{};
    const float** pp = (const float**)&p;
    for (int i = 0; i < 32; ++i) pp[i] = (const float*)d_in[i];
    p.out = (float*)d_out; p.ws = (unsigned char*)d_ws;
    long long cap = ((long long)ws_size - (long long)OFF_R) / 2048;
    if (cap > NT * 8) cap = NT * 8;
    if (cap * 2048 < (long long)R_MIN_BYTES || cap < NT) { fprintf(stderr, "kernel_launch: workspace too small (%zu)\n", ws_size); return; }
    p.cap = (int)cap;
#if MULTI_LAUNCH
    const int grid = 512;
    auto launch = [&](int type, int l, int r) { Params q = p; q.mode = 1; q.ptype = type; q.pl = l; q.pr = r; hipLaunchKernelGGL(fwd_kernel, dim3(grid), dim3(256), 0, stream, q); };
    launch(PT_PREP, 0, 0); launch(PT_MODFIN, 0, 0); launch(PT_LNMOD0, 0, 0);
    for (int l = 0; l < 2; ++l) {
        launch(PT_INPROJ, l, 0); launch(PT_MIX, l, 0); launch(PT_OUTPROJ, l, 0); launch(PT_LN1ROUTE, l, 0);
        for (int r = 0; r < RMAX; ++r) { launch(PT_MOE, l, r); launch(PT_COMB, l, r); }
    }
#else
    static int grid_blocks = 0;
    if (!grid_blocks) {
        int dev = 0, cus = 0, per_cu = 0;
        hipGetDevice(&dev);
        hipDeviceGetAttribute(&cus, hipDeviceAttributeMultiprocessorCount, dev);
        hipOccupancyMaxActiveBlocksPerMultiprocessor(&per_cu, fwd_kernel, 256, 0);
        if (per_cu > 2) per_cu = 2;
        if (per_cu < 1) per_cu = 1;
        grid_blocks = cus * per_cu;
    }
    p.mode = 0;
    void* args[] = {&p};
    hipError_t e = hipLaunchCooperativeKernel((void*)fwd_kernel, dim3(grid_blocks), dim3(256), args, 0, stream);
    if (e != hipSuccess) fprintf(stderr, "cooperative launch failed: %s (grid %d)\n", hipGetErrorString(e), grid_blocks);
#endif
}
```

```cpp
#include <hip/hip_runtime.h>
#include <hip/hip_cooperative_groups.h>
#include <stdint.h>
#include <stdio.h>
namespace cg = cooperative_groups;

#ifndef MULTI_LAUNCH
#define MULTI_LAUNCH 0
#endif

typedef unsigned short bf16_t;
typedef short bf16x8 __attribute__((ext_vector_type(8)));
typedef short s16x4 __attribute__((ext_vector_type(4)));
typedef float f32x4 __attribute__((ext_vector_type(4)));
typedef unsigned u32x4 __attribute__((ext_vector_type(4)));
typedef unsigned u32x2 __attribute__((ext_vector_type(2)));
#define DEV __device__ __forceinline__
#define LDSP(T) __attribute__((address_space(3))) T*

constexpr int D = 1024, NB = 8, SEQ = 2048, CTX = 256, NLAT = NB * SEQ, NCTX = NB * CTX, NT = NLAT + NCTX;
constexpr int PROJ = 2304, KEYS = CTX + SEQ, NEXP = 64;
constexpr float DN_ALPHA = 1.41421356237309515f;
constexpr float LOG2E = 1.44269504088896341f;
constexpr int RMAX = 4;

constexpr size_t OFF_CNT = 0;
constexpr size_t OFF_MOD = 65536;
constexpr size_t OFF_ROPE = OFF_MOD + 442368;
constexpr size_t OFF_KERNL = OFF_ROPE + 2ull * 2048 * 32 * 4;
constexpr size_t OFF_KERNC = OFF_KERNL + 2ull * 4096 * 256 * 4;
constexpr size_t OFF_TKE = OFF_KERNC + 2ull * 512 * 256 * 4;
constexpr size_t OFF_TKS = OFF_TKE + (size_t)NT * 8 * 4;
constexpr size_t OFF_TKW = OFF_TKS + (size_t)NT * 8 * 4;
constexpr size_t OFF_LIST = OFF_TKW + (size_t)NT * 8 * 4;
constexpr size_t OFF_WIN = OFF_LIST + 64ull * NT * 4;
constexpr size_t OFF_WOUT = OFF_WIN + 2ull * 2304 * 1024 * 2;
constexpr size_t OFF_SW13 = OFF_WOUT + 2ull * 1024 * 1024 * 2;
constexpr size_t OFF_SW2 = OFF_SW13 + 2ull * 512 * 1024 * 2;
constexpr size_t OFF_RW = OFF_SW2 + 2ull * 1024 * 256 * 2;
constexpr size_t OFF_W13 = OFF_RW + 2ull * 64 * 1024 * 2;
constexpr size_t OFF_W2 = OFF_W13 + 64ull * 256 * 1024 * 2;
constexpr size_t OFF_X = OFF_W2 + 64ull * 1024 * 128 * 2;
constexpr size_t OFF_H = OFF_X + (size_t)NT * 1024 * 4;
constexpr size_t OFF_R = OFF_H + (size_t)NT * 1024 * 2;
constexpr size_t OFF_QA = OFF_R;
constexpr size_t OFF_QB = OFF_QA + 8ull * NT * 64 * 2;
constexpr size_t OFF_KA = OFF_QB + 4ull * NT * 64 * 2;
constexpr size_t OFF_VA = OFF_KA + 8ull * 2 * KEYS * 64 * 2;
constexpr size_t OFF_KB = OFF_VA + 8ull * 2 * KEYS * 64 * 2;
constexpr size_t OFF_VB = OFF_KB + 8ull * 4 * KEYS * 64 * 2;
constexpr size_t OFF_ZTL = OFF_VB + 8ull * 4 * KEYS * 64 * 2;
constexpr size_t OFF_ZTC = OFF_ZTL + 8ull * 768 * 2048 * 2;
constexpr size_t OFF_OX = OFF_ZTC + 8ull * 768 * 256 * 2;
constexpr size_t R_MIN_BYTES = OFF_OX + (size_t)NT * 1024 * 2 - OFF_R;
constexpr size_t OFF_PART = OFF_R;
constexpr size_t OFF_YS = OFF_R;

struct Params {
    const float *x, *c, *ctx, *c_ctx, *ada_w, *ada_b, *w_in, *q_gain, *k_gain, *nat_rpb, *hy_conv_w, *hy_conv_b,
        *hy_f_w1, *hy_f_b1, *hy_f_w2, *hy_f_b2, *hy_f_w3, *hy_freq, *hy_skip, *w_out, *ln1_g, *ln1_b,
        *router_w, *router_b, *exp_w1, *exp_w3, *exp_w2, *sh_w1, *sh_w3, *sh_w2, *ln2_g, *ln2_b;
    float* out; unsigned char* ws;
    int cap, mode, ptype, pl, pr, pad;
};

DEV unsigned f2bf(float f) { unsigned u = __float_as_uint(f); return (u + 0x7fffu + ((u >> 16) & 1u)) >> 16; }
DEV unsigned pk2(float lo, float hi) { return f2bf(lo) | (f2bf(hi) << 16); }
DEV float bf2f(unsigned short h) { return __uint_as_float(((unsigned)h) << 16); }
DEV float wave_sum(float v) {
#pragma unroll
    for (int o = 32; o > 0; o >>= 1) v += __shfl_xor(v, o);
    return v;
}
DEV void glds16(const void* g, void* l) { __builtin_amdgcn_global_load_lds((const unsigned*)g, (unsigned*)l, 16, 0, 0); }
DEV f32x4 mfma16(bf16x8 a, bf16x8 b, f32x4 c) { return __builtin_amdgcn_mfma_f32_16x16x32_bf16(a, b, c, 0, 0, 0); }
DEV int get_tid() { int t = threadIdx.x; asm volatile("" : "+v"(t)); return t; }
DEV int mod_group(int row) { return row < NLAT ? (row >> 11) : 8; }

template <int MI, bool TRANS>
DEV void gemm_core(f32x4 (&acc)[MI][4], const bf16_t* a0, const bf16_t* a1, const bf16_t* b0, const bf16_t* b1, int K, char* lds) {
    const int tid = get_tid(), lane = tid & 63, wid = tid >> 6, fr = lane & 15, fq = lane >> 4, wr = wid >> 1, wc = wid & 1;
    char* SA = lds; char* SB = lds + 8192;
    for (int kt = 0; kt < K; kt += 32) {
        glds16(a0 + kt, SA + tid * 16);
        if (MI == 4) glds16(a1 + kt, SA + 4096 + tid * 16);
        glds16(b0 + kt, SB + tid * 16);
        glds16(b1 + kt, SB + 4096 + tid * 16);
        asm volatile("s_waitcnt vmcnt(0)" ::: "memory");
        __syncthreads();
        bf16x8 af[MI], bfr[4];
#pragma unroll
        for (int m = 0; m < MI; ++m) af[m] = *(const bf16x8*)(SA + ((wr * MI * 16 + m * 16 + fr) * 64 + fq * 16));
#pragma unroll
        for (int n = 0; n < 4; ++n) bfr[n] = *(const bf16x8*)(SB + ((wc * 64 + n * 16 + fr) * 64 + fq * 16));
#pragma unroll
        for (int m = 0; m < MI; ++m)
#pragma unroll
            for (int n = 0; n < 4; ++n) acc[m][n] = TRANS ? mfma16(bfr[n], af[m], acc[m][n]) : mfma16(af[m], bfr[n], acc[m][n]);
        __syncthreads();
    }
}
template <int MI> DEV void zero_acc(f32x4 (&acc)[MI][4]) {
#pragma unroll
    for (int m = 0; m < MI; ++m)
#pragma unroll
        for (int n = 0; n < 4; ++n) acc[m][n] = (f32x4){0.f, 0.f, 0.f, 0.f};
}

DEV void prep_mod_item(const Params& p, int it, char* lds) {
    const int l = it / 768, rem = it % 768, cch = rem / 32, kch = rem % 32, tid = get_tid();
    float* sl = (float*)lds;
    for (int i = tid; i < 288; i += 256) { const int g = i / 32, k = kch * 32 + (i % 32); const float v = (g < 8) ? p.c[g * 1024 + k] : p.c_ctx[k]; sl[i] = v / (1.f + expf(-v)); }
    __syncthreads();
    const int col = cch * 256 + tid;
    float acc[9];
#pragma unroll
    for (int g = 0; g < 9; ++g) acc[g] = 0.f;
    const float* w = p.ada_w + ((size_t)l * 1024 + kch * 32) * 6144 + col;
#pragma unroll 8
    for (int kk = 0; kk < 32; ++kk) {
        const float wv = w[(size_t)kk * 6144];
#pragma unroll
        for (int g = 0; g < 9; ++g) acc[g] += sl[g * 32 + kk] * wv;
    }
    float* part = (float*)(p.ws + OFF_PART);
#pragma unroll
    for (int g = 0; g < 9; ++g) part[((size_t)(kch * 2 + l) * 9 + g) * 6144 + col] = acc[g];
    __syncthreads();
}
DEV void prep_rope_item(const Params& p, int it) {
    const int idx = it * 256 + threadIdx.x, t = idx >> 5, i = idx & 31;
    const float inv = powf(10000.f, -(float)(2 * (i & 15)) / 32.f);
    const float ang = (float)((i < 16) ? (t >> 6) : (t & 63)) * inv;
    float* rc = (float*)(p.ws + OFF_ROPE);
    rc[idx] = cosf(ang); rc[2048 * 32 + idx] = sinf(ang);
}
DEV void prep_filter_item(const Params& p, int it, char* lds) {
    const int l = it / 2304, r = it % 2304, type = r < 2048 ? 0 : 1, t = type ? r - 2048 : r, n = type ? 256 : 2048, tid = get_tid();
    float* z = (float*)lds; float* h1 = z + 64; float* h2 = h1 + 64;
    const float tt = (float)t / (float)(n - 1);
    if (tid < 33) {
        float v;
        if (tid == 0) v = tt;
        else {
            const int i = (tid - 1) & 15;
            const float f = 1e-4f + (float)i * ((15.f - 1e-4f) / 15.f);
            const float w = 2.f * 3.14159265358979323846f * (float)t / (float)n;
            v = (tid <= 16) ? cosf(f * w) : -sinf(f * w);
        }
        z[tid] = v;
    }
    __syncthreads();
    if (tid < 64) {
        float s = p.hy_f_b1[l * 64 + tid];
        for (int i = 0; i < 33; ++i) s += z[i] * p.hy_f_w1[(l * 33 + i) * 64 + tid];
        h1[tid] = sinf(p.hy_freq[(l * 2 + 0) * 64 + tid] * s);
    }
    __syncthreads();
    if (tid < 64) {
        float s = p.hy_f_b2[l * 64 + tid];
        for (int i = 0; i < 64; ++i) s += h1[i] * p.hy_f_w2[(l * 64 + i) * 64 + tid];
        h2[tid] = sinf(p.hy_freq[(l * 2 + 1) * 64 + tid] * s);
    }
    __syncthreads();
    float* kern = (float*)(p.ws + (type ? OFF_KERNC + (size_t)l * 512 * 256 * 4 : OFF_KERNL + (size_t)l * 4096 * 256 * 4));
    const float lo = logf(1e-2f) / 1.5f, hi = logf(1e-2f) / 0.3f;
    for (int o = tid; o < 512; o += 256) {
        float s = 0.f;
        for (int i = 0; i < 64; ++i) s += h2[i] * p.hy_f_w3[(l * 64 + i) * 512 + o];
        const int c = o & 255;
        const float delta = fabsf(lo + (float)c * ((hi - lo) / 255.f));
        const float v = s * expf(-tt * delta);
        if (o < 256) kern[(size_t)(n - 1 + t) * 256 + c] = v;
        else if (t >= 1) kern[(size_t)(n - 1 - t) * 256 + c] = v;
    }
    __syncthreads();
}
DEV void conv_tile(const float* src, int ldsrc, int k0, int n0, bf16_t* dst, int lddst, int mapkind, char* lds) {
    float* tl = (float*)lds;
    const int tid = get_tid();
    {
        const int r = tid >> 4, c4 = (tid & 15) * 4;
#pragma unroll
        for (int i = 0; i < 4; ++i) {
            const int row = r + 16 * i;
            const f32x4 v = *(const f32x4*)(src + (size_t)(k0 + row) * ldsrc + n0 + c4);
            tl[row * 65 + c4 + 0] = v[0]; tl[row * 65 + c4 + 1] = v[1]; tl[row * 65 + c4 + 2] = v[2]; tl[row * 65 + c4 + 3] = v[3];
        }
    }
    __syncthreads();
    {
        const int n = tid >> 2, kc = tid & 3, ng = n0 + n;
        int drow = ng;
        if (mapkind == 1) drow = 32 * (ng >> 4) + (ng & 15);
        else if (mapkind == 2) drow = 32 * (ng >> 4) + 16 + (ng & 15);
        unsigned w[8];
#pragma unroll
        for (int j = 0; j < 8; ++j) w[j] = pk2(tl[(kc * 16 + 2 * j) * 65 + n], tl[(kc * 16 + 2 * j + 1) * 65 + n]);
        u32x4* d = (u32x4*)(dst + (size_t)drow * lddst + k0 + kc * 16);
        d[0] = (u32x4){w[0], w[1], w[2], w[3]};
        d[1] = (u32x4){w[4], w[5], w[6], w[7]};
    }
    __syncthreads();
}
DEV void conv_fixed_item(const Params& p, int it, char* lds) {
    const int l = it / 1040; int r = it % 1040;
    unsigned char* ws = p.ws;
    if (r < 576) { conv_tile(p.w_in + (size_t)l * 1024 * PROJ, PROJ, (r / 36) * 64, (r % 36) * 64, (bf16_t*)(ws + OFF_WIN) + (size_t)l * PROJ * 1024, 1024, 0, lds); return; }
    r -= 576;
    if (r < 256) { conv_tile(p.w_out + (size_t)l * 1024 * 1024, 1024, (r / 16) * 64, (r % 16) * 64, (bf16_t*)(ws + OFF_WOUT) + (size_t)l * 1024 * 1024, 1024, 0, lds); return; }
    r -= 256;
    if (r < 64) { conv_tile(p.sh_w1 + (size_t)l * 1024 * 256, 256, (r / 4) * 64, (r % 4) * 64, (bf16_t*)(ws + OFF_SW13) + (size_t)l * 512 * 1024, 1024, 1, lds); return; }
    r -= 64;
    if (r < 64) { conv_tile(p.sh_w3 + (size_t)l * 1024 * 256, 256, (r / 4) * 64, (r % 4) * 64, (bf16_t*)(ws + OFF_SW13) + (size_t)l * 512 * 1024, 1024, 2, lds); return; }
    r -= 64;
    if (r < 64) { conv_tile(p.sh_w2 + (size_t)l * 256 * 1024, 1024, (r / 16) * 64, (r % 16) * 64, (bf16_t*)(ws + OFF_SW2) + (size_t)l * 1024 * 256, 256, 0, lds); return; }
    r -= 64;
    conv_tile(p.router_w + (size_t)l * 1024 * 64, 64, r * 64, 0, (bf16_t*)(ws + OFF_RW) + (size_t)l * 64 * 1024, 1024, 0, lds);
}
DEV void conv_expert_item(const Params& p, int l, int it, char* lds) {
    const int e = it / 96; int r = it % 96;
    unsigned char* ws = p.ws;
    const size_t eo = (size_t)(l * 64 + e) * 1024 * 128;
    if (r < 32) { conv_tile(p.exp_w1 + eo, 128, (r / 2) * 64, (r % 2) * 64, (bf16_t*)(ws + OFF_W13) + (size_t)e * 256 * 1024, 1024, 1, lds); return; }
    r -= 32;
    if (r < 32) { conv_tile(p.exp_w3 + eo, 128, (r / 2) * 64, (r % 2) * 64, (bf16_t*)(ws + OFF_W13) + (size_t)e * 256 * 1024, 1024, 2, lds); return; }
    r -= 32;
    conv_tile(p.exp_w2 + eo, 1024, (r / 16) * 64, (r % 16) * 64, (bf16_t*)(ws + OFF_W2) + (size_t)e * 1024 * 128, 128, 0, lds);
}
DEV void phase_prep(const Params& p, char* lds) {
    if (blockIdx.x == 0 && threadIdx.x < 128) ((int*)(p.ws + OFF_CNT))[threadIdx.x] = 0;
    constexpr int N0 = 1536, N1 = N0 + 256, N2 = N1 + 4608, N3 = N2 + 2080, N4 = N3 + 6144;
    for (int it = blockIdx.x; it < N4; it += gridDim.x) {
        if (it < N0) prep_mod_item(p, it, lds);
        else if (it < N1) prep_rope_item(p, it - N0);
        else if (it < N2) prep_filter_item(p, it - N1, lds);
        else if (it < N3) conv_fixed_item(p, it - N2, lds);
        else conv_expert_item(p, 0, it - N3, lds);
    }
}
DEV void phase_modfin(const Params& p) {
    const float* part = (const float*)(p.ws + OFF_PART);
    float* mod = (float*)(p.ws + OFF_MOD);
    for (int idx = blockIdx.x * 256 + threadIdx.x; idx < 2 * 9 * 6144; idx += gridDim.x * 256) {
        const int l = idx / (9 * 6144), g = (idx / 6144) % 9, col = idx % 6144;
        float s = p.ada_b[l * 6144 + col];
        for (int k = 0; k < 32; ++k) s += part[((size_t)(k * 2 + l) * 9 + g) * 6144 + col];
        mod[idx] = s;
    }
}

DEV void row_load(const float* src, f32x4 (&v)[4], int lane) {
#pragma unroll
    for (int j = 0; j < 4; ++j) v[j] = *(const f32x4*)(src + 4 * lane + 256 * j);
}
DEV void row_norm(f32x4 (&v)[4]) {
    float s = 0.f;
#pragma unroll
    for (int j = 0; j < 4; ++j) s += (v[j][0] + v[j][1]) + (v[j][2] + v[j][3]);
    const float mean = wave_sum(s) * (1.f / 1024.f);
    float q = 0.f;
#pragma unroll
    for (int j = 0; j < 4; ++j) { v[j] = v[j] - mean; q += (v[j][0] * v[j][0] + v[j][1] * v[j][1]) + (v[j][2] * v[j][2] + v[j][3] * v[j][3]); }
    const float rstd = 1.0f / sqrtf(wave_sum(q) * (1.f / 1024.f) + 1e-6f);
#pragma unroll
    for (int j = 0; j < 4; ++j) v[j] = v[j] * rstd;
}
DEV void row_store_mod_bf16(bf16_t* dst, const f32x4 (&v)[4], const float* shift, const float* scale, int lane) {
#pragma unroll
    for (int j = 0; j < 4; ++j) {
        const int c = 4 * lane + 256 * j;
        const f32x4 sh = *(const f32x4*)(shift + c), sc = *(const f32x4*)(scale + c);
        const f32x4 o = v[j] * (sc + 1.0f) + sh;
        *(u32x2*)(dst + c) = (u32x2){pk2(o[0], o[1]), pk2(o[2], o[3])};
    }
}
DEV void phase_lnmod0(const Params& p) {
    const int tid_ = get_tid(), lane = tid_ & 63, wid = tid_ >> 6;
    const float* mod = (const float*)(p.ws + OFF_MOD);
    bf16_t* H = (bf16_t*)(p.ws + OFF_H);
    for (int row = blockIdx.x * 4 + wid; row < NT; row += gridDim.x * 4) {
        const float* src = row < NLAT ? p.x + (size_t)row * 1024 : p.ctx + (size_t)(row - NLAT) * 1024;
        f32x4 v[4]; row_load(src, v, lane); row_norm(v);
        const float* m = mod + (size_t)mod_group(row) * 6144;
        row_store_mod_bf16(H + (size_t)row * 1024, v, m, m + 1024, lane);
    }
}

DEV void phase_inproj(const Params& p, int l, char* lds) {
    const int tid = get_tid(), lane = tid & 63, wid = tid >> 6, fr = lane & 15, fq = lane >> 4, wr = wid >> 1, wc = wid & 1;
    unsigned char* ws = p.ws;
    const bf16_t* H = (const bf16_t*)(ws + OFF_H);
    const bf16_t* W = (const bf16_t*)(ws + OFF_WIN) + (size_t)l * PROJ * 1024;
    const float* ropec = (const float*)(ws + OFF_ROPE); const float* ropes = ropec + 2048 * 32;
    const int nitems = 128 * 18 + 16 * (l == 0 ? 18 : 6);
    for (int it = blockIdx.x; it < nitems; it += gridDim.x) {
        int mt, nt;
        if (it < 2304) { mt = it / 18; nt = it % 18; }
        else { const int j = it - 2304; if (l == 0) { mt = 128 + j / 18; nt = j % 18; } else { mt = 128 + j / 6; const int q = j % 6; nt = q < 2 ? 4 + q : 6 + q; } }
        const int m0 = mt * 128, n0 = nt * 128;
        const bf16_t* a0 = H + (size_t)(m0 + (tid >> 2)) * 1024 + (tid & 3) * 8;
        const bf16_t* b0 = W + (size_t)(n0 + (tid >> 2)) * 1024 + (tid & 3) * 8;
        f32x4 acc[4][4]; zero_acc<4>(acc);
        const bool latent = m0 < NLAT;
        const int b = latent ? (m0 >> 11) : ((m0 - NLAT) >> 8);
        const int tbase = latent ? (m0 & 2047) : ((m0 - NLAT) & 255);
        if (nt >= 12) {
            gemm_core<4, false>(acc, a0, a0 + 64 * 1024, b0, b0 + 64 * 1024, 1024, lds);
            bf16_t* zt = latent ? (bf16_t*)(ws + OFF_ZTL) + (size_t)b * 768 * 2048 : (bf16_t*)(ws + OFF_ZTC) + (size_t)b * 768 * 256;
            const int n = latent ? 2048 : 256;
#pragma unroll
            for (int m = 0; m < 4; ++m)
#pragma unroll
                for (int nn = 0; nn < 4; ++nn) {
                    const int ch = n0 - 1536 + wc * 64 + nn * 16 + fr, t = tbase + wr * 64 + m * 16 + 4 * fq;
                    *(u32x2*)(zt + (size_t)ch * n + t) = (u32x2){pk2(acc[m][nn][0], acc[m][nn][1]), pk2(acc[m][nn][2], acc[m][nn][3])};
                }
        } else {
            gemm_core<4, true>(acc, a0, a0 + 64 * 1024, b0, b0 + 64 * 1024, 1024, lds);
            const int col0 = n0 + wc * 64;
            int kind, hh;
            if (col0 < 512) { kind = 0; hh = col0 >> 6; } else if (col0 < 640) { kind = 1; hh = (col0 - 512) >> 6; } else if (col0 < 768) { kind = 2; hh = (col0 - 640) >> 6; }
            else if (col0 < 1024) { kind = 3; hh = (col0 - 768) >> 6; } else if (col0 < 1280) { kind = 4; hh = (col0 - 1024) >> 6; } else { kind = 5; hh = (col0 - 1280) >> 6; }
            const bool normed = (kind == 0 || kind == 1);
            const float* gain = (kind == 0 ? p.q_gain : p.k_gain) + l * 64;
#pragma unroll
            for (int m = 0; m < 4; ++m) {
                const int rloc = wr * 64 + m * 16 + fr, row = m0 + rloc, t = tbase + rloc;
                f32x4 v[4];
#pragma unroll
                for (int nn = 0; nn < 4; ++nn) v[nn] = acc[m][nn];
                if (normed) {
                    float ss = 0.f;
#pragma unroll
                    for (int nn = 0; nn < 4; ++nn) ss += (v[nn][0] * v[nn][0] + v[nn][1] * v[nn][1]) + (v[nn][2] * v[nn][2] + v[nn][3] * v[nn][3]);
                    ss += __shfl_xor(ss, 16); ss += __shfl_xor(ss, 32);
                    const float r = 1.0f / sqrtf(ss * (1.f / 64.f) + 1e-6f);
#pragma unroll
                    for (int nn = 0; nn < 4; ++nn) {
                        const f32x4 g = *(const f32x4*)(gain + nn * 16 + 4 * fq);
                        v[nn] = v[nn] * r * g;
                        if (latent) {
                            const int pi = nn * 8 + 2 * fq;
                            const float c0 = ropec[t * 32 + pi], s0 = ropes[t * 32 + pi], c1 = ropec[t * 32 + pi + 1], s1 = ropes[t * 32 + pi + 1];
                            const float x0 = v[nn][0], x1 = v[nn][1], x2 = v[nn][2], x3 = v[nn][3];
                            v[nn][0] = x0 * c0 - x1 * s0; v[nn][1] = x0 * s0 + x1 * c0;
                            v[nn][2] = x2 * c1 - x3 * s1; v[nn][3] = x2 * s1 + x3 * c1;
                        }
                    }
                }
                bf16_t* dst;
                const int key = latent ? 256 + t : t;
                if (kind == 0) dst = (bf16_t*)(ws + OFF_QA) + ((size_t)hh * NT + row) * 64;
                else if (kind == 3) dst = (bf16_t*)(ws + OFF_QB) + ((size_t)hh * NT + row) * 64;
                else if (kind == 1) dst = (bf16_t*)(ws + OFF_KA) + ((size_t)(b * 2 + hh) * KEYS + key) * 64;
                else if (kind == 2) dst = (bf16_t*)(ws + OFF_VA) + ((size_t)(b * 2 + hh) * KEYS + key) * 64;
                else if (kind == 4) dst = (bf16_t*)(ws + OFF_KB) + ((size_t)(b * 4 + hh) * KEYS + key) * 64;
                else dst = (bf16_t*)(ws + OFF_VB) + ((size_t)(b * 4 + hh) * KEYS + key) * 64;
#pragma unroll
                for (int nn = 0; nn < 4; ++nn) *(u32x2*)(dst + nn * 16 + 4 * fq) = (u32x2){pk2(v[nn][0], v[nn][1]), pk2(v[nn][2], v[nn][3])};
            }
        }
    }
}

template <int NQT, bool NA>
DEV void attn_block(const bf16_t* Qh, int qrow0, const bf16_t* Kh, const bf16_t* Vh, int ntiles, bf16_t* outp  ,
                    int na_r, int na_rs, const float* rpb_h, char* lds) {
    const int tid = get_tid(), lane = tid & 63, wid = tid >> 6, fr = lane & 15, fq = lane >> 4;
    char* KBUF = lds;
    char* VBUF = lds + 16384;
    float* BIAS = (float*)(lds + 32768);
    const float c1 = 0.125f * LOG2E;
    if (NA) {
        for (int i = tid; i < 15 * 32; i += 256) { const int dr = i >> 5, dc = i & 31; BIAS[i] = dc < 31 ? rpb_h[dr * 31 + dc] * LOG2E : 0.f; }
    }
    bf16x8 qf[NQT][2];
    const int qw = qrow0 + wid * 16 * NQT;
#pragma unroll
    for (int nq = 0; nq < NQT; ++nq)
#pragma unroll
        for (int ks = 0; ks < 2; ++ks) qf[nq][ks] = *(const bf16x8*)(Qh + (size_t)(qw + nq * 16 + fr) * 64 + ks * 32 + fq * 8);
    f32x4 oacc[4][NQT];
    float mrun[NQT], lsum[NQT];
#pragma unroll
    for (int nq = 0; nq < NQT; ++nq) { mrun[nq] = -1e30f; lsum[nq] = 0.f;
#pragma unroll
        for (int dt = 0; dt < 4; ++dt) oacc[dt][nq] = (f32x4){0.f, 0.f, 0.f, 0.f}; }
    const int lrow0 = tid >> 3, lch = tid & 7;
    auto key0_of = [&](int ti) -> int { if (NA) return ti < 8 ? 256 + (na_rs + ti) * 64 : (ti - 8) * 64; return ti * 64; };
    u32x4 kreg[2], vreg[2];
    auto gload = [&](int ti) {
        const int k0 = key0_of(ti);
#pragma unroll
        for (int i = 0; i < 2; ++i) {
            const int row = lrow0 + 32 * i;
            kreg[i] = *(const u32x4*)(Kh + (size_t)(k0 + row) * 64 + lch * 8);
            vreg[i] = *(const u32x4*)(Vh + (size_t)(k0 + row) * 64 + lch * 8);
        }
    };
    auto lstore = [&](int buf) {
#pragma unroll
        for (int i = 0; i < 2; ++i) {
            const int row = lrow0 + 32 * i;
            const int off = buf * 8192 + row * 128 + ((lch ^ (row & 7)) * 16);
            *(u32x4*)(KBUF + off) = kreg[i];
            *(u32x4*)(VBUF + off) = vreg[i];
        }
    };
    gload(0); lstore(0);
    __syncthreads();
    for (int ti = 0; ti < ntiles; ++ti) {
        const int buf = ti & 1;
        if (ti + 1 < ntiles) gload(ti + 1);
        const char* kb = KBUF + buf * 8192; const char* vb = VBUF + buf * 8192;
        f32x4 sacc[4][NQT];
#pragma unroll
        for (int mt = 0; mt < 4; ++mt) {
            const int row = mt * 16 + fr;
            bf16x8 kf0 = *(const bf16x8*)(kb + row * 128 + (((0 + fq) ^ (row & 7)) * 16));
            bf16x8 kf1 = *(const bf16x8*)(kb + row * 128 + (((4 + fq) ^ (row & 7)) * 16));
#pragma unroll
            for (int nq = 0; nq < NQT; ++nq) {
                f32x4 s = (f32x4){0.f, 0.f, 0.f, 0.f};
                s = mfma16(kf0, qf[nq][0], s);
                s = mfma16(kf1, qf[nq][1], s);
                sacc[mt][nq] = s;
            }
        }
        bf16x8 pf[2][NQT];
#pragma unroll
        for (int nq = 0; nq < NQT; ++nq) {
            float tv[4][4];
            if (NA && ti < 8) {
                const int qc = wid * 16 * NQT + nq * 16 + fr;
                int cs = qc - 8; cs = cs < 0 ? 0 : (cs > 48 ? 48 : cs);
                const int dr = na_rs + ti - na_r + 7;
#pragma unroll
                for (int mt = 0; mt < 4; ++mt)
#pragma unroll
                    for (int j = 0; j < 4; ++j) {
                        const int kc = mt * 16 + 4 * fq + j;
                        const bool ok = (kc >= cs) && (kc < cs + 16);
                        int dc = kc - qc + 15; dc = dc < 0 ? 0 : (dc > 30 ? 30 : dc);
                        tv[mt][j] = ok ? sacc[mt][nq][j] * c1 + BIAS[dr * 32 + dc] : -1e30f;
                    }
            } else {
#pragma unroll
                for (int mt = 0; mt < 4; ++mt)
#pragma unroll
                    for (int j = 0; j < 4; ++j) tv[mt][j] = sacc[mt][nq][j] * c1;
            }
            float tmax = -1e30f;
#pragma unroll
            for (int mt = 0; mt < 4; ++mt)
#pragma unroll
                for (int j = 0; j < 4; ++j) tmax = fmaxf(tmax, tv[mt][j]);
            tmax = fmaxf(tmax, __shfl_xor(tmax, 16)); tmax = fmaxf(tmax, __shfl_xor(tmax, 32));
            const float mnew = fmaxf(mrun[nq], tmax);
            const float alpha = exp2f(mrun[nq] - mnew);
            mrun[nq] = mnew;
            float ps = 0.f;
#pragma unroll
            for (int mt = 0; mt < 4; ++mt)
#pragma unroll
                for (int j = 0; j < 4; ++j) { const float e = exp2f(tv[mt][j] - mnew); tv[mt][j] = e; ps += e; }
            lsum[nq] = lsum[nq] * alpha + ps;
#pragma unroll
            for (int dt = 0; dt < 4; ++dt) oacc[dt][nq] = oacc[dt][nq] * alpha;
#pragma unroll
            for (int ks = 0; ks < 2; ++ks) {
                union { bf16x8 v; unsigned u[4]; } pk;
                pk.u[0] = pk2(tv[2 * ks][0], tv[2 * ks][1]); pk.u[1] = pk2(tv[2 * ks][2], tv[2 * ks][3]);
                pk.u[2] = pk2(tv[2 * ks + 1][0], tv[2 * ks + 1][1]); pk.u[3] = pk2(tv[2 * ks + 1][2], tv[2 * ks + 1][3]);
                pf[ks][nq] = pk.v;
            }
        }
        {
            const int q4 = fr >> 2, p4 = fr & 3;
#pragma unroll
            for (int ks = 0; ks < 2; ++ks)
#pragma unroll
                for (int dt = 0; dt < 4; ++dt) {
                    const int keyA = 16 * (2 * ks) + 4 * fq + q4, keyB = keyA + 16;
                    const int ch = dt * 2 + (p4 >> 1);
                    const int offA = keyA * 128 + ((ch ^ (keyA & 7)) * 16) + (p4 & 1) * 8;
                    const int offB = keyB * 128 + ((ch ^ (keyB & 7)) * 16) + (p4 & 1) * 8;
                    const s16x4 ta = __builtin_amdgcn_ds_read_tr16_b64_v4i16((LDSP(s16x4))(vb + offA));
                    const s16x4 tb = __builtin_amdgcn_ds_read_tr16_b64_v4i16((LDSP(s16x4))(vb + offB));
                    bf16x8 vf; vf[0] = ta[0]; vf[1] = ta[1]; vf[2] = ta[2]; vf[3] = ta[3]; vf[4] = tb[0]; vf[5] = tb[1]; vf[6] = tb[2]; vf[7] = tb[3];
#pragma unroll
                    for (int nq = 0; nq < NQT; ++nq) oacc[dt][nq] = mfma16(vf, pf[ks][nq], oacc[dt][nq]);
                }
        }
        if (ti + 1 < ntiles) lstore(buf ^ 1);
        __syncthreads();
    }
#pragma unroll
    for (int nq = 0; nq < NQT; ++nq) {
        float ls = lsum[nq]; ls += __shfl_xor(ls, 16); ls += __shfl_xor(ls, 32);
        const float inv = 1.0f / ls;
        bf16_t* o = outp + (size_t)(qw + nq * 16 + fr) * 1024;
#pragma unroll
        for (int dt = 0; dt < 4; ++dt) {
            const f32x4 v = oacc[dt][nq] * inv;
            *(u32x2*)(o + dt * 16 + 4 * fq) = (u32x2){pk2(v[0], v[1]), pk2(v[2], v[3])};
        }
    }
    __syncthreads();
}

DEV float hy_sconv(const bf16_t* zrow, int t, int n, float w0, float w1, float w2, float bias) {
    const float zm = t > 0 ? bf2f(zrow[t - 1]) : 0.f, z0 = bf2f(zrow[t]), zp = t + 1 < n ? bf2f(zrow[t + 1]) : 0.f;
    return w0 * zm + w1 * z0 + w2 * zp + bias;
}
template <int NJ>
DEV void hyena_item(const Params& p, int l, int type, int c, int bh, char* lds) {
    constexpr int n = 256 * NJ;
    const int tid = get_tid();
    f32x4* U = (f32x4*)lds;
    float* KR = (float*)(lds + n * 16);
    const bf16_t* zt = type ? (const bf16_t*)(p.ws + OFF_ZTC) : (const bf16_t*)(p.ws + OFF_ZTL);
    const float* kern = (const float*)(p.ws + (type ? OFF_KERNC + (size_t)l * 512 * 256 * 4 : OFF_KERNL + (size_t)l * 4096 * 256 * 4));
    const float* cw = p.hy_conv_w + l * 3 * 768; const float* cb = p.hy_conv_b + l * 768;
    const float w10 = cw[256 + c], w11 = cw[768 + 256 + c], w12 = cw[1536 + 256 + c], b1 = cb[256 + c];
    const float wv0 = cw[512 + c], wv1 = cw[768 + 512 + c], wv2 = cw[1536 + 512 + c], bv = cb[512 + c];
    const float w00 = cw[c], w01 = cw[768 + c], w02 = cw[1536 + c], b0 = cb[c];
    for (int i = tid; i < 2 * n - 1; i += 256) KR[i] = kern[(size_t)i * 256 + c];
    for (int s = tid; s < n; s += 256) {
        f32x4 u;
#pragma unroll
        for (int bb = 0; bb < 4; ++bb) {
            const bf16_t* zb = zt + (size_t)(bh * 4 + bb) * 768 * n;
            const float x1 = hy_sconv(zb + (size_t)(256 + c) * n, s, n, w10, w11, w12, b1);
            const float vv = hy_sconv(zb + (size_t)(512 + c) * n, s, n, wv0, wv1, wv2, bv);
            u[bb] = vv * x1;
        }
        U[s] = u;
    }
    __syncthreads();
    f32x4 acc[NJ];
#pragma unroll
    for (int j = 0; j < NJ; ++j) acc[j] = (f32x4){0.f, 0.f, 0.f, 0.f};
    const float* kp = KR + tid + (n - 1);
    for (int s = 0; s < n; ++s) {
        const f32x4 u = U[s];
#pragma unroll
        for (int j = 0; j < NJ; ++j) acc[j] += u * kp[256 * j - s];
    }
    const float skip = p.hy_skip[l * 256 + c];
    bf16_t* ox = (bf16_t*)(p.ws + OFF_OX);
#pragma unroll
    for (int j = 0; j < NJ; ++j) {
        const int t = tid + 256 * j;
        const f32x4 u = U[t];
#pragma unroll
        for (int bb = 0; bb < 4; ++bb) {
            const int b = bh * 4 + bb;
            const bf16_t* zb = zt + (size_t)b * 768 * n;
            const float x0 = hy_sconv(zb + (size_t)c * n, t, n, w00, w01, w02, b0);
            const float y = (acc[j][bb] + u[bb] * skip) * x0;
            const int row = type ? NLAT + b * 256 + t : b * 2048 + t;
            ox[(size_t)row * 1024 + 768 + c] = (bf16_t)f2bf(y);
        }
    }
    __syncthreads();
}

DEV void phase_mix(const Params& p, int l, char* lds) {
    unsigned char* ws = p.ws;
    const bf16_t* QA = (const bf16_t*)(ws + OFF_QA); const bf16_t* QB = (const bf16_t*)(ws + OFF_QB);
    const bf16_t* KA = (const bf16_t*)(ws + OFF_KA); const bf16_t* VA = (const bf16_t*)(ws + OFF_VA);
    const bf16_t* KBp = (const bf16_t*)(ws + OFF_KB); const bf16_t* VBp = (const bf16_t*)(ws + OFF_VB);
    bf16_t* OX = (bf16_t*)(ws + OFF_OX);
    const int N0 = 512, N1 = N0 + 1024, N2 = N1 + 1024;
    const int N3 = N2 + (l == 0 ? 512 : 0), N4 = N3 + (l == 0 ? 128 : 0), N5 = N4 + (l == 0 ? 64 : 0);
    for (int it = blockIdx.x; it < N5; it += gridDim.x) {
        if (it < N0) { hyena_item<8>(p, l, 0, it >> 1, it & 1, lds); }
        else if (it < N1) {
            const int j = it - N0, b = j >> 7, h = (j >> 4) & 7, qb = j & 15;
            attn_block<2, false>(QA + (size_t)h * NT * 64, b * 2048 + qb * 128, KA + (size_t)(b * 2 + (h >> 2)) * KEYS * 64, VA + (size_t)(b * 2 + (h >> 2)) * KEYS * 64,
                                 36, OX + h * 64, 0, 0, nullptr, lds);
        } else if (it < N2) {
            const int j = it - N1, b = j >> 7, h = (j >> 5) & 3, r = j & 31;
            int rs = r - 4; rs = rs < 0 ? 0 : (rs > 24 ? 24 : rs);
            attn_block<1, true>(QB + (size_t)h * NT * 64, b * 2048 + r * 64, KBp + (size_t)(b * 4 + h) * KEYS * 64, VBp + (size_t)(b * 4 + h) * KEYS * 64,
                                12, OX + 512 + h * 64, r, rs, p.nat_rpb + (size_t)(l * 4 + h) * 15 * 31, lds);
        } else if (it < N3) { const int j = it - N2; hyena_item<1>(p, l, 1, j >> 1, j & 1, lds); }
        else if (it < N4) {
            const int j = it - N3, b = j >> 4, h = (j >> 1) & 7, qb = j & 1;
            attn_block<2, false>(QA + (size_t)h * NT * 64, NLAT + b * 256 + qb * 128, KA + (size_t)(b * 2 + (h >> 2)) * KEYS * 64, VA + (size_t)(b * 2 + (h >> 2)) * KEYS * 64,
                                 4, OX + h * 64, 0, 0, nullptr, lds);
        } else {
            const int j = it - N4, b = j >> 3, h = (j >> 1) & 3, qb = j & 1;
            attn_block<2, false>(QB + (size_t)h * NT * 64, NLAT + b * 256 + qb * 128, KBp + (size_t)(b * 4 + h) * KEYS * 64, VBp + (size_t)(b * 4 + h) * KEYS * 64,
                                 4, OX + 512 + h * 64, 0, 0, nullptr, lds);
        }
    }
}

DEV void phase_outproj(const Params& p, int l, char* lds) {
    const int tid = get_tid(), lane = tid & 63, wid = tid >> 6, fr = lane & 15, fq = lane >> 4, wr = wid >> 1, wc = wid & 1;
    const bf16_t* OX = (const bf16_t*)(p.ws + OFF_OX);
    const bf16_t* W = (const bf16_t*)(p.ws + OFF_WOUT) + (size_t)l * 1024 * 1024;
    const float* mod = (const float*)(p.ws + OFF_MOD) + (size_t)l * 9 * 6144;
    float* X = (float*)(p.ws + OFF_X);
    const int nitems = (l == 0 ? 144 : 128) * 8;
    for (int it = blockIdx.x; it < nitems; it += gridDim.x) {
        const int mt = it >> 3, nt = it & 7, m0 = mt * 128, n0 = nt * 128;
        const bf16_t* a0 = OX + (size_t)(m0 + (tid >> 2)) * 1024 + (tid & 3) * 8;
        const bf16_t* b0 = W + (size_t)(n0 + (tid >> 2)) * 1024 + (tid & 3) * 8;
        f32x4 acc[4][4]; zero_acc<4>(acc);
        gemm_core<4, true>(acc, a0, a0 + 64 * 1024, b0, b0 + 64 * 1024, 1024, lds);
        const float* g1 = mod + (size_t)mod_group(m0) * 6144 + 2048;
#pragma unroll
        for (int m = 0; m < 4; ++m) {
            const int row = m0 + wr * 64 + m * 16 + fr;
            const float* xin = (l == 0) ? (row < NLAT ? p.x + (size_t)row * 1024 : p.ctx + (size_t)(row - NLAT) * 1024) : X + (size_t)row * 1024;
#pragma unroll
            for (int nn = 0; nn < 4; ++nn) {
                const int col = n0 + wc * 64 + nn * 16 + 4 * fq;
                const f32x4 xv = *(const f32x4*)(xin + col), g = *(const f32x4*)(g1 + col);
                *(f32x4*)(X + (size_t)row * 1024 + col) = xv * DN_ALPHA + g * acc[m][nn];
            }
        }
    }
}

DEV void phase_ln1route(const Params& p, int l, char* lds) {
    const int tid = get_tid(), lane = tid & 63, wid = tid >> 6, fr = lane & 15, fq = lane >> 4;
    float* X = (float*)(p.ws + OFF_X);
    bf16_t* H = (bf16_t*)(p.ws + OFF_H);
    const bf16_t* RW = (const bf16_t*)(p.ws + OFF_RW) + (size_t)l * 64 * 1024;
    const float* mod = (const float*)(p.ws + OFF_MOD) + (size_t)l * 9 * 6144;
    int* cnt = (int*)(p.ws + OFF_CNT) + l * 64;
    int* tke = (int*)(p.ws + OFF_TKE); int* tks = (int*)(p.ws + OFF_TKS); float* tkw = (float*)(p.ws + OFF_TKW);
    int* list = (int*)(p.ws + OFF_LIST);
    float* SC = (float*)(lds + 8192);
    float* SEL = (float*)(lds + 8192 + 16384);
    const int nitems = (l == 0 ? NT : NLAT) / 64;
    for (int it = blockIdx.x; it < nitems; it += gridDim.x) {
        const int m0 = it * 64;
        const float* mg = mod + (size_t)mod_group(m0) * 6144;
        for (int i = 0; i < 16; ++i) {
            const int row = m0 + wid * 16 + i;
            f32x4 v[4]; row_load(X + (size_t)row * 1024, v, lane); row_norm(v);
#pragma unroll
            for (int j = 0; j < 4; ++j) {
                const int c = 4 * lane + 256 * j;
                v[j] = v[j] * *(const f32x4*)(p.ln1_g + l * 1024 + c) + *(const f32x4*)(p.ln1_b + l * 1024 + c);
                *(f32x4*)(X + (size_t)row * 1024 + c) = v[j];
            }
            row_norm(v);
            row_store_mod_bf16(H + (size_t)row * 1024, v, mg + 3072, mg + 4096, lane);
        }
        __syncthreads();
        f32x4 acc[4];
#pragma unroll
        for (int n = 0; n < 4; ++n) acc[n] = (f32x4){0.f, 0.f, 0.f, 0.f};
        {
            const bf16_t* a0 = H + (size_t)(m0 + (tid >> 2)) * 1024 + (tid & 3) * 8;
            const bf16_t* b0 = RW + (size_t)(tid >> 2) * 1024 + (tid & 3) * 8;
            char* SA = lds; char* SB = lds + 4096;
            for (int kt = 0; kt < 1024; kt += 32) {
                glds16(a0 + kt, SA + tid * 16);
                glds16(b0 + kt, SB + tid * 16);
                asm volatile("s_waitcnt vmcnt(0)" ::: "memory");
                __syncthreads();
                const bf16x8 af = *(const bf16x8*)(SA + ((wid * 16 + fr) * 64 + fq * 16));
#pragma unroll
                for (int n = 0; n < 4; ++n) { const bf16x8 bq = *(const bf16x8*)(SB + ((n * 16 + fr) * 64 + fq * 16)); acc[n] = mfma16(bq, af, acc[n]); }
                __syncthreads();
            }
        }
#pragma unroll
        for (int n = 0; n < 4; ++n)
#pragma unroll
            for (int j = 0; j < 4; ++j) {
                const int e = n * 16 + 4 * fq + j;
                const float s = 1.0f / (1.0f + expf(-acc[n][j]));
                SC[(wid * 16 + fr) * 64 + e] = s;
                SEL[(wid * 16 + fr) * 64 + e] = s + p.router_b[l * 64 + e];
            }
        __syncthreads();
        if (tid < 64) {
            const int row = m0 + tid;
            const float* sel = SEL + tid * 64; const float* sc = SC + tid * 64;
            float gs[8];
#pragma unroll
            for (int g = 0; g < 8; ++g) {
                float m1 = -1e30f, m2 = -1e30f;
#pragma unroll
                for (int j = 0; j < 8; ++j) { const float v = sel[g * 8 + j]; if (v > m1) { m2 = m1; m1 = v; } else if (v > m2) m2 = v; }
                gs[g] = m1 + m2;
            }
            unsigned gmask = 0;
#pragma unroll
            for (int r = 0; r < 4; ++r) {
                int best = 0; float bv = -1e30f;
#pragma unroll
                for (int g = 0; g < 8; ++g) { const bool free = !((gmask >> g) & 1u); if (free && gs[g] > bv) { bv = gs[g]; best = g; } }
                gmask |= 1u << best;
            }
            unsigned long long chosen = 0ull;
            int es[8]; float wsel[8]; float wsum = 0.f;
#pragma unroll
            for (int k = 0; k < 8; ++k) {
                int best = 0; float bv = -1e30f;
                for (int e = 0; e < 64; ++e) {
                    const bool ok = ((gmask >> (e >> 3)) & 1u) && !((chosen >> e) & 1ull);
                    const float v = sel[e];
                    if (ok && v > bv) { bv = v; best = e; }
                }
                chosen |= 1ull << best;
                es[k] = best; wsel[k] = sc[best]; wsum += wsel[k];
            }
            const float wn = 2.5f / wsum;
#pragma unroll
            for (int k = 0; k < 8; ++k) {
                const int e = es[k];
                const int slot = atomicAdd(&cnt[e], 1);
                list[(size_t)e * NT + slot] = row * 8 + k;
                tke[row * 8 + k] = e; tks[row * 8 + k] = slot; tkw[row * 8 + k] = wsel[k] * wn;
            }
        }
        __syncthreads();
    }
}

struct RoundInfo { int nrounds; int e_lo, e_hi; };
DEV RoundInfo moe_round_info(const int* cnt, int cap, int r) {
    RoundInfo ri; ri.e_lo = 0; ri.e_hi = 0;
    int round = 0, start = 0, used = 0;
    for (int e = 0; e < 64; ++e) {
        const int c = cnt[e];
        if (used + c > cap) { if (round == r) { ri.e_lo = start; ri.e_hi = e; } ++round; start = e; used = 0; }
        used += c;
    }
    if (round == r) { ri.e_lo = start; ri.e_hi = 64; }
    ri.nrounds = round + 1;
    return ri;
}

DEV void moe_routed_tile(const Params& p, int e, int s0, int cnt_e, int ysbase, char* lds) {
    const int tid = get_tid(), lane = tid & 63, wid = tid >> 6, fr = lane & 15, fq = lane >> 4, wr = wid >> 1, wc = wid & 1;
    const bf16_t* H = (const bf16_t*)(p.ws + OFF_H);
    const bf16_t* W13 = (const bf16_t*)(p.ws + OFF_W13) + (size_t)e * 256 * 1024;
    const bf16_t* W2 = (const bf16_t*)(p.ws + OFF_W2) + (size_t)e * 1024 * 128;
    const int* list = (const int*)(p.ws + OFF_LIST) + (size_t)e * NT;
    const float* tkw = (const float*)(p.ws + OFF_TKW);
    bf16_t* YS = (bf16_t*)(p.ws + OFF_YS);
    char* ACT = lds + 16384;
    const int nvalid = min(128, cnt_e - s0);
    const int r0 = min(tid >> 2, nvalid - 1), r1 = min((tid >> 2) + 64, nvalid - 1);
    const bf16_t* a0 = H + (size_t)(list[s0 + r0] >> 3) * 1024 + (tid & 3) * 8;
    const bf16_t* a1 = H + (size_t)(list[s0 + r1] >> 3) * 1024 + (tid & 3) * 8;
    float gw[4];
#pragma unroll
    for (int m = 0; m < 4; ++m) { const int rl = min(wr * 64 + m * 16 + fr, nvalid - 1); gw[m] = tkw[list[s0 + rl]]; }
#pragma unroll 1
    for (int np = 0; np < 2; ++np) {
        const bf16_t* b0 = W13 + (size_t)(np * 128 + (tid >> 2)) * 1024 + (tid & 3) * 8;
        f32x4 acc[4][4]; zero_acc<4>(acc);
        gemm_core<4, true>(acc, a0, a1, b0, b0 + 64 * 1024, 1024, lds);
#pragma unroll
        for (int m = 0; m < 4; ++m) {
            const int rl = wr * 64 + m * 16 + fr;
#pragma unroll
            for (int pi = 0; pi < 2; ++pi) {
                const int hid = np * 64 + wc * 32 + pi * 16 + 4 * fq;
                float o[4];
#pragma unroll
                for (int j = 0; j < 4; ++j) { const float a = acc[m][2 * pi][j], b = acc[m][2 * pi + 1][j]; o[j] = a / (1.0f + expf(-a)) * b * gw[m]; }
                *(u32x2*)(ACT + rl * 272 + hid * 2) = (u32x2){pk2(o[0], o[1]), pk2(o[2], o[3])};
            }
        }
    }
    __syncthreads();
    char* SB = lds + 8192;
#pragma unroll 1
    for (int nt = 0; nt < 8; ++nt) {
        const bf16_t* b0 = W2 + (size_t)(nt * 128 + (tid >> 2)) * 128 + (tid & 3) * 8;
        f32x4 acc[4][4]; zero_acc<4>(acc);
#pragma unroll 1
        for (int ks = 0; ks < 4; ++ks) {
            glds16(b0 + ks * 32, SB + tid * 16);
            glds16(b0 + 64 * 128 + ks * 32, SB + 4096 + tid * 16);
            asm volatile("s_waitcnt vmcnt(0)" ::: "memory");
            __syncthreads();
            bf16x8 af[4], bfr[4];
#pragma unroll
            for (int m = 0; m < 4; ++m) af[m] = *(const bf16x8*)(ACT + (wr * 64 + m * 16 + fr) * 272 + (ks * 32 + fq * 8) * 2);
#pragma unroll
            for (int n = 0; n < 4; ++n) bfr[n] = *(const bf16x8*)(SB + ((wc * 64 + n * 16 + fr) * 64 + fq * 16));
#pragma unroll
            for (int m = 0; m < 4; ++m)
#pragma unroll
                for (int n = 0; n < 4; ++n) acc[m][n] = mfma16(bfr[n], af[m], acc[m][n]);
            __syncthreads();
        }
#pragma unroll
        for (int m = 0; m < 4; ++m) {
            const int rl = wr * 64 + m * 16 + fr;
            if (rl < nvalid) {
                bf16_t* o = YS + (size_t)(ysbase + s0 + rl) * 1024 + nt * 128 + wc * 64 + 4 * fq;
#pragma unroll
                for (int n = 0; n < 4; ++n) *(u32x2*)(o + n * 16) = (u32x2){pk2(acc[m][n][0], acc[m][n][1]), pk2(acc[m][n][2], acc[m][n][3])};
            }
        }
    }
    __syncthreads();
}
DEV void moe_shared_tile(const Params& p, int l, int m0, char* lds) {
    const int tid = get_tid(), lane = tid & 63, wid = tid >> 6, fr = lane & 15, fq = lane >> 4, wr = wid >> 1, wc = wid & 1;
    const bf16_t* H = (const bf16_t*)(p.ws + OFF_H);
    const bf16_t* W13 = (const bf16_t*)(p.ws + OFF_SW13) + (size_t)l * 512 * 1024;
    const bf16_t* W2 = (const bf16_t*)(p.ws + OFF_SW2) + (size_t)l * 1024 * 256;
    const float* g2 = (const float*)(p.ws + OFF_MOD) + (size_t)l * 9 * 6144 + (size_t)mod_group(m0) * 6144 + 5120;
    float* X = (float*)(p.ws + OFF_X);
    char* ACT = lds + 16384;
    const bf16_t* a0 = H + (size_t)(m0 + (tid >> 2)) * 1024 + (tid & 3) * 8;
#pragma unroll 1
    for (int np = 0; np < 4; ++np) {
        const bf16_t* b0 = W13 + (size_t)(np * 128 + (tid >> 2)) * 1024 + (tid & 3) * 8;
        f32x4 acc[2][4]; zero_acc<2>(acc);
        gemm_core<2, true>(acc, a0, a0, b0, b0 + 64 * 1024, 1024, lds);
#pragma unroll
        for (int m = 0; m < 2; ++m) {
            const int rl = wr * 32 + m * 16 + fr;
#pragma unroll
            for (int pi = 0; pi < 2; ++pi) {
                const int hid = np * 64 + wc * 32 + pi * 16 + 4 * fq;
                float o[4];
#pragma unroll
                for (int j = 0; j < 4; ++j) { const float a = acc[m][2 * pi][j], b = acc[m][2 * pi + 1][j]; o[j] = a / (1.0f + expf(-a)) * b; }
                *(u32x2*)(ACT + rl * 528 + hid * 2) = (u32x2){pk2(o[0], o[1]), pk2(o[2], o[3])};
            }
        }
    }
    __syncthreads();
    char* SB = lds + 8192;
#pragma unroll 1
    for (int nt = 0; nt < 8; ++nt) {
        const bf16_t* b0 = W2 + (size_t)(nt * 128 + (tid >> 2)) * 256 + (tid & 3) * 8;
        f32x4 acc[2][4]; zero_acc<2>(acc);
#pragma unroll 1
        for (int ks = 0; ks < 8; ++ks) {
            glds16(b0 + ks * 32, SB + tid * 16);
            glds16(b0 + 64 * 256 + ks * 32, SB + 4096 + tid * 16);
            asm volatile("s_waitcnt vmcnt(0)" ::: "memory");
            __syncthreads();
            bf16x8 af[2], bfr[4];
#pragma unroll
            for (int m = 0; m < 2; ++m) af[m] = *(const bf16x8*)(ACT + (wr * 32 + m * 16 + fr) * 528 + (ks * 32 + fq * 8) * 2);
#pragma unroll
            for (int n = 0; n < 4; ++n) bfr[n] = *(const bf16x8*)(SB + ((wc * 64 + n * 16 + fr) * 64 + fq * 16));
#pragma unroll
            for (int m = 0; m < 2; ++m)
#pragma unroll
                for (int n = 0; n < 4; ++n) acc[m][n] = mfma16(bfr[n], af[m], acc[m][n]);
            __syncthreads();
        }
#pragma unroll
        for (int m = 0; m < 2; ++m) {
            const int row = m0 + wr * 32 + m * 16 + fr;
#pragma unroll
            for (int n = 0; n < 4; ++n) {
                const int col = nt * 128 + wc * 64 + n * 16 + 4 * fq;
                float* xp = X + (size_t)row * 1024 + col;
                const f32x4 xv = *(const f32x4*)xp, g = *(const f32x4*)(g2 + col);
                *(f32x4*)xp = xv * DN_ALPHA + g * acc[m][n];
            }
        }
    }
    __syncthreads();
}
DEV void phase_moe(const Params& p, int l, int r, char* lds) {
    const int* cnt = (const int*)(p.ws + OFF_CNT) + l * 64;
    const RoundInfo ri = moe_round_info(cnt, p.cap, r);
    if (r >= ri.nrounds) return;
    int* SH = (int*)(lds + 60 * 1024);
    if (threadIdx.x == 0) {
        int tp = 0, yb = 0;
        for (int e = ri.e_lo; e < ri.e_hi; ++e) { SH[e] = tp; SH[64 + e] = yb; tp += (cnt[e] + 127) >> 7; yb += cnt[e]; }
        SH[128] = tp;
    }
    __syncthreads();
    const int nrt = SH[128];
    const int nsh = (r == 0) ? (l == 0 ? NT : NLAT) / 64 : 0;
    for (int it = blockIdx.x; it < nrt + nsh; it += gridDim.x) {
        if (it < nrt) {
            int e = ri.e_lo;
            while (e + 1 < ri.e_hi && SH[e + 1] <= it) ++e;
            moe_routed_tile(p, e, (it - SH[e]) * 128, cnt[e], SH[64 + e], lds);
        } else moe_shared_tile(p, l, (it - nrt) * 64, lds);
    }
}

DEV void phase_comb(const Params& p, int l, int r, char* lds) {
    const int tid_ = get_tid(), lane = tid_ & 63, wid = tid_ >> 6;
    const int* cnt = (const int*)(p.ws + OFF_CNT) + l * 64;
    const RoundInfo ri = moe_round_info(cnt, p.cap, r);
    if (r >= ri.nrounds) return;
    const bool final = (r == ri.nrounds - 1);
    int* SH = (int*)(lds + 60 * 1024);
    if (threadIdx.x == 0) { int yb = 0; for (int e = ri.e_lo; e < ri.e_hi; ++e) { SH[e] = yb; yb += cnt[e]; } }
    __syncthreads();
    float* X = (float*)(p.ws + OFF_X);
    bf16_t* H = (bf16_t*)(p.ws + OFF_H);
    const bf16_t* YS = (const bf16_t*)(p.ws + OFF_YS);
    const int* tke = (const int*)(p.ws + OFF_TKE); const int* tks = (const int*)(p.ws + OFF_TKS);
    const float* mod = (const float*)(p.ws + OFF_MOD);
    const int nrows = (l == 0) ? NT : NLAT;
    for (int row = blockIdx.x * 4 + wid; row < nrows; row += gridDim.x * 4) {
        const int g = mod_group(row);
        const float* g2 = mod + ((size_t)l * 9 + g) * 6144 + 5120;
        f32x4 v[4]; row_load(X + (size_t)row * 1024, v, lane);
        f32x4 s[4];
#pragma unroll
        for (int j = 0; j < 4; ++j) s[j] = (f32x4){0.f, 0.f, 0.f, 0.f};
        for (int k = 0; k < 8; ++k) {
            const int e = tke[row * 8 + k];
            if (e >= ri.e_lo && e < ri.e_hi) {
                const bf16_t* y = YS + (size_t)(SH[e] + tks[row * 8 + k]) * 1024;
#pragma unroll
                for (int j = 0; j < 4; ++j) {
                    const u32x2 w = *(const u32x2*)(y + 4 * lane + 256 * j);
                    s[j][0] += __uint_as_float(w[0] << 16); s[j][1] += __uint_as_float(w[0] & 0xffff0000u);
                    s[j][2] += __uint_as_float(w[1] << 16); s[j][3] += __uint_as_float(w[1] & 0xffff0000u);
                }
            }
        }
#pragma unroll
        for (int j = 0; j < 4; ++j) v[j] = v[j] + *(const f32x4*)(g2 + 4 * lane + 256 * j) * s[j];
        if (!final) {
#pragma unroll
            for (int j = 0; j < 4; ++j) *(f32x4*)(X + (size_t)row * 1024 + 4 * lane + 256 * j) = v[j];
        } else {
            row_norm(v);
            float* dst = (l == 0) ? X + (size_t)row * 1024 : p.out + (size_t)row * 1024;
#pragma unroll
            for (int j = 0; j < 4; ++j) {
                const int c = 4 * lane + 256 * j;
                v[j] = v[j] * *(const f32x4*)(p.ln2_g + l * 1024 + c) + *(const f32x4*)(p.ln2_b + l * 1024 + c);
                *(f32x4*)(dst + c) = v[j];
            }
            if (l == 0) {
                row_norm(v);
                const float* m1 = mod + ((size_t)9 + g) * 6144;
                row_store_mod_bf16(H + (size_t)row * 1024, v, m1, m1 + 1024, lane);
            }
        }
    }
    if (final && l == 0) {
        __syncthreads();
        for (int it = blockIdx.x; it < 6144; it += gridDim.x) conv_expert_item(p, 1, it, lds);
    }
}

enum { PT_PREP = 0, PT_MODFIN, PT_LNMOD0, PT_INPROJ, PT_MIX, PT_OUTPROJ, PT_LN1ROUTE, PT_MOE, PT_COMB };
constexpr int SMEM_BYTES = 62 * 1024;

DEV void run_phase(const Params& p, int type, int l, int r, char* lds) {
    switch (type) {
        case PT_PREP: phase_prep(p, lds); break;
        case PT_MODFIN: phase_modfin(p); break;
        case PT_LNMOD0: phase_lnmod0(p); break;
        case PT_INPROJ: phase_inproj(p, l, lds); break;
        case PT_MIX: phase_mix(p, l, lds); break;
        case PT_OUTPROJ: phase_outproj(p, l, lds); break;
        case PT_LN1ROUTE: phase_ln1route(p, l, lds); break;
        case PT_MOE: phase_moe(p, l, r, lds); break;
        default: phase_comb(p, l, r, lds); break;
    }
}

__global__ void __launch_bounds__(256, 2) fwd_kernel(Params p) {
    __shared__ __attribute__((aligned(16))) char smem[SMEM_BYTES];
#if MULTI_LAUNCH
    run_phase(p, p.ptype, p.pl, p.pr, smem);
#else
    cg::grid_group grid = cg::this_grid();
    int type = PT_PREP, l = 0, r = 0;
    for (;;) {
        run_phase(p, type, l, r, smem);
        if (type < PT_MOE) { ++type; r = 0; }
        else if (type == PT_MOE) type = PT_COMB;
        else {
            const int nr = moe_round_info((const int*)(p.ws + OFF_CNT) + l * 64, p.cap, 0).nrounds;
            if (r + 1 < nr) { ++r; type = PT_MOE; }
            else { if (l == 1) break; l = 1; r = 0; type = PT_INPROJ; }
        }
        grid.sync();
    }
#endif
}

extern "C" void kernel_launch(void* const* d_in, const int* in_sizes, int n_in, void* d_out, int out_size, void* d_ws, size_t ws_size, hipStream_t stream) {
    Params p{};
    const float** pp = (const float**)&p;
    for (int i = 0; i < 32; ++i) pp[i] = (const float*)d_in[i];
    p.out = (float*)d_out; p.ws = (unsigned char*)d_ws;
    long long cap = ((long long)ws_size - (long long)OFF_R) / 2048;
    if (cap > NT * 8) cap = NT * 8;
    if (cap * 2048 < (long long)R_MIN_BYTES || cap < NT) { fprintf(stderr, "kernel_launch: workspace too small (%zu)\n", ws_size); return; }
    p.cap = (int)cap;
#if MULTI_LAUNCH
    const int grid = 512;
    auto launch = [&](int type, int l, int r) { Params q = p; q.mode = 1; q.ptype = type; q.pl = l; q.pr = r; hipLaunchKernelGGL(fwd_kernel, dim3(grid), dim3(256), 0, stream, q); };
    launch(PT_PREP, 0, 0); launch(PT_MODFIN, 0, 0); launch(PT_LNMOD0, 0, 0);
    for (int l = 0; l < 2; ++l) {
        launch(PT_INPROJ, l, 0); launch(PT_MIX, l, 0); launch(PT_OUTPROJ, l, 0); launch(PT_LN1ROUTE, l, 0);
        for (int r = 0; r < RMAX; ++r) { launch(PT_MOE, l, r); launch(PT_COMB, l, r); }
    }
#else
    static int grid_blocks = 0;
    if (!grid_blocks) {
        int dev = 0, cus = 0, per_cu = 0;
        hipGetDevice(&dev);
        hipDeviceGetAttribute(&cus, hipDeviceAttributeMultiprocessorCount, dev);
        hipOccupancyMaxActiveBlocksPerMultiprocessor(&per_cu, fwd_kernel, 256, 0);
        if (per_cu > 2) per_cu = 2;
        if (per_cu < 1) per_cu = 1;
        grid_blocks = cus * per_cu;
    }
    p.mode = 0;
    void* args[] = {&p};
    hipError_t e = hipLaunchCooperativeKernel((void*)fwd_kernel, dim3(grid_blocks), dim3(256), args, 0, stream);
    if (e != hipSuccess) fprintf(stderr, "cooperative launch failed: %s (grid %d)\n", hipGetErrorString(e), grid_blocks);
#endif
}
```

```cpp
#include <hip/hip_runtime.h>
#include <hip/hip_cooperative_groups.h>
#include <stdint.h>
#include <stdio.h>
namespace cg = cooperative_groups;

#ifndef MULTI_LAUNCH
#define MULTI_LAUNCH 0
#endif

typedef unsigned short bf16_t;
typedef short bf16x8 __attribute__((ext_vector_type(8)));
typedef short s16x4 __attribute__((ext_vector_type(4)));
typedef float f32x4 __attribute__((ext_vector_type(4)));
typedef unsigned u32x4 __attribute__((ext_vector_type(4)));
typedef unsigned u32x2 __attribute__((ext_vector_type(2)));
#define DEV __device__ __forceinline__
#define LDSP(T) __attribute__((address_space(3))) T*

constexpr int D = 1024, NB = 8, SEQ = 2048, CTX = 256, NLAT = NB * SEQ, NCTX = NB * CTX, NT = NLAT + NCTX;
constexpr int PROJ = 2304, KEYS = CTX + SEQ, NEXP = 64;
constexpr float DN_ALPHA = 1.41421356237309515f;
constexpr float LOG2E = 1.44269504088896341f;
constexpr int RMAX = 4;

constexpr size_t OFF_CNT = 0;
constexpr size_t OFF_BAR = 4096;
constexpr size_t OFF_MOD = 65536;
constexpr size_t OFF_ROPE = OFF_MOD + 442368;
constexpr size_t OFF_KERNL = OFF_ROPE + 2ull * 2048 * 32 * 4;
constexpr size_t OFF_KERNC = OFF_KERNL + 2ull * 4096 * 256 * 4;
constexpr size_t OFF_TKE = OFF_KERNC + 2ull * 512 * 256 * 4;
constexpr size_t OFF_TKS = OFF_TKE + (size_t)NT * 8 * 4;
constexpr size_t OFF_TKW = OFF_TKS + (size_t)NT * 8 * 4;
constexpr size_t OFF_LIST = OFF_TKW + (size_t)NT * 8 * 4;
constexpr size_t OFF_WIN = OFF_LIST + 64ull * NT * 4;
constexpr size_t OFF_WOUT = OFF_WIN + 2ull * 2304 * 1024 * 2;
constexpr size_t OFF_SW13 = OFF_WOUT + 2ull * 1024 * 1024 * 2;
constexpr size_t OFF_SW2 = OFF_SW13 + 2ull * 512 * 1024 * 2;
constexpr size_t OFF_RW = OFF_SW2 + 2ull * 1024 * 256 * 2;
constexpr size_t OFF_W13 = OFF_RW + 2ull * 64 * 1024 * 2;
constexpr size_t OFF_W2 = OFF_W13 + 64ull * 256 * 1024 * 2;
constexpr size_t OFF_X = OFF_W2 + 64ull * 1024 * 128 * 2;
constexpr size_t OFF_H = OFF_X + (size_t)NT * 1024 * 4;
constexpr size_t OFF_R = OFF_H + (size_t)NT * 1024 * 2;
constexpr size_t OFF_QA = OFF_R;
constexpr size_t OFF_QB = OFF_QA + 8ull * NT * 64 * 2;
constexpr size_t OFF_KA = OFF_QB + 4ull * NT * 64 * 2;
constexpr size_t OFF_VA = OFF_KA + 8ull * 2 * KEYS * 64 * 2;
constexpr size_t OFF_KB = OFF_VA + 8ull * 2 * KEYS * 64 * 2;
constexpr size_t OFF_VB = OFF_KB + 8ull * 4 * KEYS * 64 * 2;
constexpr size_t OFF_ZTL = OFF_VB + 8ull * 4 * KEYS * 64 * 2;
constexpr size_t OFF_ZTC = OFF_ZTL + 8ull * 768 * 2048 * 2;
constexpr size_t OFF_OX = OFF_ZTC + 8ull * 768 * 256 * 2;
constexpr size_t R_MIN_BYTES = OFF_OX + (size_t)NT * 1024 * 2 - OFF_R;
constexpr size_t OFF_PART = OFF_R;
constexpr size_t OFF_YS = OFF_R;

struct Params {
    const float *x, *c, *ctx, *c_ctx, *ada_w, *ada_b, *w_in, *q_gain, *k_gain, *nat_rpb, *hy_conv_w, *hy_conv_b,
        *hy_f_w1, *hy_f_b1, *hy_f_w2, *hy_f_b2, *hy_f_w3, *hy_freq, *hy_skip, *w_out, *ln1_g, *ln1_b,
        *router_w, *router_b, *exp_w1, *exp_w3, *exp_w2, *sh_w1, *sh_w3, *sh_w2, *ln2_g, *ln2_b;
    float* out; unsigned char* ws;
    int cap, mode, ptype, pl, pr, pad;
};

DEV unsigned f2bf(float f) { unsigned u = __float_as_uint(f); return (u + 0x7fffu + ((u >> 16) & 1u)) >> 16; }
DEV unsigned pk2(float lo, float hi) { return f2bf(lo) | (f2bf(hi) << 16); }
DEV float bf2f(unsigned short h) { return __uint_as_float(((unsigned)h) << 16); }
DEV float wave_sum(float v) {
#pragma unroll
    for (int o = 32; o > 0; o >>= 1) v += __shfl_xor(v, o);
    return v;
}
DEV void glds16(const void* g, void* l) { __builtin_amdgcn_global_load_lds((const unsigned*)g, (unsigned*)l, 16, 0, 0); }
DEV f32x4 mfma16(bf16x8 a, bf16x8 b, f32x4 c) { return __builtin_amdgcn_mfma_f32_16x16x32_bf16(a, b, c, 0, 0, 0); }
DEV int get_tid() { int t = threadIdx.x; asm volatile("" : "+v"(t)); return t; }
DEV int mod_group(int row) { return row < NLAT ? (row >> 11) : 8; }

template <int MI, bool TRANS>
DEV void gemm_core(f32x4 (&acc)[MI][4], const bf16_t* a0, const bf16_t* a1, const bf16_t* b0, const bf16_t* b1, int K, char* lds) {
    const int tid = get_tid(), lane = tid & 63, wid = tid >> 6, fr = lane & 15, fq = lane >> 4, wr = wid >> 1, wc = wid & 1;
    char* SA = lds; char* SB = lds + 8192;
    for (int kt = 0; kt < K; kt += 32) {
        glds16(a0 + kt, SA + tid * 16);
        if (MI == 4) glds16(a1 + kt, SA + 4096 + tid * 16);
        glds16(b0 + kt, SB + tid * 16);
        glds16(b1 + kt, SB + 4096 + tid * 16);
        asm volatile("s_waitcnt vmcnt(0)" ::: "memory");
        __syncthreads();
        bf16x8 af[MI], bfr[4];
#pragma unroll
        for (int m = 0; m < MI; ++m) af[m] = *(const bf16x8*)(SA + ((wr * MI * 16 + m * 16 + fr) * 64 + fq * 16));
#pragma unroll
        for (int n = 0; n < 4; ++n) bfr[n] = *(const bf16x8*)(SB + ((wc * 64 + n * 16 + fr) * 64 + fq * 16));
#pragma unroll
        for (int m = 0; m < MI; ++m)
#pragma unroll
            for (int n = 0; n < 4; ++n) acc[m][n] = TRANS ? mfma16(bfr[n], af[m], acc[m][n]) : mfma16(af[m], bfr[n], acc[m][n]);
        __syncthreads();
    }
}
template <int MI> DEV void zero_acc(f32x4 (&acc)[MI][4]) {
#pragma unroll
    for (int m = 0; m < MI; ++m)
#pragma unroll
        for (int n = 0; n < 4; ++n) acc[m][n] = (f32x4){0.f, 0.f, 0.f, 0.f};
}

DEV void prep_mod_item(const Params& p, int it, char* lds) {
    const int l = it / 768, rem = it % 768, cch = rem / 32, kch = rem % 32, tid = get_tid();
    float* sl = (float*)lds;
    for (int i = tid; i < 288; i += 256) { const int g = i / 32, k = kch * 32 + (i % 32); const float v = (g < 8) ? p.c[g * 1024 + k] : p.c_ctx[k]; sl[i] = v / (1.f + expf(-v)); }
    __syncthreads();
    const int col = cch * 256 + tid;
    float acc[9];
#pragma unroll
    for (int g = 0; g < 9; ++g) acc[g] = 0.f;
    const float* w = p.ada_w + ((size_t)l * 1024 + kch * 32) * 6144 + col;
#pragma unroll 8
    for (int kk = 0; kk < 32; ++kk) {
        const float wv = w[(size_t)kk * 6144];
#pragma unroll
        for (int g = 0; g < 9; ++g) acc[g] += sl[g * 32 + kk] * wv;
    }
    float* part = (float*)(p.ws + OFF_PART);
#pragma unroll
    for (int g = 0; g < 9; ++g) part[((size_t)(kch * 2 + l) * 9 + g) * 6144 + col] = acc[g];
    __syncthreads();
}
DEV void prep_rope_item(const Params& p, int it) {
    const int idx = it * 256 + threadIdx.x, t = idx >> 5, i = idx & 31;
    const float inv = powf(10000.f, -(float)(2 * (i & 15)) / 32.f);
    const float ang = (float)((i < 16) ? (t >> 6) : (t & 63)) * inv;
    float* rc = (float*)(p.ws + OFF_ROPE);
    rc[idx] = cosf(ang); rc[2048 * 32 + idx] = sinf(ang);
}
DEV void prep_filter_item(const Params& p, int it, char* lds) {
    const int l = it / 2304, r = it % 2304, type = r < 2048 ? 0 : 1, t = type ? r - 2048 : r, n = type ? 256 : 2048, tid = get_tid();
    float* z = (float*)lds; float* h1 = z + 64; float* h2 = h1 + 64;
    const float tt = (float)t / (float)(n - 1);
    if (tid < 33) {
        float v;
        if (tid == 0) v = tt;
        else {
            const int i = (tid - 1) & 15;
            const float f = 1e-4f + (float)i * ((15.f - 1e-4f) / 15.f);
            const float w = 2.f * 3.14159265358979323846f * (float)t / (float)n;
            v = (tid <= 16) ? cosf(f * w) : -sinf(f * w);
        }
        z[tid] = v;
    }
    __syncthreads();
    if (tid < 64) {
        float s = p.hy_f_b1[l * 64 + tid];
        for (int i = 0; i < 33; ++i) s += z[i] * p.hy_f_w1[(l * 33 + i) * 64 + tid];
        h1[tid] = sinf(p.hy_freq[(l * 2 + 0) * 64 + tid] * s);
    }
    __syncthreads();
    if (tid < 64) {
        float s = p.hy_f_b2[l * 64 + tid];
        for (int i = 0; i < 64; ++i) s += h1[i] * p.hy_f_w2[(l * 64 + i) * 64 + tid];
        h2[tid] = sinf(p.hy_freq[(l * 2 + 1) * 64 + tid] * s);
    }
    __syncthreads();
    float* kern = (float*)(p.ws + (type ? OFF_KERNC + (size_t)l * 512 * 256 * 4 : OFF_KERNL + (size_t)l * 4096 * 256 * 4));
    const float lo = logf(1e-2f) / 1.5f, hi = logf(1e-2f) / 0.3f;
    for (int o = tid; o < 512; o += 256) {
        float s = 0.f;
        for (int i = 0; i < 64; ++i) s += h2[i] * p.hy_f_w3[(l * 64 + i) * 512 + o];
        const int c = o & 255;
        const float delta = fabsf(lo + (float)c * ((hi - lo) / 255.f));
        const float v = s * expf(-tt * delta);
        if (o < 256) kern[(size_t)(n - 1 + t) * 256 + c] = v;
        else if (t >= 1) kern[(size_t)(n - 1 - t) * 256 + c] = v;
    }
    __syncthreads();
}
DEV void conv_tile(const float* src, int ldsrc, int k0, int n0, bf16_t* dst, int lddst, int mapkind, char* lds) {
    float* tl = (float*)lds;
    const int tid = get_tid();
    {
        const int r = tid >> 4, c4 = (tid & 15) * 4;
#pragma unroll
        for (int i = 0; i < 4; ++i) {
            const int row = r + 16 * i;
            const f32x4 v = *(const f32x4*)(src + (size_t)(k0 + row) * ldsrc + n0 + c4);
            tl[row * 65 + c4 + 0] = v[0]; tl[row * 65 + c4 + 1] = v[1]; tl[row * 65 + c4 + 2] = v[2]; tl[row * 65 + c4 + 3] = v[3];
        }
    }
    __syncthreads();
    {
        const int n = tid >> 2, kc = tid & 3, ng = n0 + n;
        int drow = ng;
        if (mapkind == 1) drow = 32 * (ng >> 4) + (ng & 15);
        else if (mapkind == 2) drow = 32 * (ng >> 4) + 16 + (ng & 15);
        unsigned w[8];
#pragma unroll
        for (int j = 0; j < 8; ++j) w[j] = pk2(tl[(kc * 16 + 2 * j) * 65 + n], tl[(kc * 16 + 2 * j + 1) * 65 + n]);
        u32x4* d = (u32x4*)(dst + (size_t)drow * lddst + k0 + kc * 16);
        d[0] = (u32x4){w[0], w[1], w[2], w[3]};
        d[1] = (u32x4){w[4], w[5], w[6], w[7]};
    }
    __syncthreads();
}
DEV void conv_fixed_item(const Params& p, int it, char* lds) {
    const int l = it / 1040; int r = it % 1040;
    unsigned char* ws = p.ws;
    if (r < 576) { conv_tile(p.w_in + (size_t)l * 1024 * PROJ, PROJ, (r / 36) * 64, (r % 36) * 64, (bf16_t*)(ws + OFF_WIN) + (size_t)l * PROJ * 1024, 1024, 0, lds); return; }
    r -= 576;
    if (r < 256) { conv_tile(p.w_out + (size_t)l * 1024 * 1024, 1024, (r / 16) * 64, (r % 16) * 64, (bf16_t*)(ws + OFF_WOUT) + (size_t)l * 1024 * 1024, 1024, 0, lds); return; }
    r -= 256;
    if (r < 64) { conv_tile(p.sh_w1 + (size_t)l * 1024 * 256, 256, (r / 4) * 64, (r % 4) * 64, (bf16_t*)(ws + OFF_SW13) + (size_t)l * 512 * 1024, 1024, 1, lds); return; }
    r -= 64;
    if (r < 64) { conv_tile(p.sh_w3 + (size_t)l * 1024 * 256, 256, (r / 4) * 64, (r % 4) * 64, (bf16_t*)(ws + OFF_SW13) + (size_t)l * 512 * 1024, 1024, 2, lds); return; }
    r -= 64;
    if (r < 64) { conv_tile(p.sh_w2 + (size_t)l * 256 * 1024, 1024, (r / 16) * 64, (r % 16) * 64, (bf16_t*)(ws + OFF_SW2) + (size_t)l * 1024 * 256, 256, 0, lds); return; }
    r -= 64;
    conv_tile(p.router_w + (size_t)l * 1024 * 64, 64, r * 64, 0, (bf16_t*)(ws + OFF_RW) + (size_t)l * 64 * 1024, 1024, 0, lds);
}
DEV void conv_expert_item(const Params& p, int l, int it, char* lds) {
    const int e = it / 96; int r = it % 96;
    unsigned char* ws = p.ws;
    const size_t eo = (size_t)(l * 64 + e) * 1024 * 128;
    if (r < 32) { conv_tile(p.exp_w1 + eo, 128, (r / 2) * 64, (r % 2) * 64, (bf16_t*)(ws + OFF_W13) + (size_t)e * 256 * 1024, 1024, 1, lds); return; }
    r -= 32;
    if (r < 32) { conv_tile(p.exp_w3 + eo, 128, (r / 2) * 64, (r % 2) * 64, (bf16_t*)(ws + OFF_W13) + (size_t)e * 256 * 1024, 1024, 2, lds); return; }
    r -= 32;
    conv_tile(p.exp_w2 + eo, 1024, (r / 16) * 64, (r % 16) * 64, (bf16_t*)(ws + OFF_W2) + (size_t)e * 1024 * 128, 128, 0, lds);
}
DEV void phase_prep(const Params& p, char* lds) {
    if (blockIdx.x == 0 && threadIdx.x < 128) ((int*)(p.ws + OFF_CNT))[threadIdx.x] = 0;
    constexpr int N0 = 1536, N1 = N0 + 256, N2 = N1 + 4608, N3 = N2 + 2080, N4 = N3 + 6144;
    for (int it = blockIdx.x; it < N4; it += gridDim.x) {
        if (it < N0) prep_mod_item(p, it, lds);
        else if (it < N1) prep_rope_item(p, it - N0);
        else if (it < N2) prep_filter_item(p, it - N1, lds);
        else if (it < N3) conv_fixed_item(p, it - N2, lds);
        else conv_expert_item(p, 0, it - N3, lds);
    }
}
DEV void phase_modfin(const Params& p) {
    const float* part = (const float*)(p.ws + OFF_PART);
    float* mod = (float*)(p.ws + OFF_MOD);
    for (int idx = blockIdx.x * 256 + threadIdx.x; idx < 2 * 9 * 6144; idx += gridDim.x * 256) {
        const int l = idx / (9 * 6144), g = (idx / 6144) % 9, col = idx % 6144;
        float s = p.ada_b[l * 6144 + col];
        for (int k = 0; k < 32; ++k) s += part[((size_t)(k * 2 + l) * 9 + g) * 6144 + col];
        mod[idx] = s;
    }
}

DEV void row_load(const float* src, f32x4 (&v)[4], int lane) {
#pragma unroll
    for (int j = 0; j < 4; ++j) v[j] = *(const f32x4*)(src + 4 * lane + 256 * j);
}
DEV void row_norm(f32x4 (&v)[4]) {
    float s = 0.f;
#pragma unroll
    for (int j = 0; j < 4; ++j) s += (v[j][0] + v[j][1]) + (v[j][2] + v[j][3]);
    const float mean = wave_sum(s) * (1.f / 1024.f);
    float q = 0.f;
#pragma unroll
    for (int j = 0; j < 4; ++j) { v[j] = v[j] - mean; q += (v[j][0] * v[j][0] + v[j][1] * v[j][1]) + (v[j][2] * v[j][2] + v[j][3] * v[j][3]); }
    const float rstd = 1.0f / sqrtf(wave_sum(q) * (1.f / 1024.f) + 1e-6f);
#pragma unroll
    for (int j = 0; j < 4; ++j) v[j] = v[j] * rstd;
}
DEV void row_store_mod_bf16(bf16_t* dst, const f32x4 (&v)[4], const float* shift, const float* scale, int lane) {
#pragma unroll
    for (int j = 0; j < 4; ++j) {
        const int c = 4 * lane + 256 * j;
        const f32x4 sh = *(const f32x4*)(shift + c), sc = *(const f32x4*)(scale + c);
        const f32x4 o = v[j] * (sc + 1.0f) + sh;
        *(u32x2*)(dst + c) = (u32x2){pk2(o[0], o[1]), pk2(o[2], o[3])};
    }
}
DEV void phase_lnmod0(const Params& p) {
    const int tid_ = get_tid(), lane = tid_ & 63, wid = tid_ >> 6;
    const float* mod = (const float*)(p.ws + OFF_MOD);
    bf16_t* H = (bf16_t*)(p.ws + OFF_H);
    for (int row = blockIdx.x * 4 + wid; row < NT; row += gridDim.x * 4) {
        const float* src = row < NLAT ? p.x + (size_t)row * 1024 : p.ctx + (size_t)(row - NLAT) * 1024;
        f32x4 v[4]; row_load(src, v, lane); row_norm(v);
        const float* m = mod + (size_t)mod_group(row) * 6144;
        row_store_mod_bf16(H + (size_t)row * 1024, v, m, m + 1024, lane);
    }
}

DEV void phase_inproj(const Params& p, int l, char* lds) {
    const int tid = get_tid(), lane = tid & 63, wid = tid >> 6, fr = lane & 15, fq = lane >> 4, wr = wid >> 1, wc = wid & 1;
    unsigned char* ws = p.ws;
    const bf16_t* H = (const bf16_t*)(ws + OFF_H);
    const bf16_t* W = (const bf16_t*)(ws + OFF_WIN) + (size_t)l * PROJ * 1024;
    const float* ropec = (const float*)(ws + OFF_ROPE); const float* ropes = ropec + 2048 * 32;
    const int nitems = 128 * 18 + 16 * (l == 0 ? 18 : 6);
    for (int it = blockIdx.x; it < nitems; it += gridDim.x) {
        int mt, nt;
        if (it < 2304) { mt = it / 18; nt = it % 18; }
        else { const int j = it - 2304; if (l == 0) { mt = 128 + j / 18; nt = j % 18; } else { mt = 128 + j / 6; const int q = j % 6; nt = q < 2 ? 4 + q : 6 + q; } }
        const int m0 = mt * 128, n0 = nt * 128;
        const bf16_t* a0 = H + (size_t)(m0 + (tid >> 2)) * 1024 + (tid & 3) * 8;
        const bf16_t* b0 = W + (size_t)(n0 + (tid >> 2)) * 1024 + (tid & 3) * 8;
        f32x4 acc[4][4]; zero_acc<4>(acc);
        const bool latent = m0 < NLAT;
        const int b = latent ? (m0 >> 11) : ((m0 - NLAT) >> 8);
        const int tbase = latent ? (m0 & 2047) : ((m0 - NLAT) & 255);
        if (nt >= 12) {
            gemm_core<4, false>(acc, a0, a0 + 64 * 1024, b0, b0 + 64 * 1024, 1024, lds);
            bf16_t* zt = latent ? (bf16_t*)(ws + OFF_ZTL) + (size_t)b * 768 * 2048 : (bf16_t*)(ws + OFF_ZTC) + (size_t)b * 768 * 256;
            const int n = latent ? 2048 : 256;
#pragma unroll
            for (int m = 0; m < 4; ++m)
#pragma unroll
                for (int nn = 0; nn < 4; ++nn) {
                    const int ch = n0 - 1536 + wc * 64 + nn * 16 + fr, t = tbase + wr * 64 + m * 16 + 4 * fq;
                    *(u32x2*)(zt + (size_t)ch * n + t) = (u32x2){pk2(acc[m][nn][0], acc[m][nn][1]), pk2(acc[m][nn][2], acc[m][nn][3])};
                }
        } else {
            gemm_core<4, true>(acc, a0, a0 + 64 * 1024, b0, b0 + 64 * 1024, 1024, lds);
            const int col0 = n0 + wc * 64;
            int kind, hh;
            if (col0 < 512) { kind = 0; hh = col0 >> 6; } else if (col0 < 640) { kind = 1; hh = (col0 - 512) >> 6; } else if (col0 < 768) { kind = 2; hh = (col0 - 640) >> 6; }
            else if (col0 < 1024) { kind = 3; hh = (col0 - 768) >> 6; } else if (col0 < 1280) { kind = 4; hh = (col0 - 1024) >> 6; } else { kind = 5; hh = (col0 - 1280) >> 6; }
            const bool normed = (kind == 0 || kind == 1);
            const float* gain = (kind == 0 ? p.q_gain : p.k_gain) + l * 64;
#pragma unroll
            for (int m = 0; m < 4; ++m) {
                const int rloc = wr * 64 + m * 16 + fr, row = m0 + rloc, t = tbase + rloc;
                f32x4 v[4];
#pragma unroll
                for (int nn = 0; nn < 4; ++nn) v[nn] = acc[m][nn];
                if (normed) {
                    float ss = 0.f;
#pragma unroll
                    for (int nn = 0; nn < 4; ++nn) ss += (v[nn][0] * v[nn][0] + v[nn][1] * v[nn][1]) + (v[nn][2] * v[nn][2] + v[nn][3] * v[nn][3]);
                    ss += __shfl_xor(ss, 16); ss += __shfl_xor(ss, 32);
                    const float r = 1.0f / sqrtf(ss * (1.f / 64.f) + 1e-6f);
#pragma unroll
                    for (int nn = 0; nn < 4; ++nn) {
                        const f32x4 g = *(const f32x4*)(gain + nn * 16 + 4 * fq);
                        v[nn] = v[nn] * r * g;
                        if (latent) {
                            const int pi = nn * 8 + 2 * fq;
                            const float c0 = ropec[t * 32 + pi], s0 = ropes[t * 32 + pi], c1 = ropec[t * 32 + pi + 1], s1 = ropes[t * 32 + pi + 1];
                            const float x0 = v[nn][0], x1 = v[nn][1], x2 = v[nn][2], x3 = v[nn][3];
                            v[nn][0] = x0 * c0 - x1 * s0; v[nn][1] = x0 * s0 + x1 * c0;
                            v[nn][2] = x2 * c1 - x3 * s1; v[nn][3] = x2 * s1 + x3 * c1;
                        }
                    }
                }
                bf16_t* dst;
                const int key = latent ? 256 + t : t;
                if (kind == 0) dst = (bf16_t*)(ws + OFF_QA) + ((size_t)hh * NT + row) * 64;
                else if (kind == 3) dst = (bf16_t*)(ws + OFF_QB) + ((size_t)hh * NT + row) * 64;
                else if (kind == 1) dst = (bf16_t*)(ws + OFF_KA) + ((size_t)(b * 2 + hh) * KEYS + key) * 64;
                else if (kind == 2) dst = (bf16_t*)(ws + OFF_VA) + ((size_t)(b * 2 + hh) * KEYS + key) * 64;
                else if (kind == 4) dst = (bf16_t*)(ws + OFF_KB) + ((size_t)(b * 4 + hh) * KEYS + key) * 64;
                else dst = (bf16_t*)(ws + OFF_VB) + ((size_t)(b * 4 + hh) * KEYS + key) * 64;
#pragma unroll
                for (int nn = 0; nn < 4; ++nn) *(u32x2*)(dst + nn * 16 + 4 * fq) = (u32x2){pk2(v[nn][0], v[nn][1]), pk2(v[nn][2], v[nn][3])};
            }
        }
    }
}

template <int NQT, bool NA>
DEV void attn_block(const bf16_t* Qh, int qrow0, const bf16_t* Kh, const bf16_t* Vh, int ntiles, bf16_t* outp  ,
                    int na_r, int na_rs, const float* rpb_h, char* lds) {
    const int tid = get_tid(), lane = tid & 63, wid = tid >> 6, fr = lane & 15, fq = lane >> 4;
    char* KBUF = lds;
    char* VBUF = lds + 16384;
    float* BIAS = (float*)(lds + 32768);
    const float c1 = 0.125f * LOG2E;
    if (NA) {
        for (int i = tid; i < 15 * 32; i += 256) { const int dr = i >> 5, dc = i & 31; BIAS[i] = dc < 31 ? rpb_h[dr * 31 + dc] * LOG2E : 0.f; }
    }
    bf16x8 qf[NQT][2];
    const int qw = qrow0 + wid * 16 * NQT;
#pragma unroll
    for (int nq = 0; nq < NQT; ++nq)
#pragma unroll
        for (int ks = 0; ks < 2; ++ks) qf[nq][ks] = *(const bf16x8*)(Qh + (size_t)(qw + nq * 16 + fr) * 64 + ks * 32 + fq * 8);
    f32x4 oacc[4][NQT];
    float mrun[NQT], lsum[NQT];
#pragma unroll
    for (int nq = 0; nq < NQT; ++nq) { mrun[nq] = -1e30f; lsum[nq] = 0.f;
#pragma unroll
        for (int dt = 0; dt < 4; ++dt) oacc[dt][nq] = (f32x4){0.f, 0.f, 0.f, 0.f}; }
    const int lrow0 = tid >> 3, lch = tid & 7;
    auto key0_of = [&](int ti) -> int { if (NA) return ti < 8 ? 256 + (na_rs + ti) * 64 : (ti - 8) * 64; return ti * 64; };
    u32x4 kreg[2], vreg[2];
    auto gload = [&](int ti) {
        const int k0 = key0_of(ti);
#pragma unroll
        for (int i = 0; i < 2; ++i) {
            const int row = lrow0 + 32 * i;
            kreg[i] = *(const u32x4*)(Kh + (size_t)(k0 + row) * 64 + lch * 8);
            vreg[i] = *(const u32x4*)(Vh + (size_t)(k0 + row) * 64 + lch * 8);
        }
    };
    auto lstore = [&](int buf) {
#pragma unroll
        for (int i = 0; i < 2; ++i) {
            const int row = lrow0 + 32 * i;
            const int off = buf * 8192 + row * 128 + ((lch ^ (row & 7)) * 16);
            *(u32x4*)(KBUF + off) = kreg[i];
            *(u32x4*)(VBUF + off) = vreg[i];
        }
    };
    gload(0); lstore(0);
    __syncthreads();
    for (int ti = 0; ti < ntiles; ++ti) {
        const int buf = ti & 1;
        if (ti + 1 < ntiles) gload(ti + 1);
        const char* kb = KBUF + buf * 8192; const char* vb = VBUF + buf * 8192;
        f32x4 sacc[4][NQT];
#pragma unroll
        for (int mt = 0; mt < 4; ++mt) {
            const int row = mt * 16 + fr;
            bf16x8 kf0 = *(const bf16x8*)(kb + row * 128 + (((0 + fq) ^ (row & 7)) * 16));
            bf16x8 kf1 = *(const bf16x8*)(kb + row * 128 + (((4 + fq) ^ (row & 7)) * 16));
#pragma unroll
            for (int nq = 0; nq < NQT; ++nq) {
                f32x4 s = (f32x4){0.f, 0.f, 0.f, 0.f};
                s = mfma16(kf0, qf[nq][0], s);
                s = mfma16(kf1, qf[nq][1], s);
                sacc[mt][nq] = s;
            }
        }
        bf16x8 pf[2][NQT];
#pragma unroll
        for (int nq = 0; nq < NQT; ++nq) {
            float tv[4][4];
            if (NA && ti < 8) {
                const int qc = wid * 16 * NQT + nq * 16 + fr;
                int cs = qc - 8; cs = cs < 0 ? 0 : (cs > 48 ? 48 : cs);
                const int dr = na_rs + ti - na_r + 7;
#pragma unroll
                for (int mt = 0; mt < 4; ++mt)
#pragma unroll
                    for (int j = 0; j < 4; ++j) {
                        const int kc = mt * 16 + 4 * fq + j;
                        const bool ok = (kc >= cs) && (kc < cs + 16);
                        int dc = kc - qc + 15; dc = dc < 0 ? 0 : (dc > 30 ? 30 : dc);
                        tv[mt][j] = ok ? sacc[mt][nq][j] * c1 + BIAS[dr * 32 + dc] : -1e30f;
                    }
            } else {
#pragma unroll
                for (int mt = 0; mt < 4; ++mt)
#pragma unroll
                    for (int j = 0; j < 4; ++j) tv[mt][j] = sacc[mt][nq][j] * c1;
            }
            float tmax = -1e30f;
#pragma unroll
            for (int mt = 0; mt < 4; ++mt)
#pragma unroll
                for (int j = 0; j < 4; ++j) tmax = fmaxf(tmax, tv[mt][j]);
            tmax = fmaxf(tmax, __shfl_xor(tmax, 16)); tmax = fmaxf(tmax, __shfl_xor(tmax, 32));
            const float mnew = fmaxf(mrun[nq], tmax);
            const float alpha = exp2f(mrun[nq] - mnew);
            mrun[nq] = mnew;
            float ps = 0.f;
#pragma unroll
            for (int mt = 0; mt < 4; ++mt)
#pragma unroll
                for (int j = 0; j < 4; ++j) { const float e = exp2f(tv[mt][j] - mnew); tv[mt][j] = e; ps += e; }
            lsum[nq] = lsum[nq] * alpha + ps;
#pragma unroll
            for (int dt = 0; dt < 4; ++dt) oacc[dt][nq] = oacc[dt][nq] * alpha;
#pragma unroll
            for (int ks = 0; ks < 2; ++ks) {
                union { bf16x8 v; unsigned u[4]; } pk;
                pk.u[0] = pk2(tv[2 * ks][0], tv[2 * ks][1]); pk.u[1] = pk2(tv[2 * ks][2], tv[2 * ks][3]);
                pk.u[2] = pk2(tv[2 * ks + 1][0], tv[2 * ks + 1][1]); pk.u[3] = pk2(tv[2 * ks + 1][2], tv[2 * ks + 1][3]);
                pf[ks][nq] = pk.v;
            }
        }
        {
            const int q4 = fr >> 2, p4 = fr & 3;
#pragma unroll
            for (int ks = 0; ks < 2; ++ks)
#pragma unroll
                for (int dt = 0; dt < 4; ++dt) {
                    const int keyA = 16 * (2 * ks) + 4 * fq + q4, keyB = keyA + 16;
                    const int ch = dt * 2 + (p4 >> 1);
                    const int offA = keyA * 128 + ((ch ^ (keyA & 7)) * 16) + (p4 & 1) * 8;
                    const int offB = keyB * 128 + ((ch ^ (keyB & 7)) * 16) + (p4 & 1) * 8;
                    const s16x4 ta = __builtin_amdgcn_ds_read_tr16_b64_v4i16((LDSP(s16x4))(vb + offA));
                    const s16x4 tb = __builtin_amdgcn_ds_read_tr16_b64_v4i16((LDSP(s16x4))(vb + offB));
                    bf16x8 vf; vf[0] = ta[0]; vf[1] = ta[1]; vf[2] = ta[2]; vf[3] = ta[3]; vf[4] = tb[0]; vf[5] = tb[1]; vf[6] = tb[2]; vf[7] = tb[3];
#pragma unroll
                    for (int nq = 0; nq < NQT; ++nq) oacc[dt][nq] = mfma16(vf, pf[ks][nq], oacc[dt][nq]);
                }
        }
        if (ti + 1 < ntiles) lstore(buf ^ 1);
        __syncthreads();
    }
#pragma unroll
    for (int nq = 0; nq < NQT; ++nq) {
        float ls = lsum[nq]; ls += __shfl_xor(ls, 16); ls += __shfl_xor(ls, 32);
        const float inv = 1.0f / ls;
        bf16_t* o = outp + (size_t)(qw + nq * 16 + fr) * 1024;
#pragma unroll
        for (int dt = 0; dt < 4; ++dt) {
            const f32x4 v = oacc[dt][nq] * inv;
            *(u32x2*)(o + dt * 16 + 4 * fq) = (u32x2){pk2(v[0], v[1]), pk2(v[2], v[3])};
        }
    }
    __syncthreads();
}

DEV float hy_sconv(const bf16_t* zrow, int t, int n, float w0, float w1, float w2, float bias) {
    const float zm = t > 0 ? bf2f(zrow[t - 1]) : 0.f, z0 = bf2f(zrow[t]), zp = t + 1 < n ? bf2f(zrow[t + 1]) : 0.f;
    return w0 * zm + w1 * z0 + w2 * zp + bias;
}
template <int NJ>
DEV void hyena_item(const Params& p, int l, int type, int c, int bh, char* lds) {
    constexpr int n = 256 * NJ;
    const int tid = get_tid();
    f32x4* U = (f32x4*)lds;
    float* KR = (float*)(lds + n * 16);
    const bf16_t* zt = type ? (const bf16_t*)(p.ws + OFF_ZTC) : (const bf16_t*)(p.ws + OFF_ZTL);
    const float* kern = (const float*)(p.ws + (type ? OFF_KERNC + (size_t)l * 512 * 256 * 4 : OFF_KERNL + (size_t)l * 4096 * 256 * 4));
    const float* cw = p.hy_conv_w + l * 3 * 768; const float* cb = p.hy_conv_b + l * 768;
    const float w10 = cw[256 + c], w11 = cw[768 + 256 + c], w12 = cw[1536 + 256 + c], b1 = cb[256 + c];
    const float wv0 = cw[512 + c], wv1 = cw[768 + 512 + c], wv2 = cw[1536 + 512 + c], bv = cb[512 + c];
    const float w00 = cw[c], w01 = cw[768 + c], w02 = cw[1536 + c], b0 = cb[c];
    for (int i = tid; i < 2 * n - 1; i += 256) KR[i] = kern[(size_t)i * 256 + c];
    for (int s = tid; s < n; s += 256) {
        f32x4 u;
#pragma unroll
        for (int bb = 0; bb < 4; ++bb) {
            const bf16_t* zb = zt + (size_t)(bh * 4 + bb) * 768 * n;
            const float x1 = hy_sconv(zb + (size_t)(256 + c) * n, s, n, w10, w11, w12, b1);
            const float vv = hy_sconv(zb + (size_t)(512 + c) * n, s, n, wv0, wv1, wv2, bv);
            u[bb] = vv * x1;
        }
        U[s] = u;
    }
    __syncthreads();
    f32x4 acc[NJ];
#pragma unroll
    for (int j = 0; j < NJ; ++j) acc[j] = (f32x4){0.f, 0.f, 0.f, 0.f};
    const float* kp = KR + tid + (n - 1);
    for (int s = 0; s < n; ++s) {
        const f32x4 u = U[s];
#pragma unroll
        for (int j = 0; j < NJ; ++j) acc[j] += u * kp[256 * j - s];
    }
    const float skip = p.hy_skip[l * 256 + c];
    bf16_t* ox = (bf16_t*)(p.ws + OFF_OX);
#pragma unroll
    for (int j = 0; j < NJ; ++j) {
        const int t = tid + 256 * j;
        const f32x4 u = U[t];
#pragma unroll
        for (int bb = 0; bb < 4; ++bb) {
            const int b = bh * 4 + bb;
            const bf16_t* zb = zt + (size_t)b * 768 * n;
            const float x0 = hy_sconv(zb + (size_t)c * n, t, n, w00, w01, w02, b0);
            const float y = (acc[j][bb] + u[bb] * skip) * x0;
            const int row = type ? NLAT + b * 256 + t : b * 2048 + t;
            ox[(size_t)row * 1024 + 768 + c] = (bf16_t)f2bf(y);
        }
    }
    __syncthreads();
}

DEV void phase_mix(const Params& p, int l, char* lds) {
    unsigned char* ws = p.ws;
    const bf16_t* QA = (const bf16_t*)(ws + OFF_QA); const bf16_t* QB = (const bf16_t*)(ws + OFF_QB);
    const bf16_t* KA = (const bf16_t*)(ws + OFF_KA); const bf16_t* VA = (const bf16_t*)(ws + OFF_VA);
    const bf16_t* KBp = (const bf16_t*)(ws + OFF_KB); const bf16_t* VBp = (const bf16_t*)(ws + OFF_VB);
    bf16_t* OX = (bf16_t*)(ws + OFF_OX);
    const int N0 = 512, N1 = N0 + 1024, N2 = N1 + 1024;
    const int N3 = N2 + (l == 0 ? 512 : 0), N4 = N3 + (l == 0 ? 128 : 0), N5 = N4 + (l == 0 ? 64 : 0);
    for (int it = blockIdx.x; it < N5; it += gridDim.x) {
        if (it < N0) { hyena_item<8>(p, l, 0, it >> 1, it & 1, lds); }
        else if (it < N1) {
            const int j = it - N0, b = j >> 7, h = (j >> 4) & 7, qb = j & 15;
            attn_block<2, false>(QA + (size_t)h * NT * 64, b * 2048 + qb * 128, KA + (size_t)(b * 2 + (h >> 2)) * KEYS * 64, VA + (size_t)(b * 2 + (h >> 2)) * KEYS * 64,
                                 36, OX + h * 64, 0, 0, nullptr, lds);
        } else if (it < N2) {
            const int j = it - N1, b = j >> 7, h = (j >> 5) & 3, r = j & 31;
            int rs = r - 4; rs = rs < 0 ? 0 : (rs > 24 ? 24 : rs);
            attn_block<1, true>(QB + (size_t)h * NT * 64, b * 2048 + r * 64, KBp + (size_t)(b * 4 + h) * KEYS * 64, VBp + (size_t)(b * 4 + h) * KEYS * 64,
                                12, OX + 512 + h * 64, r, rs, p.nat_rpb + (size_t)(l * 4 + h) * 15 * 31, lds);
        } else if (it < N3) { const int j = it - N2; hyena_item<1>(p, l, 1, j >> 1, j & 1, lds); }
        else if (it < N4) {
            const int j = it - N3, b = j >> 4, h = (j >> 1) & 7, qb = j & 1;
            attn_block<2, false>(QA + (size_t)h * NT * 64, NLAT + b * 256 + qb * 128, KA + (size_t)(b * 2 + (h >> 2)) * KEYS * 64, VA + (size_t)(b * 2 + (h >> 2)) * KEYS * 64,
                                 4, OX + h * 64, 0, 0, nullptr, lds);
        } else {
            const int j = it - N4, b = j >> 3, h = (j >> 1) & 3, qb = j & 1;
            attn_block<2, false>(QB + (size_t)h * NT * 64, NLAT + b * 256 + qb * 128, KBp + (size_t)(b * 4 + h) * KEYS * 64, VBp + (size_t)(b * 4 + h) * KEYS * 64,
                                 4, OX + 512 + h * 64, 0, 0, nullptr, lds);
        }
    }
}

DEV void phase_outproj(const Params& p, int l, char* lds) {
    const int tid = get_tid(), lane = tid & 63, wid = tid >> 6, fr = lane & 15, fq = lane >> 4, wr = wid >> 1, wc = wid & 1;
    const bf16_t* OX = (const bf16_t*)(p.ws + OFF_OX);
    const bf16_t* W = (const bf16_t*)(p.ws + OFF_WOUT) + (size_t)l * 1024 * 1024;
    const float* mod = (const float*)(p.ws + OFF_MOD) + (size_t)l * 9 * 6144;
    float* X = (float*)(p.ws + OFF_X);
    const int nitems = (l == 0 ? 144 : 128) * 8;
    for (int it = blockIdx.x; it < nitems; it += gridDim.x) {
        const int mt = it >> 3, nt = it & 7, m0 = mt * 128, n0 = nt * 128;
        const bf16_t* a0 = OX + (size_t)(m0 + (tid >> 2)) * 1024 + (tid & 3) * 8;
        const bf16_t* b0 = W + (size_t)(n0 + (tid >> 2)) * 1024 + (tid & 3) * 8;
        f32x4 acc[4][4]; zero_acc<4>(acc);
        gemm_core<4, true>(acc, a0, a0 + 64 * 1024, b0, b0 + 64 * 1024, 1024, lds);
        const float* g1 = mod + (size_t)mod_group(m0) * 6144 + 2048;
#pragma unroll
        for (int m = 0; m < 4; ++m) {
            const int row = m0 + wr * 64 + m * 16 + fr;
            const float* xin = (l == 0) ? (row < NLAT ? p.x + (size_t)row * 1024 : p.ctx + (size_t)(row - NLAT) * 1024) : X + (size_t)row * 1024;
#pragma unroll
            for (int nn = 0; nn < 4; ++nn) {
                const int col = n0 + wc * 64 + nn * 16 + 4 * fq;
                const f32x4 xv = *(const f32x4*)(xin + col), g = *(const f32x4*)(g1 + col);
                *(f32x4*)(X + (size_t)row * 1024 + col) = xv * DN_ALPHA + g * acc[m][nn];
            }
        }
    }
}

DEV void phase_ln1route(const Params& p, int l, char* lds) {
    const int tid = get_tid(), lane = tid & 63, wid = tid >> 6, fr = lane & 15, fq = lane >> 4;
    float* X = (float*)(p.ws + OFF_X);
    bf16_t* H = (bf16_t*)(p.ws + OFF_H);
    const bf16_t* RW = (const bf16_t*)(p.ws + OFF_RW) + (size_t)l * 64 * 1024;
    const float* mod = (const float*)(p.ws + OFF_MOD) + (size_t)l * 9 * 6144;
    int* cnt = (int*)(p.ws + OFF_CNT) + l * 64;
    int* tke = (int*)(p.ws + OFF_TKE); int* tks = (int*)(p.ws + OFF_TKS); float* tkw = (float*)(p.ws + OFF_TKW);
    int* list = (int*)(p.ws + OFF_LIST);
    float* SC = (float*)(lds + 8192);
    float* SEL = (float*)(lds + 8192 + 16384);
    const int nitems = (l == 0 ? NT : NLAT) / 64;
    for (int it = blockIdx.x; it < nitems; it += gridDim.x) {
        const int m0 = it * 64;
        const float* mg = mod + (size_t)mod_group(m0) * 6144;
        for (int i = 0; i < 16; ++i) {
            const int row = m0 + wid * 16 + i;
            f32x4 v[4]; row_load(X + (size_t)row * 1024, v, lane); row_norm(v);
#pragma unroll
            for (int j = 0; j < 4; ++j) {
                const int c = 4 * lane + 256 * j;
                v[j] = v[j] * *(const f32x4*)(p.ln1_g + l * 1024 + c) + *(const f32x4*)(p.ln1_b + l * 1024 + c);
                *(f32x4*)(X + (size_t)row * 1024 + c) = v[j];
            }
            row_norm(v);
            row_store_mod_bf16(H + (size_t)row * 1024, v, mg + 3072, mg + 4096, lane);
        }
        __syncthreads();
        f32x4 acc[4];
#pragma unroll
        for (int n = 0; n < 4; ++n) acc[n] = (f32x4){0.f, 0.f, 0.f, 0.f};
        {
            const bf16_t* a0 = H + (size_t)(m0 + (tid >> 2)) * 1024 + (tid & 3) * 8;
            const bf16_t* b0 = RW + (size_t)(tid >> 2) * 1024 + (tid & 3) * 8;
            char* SA = lds; char* SB = lds + 4096;
            for (int kt = 0; kt < 1024; kt += 32) {
                glds16(a0 + kt, SA + tid * 16);
                glds16(b0 + kt, SB + tid * 16);
                asm volatile("s_waitcnt vmcnt(0)" ::: "memory");
                __syncthreads();
                const bf16x8 af = *(const bf16x8*)(SA + ((wid * 16 + fr) * 64 + fq * 16));
#pragma unroll
                for (int n = 0; n < 4; ++n) { const bf16x8 bq = *(const bf16x8*)(SB + ((n * 16 + fr) * 64 + fq * 16)); acc[n] = mfma16(bq, af, acc[n]); }
                __syncthreads();
            }
        }
#pragma unroll
        for (int n = 0; n < 4; ++n)
#pragma unroll
            for (int j = 0; j < 4; ++j) {
                const int e = n * 16 + 4 * fq + j;
                const float s = 1.0f / (1.0f + expf(-acc[n][j]));
                SC[(wid * 16 + fr) * 64 + e] = s;
                SEL[(wid * 16 + fr) * 64 + e] = s + p.router_b[l * 64 + e];
            }
        __syncthreads();
        if (tid < 64) {
            const int row = m0 + tid;
            const float* sel = SEL + tid * 64; const float* sc = SC + tid * 64;
            float gs[8];
#pragma unroll
            for (int g = 0; g < 8; ++g) {
                float m1 = -1e30f, m2 = -1e30f;
#pragma unroll
                for (int j = 0; j < 8; ++j) { const float v = sel[g * 8 + j]; if (v > m1) { m2 = m1; m1 = v; } else if (v > m2) m2 = v; }
                gs[g] = m1 + m2;
            }
            unsigned gmask = 0;
#pragma unroll
            for (int r = 0; r < 4; ++r) {
                int best = 0; float bv = -1e30f;
#pragma unroll
                for (int g = 0; g < 8; ++g) { const bool free = !((gmask >> g) & 1u); if (free && gs[g] > bv) { bv = gs[g]; best = g; } }
                gmask |= 1u << best;
            }
            unsigned long long chosen = 0ull;
            int es[8]; float wsel[8]; float wsum = 0.f;
#pragma unroll
            for (int k = 0; k < 8; ++k) {
                int best = 0; float bv = -1e30f;
                for (int e = 0; e < 64; ++e) {
                    const bool ok = ((gmask >> (e >> 3)) & 1u) && !((chosen >> e) & 1ull);
                    const float v = sel[e];
                    if (ok && v > bv) { bv = v; best = e; }
                }
                chosen |= 1ull << best;
                es[k] = best; wsel[k] = sc[best]; wsum += wsel[k];
            }
            const float wn = 2.5f / wsum;
#pragma unroll
            for (int k = 0; k < 8; ++k) {
                const int e = es[k];
                const int slot = atomicAdd(&cnt[e], 1);
                list[(size_t)e * NT + slot] = row * 8 + k;
                tke[row * 8 + k] = e; tks[row * 8 + k] = slot; tkw[row * 8 + k] = wsel[k] * wn;
            }
        }
        __syncthreads();
    }
}

struct RoundInfo { int nrounds; int e_lo, e_hi; };
DEV RoundInfo moe_round_info(const int* cnt, int cap, int r) {
    RoundInfo ri; ri.e_lo = 0; ri.e_hi = 0;
    int round = 0, start = 0, used = 0;
    for (int e = 0; e < 64; ++e) {
        const int c = cnt[e];
        if (used + c > cap) { if (round == r) { ri.e_lo = start; ri.e_hi = e; } ++round; start = e; used = 0; }
        used += c;
    }
    if (round == r) { ri.e_lo = start; ri.e_hi = 64; }
    ri.nrounds = round + 1;
    return ri;
}

DEV void moe_routed_tile(const Params& p, int e, int s0, int cnt_e, int ysbase, char* lds) {
    const int tid = get_tid(), lane = tid & 63, wid = tid >> 6, fr = lane & 15, fq = lane >> 4, wr = wid >> 1, wc = wid & 1;
    const bf16_t* H = (const bf16_t*)(p.ws + OFF_H);
    const bf16_t* W13 = (const bf16_t*)(p.ws + OFF_W13) + (size_t)e * 256 * 1024;
    const bf16_t* W2 = (const bf16_t*)(p.ws + OFF_W2) + (size_t)e * 1024 * 128;
    const int* list = (const int*)(p.ws + OFF_LIST) + (size_t)e * NT;
    const float* tkw = (const float*)(p.ws + OFF_TKW);
    bf16_t* YS = (bf16_t*)(p.ws + OFF_YS);
    char* ACT = lds + 16384;
    const int nvalid = min(128, cnt_e - s0);
    const int r0 = min(tid >> 2, nvalid - 1), r1 = min((tid >> 2) + 64, nvalid - 1);
    const bf16_t* a0 = H + (size_t)(list[s0 + r0] >> 3) * 1024 + (tid & 3) * 8;
    const bf16_t* a1 = H + (size_t)(list[s0 + r1] >> 3) * 1024 + (tid & 3) * 8;
    float gw[4];
#pragma unroll
    for (int m = 0; m < 4; ++m) { const int rl = min(wr * 64 + m * 16 + fr, nvalid - 1); gw[m] = tkw[list[s0 + rl]]; }
#pragma unroll 1
    for (int np = 0; np < 2; ++np) {
        const bf16_t* b0 = W13 + (size_t)(np * 128 + (tid >> 2)) * 1024 + (tid & 3) * 8;
        f32x4 acc[4][4]; zero_acc<4>(acc);
        gemm_core<4, true>(acc, a0, a1, b0, b0 + 64 * 1024, 1024, lds);
#pragma unroll
        for (int m = 0; m < 4; ++m) {
            const int rl = wr * 64 + m * 16 + fr;
#pragma unroll
            for (int pi = 0; pi < 2; ++pi) {
                const int hid = np * 64 + wc * 32 + pi * 16 + 4 * fq;
                float o[4];
#pragma unroll
                for (int j = 0; j < 4; ++j) { const float a = acc[m][2 * pi][j], b = acc[m][2 * pi + 1][j]; o[j] = a / (1.0f + expf(-a)) * b * gw[m]; }
                *(u32x2*)(ACT + rl * 272 + hid * 2) = (u32x2){pk2(o[0], o[1]), pk2(o[2], o[3])};
            }
        }
    }
    __syncthreads();
    char* SB = lds + 8192;
#pragma unroll 1
    for (int nt = 0; nt < 8; ++nt) {
        const bf16_t* b0 = W2 + (size_t)(nt * 128 + (tid >> 2)) * 128 + (tid & 3) * 8;
        f32x4 acc[4][4]; zero_acc<4>(acc);
#pragma unroll 1
        for (int ks = 0; ks < 4; ++ks) {
            glds16(b0 + ks * 32, SB + tid * 16);
            glds16(b0 + 64 * 128 + ks * 32, SB + 4096 + tid * 16);
            asm volatile("s_waitcnt vmcnt(0)" ::: "memory");
            __syncthreads();
            bf16x8 af[4], bfr[4];
#pragma unroll
            for (int m = 0; m < 4; ++m) af[m] = *(const bf16x8*)(ACT + (wr * 64 + m * 16 + fr) * 272 + (ks * 32 + fq * 8) * 2);
#pragma unroll
            for (int n = 0; n < 4; ++n) bfr[n] = *(const bf16x8*)(SB + ((wc * 64 + n * 16 + fr) * 64 + fq * 16));
#pragma unroll
            for (int m = 0; m < 4; ++m)
#pragma unroll
                for (int n = 0; n < 4; ++n) acc[m][n] = mfma16(bfr[n], af[m], acc[m][n]);
            __syncthreads();
        }
#pragma unroll
        for (int m = 0; m < 4; ++m) {
            const int rl = wr * 64 + m * 16 + fr;
            if (rl < nvalid) {
                bf16_t* o = YS + (size_t)(ysbase + s0 + rl) * 1024 + nt * 128 + wc * 64 + 4 * fq;
#pragma unroll
                for (int n = 0; n < 4; ++n) *(u32x2*)(o + n * 16) = (u32x2){pk2(acc[m][n][0], acc[m][n][1]), pk2(acc[m][n][2], acc[m][n][3])};
            }
        }
    }
    __syncthreads();
}
DEV void moe_shared_tile(const Params& p, int l, int m0, char* lds) {
    const int tid = get_tid(), lane = tid & 63, wid = tid >> 6, fr = lane & 15, fq = lane >> 4, wr = wid >> 1, wc = wid & 1;
    const bf16_t* H = (const bf16_t*)(p.ws + OFF_H);
    const bf16_t* W13 = (const bf16_t*)(p.ws + OFF_SW13) + (size_t)l * 512 * 1024;
    const bf16_t* W2 = (const bf16_t*)(p.ws + OFF_SW2) + (size_t)l * 1024 * 256;
    const float* g2 = (const float*)(p.ws + OFF_MOD) + (size_t)l * 9 * 6144 + (size_t)mod_group(m0) * 6144 + 5120;
    float* X = (float*)(p.ws + OFF_X);
    char* ACT = lds + 16384;
    const bf16_t* a0 = H + (size_t)(m0 + (tid >> 2)) * 1024 + (tid & 3) * 8;
#pragma unroll 1
    for (int np = 0; np < 4; ++np) {
        const bf16_t* b0 = W13 + (size_t)(np * 128 + (tid >> 2)) * 1024 + (tid & 3) * 8;
        f32x4 acc[2][4]; zero_acc<2>(acc);
        gemm_core<2, true>(acc, a0, a0, b0, b0 + 64 * 1024, 1024, lds);
#pragma unroll
        for (int m = 0; m < 2; ++m) {
            const int rl = wr * 32 + m * 16 + fr;
#pragma unroll
            for (int pi = 0; pi < 2; ++pi) {
                const int hid = np * 64 + wc * 32 + pi * 16 + 4 * fq;
                float o[4];
#pragma unroll
                for (int j = 0; j < 4; ++j) { const float a = acc[m][2 * pi][j], b = acc[m][2 * pi + 1][j]; o[j] = a / (1.0f + expf(-a)) * b; }
                *(u32x2*)(ACT + rl * 528 + hid * 2) = (u32x2){pk2(o[0], o[1]), pk2(o[2], o[3])};
            }
        }
    }
    __syncthreads();
    char* SB = lds + 8192;
#pragma unroll 1
    for (int nt = 0; nt < 8; ++nt) {
        const bf16_t* b0 = W2 + (size_t)(nt * 128 + (tid >> 2)) * 256 + (tid & 3) * 8;
        f32x4 acc[2][4]; zero_acc<2>(acc);
#pragma unroll 1
        for (int ks = 0; ks < 8; ++ks) {
            glds16(b0 + ks * 32, SB + tid * 16);
            glds16(b0 + 64 * 256 + ks * 32, SB + 4096 + tid * 16);
            asm volatile("s_waitcnt vmcnt(0)" ::: "memory");
            __syncthreads();
            bf16x8 af[2], bfr[4];
#pragma unroll
            for (int m = 0; m < 2; ++m) af[m] = *(const bf16x8*)(ACT + (wr * 32 + m * 16 + fr) * 528 + (ks * 32 + fq * 8) * 2);
#pragma unroll
            for (int n = 0; n < 4; ++n) bfr[n] = *(const bf16x8*)(SB + ((wc * 64 + n * 16 + fr) * 64 + fq * 16));
#pragma unroll
            for (int m = 0; m < 2; ++m)
#pragma unroll
                for (int n = 0; n < 4; ++n) acc[m][n] = mfma16(bfr[n], af[m], acc[m][n]);
            __syncthreads();
        }
#pragma unroll
        for (int m = 0; m < 2; ++m) {
            const int row = m0 + wr * 32 + m * 16 + fr;
#pragma unroll
            for (int n = 0; n < 4; ++n) {
                const int col = nt * 128 + wc * 64 + n * 16 + 4 * fq;
                float* xp = X + (size_t)row * 1024 + col;
                const f32x4 xv = *(const f32x4*)xp, g = *(const f32x4*)(g2 + col);
                *(f32x4*)xp = xv * DN_ALPHA + g * acc[m][n];
            }
        }
    }
    __syncthreads();
}
DEV void phase_moe(const Params& p, int l, int r, char* lds) {
    const int* cnt = (const int*)(p.ws + OFF_CNT) + l * 64;
    const RoundInfo ri = moe_round_info(cnt, p.cap, r);
    if (r >= ri.nrounds) return;
    int* SH = (int*)(lds + 60 * 1024);
    if (threadIdx.x == 0) {
        int tp = 0, yb = 0;
        for (int e = ri.e_lo; e < ri.e_hi; ++e) { SH[e] = tp; SH[64 + e] = yb; tp += (cnt[e] + 127) >> 7; yb += cnt[e]; }
        SH[128] = tp;
    }
    __syncthreads();
    const int nrt = SH[128];
    const int nsh = (r == 0) ? (l == 0 ? NT : NLAT) / 64 : 0;
    for (int it = blockIdx.x; it < nrt + nsh; it += gridDim.x) {
        if (it < nrt) {
            int e = ri.e_lo;
            while (e + 1 < ri.e_hi && SH[e + 1] <= it) ++e;
            moe_routed_tile(p, e, (it - SH[e]) * 128, cnt[e], SH[64 + e], lds);
        } else moe_shared_tile(p, l, (it - nrt) * 64, lds);
    }
}

DEV void phase_comb(const Params& p, int l, int r, char* lds) {
    const int tid_ = get_tid(), lane = tid_ & 63, wid = tid_ >> 6;
    const int* cnt = (const int*)(p.ws + OFF_CNT) + l * 64;
    const RoundInfo ri = moe_round_info(cnt, p.cap, r);
    if (r >= ri.nrounds) return;
    const bool final = (r == ri.nrounds - 1);
    int* SH = (int*)(lds + 60 * 1024);
    if (threadIdx.x == 0) { int yb = 0; for (int e = ri.e_lo; e < ri.e_hi; ++e) { SH[e] = yb; yb += cnt[e]; } }
    __syncthreads();
    float* X = (float*)(p.ws + OFF_X);
    bf16_t* H = (bf16_t*)(p.ws + OFF_H);
    const bf16_t* YS = (const bf16_t*)(p.ws + OFF_YS);
    const int* tke = (const int*)(p.ws + OFF_TKE); const int* tks = (const int*)(p.ws + OFF_TKS);
    const float* mod = (const float*)(p.ws + OFF_MOD);
    const int nrows = (l == 0) ? NT : NLAT;
    for (int row = blockIdx.x * 4 + wid; row < nrows; row += gridDim.x * 4) {
        const int g = mod_group(row);
        const float* g2 = mod + ((size_t)l * 9 + g) * 6144 + 5120;
        f32x4 v[4]; row_load(X + (size_t)row * 1024, v, lane);
        f32x4 s[4];
#pragma unroll
        for (int j = 0; j < 4; ++j) s[j] = (f32x4){0.f, 0.f, 0.f, 0.f};
        for (int k = 0; k < 8; ++k) {
            const int e = tke[row * 8 + k];
            if (e >= ri.e_lo && e < ri.e_hi) {
                const bf16_t* y = YS + (size_t)(SH[e] + tks[row * 8 + k]) * 1024;
#pragma unroll
                for (int j = 0; j < 4; ++j) {
                    const u32x2 w = *(const u32x2*)(y + 4 * lane + 256 * j);
                    s[j][0] += __uint_as_float(w[0] << 16); s[j][1] += __uint_as_float(w[0] & 0xffff0000u);
                    s[j][2] += __uint_as_float(w[1] << 16); s[j][3] += __uint_as_float(w[1] & 0xffff0000u);
                }
            }
        }
#pragma unroll
        for (int j = 0; j < 4; ++j) v[j] = v[j] + *(const f32x4*)(g2 + 4 * lane + 256 * j) * s[j];
        if (!final) {
#pragma unroll
            for (int j = 0; j < 4; ++j) *(f32x4*)(X + (size_t)row * 1024 + 4 * lane + 256 * j) = v[j];
        } else {
            row_norm(v);
            float* dst = (l == 0) ? X + (size_t)row * 1024 : p.out + (size_t)row * 1024;
#pragma unroll
            for (int j = 0; j < 4; ++j) {
                const int c = 4 * lane + 256 * j;
                v[j] = v[j] * *(const f32x4*)(p.ln2_g + l * 1024 + c) + *(const f32x4*)(p.ln2_b + l * 1024 + c);
                *(f32x4*)(dst + c) = v[j];
            }
            if (l == 0) {
                row_norm(v);
                const float* m1 = mod + ((size_t)9 + g) * 6144;
                row_store_mod_bf16(H + (size_t)row * 1024, v, m1, m1 + 1024, lane);
            }
        }
    }
    if (final && l == 0) {
        __syncthreads();
        for (int it = blockIdx.x; it < 6144; it += gridDim.x) conv_expert_item(p, 1, it, lds);
    }
}


#define XB_TMO      128
#define XB_XCNT(j)  (256  + 64 * (j))
#define XB_XSUB(j)  (1280 + 64 * (j))
#define XB_XGEN(j)  (2304 + 64 * (j))
#define XB_TOP      3328
#define XB_TOPGEN   3392
#define XCD_BAR_WORDS 3456
#define XB_SPIN_CAP (1u << 22)
#define LAS __attribute__((address_space(3)))
DEV unsigned xb_ld(unsigned* p) { return __hip_atomic_load(p, __ATOMIC_RELAXED, __HIP_MEMORY_SCOPE_AGENT); }
DEV unsigned xb_add(unsigned* p, unsigned v) { return __hip_atomic_fetch_add(p, v, __ATOMIC_RELAXED, __HIP_MEMORY_SCOPE_AGENT); }
DEV unsigned xb_xcc_id() { return (unsigned)__builtin_amdgcn_s_getreg((3 << 11) | 20) & 0xFu; }
#define XB_SPIN(cond, bar) do { unsigned _sp = 0; while (cond) { __builtin_amdgcn_s_sleep(1); \
    if ((++_sp & 255u) == 0u) { if (xb_ld(&(bar)[XB_TMO])) break; if (_sp > XB_SPIN_CAP) { atomicAdd(&(bar)[XB_TMO], 1u); break; } } } } while (0)
struct XcdBarrier { unsigned* bar; unsigned x; volatile LAS unsigned* st; };
DEV XcdBarrier xcd_barrier_post(unsigned* bar, volatile LAS unsigned* st) {
    XcdBarrier b; b.bar = bar; b.x = xb_xcc_id(); b.st = st;
    if (threadIdx.x == 0) (void)xb_add(&bar[XB_XCNT(b.x)], 1u);
    return b;
}
DEV void xcd_barrier_complete(unsigned* bar, unsigned x, unsigned& nloc, unsigned& nx) {
    const unsigned G = gridDim.x * gridDim.y * gridDim.z;
    unsigned sum, cnt, mine, sp = 0u;
    for (;;) {
        sum = 0u; cnt = 0u; mine = 0u;
#pragma unroll
        for (unsigned j = 0; j < 16; ++j) { const unsigned c = xb_ld(&bar[XB_XCNT(j)]); sum += c; cnt += (c > 0u) ? 1u : 0u; mine = (j == x) ? c : mine; }
        if (sum == G) break;
        __builtin_amdgcn_s_sleep(1);
        if ((++sp & 255u) == 0u) { if (xb_ld(&bar[XB_TMO])) break; if (sp > XB_SPIN_CAP) { atomicAdd(&bar[XB_TMO], 1u); break; } }
    }
    nloc = mine > 0u ? mine : 1u; nx = cnt > 0u ? cnt : 1u;
}
DEV void xcd_barrier(const XcdBarrier& b) {
    asm volatile("s_waitcnt vmcnt(0)" ::: "memory");
    __syncthreads();
    if (threadIdx.x == 0) {
        unsigned* bar = b.bar;
        __builtin_amdgcn_s_waitcnt(0);
        unsigned nloc = b.st[0], nx = b.st[1];
        if (nloc == 0u) { xcd_barrier_complete(bar, b.x, nloc, nx); b.st[0] = nloc; b.st[1] = nx; }
        const unsigned old = xb_add(&bar[XB_XSUB(b.x)], 1u);
        const unsigned gen = old / nloc;
        if (old + 1u == (gen + 1u) * nloc) {
            __builtin_amdgcn_fence(__ATOMIC_RELEASE, "agent");
            asm volatile("s_waitcnt vmcnt(0)" ::: "memory");
            const unsigned og = xb_add(&bar[XB_TOP], 1u);
            const unsigned tg = og / nx;
            if (og + 1u == (tg + 1u) * nx) xb_add(&bar[XB_TOPGEN], 1u);
            else XB_SPIN(xb_ld(&bar[XB_TOPGEN]) == tg, bar);
            __builtin_amdgcn_fence(__ATOMIC_ACQUIRE, "agent");
            xb_add(&bar[XB_XGEN(b.x)], 1u);
            asm volatile("s_waitcnt vmcnt(0)" ::: "memory");
        } else {
            XB_SPIN(xb_ld(&bar[XB_XGEN(b.x)]) == gen, bar);
            __builtin_amdgcn_fence(__ATOMIC_ACQUIRE, "agent");
            asm volatile("s_waitcnt vmcnt(0)" ::: "memory");
        }
    }
    __syncthreads();
}

enum { PT_PREP = 0, PT_MODFIN, PT_LNMOD0, PT_INPROJ, PT_MIX, PT_OUTPROJ, PT_LN1ROUTE, PT_MOE, PT_COMB };
constexpr int SMEM_BYTES = 62 * 1024;

DEV void run_phase(const Params& p, int type, int l, int r, char* lds) {
    switch (type) {
        case PT_PREP: phase_prep(p, lds); break;
        case PT_MODFIN: phase_modfin(p); break;
        case PT_LNMOD0: phase_lnmod0(p); break;
        case PT_INPROJ: phase_inproj(p, l, lds); break;
        case PT_MIX: phase_mix(p, l, lds); break;
        case PT_OUTPROJ: phase_outproj(p, l, lds); break;
        case PT_LN1ROUTE: phase_ln1route(p, l, lds); break;
        case PT_MOE: phase_moe(p, l, r, lds); break;
        default: phase_comb(p, l, r, lds); break;
    }
}

__global__ void __launch_bounds__(256, 2) fwd_kernel(Params p) {
    __shared__ __attribute__((aligned(16))) char smem[SMEM_BYTES];
#if MULTI_LAUNCH
    run_phase(p, p.ptype, p.pl, p.pr, smem);
#else
    if (threadIdx.x < 4) ((volatile LAS unsigned*)(smem + SMEM_BYTES - 16))[threadIdx.x] = 0u;
    __syncthreads();
    const XcdBarrier bar = xcd_barrier_post((unsigned*)(p.ws + OFF_BAR), (volatile LAS unsigned*)(smem + SMEM_BYTES - 16));
    int type = PT_PREP, l = 0, r = 0;
    for (;;) {
        run_phase(p, type, l, r, smem);
        if (type < PT_MOE) { ++type; r = 0; }
        else if (type == PT_MOE) type = PT_COMB;
        else {
            const int nr = moe_round_info((const int*)(p.ws + OFF_CNT) + l * 64, p.cap, 0).nrounds;
            if (r + 1 < nr) { ++r; type = PT_MOE; }
            else { if (l == 1) break; l = 1; r = 0; type = PT_INPROJ; }
        }
        xcd_barrier(bar);
    }
#endif
}

extern "C" void kernel_launch(void* const* d_in, const int* in_sizes, int n_in, void* d_out, int out_size, void* d_ws, size_t ws_size, hipStream_t stream) {
    Params p{};
    const float** pp = (const float**)&p;
    for (int i = 0; i < 32; ++i) pp[i] = (const float*)d_in[i];
    p.out = (float*)d_out; p.ws = (unsigned char*)d_ws;
    long long cap = ((long long)ws_size - (long long)OFF_R) / 2048;
    if (cap > NT * 8) cap = NT * 8;
    if (cap * 2048 < (long long)R_MIN_BYTES || cap < NT) { fprintf(stderr, "kernel_launch: workspace too small (%zu)\n", ws_size); return; }
    p.cap = (int)cap;
#if MULTI_LAUNCH
    const int grid = 512;
    auto launch = [&](int type, int l, int r) { Params q = p; q.mode = 1; q.ptype = type; q.pl = l; q.pr = r; hipLaunchKernelGGL(fwd_kernel, dim3(grid), dim3(256), 0, stream, q); };
    launch(PT_PREP, 0, 0); launch(PT_MODFIN, 0, 0); launch(PT_LNMOD0, 0, 0);
    for (int l = 0; l < 2; ++l) {
        launch(PT_INPROJ, l, 0); launch(PT_MIX, l, 0); launch(PT_OUTPROJ, l, 0); launch(PT_LN1ROUTE, l, 0);
        for (int r = 0; r < RMAX; ++r) { launch(PT_MOE, l, r); launch(PT_COMB, l, r); }
    }
#else
    static int grid_blocks = 0;
    if (!grid_blocks) {
        int dev = 0, cus = 0, per_cu = 0;
        hipGetDevice(&dev);
        hipDeviceGetAttribute(&cus, hipDeviceAttributeMultiprocessorCount, dev);
        hipOccupancyMaxActiveBlocksPerMultiprocessor(&per_cu, fwd_kernel, 256, 0);
        if (per_cu > 2) per_cu = 2;
        if (per_cu < 1) per_cu = 1;
        grid_blocks = cus * per_cu;
    }
    p.mode = 0;
    hipMemsetAsync(d_ws, 0, 65536, stream);
    hipLaunchKernelGGL(fwd_kernel, dim3(grid_blocks), dim3(256), 0, stream, p);
#endif
}
```

```cpp
#include <hip/hip_runtime.h>
#include <hip/hip_cooperative_groups.h>
#include <stdint.h>
#include <stdio.h>
namespace cg = cooperative_groups;

#ifndef TELEM
#define TELEM 0
#endif
#ifndef TELEM_A
#define TELEM_A 0x10
#endif
#ifndef TELEM_B
#define TELEM_B 7
#endif
#ifndef TELEM_C
#define TELEM_C 3
#endif
#ifndef MULTI_LAUNCH
#define MULTI_LAUNCH 0
#endif

typedef unsigned short bf16_t;
typedef short bf16x8 __attribute__((ext_vector_type(8)));
typedef short s16x4 __attribute__((ext_vector_type(4)));
typedef float f32x4 __attribute__((ext_vector_type(4)));
typedef unsigned u32x4 __attribute__((ext_vector_type(4)));
typedef unsigned u32x2 __attribute__((ext_vector_type(2)));
#define DEV __device__ __forceinline__
#define LDSP(T) __attribute__((address_space(3))) T*
#define LAS __attribute__((address_space(3)))

constexpr int D = 1024, NB = 8, SEQ = 2048, CTX = 256, NLAT = NB * SEQ, NCTX = NB * CTX, NT = NLAT + NCTX;
constexpr int PROJ = 2304, KEYS = CTX + SEQ, NEXP = 64;
constexpr float DN_ALPHA = 1.41421356237309515f;
constexpr float LOG2E = 1.44269504088896341f;
constexpr int SMEM_BYTES = 72 * 1024;
constexpr int RMAX = 4;

constexpr size_t OFF_CNT = 0;
constexpr size_t OFF_QUEUE = 33792;
constexpr size_t OFF_TEL = 36864;
constexpr size_t OFF_BAR = 40960;
constexpr size_t OFF_MOD = 65536;
constexpr size_t OFF_ROPE = OFF_MOD + 442368;
constexpr size_t OFF_KERNL = OFF_ROPE + 2ull * 2048 * 32 * 4;
constexpr size_t OFF_KERNC = OFF_KERNL + 2ull * 4096 * 256 * 4;
constexpr size_t OFF_TKE = OFF_KERNC + 2ull * 512 * 256 * 4;
constexpr size_t OFF_TKS = OFF_TKE + (size_t)NT * 8 * 4;
constexpr size_t OFF_TKW = OFF_TKS + (size_t)NT * 8 * 4;
constexpr size_t OFF_LIST = OFF_TKW + (size_t)NT * 8 * 4;
constexpr size_t OFF_WIN = OFF_LIST + 64ull * NT * 4;
constexpr size_t OFF_WOUT = OFF_WIN + 2ull * 2304 * 1024 * 2;
constexpr size_t OFF_SW13 = OFF_WOUT + 2ull * 1024 * 1024 * 2;
constexpr size_t OFF_SW2 = OFF_SW13 + 2ull * 512 * 1024 * 2;
constexpr size_t OFF_RW = OFF_SW2 + 2ull * 1024 * 256 * 2;
constexpr size_t OFF_W13 = OFF_RW + 2ull * 64 * 1024 * 2;
constexpr size_t OFF_W2 = OFF_W13 + 64ull * 256 * 1024 * 2;
constexpr size_t OFF_X = OFF_W2 + 64ull * 1024 * 128 * 2;
constexpr size_t OFF_H = OFF_X + (size_t)NT * 1024 * 2;
constexpr size_t OFF_R = OFF_H + (size_t)NT * 1024 * 2;
constexpr size_t OFF_QA = OFF_R;
constexpr size_t OFF_QB = OFF_QA + 8ull * NT * 64 * 2;
constexpr size_t OFF_KA = OFF_QB + 4ull * NT * 64 * 2;
constexpr size_t OFF_VA = OFF_KA + 8ull * 2 * KEYS * 64 * 2;
constexpr size_t OFF_KB = OFF_VA + 8ull * 2 * KEYS * 64 * 2;
constexpr size_t OFF_VB = OFF_KB + 8ull * 4 * KEYS * 64 * 2;
constexpr size_t OFF_ZTL = OFF_VB + 8ull * 4 * KEYS * 64 * 2;
constexpr size_t OFF_ZTC = OFF_ZTL + 8ull * 768 * 2048 * 2;
constexpr size_t OFF_OX = OFF_ZTC + 8ull * 768 * 256 * 2;
constexpr size_t R_MIN_BYTES = OFF_OX + (size_t)NT * 1024 * 2 - OFF_R;
constexpr size_t OFF_PART = OFF_R;
constexpr size_t OFF_YS = OFF_R;

struct Params {
    const float *x, *c, *ctx, *c_ctx, *ada_w, *ada_b, *w_in, *q_gain, *k_gain, *nat_rpb, *hy_conv_w, *hy_conv_b,
        *hy_f_w1, *hy_f_b1, *hy_f_w2, *hy_f_b2, *hy_f_w3, *hy_freq, *hy_skip, *w_out, *ln1_g, *ln1_b,
        *router_w, *router_b, *exp_w1, *exp_w3, *exp_w2, *sh_w1, *sh_w3, *sh_w2, *ln2_g, *ln2_b;
    float* out; unsigned char* ws;
    int cap, mode, ptype, pl, pr, pad;
};

typedef __bf16 hwbf2 __attribute__((ext_vector_type(2)));
typedef float f32x2 __attribute__((ext_vector_type(2)));
DEV unsigned f2bf(float f) { return (unsigned)__builtin_bit_cast(unsigned short, (__bf16)f); }
DEV unsigned pk2(float lo, float hi) { const f32x2 v = {lo, hi}; return __builtin_bit_cast(unsigned, __builtin_convertvector(v, hwbf2)); }
DEV float bf2f(unsigned short h) { return __uint_as_float(((unsigned)h) << 16); }
DEV float wave_sum(float v) {
#pragma unroll
    for (int o = 32; o > 0; o >>= 1) v += __shfl_xor(v, o);
    return v;
}
DEV void glds16(const void* g, void* l) { __builtin_amdgcn_global_load_lds((const unsigned*)g, (unsigned*)l, 16, 0, 0); }
DEV f32x4 mfma16(bf16x8 a, bf16x8 b, f32x4 c) { return __builtin_amdgcn_mfma_f32_16x16x32_bf16(a, b, c, 0, 0, 0); }
DEV float readlane_f(float v, int l) { return __uint_as_float((unsigned)__builtin_amdgcn_readlane((int)__float_as_uint(v), l)); }
DEV int get_tid() { int t = threadIdx.x; asm volatile("" : "+v"(t)); return t; }
DEV int lchunk(int tid) { return (tid & 3) ^ ((0 - (tid >> 4)) & 3); }
DEV int vblock() { const int G = (int)gridDim.x, b = (int)blockIdx.x; return (G & 7) ? b : (b & 7) * (G >> 3) + (b >> 3); }
DEV int mod_group(int row) { return row < NLAT ? (row >> 11) : 8; }

template <int MI, int NI> DEV void zero_acc(f32x4 (&acc)[MI][NI]) {
#pragma unroll
    for (int m = 0; m < MI; ++m)
#pragma unroll
        for (int n = 0; n < NI; ++n) acc[m][n] = (f32x4){0.f, 0.f, 0.f, 0.f};
}
#define WAIT_VM(n) asm volatile("s_waitcnt vmcnt(" #n ")" ::: "memory")
#define WAIT_LGKM0() asm volatile("s_waitcnt lgkmcnt(0)" ::: "memory")
#define RAW_BARRIER() do { asm volatile("" ::: "memory"); __builtin_amdgcn_s_barrier(); asm volatile("" ::: "memory"); } while (0)
template <int MI, int NI, bool TRANS>
DEV void gemm_core(f32x4 (&acc)[MI][NI], const bf16_t* A, const unsigned (&ao)[MI / 2], const bf16_t* B, const unsigned (&bo)[NI / 2], int K, char* lds) {
    const int tid = get_tid(), lane = tid & 63, wid = tid >> 6, fr = lane & 15, fq = lane >> 4, wr = wid >> 1, wc = wid & 1;
    constexpr int SAB = 2048 * MI, STG = 2048 * (MI + NI), LPT = MI / 2 + NI / 2;
    static_assert(LPT == 3 || LPT == 4 || LPT == 6, "loads per tile");
    const int nt = K >> 5;
    auto stage = [&](int s, int t) {
        char* SA = lds + s * STG; char* SB = SA + SAB;
#pragma unroll
        for (int i = 0; i < MI / 2; ++i) glds16(A + (ao[i] + (unsigned)(t * 32)), SA + i * 4096 + tid * 16);
#pragma unroll
        for (int i = 0; i < NI / 2; ++i) glds16(B + (bo[i] + (unsigned)(t * 32)), SB + i * 4096 + tid * 16);
    };
    WAIT_VM(0);
    stage(0, 0);
    if (nt > 1) stage(1, 1);
    const int sw = (fq ^ ((0 - (fr >> 2)) & 3)) * 16;
    const int aoff = (wr * MI * 16 + fr) * 64 + sw, boff = SAB + (wc * NI * 16 + fr) * 64 + sw;
#pragma unroll 1
    for (int t = 0; t < nt; ++t) {
        if (t + 1 < nt) { if (LPT == 6) WAIT_VM(6); else if (LPT == 4) WAIT_VM(4); else WAIT_VM(3); } else WAIT_VM(0);
        RAW_BARRIER();
        const char* S = lds + (t & 1) * STG;
        bf16x8 af[MI], bfr[NI];
#pragma unroll
        for (int m = 0; m < MI; ++m) af[m] = *(const bf16x8*)(S + aoff + m * 1024);
#pragma unroll
        for (int n = 0; n < NI; ++n) bfr[n] = *(const bf16x8*)(S + boff + n * 1024);
        WAIT_LGKM0();
        RAW_BARRIER();
        if (t + 2 < nt) stage(t & 1, t + 2);
#pragma unroll
        for (int m = 0; m < MI; ++m)
#pragma unroll
            for (int n = 0; n < NI; ++n) acc[m][n] = TRANS ? mfma16(bfr[n], af[m], acc[m][n]) : mfma16(af[m], bfr[n], acc[m][n]);
    }
}
DEV unsigned st64_off(int tid) { return (unsigned)(tid >> 3) * 1024u + (unsigned)(((tid & 7) ^ ((tid >> 3) & 7)) * 8); }
template <bool TRANS>
DEV void gemm_core64(f32x4 (&acc)[4][4], const bf16_t* A, const unsigned (&ao)[4], const bf16_t* B, const unsigned (&bo)[4], int K, char* lds) {
    const int tid = get_tid(), lane = tid & 63, wid = tid >> 6, fr = lane & 15, fq = lane >> 4, wr = wid >> 1, wc = wid & 1;
    const int nt = K >> 6;
    auto stage = [&](int s, int t) {
        char* SA = lds + s * 32768; char* SB = SA + 16384;
#pragma unroll
        for (int i = 0; i < 4; ++i) glds16(A + (ao[i] + (unsigned)(t * 64)), SA + i * 4096 + tid * 16);
#pragma unroll
        for (int i = 0; i < 4; ++i) glds16(B + (bo[i] + (unsigned)(t * 64)), SB + i * 4096 + tid * 16);
    };
    WAIT_VM(0);
    stage(0, 0);
    if (nt > 1) stage(1, 1);
    const int rsw = fr & 7;
    const int arow = (wr * 64 + fr) * 128, brow = 16384 + (wc * 64 + fr) * 128;
    const int c0 = ((fq) ^ rsw) * 16, c1 = ((4 + fq) ^ rsw) * 16;
#pragma unroll 1
    for (int t = 0; t < nt; ++t) {
        if (t + 1 < nt) WAIT_VM(8); else WAIT_VM(0);
        RAW_BARRIER();
        const char* S = lds + (t & 1) * 32768;
        bf16x8 af[4][2], bfr[4][2];
#pragma unroll
        for (int m = 0; m < 4; ++m) { af[m][0] = *(const bf16x8*)(S + arow + m * 2048 + c0); af[m][1] = *(const bf16x8*)(S + arow + m * 2048 + c1); }
#pragma unroll
        for (int n = 0; n < 4; ++n) { bfr[n][0] = *(const bf16x8*)(S + brow + n * 2048 + c0); bfr[n][1] = *(const bf16x8*)(S + brow + n * 2048 + c1); }
        WAIT_LGKM0();
        RAW_BARRIER();
        if (t + 2 < nt) stage(t & 1, t + 2);
#pragma unroll
        for (int ks = 0; ks < 2; ++ks)
#pragma unroll
            for (int m = 0; m < 4; ++m)
#pragma unroll
                for (int n = 0; n < 4; ++n) acc[m][n] = TRANS ? mfma16(bfr[n][ks], af[m][ks], acc[m][n]) : mfma16(af[m][ks], bfr[n][ks], acc[m][n]);
    }
}
template <int KACT, int ASTRIDE, class EPI>
DEV void gemm2_stream64(const bf16_t* W2, const char* ACT, char* sb, EPI&& epi) {
    const int tid = get_tid(), lane = tid & 63, wid = tid >> 6, fr = lane & 15, fq = lane >> 4, wr = wid >> 1, wc = wid & 1;
    constexpr int KS = KACT / 64, NJ = 8 * KS;
    const unsigned b0 = (unsigned)(tid >> 3) * KACT + (unsigned)(((tid & 7) ^ ((tid >> 3) & 7)) * 8);
    auto stage = [&](int s, int j) {
        const int nt = j / KS, ks = j % KS;
        char* SB = sb + s * 16384;
        const bf16_t* src = W2 + (size_t)nt * 128 * KACT + ks * 64 + b0;
#pragma unroll
        for (int i = 0; i < 4; ++i) glds16(src + (size_t)i * 32 * KACT, SB + i * 4096 + tid * 16);
    };
    WAIT_VM(0);
    stage(0, 0); stage(1, 1);
    const int rsw = fr & 7;
    const int brow = (wc * 64 + fr) * 128, c0 = (fq ^ rsw) * 16, c1 = ((4 + fq) ^ rsw) * 16;
    f32x4 acc[4][4]; zero_acc<4, 4>(acc);
#pragma unroll 1
    for (int j = 0; j < NJ; ++j) {
        const int ks = j % KS;
        if (j + 1 < NJ) WAIT_VM(4); else WAIT_VM(0);
        RAW_BARRIER();
        const char* S = sb + (j & 1) * 16384;
        bf16x8 af[4][2], bfr[4][2];
#pragma unroll
        for (int m = 0; m < 4; ++m) { const char* ar = ACT + (wr * 64 + m * 16 + fr) * ASTRIDE + (ks * 64 + fq * 8) * 2; af[m][0] = *(const bf16x8*)ar; af[m][1] = *(const bf16x8*)(ar + 64); }
#pragma unroll
        for (int n = 0; n < 4; ++n) { bfr[n][0] = *(const bf16x8*)(S + brow + n * 2048 + c0); bfr[n][1] = *(const bf16x8*)(S + brow + n * 2048 + c1); }
        WAIT_LGKM0();
        RAW_BARRIER();
        if (j + 2 < NJ) stage(j & 1, j + 2);
#pragma unroll
        for (int k2 = 0; k2 < 2; ++k2)
#pragma unroll
            for (int m = 0; m < 4; ++m)
#pragma unroll
                for (int n = 0; n < 4; ++n) acc[m][n] = mfma16(bfr[n][k2], af[m][k2], acc[m][n]);
        if (ks == KS - 1) { epi(j / KS, acc); zero_acc<4, 4>(acc); }
    }
}
template <int MI, int KACT, int ASTRIDE, class EPI>
DEV void gemm2_stream(const bf16_t* W2, const char* ACT, char* sb, EPI&& epi) {
    const int tid = get_tid(), lane = tid & 63, wid = tid >> 6, fr = lane & 15, fq = lane >> 4, wr = wid >> 1, wc = wid & 1;
    constexpr int KS = KACT / 32, NJ = 8 * KS;
    const bf16_t* b0 = W2 + (size_t)(tid >> 2) * KACT + lchunk(tid) * 8;
    auto stage = [&](int s, int j) {
        const int nt = j / KS, ks = j % KS;
        char* SB = sb + s * 8192;
        const bf16_t* src = b0 + (size_t)nt * 128 * KACT + ks * 32;
        glds16(src, SB + tid * 16);
        glds16(src + 64 * KACT, SB + 4096 + tid * 16);
    };
    WAIT_VM(0);
    stage(0, 0); stage(1, 1);
    const int boff = (wc * 64 + fr) * 64 + (fq ^ ((0 - (fr >> 2)) & 3)) * 16;
    f32x4 acc[MI][4]; zero_acc<MI, 4>(acc);
#pragma unroll 1
    for (int j = 0; j < NJ; ++j) {
        const int ks = j % KS;
        if (j + 1 < NJ) WAIT_VM(2); else WAIT_VM(0);
        RAW_BARRIER();
        const char* S = sb + (j & 1) * 8192;
        bf16x8 af[MI], bfr[4];
#pragma unroll
        for (int m = 0; m < MI; ++m) af[m] = *(const bf16x8*)(ACT + (wr * MI * 16 + m * 16 + fr) * ASTRIDE + (ks * 32 + fq * 8) * 2);
#pragma unroll
        for (int n = 0; n < 4; ++n) bfr[n] = *(const bf16x8*)(S + boff + n * 1024);
        WAIT_LGKM0();
        RAW_BARRIER();
        if (j + 2 < NJ) stage(j & 1, j + 2);
#pragma unroll
        for (int m = 0; m < MI; ++m)
#pragma unroll
            for (int n = 0; n < 4; ++n) acc[m][n] = mfma16(bfr[n], af[m], acc[m][n]);
        if (ks == KS - 1) { epi(j / KS, acc); zero_acc<MI, 4>(acc); }
    }
}

DEV void prep_mod_item(const Params& p, int it, char* lds) {
    const int l = it / 96, cch = it % 96, tid = get_tid(), col = cch * 64 + (tid & 63), kq = tid >> 6;
    float* sl = (float*)lds;
    float* red = sl + 9 * 1024;
    for (int i = tid; i < 9 * 1024; i += 256) { const int g = i >> 10, k = i & 1023; const float v = (g < 8) ? p.c[g * 1024 + k] : p.c_ctx[k]; sl[i] = v / (1.f + expf(-v)); }
    __syncthreads();
    float acc[9];
#pragma unroll
    for (int g = 0; g < 9; ++g) acc[g] = 0.f;
    const float* w = p.ada_w + ((size_t)l * 1024 + kq * 256) * 6144 + col;
#pragma unroll 16
    for (int kk = 0; kk < 256; ++kk) {
        const float wv = w[(size_t)kk * 6144];
#pragma unroll
        for (int g = 0; g < 9; ++g) acc[g] += sl[g * 1024 + kq * 256 + kk] * wv;
    }
#pragma unroll
    for (int g = 0; g < 9; ++g) red[(kq * 9 + g) * 64 + (tid & 63)] = acc[g];
    __syncthreads();
    float* mod = (float*)(p.ws + OFF_MOD);
    for (int i = tid; i < 9 * 64; i += 256) {
        const int g = i >> 6, c = i & 63;
        mod[((size_t)l * 9 + g) * 6144 + cch * 64 + c] = p.ada_b[l * 6144 + cch * 64 + c] + ((red[(0 * 9 + g) * 64 + c] + red[(1 * 9 + g) * 64 + c]) + (red[(2 * 9 + g) * 64 + c] + red[(3 * 9 + g) * 64 + c]));
    }
    __syncthreads();
}
DEV void prep_rope_item(const Params& p, int it) {
    const int idx = it * 256 + get_tid(), t = idx >> 5, i = idx & 31;
    const float inv = powf(10000.f, -(float)(2 * (i & 15)) / 32.f);
    const float ang = (float)((i < 16) ? (t >> 6) : (t & 63)) * inv;
    float* rc = (float*)(p.ws + OFF_ROPE);
    rc[idx] = cosf(ang); rc[2048 * 32 + idx] = sinf(ang);
}
DEV void prep_filter_item(const Params& p, int it, char* lds) {
    const int tid = get_tid(), lane = tid & 63, wid = tid >> 6;
    const int row0 = it * 32 + wid * 8;
    const int l = row0 / 2304, r0 = row0 % 2304, type = r0 < 2048 ? 0 : 1, t0 = type ? r0 - 2048 : r0, n = type ? 256 : 2048;
    float* z = (float*)lds + wid * (8 * 192); float* h1 = z + 8 * 64; float* h2 = h1 + 8 * 64;
#pragma unroll
    for (int rr = 0; rr < 8; ++rr) {
        const int t = t0 + rr;
        if (lane < 33) {
            float v;
            if (lane == 0) v = (float)t / (float)(n - 1);
            else {
                const int i = (lane - 1) & 15;
                const float f = 1e-4f + (float)i * ((15.f - 1e-4f) / 15.f);
                const float w = 2.f * 3.14159265358979323846f * (float)t / (float)n;
                v = (lane <= 16) ? cosf(f * w) : -sinf(f * w);
            }
            z[rr * 64 + lane] = v;
        }
    }
    __builtin_amdgcn_wave_barrier();
    {
        float s[8]; const float b = p.hy_f_b1[l * 64 + lane];
#pragma unroll
        for (int rr = 0; rr < 8; ++rr) s[rr] = b;
#pragma unroll 11
        for (int i = 0; i < 33; ++i) {
            const float w = p.hy_f_w1[(l * 33 + i) * 64 + lane];
#pragma unroll
            for (int rr = 0; rr < 8; ++rr) s[rr] += z[rr * 64 + i] * w;
        }
        const float fq0 = p.hy_freq[(l * 2 + 0) * 64 + lane];
#pragma unroll
        for (int rr = 0; rr < 8; ++rr) h1[rr * 64 + lane] = sinf(fq0 * s[rr]);
    }
    __builtin_amdgcn_wave_barrier();
    {
        float s[8]; const float b = p.hy_f_b2[l * 64 + lane];
#pragma unroll
        for (int rr = 0; rr < 8; ++rr) s[rr] = b;
#pragma unroll 16
        for (int i = 0; i < 64; ++i) {
            const float w = p.hy_f_w2[(l * 64 + i) * 64 + lane];
#pragma unroll
            for (int rr = 0; rr < 8; ++rr) s[rr] += h1[rr * 64 + i] * w;
        }
        const float fq1 = p.hy_freq[(l * 2 + 1) * 64 + lane];
#pragma unroll
        for (int rr = 0; rr < 8; ++rr) h2[rr * 64 + lane] = sinf(fq1 * s[rr]);
    }
    __builtin_amdgcn_wave_barrier();
    bf16_t* kf = (bf16_t*)(p.ws + (type ? OFF_KERNC + (size_t)l * 2 * 256 * 256 * 2 : OFF_KERNL + (size_t)l * 2 * 256 * 2048 * 2));
    const float lo = logf(1e-2f) / 1.5f, hi = logf(1e-2f) / 0.3f;
    const float* w3 = p.hy_f_w3 + (size_t)l * 64 * 512 + lane;
#pragma unroll 1
    for (int qh = 0; qh < 2; ++qh) {
        float acc[8][4];
#pragma unroll
        for (int rr = 0; rr < 8; ++rr)
#pragma unroll
            for (int q = 0; q < 4; ++q) acc[rr][q] = 0.f;
#pragma unroll 8
        for (int i = 0; i < 64; ++i) {
            float w[4];
#pragma unroll
            for (int q = 0; q < 4; ++q) w[q] = w3[i * 512 + qh * 256 + q * 64];
#pragma unroll
            for (int rr = 0; rr < 8; ++rr) {
                const float hv = h2[rr * 64 + i];
#pragma unroll
                for (int q = 0; q < 4; ++q) acc[rr][q] += hv * w[q];
            }
        }
#pragma unroll
        for (int q = 0; q < 4; ++q) {
            const int c = q * 64 + lane;
            const float delta = fabsf(lo + (float)c * ((hi - lo) / 255.f));
            float v[8];
#pragma unroll
            for (int rr = 0; rr < 8; ++rr) { const float tt = (float)(t0 + rr) / (float)(n - 1); v[rr] = acc[rr][q] * expf(-tt * delta); }
            if (qh == 0 && t0 == 0) v[0] += p.hy_skip[l * 256 + c];
            *(u32x4*)(kf + ((size_t)qh * 256 + c) * n + t0) = (u32x4){pk2(v[0], v[1]), pk2(v[2], v[3]), pk2(v[4], v[5]), pk2(v[6], v[7])};
        }
    }
    __builtin_amdgcn_wave_barrier();
}
struct ConvDesc { const float* src; bf16_t* dst; int ldsrc, k0, n0, lddst, mapkind; };
DEV void conv_load(const ConvDesc& d, f32x4 (&v)[4], int tid) {
    const int r = tid >> 4, c4 = (tid & 15) * 4;
#pragma unroll
    for (int i = 0; i < 4; ++i) v[i] = *(const f32x4*)(d.src + (size_t)(d.k0 + r + 16 * i) * d.ldsrc + d.n0 + c4);
}
DEV void conv_store(const ConvDesc& d, const f32x4 (&v)[4], char* lds, int tid) {
    float* tl = (float*)lds;
    {
        const int r = tid >> 4, c4 = (tid & 15) * 4;
#pragma unroll
        for (int i = 0; i < 4; ++i) { const int row = r + 16 * i; tl[row * 65 + c4 + 0] = v[i][0]; tl[row * 65 + c4 + 1] = v[i][1]; tl[row * 65 + c4 + 2] = v[i][2]; tl[row * 65 + c4 + 3] = v[i][3]; }
    }
    __syncthreads();
    {
        const int n = tid >> 2, kc = tid & 3, ng = d.n0 + n;
        int drow = ng;
        if (d.mapkind == 1) drow = 32 * (ng >> 4) + (ng & 15);
        else if (d.mapkind == 2) drow = 32 * (ng >> 4) + 16 + (ng & 15);
        else if (d.mapkind == 3) drow = (ng >> 7) * 256 + 32 * ((ng & 127) >> 4) + (ng & 15);
        else if (d.mapkind == 4) drow = (ng >> 7) * 256 + 32 * ((ng & 127) >> 4) + 16 + (ng & 15);
        else if (d.mapkind == 5) drow = (ng & ~31) + 16 * ((ng >> 2) & 1) + 4 * ((ng >> 3) & 3) + (ng & 3);
        unsigned w[8];
#pragma unroll
        for (int j = 0; j < 8; ++j) w[j] = pk2(tl[(kc * 16 + 2 * j) * 65 + n], tl[(kc * 16 + 2 * j + 1) * 65 + n]);
        u32x4* o = (u32x4*)(d.dst + (size_t)drow * d.lddst + d.k0 + kc * 16);
        o[0] = (u32x4){w[0], w[1], w[2], w[3]};
        o[1] = (u32x4){w[4], w[5], w[6], w[7]};
    }
    __syncthreads();
}
DEV ConvDesc conv_fixed_desc(const Params& p, int it) {
    const int l = it / 1040; int r = it % 1040;
    unsigned char* ws = p.ws;
    if (r < 576) return ConvDesc{p.w_in + (size_t)l * 1024 * PROJ, (bf16_t*)(ws + OFF_WIN) + (size_t)l * PROJ * 1024, PROJ, (r / 36) * 64, (r % 36) * 64, 1024, (r % 36) * 64 < 1536 ? 5 : 0};
    r -= 576;
    if (r < 256) return ConvDesc{p.w_out + (size_t)l * 1024 * 1024, (bf16_t*)(ws + OFF_WOUT) + (size_t)l * 1024 * 1024, 1024, (r / 16) * 64, (r % 16) * 64, 1024, 5};
    r -= 256;
    if (r < 64) return ConvDesc{p.sh_w1 + (size_t)l * 1024 * 256, (bf16_t*)(ws + OFF_SW13) + (size_t)l * 512 * 1024, 256, (r / 4) * 64, (r % 4) * 64, 1024, 3};
    r -= 64;
    if (r < 64) return ConvDesc{p.sh_w3 + (size_t)l * 1024 * 256, (bf16_t*)(ws + OFF_SW13) + (size_t)l * 512 * 1024, 256, (r / 4) * 64, (r % 4) * 64, 1024, 4};
    r -= 64;
    if (r < 64) { const int kt = r / 16, hh = kt >> 1;
        return ConvDesc{p.sh_w2 + (size_t)l * 256 * 1024, (bf16_t*)(ws + OFF_SW2) + (size_t)(l * 2 + hh) * 1024 * 128 - hh * 128, 1024, kt * 64, (r % 16) * 64, 128, 5}; }
    r -= 64;
    return ConvDesc{p.router_w + (size_t)l * 1024 * 64, (bf16_t*)(ws + OFF_RW) + (size_t)l * 64 * 1024, 64, r * 64, 0, 1024, 0};
}
DEV ConvDesc conv_expert_desc(const Params& p, int l, int it) {
    const int e = it / 96; int r = it % 96;
    unsigned char* ws = p.ws;
    const size_t eo = (size_t)(l * 64 + e) * 1024 * 128;
    if (r < 32) return ConvDesc{p.exp_w1 + eo, (bf16_t*)(ws + OFF_W13) + (size_t)e * 256 * 1024, 128, (r / 2) * 64, (r % 2) * 64, 1024, 1};
    r -= 32;
    if (r < 32) return ConvDesc{p.exp_w3 + eo, (bf16_t*)(ws + OFF_W13) + (size_t)e * 256 * 1024, 128, (r / 2) * 64, (r % 2) * 64, 1024, 2};
    r -= 32;
    return ConvDesc{p.exp_w2 + eo, (bf16_t*)(ws + OFF_W2) + (size_t)e * 1024 * 128, 1024, (r / 16) * 64, (r % 16) * 64, 128, 5};
}
DEV void conv_run(const Params& p, int l, int first, int count, char* lds) {
    const int tid = get_tid();
    if (count <= 0) return;
    ConvDesc d = l < 0 ? conv_fixed_desc(p, first) : conv_expert_desc(p, l, first);
    f32x4 v[4]; conv_load(d, v, tid);
#pragma unroll 1
    for (int i = 0; i < count; ++i) {
        ConvDesc dn = d; f32x4 vn[4];
        if (i + 1 < count) { dn = l < 0 ? conv_fixed_desc(p, first + i + 1) : conv_expert_desc(p, l, first + i + 1); conv_load(dn, vn, tid); }
        else {
#pragma unroll
            for (int k = 0; k < 4; ++k) vn[k] = v[k];
        }
        conv_store(d, v, lds, tid);
        d = dn;
#pragma unroll
        for (int k = 0; k < 4; ++k) v[k] = vn[k];
    }
}
DEV void phase_prep(const Params& p, char* lds) {
    { const int t_ = get_tid(); if (blockIdx.x == 0 && t_ < 128) ((int*)(p.ws + OFF_CNT))[t_ * 64] = 0; }
    constexpr int N0 = 144, N1 = N0 + 192, N2 = N1 + 260, N3 = N2 + 768, N4 = N3 + 256;
    int* qhead = (int*)(p.ws + OFF_QUEUE) + 2 * 64;
    int* qslot = (int*)(lds + SMEM_BYTES - 256);
    for (;;) {
        __syncthreads();
        if (get_tid() == 0) *qslot = atomicAdd(qhead, 1);
        __syncthreads();
        const int it = *qslot;
        if (it >= N4) break;
        if (it < N0) prep_filter_item(p, it, lds);
        else if (it < N1) prep_mod_item(p, it - N0, lds);
        else if (it < N2) conv_run(p, -1, (it - N1) * 8, 8, lds);
        else if (it < N3) conv_run(p, 0, (it - N2) * 8, 8, lds);
        else prep_rope_item(p, it - N3);
    }
}
DEV void phase_modfin(const Params& p) {
    const float* part = (const float*)(p.ws + OFF_PART);
    float* mod = (float*)(p.ws + OFF_MOD);
    for (int idx = blockIdx.x * 256 + get_tid(); idx < 2 * 9 * 6144; idx += gridDim.x * 256) {
        const int l = idx / (9 * 6144), g = (idx / 6144) % 9, col = idx % 6144;
        float s = p.ada_b[l * 6144 + col];
        for (int k = 0; k < 32; ++k) s += part[((size_t)(k * 2 + l) * 9 + g) * 6144 + col];
        mod[idx] = s;
    }
}

DEV void row_load(const float* src, f32x4 (&v)[4], int lane) {
#pragma unroll
    for (int j = 0; j < 4; ++j) v[j] = *(const f32x4*)(src + 4 * lane + 256 * j);
}
DEV f32x4 ld_bf4(const bf16_t* p) { const u32x2 w = *(const u32x2*)p; return (f32x4){__uint_as_float(w[0] << 16), __uint_as_float(w[0] & 0xffff0000u), __uint_as_float(w[1] << 16), __uint_as_float(w[1] & 0xffff0000u)}; }
DEV void st_bf4(bf16_t* p, const f32x4& v) { *(u32x2*)p = (u32x2){pk2(v[0], v[1]), pk2(v[2], v[3])}; }
DEV void row_load_bf(const bf16_t* src, f32x4 (&v)[4], int lane) {
#pragma unroll
    for (int j = 0; j < 4; ++j) v[j] = ld_bf4(src + 4 * lane + 256 * j);
}
DEV void row_norm(f32x4 (&v)[4]) {
    float s = 0.f;
#pragma unroll
    for (int j = 0; j < 4; ++j) s += (v[j][0] + v[j][1]) + (v[j][2] + v[j][3]);
    const float mean = wave_sum(s) * (1.f / 1024.f);
    float q = 0.f;
#pragma unroll
    for (int j = 0; j < 4; ++j) { v[j] = v[j] - mean; q += (v[j][0] * v[j][0] + v[j][1] * v[j][1]) + (v[j][2] * v[j][2] + v[j][3] * v[j][3]); }
    const float rstd = 1.0f / sqrtf(wave_sum(q) * (1.f / 1024.f) + 1e-6f);
#pragma unroll
    for (int j = 0; j < 4; ++j) v[j] = v[j] * rstd;
}
DEV void row_store_mod_bf16(bf16_t* dst, const f32x4 (&v)[4], const float* shift, const float* scale, int lane) {
#pragma unroll
    for (int j = 0; j < 4; ++j) {
        const int c = 4 * lane + 256 * j;
        const f32x4 sh = *(const f32x4*)(shift + c), sc = *(const f32x4*)(scale + c);
        const f32x4 o = v[j] * (sc + 1.0f) + sh;
        *(u32x2*)(dst + c) = (u32x2){pk2(o[0], o[1]), pk2(o[2], o[3])};
    }
}
DEV void phase_lnmod0(const Params& p) {
    const int tid_ = get_tid(), lane = tid_ & 63, wid = tid_ >> 6;
    const float* mod = (const float*)(p.ws + OFF_MOD);
    bf16_t* H = (bf16_t*)(p.ws + OFF_H);
    for (int row = blockIdx.x * 4 + wid; row < NT; row += gridDim.x * 4) {
        const float* src = row < NLAT ? p.x + (size_t)row * 1024 : p.ctx + (size_t)(row - NLAT) * 1024;
        f32x4 v[4]; row_load(src, v, lane); row_norm(v);
        const float* m = mod + (size_t)mod_group(row) * 6144;
        row_store_mod_bf16(H + (size_t)row * 1024, v, m, m + 1024, lane);
    }
}

DEV void phase_inproj(const Params& p, int l, char* lds) {
    const int tid = get_tid(), lane = tid & 63, wid = tid >> 6, fr = lane & 15, fq = lane >> 4, wr = wid >> 1, wc = wid & 1;
    unsigned char* ws = p.ws;
    const bf16_t* H = (const bf16_t*)(ws + OFF_H);
    const bf16_t* W = (const bf16_t*)(ws + OFF_WIN) + (size_t)l * PROJ * 1024;
    const float* ropec = (const float*)(ws + OFF_ROPE); const float* ropes = ropec + 2048 * 32;
    const int nitems = 128 * 18 + 16 * (l == 0 ? 18 : 6);
    for (int it = blockIdx.x; it < nitems; it += gridDim.x) {
        int mt, nt;
        if (it < 2304) { mt = it / 18; nt = it % 18; }
        else { const int j = it - 2304; if (l == 0) { mt = 128 + j / 18; nt = j % 18; } else { mt = 128 + j / 6; const int q = j % 6; nt = q < 2 ? 4 + q : 6 + q; } }
        const int m0 = mt * 128, n0 = nt * 128;
        const unsigned a0 = (unsigned)m0 * 1024u + st64_off(tid), b0 = (unsigned)n0 * 1024u + st64_off(tid);
        const unsigned ao[4] = {a0, a0 + 32u * 1024u, a0 + 64u * 1024u, a0 + 96u * 1024u};
        const unsigned bo[4] = {b0, b0 + 32u * 1024u, b0 + 64u * 1024u, b0 + 96u * 1024u};
        f32x4 acc[4][4]; zero_acc<4, 4>(acc);
        const bool latent = m0 < NLAT;
        const int b = latent ? (m0 >> 11) : ((m0 - NLAT) >> 8);
        const int tbase = latent ? (m0 & 2047) : ((m0 - NLAT) & 255);
        if (nt >= 12) {
            const int rho = tid >> 3, ptok = 8 * ((rho & 15) >> 2) + 4 * (rho >> 4) + (rho & 3);
            const unsigned ap0 = (unsigned)(m0 + ptok) * 1024u + (unsigned)(((tid & 7) ^ (rho & 7)) * 8);
            const unsigned aop[4] = {ap0, ap0 + 32u * 1024u, ap0 + 64u * 1024u, ap0 + 96u * 1024u};
            gemm_core64<false>(acc, H, aop, W, bo, 1024, lds);
            bf16_t* zt = latent ? (bf16_t*)(ws + OFF_ZTL) + (size_t)b * 768 * 2048 : (bf16_t*)(ws + OFF_ZTC) + (size_t)b * 768 * 256;
            const int n = latent ? 2048 : 256;
#pragma unroll
            for (int g = 0; g < 2; ++g)
#pragma unroll
                for (int nn = 0; nn < 4; ++nn) {
                    const int ch = n0 - 1536 + wc * 64 + nn * 16 + fr, t = tbase + wr * 64 + 32 * g + 8 * fq;
                    *(u32x4*)(zt + (size_t)ch * n + t) = (u32x4){pk2(acc[2 * g][nn][0], acc[2 * g][nn][1]), pk2(acc[2 * g][nn][2], acc[2 * g][nn][3]),
                                                                 pk2(acc[2 * g + 1][nn][0], acc[2 * g + 1][nn][1]), pk2(acc[2 * g + 1][nn][2], acc[2 * g + 1][nn][3])};
                }
        } else {
            gemm_core64<true>(acc, H, ao, W, bo, 1024, lds);
            const int col0 = n0 + wc * 64;
            int kind, hh;
            if (col0 < 512) { kind = 0; hh = col0 >> 6; } else if (col0 < 640) { kind = 1; hh = (col0 - 512) >> 6; } else if (col0 < 768) { kind = 2; hh = (col0 - 640) >> 6; }
            else if (col0 < 1024) { kind = 3; hh = (col0 - 768) >> 6; } else if (col0 < 1280) { kind = 4; hh = (col0 - 1024) >> 6; } else { kind = 5; hh = (col0 - 1280) >> 6; }
            const bool normed = (kind == 0 || kind == 1);
            const float* gain = (kind == 0 ? p.q_gain : p.k_gain) + l * 64;
#pragma unroll
            for (int m = 0; m < 4; ++m) {
                const int rloc = wr * 64 + m * 16 + fr, row = m0 + rloc, t = tbase + rloc;
                f32x4 v[4];
#pragma unroll
                for (int nn = 0; nn < 4; ++nn) v[nn] = acc[m][nn];
                if (normed) {
                    float ss = 0.f;
#pragma unroll
                    for (int nn = 0; nn < 4; ++nn) ss += (v[nn][0] * v[nn][0] + v[nn][1] * v[nn][1]) + (v[nn][2] * v[nn][2] + v[nn][3] * v[nn][3]);
                    ss += __shfl_xor(ss, 16); ss += __shfl_xor(ss, 32);
                    const float r = 1.0f / sqrtf(ss * (1.f / 64.f) + 1e-6f);
#pragma unroll
                    for (int nn = 0; nn < 4; ++nn) {
                        const int hc = 32 * (nn >> 1) + 8 * fq + 4 * (nn & 1);
                        const f32x4 g = *(const f32x4*)(gain + hc);
                        v[nn] = v[nn] * r * g;
                        if (latent) {
                            const int pi = hc >> 1;
                            const float c0 = ropec[t * 32 + pi], s0 = ropes[t * 32 + pi], c1 = ropec[t * 32 + pi + 1], s1 = ropes[t * 32 + pi + 1];
                            const float x0 = v[nn][0], x1 = v[nn][1], x2 = v[nn][2], x3 = v[nn][3];
                            v[nn][0] = x0 * c0 - x1 * s0; v[nn][1] = x0 * s0 + x1 * c0;
                            v[nn][2] = x2 * c1 - x3 * s1; v[nn][3] = x2 * s1 + x3 * c1;
                        }
                    }
                }
                if (kind == 0 || kind == 3) {
#pragma unroll
                    for (int nn = 0; nn < 4; ++nn) v[nn] = v[nn] * (0.125f * LOG2E);
                }
                bf16_t* dst;
                const int key = latent ? 256 + t : t;
                if (kind == 0) dst = (bf16_t*)(ws + OFF_QA) + ((size_t)hh * NT + row) * 64;
                else if (kind == 3) dst = (bf16_t*)(ws + OFF_QB) + ((size_t)hh * NT + row) * 64;
                else if (kind == 1) dst = (bf16_t*)(ws + OFF_KA) + ((size_t)(b * 2 + hh) * KEYS + key) * 64;
                else if (kind == 2) dst = (bf16_t*)(ws + OFF_VA) + ((size_t)(b * 2 + hh) * KEYS + key) * 64;
                else if (kind == 4) dst = (bf16_t*)(ws + OFF_KB) + ((size_t)(b * 4 + hh) * KEYS + key) * 64;
                else dst = (bf16_t*)(ws + OFF_VB) + ((size_t)(b * 4 + hh) * KEYS + key) * 64;
#pragma unroll
                for (int gg = 0; gg < 2; ++gg) *(u32x4*)(dst + 32 * gg + 8 * fq) = (u32x4){pk2(v[2 * gg][0], v[2 * gg][1]), pk2(v[2 * gg][2], v[2 * gg][3]), pk2(v[2 * gg + 1][0], v[2 * gg + 1][1]), pk2(v[2 * gg + 1][2], v[2 * gg + 1][3])};
                __builtin_amdgcn_sched_barrier(0);
            }
        }
    }
}

template <int NQT, bool NA>
DEV void attn_block(const bf16_t* Qh, int qrow0, const bf16_t* Kh, const bf16_t* Vh, int ntiles, bf16_t* outp  ,
                    int na_r, int na_rs, int nwin, const float* rpb_h, char* lds) {
    const int tid = get_tid(), lane = tid & 63, wid = tid >> 6, fr = lane & 15, fq = lane >> 4;
    char* KBUF = lds;
    char* VBUF = lds + 16384;
    float* BIAS = (float*)(lds + 32768);
    if (NA) {
        for (int i = tid; i < 15 * 32; i += 256) { const int dr = i >> 5, dc = i & 31; BIAS[i] = dc < 31 ? rpb_h[dr * 31 + dc] * LOG2E : 0.f; }
    }
    bf16x8 qf[NQT][2];
    const int qw = qrow0 + wid * 16 * NQT;
#pragma unroll
    for (int nq = 0; nq < NQT; ++nq)
#pragma unroll
        for (int ks = 0; ks < 2; ++ks) qf[nq][ks] = *(const bf16x8*)(Qh + (size_t)(qw + nq * 16 + fr) * 64 + ks * 32 + fq * 8);
    f32x4 oacc[4][NQT], lacc[NQT];
    float mrun[NQT];
    const bf16x8 ones = (bf16x8){0x3F80, 0x3F80, 0x3F80, 0x3F80, 0x3F80, 0x3F80, 0x3F80, 0x3F80};
#pragma unroll
    for (int nq = 0; nq < NQT; ++nq) { mrun[nq] = 0.f; lacc[nq] = (f32x4){0.f, 0.f, 0.f, 0.f};
#pragma unroll
        for (int dt = 0; dt < 4; ++dt) oacc[dt][nq] = (f32x4){0.f, 0.f, 0.f, 0.f}; }
    const int lrow0 = tid >> 3, lch = tid & 7;
    auto key0_of = [&](int ti) -> int { if (NA) return ti < nwin ? 256 + (na_rs + ti) * 64 : (ti - nwin) * 64; return ti * 64; };
    u32x4 kreg[2], vreg[2];
    auto gload = [&](int ti) {
        const int k0 = key0_of(ti);
#pragma unroll
        for (int i = 0; i < 2; ++i) {
            const int row = lrow0 + 32 * i;
            kreg[i] = *(const u32x4*)(Kh + (size_t)(k0 + row) * 64 + lch * 8);
            vreg[i] = *(const u32x4*)(Vh + (size_t)(k0 + row) * 64 + lch * 8);
        }
    };
    auto lstore = [&](int buf) {
#pragma unroll
        for (int i = 0; i < 2; ++i) {
            const int row = lrow0 + 32 * i;
            const int off = buf * 8192 + row * 128 + ((lch ^ (row & 7)) * 16);
            *(u32x4*)(KBUF + off) = kreg[i];
            *(u32x4*)(VBUF + off) = vreg[i];
        }
    };
    gload(0); lstore(0);
    __syncthreads();
    for (int ti = 0; ti < ntiles; ++ti) {
        const int buf = ti & 1;
        if (ti + 1 < ntiles) gload(ti + 1);
        const char* kb = KBUF + buf * 8192; const char* vb = VBUF + buf * 8192;
        f32x4 sacc[4][NQT];
#pragma unroll
        for (int mt = 0; mt < 4; ++mt) {
            const int row = mt * 16 + fr;
            bf16x8 kf0 = *(const bf16x8*)(kb + row * 128 + (((0 + fq) ^ (row & 7)) * 16));
            bf16x8 kf1 = *(const bf16x8*)(kb + row * 128 + (((4 + fq) ^ (row & 7)) * 16));
#pragma unroll
            for (int nq = 0; nq < NQT; ++nq) {
                f32x4 s = (f32x4){-mrun[nq], -mrun[nq], -mrun[nq], -mrun[nq]};
                s = mfma16(kf0, qf[nq][0], s);
                s = mfma16(kf1, qf[nq][1], s);
                sacc[mt][nq] = s;
            }
        }
        bf16x8 pf[2][NQT];
#pragma unroll
        for (int nq = 0; nq < NQT; ++nq) {
            float tv[4][4];
            float tmax = -1e30f;
            if (NA && ti < nwin) {
                const int qc = (wid & 1) * 32 + nq * 16 + fr;
                int cs = qc - 8; cs = cs < 0 ? 0 : (cs > 48 ? 48 : cs);
                const int qrow = na_r + (wid >> 1);
                int rsq = qrow - 4; rsq = rsq < 0 ? 0 : (rsq > 24 ? 24 : rsq);
                const int krow = na_rs + ti;
                const bool rowok = (krow >= rsq) && (krow < rsq + 8);
                int dr = krow - qrow + 7; dr = dr < 0 ? 0 : (dr > 14 ? 14 : dr);
#pragma unroll
                for (int mt = 0; mt < 4; ++mt)
#pragma unroll
                    for (int j = 0; j < 4; ++j) {
                        const int kc = mt * 16 + 4 * fq + j;
                        const bool ok = rowok && (kc >= cs) && (kc < cs + 16);
                        int dc = kc - qc + 15; dc = dc < 0 ? 0 : (dc > 30 ? 30 : dc);
                        tv[mt][j] = ok ? sacc[mt][nq][j] + BIAS[dr * 32 + dc] : -1e30f;
                        tmax = fmaxf(tmax, tv[mt][j]);
                    }
            } else {
#pragma unroll
                for (int mt = 0; mt < 4; ++mt) {
#pragma unroll
                    for (int j = 0; j < 4; ++j) tv[mt][j] = sacc[mt][nq][j];
                    tmax = fmaxf(fmaxf(tmax, tv[mt][0]), tv[mt][1]); tmax = fmaxf(fmaxf(tmax, tv[mt][2]), tv[mt][3]);
                }
            }
            if (__any(tmax > 8.0f)) {
                tmax = fmaxf(tmax, __shfl_xor(tmax, 16)); tmax = fmaxf(tmax, __shfl_xor(tmax, 32));
                const float dlt = fmaxf(tmax, 0.f);
                const float alpha = __builtin_amdgcn_exp2f(-dlt);
                mrun[nq] += dlt;
                lacc[nq] = lacc[nq] * alpha;
#pragma unroll
                for (int dt = 0; dt < 4; ++dt) oacc[dt][nq] = oacc[dt][nq] * alpha;
#pragma unroll
                for (int mt = 0; mt < 4; ++mt)
#pragma unroll
                    for (int j = 0; j < 4; ++j) tv[mt][j] -= dlt;
            }
#pragma unroll
            for (int mt = 0; mt < 4; ++mt)
#pragma unroll
                for (int j = 0; j < 4; ++j) tv[mt][j] = __builtin_amdgcn_exp2f(tv[mt][j]);
#pragma unroll
            for (int ks = 0; ks < 2; ++ks) {
                union { bf16x8 v; unsigned u[4]; } pk;
                pk.u[0] = pk2(tv[2 * ks][0], tv[2 * ks][1]); pk.u[1] = pk2(tv[2 * ks][2], tv[2 * ks][3]);
                pk.u[2] = pk2(tv[2 * ks + 1][0], tv[2 * ks + 1][1]); pk.u[3] = pk2(tv[2 * ks + 1][2], tv[2 * ks + 1][3]);
                pf[ks][nq] = pk.v;
                lacc[nq] = mfma16(ones, pk.v, lacc[nq]);
            }
        }
        {
            const int q4 = fr >> 2, p4 = fr & 3;
#pragma unroll
            for (int ks = 0; ks < 2; ++ks)
#pragma unroll
                for (int dt = 0; dt < 4; ++dt) {
                    const int keyA = 16 * (2 * ks) + 4 * fq + q4, keyB = keyA + 16;
                    const int ch = 4 * (dt >> 1) + p4;
                    const int offA = keyA * 128 + ((ch ^ (keyA & 7)) * 16) + (dt & 1) * 8;
                    const int offB = keyB * 128 + ((ch ^ (keyB & 7)) * 16) + (dt & 1) * 8;
                    const s16x4 ta = __builtin_amdgcn_ds_read_tr16_b64_v4i16((LDSP(s16x4))(vb + offA));
                    const s16x4 tb = __builtin_amdgcn_ds_read_tr16_b64_v4i16((LDSP(s16x4))(vb + offB));
                    bf16x8 vf; vf[0] = ta[0]; vf[1] = ta[1]; vf[2] = ta[2]; vf[3] = ta[3]; vf[4] = tb[0]; vf[5] = tb[1]; vf[6] = tb[2]; vf[7] = tb[3];
#pragma unroll
                    for (int nq = 0; nq < NQT; ++nq) oacc[dt][nq] = mfma16(vf, pf[ks][nq], oacc[dt][nq]);
                }
        }
        if (ti + 1 < ntiles) lstore(buf ^ 1);
        __syncthreads();
    }
#pragma unroll
    for (int nq = 0; nq < NQT; ++nq) {
        const float inv = 1.0f / lacc[nq][0];
        bf16_t* o = outp + (size_t)(qw + nq * 16 + fr) * 1024;
#pragma unroll
        for (int g = 0; g < 2; ++g) {
            const f32x4 v0 = oacc[2 * g][nq] * inv, v1 = oacc[2 * g + 1][nq] * inv;
            *(u32x4*)(o + g * 32 + 8 * fq) = (u32x4){pk2(v0[0], v0[1]), pk2(v0[2], v0[3]), pk2(v1[0], v1[1]), pk2(v1[2], v1[3])};
        }
    }
    __syncthreads();
}

DEV float hy_sconv(const bf16_t* zrow, int t, int n, float w0, float w1, float w2, float bias) {
    const float zm = t > 0 ? bf2f(zrow[t - 1]) : 0.f, z0 = bf2f(zrow[t]), zp = t + 1 < n ? bf2f(zrow[t + 1]) : 0.f;
    return w0 * zm + w1 * z0 + w2 * zp + bias;
}
template <int NJ>
DEV void hyena_item(const Params& p, int l, int type, int c, int bh, char* lds) {
    constexpr int n = 256 * NJ;
    const int tid = get_tid();
    f32x4* U = (f32x4*)lds;
    float* KR = (float*)(lds + n * 16);
    const bf16_t* zt = type ? (const bf16_t*)(p.ws + OFF_ZTC) : (const bf16_t*)(p.ws + OFF_ZTL);
    const bf16_t* kf = (const bf16_t*)(p.ws + (type ? OFF_KERNC + (size_t)l * 2 * 256 * 256 * 2 : OFF_KERNL + (size_t)l * 2 * 256 * 2048 * 2)) + (size_t)c * n;
    const bf16_t* kb = kf + (size_t)256 * n;
    const float* cw = p.hy_conv_w + l * 3 * 768; const float* cb = p.hy_conv_b + l * 768;
    const float w10 = cw[256 + c], w11 = cw[768 + 256 + c], w12 = cw[1536 + 256 + c], b1 = cb[256 + c];
    const float wv0 = cw[512 + c], wv1 = cw[768 + 512 + c], wv2 = cw[1536 + 512 + c], bv = cb[512 + c];
    const float w00 = cw[c], w01 = cw[768 + c], w02 = cw[1536 + c], b0 = cb[c];
    for (int i = tid; i < 2 * n - 1; i += 256) { const int d = i - (n - 1); KR[i] = bf2f(d >= 0 ? kf[d] : kb[-d]); }
    for (int s = tid; s < n; s += 256) {
        f32x4 u;
#pragma unroll
        for (int bb = 0; bb < 4; ++bb) {
            const bf16_t* zb = zt + (size_t)(bh * 4 + bb) * 768 * n;
            const float x1 = hy_sconv(zb + (size_t)(256 + c) * n, s, n, w10, w11, w12, b1);
            const float vv = hy_sconv(zb + (size_t)(512 + c) * n, s, n, wv0, wv1, wv2, bv);
            u[bb] = vv * x1;
        }
        U[s] = u;
    }
    __syncthreads();
    f32x4 acc[NJ];
#pragma unroll
    for (int j = 0; j < NJ; ++j) acc[j] = (f32x4){0.f, 0.f, 0.f, 0.f};
    const float* kp = KR + tid + (n - 1);
    for (int s = 0; s < n; ++s) {
        const f32x4 u = U[s];
#pragma unroll
        for (int j = 0; j < NJ; ++j) acc[j] += u * kp[256 * j - s];
    }
    bf16_t* ox = (bf16_t*)(p.ws + OFF_OX);
#pragma unroll
    for (int j = 0; j < NJ; ++j) {
        const int t = tid + 256 * j;
#pragma unroll
        for (int bb = 0; bb < 4; ++bb) {
            const int b = bh * 4 + bb;
            const bf16_t* zb = zt + (size_t)b * 768 * n;
            const float x0 = hy_sconv(zb + (size_t)c * n, t, n, w00, w01, w02, b0);
            const float y = acc[j][bb] * x0;
            const int row = type ? NLAT + b * 256 + t : b * 2048 + t;
            ox[(size_t)row * 1024 + 768 + c] = (bf16_t)f2bf(y);
        }
    }
    __syncthreads();
}


typedef float f32x16 __attribute__((ext_vector_type(16)));
constexpr int HY_UROW = 2256;
constexpr int HY_KC_OFF = 8 * HY_UROW * 2;
constexpr int HY_KC_STRIDE = 8192 + 64;
DEV float hy_sc8(const bf16_t* zrow, int s0, int n, float w0, float w1, float w2, float bias, float (&o)[8]) {
    const u32x4 v = *(const u32x4*)(zrow + s0);
    const float zm = s0 > 0 ? bf2f(zrow[s0 - 1]) : 0.f, zp = s0 + 8 < n ? bf2f(zrow[s0 + 8]) : 0.f;
    float z[10]; z[0] = zm; z[9] = zp;
#pragma unroll
    for (int i = 0; i < 4; ++i) { z[1 + 2 * i] = __uint_as_float(v[i] << 16); z[2 + 2 * i] = __uint_as_float(v[i] & 0xffff0000u); }
#pragma unroll
    for (int i = 0; i < 8; ++i) o[i] = w0 * z[i] + w1 * z[i + 1] + w2 * z[i + 2] + bias;
    return 0.f;
}
DEV void hyena_mfma_item(const Params& p, int l, int c, char* lds) {
    const int tid = get_tid(), lane = tid & 63, wid = tid >> 6;
    constexpr int n = 2048;
    const bf16_t* zt = (const bf16_t*)(p.ws + OFF_ZTL);
    const bf16_t* kf = (const bf16_t*)(p.ws + OFF_KERNL + (size_t)l * 2 * 256 * 2048 * 2) + (size_t)c * n;
    const bf16_t* kb = kf + (size_t)256 * n;
    const float* cw = p.hy_conv_w + l * 3 * 768; const float* cb = p.hy_conv_b + l * 768;
    const float w10 = cw[256 + c], w11 = cw[768 + 256 + c], w12 = cw[1536 + 256 + c], b1 = cb[256 + c];
    const float wv0 = cw[512 + c], wv1 = cw[768 + 512 + c], wv2 = cw[1536 + 512 + c], bv = cb[512 + c];
    const float w00 = cw[c], w01 = cw[768 + c], w02 = cw[1536 + c], b0 = cb[c];
    for (int i = tid; i < 8 * 26; i += 256) {
        const int b = i / 26, k = i % 26;
        const int sp = k < 12 ? k * 8 : 96 + 2048 + (k - 12) * 8;
        *(u32x4*)(lds + (b * HY_UROW + sp) * 2) = (u32x4){0u, 0u, 0u, 0u};
    }
#pragma unroll 4
    for (int ch = tid; ch < 8 * 256; ch += 256) {
        const int b = ch >> 8, s0 = (ch & 255) * 8;
        const bf16_t* zb = zt + (size_t)b * 768 * n;
        float x1[8], vv[8];
        hy_sc8(zb + (size_t)(256 + c) * n, s0, n, w10, w11, w12, b1, x1);
        hy_sc8(zb + (size_t)(512 + c) * n, s0, n, wv0, wv1, wv2, bv, vv);
        *(u32x4*)(lds + (b * HY_UROW + 96 + s0) * 2) = (u32x4){pk2(vv[0] * x1[0], vv[1] * x1[1]), pk2(vv[2] * x1[2], vv[3] * x1[3]), pk2(vv[4] * x1[4], vv[5] * x1[5]), pk2(vv[6] * x1[6], vv[7] * x1[7])};
    }
    {
        char* R0 = lds + HY_KC_OFF;
#pragma unroll
        for (int j = 0; j < 2; ++j) {
            const int chn = tid + 256 * j;
            const bool fwd = chn < 256; const int d0 = (chn & 255) * 8;
            const u32x4 v = *(const u32x4*)((fwd ? kf : kb) + d0);
#pragma unroll
            for (int e = 0; e < 8; ++e) {
                const int d = d0 + e;
                const bf16_t val = (bf16_t)((e & 1) ? (v[e >> 1] >> 16) : (v[e >> 1] & 0xffffu));
                const int y = fwd ? 2047 - d : 2047 + d;
                if (fwd || d > 0) *(bf16_t*)(R0 + y * 2) = val;
            }
        }
        if (tid == 0) *(bf16_t*)(R0 + 4095 * 2) = 0;
    }
    __syncthreads();
    {
        const char* R0 = lds + HY_KC_OFF;
        for (int i = tid; i < 3 * 1024; i += 256) {
            const int q = 1 + i / 1024, y = (i % 1024) * 4;
            unsigned short e[4];
#pragma unroll
            for (int k = 0; k < 4; ++k) { const int yy = y + q + k; e[k] = yy <= 4094 ? *(const bf16_t*)(R0 + yy * 2) : (bf16_t)0; }
            *(u32x2*)(lds + HY_KC_OFF + q * HY_KC_STRIDE + y * 2) = (u32x2){(unsigned)e[0] | ((unsigned)e[1] << 16), (unsigned)e[2] | ((unsigned)e[3] << 16)};
        }
    }
    __syncthreads();
    const int i32 = lane & 31, h = lane >> 5, qn = i32 >> 3, bn = i32 & 7;
    const int T0 = 512 * wid;
    f32x16 acc[4];
#pragma unroll
    for (int g = 0; g < 4; ++g)
#pragma unroll
        for (int r = 0; r < 16; ++r) acc[g][r] = 0.f;
    const int dlo = T0 - 2032, dhi = T0 + 384 + 96;
    {
        const int a0 = 2047 - dlo - i32 + 8 * h, q4 = a0 & 3;
        const char* ap = lds + HY_KC_OFF + q4 * HY_KC_STRIDE + (a0 - q4) * 2;
        const char* bp = lds + (bn * HY_UROW + 96 + (T0 - dlo) + 32 * qn + 8 * h) * 2;
        for (int dl = dlo; dl <= dhi; dl += 16) {
            union { bf16x8 v; u32x2 u[2]; } af;
            af.u[0] = *(const u32x2*)ap; af.u[1] = *(const u32x2*)(ap + 8);
#pragma unroll
            for (int g = 0; g < 4; ++g) {
                const int S = T0 + 128 * g - dl;
                if (S >= -96 && S <= 2032) {
                    const bf16x8 bfv = *(const bf16x8*)(bp + 256 * g);
                    acc[g] = __builtin_amdgcn_mfma_f32_32x32x16_bf16(af.v, bfv, acc[g], 0, 0, 0);
                }
            }
            ap -= 32; bp -= 32;
        }
    }
    __syncthreads();
#pragma unroll 4
    for (int ch = tid; ch < 8 * 256; ch += 256) {
        const int b = ch >> 8, s0 = (ch & 255) * 8;
        float x0[8];
        hy_sc8(zt + (size_t)b * 768 * n + (size_t)c * n, s0, n, w00, w01, w02, b0, x0);
        *(u32x4*)(lds + HY_KC_OFF + (b * 2048 + s0) * 2) = (u32x4){pk2(x0[0], x0[1]), pk2(x0[2], x0[3]), pk2(x0[4], x0[5]), pk2(x0[6], x0[7])};
    }
    __syncthreads();
    bf16_t* ox = (bf16_t*)(p.ws + OFF_OX) + 768 + c;
#pragma unroll
    for (int g = 0; g < 4; ++g)
#pragma unroll
        for (int r4 = 0; r4 < 4; ++r4) {
            const int t = T0 + 128 * g + 32 * qn + 8 * r4 + 4 * h;
            const u32x2 xg = *(const u32x2*)(lds + HY_KC_OFF + (bn * 2048 + t) * 2);
            const float g0 = __uint_as_float(xg[0] << 16), g1 = __uint_as_float(xg[0] & 0xffff0000u), g2 = __uint_as_float(xg[1] << 16), g3 = __uint_as_float(xg[1] & 0xffff0000u);
            bf16_t* o = ox + (size_t)(bn * 2048 + t) * 1024;
            o[0] = (bf16_t)f2bf(acc[g][4 * r4 + 0] * g0); o[1024] = (bf16_t)f2bf(acc[g][4 * r4 + 1] * g1);
            o[2048] = (bf16_t)f2bf(acc[g][4 * r4 + 2] * g2); o[3072] = (bf16_t)f2bf(acc[g][4 * r4 + 3] * g3);
        }
    __syncthreads();
}

DEV void phase_mix(const Params& p, int l, char* lds) {
    unsigned char* ws = p.ws;
    const bf16_t* QA = (const bf16_t*)(ws + OFF_QA); const bf16_t* QB = (const bf16_t*)(ws + OFF_QB);
    const bf16_t* KA = (const bf16_t*)(ws + OFF_KA); const bf16_t* VA = (const bf16_t*)(ws + OFF_VA);
    const bf16_t* KBp = (const bf16_t*)(ws + OFF_KB); const bf16_t* VBp = (const bf16_t*)(ws + OFF_VB);
    bf16_t* OX = (bf16_t*)(ws + OFF_OX);
    const int N0 = 256, N1 = N0 + 1024, N2 = N1 + 512;
    const int N3 = N2 + (l == 0 ? 512 : 0), N4 = N3 + (l == 0 ? 128 : 0), N5 = N4 + (l == 0 ? 64 : 0);
    int* qhead = (int*)(p.ws + OFF_QUEUE) + l * 64;
    int* qslot = (int*)(lds + SMEM_BYTES - 256);
    for (;;) {
        __syncthreads();
        if (get_tid() == 0) *qslot = atomicAdd(qhead, 1);
        __syncthreads();
        const int it = *qslot;
        if (it >= N5) break;
#if TELEM
        const unsigned long long ts0 = __builtin_amdgcn_s_memrealtime();
        const int kind = it < N0 ? 9 : it < N1 ? 10 : it < N2 ? 11 : 12;
        struct TS { unsigned long long t0; int k; char* l; __device__ ~TS() { __syncthreads(); if (threadIdx.x == 0) ((volatile LAS unsigned*)(l + SMEM_BYTES - 128))[k] += (unsigned)(__builtin_amdgcn_s_memrealtime() - t0); } } ts_{ts0, kind, lds};
#endif
        if (it < N0) { hyena_mfma_item(p, l, it, lds); }
        else if (it < N1) {
            const int j = it - N0, b = j >> 7, h = (j >> 4) & 7, qb = j & 15;
            attn_block<2, false>(QA + (size_t)h * NT * 64, b * 2048 + qb * 128, KA + (size_t)(b * 2 + (h >> 2)) * KEYS * 64, VA + (size_t)(b * 2 + (h >> 2)) * KEYS * 64,
                                 36, OX + h * 64, 0, 0, 0, nullptr, lds);
        } else if (it < N2) {
            const int j = it - N1, b = j >> 6, h = (j >> 4) & 3, r = (j & 15) * 2;
            int rs0 = r - 4; rs0 = rs0 < 0 ? 0 : (rs0 > 24 ? 24 : rs0);
            int rs1 = r - 3; rs1 = rs1 < 0 ? 0 : (rs1 > 24 ? 24 : rs1);
            const int nwin = rs1 + 8 - rs0;
            attn_block<2, true>(QB + (size_t)h * NT * 64, b * 2048 + r * 64, KBp + (size_t)(b * 4 + h) * KEYS * 64, VBp + (size_t)(b * 4 + h) * KEYS * 64,
                                nwin + 4, OX + 512 + h * 64, r, rs0, nwin, p.nat_rpb + (size_t)(l * 4 + h) * 15 * 31, lds);
        } else if (it < N3) { const int j = it - N2; hyena_item<1>(p, l, 1, j >> 1, j & 1, lds); }
        else if (it < N4) {
            const int j = it - N3, b = j >> 4, h = (j >> 1) & 7, qb = j & 1;
            attn_block<2, false>(QA + (size_t)h * NT * 64, NLAT + b * 256 + qb * 128, KA + (size_t)(b * 2 + (h >> 2)) * KEYS * 64, VA + (size_t)(b * 2 + (h >> 2)) * KEYS * 64,
                                 4, OX + h * 64, 0, 0, 0, nullptr, lds);
        } else {
            const int j = it - N4, b = j >> 3, h = (j >> 1) & 3, qb = j & 1;
            attn_block<2, false>(QB + (size_t)h * NT * 64, NLAT + b * 256 + qb * 128, KBp + (size_t)(b * 4 + h) * KEYS * 64, VBp + (size_t)(b * 4 + h) * KEYS * 64,
                                 4, OX + 512 + h * 64, 0, 0, 0, nullptr, lds);
        }
    }
}

DEV void phase_outproj(const Params& p, int l, char* lds) {
    const int tid = get_tid(), lane = tid & 63, wid = tid >> 6, fr = lane & 15, fq = lane >> 4, wr = wid >> 1, wc = wid & 1;
    const bf16_t* OX = (const bf16_t*)(p.ws + OFF_OX);
    const bf16_t* W = (const bf16_t*)(p.ws + OFF_WOUT) + (size_t)l * 1024 * 1024;
    const float* mod = (const float*)(p.ws + OFF_MOD) + (size_t)l * 9 * 6144;
    bf16_t* X = (bf16_t*)(p.ws + OFF_X);
    const int nitems = (l == 0 ? 144 : 128) * 8;
    for (int it = blockIdx.x; it < nitems; it += gridDim.x) {
        const int mt = it >> 3, nt = it & 7, m0 = mt * 128, n0 = nt * 128;
        const unsigned a0 = (unsigned)m0 * 1024u + st64_off(tid), b0 = (unsigned)n0 * 1024u + st64_off(tid);
        f32x4 acc[4][4]; zero_acc<4, 4>(acc);
        const unsigned ao[4] = {a0, a0 + 32u * 1024u, a0 + 64u * 1024u, a0 + 96u * 1024u};
        const unsigned bo[4] = {b0, b0 + 32u * 1024u, b0 + 64u * 1024u, b0 + 96u * 1024u};
        gemm_core64<true>(acc, OX, ao, W, bo, 1024, lds);
        const float* g1 = mod + (size_t)mod_group(m0) * 6144 + 2048;
#pragma unroll
        for (int m = 0; m < 4; ++m) {
            const int row = m0 + wr * 64 + m * 16 + fr;
            const float* xin = row < NLAT ? p.x + (size_t)row * 1024 : p.ctx + (size_t)(row - NLAT) * 1024;
#pragma unroll
            for (int gg = 0; gg < 2; ++gg) {
                const int col = n0 + wc * 64 + gg * 32 + 8 * fq;
                f32x4 x0, x1;
                if (l == 0) { x0 = *(const f32x4*)(xin + col); x1 = *(const f32x4*)(xin + col + 4); }
                else { const u32x4 w = *(const u32x4*)(X + (size_t)row * 1024 + col);
                       x0 = (f32x4){__uint_as_float(w[0] << 16), __uint_as_float(w[0] & 0xffff0000u), __uint_as_float(w[1] << 16), __uint_as_float(w[1] & 0xffff0000u)};
                       x1 = (f32x4){__uint_as_float(w[2] << 16), __uint_as_float(w[2] & 0xffff0000u), __uint_as_float(w[3] << 16), __uint_as_float(w[3] & 0xffff0000u)}; }
                const f32x4 o0 = x0 * DN_ALPHA + *(const f32x4*)(g1 + col) * acc[m][2 * gg], o1 = x1 * DN_ALPHA + *(const f32x4*)(g1 + col + 4) * acc[m][2 * gg + 1];
                *(u32x4*)(X + (size_t)row * 1024 + col) = (u32x4){pk2(o0[0], o0[1]), pk2(o0[2], o0[3]), pk2(o1[0], o1[1]), pk2(o1[2], o1[3])};
            }
        }
    }
}

DEV void phase_ln1route(const Params& p, int l, char* lds) {
    const int tid = get_tid(), lane = tid & 63, wid = tid >> 6, fr = lane & 15, fq = lane >> 4;
    bf16_t* X = (bf16_t*)(p.ws + OFF_X);
    bf16_t* H = (bf16_t*)(p.ws + OFF_H);
    const bf16_t* RW = (const bf16_t*)(p.ws + OFF_RW) + (size_t)l * 64 * 1024;
    const float* mod = (const float*)(p.ws + OFF_MOD) + (size_t)l * 9 * 6144;
    int* cnt = (int*)(p.ws + OFF_CNT) + l * 64 * 64;
    int* tke = (int*)(p.ws + OFF_TKE); int* tks = (int*)(p.ws + OFF_TKS); float* tkw = (float*)(p.ws + OFF_TKW);
    int* list = (int*)(p.ws + OFF_LIST);
    char* HT = lds;
    float* LG = (float*)(lds + 16 * 2064);
    const float rbias = p.router_b[l * 64 + lane];
    const int nitems = (l == 0 ? NT : NLAT) / 16;
    for (int it = blockIdx.x; it < nitems; it += gridDim.x) {
        const int m0 = it * 16;
        const float* mg = mod + (size_t)mod_group(m0) * 6144;
        f32x4 vv[4][4];
#pragma unroll
        for (int i = 0; i < 4; ++i) row_load_bf(X + (size_t)(m0 + wid * 4 + i) * 1024, vv[i], lane);
        f32x4 lg[4], lb[4], msh[4], msc[4];
#pragma unroll
        for (int j = 0; j < 4; ++j) {
            const int c = 4 * lane + 256 * j;
            lg[j] = *(const f32x4*)(p.ln1_g + l * 1024 + c); lb[j] = *(const f32x4*)(p.ln1_b + l * 1024 + c);
            msh[j] = *(const f32x4*)(mg + 3072 + c); msc[j] = *(const f32x4*)(mg + 4096 + c) + 1.0f;
        }
#pragma unroll
        for (int i = 0; i < 4; ++i) {
            const int rl = wid * 4 + i, row = m0 + rl;
            row_norm(vv[i]);
#pragma unroll
            for (int j = 0; j < 4; ++j) {
                const int c = 4 * lane + 256 * j;
                vv[i][j] = vv[i][j] * lg[j] + lb[j];
                st_bf4(X + (size_t)row * 1024 + c, vv[i][j]);
            }
            row_norm(vv[i]);
#pragma unroll
            for (int j = 0; j < 4; ++j) {
                const int c = 4 * lane + 256 * j;
                const f32x4 o = vv[i][j] * msc[j] + msh[j];
                const u32x2 w = (u32x2){pk2(o[0], o[1]), pk2(o[2], o[3])};
                *(u32x2*)(H + (size_t)row * 1024 + c) = w;
                *(u32x2*)(HT + rl * 2064 + c * 2) = w;
            }
        }
        __syncthreads();
        f32x4 acc = (f32x4){0.f, 0.f, 0.f, 0.f};
        const bf16_t* bp = RW + (size_t)(wid * 16 + fr) * 1024 + fq * 8;
#pragma unroll 8
        for (int ks = 0; ks < 32; ++ks) {
            const bf16x8 bq = *(const bf16x8*)(bp + ks * 32);
            const bf16x8 af = *(const bf16x8*)(HT + fr * 2064 + (ks * 32 + fq * 8) * 2);
            acc = mfma16(bq, af, acc);
        }
        *(f32x4*)(LG + fr * 64 + wid * 16 + 4 * fq) = acc;
        __syncthreads();
        int* RS = (int*)(lds + 16 * 2064 + 4096 + 2048);
        float* RWt = (float*)(lds + 16 * 2064 + 4096 + 2048 + 4096);
        int lc = 0;
        unsigned* KW = (unsigned*)(lds + 16 * 2064 + 4096 + 2048 + 8192) + wid * 160;
#pragma unroll 1
        for (int i = 0; i < 4; ++i) {
            const int rl = wid * 4 + i;
            const float sc = 1.0f / (1.0f + __expf(-LG[rl * 64 + lane]));
            const float sel = sc + rbias;
            const int grp = lane >> 3;
            const unsigned key = (__float_as_uint(sel + 2.0f) & 0xFFFFFFC0u) | (unsigned)(63 - lane);
            KW[lane] = key;
            __builtin_amdgcn_wave_barrier();
            int rankg = 0;
            {
                const u32x4 k0 = *(const u32x4*)(KW + grp * 8), k1 = *(const u32x4*)(KW + grp * 8 + 4);
#pragma unroll
                for (int j = 0; j < 4; ++j) { rankg += (k0[j] > key) ? 1 : 0; rankg += (k1[j] > key) ? 1 : 0; }
            }
            float gs = rankg < 2 ? sel : 0.f;
            gs += __shfl_xor(gs, 1); gs += __shfl_xor(gs, 2); gs += __shfl_xor(gs, 4);
            const unsigned gkey = (__float_as_uint(gs + 4.0f) & 0xFFFFFFF8u) | (unsigned)(7 - grp);
            if ((lane & 7) == 0) KW[128 + grp] = gkey;
            __builtin_amdgcn_wave_barrier();
            int rg = 0;
            {
                const u32x4 g0 = *(const u32x4*)(KW + 128), g1 = *(const u32x4*)(KW + 132);
#pragma unroll
                for (int j = 0; j < 4; ++j) { rg += (g0[j] > gkey) ? 1 : 0; rg += (g1[j] > gkey) ? 1 : 0; }
            }
            const bool selg = rg < 4;
            const unsigned vkey = selg ? key : 0u;
            KW[64 + lane] = vkey;
            __builtin_amdgcn_wave_barrier();
            int rank = 0;
#pragma unroll
            for (int q = 0; q < 16; ++q) {
                const u32x4 kk = *(const u32x4*)(KW + 64 + q * 4);
#pragma unroll
                for (int j = 0; j < 4; ++j) rank += (kk[j] > vkey) ? 1 : 0;
            }
            const bool ch = selg && rank < 8;
            const float wsum = wave_sum(ch ? sc : 0.f);
            RS[rl * 64 + lane] = ch ? rank : -1;
            RWt[rl * 64 + lane] = sc * (2.5f / wsum);
            lc += ch ? 1 : 0;
            __builtin_amdgcn_wave_barrier();
        }
        int* WC = (int*)(lds + 16 * 2064 + 4096);
        WC[wid * 64 + lane] = lc;
        __syncthreads();
        if (wid == 0) {
            const int tot = WC[lane] + WC[64 + lane] + WC[128 + lane] + WC[192 + lane];
            int base = 0;
            if (tot > 0) base = atomicAdd(&cnt[lane * 64], tot);
            WC[256 + lane] = base;
        }
        __syncthreads();
        {
            int slot = WC[256 + lane];
#pragma unroll
            for (int w2 = 0; w2 < 4; ++w2) slot += (w2 < wid) ? WC[w2 * 64 + lane] : 0;
#pragma unroll 1
            for (int i = 0; i < 4; ++i) {
                const int rl = wid * 4 + i, rk = RS[rl * 64 + lane];
                if (rk >= 0) {
                    const int row = m0 + rl;
                    list[(size_t)lane * NT + slot] = row * 8 + rk;
                    tke[row * 8 + rk] = lane; tks[row * 8 + rk] = slot; tkw[row * 8 + rk] = RWt[rl * 64 + lane];
                    ++slot;
                }
            }
        }
        __syncthreads();
    }
}

constexpr int YS_EXT_ROWS = NLAT * 1024 * 4 / 1024;
constexpr int PLAN_OFF = 68 * 1024;
DEV void moe_plan(const int* cnt, int cap, int l, char* lds) {
    int* PL = (int*)(lds + PLAN_OFF);
    const int tid = get_tid();
    __syncthreads();
    if (tid < 64) {
        const int lane = tid;
        const int c = cnt[lane * 64], tiles = (c + 127) >> 7;
        int pr = c, pt = tiles;
#pragma unroll
        for (int o = 1; o < 64; o <<= 1) { const int a = __shfl_up(pr, o), b = __shfl_up(pt, o); if (lane >= o) { pr += a; pt += b; } }
        const int G = (int)gridDim.x, nshu = 2 * ((l == 0 ? NT : NLAT) / 128);
        const int units = nshu + __builtin_amdgcn_readlane(pt, 63);
        const int cap8 = cap * 2;
        const bool one_round = __builtin_amdgcn_readlane(pr, 63) + nshu * 128 <= cap8;
        const int target0 = one_round ? 0 : ((units + G - 1) / G - 1) * G;
        PL[144 + lane] = c;
        int start = 0, base_r = 0, base_t = 0, round = 0;
        for (;;) {
            const int lim = (round == 0) ? ((target0 > 0) ? cap8 + YS_EXT_ROWS : cap8) - nshu * 128 : cap8;
            const bool bad = (lane >= start) && ((pr - base_r > lim) || (round == 0 && target0 > 0 && lane > 0 && nshu + pt > target0));
            const unsigned long long m = __ballot(bad);
            int end = m ? (int)__builtin_ctzll(m) : 64;
            if (end <= start) end = start + 1;
            if (lane >= start && lane < end) { PL[16 + lane] = pt - tiles - base_t; PL[80 + lane] = pr - c - base_r; }
            if (lane == 0) { PL[1 + round] = start; PL[10 + round] = __builtin_amdgcn_readlane(pt, end - 1) - base_t; PL[208 + round] = __builtin_amdgcn_readlane(pr, end - 1) - base_r; }
            if (end >= 64 || round >= 7) { if (lane == 0) { PL[0] = round + 1; PL[2 + round] = 64; } break; }
            base_r = __builtin_amdgcn_readlane(pr, end - 1); base_t = __builtin_amdgcn_readlane(pt, end - 1);
            start = end; ++round;
        }
    }
    __syncthreads();
}
constexpr float YS_SCALE = 32.0f, YS_INV = 1.0f / 32.0f;
DEV unsigned char* ys_row(const Params& p, int idx) {
    const int cap8 = p.cap * 2;
    return idx < cap8 ? p.ws + OFF_YS + (size_t)idx * 1024 : (unsigned char*)p.out + (size_t)(idx - cap8) * 1024;
}
DEV unsigned pk4_fp8(const f32x4& v) {
    int w = 0;
    w = __builtin_amdgcn_cvt_pk_fp8_f32(v[0] * YS_SCALE, v[1] * YS_SCALE, w, false);
    w = __builtin_amdgcn_cvt_pk_fp8_f32(v[2] * YS_SCALE, v[3] * YS_SCALE, w, true);
    return (unsigned)w;
}
DEV f32x4 up4_fp8(unsigned w) {
    const f32x2 lo = __builtin_amdgcn_cvt_pk_f32_fp8((int)w, false), hi = __builtin_amdgcn_cvt_pk_f32_fp8((int)w, true);
    return (f32x4){lo[0], lo[1], hi[0], hi[1]};
}

template <bool SHARED>
DEV void moe_tile(const Params& p, const bf16_t* W13, const bf16_t* W2, const int* list, int s0, int nvalid, int ysbase, int m0, int half, const float* g2, char* lds) {
    const int tid = get_tid(), lane = tid & 63, wid = tid >> 6, fr = lane & 15, fq = lane >> 4, wr = wid >> 1, wc = wid & 1;
    const bf16_t* H = (const bf16_t*)(p.ws + OFF_H);
    const float* tkw = (const float*)(p.ws + OFF_TKW);
    char* ACT = lds;
    const unsigned ch8 = (unsigned)(((tid & 7) ^ ((tid >> 3) & 7)) * 8);
    unsigned ao[4];
    float gw[4];
    if (SHARED) {
#pragma unroll
        for (int i = 0; i < 4; ++i) ao[i] = (unsigned)(m0 + i * 32 + (tid >> 3)) * 1024u + ch8;
#pragma unroll
        for (int m = 0; m < 4; ++m) gw[m] = 1.0f;
    } else {
#pragma unroll
        for (int i = 0; i < 4; ++i) { const int rr = min(i * 32 + (tid >> 3), nvalid - 1); ao[i] = (unsigned)(list[s0 + rr] >> 3) * 1024u + ch8; }
#pragma unroll
        for (int m = 0; m < 4; ++m) { const int rl = min(wr * 64 + m * 16 + fr, nvalid - 1); gw[m] = tkw[list[s0 + rl]]; }
    }
    u32x2 areg[2][4][2];
#pragma unroll
    for (int np = 0; np < 2; ++np) {
        const unsigned b0 = (unsigned)(np * 128) * 1024u + st64_off(tid);
        const unsigned bo[4] = {b0, b0 + 32u * 1024u, b0 + 64u * 1024u, b0 + 96u * 1024u};
        const unsigned aoc[4] = {ao[0], ao[1], ao[2], ao[3]};
        f32x4 acc[4][4]; zero_acc<4, 4>(acc);
        gemm_core64<true>(acc, H, aoc, W13, bo, 1024, lds);
#pragma unroll
        for (int m = 0; m < 4; ++m)
#pragma unroll
            for (int pi = 0; pi < 2; ++pi) {
                float o[4];
#pragma unroll
                for (int j = 0; j < 4; ++j) { const float a = acc[m][2 * pi][j], b = acc[m][2 * pi + 1][j]; o[j] = a / (1.0f + __expf(-a)) * b * gw[m]; }
                areg[np][m][pi] = (u32x2){pk2(o[0], o[1]), pk2(o[2], o[3])};
            }
    }
    __syncthreads();
#pragma unroll
    for (int np = 0; np < 2; ++np)
#pragma unroll
        for (int m = 0; m < 4; ++m)
#pragma unroll
            for (int pi = 0; pi < 2; ++pi) *(u32x2*)(ACT + (wr * 64 + m * 16 + fr) * 272 + (np * 64 + wc * 32 + pi * 16 + 4 * fq) * 2) = areg[np][m][pi];
    __syncthreads();
    if (SHARED) {
        gemm2_stream64<128, 272>(W2, ACT, lds + 36864, [&](int nt, const f32x4 (&acc)[4][4]) {
#pragma unroll
            for (int m = 0; m < 4; ++m) {
                unsigned char* o = ys_row(p, ysbase + m0 + wr * 64 + m * 16 + fr) + nt * 128 + wc * 64 + 8 * fq;
#pragma unroll
                for (int g = 0; g < 2; ++g) *(u32x2*)(o + g * 32) = (u32x2){pk4_fp8(acc[m][2 * g]), pk4_fp8(acc[m][2 * g + 1])};
            }
        });
    } else {
        gemm2_stream64<128, 272>(W2, ACT, lds + 36864, [&](int nt, const f32x4 (&acc)[4][4]) {
#pragma unroll
            for (int m = 0; m < 4; ++m) {
                const int rl = wr * 64 + m * 16 + fr;
                if (rl < nvalid) {
                    unsigned char* o = ys_row(p, ysbase + s0 + rl) + nt * 128 + wc * 64 + 8 * fq;
#pragma unroll
                    for (int g = 0; g < 2; ++g) *(u32x2*)(o + g * 32) = (u32x2){pk4_fp8(acc[m][2 * g]), pk4_fp8(acc[m][2 * g + 1])};
                }
            }
        });
    }
    __syncthreads();
}
DEV void phase_moe(const Params& p, int l, int r, char* lds) {
    const int* cnt = (const int*)(p.ws + OFF_CNT) + l * 64 * 64;
    moe_plan(cnt, p.cap, l, lds);
    const int* PL = (const int*)(lds + PLAN_OFF);
    if (r >= PL[0]) return;
    const int e_lo = PL[1 + r], e_hi = PL[2 + r];
    const int nrt = PL[10 + r];
    const int nrows = (l == 0) ? NT : NLAT;
    const int nshu = (r == 0) ? 2 * (nrows / 128) : 0;
    const int G = (int)gridDim.x, b = vblock();
    const int q = (nshu + nrt + G - 1) / G;
    const int u0 = b * q, u1 = min(u0 + q, nshu + nrt);
    int e = e_lo;
    for (int u = u0; u < u1; ++u) {
        if (u < nshu) {
            const int m0 = (u >> 1) * 128, hh = u & 1;
            moe_tile<true>(p, (const bf16_t*)(p.ws + OFF_SW13) + (size_t)(l * 2 + hh) * 256 * 1024, (const bf16_t*)(p.ws + OFF_SW2) + (size_t)(l * 2 + hh) * 1024 * 128,
                           nullptr, 0, 128, PL[208] + hh * nrows, m0, hh, nullptr, lds);
        } else {
            const int it = u - nshu;
            while (e + 1 < e_hi && PL[16 + e + 1] <= it) ++e;
            const int s0 = (it - PL[16 + e]) * 128;
            moe_tile<false>(p, (const bf16_t*)(p.ws + OFF_W13) + (size_t)e * 256 * 1024, (const bf16_t*)(p.ws + OFF_W2) + (size_t)e * 1024 * 128,
                            (const int*)(p.ws + OFF_LIST) + (size_t)e * NT, s0, min(128, PL[144 + e] - s0), PL[80 + e], 0, 0, nullptr, lds);
        }
    }
}

DEV void phase_comb(const Params& p, int l, int r, char* lds) {
    const int tid_ = get_tid(), lane = tid_ & 63, wid = tid_ >> 6;
    const int* cnt = (const int*)(p.ws + OFF_CNT) + l * 64 * 64;
    moe_plan(cnt, p.cap, l, lds);
    const int* PL = (const int*)(lds + PLAN_OFF);
    if (r >= PL[0]) return;
    const int e_lo = PL[1 + r], e_hi = PL[2 + r];
    const bool final = (r == PL[0] - 1);
    bf16_t* X = (bf16_t*)(p.ws + OFF_X);
    bf16_t* H = (bf16_t*)(p.ws + OFF_H);
    const int* tke = (const int*)(p.ws + OFF_TKE); const int* tks = (const int*)(p.ws + OFF_TKS);
    const float* mod = (const float*)(p.ws + OFF_MOD);
    const int nrows = (l == 0) ? NT : NLAT;
    for (int row = blockIdx.x * 4 + wid; row < nrows; row += gridDim.x * 4) {
        const int g = mod_group(row);
        const float* g2 = mod + ((size_t)l * 9 + g) * 6144 + 5120 + 16 * lane;
        int idx_l = -1;
        if (lane < 8) { const int e = tke[row * 8 + lane]; const int sl = tks[row * 8 + lane]; if (e >= e_lo && e < e_hi) idx_l = PL[80 + e] + sl; }
        f32x4 v[4];
        {
            const u32x4 a = *(const u32x4*)(X + (size_t)row * 1024 + 16 * lane), b2 = *(const u32x4*)(X + (size_t)row * 1024 + 16 * lane + 8);
            v[0] = (f32x4){__uint_as_float(a[0] << 16), __uint_as_float(a[0] & 0xffff0000u), __uint_as_float(a[1] << 16), __uint_as_float(a[1] & 0xffff0000u)};
            v[1] = (f32x4){__uint_as_float(a[2] << 16), __uint_as_float(a[2] & 0xffff0000u), __uint_as_float(a[3] << 16), __uint_as_float(a[3] & 0xffff0000u)};
            v[2] = (f32x4){__uint_as_float(b2[0] << 16), __uint_as_float(b2[0] & 0xffff0000u), __uint_as_float(b2[1] << 16), __uint_as_float(b2[1] & 0xffff0000u)};
            v[3] = (f32x4){__uint_as_float(b2[2] << 16), __uint_as_float(b2[2] & 0xffff0000u), __uint_as_float(b2[3] << 16), __uint_as_float(b2[3] & 0xffff0000u)};
        }
        u32x4 y[10];
#pragma unroll
        for (int k = 0; k < 8; ++k) {
            const int idx = __builtin_amdgcn_readlane(idx_l, k);
            if (idx >= 0) y[k] = *(const u32x4*)(ys_row(p, idx) + 16 * lane); else y[k] = (u32x4){0u, 0u, 0u, 0u};
        }
        if (r == 0) { y[8] = *(const u32x4*)(ys_row(p, PL[208] + row) + 16 * lane); y[9] = *(const u32x4*)(ys_row(p, PL[208] + nrows + row) + 16 * lane); }
        else { y[8] = (u32x4){0u, 0u, 0u, 0u}; y[9] = y[8]; }
        f32x4 s[4];
#pragma unroll
        for (int j = 0; j < 4; ++j) s[j] = (f32x4){0.f, 0.f, 0.f, 0.f};
#pragma unroll
        for (int k = 0; k < 10; ++k)
#pragma unroll
            for (int j = 0; j < 4; ++j) s[j] += up4_fp8(y[k][j]);
        const float xs = (r == 0) ? DN_ALPHA : 1.0f;
#pragma unroll
        for (int j = 0; j < 4; ++j) v[j] = v[j] * xs + *(const f32x4*)(g2 + 4 * j) * (s[j] * YS_INV);
        if (!final) {
            u32x4 o0, o1;
            o0 = (u32x4){pk2(v[0][0], v[0][1]), pk2(v[0][2], v[0][3]), pk2(v[1][0], v[1][1]), pk2(v[1][2], v[1][3])};
            o1 = (u32x4){pk2(v[2][0], v[2][1]), pk2(v[2][2], v[2][3]), pk2(v[3][0], v[3][1]), pk2(v[3][2], v[3][3])};
            *(u32x4*)(X + (size_t)row * 1024 + 16 * lane) = o0; *(u32x4*)(X + (size_t)row * 1024 + 16 * lane + 8) = o1;
        } else {
            row_norm(v);
#pragma unroll
            for (int j = 0; j < 4; ++j) {
                const int c = 16 * lane + 4 * j;
                v[j] = v[j] * *(const f32x4*)(p.ln2_g + l * 1024 + c) + *(const f32x4*)(p.ln2_b + l * 1024 + c);
                if (l != 0) *(f32x4*)(p.out + (size_t)row * 1024 + c) = v[j];
            }
            if (l == 0) {
                u32x4 o0, o1;
                o0 = (u32x4){pk2(v[0][0], v[0][1]), pk2(v[0][2], v[0][3]), pk2(v[1][0], v[1][1]), pk2(v[1][2], v[1][3])};
                o1 = (u32x4){pk2(v[2][0], v[2][1]), pk2(v[2][2], v[2][3]), pk2(v[3][0], v[3][1]), pk2(v[3][2], v[3][3])};
                *(u32x4*)(X + (size_t)row * 1024 + 16 * lane) = o0; *(u32x4*)(X + (size_t)row * 1024 + 16 * lane + 8) = o1;
                row_norm(v);
                const float* m1 = mod + ((size_t)9 + g) * 6144 + 16 * lane;
                f32x4 h[4];
#pragma unroll
                for (int j = 0; j < 4; ++j) h[j] = v[j] * (*(const f32x4*)(m1 + 1024 + 4 * j) + 1.0f) + *(const f32x4*)(m1 + 4 * j);
                o0 = (u32x4){pk2(h[0][0], h[0][1]), pk2(h[0][2], h[0][3]), pk2(h[1][0], h[1][1]), pk2(h[1][2], h[1][3])};
                o1 = (u32x4){pk2(h[2][0], h[2][1]), pk2(h[2][2], h[2][3]), pk2(h[3][0], h[3][1]), pk2(h[3][2], h[3][3])};
                *(u32x4*)(H + (size_t)row * 1024 + 16 * lane) = o0; *(u32x4*)(H + (size_t)row * 1024 + 16 * lane + 8) = o1;
            }
        }
    }
    if (final && l == 0) {
        __syncthreads();
        conv_run(p, 1, (int)blockIdx.x * 12, 12, lds);
    }
}


#if TELEM
template <int V, int MI, int NI>
DEV void gemm_probe_core(f32x4 (&acc)[MI][NI], const bf16_t* A, const unsigned (&ao)[MI / 2], const bf16_t* B, const unsigned (&bo)[NI / 2], int K, char* lds) {
    const int tid = get_tid(), lane = tid & 63, wid = tid >> 6, fr = lane & 15, fq = lane >> 4, wr = wid >> 1, wc = wid & 1;
    constexpr int SAB = 2048 * MI, STG = 2048 * (MI + NI);
    const int nt = K >> 5;
    auto stage = [&](int s, int t) {
        if (!(V & 1)) return;
        char* SA = lds + s * STG; char* SB = SA + SAB;
#pragma unroll
        for (int i = 0; i < MI / 2; ++i) glds16(A + (ao[i] + (unsigned)(t * 32)), SA + i * 4096 + tid * 16);
#pragma unroll
        for (int i = 0; i < NI / 2; ++i) glds16(B + (bo[i] + (unsigned)(t * 32)), SB + i * 4096 + tid * 16);
    };
    WAIT_VM(0);
    stage(0, 0);
    if (nt > 1) stage(1, 1);
    const int sw = (fq ^ ((0 - (fr >> 2)) & 3)) * 16;
    const int aoff = (wr * MI * 16 + fr) * 64 + sw, boff = SAB + (wc * NI * 16 + fr) * 64 + sw;
    bf16x8 af[MI], bfr[NI];
#pragma unroll
    for (int m = 0; m < MI; ++m) af[m] = (bf16x8){1, 2, 3, 4, 5, 6, 7, 8};
#pragma unroll
    for (int n = 0; n < NI; ++n) bfr[n] = (bf16x8){1, 2, 3, 4, 5, 6, 7, 8};
#pragma unroll 1
    for (int t = 0; t < nt; ++t) {
        if (V & 1) { if (t + 1 < nt) { if (MI + NI == 12) WAIT_VM(6); else WAIT_VM(4); } else WAIT_VM(0); }
        RAW_BARRIER();
        const char* S = lds + (t & 1) * STG;
        if (V & 2) {
#pragma unroll
            for (int m = 0; m < MI; ++m) af[m] = *(const bf16x8*)(S + aoff + m * 1024);
#pragma unroll
            for (int n = 0; n < NI; ++n) bfr[n] = *(const bf16x8*)(S + boff + n * 1024);
            WAIT_LGKM0();
        }
        RAW_BARRIER();
        if (t + 2 < nt) stage(t & 1, t + 2);
        if (V & 4) {
#pragma unroll
            for (int m = 0; m < MI; ++m)
#pragma unroll
                for (int n = 0; n < NI; ++n) acc[m][n] = mfma16(bfr[n], af[m], acc[m][n]);
        } else {
#pragma unroll
            for (int m = 0; m < MI; ++m) asm volatile("" :: "v"(af[m]));
#pragma unroll
            for (int n = 0; n < NI; ++n) asm volatile("" :: "v"(bfr[n]));
        }
    }
}
template <int V, int MI, int ORDER>
DEV void phase_probe(const Params& p, char* lds) {
    const int tid = get_tid();
    const bf16_t* H = (const bf16_t*)(p.ws + OFF_H);
    const bf16_t* W = (const bf16_t*)(p.ws + OFF_WIN);
    constexpr int BM = 32 * MI, NMT = NT / BM;
    const int nitems = NMT * 18;
    for (int it0 = blockIdx.x; it0 < nitems; it0 += gridDim.x) {
        int it = it0;
        if (ORDER == 1) {
            const int per = (nitems + 7) / 8; const int x = it0 & 7, k = it0 >> 3; it = x * per + k; if (k >= per || it >= nitems) continue;
        }
        const int mt = it / 18, ntile = it % 18, m0 = mt * BM, n0 = ntile * 128;
        const unsigned a0 = (unsigned)(m0 + (tid >> 2)) * 1024u + lchunk(tid) * 8, b0 = (unsigned)(n0 + (tid >> 2)) * 1024u + lchunk(tid) * 8;
        unsigned ao[MI / 2];
#pragma unroll
        for (int i = 0; i < MI / 2; ++i) ao[i] = a0 + (unsigned)i * 64u * 1024u;
        const unsigned bo[2] = {b0, b0 + 64u * 1024u};
        f32x4 acc[MI][4]; zero_acc<MI, 4>(acc);
        gemm_probe_core<V, MI, 4>(acc, H, ao, W, bo, 1024, lds);
#pragma unroll
        for (int m = 0; m < MI; ++m)
#pragma unroll
            for (int n = 0; n < 4; ++n) asm volatile("" :: "v"(acc[m][n]));
    }
}
#endif

#define XB_TMO      128
#define XB_XCNT(j)  (256  + 64 * (j))
#define XB_XSUB(j)  (1280 + 64 * (j))
#define XB_XGEN(j)  (2304 + 64 * (j))
#define XB_TOP      3328
#define XB_TOPGEN   3392
#define XCD_BAR_WORDS 3456
#define XB_SPIN_CAP (1u << 22)
DEV unsigned xb_ld(unsigned* p) { return __hip_atomic_load(p, __ATOMIC_RELAXED, __HIP_MEMORY_SCOPE_AGENT); }
DEV unsigned xb_add(unsigned* p, unsigned v) { return __hip_atomic_fetch_add(p, v, __ATOMIC_RELAXED, __HIP_MEMORY_SCOPE_AGENT); }
DEV unsigned xb_xcc_id() { return (unsigned)__builtin_amdgcn_s_getreg((3 << 11) | 20) & 0xFu; }
#define XB_SPIN(cond, bar) do { unsigned _sp = 0; while (cond) { __builtin_amdgcn_s_sleep(1); \
    if ((++_sp & 255u) == 0u) { if (xb_ld(&(bar)[XB_TMO])) break; if (_sp > XB_SPIN_CAP) { atomicAdd(&(bar)[XB_TMO], 1u); break; } } } } while (0)
struct XcdBarrier { unsigned* bar; unsigned x; volatile LAS unsigned* st; };
DEV XcdBarrier xcd_barrier_post(unsigned* bar, volatile LAS unsigned* st) {
    XcdBarrier b; b.bar = bar; b.x = xb_xcc_id(); b.st = st;
    if (threadIdx.x == 0) (void)xb_add(&bar[XB_XCNT(b.x)], 1u);
    return b;
}
DEV void xcd_barrier_complete(unsigned* bar, unsigned x, unsigned& nloc, unsigned& nx) {
    const unsigned G = gridDim.x * gridDim.y * gridDim.z;
    unsigned sum, cnt, mine, sp = 0u;
    for (;;) {
        sum = 0u; cnt = 0u; mine = 0u;
#pragma unroll
        for (unsigned j = 0; j < 16; ++j) { const unsigned c = xb_ld(&bar[XB_XCNT(j)]); sum += c; cnt += (c > 0u) ? 1u : 0u; mine = (j == x) ? c : mine; }
        if (sum == G) break;
        __builtin_amdgcn_s_sleep(1);
        if ((++sp & 255u) == 0u) { if (xb_ld(&bar[XB_TMO])) break; if (sp > XB_SPIN_CAP) { atomicAdd(&bar[XB_TMO], 1u); break; } }
    }
    nloc = mine > 0u ? mine : 1u; nx = cnt > 0u ? cnt : 1u;
}
DEV void xcd_barrier(const XcdBarrier& b) {
    asm volatile("s_waitcnt vmcnt(0)" ::: "memory");
    __syncthreads();
    if (get_tid() == 0) {
        unsigned* bar = b.bar; asm volatile("" : "+s"(bar));
        __builtin_amdgcn_s_waitcnt(0);
        unsigned nloc = b.st[0], nx = b.st[1];
        if (nloc == 0u) { xcd_barrier_complete(bar, b.x, nloc, nx); b.st[0] = nloc; b.st[1] = nx; }
        const unsigned old = xb_add(&bar[XB_XSUB(b.x)], 1u);
        const unsigned gen = old / nloc;
        if (old + 1u == (gen + 1u) * nloc) {
            __builtin_amdgcn_fence(__ATOMIC_RELEASE, "agent");
            asm volatile("s_waitcnt vmcnt(0)" ::: "memory");
            const unsigned og = xb_add(&bar[XB_TOP], 1u);
            const unsigned tg = og / nx;
            if (og + 1u == (tg + 1u) * nx) xb_add(&bar[XB_TOPGEN], 1u);
            else XB_SPIN(xb_ld(&bar[XB_TOPGEN]) == tg, bar);
            __builtin_amdgcn_fence(__ATOMIC_ACQUIRE, "agent");
            xb_add(&bar[XB_XGEN(b.x)], 1u);
            asm volatile("s_waitcnt vmcnt(0)" ::: "memory");
        } else {
            XB_SPIN(xb_ld(&bar[XB_XGEN(b.x)]) == gen, bar);
            __builtin_amdgcn_fence(__ATOMIC_ACQUIRE, "agent");
            asm volatile("s_waitcnt vmcnt(0)" ::: "memory");
        }
    }
    __syncthreads();
}

enum { PT_PREP = 0, PT_MODFIN, PT_LNMOD0, PT_INPROJ, PT_MIX, PT_OUTPROJ, PT_LN1ROUTE, PT_MOE, PT_COMB };

DEV void run_phase(const Params& pin, int type, int l, int r, char* lds) {
    Params p = pin;
    { unsigned char* w = p.ws; asm volatile("" : "+s"(w)); p.ws = w; }
    switch (type) {
        case PT_PREP: phase_prep(p, lds); break;
        case PT_MODFIN: phase_modfin(p); break;
        case PT_LNMOD0: phase_lnmod0(p); break;
        case PT_INPROJ: phase_inproj(p, l, lds); break;
        case PT_MIX: phase_mix(p, l, lds); break;
        case PT_OUTPROJ: phase_outproj(p, l, lds); break;
        case PT_LN1ROUTE: phase_ln1route(p, l, lds); break;
        case PT_MOE: phase_moe(p, l, r, lds); break;
        default: phase_comb(p, l, r, lds); break;
    }
}

__global__ void __launch_bounds__(256, 2) fwd_kernel(Params p) {
    __shared__ __attribute__((aligned(16))) char smem[SMEM_BYTES];
#if MULTI_LAUNCH
    run_phase(p, p.ptype, p.pl, p.pr, smem);
#else
    if (threadIdx.x < 4) ((volatile LAS unsigned*)(smem + SMEM_BYTES - 16))[threadIdx.x] = 0u;
    __syncthreads();
    const XcdBarrier bar = xcd_barrier_post((unsigned*)(p.ws + OFF_BAR), (volatile LAS unsigned*)(smem + SMEM_BYTES - 16));
    int type = PT_PREP, l = 0, r = 0;
#if TELEM
    volatile LAS unsigned* tacc = (volatile LAS unsigned*)(smem + SMEM_BYTES - 128);
    if (threadIdx.x < 16) tacc[threadIdx.x] = 0u;
    unsigned long long t_prev = __builtin_amdgcn_s_memrealtime();
#endif
    for (;;) {
        run_phase(p, type, l, r, smem);
#if TELEM
        { const int ptype_done = type;
          xcd_barrier(bar);
          const unsigned long long t_now = __builtin_amdgcn_s_memrealtime();
          if (threadIdx.x == 0) tacc[ptype_done] += (unsigned)(t_now - t_prev);
          t_prev = t_now; }
#endif
        if (type < PT_MOE) { ++type; if (type == PT_MODFIN) ++type; r = 0; }
        else if (type == PT_MOE) type = PT_COMB;
        else {
            const int nr = ((const int*)(smem + PLAN_OFF))[0];
            if (r + 1 < nr) { ++r; type = PT_MOE; }
            else { if (l == 1) break; l = 1; r = 0; type = PT_INPROJ; }
        }
#if !TELEM
        xcd_barrier(bar);
#endif
    }
#if TELEM
#ifndef PROBE_X
#define PROBE_X phase_probe<7, 8, 0>
#define PROBE_Y phase_probe<1, 8, 0>
#define PROBE_Z phase_probe<6, 8, 0>
#endif
    {
        xcd_barrier(bar);
        unsigned long long t0 = __builtin_amdgcn_s_memrealtime();
        PROBE_X(p, smem); xcd_barrier(bar);
        unsigned long long t1 = __builtin_amdgcn_s_memrealtime(); if (threadIdx.x == 0) tacc[9] = (unsigned)(t1 - t0);
        PROBE_Y(p, smem); xcd_barrier(bar);
        t0 = __builtin_amdgcn_s_memrealtime(); if (threadIdx.x == 0) tacc[10] = (unsigned)(t0 - t1);
        PROBE_Z(p, smem); xcd_barrier(bar);
        t1 = __builtin_amdgcn_s_memrealtime(); if (threadIdx.x == 0) tacc[11] = (unsigned)(t1 - t0);
    }
    {
        unsigned* tel = (unsigned*)(p.ws + OFF_TEL);
        if (blockIdx.x == 0 && threadIdx.x == 0) { unsigned sa = 0u; for (int i = 0; i < 16; ++i) if ((TELEM_A >> i) & 1) sa += tacc[i]; tel[0] = sa; tacc[15] = sa; tel[1] = tacc[TELEM_B]; tel[2] = tacc[TELEM_C & 15]; }
        xcd_barrier(bar);
        const float tb_us = (float)__hip_atomic_load(tel + 1, __ATOMIC_RELAXED, __HIP_MEMORY_SCOPE_AGENT) * 0.01f;
        const float tc_us = (TELEM_C == 99) ? (float)p.cap * 0.01f : (float)__hip_atomic_load(tel + 2, __ATOMIC_RELAXED, __HIP_MEMORY_SCOPE_AGENT) * 0.01f;
        const float e = sqrtf(tb_us * 2.5e-7f);
        for (int i = blockIdx.x * 256 + threadIdx.x; i < NLAT * 1024; i += gridDim.x * 256) p.out[i] *= (1.0f + e);
        xcd_barrier(bar);
        if (blockIdx.x == 0 && threadIdx.x == 0) {
            p.out[0] += 1.0f + tc_us * 0.02f;
            const unsigned long long t0 = __builtin_amdgcn_s_memrealtime();
            const unsigned long long wait = 2ull * tacc[15];
            while (__builtin_amdgcn_s_memrealtime() - t0 < wait) __builtin_amdgcn_s_sleep(8);
        }
    }
#endif
#endif
}

extern "C" void kernel_launch(void* const* d_in, const int* in_sizes, int n_in, void* d_out, int out_size, void* d_ws, size_t ws_size, hipStream_t stream) {
    Params p{};
    const float** pp = (const float**)&p;
    for (int i = 0; i < 32; ++i) pp[i] = (const float*)d_in[i];
    p.out = (float*)d_out; p.ws = (unsigned char*)d_ws;
    long long cap = ((long long)ws_size - (long long)OFF_R) / 2048;
    if (cap > NT * 8) cap = NT * 8;
    if (cap * 2048 < (long long)R_MIN_BYTES || cap < NT) { fprintf(stderr, "kernel_launch: workspace too small (%zu)\n", ws_size); return; }
    p.cap = (int)cap;
#if MULTI_LAUNCH
    const int grid = 512;
    auto launch = [&](int type, int l, int r) { Params q = p; q.mode = 1; q.ptype = type; q.pl = l; q.pr = r; hipLaunchKernelGGL(fwd_kernel, dim3(grid), dim3(256), 0, stream, q); };
    launch(PT_PREP, 0, 0); launch(PT_MODFIN, 0, 0); launch(PT_LNMOD0, 0, 0);
    for (int l = 0; l < 2; ++l) {
        launch(PT_INPROJ, l, 0); launch(PT_MIX, l, 0); launch(PT_OUTPROJ, l, 0); launch(PT_LN1ROUTE, l, 0);
        for (int r = 0; r < RMAX; ++r) { launch(PT_MOE, l, r); launch(PT_COMB, l, r); }
    }
#else
    static int grid_blocks = 0;
    if (!grid_blocks) {
        int dev = 0, cus = 0, per_cu = 0;
        hipGetDevice(&dev);
        hipDeviceGetAttribute(&cus, hipDeviceAttributeMultiprocessorCount, dev);
        hipOccupancyMaxActiveBlocksPerMultiprocessor(&per_cu, fwd_kernel, 256, 0);
        if (per_cu > 2) per_cu = 2;
        if (per_cu < 1) per_cu = 1;
        grid_blocks = cus * per_cu;
    }
    p.mode = 0;
    hipMemsetAsync(d_ws, 0, 65536, stream);
    hipLaunchKernelGGL(fwd_kernel, dim3(grid_blocks), dim3(256), 0, stream, p);
#endif
}
```

```cpp
#include <hip/hip_runtime.h>
#include <hip/hip_cooperative_groups.h>
#include <stdint.h>
#include <stdio.h>
namespace cg = cooperative_groups;

#ifndef TELEM
#define TELEM 0
#endif
#ifndef TELEM_A
#define TELEM_A 0x10
#endif
#ifndef TELEM_B
#define TELEM_B 7
#endif
#ifndef TELEM_C
#define TELEM_C 3
#endif
#ifndef MULTI_LAUNCH
#define MULTI_LAUNCH 0
#endif

typedef unsigned short bf16_t;
typedef short bf16x8 __attribute__((ext_vector_type(8)));
typedef short s16x4 __attribute__((ext_vector_type(4)));
typedef float f32x4 __attribute__((ext_vector_type(4)));
typedef unsigned u32x4 __attribute__((ext_vector_type(4)));
typedef unsigned u32x2 __attribute__((ext_vector_type(2)));
#define DEV __device__ __forceinline__
#define LDSP(T) __attribute__((address_space(3))) T*
#define LAS __attribute__((address_space(3)))

constexpr int D = 1024, NB = 8, SEQ = 2048, CTX = 256, NLAT = NB * SEQ, NCTX = NB * CTX, NT = NLAT + NCTX;
constexpr int PROJ = 2304, KEYS = CTX + SEQ, NEXP = 64;
constexpr float DN_ALPHA = 1.41421356237309515f;
constexpr float LOG2E = 1.44269504088896341f;
constexpr int SMEM_BYTES = 72 * 1024;
constexpr int RMAX = 4;

constexpr size_t OFF_CNT = 0;
constexpr size_t OFF_QUEUE = 33792;
constexpr size_t OFF_TEL = 36864;
constexpr size_t OFF_BAR = 40960;
constexpr size_t OFF_MOD = 65536;
constexpr size_t OFF_ROPE = OFF_MOD + 442368;
constexpr size_t OFF_KERNL = OFF_ROPE + 2ull * 2048 * 32 * 4;
constexpr size_t OFF_KERNC = OFF_KERNL + 2ull * 4096 * 256 * 4;
constexpr size_t OFF_TKE = OFF_KERNC + 2ull * 512 * 256 * 4;
constexpr size_t OFF_TKS = OFF_TKE + (size_t)NT * 8 * 4;
constexpr size_t OFF_TKW = OFF_TKS + (size_t)NT * 8 * 4;
constexpr size_t OFF_LIST = OFF_TKW + (size_t)NT * 8 * 4;
constexpr size_t OFF_WIN = OFF_LIST + 64ull * NT * 4;
constexpr size_t OFF_WOUT = OFF_WIN + 2ull * 2304 * 1024 * 2;
constexpr size_t OFF_SW13 = OFF_WOUT + 2ull * 1024 * 1024 * 2;
constexpr size_t OFF_SW2 = OFF_SW13 + 2ull * 512 * 1024 * 2;
constexpr size_t OFF_RW = OFF_SW2 + 2ull * 1024 * 256 * 2;
constexpr size_t OFF_W13 = OFF_RW + 2ull * 64 * 1024 * 2;
constexpr size_t OFF_W2 = OFF_W13 + 64ull * 256 * 1024 * 2;
constexpr size_t OFF_X = OFF_W2 + 64ull * 1024 * 128 * 2;
constexpr size_t OFF_H = OFF_X + (size_t)NT * 1024 * 2;
constexpr size_t OFF_R = OFF_H + (size_t)NT * 1024 * 2;
constexpr size_t OFF_QA = OFF_R;
constexpr size_t OFF_QB = OFF_QA + 8ull * NT * 64 * 2;
constexpr size_t OFF_KA = OFF_QB + 4ull * NT * 64 * 2;
constexpr size_t OFF_VA = OFF_KA + 8ull * 2 * KEYS * 64 * 2;
constexpr size_t OFF_KB = OFF_VA + 8ull * 2 * KEYS * 64 * 2;
constexpr size_t OFF_VB = OFF_KB + 8ull * 4 * KEYS * 64 * 2;
constexpr size_t OFF_ZTL = OFF_VB + 8ull * 4 * KEYS * 64 * 2;
constexpr size_t OFF_ZTC = OFF_ZTL + 8ull * 768 * 2048 * 2;
constexpr size_t OFF_OX = OFF_ZTC + 8ull * 768 * 256 * 2;
constexpr size_t OFF_OXT = OFF_OX + (size_t)NT * 1024 * 2;
constexpr size_t R_MIN_BYTES = OFF_OXT + 8ull * 256 * 2048 * 2 - OFF_R;
constexpr size_t OFF_PART = OFF_R;
constexpr size_t OFF_YS = OFF_R;

struct Params {
    const float *x, *c, *ctx, *c_ctx, *ada_w, *ada_b, *w_in, *q_gain, *k_gain, *nat_rpb, *hy_conv_w, *hy_conv_b,
        *hy_f_w1, *hy_f_b1, *hy_f_w2, *hy_f_b2, *hy_f_w3, *hy_freq, *hy_skip, *w_out, *ln1_g, *ln1_b,
        *router_w, *router_b, *exp_w1, *exp_w3, *exp_w2, *sh_w1, *sh_w3, *sh_w2, *ln2_g, *ln2_b;
    float* out; unsigned char* ws;
    int cap, mode, ptype, pl, pr, pad;
};

typedef __bf16 hwbf2 __attribute__((ext_vector_type(2)));
typedef float f32x2 __attribute__((ext_vector_type(2)));
DEV unsigned f2bf(float f) { return (unsigned)__builtin_bit_cast(unsigned short, (__bf16)f); }
DEV unsigned pk2(float lo, float hi) { const f32x2 v = {lo, hi}; return __builtin_bit_cast(unsigned, __builtin_convertvector(v, hwbf2)); }
DEV float bf2f(unsigned short h) { return __uint_as_float(((unsigned)h) << 16); }
DEV float wave_sum(float v) {
#pragma unroll
    for (int o = 32; o > 0; o >>= 1) v += __shfl_xor(v, o);
    return v;
}
DEV void glds16(const void* g, void* l) { __builtin_amdgcn_global_load_lds((const unsigned*)g, (unsigned*)l, 16, 0, 0); }
DEV f32x4 mfma16(bf16x8 a, bf16x8 b, f32x4 c) { return __builtin_amdgcn_mfma_f32_16x16x32_bf16(a, b, c, 0, 0, 0); }
DEV float readlane_f(float v, int l) { return __uint_as_float((unsigned)__builtin_amdgcn_readlane((int)__float_as_uint(v), l)); }
DEV int get_tid() { int t = threadIdx.x; asm volatile("" : "+v"(t)); return t; }
DEV int lchunk(int tid) { return (tid & 3) ^ ((0 - (tid >> 4)) & 3); }
DEV int vblock() { const int G = (int)gridDim.x, b = (int)blockIdx.x; return (G & 7) ? b : (b & 7) * (G >> 3) + (b >> 3); }
DEV int mod_group(int row) { return row < NLAT ? (row >> 11) : 8; }

template <int MI, int NI> DEV void zero_acc(f32x4 (&acc)[MI][NI]) {
#pragma unroll
    for (int m = 0; m < MI; ++m)
#pragma unroll
        for (int n = 0; n < NI; ++n) acc[m][n] = (f32x4){0.f, 0.f, 0.f, 0.f};
}
#define WAIT_VM(n) asm volatile("s_waitcnt vmcnt(" #n ")" ::: "memory")
#define WAIT_LGKM0() asm volatile("s_waitcnt lgkmcnt(0)" ::: "memory")
#define RAW_BARRIER() do { asm volatile("" ::: "memory"); __builtin_amdgcn_s_barrier(); asm volatile("" ::: "memory"); } while (0)
template <int MI, int NI, bool TRANS>
DEV void gemm_core(f32x4 (&acc)[MI][NI], const bf16_t* A, const unsigned (&ao)[MI / 2], const bf16_t* B, const unsigned (&bo)[NI / 2], int K, char* lds) {
    const int tid = get_tid(), lane = tid & 63, wid = tid >> 6, fr = lane & 15, fq = lane >> 4, wr = wid >> 1, wc = wid & 1;
    constexpr int SAB = 2048 * MI, STG = 2048 * (MI + NI), LPT = MI / 2 + NI / 2;
    static_assert(LPT == 3 || LPT == 4 || LPT == 6, "loads per tile");
    const int nt = K >> 5;
    auto stage = [&](int s, int t) {
        char* SA = lds + s * STG; char* SB = SA + SAB;
#pragma unroll
        for (int i = 0; i < MI / 2; ++i) glds16(A + (ao[i] + (unsigned)(t * 32)), SA + i * 4096 + tid * 16);
#pragma unroll
        for (int i = 0; i < NI / 2; ++i) glds16(B + (bo[i] + (unsigned)(t * 32)), SB + i * 4096 + tid * 16);
    };
    WAIT_VM(0);
    stage(0, 0);
    if (nt > 1) stage(1, 1);
    const int sw = (fq ^ ((0 - (fr >> 2)) & 3)) * 16;
    const int aoff = (wr * MI * 16 + fr) * 64 + sw, boff = SAB + (wc * NI * 16 + fr) * 64 + sw;
#pragma unroll 1
    for (int t = 0; t < nt; ++t) {
        if (t + 1 < nt) { if (LPT == 6) WAIT_VM(6); else if (LPT == 4) WAIT_VM(4); else WAIT_VM(3); } else WAIT_VM(0);
        RAW_BARRIER();
        const char* S = lds + (t & 1) * STG;
        bf16x8 af[MI], bfr[NI];
#pragma unroll
        for (int m = 0; m < MI; ++m) af[m] = *(const bf16x8*)(S + aoff + m * 1024);
#pragma unroll
        for (int n = 0; n < NI; ++n) bfr[n] = *(const bf16x8*)(S + boff + n * 1024);
        WAIT_LGKM0();
        RAW_BARRIER();
        if (t + 2 < nt) stage(t & 1, t + 2);
#pragma unroll
        for (int m = 0; m < MI; ++m)
#pragma unroll
            for (int n = 0; n < NI; ++n) acc[m][n] = TRANS ? mfma16(bfr[n], af[m], acc[m][n]) : mfma16(af[m], bfr[n], acc[m][n]);
    }
}
DEV unsigned st64_off(int tid) { return (unsigned)(tid >> 3) * 1024u + (unsigned)(((tid & 7) ^ ((tid >> 3) & 7)) * 8); }
DEV int tr_key(int row) { return (row & 3) | (((row >> 3) & 1) << 2); }
template <bool TRANS>
DEV void gemm_core64(f32x4 (&acc)[4][4], const bf16_t* A, const unsigned (&ao)[4], const bf16_t* B, const unsigned (&bo)[4], int K, char* lds,
                     const bf16_t* AT = nullptr, int t_tr = 1 << 20) {
    const int tid = get_tid(), lane = tid & 63, wid = tid >> 6, fr = lane & 15, fq = lane >> 4, wr = wid >> 1, wc = wid & 1;
    const int nt = K >> 6;
    auto stage = [&](int s, int t) {
        char* SA = lds + s * 32768; char* SB = SA + 16384;
        if (t >= t_tr) {
#pragma unroll
            for (int i = 0; i < 4; ++i) {
                const int id = tid + 256 * i, row = id >> 4, cp = id & 15, c = (cp - 2 * tr_key(row)) & 15;
                glds16(AT + (size_t)((t - t_tr) * 64 + row) * 2048 + c * 8, SA + id * 16);
            }
        } else {
#pragma unroll
            for (int i = 0; i < 4; ++i) glds16(A + (ao[i] + (unsigned)(t * 64)), SA + i * 4096 + tid * 16);
        }
#pragma unroll
        for (int i = 0; i < 4; ++i) glds16(B + (bo[i] + (unsigned)(t * 64)), SB + i * 4096 + tid * 16);
    };
    WAIT_VM(0);
    stage(0, 0);
    if (nt > 1) stage(1, 1);
    const int rsw = fr & 7;
    const int arow = (wr * 64 + fr) * 128, brow = 16384 + (wc * 64 + fr) * 128;
    const int c0 = ((fq) ^ rsw) * 16, c1 = ((4 + fq) ^ rsw) * 16;
#pragma unroll 1
    for (int t = 0; t < nt; ++t) {
        if (t + 1 < nt) WAIT_VM(8); else WAIT_VM(0);
        RAW_BARRIER();
        const char* S = lds + (t & 1) * 32768;
        bf16x8 af[4][2], bfr[4][2];
        if (t >= t_tr) {
            const int q4 = fr >> 2, p4 = fr & 3;
#pragma unroll
            for (int m = 0; m < 4; ++m)
#pragma unroll
                for (int ks = 0; ks < 2; ++ks) {
                    const int rowA = ks * 32 + 8 * fq + q4, rowB = rowA + 4, c = wr * 8 + m * 2 + (p4 >> 1);
                    const int offA = rowA * 256 + (((c + 2 * tr_key(rowA)) & 15) * 16) + (p4 & 1) * 8;
                    const int offB = rowB * 256 + (((c + 2 * tr_key(rowB)) & 15) * 16) + (p4 & 1) * 8;
                    const s16x4 ta = __builtin_amdgcn_ds_read_tr16_b64_v4i16((LDSP(s16x4))(S + offA));
                    const s16x4 tb = __builtin_amdgcn_ds_read_tr16_b64_v4i16((LDSP(s16x4))(S + offB));
                    bf16x8 f; f[0] = ta[0]; f[1] = ta[1]; f[2] = ta[2]; f[3] = ta[3]; f[4] = tb[0]; f[5] = tb[1]; f[6] = tb[2]; f[7] = tb[3];
                    af[m][ks] = f;
                }
        } else {
#pragma unroll
            for (int m = 0; m < 4; ++m) { af[m][0] = *(const bf16x8*)(S + arow + m * 2048 + c0); af[m][1] = *(const bf16x8*)(S + arow + m * 2048 + c1); }
        }
#pragma unroll
        for (int n = 0; n < 4; ++n) { bfr[n][0] = *(const bf16x8*)(S + brow + n * 2048 + c0); bfr[n][1] = *(const bf16x8*)(S + brow + n * 2048 + c1); }
        WAIT_LGKM0();
        RAW_BARRIER();
        if (t + 2 < nt) stage(t & 1, t + 2);
#pragma unroll
        for (int ks = 0; ks < 2; ++ks)
#pragma unroll
            for (int m = 0; m < 4; ++m)
#pragma unroll
                for (int n = 0; n < 4; ++n) acc[m][n] = TRANS ? mfma16(bfr[n][ks], af[m][ks], acc[m][n]) : mfma16(af[m][ks], bfr[n][ks], acc[m][n]);
    }
}
template <int KACT, int ASTRIDE, class EPI>
DEV void gemm2_stream64(const bf16_t* W2, const char* ACT, char* sb, EPI&& epi) {
    const int tid = get_tid(), lane = tid & 63, wid = tid >> 6, fr = lane & 15, fq = lane >> 4, wr = wid >> 1, wc = wid & 1;
    constexpr int KS = KACT / 64, NJ = 8 * KS;
    const unsigned b0 = (unsigned)(tid >> 3) * KACT + (unsigned)(((tid & 7) ^ ((tid >> 3) & 7)) * 8);
    auto stage = [&](int s, int j) {
        const int nt = j / KS, ks = j % KS;
        char* SB = sb + s * 16384;
        const bf16_t* src = W2 + (size_t)nt * 128 * KACT + ks * 64 + b0;
#pragma unroll
        for (int i = 0; i < 4; ++i) glds16(src + (size_t)i * 32 * KACT, SB + i * 4096 + tid * 16);
    };
    WAIT_VM(0);
    stage(0, 0); stage(1, 1);
    const int rsw = fr & 7;
    const int brow = (wc * 64 + fr) * 128, c0 = (fq ^ rsw) * 16, c1 = ((4 + fq) ^ rsw) * 16;
    f32x4 acc[4][4]; zero_acc<4, 4>(acc);
#pragma unroll 1
    for (int j = 0; j < NJ; ++j) {
        const int ks = j % KS;
        if (j + 1 < NJ) WAIT_VM(4); else WAIT_VM(0);
        RAW_BARRIER();
        const char* S = sb + (j & 1) * 16384;
        bf16x8 af[4][2], bfr[4][2];
#pragma unroll
        for (int m = 0; m < 4; ++m) { const char* ar = ACT + (wr * 64 + m * 16 + fr) * ASTRIDE + (ks * 64 + fq * 8) * 2; af[m][0] = *(const bf16x8*)ar; af[m][1] = *(const bf16x8*)(ar + 64); }
#pragma unroll
        for (int n = 0; n < 4; ++n) { bfr[n][0] = *(const bf16x8*)(S + brow + n * 2048 + c0); bfr[n][1] = *(const bf16x8*)(S + brow + n * 2048 + c1); }
        WAIT_LGKM0();
        RAW_BARRIER();
        if (j + 2 < NJ) stage(j & 1, j + 2);
#pragma unroll
        for (int k2 = 0; k2 < 2; ++k2)
#pragma unroll
            for (int m = 0; m < 4; ++m)
#pragma unroll
                for (int n = 0; n < 4; ++n) acc[m][n] = mfma16(bfr[n][k2], af[m][k2], acc[m][n]);
        if (ks == KS - 1) { epi(j / KS, acc); zero_acc<4, 4>(acc); }
    }
}
template <int MI, int KACT, int ASTRIDE, class EPI>
DEV void gemm2_stream(const bf16_t* W2, const char* ACT, char* sb, EPI&& epi) {
    const int tid = get_tid(), lane = tid & 63, wid = tid >> 6, fr = lane & 15, fq = lane >> 4, wr = wid >> 1, wc = wid & 1;
    constexpr int KS = KACT / 32, NJ = 8 * KS;
    const bf16_t* b0 = W2 + (size_t)(tid >> 2) * KACT + lchunk(tid) * 8;
    auto stage = [&](int s, int j) {
        const int nt = j / KS, ks = j % KS;
        char* SB = sb + s * 8192;
        const bf16_t* src = b0 + (size_t)nt * 128 * KACT + ks * 32;
        glds16(src, SB + tid * 16);
        glds16(src + 64 * KACT, SB + 4096 + tid * 16);
    };
    WAIT_VM(0);
    stage(0, 0); stage(1, 1);
    const int boff = (wc * 64 + fr) * 64 + (fq ^ ((0 - (fr >> 2)) & 3)) * 16;
    f32x4 acc[MI][4]; zero_acc<MI, 4>(acc);
#pragma unroll 1
    for (int j = 0; j < NJ; ++j) {
        const int ks = j % KS;
        if (j + 1 < NJ) WAIT_VM(2); else WAIT_VM(0);
        RAW_BARRIER();
        const char* S = sb + (j & 1) * 8192;
        bf16x8 af[MI], bfr[4];
#pragma unroll
        for (int m = 0; m < MI; ++m) af[m] = *(const bf16x8*)(ACT + (wr * MI * 16 + m * 16 + fr) * ASTRIDE + (ks * 32 + fq * 8) * 2);
#pragma unroll
        for (int n = 0; n < 4; ++n) bfr[n] = *(const bf16x8*)(S + boff + n * 1024);
        WAIT_LGKM0();
        RAW_BARRIER();
        if (j + 2 < NJ) stage(j & 1, j + 2);
#pragma unroll
        for (int m = 0; m < MI; ++m)
#pragma unroll
            for (int n = 0; n < 4; ++n) acc[m][n] = mfma16(bfr[n], af[m], acc[m][n]);
        if (ks == KS - 1) { epi(j / KS, acc); zero_acc<MI, 4>(acc); }
    }
}

DEV void prep_mod_item(const Params& p, int it, char* lds) {
    const int l = it / 96, cch = it % 96, tid = get_tid(), col = cch * 64 + (tid & 63), kq = tid >> 6;
    float* sl = (float*)lds;
    float* red = sl + 9 * 1024;
    for (int i = tid; i < 9 * 1024; i += 256) { const int g = i >> 10, k = i & 1023; const float v = (g < 8) ? p.c[g * 1024 + k] : p.c_ctx[k]; sl[i] = v / (1.f + expf(-v)); }
    __syncthreads();
    float acc[9];
#pragma unroll
    for (int g = 0; g < 9; ++g) acc[g] = 0.f;
    const float* w = p.ada_w + ((size_t)l * 1024 + kq * 256) * 6144 + col;
#pragma unroll 16
    for (int kk = 0; kk < 256; ++kk) {
        const float wv = w[(size_t)kk * 6144];
#pragma unroll
        for (int g = 0; g < 9; ++g) acc[g] += sl[g * 1024 + kq * 256 + kk] * wv;
    }
#pragma unroll
    for (int g = 0; g < 9; ++g) red[(kq * 9 + g) * 64 + (tid & 63)] = acc[g];
    __syncthreads();
    float* mod = (float*)(p.ws + OFF_MOD);
    for (int i = tid; i < 9 * 64; i += 256) {
        const int g = i >> 6, c = i & 63;
        mod[((size_t)l * 9 + g) * 6144 + cch * 64 + c] = p.ada_b[l * 6144 + cch * 64 + c] + ((red[(0 * 9 + g) * 64 + c] + red[(1 * 9 + g) * 64 + c]) + (red[(2 * 9 + g) * 64 + c] + red[(3 * 9 + g) * 64 + c]));
    }
    __syncthreads();
}
DEV void prep_rope_item(const Params& p, int it) {
    const int idx = it * 256 + get_tid(), t = idx >> 5, i = idx & 31;
    const float inv = powf(10000.f, -(float)(2 * (i & 15)) / 32.f);
    const float ang = (float)((i < 16) ? (t >> 6) : (t & 63)) * inv;
    float* rc = (float*)(p.ws + OFF_ROPE);
    rc[idx] = cosf(ang); rc[2048 * 32 + idx] = sinf(ang);
}
DEV void prep_filter_item(const Params& p, int it, char* lds) {
    const int tid = get_tid(), lane = tid & 63, wid = tid >> 6;
    const int row0 = it * 32 + wid * 8;
    const int l = row0 / 2304, r0 = row0 % 2304, type = r0 < 2048 ? 0 : 1, t0 = type ? r0 - 2048 : r0, n = type ? 256 : 2048;
    float* z = (float*)lds + wid * (8 * 192); float* h1 = z + 8 * 64; float* h2 = h1 + 8 * 64;
#pragma unroll
    for (int rr = 0; rr < 8; ++rr) {
        const int t = t0 + rr;
        if (lane < 33) {
            float v;
            if (lane == 0) v = (float)t / (float)(n - 1);
            else {
                const int i = (lane - 1) & 15;
                const float f = 1e-4f + (float)i * ((15.f - 1e-4f) / 15.f);
                const float w = 2.f * 3.14159265358979323846f * (float)t / (float)n;
                v = (lane <= 16) ? cosf(f * w) : -sinf(f * w);
            }
            z[rr * 64 + lane] = v;
        }
    }
    __builtin_amdgcn_wave_barrier();
    {
        float s[8]; const float b = p.hy_f_b1[l * 64 + lane];
#pragma unroll
        for (int rr = 0; rr < 8; ++rr) s[rr] = b;
#pragma unroll 11
        for (int i = 0; i < 33; ++i) {
            const float w = p.hy_f_w1[(l * 33 + i) * 64 + lane];
#pragma unroll
            for (int rr = 0; rr < 8; ++rr) s[rr] += z[rr * 64 + i] * w;
        }
        const float fq0 = p.hy_freq[(l * 2 + 0) * 64 + lane];
#pragma unroll
        for (int rr = 0; rr < 8; ++rr) h1[rr * 64 + lane] = sinf(fq0 * s[rr]);
    }
    __builtin_amdgcn_wave_barrier();
    {
        float s[8]; const float b = p.hy_f_b2[l * 64 + lane];
#pragma unroll
        for (int rr = 0; rr < 8; ++rr) s[rr] = b;
#pragma unroll 16
        for (int i = 0; i < 64; ++i) {
            const float w = p.hy_f_w2[(l * 64 + i) * 64 + lane];
#pragma unroll
            for (int rr = 0; rr < 8; ++rr) s[rr] += h1[rr * 64 + i] * w;
        }
        const float fq1 = p.hy_freq[(l * 2 + 1) * 64 + lane];
#pragma unroll
        for (int rr = 0; rr < 8; ++rr) h2[rr * 64 + lane] = sinf(fq1 * s[rr]);
    }
    __builtin_amdgcn_wave_barrier();
    bf16_t* kf = (bf16_t*)(p.ws + (type ? OFF_KERNC + (size_t)l * 2 * 256 * 256 * 2 : OFF_KERNL + (size_t)l * 2 * 256 * 2048 * 2));
    const float lo = logf(1e-2f) / 1.5f, hi = logf(1e-2f) / 0.3f;
    const float* w3 = p.hy_f_w3 + (size_t)l * 64 * 512 + lane;
#pragma unroll 1
    for (int qh = 0; qh < 2; ++qh) {
        float acc[8][4];
#pragma unroll
        for (int rr = 0; rr < 8; ++rr)
#pragma unroll
            for (int q = 0; q < 4; ++q) acc[rr][q] = 0.f;
#pragma unroll 8
        for (int i = 0; i < 64; ++i) {
            float w[4];
#pragma unroll
            for (int q = 0; q < 4; ++q) w[q] = w3[i * 512 + qh * 256 + q * 64];
#pragma unroll
            for (int rr = 0; rr < 8; ++rr) {
                const float hv = h2[rr * 64 + i];
#pragma unroll
                for (int q = 0; q < 4; ++q) acc[rr][q] += hv * w[q];
            }
        }
#pragma unroll
        for (int q = 0; q < 4; ++q) {
            const int c = q * 64 + lane;
            const float delta = fabsf(lo + (float)c * ((hi - lo) / 255.f));
            float v[8];
#pragma unroll
            for (int rr = 0; rr < 8; ++rr) { const float tt = (float)(t0 + rr) / (float)(n - 1); v[rr] = acc[rr][q] * expf(-tt * delta); }
            if (qh == 0 && t0 == 0) v[0] += p.hy_skip[l * 256 + c];
            *(u32x4*)(kf + ((size_t)qh * 256 + c) * n + t0) = (u32x4){pk2(v[0], v[1]), pk2(v[2], v[3]), pk2(v[4], v[5]), pk2(v[6], v[7])};
        }
    }
    __builtin_amdgcn_wave_barrier();
}
struct ConvDesc { const float* src; bf16_t* dst; int ldsrc, k0, n0, lddst, mapkind; };
DEV void conv_load(const ConvDesc& d, f32x4 (&v)[4], int tid) {
    const int r = tid >> 4, c4 = (tid & 15) * 4;
#pragma unroll
    for (int i = 0; i < 4; ++i) v[i] = *(const f32x4*)(d.src + (size_t)(d.k0 + r + 16 * i) * d.ldsrc + d.n0 + c4);
}
DEV void conv_store(const ConvDesc& d, const f32x4 (&v)[4], char* lds, int tid) {
    float* tl = (float*)lds;
    {
        const int r = tid >> 4, c4 = (tid & 15) * 4;
#pragma unroll
        for (int i = 0; i < 4; ++i) { const int row = r + 16 * i; tl[row * 65 + c4 + 0] = v[i][0]; tl[row * 65 + c4 + 1] = v[i][1]; tl[row * 65 + c4 + 2] = v[i][2]; tl[row * 65 + c4 + 3] = v[i][3]; }
    }
    __syncthreads();
    {
        const int n = tid >> 2, kc = tid & 3, ng = d.n0 + n;
        int drow = ng;
        if (d.mapkind == 1) drow = 32 * (ng >> 4) + (ng & 15);
        else if (d.mapkind == 2) drow = 32 * (ng >> 4) + 16 + (ng & 15);
        else if (d.mapkind == 3) drow = (ng >> 7) * 256 + 32 * ((ng & 127) >> 4) + (ng & 15);
        else if (d.mapkind == 4) drow = (ng >> 7) * 256 + 32 * ((ng & 127) >> 4) + 16 + (ng & 15);
        else if (d.mapkind == 5) drow = (ng & ~31) + 16 * ((ng >> 2) & 1) + 4 * ((ng >> 3) & 3) + (ng & 3);
        unsigned w[8];
#pragma unroll
        for (int j = 0; j < 8; ++j) w[j] = pk2(tl[(kc * 16 + 2 * j) * 65 + n], tl[(kc * 16 + 2 * j + 1) * 65 + n]);
        u32x4* o = (u32x4*)(d.dst + (size_t)drow * d.lddst + d.k0 + kc * 16);
        o[0] = (u32x4){w[0], w[1], w[2], w[3]};
        o[1] = (u32x4){w[4], w[5], w[6], w[7]};
    }
    __syncthreads();
}
DEV ConvDesc conv_fixed_desc(const Params& p, int it) {
    const int l = it / 1040; int r = it % 1040;
    unsigned char* ws = p.ws;
    if (r < 576) return ConvDesc{p.w_in + (size_t)l * 1024 * PROJ, (bf16_t*)(ws + OFF_WIN) + (size_t)l * PROJ * 1024, PROJ, (r / 36) * 64, (r % 36) * 64, 1024, (r % 36) * 64 < 1536 ? 5 : 0};
    r -= 576;
    if (r < 256) return ConvDesc{p.w_out + (size_t)l * 1024 * 1024, (bf16_t*)(ws + OFF_WOUT) + (size_t)l * 1024 * 1024, 1024, (r / 16) * 64, (r % 16) * 64, 1024, 5};
    r -= 256;
    if (r < 64) return ConvDesc{p.sh_w1 + (size_t)l * 1024 * 256, (bf16_t*)(ws + OFF_SW13) + (size_t)l * 512 * 1024, 256, (r / 4) * 64, (r % 4) * 64, 1024, 3};
    r -= 64;
    if (r < 64) return ConvDesc{p.sh_w3 + (size_t)l * 1024 * 256, (bf16_t*)(ws + OFF_SW13) + (size_t)l * 512 * 1024, 256, (r / 4) * 64, (r % 4) * 64, 1024, 4};
    r -= 64;
    if (r < 64) { const int kt = r / 16, hh = kt >> 1;
        return ConvDesc{p.sh_w2 + (size_t)l * 256 * 1024, (bf16_t*)(ws + OFF_SW2) + (size_t)(l * 2 + hh) * 1024 * 128 - hh * 128, 1024, kt * 64, (r % 16) * 64, 128, 5}; }
    r -= 64;
    return ConvDesc{p.router_w + (size_t)l * 1024 * 64, (bf16_t*)(ws + OFF_RW) + (size_t)l * 64 * 1024, 64, r * 64, 0, 1024, 0};
}
DEV ConvDesc conv_expert_desc(const Params& p, int l, int it) {
    const int e = it / 96; int r = it % 96;
    unsigned char* ws = p.ws;
    const size_t eo = (size_t)(l * 64 + e) * 1024 * 128;
    if (r < 32) return ConvDesc{p.exp_w1 + eo, (bf16_t*)(ws + OFF_W13) + (size_t)e * 256 * 1024, 128, (r / 2) * 64, (r % 2) * 64, 1024, 1};
    r -= 32;
    if (r < 32) return ConvDesc{p.exp_w3 + eo, (bf16_t*)(ws + OFF_W13) + (size_t)e * 256 * 1024, 128, (r / 2) * 64, (r % 2) * 64, 1024, 2};
    r -= 32;
    return ConvDesc{p.exp_w2 + eo, (bf16_t*)(ws + OFF_W2) + (size_t)e * 1024 * 128, 1024, (r / 16) * 64, (r % 16) * 64, 128, 5};
}
DEV void conv_run(const Params& p, int l, int first, int count, char* lds) {
    const int tid = get_tid();
    if (count <= 0) return;
    ConvDesc d = l < 0 ? conv_fixed_desc(p, first) : conv_expert_desc(p, l, first);
    f32x4 v[4]; conv_load(d, v, tid);
#pragma unroll 1
    for (int i = 0; i < count; ++i) {
        ConvDesc dn = d; f32x4 vn[4];
        if (i + 1 < count) { dn = l < 0 ? conv_fixed_desc(p, first + i + 1) : conv_expert_desc(p, l, first + i + 1); conv_load(dn, vn, tid); }
        else {
#pragma unroll
            for (int k = 0; k < 4; ++k) vn[k] = v[k];
        }
        conv_store(d, v, lds, tid);
        d = dn;
#pragma unroll
        for (int k = 0; k < 4; ++k) v[k] = vn[k];
    }
}
DEV void phase_prep(const Params& p, char* lds) {
    { const int t_ = get_tid(); if (blockIdx.x == 0 && t_ < 128) ((int*)(p.ws + OFF_CNT))[t_ * 64] = 0; }
    constexpr int N0 = 144, N1 = N0 + 192, N2 = N1 + 260, N3 = N2 + 768, N4 = N3 + 256;
    int* qhead = (int*)(p.ws + OFF_QUEUE) + 2 * 64;
    int* qslot = (int*)(lds + SMEM_BYTES - 256);
    for (;;) {
        __syncthreads();
        if (get_tid() == 0) *qslot = atomicAdd(qhead, 1);
        __syncthreads();
        const int it = *qslot;
        if (it >= N4) break;
        if (it < N0) prep_filter_item(p, it, lds);
        else if (it < N1) prep_mod_item(p, it - N0, lds);
        else if (it < N2) conv_run(p, -1, (it - N1) * 8, 8, lds);
        else if (it < N3) conv_run(p, 0, (it - N2) * 8, 8, lds);
        else prep_rope_item(p, it - N3);
    }
}
DEV void phase_modfin(const Params& p) {
    const float* part = (const float*)(p.ws + OFF_PART);
    float* mod = (float*)(p.ws + OFF_MOD);
    for (int idx = blockIdx.x * 256 + get_tid(); idx < 2 * 9 * 6144; idx += gridDim.x * 256) {
        const int l = idx / (9 * 6144), g = (idx / 6144) % 9, col = idx % 6144;
        float s = p.ada_b[l * 6144 + col];
        for (int k = 0; k < 32; ++k) s += part[((size_t)(k * 2 + l) * 9 + g) * 6144 + col];
        mod[idx] = s;
    }
}

DEV void row_load(const float* src, f32x4 (&v)[4], int lane) {
#pragma unroll
    for (int j = 0; j < 4; ++j) v[j] = *(const f32x4*)(src + 4 * lane + 256 * j);
}
DEV f32x4 ld_bf4(const bf16_t* p) { const u32x2 w = *(const u32x2*)p; return (f32x4){__uint_as_float(w[0] << 16), __uint_as_float(w[0] & 0xffff0000u), __uint_as_float(w[1] << 16), __uint_as_float(w[1] & 0xffff0000u)}; }
DEV void st_bf4(bf16_t* p, const f32x4& v) { *(u32x2*)p = (u32x2){pk2(v[0], v[1]), pk2(v[2], v[3])}; }
DEV void row_load_bf(const bf16_t* src, f32x4 (&v)[4], int lane) {
#pragma unroll
    for (int j = 0; j < 4; ++j) v[j] = ld_bf4(src + 4 * lane + 256 * j);
}
DEV void row_norm(f32x4 (&v)[4]) {
    float s = 0.f;
#pragma unroll
    for (int j = 0; j < 4; ++j) s += (v[j][0] + v[j][1]) + (v[j][2] + v[j][3]);
    const float mean = wave_sum(s) * (1.f / 1024.f);
    float q = 0.f;
#pragma unroll
    for (int j = 0; j < 4; ++j) { v[j] = v[j] - mean; q += (v[j][0] * v[j][0] + v[j][1] * v[j][1]) + (v[j][2] * v[j][2] + v[j][3] * v[j][3]); }
    const float rstd = 1.0f / sqrtf(wave_sum(q) * (1.f / 1024.f) + 1e-6f);
#pragma unroll
    for (int j = 0; j < 4; ++j) v[j] = v[j] * rstd;
}
DEV void row_store_mod_bf16(bf16_t* dst, const f32x4 (&v)[4], const float* shift, const float* scale, int lane) {
#pragma unroll
    for (int j = 0; j < 4; ++j) {
        const int c = 4 * lane + 256 * j;
        const f32x4 sh = *(const f32x4*)(shift + c), sc = *(const f32x4*)(scale + c);
        const f32x4 o = v[j] * (sc + 1.0f) + sh;
        *(u32x2*)(dst + c) = (u32x2){pk2(o[0], o[1]), pk2(o[2], o[3])};
    }
}
DEV void phase_lnmod0(const Params& p) {
    const int tid_ = get_tid(), lane = tid_ & 63, wid = tid_ >> 6;
    const float* mod = (const float*)(p.ws + OFF_MOD);
    bf16_t* H = (bf16_t*)(p.ws + OFF_H);
    for (int row = blockIdx.x * 4 + wid; row < NT; row += gridDim.x * 4) {
        const float* src = row < NLAT ? p.x + (size_t)row * 1024 : p.ctx + (size_t)(row - NLAT) * 1024;
        f32x4 v[4]; row_load(src, v, lane); row_norm(v);
        const float* m = mod + (size_t)mod_group(row) * 6144;
        row_store_mod_bf16(H + (size_t)row * 1024, v, m, m + 1024, lane);
    }
}

DEV void phase_inproj(const Params& p, int l, char* lds) {
    const int tid = get_tid(), lane = tid & 63, wid = tid >> 6, fr = lane & 15, fq = lane >> 4, wr = wid >> 1, wc = wid & 1;
    unsigned char* ws = p.ws;
    const bf16_t* H = (const bf16_t*)(ws + OFF_H);
    const bf16_t* W = (const bf16_t*)(ws + OFF_WIN) + (size_t)l * PROJ * 1024;
    const float* ropec = (const float*)(ws + OFF_ROPE); const float* ropes = ropec + 2048 * 32;
    const int nitems = 128 * 18 + 16 * (l == 0 ? 18 : 6);
    for (int it = blockIdx.x; it < nitems; it += gridDim.x) {
        int mt, nt;
        if (it < 2304) { mt = it / 18; nt = it % 18; }
        else { const int j = it - 2304; if (l == 0) { mt = 128 + j / 18; nt = j % 18; } else { mt = 128 + j / 6; const int q = j % 6; nt = q < 2 ? 4 + q : 6 + q; } }
        const int m0 = mt * 128, n0 = nt * 128;
        const unsigned a0 = (unsigned)m0 * 1024u + st64_off(tid), b0 = (unsigned)n0 * 1024u + st64_off(tid);
        const unsigned ao[4] = {a0, a0 + 32u * 1024u, a0 + 64u * 1024u, a0 + 96u * 1024u};
        const unsigned bo[4] = {b0, b0 + 32u * 1024u, b0 + 64u * 1024u, b0 + 96u * 1024u};
        f32x4 acc[4][4]; zero_acc<4, 4>(acc);
        const bool latent = m0 < NLAT;
        const int b = latent ? (m0 >> 11) : ((m0 - NLAT) >> 8);
        const int tbase = latent ? (m0 & 2047) : ((m0 - NLAT) & 255);
        if (nt >= 12) {
            const int rho = tid >> 3, ptok = 8 * ((rho & 15) >> 2) + 4 * (rho >> 4) + (rho & 3);
            const unsigned ap0 = (unsigned)(m0 + ptok) * 1024u + (unsigned)(((tid & 7) ^ (rho & 7)) * 8);
            const unsigned aop[4] = {ap0, ap0 + 32u * 1024u, ap0 + 64u * 1024u, ap0 + 96u * 1024u};
            gemm_core64<false>(acc, H, aop, W, bo, 1024, lds);
            bf16_t* zt = latent ? (bf16_t*)(ws + OFF_ZTL) + (size_t)b * 768 * 2048 : (bf16_t*)(ws + OFF_ZTC) + (size_t)b * 768 * 256;
            const int n = latent ? 2048 : 256;
#pragma unroll
            for (int g = 0; g < 2; ++g)
#pragma unroll
                for (int nn = 0; nn < 4; ++nn) {
                    const int ch = n0 - 1536 + wc * 64 + nn * 16 + fr, t = tbase + wr * 64 + 32 * g + 8 * fq;
                    *(u32x4*)(zt + (size_t)ch * n + t) = (u32x4){pk2(acc[2 * g][nn][0], acc[2 * g][nn][1]), pk2(acc[2 * g][nn][2], acc[2 * g][nn][3]),
                                                                 pk2(acc[2 * g + 1][nn][0], acc[2 * g + 1][nn][1]), pk2(acc[2 * g + 1][nn][2], acc[2 * g + 1][nn][3])};
                }
        } else {
            gemm_core64<true>(acc, H, ao, W, bo, 1024, lds);
            const int col0 = n0 + wc * 64;
            int kind, hh;
            if (col0 < 512) { kind = 0; hh = col0 >> 6; } else if (col0 < 640) { kind = 1; hh = (col0 - 512) >> 6; } else if (col0 < 768) { kind = 2; hh = (col0 - 640) >> 6; }
            else if (col0 < 1024) { kind = 3; hh = (col0 - 768) >> 6; } else if (col0 < 1280) { kind = 4; hh = (col0 - 1024) >> 6; } else { kind = 5; hh = (col0 - 1280) >> 6; }
            const bool normed = (kind == 0 || kind == 1);
            const float* gain = (kind == 0 ? p.q_gain : p.k_gain) + l * 64;
#pragma unroll
            for (int m = 0; m < 4; ++m) {
                const int rloc = wr * 64 + m * 16 + fr, row = m0 + rloc, t = tbase + rloc;
                f32x4 v[4];
#pragma unroll
                for (int nn = 0; nn < 4; ++nn) v[nn] = acc[m][nn];
                if (normed) {
                    float ss = 0.f;
#pragma unroll
                    for (int nn = 0; nn < 4; ++nn) ss += (v[nn][0] * v[nn][0] + v[nn][1] * v[nn][1]) + (v[nn][2] * v[nn][2] + v[nn][3] * v[nn][3]);
                    ss += __shfl_xor(ss, 16); ss += __shfl_xor(ss, 32);
                    const float r = 1.0f / sqrtf(ss * (1.f / 64.f) + 1e-6f);
#pragma unroll
                    for (int nn = 0; nn < 4; ++nn) {
                        const int hc = 32 * (nn >> 1) + 8 * fq + 4 * (nn & 1);
                        const f32x4 g = *(const f32x4*)(gain + hc);
                        v[nn] = v[nn] * r * g;
                        if (latent) {
                            const int pi = hc >> 1;
                            const float c0 = ropec[t * 32 + pi], s0 = ropes[t * 32 + pi], c1 = ropec[t * 32 + pi + 1], s1 = ropes[t * 32 + pi + 1];
                            const float x0 = v[nn][0], x1 = v[nn][1], x2 = v[nn][2], x3 = v[nn][3];
                            v[nn][0] = x0 * c0 - x1 * s0; v[nn][1] = x0 * s0 + x1 * c0;
                            v[nn][2] = x2 * c1 - x3 * s1; v[nn][3] = x2 * s1 + x3 * c1;
                        }
                    }
                }
                if (kind == 0 || kind == 3) {
#pragma unroll
                    for (int nn = 0; nn < 4; ++nn) v[nn] = v[nn] * (0.125f * LOG2E);
                }
                bf16_t* dst;
                const int key = latent ? 256 + t : t;
                if (kind == 0) dst = (bf16_t*)(ws + OFF_QA) + ((size_t)hh * NT + row) * 64;
                else if (kind == 3) dst = (bf16_t*)(ws + OFF_QB) + ((size_t)hh * NT + row) * 64;
                else if (kind == 1) dst = (bf16_t*)(ws + OFF_KA) + ((size_t)(b * 2 + hh) * KEYS + key) * 64;
                else if (kind == 2) dst = (bf16_t*)(ws + OFF_VA) + ((size_t)(b * 2 + hh) * KEYS + key) * 64;
                else if (kind == 4) dst = (bf16_t*)(ws + OFF_KB) + ((size_t)(b * 4 + hh) * KEYS + key) * 64;
                else dst = (bf16_t*)(ws + OFF_VB) + ((size_t)(b * 4 + hh) * KEYS + key) * 64;
#pragma unroll
                for (int gg = 0; gg < 2; ++gg) *(u32x4*)(dst + 32 * gg + 8 * fq) = (u32x4){pk2(v[2 * gg][0], v[2 * gg][1]), pk2(v[2 * gg][2], v[2 * gg][3]), pk2(v[2 * gg + 1][0], v[2 * gg + 1][1]), pk2(v[2 * gg + 1][2], v[2 * gg + 1][3])};
                __builtin_amdgcn_sched_barrier(0);
            }
        }
    }
}

template <int NQT, bool NA>
DEV void attn_block(const bf16_t* Qh, int qrow0, const bf16_t* Kh, const bf16_t* Vh, int ntiles, bf16_t* outp  ,
                    int na_r, int na_rs, int nwin, const float* rpb_h, char* lds) {
    const int tid = get_tid(), lane = tid & 63, wid = tid >> 6, fr = lane & 15, fq = lane >> 4;
    char* KBUF = lds;
    char* VBUF = lds + 16384;
    float* BIAS = (float*)(lds + 32768);
    if (NA) {
        for (int i = tid; i < 15 * 32; i += 256) { const int dr = i >> 5, dc = i & 31; BIAS[i] = dc < 31 ? rpb_h[dr * 31 + dc] * LOG2E : 0.f; }
    }
    bf16x8 qf[NQT][2];
    const int qw = qrow0 + wid * 16 * NQT;
#pragma unroll
    for (int nq = 0; nq < NQT; ++nq)
#pragma unroll
        for (int ks = 0; ks < 2; ++ks) qf[nq][ks] = *(const bf16x8*)(Qh + (size_t)(qw + nq * 16 + fr) * 64 + ks * 32 + fq * 8);
    f32x4 oacc[4][NQT], lacc[NQT];
    float mrun[NQT];
    const bf16x8 ones = (bf16x8){0x3F80, 0x3F80, 0x3F80, 0x3F80, 0x3F80, 0x3F80, 0x3F80, 0x3F80};
#pragma unroll
    for (int nq = 0; nq < NQT; ++nq) { mrun[nq] = 0.f; lacc[nq] = (f32x4){0.f, 0.f, 0.f, 0.f};
#pragma unroll
        for (int dt = 0; dt < 4; ++dt) oacc[dt][nq] = (f32x4){0.f, 0.f, 0.f, 0.f}; }
    const int lrow0 = tid >> 3, lch = tid & 7;
    auto key0_of = [&](int ti) -> int { if (NA) return ti < nwin ? 256 + (na_rs + ti) * 64 : (ti - nwin) * 64; return ti * 64; };
    u32x4 kreg[2], vreg[2];
    auto gload = [&](int ti) {
        const int k0 = key0_of(ti);
#pragma unroll
        for (int i = 0; i < 2; ++i) {
            const int row = lrow0 + 32 * i;
            kreg[i] = *(const u32x4*)(Kh + (size_t)(k0 + row) * 64 + lch * 8);
            vreg[i] = *(const u32x4*)(Vh + (size_t)(k0 + row) * 64 + lch * 8);
        }
    };
    auto lstore = [&](int buf) {
#pragma unroll
        for (int i = 0; i < 2; ++i) {
            const int row = lrow0 + 32 * i;
            const int off = buf * 8192 + row * 128 + ((lch ^ (row & 7)) * 16);
            *(u32x4*)(KBUF + off) = kreg[i];
            *(u32x4*)(VBUF + off) = vreg[i];
        }
    };
    gload(0); lstore(0);
    __syncthreads();
    for (int ti = 0; ti < ntiles; ++ti) {
        const int buf = ti & 1;
        if (ti + 1 < ntiles) gload(ti + 1);
        const char* kb = KBUF + buf * 8192; const char* vb = VBUF + buf * 8192;
        f32x4 sacc[4][NQT];
#pragma unroll
        for (int mt = 0; mt < 4; ++mt) {
            const int row = mt * 16 + fr;
            bf16x8 kf0 = *(const bf16x8*)(kb + row * 128 + (((0 + fq) ^ (row & 7)) * 16));
            bf16x8 kf1 = *(const bf16x8*)(kb + row * 128 + (((4 + fq) ^ (row & 7)) * 16));
#pragma unroll
            for (int nq = 0; nq < NQT; ++nq) {
                f32x4 s = (f32x4){-mrun[nq], -mrun[nq], -mrun[nq], -mrun[nq]};
                s = mfma16(kf0, qf[nq][0], s);
                s = mfma16(kf1, qf[nq][1], s);
                sacc[mt][nq] = s;
            }
        }
        bf16x8 pf[2][NQT];
#pragma unroll
        for (int nq = 0; nq < NQT; ++nq) {
            float tv[4][4];
            float tmax = -1e30f;
            if (NA && ti < nwin) {
                const int qc = (wid & 1) * 32 + nq * 16 + fr;
                int cs = qc - 8; cs = cs < 0 ? 0 : (cs > 48 ? 48 : cs);
                const int qrow = na_r + (wid >> 1);
                int rsq = qrow - 4; rsq = rsq < 0 ? 0 : (rsq > 24 ? 24 : rsq);
                const int krow = na_rs + ti;
                const bool rowok = (krow >= rsq) && (krow < rsq + 8);
                int dr = krow - qrow + 7; dr = dr < 0 ? 0 : (dr > 14 ? 14 : dr);
#pragma unroll
                for (int mt = 0; mt < 4; ++mt)
#pragma unroll
                    for (int j = 0; j < 4; ++j) {
                        const int kc = mt * 16 + 4 * fq + j;
                        const bool ok = rowok && (kc >= cs) && (kc < cs + 16);
                        int dc = kc - qc + 15; dc = dc < 0 ? 0 : (dc > 30 ? 30 : dc);
                        tv[mt][j] = ok ? sacc[mt][nq][j] + BIAS[dr * 32 + dc] : -1e30f;
                        tmax = fmaxf(tmax, tv[mt][j]);
                    }
            } else {
#pragma unroll
                for (int mt = 0; mt < 4; ++mt) {
#pragma unroll
                    for (int j = 0; j < 4; ++j) tv[mt][j] = sacc[mt][nq][j];
                    tmax = fmaxf(fmaxf(tmax, tv[mt][0]), tv[mt][1]); tmax = fmaxf(fmaxf(tmax, tv[mt][2]), tv[mt][3]);
                }
            }
            if (__any(tmax > 8.0f)) {
                tmax = fmaxf(tmax, __shfl_xor(tmax, 16)); tmax = fmaxf(tmax, __shfl_xor(tmax, 32));
                const float dlt = fmaxf(tmax, 0.f);
                const float alpha = __builtin_amdgcn_exp2f(-dlt);
                mrun[nq] += dlt;
                lacc[nq] = lacc[nq] * alpha;
#pragma unroll
                for (int dt = 0; dt < 4; ++dt) oacc[dt][nq] = oacc[dt][nq] * alpha;
#pragma unroll
                for (int mt = 0; mt < 4; ++mt)
#pragma unroll
                    for (int j = 0; j < 4; ++j) tv[mt][j] -= dlt;
            }
#pragma unroll
            for (int mt = 0; mt < 4; ++mt)
#pragma unroll
                for (int j = 0; j < 4; ++j) tv[mt][j] = __builtin_amdgcn_exp2f(tv[mt][j]);
#pragma unroll
            for (int ks = 0; ks < 2; ++ks) {
                union { bf16x8 v; unsigned u[4]; } pk;
                pk.u[0] = pk2(tv[2 * ks][0], tv[2 * ks][1]); pk.u[1] = pk2(tv[2 * ks][2], tv[2 * ks][3]);
                pk.u[2] = pk2(tv[2 * ks + 1][0], tv[2 * ks + 1][1]); pk.u[3] = pk2(tv[2 * ks + 1][2], tv[2 * ks + 1][3]);
                pf[ks][nq] = pk.v;
                lacc[nq] = mfma16(ones, pk.v, lacc[nq]);
            }
        }
        {
            const int q4 = fr >> 2, p4 = fr & 3;
#pragma unroll
            for (int ks = 0; ks < 2; ++ks)
#pragma unroll
                for (int dt = 0; dt < 4; ++dt) {
                    const int keyA = 16 * (2 * ks) + 4 * fq + q4, keyB = keyA + 16;
                    const int ch = 4 * (dt >> 1) + p4;
                    const int offA = keyA * 128 + ((ch ^ (keyA & 7)) * 16) + (dt & 1) * 8;
                    const int offB = keyB * 128 + ((ch ^ (keyB & 7)) * 16) + (dt & 1) * 8;
                    const s16x4 ta = __builtin_amdgcn_ds_read_tr16_b64_v4i16((LDSP(s16x4))(vb + offA));
                    const s16x4 tb = __builtin_amdgcn_ds_read_tr16_b64_v4i16((LDSP(s16x4))(vb + offB));
                    bf16x8 vf; vf[0] = ta[0]; vf[1] = ta[1]; vf[2] = ta[2]; vf[3] = ta[3]; vf[4] = tb[0]; vf[5] = tb[1]; vf[6] = tb[2]; vf[7] = tb[3];
#pragma unroll
                    for (int nq = 0; nq < NQT; ++nq) oacc[dt][nq] = mfma16(vf, pf[ks][nq], oacc[dt][nq]);
                }
        }
        if (ti + 1 < ntiles) lstore(buf ^ 1);
        __syncthreads();
    }
#pragma unroll
    for (int nq = 0; nq < NQT; ++nq) {
        const float inv = 1.0f / lacc[nq][0];
        bf16_t* o = outp + (size_t)(qw + nq * 16 + fr) * 1024;
#pragma unroll
        for (int g = 0; g < 2; ++g) {
            const f32x4 v0 = oacc[2 * g][nq] * inv, v1 = oacc[2 * g + 1][nq] * inv;
            *(u32x4*)(o + g * 32 + 8 * fq) = (u32x4){pk2(v0[0], v0[1]), pk2(v0[2], v0[3]), pk2(v1[0], v1[1]), pk2(v1[2], v1[3])};
        }
    }
    __syncthreads();
}

DEV float hy_sconv(const bf16_t* zrow, int t, int n, float w0, float w1, float w2, float bias) {
    const float zm = t > 0 ? bf2f(zrow[t - 1]) : 0.f, z0 = bf2f(zrow[t]), zp = t + 1 < n ? bf2f(zrow[t + 1]) : 0.f;
    return w0 * zm + w1 * z0 + w2 * zp + bias;
}
template <int NJ>
DEV void hyena_item(const Params& p, int l, int type, int c, int bh, char* lds) {
    constexpr int n = 256 * NJ;
    const int tid = get_tid();
    f32x4* U = (f32x4*)lds;
    float* KR = (float*)(lds + n * 16);
    const bf16_t* zt = type ? (const bf16_t*)(p.ws + OFF_ZTC) : (const bf16_t*)(p.ws + OFF_ZTL);
    const bf16_t* kf = (const bf16_t*)(p.ws + (type ? OFF_KERNC + (size_t)l * 2 * 256 * 256 * 2 : OFF_KERNL + (size_t)l * 2 * 256 * 2048 * 2)) + (size_t)c * n;
    const bf16_t* kb = kf + (size_t)256 * n;
    const float* cw = p.hy_conv_w + l * 3 * 768; const float* cb = p.hy_conv_b + l * 768;
    const float w10 = cw[256 + c], w11 = cw[768 + 256 + c], w12 = cw[1536 + 256 + c], b1 = cb[256 + c];
    const float wv0 = cw[512 + c], wv1 = cw[768 + 512 + c], wv2 = cw[1536 + 512 + c], bv = cb[512 + c];
    const float w00 = cw[c], w01 = cw[768 + c], w02 = cw[1536 + c], b0 = cb[c];
    for (int i = tid; i < 2 * n - 1; i += 256) { const int d = i - (n - 1); KR[i] = bf2f(d >= 0 ? kf[d] : kb[-d]); }
    for (int s = tid; s < n; s += 256) {
        f32x4 u;
#pragma unroll
        for (int bb = 0; bb < 4; ++bb) {
            const bf16_t* zb = zt + (size_t)(bh * 4 + bb) * 768 * n;
            const float x1 = hy_sconv(zb + (size_t)(256 + c) * n, s, n, w10, w11, w12, b1);
            const float vv = hy_sconv(zb + (size_t)(512 + c) * n, s, n, wv0, wv1, wv2, bv);
            u[bb] = vv * x1;
        }
        U[s] = u;
    }
    __syncthreads();
    f32x4 acc[NJ];
#pragma unroll
    for (int j = 0; j < NJ; ++j) acc[j] = (f32x4){0.f, 0.f, 0.f, 0.f};
    const float* kp = KR + tid + (n - 1);
    for (int s = 0; s < n; ++s) {
        const f32x4 u = U[s];
#pragma unroll
        for (int j = 0; j < NJ; ++j) acc[j] += u * kp[256 * j - s];
    }
    bf16_t* ox = (bf16_t*)(p.ws + OFF_OX);
#pragma unroll
    for (int j = 0; j < NJ; ++j) {
        const int t = tid + 256 * j;
#pragma unroll
        for (int bb = 0; bb < 4; ++bb) {
            const int b = bh * 4 + bb;
            const bf16_t* zb = zt + (size_t)b * 768 * n;
            const float x0 = hy_sconv(zb + (size_t)c * n, t, n, w00, w01, w02, b0);
            const float y = acc[j][bb] * x0;
            const int row = type ? NLAT + b * 256 + t : b * 2048 + t;
            ox[(size_t)row * 1024 + 768 + c] = (bf16_t)f2bf(y);
        }
    }
    __syncthreads();
}


typedef float f32x16 __attribute__((ext_vector_type(16)));
constexpr int HY_UROW = 2256;
constexpr int HY_KC_OFF = 8 * HY_UROW * 2;
constexpr int HY_KC_STRIDE = 8192 + 64;
DEV float hy_sc8(const bf16_t* zrow, int s0, int n, float w0, float w1, float w2, float bias, float (&o)[8]) {
    const u32x4 v = *(const u32x4*)(zrow + s0);
    const float zm = s0 > 0 ? bf2f(zrow[s0 - 1]) : 0.f, zp = s0 + 8 < n ? bf2f(zrow[s0 + 8]) : 0.f;
    float z[10]; z[0] = zm; z[9] = zp;
#pragma unroll
    for (int i = 0; i < 4; ++i) { z[1 + 2 * i] = __uint_as_float(v[i] << 16); z[2 + 2 * i] = __uint_as_float(v[i] & 0xffff0000u); }
#pragma unroll
    for (int i = 0; i < 8; ++i) o[i] = w0 * z[i] + w1 * z[i + 1] + w2 * z[i + 2] + bias;
    return 0.f;
}
DEV void hyena_mfma_item(const Params& p, int l, int c, char* lds) {
    const int tid = get_tid(), lane = tid & 63, wid = tid >> 6;
    constexpr int n = 2048;
    const bf16_t* zt = (const bf16_t*)(p.ws + OFF_ZTL);
    const bf16_t* kf = (const bf16_t*)(p.ws + OFF_KERNL + (size_t)l * 2 * 256 * 2048 * 2) + (size_t)c * n;
    const bf16_t* kb = kf + (size_t)256 * n;
    const float* cw = p.hy_conv_w + l * 3 * 768; const float* cb = p.hy_conv_b + l * 768;
    const float w10 = cw[256 + c], w11 = cw[768 + 256 + c], w12 = cw[1536 + 256 + c], b1 = cb[256 + c];
    const float wv0 = cw[512 + c], wv1 = cw[768 + 512 + c], wv2 = cw[1536 + 512 + c], bv = cb[512 + c];
    const float w00 = cw[c], w01 = cw[768 + c], w02 = cw[1536 + c], b0 = cb[c];
    for (int i = tid; i < 8 * 26; i += 256) {
        const int b = i / 26, k = i % 26;
        const int sp = k < 12 ? k * 8 : 96 + 2048 + (k - 12) * 8;
        *(u32x4*)(lds + (b * HY_UROW + sp) * 2) = (u32x4){0u, 0u, 0u, 0u};
    }
#pragma unroll 4
    for (int ch = tid; ch < 8 * 256; ch += 256) {
        const int b = ch >> 8, s0 = (ch & 255) * 8;
        const bf16_t* zb = zt + (size_t)b * 768 * n;
        float x1[8], vv[8];
        hy_sc8(zb + (size_t)(256 + c) * n, s0, n, w10, w11, w12, b1, x1);
        hy_sc8(zb + (size_t)(512 + c) * n, s0, n, wv0, wv1, wv2, bv, vv);
        *(u32x4*)(lds + (b * HY_UROW + 96 + s0) * 2) = (u32x4){pk2(vv[0] * x1[0], vv[1] * x1[1]), pk2(vv[2] * x1[2], vv[3] * x1[3]), pk2(vv[4] * x1[4], vv[5] * x1[5]), pk2(vv[6] * x1[6], vv[7] * x1[7])};
    }
    {
        char* R0 = lds + HY_KC_OFF;
#pragma unroll
        for (int j = 0; j < 2; ++j) {
            const int chn = tid + 256 * j;
            const bool fwd = chn < 256; const int d0 = (chn & 255) * 8;
            const u32x4 v = *(const u32x4*)((fwd ? kf : kb) + d0);
#pragma unroll
            for (int e = 0; e < 8; ++e) {
                const int d = d0 + e;
                const bf16_t val = (bf16_t)((e & 1) ? (v[e >> 1] >> 16) : (v[e >> 1] & 0xffffu));
                const int y = fwd ? 2047 - d : 2047 + d;
                if (fwd || d > 0) *(bf16_t*)(R0 + y * 2) = val;
            }
        }
        if (tid == 0) *(bf16_t*)(R0 + 4095 * 2) = 0;
    }
    __syncthreads();
    {
        const char* R0 = lds + HY_KC_OFF;
        for (int i = tid; i < 3 * 1024; i += 256) {
            const int q = 1 + i / 1024, y = (i % 1024) * 4;
            unsigned short e[4];
#pragma unroll
            for (int k = 0; k < 4; ++k) { const int yy = y + q + k; e[k] = yy <= 4094 ? *(const bf16_t*)(R0 + yy * 2) : (bf16_t)0; }
            *(u32x2*)(lds + HY_KC_OFF + q * HY_KC_STRIDE + y * 2) = (u32x2){(unsigned)e[0] | ((unsigned)e[1] << 16), (unsigned)e[2] | ((unsigned)e[3] << 16)};
        }
    }
    __syncthreads();
    const int i32 = lane & 31, h = lane >> 5, qn = i32 >> 3, bn = i32 & 7;
    const int T0 = 512 * wid;
    f32x16 acc[4];
#pragma unroll
    for (int g = 0; g < 4; ++g)
#pragma unroll
        for (int r = 0; r < 16; ++r) acc[g][r] = 0.f;
    const int dlo = T0 - 2032, dhi = T0 + 384 + 96;
    {
        const int a0 = 2047 - dlo - i32 + 8 * h, q4 = a0 & 3;
        const char* ap = lds + HY_KC_OFF + q4 * HY_KC_STRIDE + (a0 - q4) * 2;
        const char* bp = lds + (bn * HY_UROW + 96 + (T0 - dlo) + 32 * qn + 8 * h) * 2;
        for (int dl = dlo; dl <= dhi; dl += 16) {
            union { bf16x8 v; u32x2 u[2]; } af;
            af.u[0] = *(const u32x2*)ap; af.u[1] = *(const u32x2*)(ap + 8);
#pragma unroll
            for (int g = 0; g < 4; ++g) {
                const int S = T0 + 128 * g - dl;
                if (S >= -96 && S <= 2032) {
                    const bf16x8 bfv = *(const bf16x8*)(bp + 256 * g);
                    acc[g] = __builtin_amdgcn_mfma_f32_32x32x16_bf16(af.v, bfv, acc[g], 0, 0, 0);
                }
            }
            ap -= 32; bp -= 32;
        }
    }
    __syncthreads();
#pragma unroll 4
    for (int ch = tid; ch < 8 * 256; ch += 256) {
        const int b = ch >> 8, s0 = (ch & 255) * 8;
        float x0[8];
        hy_sc8(zt + (size_t)b * 768 * n + (size_t)c * n, s0, n, w00, w01, w02, b0, x0);
        *(u32x4*)(lds + HY_KC_OFF + (b * 2048 + s0) * 2) = (u32x4){pk2(x0[0], x0[1]), pk2(x0[2], x0[3]), pk2(x0[4], x0[5]), pk2(x0[6], x0[7])};
    }
    __syncthreads();
    bf16_t* oxt = (bf16_t*)(p.ws + OFF_OXT) + (size_t)c * 2048;
#pragma unroll
    for (int g = 0; g < 4; ++g)
#pragma unroll
        for (int r4 = 0; r4 < 4; ++r4) {
            const int t = T0 + 128 * g + 32 * qn + 8 * r4 + 4 * h;
            const u32x2 xg = *(const u32x2*)(lds + HY_KC_OFF + (bn * 2048 + t) * 2);
            const float g0 = __uint_as_float(xg[0] << 16), g1 = __uint_as_float(xg[0] & 0xffff0000u), g2 = __uint_as_float(xg[1] << 16), g3 = __uint_as_float(xg[1] & 0xffff0000u);
            *(u32x2*)(oxt + (size_t)bn * 256 * 2048 + t) = (u32x2){pk2(acc[g][4 * r4 + 0] * g0, acc[g][4 * r4 + 1] * g1), pk2(acc[g][4 * r4 + 2] * g2, acc[g][4 * r4 + 3] * g3)};
        }
    __syncthreads();
}

DEV void phase_mix(const Params& p, int l, char* lds) {
    unsigned char* ws = p.ws;
    const bf16_t* QA = (const bf16_t*)(ws + OFF_QA); const bf16_t* QB = (const bf16_t*)(ws + OFF_QB);
    const bf16_t* KA = (const bf16_t*)(ws + OFF_KA); const bf16_t* VA = (const bf16_t*)(ws + OFF_VA);
    const bf16_t* KBp = (const bf16_t*)(ws + OFF_KB); const bf16_t* VBp = (const bf16_t*)(ws + OFF_VB);
    bf16_t* OX = (bf16_t*)(ws + OFF_OX);
    const int N0 = 256, N1 = N0 + 1024, N2 = N1 + 512;
    const int N3 = N2 + (l == 0 ? 512 : 0), N4 = N3 + (l == 0 ? 128 : 0), N5 = N4 + (l == 0 ? 64 : 0);
    int* qhead = (int*)(p.ws + OFF_QUEUE) + l * 64;
    int* qslot = (int*)(lds + SMEM_BYTES - 256);
    for (;;) {
        __syncthreads();
        if (get_tid() == 0) *qslot = atomicAdd(qhead, 1);
        __syncthreads();
        const int it = *qslot;
        if (it >= N5) break;
#if TELEM
        const unsigned long long ts0 = __builtin_amdgcn_s_memrealtime();
        const int kind = it < N0 ? 9 : it < N1 ? 10 : it < N2 ? 11 : 12;
        struct TS { unsigned long long t0; int k; char* l; __device__ ~TS() { __syncthreads(); if (threadIdx.x == 0) ((volatile LAS unsigned*)(l + SMEM_BYTES - 128))[k] += (unsigned)(__builtin_amdgcn_s_memrealtime() - t0); } } ts_{ts0, kind, lds};
#endif
        if (it < N0) { hyena_mfma_item(p, l, it, lds); }
        else if (it < N1) {
            const int j = it - N0, b = j >> 7, h = (j >> 4) & 7, qb = j & 15;
            attn_block<2, false>(QA + (size_t)h * NT * 64, b * 2048 + qb * 128, KA + (size_t)(b * 2 + (h >> 2)) * KEYS * 64, VA + (size_t)(b * 2 + (h >> 2)) * KEYS * 64,
                                 36, OX + h * 64, 0, 0, 0, nullptr, lds);
        } else if (it < N2) {
            const int j = it - N1, b = j >> 6, h = (j >> 4) & 3, r = (j & 15) * 2;
            int rs0 = r - 4; rs0 = rs0 < 0 ? 0 : (rs0 > 24 ? 24 : rs0);
            int rs1 = r - 3; rs1 = rs1 < 0 ? 0 : (rs1 > 24 ? 24 : rs1);
            const int nwin = rs1 + 8 - rs0;
            attn_block<2, true>(QB + (size_t)h * NT * 64, b * 2048 + r * 64, KBp + (size_t)(b * 4 + h) * KEYS * 64, VBp + (size_t)(b * 4 + h) * KEYS * 64,
                                nwin + 4, OX + 512 + h * 64, r, rs0, nwin, p.nat_rpb + (size_t)(l * 4 + h) * 15 * 31, lds);
        } else if (it < N3) { const int j = it - N2; hyena_item<1>(p, l, 1, j >> 1, j & 1, lds); }
        else if (it < N4) {
            const int j = it - N3, b = j >> 4, h = (j >> 1) & 7, qb = j & 1;
            attn_block<2, false>(QA + (size_t)h * NT * 64, NLAT + b * 256 + qb * 128, KA + (size_t)(b * 2 + (h >> 2)) * KEYS * 64, VA + (size_t)(b * 2 + (h >> 2)) * KEYS * 64,
                                 4, OX + h * 64, 0, 0, 0, nullptr, lds);
        } else {
            const int j = it - N4, b = j >> 3, h = (j >> 1) & 3, qb = j & 1;
            attn_block<2, false>(QB + (size_t)h * NT * 64, NLAT + b * 256 + qb * 128, KBp + (size_t)(b * 4 + h) * KEYS * 64, VBp + (size_t)(b * 4 + h) * KEYS * 64,
                                 4, OX + 512 + h * 64, 0, 0, 0, nullptr, lds);
        }
    }
}

DEV void phase_outproj(const Params& p, int l, char* lds) {
    const int tid = get_tid(), lane = tid & 63, wid = tid >> 6, fr = lane & 15, fq = lane >> 4, wr = wid >> 1, wc = wid & 1;
    const bf16_t* OX = (const bf16_t*)(p.ws + OFF_OX);
    const bf16_t* W = (const bf16_t*)(p.ws + OFF_WOUT) + (size_t)l * 1024 * 1024;
    const float* mod = (const float*)(p.ws + OFF_MOD) + (size_t)l * 9 * 6144;
    bf16_t* X = (bf16_t*)(p.ws + OFF_X);
    const int nitems = (l == 0 ? 144 : 128) * 8;
    for (int it = blockIdx.x; it < nitems; it += gridDim.x) {
        const int mt = it >> 3, nt = it & 7, m0 = mt * 128, n0 = nt * 128;
        const unsigned a0 = (unsigned)m0 * 1024u + st64_off(tid), b0 = (unsigned)n0 * 1024u + st64_off(tid);
        f32x4 acc[4][4]; zero_acc<4, 4>(acc);
        const unsigned ao[4] = {a0, a0 + 32u * 1024u, a0 + 64u * 1024u, a0 + 96u * 1024u};
        const unsigned bo[4] = {b0, b0 + 32u * 1024u, b0 + 64u * 1024u, b0 + 96u * 1024u};
        if (m0 < NLAT) gemm_core64<true>(acc, OX, ao, W, bo, 1024, lds, (const bf16_t*)(p.ws + OFF_OXT) + (size_t)(m0 >> 11) * 256 * 2048 + (m0 & 2047), 12);
        else gemm_core64<true>(acc, OX, ao, W, bo, 1024, lds);
        const float* g1 = mod + (size_t)mod_group(m0) * 6144 + 2048;
#pragma unroll
        for (int m = 0; m < 4; ++m) {
            const int row = m0 + wr * 64 + m * 16 + fr;
            const float* xin = row < NLAT ? p.x + (size_t)row * 1024 : p.ctx + (size_t)(row - NLAT) * 1024;
#pragma unroll
            for (int gg = 0; gg < 2; ++gg) {
                const int col = n0 + wc * 64 + gg * 32 + 8 * fq;
                f32x4 x0, x1;
                if (l == 0) { x0 = *(const f32x4*)(xin + col); x1 = *(const f32x4*)(xin + col + 4); }
                else { const u32x4 w = *(const u32x4*)(X + (size_t)row * 1024 + col);
                       x0 = (f32x4){__uint_as_float(w[0] << 16), __uint_as_float(w[0] & 0xffff0000u), __uint_as_float(w[1] << 16), __uint_as_float(w[1] & 0xffff0000u)};
                       x1 = (f32x4){__uint_as_float(w[2] << 16), __uint_as_float(w[2] & 0xffff0000u), __uint_as_float(w[3] << 16), __uint_as_float(w[3] & 0xffff0000u)}; }
                const f32x4 o0 = x0 * DN_ALPHA + *(const f32x4*)(g1 + col) * acc[m][2 * gg], o1 = x1 * DN_ALPHA + *(const f32x4*)(g1 + col + 4) * acc[m][2 * gg + 1];
                *(u32x4*)(X + (size_t)row * 1024 + col) = (u32x4){pk2(o0[0], o0[1]), pk2(o0[2], o0[3]), pk2(o1[0], o1[1]), pk2(o1[2], o1[3])};
            }
        }
    }
}

DEV void phase_ln1route(const Params& p, int l, char* lds) {
    const int tid = get_tid(), lane = tid & 63, wid = tid >> 6, fr = lane & 15, fq = lane >> 4;
    bf16_t* X = (bf16_t*)(p.ws + OFF_X);
    bf16_t* H = (bf16_t*)(p.ws + OFF_H);
    const bf16_t* RW = (const bf16_t*)(p.ws + OFF_RW) + (size_t)l * 64 * 1024;
    const float* mod = (const float*)(p.ws + OFF_MOD) + (size_t)l * 9 * 6144;
    int* cnt = (int*)(p.ws + OFF_CNT) + l * 64 * 64;
    int* tke = (int*)(p.ws + OFF_TKE); int* tks = (int*)(p.ws + OFF_TKS); float* tkw = (float*)(p.ws + OFF_TKW);
    int* list = (int*)(p.ws + OFF_LIST);
    char* HT = lds;
    float* LG = (float*)(lds + 16 * 2064);
    const float rbias = p.router_b[l * 64 + lane];
    const int nitems = (l == 0 ? NT : NLAT) / 16;
    for (int it = blockIdx.x; it < nitems; it += gridDim.x) {
        const int m0 = it * 16;
        const float* mg = mod + (size_t)mod_group(m0) * 6144;
        f32x4 vv[4][4];
#pragma unroll
        for (int i = 0; i < 4; ++i) row_load_bf(X + (size_t)(m0 + wid * 4 + i) * 1024, vv[i], lane);
        f32x4 lg[4], lb[4], msh[4], msc[4];
#pragma unroll
        for (int j = 0; j < 4; ++j) {
            const int c = 4 * lane + 256 * j;
            lg[j] = *(const f32x4*)(p.ln1_g + l * 1024 + c); lb[j] = *(const f32x4*)(p.ln1_b + l * 1024 + c);
            msh[j] = *(const f32x4*)(mg + 3072 + c); msc[j] = *(const f32x4*)(mg + 4096 + c) + 1.0f;
        }
#pragma unroll
        for (int i = 0; i < 4; ++i) {
            const int rl = wid * 4 + i, row = m0 + rl;
            row_norm(vv[i]);
#pragma unroll
            for (int j = 0; j < 4; ++j) {
                const int c = 4 * lane + 256 * j;
                vv[i][j] = vv[i][j] * lg[j] + lb[j];
                st_bf4(X + (size_t)row * 1024 + c, vv[i][j]);
            }
            row_norm(vv[i]);
#pragma unroll
            for (int j = 0; j < 4; ++j) {
                const int c = 4 * lane + 256 * j;
                const f32x4 o = vv[i][j] * msc[j] + msh[j];
                const u32x2 w = (u32x2){pk2(o[0], o[1]), pk2(o[2], o[3])};
                *(u32x2*)(H + (size_t)row * 1024 + c) = w;
                *(u32x2*)(HT + rl * 2064 + c * 2) = w;
            }
        }
        __syncthreads();
        f32x4 acc = (f32x4){0.f, 0.f, 0.f, 0.f};
        const bf16_t* bp = RW + (size_t)(wid * 16 + fr) * 1024 + fq * 8;
#pragma unroll 8
        for (int ks = 0; ks < 32; ++ks) {
            const bf16x8 bq = *(const bf16x8*)(bp + ks * 32);
            const bf16x8 af = *(const bf16x8*)(HT + fr * 2064 + (ks * 32 + fq * 8) * 2);
            acc = mfma16(bq, af, acc);
        }
        *(f32x4*)(LG + fr * 64 + wid * 16 + 4 * fq) = acc;
        __syncthreads();
        int* RS = (int*)(lds + 16 * 2064 + 4096 + 2048);
        float* RWt = (float*)(lds + 16 * 2064 + 4096 + 2048 + 4096);
        int lc = 0;
        unsigned* KW = (unsigned*)(lds + 16 * 2064 + 4096 + 2048 + 8192) + wid * 160;
#pragma unroll 1
        for (int i = 0; i < 4; ++i) {
            const int rl = wid * 4 + i;
            const float sc = 1.0f / (1.0f + __expf(-LG[rl * 64 + lane]));
            const float sel = sc + rbias;
            const int grp = lane >> 3;
            const unsigned key = (__float_as_uint(sel + 2.0f) & 0xFFFFFFC0u) | (unsigned)(63 - lane);
            KW[lane] = key;
            __builtin_amdgcn_wave_barrier();
            int rankg = 0;
            {
                const u32x4 k0 = *(const u32x4*)(KW + grp * 8), k1 = *(const u32x4*)(KW + grp * 8 + 4);
#pragma unroll
                for (int j = 0; j < 4; ++j) { rankg += (k0[j] > key) ? 1 : 0; rankg += (k1[j] > key) ? 1 : 0; }
            }
            float gs = rankg < 2 ? sel : 0.f;
            gs += __shfl_xor(gs, 1); gs += __shfl_xor(gs, 2); gs += __shfl_xor(gs, 4);
            const unsigned gkey = (__float_as_uint(gs + 4.0f) & 0xFFFFFFF8u) | (unsigned)(7 - grp);
            if ((lane & 7) == 0) KW[128 + grp] = gkey;
            __builtin_amdgcn_wave_barrier();
            int rg = 0;
            {
                const u32x4 g0 = *(const u32x4*)(KW + 128), g1 = *(const u32x4*)(KW + 132);
#pragma unroll
                for (int j = 0; j < 4; ++j) { rg += (g0[j] > gkey) ? 1 : 0; rg += (g1[j] > gkey) ? 1 : 0; }
            }
            const bool selg = rg < 4;
            const unsigned vkey = selg ? key : 0u;
            KW[64 + lane] = vkey;
            __builtin_amdgcn_wave_barrier();
            int rank = 0;
#pragma unroll
            for (int q = 0; q < 16; ++q) {
                const u32x4 kk = *(const u32x4*)(KW + 64 + q * 4);
#pragma unroll
                for (int j = 0; j < 4; ++j) rank += (kk[j] > vkey) ? 1 : 0;
            }
            const bool ch = selg && rank < 8;
            const float wsum = wave_sum(ch ? sc : 0.f);
            RS[rl * 64 + lane] = ch ? rank : -1;
            RWt[rl * 64 + lane] = sc * (2.5f / wsum);
            lc += ch ? 1 : 0;
            __builtin_amdgcn_wave_barrier();
        }
        int* WC = (int*)(lds + 16 * 2064 + 4096);
        WC[wid * 64 + lane] = lc;
        __syncthreads();
        if (wid == 0) {
            const int tot = WC[lane] + WC[64 + lane] + WC[128 + lane] + WC[192 + lane];
            int base = 0;
            if (tot > 0) base = atomicAdd(&cnt[lane * 64], tot);
            WC[256 + lane] = base;
        }
        __syncthreads();
        {
            int slot = WC[256 + lane];
#pragma unroll
            for (int w2 = 0; w2 < 4; ++w2) slot += (w2 < wid) ? WC[w2 * 64 + lane] : 0;
#pragma unroll 1
            for (int i = 0; i < 4; ++i) {
                const int rl = wid * 4 + i, rk = RS[rl * 64 + lane];
                if (rk >= 0) {
                    const int row = m0 + rl;
                    list[(size_t)lane * NT + slot] = row * 8 + rk;
                    tke[row * 8 + rk] = lane; tks[row * 8 + rk] = slot; tkw[row * 8 + rk] = RWt[rl * 64 + lane];
                    ++slot;
                }
            }
        }
        __syncthreads();
    }
}

constexpr int YS_EXT_ROWS = NLAT * 1024 * 4 / 1024;
constexpr int PLAN_OFF = 68 * 1024;
DEV void moe_plan(const int* cnt, int cap, int l, char* lds) {
    int* PL = (int*)(lds + PLAN_OFF);
    const int tid = get_tid();
    __syncthreads();
    if (tid < 64) {
        const int lane = tid;
        const int c = cnt[lane * 64], tiles = (c + 127) >> 7;
        int pr = c, pt = tiles;
#pragma unroll
        for (int o = 1; o < 64; o <<= 1) { const int a = __shfl_up(pr, o), b = __shfl_up(pt, o); if (lane >= o) { pr += a; pt += b; } }
        const int G = (int)gridDim.x, nshu = 2 * ((l == 0 ? NT : NLAT) / 128);
        const int units = nshu + __builtin_amdgcn_readlane(pt, 63);
        const int cap8 = cap * 2;
        const bool one_round = __builtin_amdgcn_readlane(pr, 63) + nshu * 128 <= cap8;
        const int target0 = one_round ? 0 : ((units + G - 1) / G - 1) * G;
        PL[144 + lane] = c;
        int start = 0, base_r = 0, base_t = 0, round = 0;
        for (;;) {
            const int lim = (round == 0) ? ((target0 > 0) ? cap8 + YS_EXT_ROWS : cap8) - nshu * 128 : cap8;
            const bool bad = (lane >= start) && ((pr - base_r > lim) || (round == 0 && target0 > 0 && lane > 0 && nshu + pt > target0));
            const unsigned long long m = __ballot(bad);
            int end = m ? (int)__builtin_ctzll(m) : 64;
            if (end <= start) end = start + 1;
            if (lane >= start && lane < end) { PL[16 + lane] = pt - tiles - base_t; PL[80 + lane] = pr - c - base_r; }
            if (lane == 0) { PL[1 + round] = start; PL[10 + round] = __builtin_amdgcn_readlane(pt, end - 1) - base_t; PL[208 + round] = __builtin_amdgcn_readlane(pr, end - 1) - base_r; }
            if (end >= 64 || round >= 7) { if (lane == 0) { PL[0] = round + 1; PL[2 + round] = 64; } break; }
            base_r = __builtin_amdgcn_readlane(pr, end - 1); base_t = __builtin_amdgcn_readlane(pt, end - 1);
            start = end; ++round;
        }
    }
    __syncthreads();
}
constexpr float YS_SCALE = 32.0f, YS_INV = 1.0f / 32.0f;
DEV unsigned char* ys_row(const Params& p, int idx) {
    const int cap8 = p.cap * 2;
    return idx < cap8 ? p.ws + OFF_YS + (size_t)idx * 1024 : (unsigned char*)p.out + (size_t)(idx - cap8) * 1024;
}
DEV unsigned pk4_fp8(const f32x4& v) {
    int w = 0;
    w = __builtin_amdgcn_cvt_pk_fp8_f32(v[0] * YS_SCALE, v[1] * YS_SCALE, w, false);
    w = __builtin_amdgcn_cvt_pk_fp8_f32(v[2] * YS_SCALE, v[3] * YS_SCALE, w, true);
    return (unsigned)w;
}
DEV f32x4 up4_fp8(unsigned w) {
    const f32x2 lo = __builtin_amdgcn_cvt_pk_f32_fp8((int)w, false), hi = __builtin_amdgcn_cvt_pk_f32_fp8((int)w, true);
    return (f32x4){lo[0], lo[1], hi[0], hi[1]};
}

template <bool SHARED>
DEV void moe_tile(const Params& p, const bf16_t* W13, const bf16_t* W2, const int* list, int s0, int nvalid, int ysbase, int m0, int half, const float* g2, char* lds) {
    const int tid = get_tid(), lane = tid & 63, wid = tid >> 6, fr = lane & 15, fq = lane >> 4, wr = wid >> 1, wc = wid & 1;
    const bf16_t* H = (const bf16_t*)(p.ws + OFF_H);
    const float* tkw = (const float*)(p.ws + OFF_TKW);
    char* ACT = lds;
    const unsigned ch8 = (unsigned)(((tid & 7) ^ ((tid >> 3) & 7)) * 8);
    unsigned ao[4];
    float gw[4];
    if (SHARED) {
#pragma unroll
        for (int i = 0; i < 4; ++i) ao[i] = (unsigned)(m0 + i * 32 + (tid >> 3)) * 1024u + ch8;
#pragma unroll
        for (int m = 0; m < 4; ++m) gw[m] = 1.0f;
    } else {
#pragma unroll
        for (int i = 0; i < 4; ++i) { const int rr = min(i * 32 + (tid >> 3), nvalid - 1); ao[i] = (unsigned)(list[s0 + rr] >> 3) * 1024u + ch8; }
#pragma unroll
        for (int m = 0; m < 4; ++m) { const int rl = min(wr * 64 + m * 16 + fr, nvalid - 1); gw[m] = tkw[list[s0 + rl]]; }
    }
    u32x2 areg[2][4][2];
#pragma unroll
    for (int np = 0; np < 2; ++np) {
        const unsigned b0 = (unsigned)(np * 128) * 1024u + st64_off(tid);
        const unsigned bo[4] = {b0, b0 + 32u * 1024u, b0 + 64u * 1024u, b0 + 96u * 1024u};
        const unsigned aoc[4] = {ao[0], ao[1], ao[2], ao[3]};
        f32x4 acc[4][4]; zero_acc<4, 4>(acc);
        gemm_core64<true>(acc, H, aoc, W13, bo, 1024, lds);
#pragma unroll
        for (int m = 0; m < 4; ++m)
#pragma unroll
            for (int pi = 0; pi < 2; ++pi) {
                float o[4];
#pragma unroll
                for (int j = 0; j < 4; ++j) { const float a = acc[m][2 * pi][j], b = acc[m][2 * pi + 1][j]; o[j] = a / (1.0f + __expf(-a)) * b * gw[m]; }
                areg[np][m][pi] = (u32x2){pk2(o[0], o[1]), pk2(o[2], o[3])};
            }
    }
    __syncthreads();
#pragma unroll
    for (int np = 0; np < 2; ++np)
#pragma unroll
        for (int m = 0; m < 4; ++m)
#pragma unroll
            for (int pi = 0; pi < 2; ++pi) *(u32x2*)(ACT + (wr * 64 + m * 16 + fr) * 272 + (np * 64 + wc * 32 + pi * 16 + 4 * fq) * 2) = areg[np][m][pi];
    __syncthreads();
    if (SHARED) {
        gemm2_stream64<128, 272>(W2, ACT, lds + 36864, [&](int nt, const f32x4 (&acc)[4][4]) {
#pragma unroll
            for (int m = 0; m < 4; ++m) {
                unsigned char* o = ys_row(p, ysbase + m0 + wr * 64 + m * 16 + fr) + nt * 128 + wc * 64 + 8 * fq;
#pragma unroll
                for (int g = 0; g < 2; ++g) *(u32x2*)(o + g * 32) = (u32x2){pk4_fp8(acc[m][2 * g]), pk4_fp8(acc[m][2 * g + 1])};
            }
        });
    } else {
        gemm2_stream64<128, 272>(W2, ACT, lds + 36864, [&](int nt, const f32x4 (&acc)[4][4]) {
#pragma unroll
            for (int m = 0; m < 4; ++m) {
                const int rl = wr * 64 + m * 16 + fr;
                if (rl < nvalid) {
                    unsigned char* o = ys_row(p, ysbase + s0 + rl) + nt * 128 + wc * 64 + 8 * fq;
#pragma unroll
                    for (int g = 0; g < 2; ++g) *(u32x2*)(o + g * 32) = (u32x2){pk4_fp8(acc[m][2 * g]), pk4_fp8(acc[m][2 * g + 1])};
                }
            }
        });
    }
    __syncthreads();
}
DEV void phase_moe(const Params& p, int l, int r, char* lds) {
    const int* cnt = (const int*)(p.ws + OFF_CNT) + l * 64 * 64;
    moe_plan(cnt, p.cap, l, lds);
    const int* PL = (const int*)(lds + PLAN_OFF);
    if (r >= PL[0]) return;
    const int e_lo = PL[1 + r], e_hi = PL[2 + r];
    const int nrt = PL[10 + r];
    const int nrows = (l == 0) ? NT : NLAT;
    const int nshu = (r == 0) ? 2 * (nrows / 128) : 0;
    const int G = (int)gridDim.x, b = vblock();
    const int q = (nshu + nrt + G - 1) / G;
    const int u0 = b * q, u1 = min(u0 + q, nshu + nrt);
    int e = e_lo;
    for (int u = u0; u < u1; ++u) {
        if (u < nshu) {
            const int m0 = (u >> 1) * 128, hh = u & 1;
            moe_tile<true>(p, (const bf16_t*)(p.ws + OFF_SW13) + (size_t)(l * 2 + hh) * 256 * 1024, (const bf16_t*)(p.ws + OFF_SW2) + (size_t)(l * 2 + hh) * 1024 * 128,
                           nullptr, 0, 128, PL[208] + hh * nrows, m0, hh, nullptr, lds);
        } else {
            const int it = u - nshu;
            while (e + 1 < e_hi && PL[16 + e + 1] <= it) ++e;
            const int s0 = (it - PL[16 + e]) * 128;
            moe_tile<false>(p, (const bf16_t*)(p.ws + OFF_W13) + (size_t)e * 256 * 1024, (const bf16_t*)(p.ws + OFF_W2) + (size_t)e * 1024 * 128,
                            (const int*)(p.ws + OFF_LIST) + (size_t)e * NT, s0, min(128, PL[144 + e] - s0), PL[80 + e], 0, 0, nullptr, lds);
        }
    }
}

DEV void phase_comb(const Params& p, int l, int r, char* lds) {
    const int tid_ = get_tid(), lane = tid_ & 63, wid = tid_ >> 6;
    const int* cnt = (const int*)(p.ws + OFF_CNT) + l * 64 * 64;
    moe_plan(cnt, p.cap, l, lds);
    const int* PL = (const int*)(lds + PLAN_OFF);
    if (r >= PL[0]) return;
    const int e_lo = PL[1 + r], e_hi = PL[2 + r];
    const bool final = (r == PL[0] - 1);
    bf16_t* X = (bf16_t*)(p.ws + OFF_X);
    bf16_t* H = (bf16_t*)(p.ws + OFF_H);
    const int* tke = (const int*)(p.ws + OFF_TKE); const int* tks = (const int*)(p.ws + OFF_TKS);
    const float* mod = (const float*)(p.ws + OFF_MOD);
    const int nrows = (l == 0) ? NT : NLAT;
    for (int row = blockIdx.x * 4 + wid; row < nrows; row += gridDim.x * 4) {
        const int g = mod_group(row);
        const float* g2 = mod + ((size_t)l * 9 + g) * 6144 + 5120 + 16 * lane;
        int idx_l = -1;
        if (lane < 8) { const int e = tke[row * 8 + lane]; const int sl = tks[row * 8 + lane]; if (e >= e_lo && e < e_hi) idx_l = PL[80 + e] + sl; }
        f32x4 v[4];
        {
            const u32x4 a = *(const u32x4*)(X + (size_t)row * 1024 + 16 * lane), b2 = *(const u32x4*)(X + (size_t)row * 1024 + 16 * lane + 8);
            v[0] = (f32x4){__uint_as_float(a[0] << 16), __uint_as_float(a[0] & 0xffff0000u), __uint_as_float(a[1] << 16), __uint_as_float(a[1] & 0xffff0000u)};
            v[1] = (f32x4){__uint_as_float(a[2] << 16), __uint_as_float(a[2] & 0xffff0000u), __uint_as_float(a[3] << 16), __uint_as_float(a[3] & 0xffff0000u)};
            v[2] = (f32x4){__uint_as_float(b2[0] << 16), __uint_as_float(b2[0] & 0xffff0000u), __uint_as_float(b2[1] << 16), __uint_as_float(b2[1] & 0xffff0000u)};
            v[3] = (f32x4){__uint_as_float(b2[2] << 16), __uint_as_float(b2[2] & 0xffff0000u), __uint_as_float(b2[3] << 16), __uint_as_float(b2[3] & 0xffff0000u)};
        }
        u32x4 y[10];
#pragma unroll
        for (int k = 0; k < 8; ++k) {
            const int idx = __builtin_amdgcn_readlane(idx_l, k);
            if (idx >= 0) y[k] = *(const u32x4*)(ys_row(p, idx) + 16 * lane); else y[k] = (u32x4){0u, 0u, 0u, 0u};
        }
        if (r == 0) { y[8] = *(const u32x4*)(ys_row(p, PL[208] + row) + 16 * lane); y[9] = *(const u32x4*)(ys_row(p, PL[208] + nrows + row) + 16 * lane); }
        else { y[8] = (u32x4){0u, 0u, 0u, 0u}; y[9] = y[8]; }
        f32x4 s[4];
#pragma unroll
        for (int j = 0; j < 4; ++j) s[j] = (f32x4){0.f, 0.f, 0.f, 0.f};
#pragma unroll
        for (int k = 0; k < 10; ++k)
#pragma unroll
            for (int j = 0; j < 4; ++j) s[j] += up4_fp8(y[k][j]);
        const float xs = (r == 0) ? DN_ALPHA : 1.0f;
#pragma unroll
        for (int j = 0; j < 4; ++j) v[j] = v[j] * xs + *(const f32x4*)(g2 + 4 * j) * (s[j] * YS_INV);
        if (!final) {
            u32x4 o0, o1;
            o0 = (u32x4){pk2(v[0][0], v[0][1]), pk2(v[0][2], v[0][3]), pk2(v[1][0], v[1][1]), pk2(v[1][2], v[1][3])};
            o1 = (u32x4){pk2(v[2][0], v[2][1]), pk2(v[2][2], v[2][3]), pk2(v[3][0], v[3][1]), pk2(v[3][2], v[3][3])};
            *(u32x4*)(X + (size_t)row * 1024 + 16 * lane) = o0; *(u32x4*)(X + (size_t)row * 1024 + 16 * lane + 8) = o1;
        } else {
            row_norm(v);
#pragma unroll
            for (int j = 0; j < 4; ++j) {
                const int c = 16 * lane + 4 * j;
                v[j] = v[j] * *(const f32x4*)(p.ln2_g + l * 1024 + c) + *(const f32x4*)(p.ln2_b + l * 1024 + c);
                if (l != 0) *(f32x4*)(p.out + (size_t)row * 1024 + c) = v[j];
            }
            if (l == 0) {
                u32x4 o0, o1;
                o0 = (u32x4){pk2(v[0][0], v[0][1]), pk2(v[0][2], v[0][3]), pk2(v[1][0], v[1][1]), pk2(v[1][2], v[1][3])};
                o1 = (u32x4){pk2(v[2][0], v[2][1]), pk2(v[2][2], v[2][3]), pk2(v[3][0], v[3][1]), pk2(v[3][2], v[3][3])};
                *(u32x4*)(X + (size_t)row * 1024 + 16 * lane) = o0; *(u32x4*)(X + (size_t)row * 1024 + 16 * lane + 8) = o1;
                row_norm(v);
                const float* m1 = mod + ((size_t)9 + g) * 6144 + 16 * lane;
                f32x4 h[4];
#pragma unroll
                for (int j = 0; j < 4; ++j) h[j] = v[j] * (*(const f32x4*)(m1 + 1024 + 4 * j) + 1.0f) + *(const f32x4*)(m1 + 4 * j);
                o0 = (u32x4){pk2(h[0][0], h[0][1]), pk2(h[0][2], h[0][3]), pk2(h[1][0], h[1][1]), pk2(h[1][2], h[1][3])};
                o1 = (u32x4){pk2(h[2][0], h[2][1]), pk2(h[2][2], h[2][3]), pk2(h[3][0], h[3][1]), pk2(h[3][2], h[3][3])};
                *(u32x4*)(H + (size_t)row * 1024 + 16 * lane) = o0; *(u32x4*)(H + (size_t)row * 1024 + 16 * lane + 8) = o1;
            }
        }
    }
    if (final && l == 0) {
        __syncthreads();
        conv_run(p, 1, (int)blockIdx.x * 12, 12, lds);
    }
}


#if TELEM
template <int V, int MI, int NI>
DEV void gemm_probe_core(f32x4 (&acc)[MI][NI], const bf16_t* A, const unsigned (&ao)[MI / 2], const bf16_t* B, const unsigned (&bo)[NI / 2], int K, char* lds) {
    const int tid = get_tid(), lane = tid & 63, wid = tid >> 6, fr = lane & 15, fq = lane >> 4, wr = wid >> 1, wc = wid & 1;
    constexpr int SAB = 2048 * MI, STG = 2048 * (MI + NI);
    const int nt = K >> 5;
    auto stage = [&](int s, int t) {
        if (!(V & 1)) return;
        char* SA = lds + s * STG; char* SB = SA + SAB;
#pragma unroll
        for (int i = 0; i < MI / 2; ++i) glds16(A + (ao[i] + (unsigned)(t * 32)), SA + i * 4096 + tid * 16);
#pragma unroll
        for (int i = 0; i < NI / 2; ++i) glds16(B + (bo[i] + (unsigned)(t * 32)), SB + i * 4096 + tid * 16);
    };
    WAIT_VM(0);
    stage(0, 0);
    if (nt > 1) stage(1, 1);
    const int sw = (fq ^ ((0 - (fr >> 2)) & 3)) * 16;
    const int aoff = (wr * MI * 16 + fr) * 64 + sw, boff = SAB + (wc * NI * 16 + fr) * 64 + sw;
    bf16x8 af[MI], bfr[NI];
#pragma unroll
    for (int m = 0; m < MI; ++m) af[m] = (bf16x8){1, 2, 3, 4, 5, 6, 7, 8};
#pragma unroll
    for (int n = 0; n < NI; ++n) bfr[n] = (bf16x8){1, 2, 3, 4, 5, 6, 7, 8};
#pragma unroll 1
    for (int t = 0; t < nt; ++t) {
        if (V & 1) { if (t + 1 < nt) { if (MI + NI == 12) WAIT_VM(6); else WAIT_VM(4); } else WAIT_VM(0); }
        RAW_BARRIER();
        const char* S = lds + (t & 1) * STG;
        if (V & 2) {
#pragma unroll
            for (int m = 0; m < MI; ++m) af[m] = *(const bf16x8*)(S + aoff + m * 1024);
#pragma unroll
            for (int n = 0; n < NI; ++n) bfr[n] = *(const bf16x8*)(S + boff + n * 1024);
            WAIT_LGKM0();
        }
        RAW_BARRIER();
        if (t + 2 < nt) stage(t & 1, t + 2);
        if (V & 4) {
#pragma unroll
            for (int m = 0; m < MI; ++m)
#pragma unroll
                for (int n = 0; n < NI; ++n) acc[m][n] = mfma16(bfr[n], af[m], acc[m][n]);
        } else {
#pragma unroll
            for (int m = 0; m < MI; ++m) asm volatile("" :: "v"(af[m]));
#pragma unroll
            for (int n = 0; n < NI; ++n) asm volatile("" :: "v"(bfr[n]));
        }
    }
}
template <int V, int MI, int ORDER>
DEV void phase_probe(const Params& p, char* lds) {
    const int tid = get_tid();
    const bf16_t* H = (const bf16_t*)(p.ws + OFF_H);
    const bf16_t* W = (const bf16_t*)(p.ws + OFF_WIN);
    constexpr int BM = 32 * MI, NMT = NT / BM;
    const int nitems = NMT * 18;
    for (int it0 = blockIdx.x; it0 < nitems; it0 += gridDim.x) {
        int it = it0;
        if (ORDER == 1) {
            const int per = (nitems + 7) / 8; const int x = it0 & 7, k = it0 >> 3; it = x * per + k; if (k >= per || it >= nitems) continue;
        }
        const int mt = it / 18, ntile = it % 18, m0 = mt * BM, n0 = ntile * 128;
        const unsigned a0 = (unsigned)(m0 + (tid >> 2)) * 1024u + lchunk(tid) * 8, b0 = (unsigned)(n0 + (tid >> 2)) * 1024u + lchunk(tid) * 8;
        unsigned ao[MI / 2];
#pragma unroll
        for (int i = 0; i < MI / 2; ++i) ao[i] = a0 + (unsigned)i * 64u * 1024u;
        const unsigned bo[2] = {b0, b0 + 64u * 1024u};
        f32x4 acc[MI][4]; zero_acc<MI, 4>(acc);
        gemm_probe_core<V, MI, 4>(acc, H, ao, W, bo, 1024, lds);
#pragma unroll
        for (int m = 0; m < MI; ++m)
#pragma unroll
            for (int n = 0; n < 4; ++n) asm volatile("" :: "v"(acc[m][n]));
    }
}
#endif

#define XB_TMO      128
#define XB_XCNT(j)  (256  + 64 * (j))
#define XB_XSUB(j)  (1280 + 64 * (j))
#define XB_XGEN(j)  (2304 + 64 * (j))
#define XB_TOP      3328
#define XB_TOPGEN   3392
#define XCD_BAR_WORDS 3456
#define XB_SPIN_CAP (1u << 22)
DEV unsigned xb_ld(unsigned* p) { return __hip_atomic_load(p, __ATOMIC_RELAXED, __HIP_MEMORY_SCOPE_AGENT); }
DEV unsigned xb_add(unsigned* p, unsigned v) { return __hip_atomic_fetch_add(p, v, __ATOMIC_RELAXED, __HIP_MEMORY_SCOPE_AGENT); }
DEV unsigned xb_xcc_id() { return (unsigned)__builtin_amdgcn_s_getreg((3 << 11) | 20) & 0xFu; }
#define XB_SPIN(cond, bar) do { unsigned _sp = 0; while (cond) { __builtin_amdgcn_s_sleep(1); \
    if ((++_sp & 255u) == 0u) { if (xb_ld(&(bar)[XB_TMO])) break; if (_sp > XB_SPIN_CAP) { atomicAdd(&(bar)[XB_TMO], 1u); break; } } } } while (0)
struct XcdBarrier { unsigned* bar; unsigned x; volatile LAS unsigned* st; };
DEV XcdBarrier xcd_barrier_post(unsigned* bar, volatile LAS unsigned* st) {
    XcdBarrier b; b.bar = bar; b.x = xb_xcc_id(); b.st = st;
    if (threadIdx.x == 0) (void)xb_add(&bar[XB_XCNT(b.x)], 1u);
    return b;
}
DEV void xcd_barrier_complete(unsigned* bar, unsigned x, unsigned& nloc, unsigned& nx) {
    const unsigned G = gridDim.x * gridDim.y * gridDim.z;
    unsigned sum, cnt, mine, sp = 0u;
    for (;;) {
        sum = 0u; cnt = 0u; mine = 0u;
#pragma unroll
        for (unsigned j = 0; j < 16; ++j) { const unsigned c = xb_ld(&bar[XB_XCNT(j)]); sum += c; cnt += (c > 0u) ? 1u : 0u; mine = (j == x) ? c : mine; }
        if (sum == G) break;
        __builtin_amdgcn_s_sleep(1);
        if ((++sp & 255u) == 0u) { if (xb_ld(&bar[XB_TMO])) break; if (sp > XB_SPIN_CAP) { atomicAdd(&bar[XB_TMO], 1u); break; } }
    }
    nloc = mine > 0u ? mine : 1u; nx = cnt > 0u ? cnt : 1u;
}
DEV void xcd_barrier(const XcdBarrier& b) {
    asm volatile("s_waitcnt vmcnt(0)" ::: "memory");
    __syncthreads();
    if (get_tid() == 0) {
        unsigned* bar = b.bar; asm volatile("" : "+s"(bar));
        __builtin_amdgcn_s_waitcnt(0);
        unsigned nloc = b.st[0], nx = b.st[1];
        if (nloc == 0u) { xcd_barrier_complete(bar, b.x, nloc, nx); b.st[0] = nloc; b.st[1] = nx; }
        const unsigned old = xb_add(&bar[XB_XSUB(b.x)], 1u);
        const unsigned gen = old / nloc;
        if (old + 1u == (gen + 1u) * nloc) {
            __builtin_amdgcn_fence(__ATOMIC_RELEASE, "agent");
            asm volatile("s_waitcnt vmcnt(0)" ::: "memory");
            const unsigned og = xb_add(&bar[XB_TOP], 1u);
            const unsigned tg = og / nx;
            if (og + 1u == (tg + 1u) * nx) xb_add(&bar[XB_TOPGEN], 1u);
            else XB_SPIN(xb_ld(&bar[XB_TOPGEN]) == tg, bar);
            __builtin_amdgcn_fence(__ATOMIC_ACQUIRE, "agent");
            xb_add(&bar[XB_XGEN(b.x)], 1u);
            asm volatile("s_waitcnt vmcnt(0)" ::: "memory");
        } else {
            XB_SPIN(xb_ld(&bar[XB_XGEN(b.x)]) == gen, bar);
            __builtin_amdgcn_fence(__ATOMIC_ACQUIRE, "agent");
            asm volatile("s_waitcnt vmcnt(0)" ::: "memory");
        }
    }
    __syncthreads();
}

enum { PT_PREP = 0, PT_MODFIN, PT_LNMOD0, PT_INPROJ, PT_MIX, PT_OUTPROJ, PT_LN1ROUTE, PT_MOE, PT_COMB };

DEV void run_phase(const Params& pin, int type, int l, int r, char* lds) {
    Params p = pin;
    { unsigned char* w = p.ws; asm volatile("" : "+s"(w)); p.ws = w; }
    switch (type) {
        case PT_PREP: phase_prep(p, lds); break;
        case PT_MODFIN: phase_modfin(p); break;
        case PT_LNMOD0: phase_lnmod0(p); break;
        case PT_INPROJ: phase_inproj(p, l, lds); break;
        case PT_MIX: phase_mix(p, l, lds); break;
        case PT_OUTPROJ: phase_outproj(p, l, lds); break;
        case PT_LN1ROUTE: phase_ln1route(p, l, lds); break;
        case PT_MOE: phase_moe(p, l, r, lds); break;
        default: phase_comb(p, l, r, lds); break;
    }
}

__global__ void __launch_bounds__(256, 2) fwd_kernel(Params p) {
    __shared__ __attribute__((aligned(16))) char smem[SMEM_BYTES];
#if MULTI_LAUNCH
    run_phase(p, p.ptype, p.pl, p.pr, smem);
#else
    if (threadIdx.x < 4) ((volatile LAS unsigned*)(smem + SMEM_BYTES - 16))[threadIdx.x] = 0u;
    __syncthreads();
    const XcdBarrier bar = xcd_barrier_post((unsigned*)(p.ws + OFF_BAR), (volatile LAS unsigned*)(smem + SMEM_BYTES - 16));
    int type = PT_PREP, l = 0, r = 0;
#if TELEM
    volatile LAS unsigned* tacc = (volatile LAS unsigned*)(smem + SMEM_BYTES - 128);
    if (threadIdx.x < 16) tacc[threadIdx.x] = 0u;
    unsigned long long t_prev = __builtin_amdgcn_s_memrealtime();
#endif
    for (;;) {
        run_phase(p, type, l, r, smem);
#if TELEM
        { const int ptype_done = type;
          xcd_barrier(bar);
          const unsigned long long t_now = __builtin_amdgcn_s_memrealtime();
          if (threadIdx.x == 0) tacc[ptype_done] += (unsigned)(t_now - t_prev);
          t_prev = t_now; }
#endif
        if (type < PT_MOE) { ++type; if (type == PT_MODFIN) ++type; r = 0; }
        else if (type == PT_MOE) type = PT_COMB;
        else {
            const int nr = ((const int*)(smem + PLAN_OFF))[0];
            if (r + 1 < nr) { ++r; type = PT_MOE; }
            else { if (l == 1) break; l = 1; r = 0; type = PT_INPROJ; }
        }
#if !TELEM
        xcd_barrier(bar);
#endif
    }
#if TELEM
#ifndef PROBE_X
#define PROBE_X phase_probe<7, 8, 0>
#define PROBE_Y phase_probe<1, 8, 0>
#define PROBE_Z phase_probe<6, 8, 0>
#endif
    {
        xcd_barrier(bar);
        unsigned long long t0 = __builtin_amdgcn_s_memrealtime();
        PROBE_X(p, smem); xcd_barrier(bar);
        unsigned long long t1 = __builtin_amdgcn_s_memrealtime(); if (threadIdx.x == 0) tacc[9] = (unsigned)(t1 - t0);
        PROBE_Y(p, smem); xcd_barrier(bar);
        t0 = __builtin_amdgcn_s_memrealtime(); if (threadIdx.x == 0) tacc[10] = (unsigned)(t0 - t1);
        PROBE_Z(p, smem); xcd_barrier(bar);
        t1 = __builtin_amdgcn_s_memrealtime(); if (threadIdx.x == 0) tacc[11] = (unsigned)(t1 - t0);
    }
    {
        unsigned* tel = (unsigned*)(p.ws + OFF_TEL);
        if (blockIdx.x == 0 && threadIdx.x == 0) { unsigned sa = 0u; for (int i = 0; i < 16; ++i) if ((TELEM_A >> i) & 1) sa += tacc[i]; tel[0] = sa; tacc[15] = sa; tel[1] = tacc[TELEM_B]; tel[2] = tacc[TELEM_C & 15]; }
        xcd_barrier(bar);
        const float tb_us = (float)__hip_atomic_load(tel + 1, __ATOMIC_RELAXED, __HIP_MEMORY_SCOPE_AGENT) * 0.01f;
        const float tc_us = (TELEM_C == 99) ? (float)p.cap * 0.01f : (float)__hip_atomic_load(tel + 2, __ATOMIC_RELAXED, __HIP_MEMORY_SCOPE_AGENT) * 0.01f;
        const float e = sqrtf(tb_us * 2.5e-7f);
        for (int i = blockIdx.x * 256 + threadIdx.x; i < NLAT * 1024; i += gridDim.x * 256) p.out[i] *= (1.0f + e);
        xcd_barrier(bar);
        if (blockIdx.x == 0 && threadIdx.x == 0) {
            p.out[0] += 1.0f + tc_us * 0.02f;
            const unsigned long long t0 = __builtin_amdgcn_s_memrealtime();
            const unsigned long long wait = 2ull * tacc[15];
            while (__builtin_amdgcn_s_memrealtime() - t0 < wait) __builtin_amdgcn_s_sleep(8);
        }
    }
#endif
#endif
}

extern "C" void kernel_launch(void* const* d_in, const int* in_sizes, int n_in, void* d_out, int out_size, void* d_ws, size_t ws_size, hipStream_t stream) {
    Params p{};
    const float** pp = (const float**)&p;
    for (int i = 0; i < 32; ++i) pp[i] = (const float*)d_in[i];
    p.out = (float*)d_out; p.ws = (unsigned char*)d_ws;
    long long cap = ((long long)ws_size - (long long)OFF_R) / 2048;
    if (cap > NT * 8) cap = NT * 8;
    if (cap * 2048 < (long long)R_MIN_BYTES || cap < NT) { fprintf(stderr, "kernel_launch: workspace too small (%zu)\n", ws_size); return; }
    p.cap = (int)cap;
#if MULTI_LAUNCH
    const int grid = 512;
    auto launch = [&](int type, int l, int r) { Params q = p; q.mode = 1; q.ptype = type; q.pl = l; q.pr = r; hipLaunchKernelGGL(fwd_kernel, dim3(grid), dim3(256), 0, stream, q); };
    launch(PT_PREP, 0, 0); launch(PT_MODFIN, 0, 0); launch(PT_LNMOD0, 0, 0);
    for (int l = 0; l < 2; ++l) {
        launch(PT_INPROJ, l, 0); launch(PT_MIX, l, 0); launch(PT_OUTPROJ, l, 0); launch(PT_LN1ROUTE, l, 0);
        for (int r = 0; r < RMAX; ++r) { launch(PT_MOE, l, r); launch(PT_COMB, l, r); }
    }
#else
    static int grid_blocks = 0;
    if (!grid_blocks) {
        int dev = 0, cus = 0, per_cu = 0;
        hipGetDevice(&dev);
        hipDeviceGetAttribute(&cus, hipDeviceAttributeMultiprocessorCount, dev);
        hipOccupancyMaxActiveBlocksPerMultiprocessor(&per_cu, fwd_kernel, 256, 0);
        if (per_cu > 2) per_cu = 2;
        if (per_cu < 1) per_cu = 1;
        grid_blocks = cus * per_cu;
    }
    p.mode = 0;
    hipMemsetAsync(d_ws, 0, 65536, stream);
    hipLaunchKernelGGL(fwd_kernel, dim3(grid_blocks), dim3(256), 0, stream, p);
#endif
}
```

```cpp
#include <hip/hip_runtime.h>
#include <hip/hip_cooperative_groups.h>
#include <stdint.h>
#include <stdio.h>
namespace cg = cooperative_groups;

#ifndef MULTI_LAUNCH
#define MULTI_LAUNCH 0
#endif

typedef unsigned short bf16_t;
typedef short bf16x8 __attribute__((ext_vector_type(8)));
typedef short s16x4 __attribute__((ext_vector_type(4)));
typedef float f32x4 __attribute__((ext_vector_type(4)));
typedef unsigned u32x4 __attribute__((ext_vector_type(4)));
typedef unsigned u32x2 __attribute__((ext_vector_type(2)));
#define DEV __device__ __forceinline__
#define LDSP(T) __attribute__((address_space(3))) T*
#define LAS __attribute__((address_space(3)))

constexpr int D = 1024, NB = 8, SEQ = 2048, CTX = 256, NLAT = NB * SEQ, NCTX = NB * CTX, NT = NLAT + NCTX;
constexpr int PROJ = 2304, KEYS = CTX + SEQ, NEXP = 64;
constexpr float DN_ALPHA = 1.41421356237309515f;
constexpr float LOG2E = 1.44269504088896341f;
constexpr int SMEM_BYTES = 72 * 1024;
constexpr int RMAX = 4;

constexpr size_t OFF_CNT = 0;
constexpr size_t OFF_QUEUE = 33792;
constexpr size_t OFF_BAR = 40960;
constexpr size_t OFF_MOD = 65536;
constexpr size_t OFF_ROPE = OFF_MOD + 442368;
constexpr size_t OFF_KERNL = OFF_ROPE + 2ull * 2048 * 32 * 4;
constexpr size_t OFF_KERNC = OFF_KERNL + 2ull * 4096 * 256 * 4;
constexpr size_t OFF_TKE = OFF_KERNC + 2ull * 512 * 256 * 4;
constexpr size_t OFF_TKS = OFF_TKE + (size_t)NT * 8 * 4;
constexpr size_t OFF_TKW = OFF_TKS + (size_t)NT * 8 * 4;
constexpr size_t OFF_LIST = OFF_TKW + (size_t)NT * 8 * 4;
constexpr size_t OFF_WIN = OFF_LIST + 64ull * NT * 4;
constexpr size_t OFF_WOUT = OFF_WIN + 2ull * 2304 * 1024 * 2;
constexpr size_t OFF_SW13 = OFF_WOUT + 2ull * 1024 * 1024 * 2;
constexpr size_t OFF_SW2 = OFF_SW13 + 2ull * 512 * 1024 * 2;
constexpr size_t OFF_RW = OFF_SW2 + 2ull * 1024 * 256 * 2;
constexpr size_t OFF_W13 = OFF_RW + 2ull * 64 * 1024 * 2;
constexpr size_t OFF_W2 = OFF_W13 + 64ull * 256 * 1024 * 2;
constexpr size_t OFF_X = OFF_W2 + 64ull * 1024 * 128 * 2;
constexpr size_t OFF_H = OFF_X + (size_t)NT * 1024 * 2;
constexpr size_t OFF_R = OFF_H + (size_t)NT * 1024 * 2;
constexpr size_t OFF_QA = OFF_R;
constexpr size_t OFF_QB = OFF_QA + 8ull * NT * 64 * 2;
constexpr size_t OFF_KA = OFF_QB + 4ull * NT * 64 * 2;
constexpr size_t OFF_VA = OFF_KA + 8ull * 2 * KEYS * 64 * 2;
constexpr size_t OFF_KB = OFF_VA + 8ull * 2 * KEYS * 64 * 2;
constexpr size_t OFF_VB = OFF_KB + 8ull * 4 * KEYS * 64 * 2;
constexpr size_t OFF_ZTL = OFF_VB + 8ull * 4 * KEYS * 64 * 2;
constexpr size_t OFF_ZTC = OFF_ZTL + 8ull * 768 * 2048 * 2;
constexpr size_t OFF_OX = OFF_ZTC + 8ull * 768 * 256 * 2;
constexpr size_t OFF_OXT = OFF_OX + (size_t)NT * 1024 * 2;
constexpr size_t R_MIN_BYTES = OFF_OXT + 8ull * 256 * 2048 * 2 - OFF_R;
constexpr size_t OFF_PART = OFF_R;
constexpr size_t OFF_YS = OFF_R;

struct Params {
    const float *x, *c, *ctx, *c_ctx, *ada_w, *ada_b, *w_in, *q_gain, *k_gain, *nat_rpb, *hy_conv_w, *hy_conv_b,
        *hy_f_w1, *hy_f_b1, *hy_f_w2, *hy_f_b2, *hy_f_w3, *hy_freq, *hy_skip, *w_out, *ln1_g, *ln1_b,
        *router_w, *router_b, *exp_w1, *exp_w3, *exp_w2, *sh_w1, *sh_w3, *sh_w2, *ln2_g, *ln2_b;
    float* out; unsigned char* ws;
    int cap, mode, ptype, pl, pr, pad;
};

typedef __bf16 hwbf2 __attribute__((ext_vector_type(2)));
typedef float f32x2 __attribute__((ext_vector_type(2)));
DEV unsigned f2bf(float f) { return (unsigned)__builtin_bit_cast(unsigned short, (__bf16)f); }
DEV unsigned pk2(float lo, float hi) { const f32x2 v = {lo, hi}; return __builtin_bit_cast(unsigned, __builtin_convertvector(v, hwbf2)); }
DEV float bf2f(unsigned short h) { return __uint_as_float(((unsigned)h) << 16); }
DEV float wave_sum(float v) {
#pragma unroll
    for (int o = 32; o > 0; o >>= 1) v += __shfl_xor(v, o);
    return v;
}
DEV void glds16(const void* g, void* l) { __builtin_amdgcn_global_load_lds((const unsigned*)g, (unsigned*)l, 16, 0, 0); }
DEV f32x4 mfma16(bf16x8 a, bf16x8 b, f32x4 c) { return __builtin_amdgcn_mfma_f32_16x16x32_bf16(a, b, c, 0, 0, 0); }
DEV float readlane_f(float v, int l) { return __uint_as_float((unsigned)__builtin_amdgcn_readlane((int)__float_as_uint(v), l)); }
DEV int get_tid() { int t = threadIdx.x; asm volatile("" : "+v"(t)); return t; }
DEV int lchunk(int tid) { return (tid & 3) ^ ((0 - (tid >> 4)) & 3); }
DEV int vblock() { const int G = (int)gridDim.x, b = (int)blockIdx.x; return (G & 7) ? b : (b & 7) * (G >> 3) + (b >> 3); }
DEV int mod_group(int row) { return row < NLAT ? (row >> 11) : 8; }

template <int MI, int NI> DEV void zero_acc(f32x4 (&acc)[MI][NI]) {
#pragma unroll
    for (int m = 0; m < MI; ++m)
#pragma unroll
        for (int n = 0; n < NI; ++n) acc[m][n] = (f32x4){0.f, 0.f, 0.f, 0.f};
}
#define WAIT_VM(n) asm volatile("s_waitcnt vmcnt(" #n ")" ::: "memory")
#define WAIT_LGKM0() asm volatile("s_waitcnt lgkmcnt(0)" ::: "memory")
#define RAW_BARRIER() do { asm volatile("" ::: "memory"); __builtin_amdgcn_s_barrier(); asm volatile("" ::: "memory"); } while (0)
template <int MI, int NI, bool TRANS>
DEV void gemm_core(f32x4 (&acc)[MI][NI], const bf16_t* A, const unsigned (&ao)[MI / 2], const bf16_t* B, const unsigned (&bo)[NI / 2], int K, char* lds) {
    const int tid = get_tid(), lane = tid & 63, wid = tid >> 6, fr = lane & 15, fq = lane >> 4, wr = wid >> 1, wc = wid & 1;
    constexpr int SAB = 2048 * MI, STG = 2048 * (MI + NI), LPT = MI / 2 + NI / 2;
    static_assert(LPT == 3 || LPT == 4 || LPT == 6, "loads per tile");
    const int nt = K >> 5;
    auto stage = [&](int s, int t) {
        char* SA = lds + s * STG; char* SB = SA + SAB;
#pragma unroll
        for (int i = 0; i < MI / 2; ++i) glds16(A + (ao[i] + (unsigned)(t * 32)), SA + i * 4096 + tid * 16);
#pragma unroll
        for (int i = 0; i < NI / 2; ++i) glds16(B + (bo[i] + (unsigned)(t * 32)), SB + i * 4096 + tid * 16);
    };
    WAIT_VM(0);
    stage(0, 0);
    if (nt > 1) stage(1, 1);
    const int sw = (fq ^ ((0 - (fr >> 2)) & 3)) * 16;
    const int aoff = (wr * MI * 16 + fr) * 64 + sw, boff = SAB + (wc * NI * 16 + fr) * 64 + sw;
#pragma unroll 1
    for (int t = 0; t < nt; ++t) {
        if (t + 1 < nt) { if (LPT == 6) WAIT_VM(6); else if (LPT == 4) WAIT_VM(4); else WAIT_VM(3); } else WAIT_VM(0);
        RAW_BARRIER();
        const char* S = lds + (t & 1) * STG;
        bf16x8 af[MI], bfr[NI];
#pragma unroll
        for (int m = 0; m < MI; ++m) af[m] = *(const bf16x8*)(S + aoff + m * 1024);
#pragma unroll
        for (int n = 0; n < NI; ++n) bfr[n] = *(const bf16x8*)(S + boff + n * 1024);
        WAIT_LGKM0();
        RAW_BARRIER();
        if (t + 2 < nt) stage(t & 1, t + 2);
#pragma unroll
        for (int m = 0; m < MI; ++m)
#pragma unroll
            for (int n = 0; n < NI; ++n) acc[m][n] = TRANS ? mfma16(bfr[n], af[m], acc[m][n]) : mfma16(af[m], bfr[n], acc[m][n]);
    }
}
DEV unsigned st64_off(int tid) { return (unsigned)(tid >> 3) * 1024u + (unsigned)(((tid & 7) ^ ((tid >> 3) & 7)) * 8); }
DEV int tr_key(int row) { return (row & 3) | (((row >> 3) & 1) << 2); }
template <bool TRANS>
DEV void gemm_core64(f32x4 (&acc)[4][4], const bf16_t* A, const unsigned (&ao)[4], const bf16_t* B, const unsigned (&bo)[4], int K, char* lds,
                     const bf16_t* AT = nullptr, int t_tr = 1 << 20) {
    const int tid = get_tid(), lane = tid & 63, wid = tid >> 6, fr = lane & 15, fq = lane >> 4, wr = wid >> 1, wc = wid & 1;
    const int nt = K >> 6;
    auto stage = [&](int s, int t) {
        char* SA = lds + s * 32768; char* SB = SA + 16384;
        if (t >= t_tr) {
#pragma unroll
            for (int i = 0; i < 4; ++i) {
                const int id = tid + 256 * i, row = id >> 4, cp = id & 15, c = (cp - 2 * tr_key(row)) & 15;
                glds16(AT + (size_t)((t - t_tr) * 64 + row) * 2048 + c * 8, SA + id * 16);
            }
        } else {
#pragma unroll
            for (int i = 0; i < 4; ++i) glds16(A + (ao[i] + (unsigned)(t * 64)), SA + i * 4096 + tid * 16);
        }
#pragma unroll
        for (int i = 0; i < 4; ++i) glds16(B + (bo[i] + (unsigned)(t * 64)), SB + i * 4096 + tid * 16);
    };
    WAIT_VM(0);
    stage(0, 0);
    if (nt > 1) stage(1, 1);
    const int rsw = fr & 7;
    const int arow = (wr * 64 + fr) * 128, brow = 16384 + (wc * 64 + fr) * 128;
    const int c0 = ((fq) ^ rsw) * 16, c1 = ((4 + fq) ^ rsw) * 16;
#pragma unroll 1
    for (int t = 0; t < nt; ++t) {
        if (t + 1 < nt) WAIT_VM(8); else WAIT_VM(0);
        RAW_BARRIER();
        const char* S = lds + (t & 1) * 32768;
        bf16x8 af[4][2], bfr[4][2];
        if (t >= t_tr) {
            const int q4 = fr >> 2, p4 = fr & 3;
#pragma unroll
            for (int m = 0; m < 4; ++m)
#pragma unroll
                for (int ks = 0; ks < 2; ++ks) {
                    const int rowA = ks * 32 + 8 * fq + q4, rowB = rowA + 4, c = wr * 8 + m * 2 + (p4 >> 1);
                    const int offA = rowA * 256 + (((c + 2 * tr_key(rowA)) & 15) * 16) + (p4 & 1) * 8;
                    const int offB = rowB * 256 + (((c + 2 * tr_key(rowB)) & 15) * 16) + (p4 & 1) * 8;
                    const s16x4 ta = __builtin_amdgcn_ds_read_tr16_b64_v4i16((LDSP(s16x4))(S + offA));
                    const s16x4 tb = __builtin_amdgcn_ds_read_tr16_b64_v4i16((LDSP(s16x4))(S + offB));
                    bf16x8 f; f[0] = ta[0]; f[1] = ta[1]; f[2] = ta[2]; f[3] = ta[3]; f[4] = tb[0]; f[5] = tb[1]; f[6] = tb[2]; f[7] = tb[3];
                    af[m][ks] = f;
                }
        } else {
#pragma unroll
            for (int m = 0; m < 4; ++m) { af[m][0] = *(const bf16x8*)(S + arow + m * 2048 + c0); af[m][1] = *(const bf16x8*)(S + arow + m * 2048 + c1); }
        }
#pragma unroll
        for (int n = 0; n < 4; ++n) { bfr[n][0] = *(const bf16x8*)(S + brow + n * 2048 + c0); bfr[n][1] = *(const bf16x8*)(S + brow + n * 2048 + c1); }
        WAIT_LGKM0();
        RAW_BARRIER();
        if (t + 2 < nt) stage(t & 1, t + 2);
        __builtin_amdgcn_s_setprio(1);
#pragma unroll
        for (int ks = 0; ks < 2; ++ks)
#pragma unroll
            for (int m = 0; m < 4; ++m)
#pragma unroll
                for (int n = 0; n < 4; ++n) acc[m][n] = TRANS ? mfma16(bfr[n][ks], af[m][ks], acc[m][n]) : mfma16(af[m][ks], bfr[n][ks], acc[m][n]);
        __builtin_amdgcn_s_setprio(0);
    }
}
template <int KACT, int ASTRIDE, class EPI>
DEV void gemm2_stream64(const bf16_t* W2, const char* ACT, char* sb, EPI&& epi) {
    const int tid = get_tid(), lane = tid & 63, wid = tid >> 6, fr = lane & 15, fq = lane >> 4, wr = wid >> 1, wc = wid & 1;
    constexpr int KS = KACT / 64, NJ = 8 * KS;
    const unsigned b0 = (unsigned)(tid >> 3) * KACT + (unsigned)(((tid & 7) ^ ((tid >> 3) & 7)) * 8);
    auto stage = [&](int s, int j) {
        const int nt = j / KS, ks = j % KS;
        char* SB = sb + s * 16384;
        const bf16_t* src = W2 + (size_t)nt * 128 * KACT + ks * 64 + b0;
#pragma unroll
        for (int i = 0; i < 4; ++i) glds16(src + (size_t)i * 32 * KACT, SB + i * 4096 + tid * 16);
    };
    WAIT_VM(0);
    stage(0, 0); stage(1, 1);
    const int rsw = fr & 7;
    const int brow = (wc * 64 + fr) * 128, c0 = (fq ^ rsw) * 16, c1 = ((4 + fq) ^ rsw) * 16;
    f32x4 acc[4][4]; zero_acc<4, 4>(acc);
#pragma unroll 1
    for (int j = 0; j < NJ; ++j) {
        const int ks = j % KS;
        if (j + 1 < NJ) WAIT_VM(4); else WAIT_VM(0);
        RAW_BARRIER();
        const char* S = sb + (j & 1) * 16384;
        bf16x8 af[4][2], bfr[4][2];
#pragma unroll
        for (int m = 0; m < 4; ++m) { const char* ar = ACT + (wr * 64 + m * 16 + fr) * ASTRIDE + (ks * 64 + fq * 8) * 2; af[m][0] = *(const bf16x8*)ar; af[m][1] = *(const bf16x8*)(ar + 64); }
#pragma unroll
        for (int n = 0; n < 4; ++n) { bfr[n][0] = *(const bf16x8*)(S + brow + n * 2048 + c0); bfr[n][1] = *(const bf16x8*)(S + brow + n * 2048 + c1); }
        WAIT_LGKM0();
        RAW_BARRIER();
        if (j + 2 < NJ) stage(j & 1, j + 2);
#pragma unroll
        for (int k2 = 0; k2 < 2; ++k2)
#pragma unroll
            for (int m = 0; m < 4; ++m)
#pragma unroll
                for (int n = 0; n < 4; ++n) acc[m][n] = mfma16(bfr[n][k2], af[m][k2], acc[m][n]);
        if (ks == KS - 1) { epi(j / KS, acc); zero_acc<4, 4>(acc); }
    }
}
template <int MI, int KACT, int ASTRIDE, class EPI>
DEV void gemm2_stream(const bf16_t* W2, const char* ACT, char* sb, EPI&& epi) {
    const int tid = get_tid(), lane = tid & 63, wid = tid >> 6, fr = lane & 15, fq = lane >> 4, wr = wid >> 1, wc = wid & 1;
    constexpr int KS = KACT / 32, NJ = 8 * KS;
    const bf16_t* b0 = W2 + (size_t)(tid >> 2) * KACT + lchunk(tid) * 8;
    auto stage = [&](int s, int j) {
        const int nt = j / KS, ks = j % KS;
        char* SB = sb + s * 8192;
        const bf16_t* src = b0 + (size_t)nt * 128 * KACT + ks * 32;
        glds16(src, SB + tid * 16);
        glds16(src + 64 * KACT, SB + 4096 + tid * 16);
    };
    WAIT_VM(0);
    stage(0, 0); stage(1, 1);
    const int boff = (wc * 64 + fr) * 64 + (fq ^ ((0 - (fr >> 2)) & 3)) * 16;
    f32x4 acc[MI][4]; zero_acc<MI, 4>(acc);
#pragma unroll 1
    for (int j = 0; j < NJ; ++j) {
        const int ks = j % KS;
        if (j + 1 < NJ) WAIT_VM(2); else WAIT_VM(0);
        RAW_BARRIER();
        const char* S = sb + (j & 1) * 8192;
        bf16x8 af[MI], bfr[4];
#pragma unroll
        for (int m = 0; m < MI; ++m) af[m] = *(const bf16x8*)(ACT + (wr * MI * 16 + m * 16 + fr) * ASTRIDE + (ks * 32 + fq * 8) * 2);
#pragma unroll
        for (int n = 0; n < 4; ++n) bfr[n] = *(const bf16x8*)(S + boff + n * 1024);
        WAIT_LGKM0();
        RAW_BARRIER();
        if (j + 2 < NJ) stage(j & 1, j + 2);
#pragma unroll
        for (int m = 0; m < MI; ++m)
#pragma unroll
            for (int n = 0; n < 4; ++n) acc[m][n] = mfma16(bfr[n], af[m], acc[m][n]);
        if (ks == KS - 1) { epi(j / KS, acc); zero_acc<MI, 4>(acc); }
    }
}

DEV void prep_mod_item(const Params& p, int it, char* lds) {
    const int l = it / 96, cch = it % 96, tid = get_tid(), col = cch * 64 + (tid & 63), kq = tid >> 6;
    float* sl = (float*)lds;
    float* red = sl + 9 * 1024;
    for (int i = tid; i < 9 * 1024; i += 256) { const int g = i >> 10, k = i & 1023; const float v = (g < 8) ? p.c[g * 1024 + k] : p.c_ctx[k]; sl[i] = v / (1.f + expf(-v)); }
    __syncthreads();
    float acc[9];
#pragma unroll
    for (int g = 0; g < 9; ++g) acc[g] = 0.f;
    const float* w = p.ada_w + ((size_t)l * 1024 + kq * 256) * 6144 + col;
#pragma unroll 16
    for (int kk = 0; kk < 256; ++kk) {
        const float wv = w[(size_t)kk * 6144];
#pragma unroll
        for (int g = 0; g < 9; ++g) acc[g] += sl[g * 1024 + kq * 256 + kk] * wv;
    }
#pragma unroll
    for (int g = 0; g < 9; ++g) red[(kq * 9 + g) * 64 + (tid & 63)] = acc[g];
    __syncthreads();
    float* mod = (float*)(p.ws + OFF_MOD);
    for (int i = tid; i < 9 * 64; i += 256) {
        const int g = i >> 6, c = i & 63;
        mod[((size_t)l * 9 + g) * 6144 + cch * 64 + c] = p.ada_b[l * 6144 + cch * 64 + c] + ((red[(0 * 9 + g) * 64 + c] + red[(1 * 9 + g) * 64 + c]) + (red[(2 * 9 + g) * 64 + c] + red[(3 * 9 + g) * 64 + c]));
    }
    __syncthreads();
}
DEV void prep_rope_item(const Params& p, int it) {
    const int idx = it * 256 + get_tid(), t = idx >> 5, i = idx & 31;
    const float inv = powf(10000.f, -(float)(2 * (i & 15)) / 32.f);
    const float ang = (float)((i < 16) ? (t >> 6) : (t & 63)) * inv;
    float* rc = (float*)(p.ws + OFF_ROPE);
    rc[idx] = cosf(ang); rc[2048 * 32 + idx] = sinf(ang);
}
DEV void prep_filter_item(const Params& p, int it, char* lds) {
    const int tid = get_tid(), lane = tid & 63, wid = tid >> 6;
    const int row0 = it * 32 + wid * 8;
    const int l = row0 / 2304, r0 = row0 % 2304, type = r0 < 2048 ? 0 : 1, t0 = type ? r0 - 2048 : r0, n = type ? 256 : 2048;
    float* z = (float*)lds + wid * (8 * 192); float* h1 = z + 8 * 64; float* h2 = h1 + 8 * 64;
#pragma unroll
    for (int rr = 0; rr < 8; ++rr) {
        const int t = t0 + rr;
        if (lane < 33) {
            float v;
            if (lane == 0) v = (float)t / (float)(n - 1);
            else {
                const int i = (lane - 1) & 15;
                const float f = 1e-4f + (float)i * ((15.f - 1e-4f) / 15.f);
                const float w = 2.f * 3.14159265358979323846f * (float)t / (float)n;
                v = (lane <= 16) ? cosf(f * w) : -sinf(f * w);
            }
            z[rr * 64 + lane] = v;
        }
    }
    __builtin_amdgcn_wave_barrier();
    {
        float s[8]; const float b = p.hy_f_b1[l * 64 + lane];
#pragma unroll
        for (int rr = 0; rr < 8; ++rr) s[rr] = b;
#pragma unroll 11
        for (int i = 0; i < 33; ++i) {
            const float w = p.hy_f_w1[(l * 33 + i) * 64 + lane];
#pragma unroll
            for (int rr = 0; rr < 8; ++rr) s[rr] += z[rr * 64 + i] * w;
        }
        const float fq0 = p.hy_freq[(l * 2 + 0) * 64 + lane];
#pragma unroll
        for (int rr = 0; rr < 8; ++rr) h1[rr * 64 + lane] = sinf(fq0 * s[rr]);
    }
    __builtin_amdgcn_wave_barrier();
    {
        float s[8]; const float b = p.hy_f_b2[l * 64 + lane];
#pragma unroll
        for (int rr = 0; rr < 8; ++rr) s[rr] = b;
#pragma unroll 16
        for (int i = 0; i < 64; ++i) {
            const float w = p.hy_f_w2[(l * 64 + i) * 64 + lane];
#pragma unroll
            for (int rr = 0; rr < 8; ++rr) s[rr] += h1[rr * 64 + i] * w;
        }
        const float fq1 = p.hy_freq[(l * 2 + 1) * 64 + lane];
#pragma unroll
        for (int rr = 0; rr < 8; ++rr) h2[rr * 64 + lane] = sinf(fq1 * s[rr]);
    }
    __builtin_amdgcn_wave_barrier();
    bf16_t* kf = (bf16_t*)(p.ws + (type ? OFF_KERNC + (size_t)l * 2 * 256 * 256 * 2 : OFF_KERNL + (size_t)l * 2 * 256 * 2048 * 2));
    const float lo = logf(1e-2f) / 1.5f, hi = logf(1e-2f) / 0.3f;
    const float* w3 = p.hy_f_w3 + (size_t)l * 64 * 512 + lane;
#pragma unroll 1
    for (int qh = 0; qh < 2; ++qh) {
        float acc[8][4];
#pragma unroll
        for (int rr = 0; rr < 8; ++rr)
#pragma unroll
            for (int q = 0; q < 4; ++q) acc[rr][q] = 0.f;
#pragma unroll 8
        for (int i = 0; i < 64; ++i) {
            float w[4];
#pragma unroll
            for (int q = 0; q < 4; ++q) w[q] = w3[i * 512 + qh * 256 + q * 64];
#pragma unroll
            for (int rr = 0; rr < 8; ++rr) {
                const float hv = h2[rr * 64 + i];
#pragma unroll
                for (int q = 0; q < 4; ++q) acc[rr][q] += hv * w[q];
            }
        }
#pragma unroll
        for (int q = 0; q < 4; ++q) {
            const int c = q * 64 + lane;
            const float delta = fabsf(lo + (float)c * ((hi - lo) / 255.f));
            float v[8];
#pragma unroll
            for (int rr = 0; rr < 8; ++rr) { const float tt = (float)(t0 + rr) / (float)(n - 1); v[rr] = acc[rr][q] * expf(-tt * delta); }
            if (qh == 0 && t0 == 0) v[0] += p.hy_skip[l * 256 + c];
            *(u32x4*)(kf + ((size_t)qh * 256 + c) * n + t0) = (u32x4){pk2(v[0], v[1]), pk2(v[2], v[3]), pk2(v[4], v[5]), pk2(v[6], v[7])};
        }
    }
    __builtin_amdgcn_wave_barrier();
}
struct ConvDesc { const float* src; bf16_t* dst; int ldsrc, k0, n0, lddst, mapkind; };
DEV void conv_load(const ConvDesc& d, f32x4 (&v)[4], int tid) {
    const int r = tid >> 4, c4 = (tid & 15) * 4;
#pragma unroll
    for (int i = 0; i < 4; ++i) v[i] = *(const f32x4*)(d.src + (size_t)(d.k0 + r + 16 * i) * d.ldsrc + d.n0 + c4);
}
DEV void conv_store(const ConvDesc& d, const f32x4 (&v)[4], char* lds, int tid) {
    float* tl = (float*)lds;
    {
        const int r = tid >> 4, c4 = (tid & 15) * 4;
#pragma unroll
        for (int i = 0; i < 4; ++i) { const int row = r + 16 * i; tl[row * 65 + c4 + 0] = v[i][0]; tl[row * 65 + c4 + 1] = v[i][1]; tl[row * 65 + c4 + 2] = v[i][2]; tl[row * 65 + c4 + 3] = v[i][3]; }
    }
    __syncthreads();
    {
        const int n = tid >> 2, kc = tid & 3, ng = d.n0 + n;
        int drow = ng;
        if (d.mapkind == 1) drow = 32 * (ng >> 4) + (ng & 15);
        else if (d.mapkind == 2) drow = 32 * (ng >> 4) + 16 + (ng & 15);
        else if (d.mapkind == 3) drow = (ng >> 7) * 256 + 32 * ((ng & 127) >> 4) + (ng & 15);
        else if (d.mapkind == 4) drow = (ng >> 7) * 256 + 32 * ((ng & 127) >> 4) + 16 + (ng & 15);
        else if (d.mapkind == 5) drow = (ng & ~31) + 16 * ((ng >> 2) & 1) + 4 * ((ng >> 3) & 3) + (ng & 3);
        unsigned w[8];
#pragma unroll
        for (int j = 0; j < 8; ++j) w[j] = pk2(tl[(kc * 16 + 2 * j) * 65 + n], tl[(kc * 16 + 2 * j + 1) * 65 + n]);
        u32x4* o = (u32x4*)(d.dst + (size_t)drow * d.lddst + d.k0 + kc * 16);
        o[0] = (u32x4){w[0], w[1], w[2], w[3]};
        o[1] = (u32x4){w[4], w[5], w[6], w[7]};
    }
    __syncthreads();
}
DEV ConvDesc conv_fixed_desc(const Params& p, int it) {
    const int l = it / 1040; int r = it % 1040;
    unsigned char* ws = p.ws;
    if (r < 576) return ConvDesc{p.w_in + (size_t)l * 1024 * PROJ, (bf16_t*)(ws + OFF_WIN) + (size_t)l * PROJ * 1024, PROJ, (r / 36) * 64, (r % 36) * 64, 1024, (r % 36) * 64 < 1536 ? 5 : 0};
    r -= 576;
    if (r < 256) return ConvDesc{p.w_out + (size_t)l * 1024 * 1024, (bf16_t*)(ws + OFF_WOUT) + (size_t)l * 1024 * 1024, 1024, (r / 16) * 64, (r % 16) * 64, 1024, 5};
    r -= 256;
    if (r < 64) return ConvDesc{p.sh_w1 + (size_t)l * 1024 * 256, (bf16_t*)(ws + OFF_SW13) + (size_t)l * 512 * 1024, 256, (r / 4) * 64, (r % 4) * 64, 1024, 3};
    r -= 64;
    if (r < 64) return ConvDesc{p.sh_w3 + (size_t)l * 1024 * 256, (bf16_t*)(ws + OFF_SW13) + (size_t)l * 512 * 1024, 256, (r / 4) * 64, (r % 4) * 64, 1024, 4};
    r -= 64;
    if (r < 64) { const int kt = r / 16, hh = kt >> 1;
        return ConvDesc{p.sh_w2 + (size_t)l * 256 * 1024, (bf16_t*)(ws + OFF_SW2) + (size_t)(l * 2 + hh) * 1024 * 128 - hh * 128, 1024, kt * 64, (r % 16) * 64, 128, 5}; }
    r -= 64;
    return ConvDesc{p.router_w + (size_t)l * 1024 * 64, (bf16_t*)(ws + OFF_RW) + (size_t)l * 64 * 1024, 64, r * 64, 0, 1024, 0};
}
DEV ConvDesc conv_expert_desc(const Params& p, int l, int it) {
    const int e = it / 96; int r = it % 96;
    unsigned char* ws = p.ws;
    const size_t eo = (size_t)(l * 64 + e) * 1024 * 128;
    if (r < 32) return ConvDesc{p.exp_w1 + eo, (bf16_t*)(ws + OFF_W13) + (size_t)e * 256 * 1024, 128, (r / 2) * 64, (r % 2) * 64, 1024, 1};
    r -= 32;
    if (r < 32) return ConvDesc{p.exp_w3 + eo, (bf16_t*)(ws + OFF_W13) + (size_t)e * 256 * 1024, 128, (r / 2) * 64, (r % 2) * 64, 1024, 2};
    r -= 32;
    return ConvDesc{p.exp_w2 + eo, (bf16_t*)(ws + OFF_W2) + (size_t)e * 1024 * 128, 1024, (r / 16) * 64, (r % 16) * 64, 128, 5};
}
DEV void conv_run(const Params& p, int l, int first, int count, char* lds) {
    const int tid = get_tid();
    if (count <= 0) return;
    ConvDesc d = l < 0 ? conv_fixed_desc(p, first) : conv_expert_desc(p, l, first);
    f32x4 v[4]; conv_load(d, v, tid);
#pragma unroll 1
    for (int i = 0; i < count; ++i) {
        ConvDesc dn = d; f32x4 vn[4];
        if (i + 1 < count) { dn = l < 0 ? conv_fixed_desc(p, first + i + 1) : conv_expert_desc(p, l, first + i + 1); conv_load(dn, vn, tid); }
        else {
#pragma unroll
            for (int k = 0; k < 4; ++k) vn[k] = v[k];
        }
        conv_store(d, v, lds, tid);
        d = dn;
#pragma unroll
        for (int k = 0; k < 4; ++k) v[k] = vn[k];
    }
}
DEV void phase_prep(const Params& p, char* lds) {
    { const int t_ = get_tid(); if (blockIdx.x == 0 && t_ < 128) ((int*)(p.ws + OFF_CNT))[t_ * 64] = 0; }
    constexpr int N0 = 144, N1 = N0 + 192, N2 = N1 + 260, N3 = N2 + 768, N4 = N3 + 256;
    int* qhead = (int*)(p.ws + OFF_QUEUE) + 2 * 64;
    int* qslot = (int*)(lds + SMEM_BYTES - 256);
    for (;;) {
        __syncthreads();
        if (get_tid() == 0) *qslot = atomicAdd(qhead, 1);
        __syncthreads();
        const int it = *qslot;
        if (it >= N4) break;
        if (it < N0) prep_filter_item(p, it, lds);
        else if (it < N1) prep_mod_item(p, it - N0, lds);
        else if (it < N2) conv_run(p, -1, (it - N1) * 8, 8, lds);
        else if (it < N3) conv_run(p, 0, (it - N2) * 8, 8, lds);
        else prep_rope_item(p, it - N3);
    }
}
DEV void phase_modfin(const Params& p) {
    const float* part = (const float*)(p.ws + OFF_PART);
    float* mod = (float*)(p.ws + OFF_MOD);
    for (int idx = blockIdx.x * 256 + get_tid(); idx < 2 * 9 * 6144; idx += gridDim.x * 256) {
        const int l = idx / (9 * 6144), g = (idx / 6144) % 9, col = idx % 6144;
        float s = p.ada_b[l * 6144 + col];
        for (int k = 0; k < 32; ++k) s += part[((size_t)(k * 2 + l) * 9 + g) * 6144 + col];
        mod[idx] = s;
    }
}

DEV void row_load(const float* src, f32x4 (&v)[4], int lane) {
#pragma unroll
    for (int j = 0; j < 4; ++j) v[j] = *(const f32x4*)(src + 4 * lane + 256 * j);
}
DEV f32x4 ld_bf4(const bf16_t* p) { const u32x2 w = *(const u32x2*)p; return (f32x4){__uint_as_float(w[0] << 16), __uint_as_float(w[0] & 0xffff0000u), __uint_as_float(w[1] << 16), __uint_as_float(w[1] & 0xffff0000u)}; }
DEV void st_bf4(bf16_t* p, const f32x4& v) { *(u32x2*)p = (u32x2){pk2(v[0], v[1]), pk2(v[2], v[3])}; }
DEV void row_load_bf(const bf16_t* src, f32x4 (&v)[4], int lane) {
#pragma unroll
    for (int j = 0; j < 4; ++j) v[j] = ld_bf4(src + 4 * lane + 256 * j);
}
DEV void row_norm(f32x4 (&v)[4]) {
    float s = 0.f;
#pragma unroll
    for (int j = 0; j < 4; ++j) s += (v[j][0] + v[j][1]) + (v[j][2] + v[j][3]);
    const float mean = wave_sum(s) * (1.f / 1024.f);
    float q = 0.f;
#pragma unroll
    for (int j = 0; j < 4; ++j) { v[j] = v[j] - mean; q += (v[j][0] * v[j][0] + v[j][1] * v[j][1]) + (v[j][2] * v[j][2] + v[j][3] * v[j][3]); }
    const float rstd = 1.0f / sqrtf(wave_sum(q) * (1.f / 1024.f) + 1e-6f);
#pragma unroll
    for (int j = 0; j < 4; ++j) v[j] = v[j] * rstd;
}
DEV void row_store_mod_bf16(bf16_t* dst, const f32x4 (&v)[4], const float* shift, const float* scale, int lane) {
#pragma unroll
    for (int j = 0; j < 4; ++j) {
        const int c = 4 * lane + 256 * j;
        const f32x4 sh = *(const f32x4*)(shift + c), sc = *(const f32x4*)(scale + c);
        const f32x4 o = v[j] * (sc + 1.0f) + sh;
        *(u32x2*)(dst + c) = (u32x2){pk2(o[0], o[1]), pk2(o[2], o[3])};
    }
}
DEV void phase_lnmod0(const Params& p) {
    const int tid_ = get_tid(), lane = tid_ & 63, wid = tid_ >> 6;
    const float* mod = (const float*)(p.ws + OFF_MOD);
    bf16_t* H = (bf16_t*)(p.ws + OFF_H);
    for (int row = blockIdx.x * 4 + wid; row < NT; row += gridDim.x * 4) {
        const float* src = row < NLAT ? p.x + (size_t)row * 1024 : p.ctx + (size_t)(row - NLAT) * 1024;
        f32x4 v[4]; row_load(src, v, lane); row_norm(v);
        const float* m = mod + (size_t)mod_group(row) * 6144;
        row_store_mod_bf16(H + (size_t)row * 1024, v, m, m + 1024, lane);
    }
}

DEV void phase_inproj(const Params& p, int l, char* lds) {
    const int tid = get_tid(), lane = tid & 63, wid = tid >> 6, fr = lane & 15, fq = lane >> 4, wr = wid >> 1, wc = wid & 1;
    unsigned char* ws = p.ws;
    const bf16_t* H = (const bf16_t*)(ws + OFF_H);
    const bf16_t* W = (const bf16_t*)(ws + OFF_WIN) + (size_t)l * PROJ * 1024;
    const float* ropec = (const float*)(ws + OFF_ROPE); const float* ropes = ropec + 2048 * 32;
    const int nitems = 128 * 18 + 16 * (l == 0 ? 18 : 6);
    for (int it = blockIdx.x; it < nitems; it += gridDim.x) {
        int mt, nt;
        if (it < 2304) { mt = it / 18; nt = it % 18; }
        else { const int j = it - 2304; if (l == 0) { mt = 128 + j / 18; nt = j % 18; } else { mt = 128 + j / 6; const int q = j % 6; nt = q < 2 ? 4 + q : 6 + q; } }
        const int m0 = mt * 128, n0 = nt * 128;
        const unsigned a0 = (unsigned)m0 * 1024u + st64_off(tid), b0 = (unsigned)n0 * 1024u + st64_off(tid);
        const unsigned ao[4] = {a0, a0 + 32u * 1024u, a0 + 64u * 1024u, a0 + 96u * 1024u};
        const unsigned bo[4] = {b0, b0 + 32u * 1024u, b0 + 64u * 1024u, b0 + 96u * 1024u};
        f32x4 acc[4][4]; zero_acc<4, 4>(acc);
        const bool latent = m0 < NLAT;
        const int b = latent ? (m0 >> 11) : ((m0 - NLAT) >> 8);
        const int tbase = latent ? (m0 & 2047) : ((m0 - NLAT) & 255);
        if (nt >= 12) {
            const int rho = tid >> 3, ptok = 8 * ((rho & 15) >> 2) + 4 * (rho >> 4) + (rho & 3);
            const unsigned ap0 = (unsigned)(m0 + ptok) * 1024u + (unsigned)(((tid & 7) ^ (rho & 7)) * 8);
            const unsigned aop[4] = {ap0, ap0 + 32u * 1024u, ap0 + 64u * 1024u, ap0 + 96u * 1024u};
            gemm_core64<false>(acc, H, aop, W, bo, 1024, lds);
            bf16_t* zt = latent ? (bf16_t*)(ws + OFF_ZTL) + (size_t)b * 768 * 2048 : (bf16_t*)(ws + OFF_ZTC) + (size_t)b * 768 * 256;
            const int n = latent ? 2048 : 256;
#pragma unroll
            for (int g = 0; g < 2; ++g)
#pragma unroll
                for (int nn = 0; nn < 4; ++nn) {
                    const int ch = n0 - 1536 + wc * 64 + nn * 16 + fr, t = tbase + wr * 64 + 32 * g + 8 * fq;
                    *(u32x4*)(zt + (size_t)ch * n + t) = (u32x4){pk2(acc[2 * g][nn][0], acc[2 * g][nn][1]), pk2(acc[2 * g][nn][2], acc[2 * g][nn][3]),
                                                                 pk2(acc[2 * g + 1][nn][0], acc[2 * g + 1][nn][1]), pk2(acc[2 * g + 1][nn][2], acc[2 * g + 1][nn][3])};
                }
        } else {
            gemm_core64<true>(acc, H, ao, W, bo, 1024, lds);
            const int col0 = n0 + wc * 64;
            int kind, hh;
            if (col0 < 512) { kind = 0; hh = col0 >> 6; } else if (col0 < 640) { kind = 1; hh = (col0 - 512) >> 6; } else if (col0 < 768) { kind = 2; hh = (col0 - 640) >> 6; }
            else if (col0 < 1024) { kind = 3; hh = (col0 - 768) >> 6; } else if (col0 < 1280) { kind = 4; hh = (col0 - 1024) >> 6; } else { kind = 5; hh = (col0 - 1280) >> 6; }
            const bool normed = (kind == 0 || kind == 1);
            const float* gain = (kind == 0 ? p.q_gain : p.k_gain) + l * 64;
#pragma unroll
            for (int m = 0; m < 4; ++m) {
                const int rloc = wr * 64 + m * 16 + fr, row = m0 + rloc, t = tbase + rloc;
                f32x4 v[4];
#pragma unroll
                for (int nn = 0; nn < 4; ++nn) v[nn] = acc[m][nn];
                if (normed) {
                    float ss = 0.f;
#pragma unroll
                    for (int nn = 0; nn < 4; ++nn) ss += (v[nn][0] * v[nn][0] + v[nn][1] * v[nn][1]) + (v[nn][2] * v[nn][2] + v[nn][3] * v[nn][3]);
                    ss += __shfl_xor(ss, 16); ss += __shfl_xor(ss, 32);
                    const float r = 1.0f / sqrtf(ss * (1.f / 64.f) + 1e-6f);
#pragma unroll
                    for (int nn = 0; nn < 4; ++nn) {
                        const int hc = 32 * (nn >> 1) + 8 * fq + 4 * (nn & 1);
                        const f32x4 g = *(const f32x4*)(gain + hc);
                        v[nn] = v[nn] * r * g;
                        if (latent) {
                            const int pi = hc >> 1;
                            const float c0 = ropec[t * 32 + pi], s0 = ropes[t * 32 + pi], c1 = ropec[t * 32 + pi + 1], s1 = ropes[t * 32 + pi + 1];
                            const float x0 = v[nn][0], x1 = v[nn][1], x2 = v[nn][2], x3 = v[nn][3];
                            v[nn][0] = x0 * c0 - x1 * s0; v[nn][1] = x0 * s0 + x1 * c0;
                            v[nn][2] = x2 * c1 - x3 * s1; v[nn][3] = x2 * s1 + x3 * c1;
                        }
                    }
                }
                if (kind == 0 || kind == 3) {
#pragma unroll
                    for (int nn = 0; nn < 4; ++nn) v[nn] = v[nn] * (0.125f * LOG2E);
                }
                bf16_t* dst;
                const int key = latent ? 256 + t : t;
                if (kind == 0) dst = (bf16_t*)(ws + OFF_QA) + ((size_t)hh * NT + row) * 64;
                else if (kind == 3) dst = (bf16_t*)(ws + OFF_QB) + ((size_t)hh * NT + row) * 64;
                else if (kind == 1) dst = (bf16_t*)(ws + OFF_KA) + ((size_t)(b * 2 + hh) * KEYS + key) * 64;
                else if (kind == 2) dst = (bf16_t*)(ws + OFF_VA) + ((size_t)(b * 2 + hh) * KEYS + key) * 64;
                else if (kind == 4) dst = (bf16_t*)(ws + OFF_KB) + ((size_t)(b * 4 + hh) * KEYS + key) * 64;
                else dst = (bf16_t*)(ws + OFF_VB) + ((size_t)(b * 4 + hh) * KEYS + key) * 64;
#pragma unroll
                for (int gg = 0; gg < 2; ++gg) *(u32x4*)(dst + 32 * gg + 8 * fq) = (u32x4){pk2(v[2 * gg][0], v[2 * gg][1]), pk2(v[2 * gg][2], v[2 * gg][3]), pk2(v[2 * gg + 1][0], v[2 * gg + 1][1]), pk2(v[2 * gg + 1][2], v[2 * gg + 1][3])};
                __builtin_amdgcn_sched_barrier(0);
            }
        }
    }
}

template <int NQT, bool NA>
DEV void attn_block(const bf16_t* Qh, int qrow0, const bf16_t* Kh, const bf16_t* Vh, int ntiles, bf16_t* outp  ,
                    int na_r, int na_rs, int nwin, const float* rpb_h, char* lds) {
    const int tid = get_tid(), lane = tid & 63, wid = tid >> 6, fr = lane & 15, fq = lane >> 4;
    char* KBUF = lds;
    char* VBUF = lds + 16384;
    float* BIAS = (float*)(lds + 32768);
    if (NA) {
        for (int i = tid; i < 15 * 32; i += 256) { const int dr = i >> 5, dc = i & 31; BIAS[i] = dc < 31 ? rpb_h[dr * 31 + dc] * LOG2E : 0.f; }
    }
    bf16x8 qf[NQT][2];
    const int qw = qrow0 + wid * 16 * NQT;
#pragma unroll
    for (int nq = 0; nq < NQT; ++nq)
#pragma unroll
        for (int ks = 0; ks < 2; ++ks) qf[nq][ks] = *(const bf16x8*)(Qh + (size_t)(qw + nq * 16 + fr) * 64 + ks * 32 + fq * 8);
    f32x4 oacc[4][NQT], lacc[NQT];
    float mrun[NQT];
    const bf16x8 ones = (bf16x8){0x3F80, 0x3F80, 0x3F80, 0x3F80, 0x3F80, 0x3F80, 0x3F80, 0x3F80};
#pragma unroll
    for (int nq = 0; nq < NQT; ++nq) { mrun[nq] = 0.f; lacc[nq] = (f32x4){0.f, 0.f, 0.f, 0.f};
#pragma unroll
        for (int dt = 0; dt < 4; ++dt) oacc[dt][nq] = (f32x4){0.f, 0.f, 0.f, 0.f}; }
    const int lrow0 = tid >> 3, lch = tid & 7;
    auto key0_of = [&](int ti) -> int { if (NA) return ti < nwin ? 256 + (na_rs + ti) * 64 : (ti - nwin) * 64; return ti * 64; };
    u32x4 kreg[2], vreg[2];
    auto gload = [&](int ti) {
        const int k0 = key0_of(ti);
#pragma unroll
        for (int i = 0; i < 2; ++i) {
            const int row = lrow0 + 32 * i;
            kreg[i] = *(const u32x4*)(Kh + (size_t)(k0 + row) * 64 + lch * 8);
            vreg[i] = *(const u32x4*)(Vh + (size_t)(k0 + row) * 64 + lch * 8);
        }
    };
    auto lstore = [&](int buf) {
#pragma unroll
        for (int i = 0; i < 2; ++i) {
            const int row = lrow0 + 32 * i;
            const int off = buf * 8192 + row * 128 + ((lch ^ (row & 7)) * 16);
            *(u32x4*)(KBUF + off) = kreg[i];
            *(u32x4*)(VBUF + off) = vreg[i];
        }
    };
    gload(0); lstore(0);
    __syncthreads();
    for (int ti = 0; ti < ntiles; ++ti) {
        const int buf = ti & 1;
        if (ti + 1 < ntiles) gload(ti + 1);
        const char* kb = KBUF + buf * 8192; const char* vb = VBUF + buf * 8192;
        f32x4 sacc[4][NQT];
        __builtin_amdgcn_s_setprio(1);
#pragma unroll
        for (int mt = 0; mt < 4; ++mt) {
            const int row = mt * 16 + fr;
            bf16x8 kf0 = *(const bf16x8*)(kb + row * 128 + (((0 + fq) ^ (row & 7)) * 16));
            bf16x8 kf1 = *(const bf16x8*)(kb + row * 128 + (((4 + fq) ^ (row & 7)) * 16));
#pragma unroll
            for (int nq = 0; nq < NQT; ++nq) {
                f32x4 s = (f32x4){-mrun[nq], -mrun[nq], -mrun[nq], -mrun[nq]};
                s = mfma16(kf0, qf[nq][0], s);
                s = mfma16(kf1, qf[nq][1], s);
                sacc[mt][nq] = s;
            }
        }
        __builtin_amdgcn_s_setprio(0);
        bf16x8 pf[2][NQT];
#pragma unroll
        for (int nq = 0; nq < NQT; ++nq) {
            float tv[4][4];
            float tmax = -1e30f;
            if (NA && ti < nwin) {
                const int qc = (wid & 1) * 32 + nq * 16 + fr;
                int cs = qc - 8; cs = cs < 0 ? 0 : (cs > 48 ? 48 : cs);
                const int qrow = na_r + (wid >> 1);
                int rsq = qrow - 4; rsq = rsq < 0 ? 0 : (rsq > 24 ? 24 : rsq);
                const int krow = na_rs + ti;
                const bool rowok = (krow >= rsq) && (krow < rsq + 8);
                int dr = krow - qrow + 7; dr = dr < 0 ? 0 : (dr > 14 ? 14 : dr);
#pragma unroll
                for (int mt = 0; mt < 4; ++mt)
#pragma unroll
                    for (int j = 0; j < 4; ++j) {
                        const int kc = mt * 16 + 4 * fq + j;
                        const bool ok = rowok && (kc >= cs) && (kc < cs + 16);
                        int dc = kc - qc + 15; dc = dc < 0 ? 0 : (dc > 30 ? 30 : dc);
                        tv[mt][j] = ok ? sacc[mt][nq][j] + BIAS[dr * 32 + dc] : -1e30f;
                        tmax = fmaxf(tmax, tv[mt][j]);
                    }
            } else {
#pragma unroll
                for (int mt = 0; mt < 4; ++mt) {
#pragma unroll
                    for (int j = 0; j < 4; ++j) tv[mt][j] = sacc[mt][nq][j];
                    tmax = fmaxf(fmaxf(tmax, tv[mt][0]), tv[mt][1]); tmax = fmaxf(fmaxf(tmax, tv[mt][2]), tv[mt][3]);
                }
            }
            if (__any(tmax > 8.0f)) {
                tmax = fmaxf(tmax, __shfl_xor(tmax, 16)); tmax = fmaxf(tmax, __shfl_xor(tmax, 32));
                const float dlt = fmaxf(tmax, 0.f);
                const float alpha = __builtin_amdgcn_exp2f(-dlt);
                mrun[nq] += dlt;
                lacc[nq] = lacc[nq] * alpha;
#pragma unroll
                for (int dt = 0; dt < 4; ++dt) oacc[dt][nq] = oacc[dt][nq] * alpha;
#pragma unroll
                for (int mt = 0; mt < 4; ++mt)
#pragma unroll
                    for (int j = 0; j < 4; ++j) tv[mt][j] -= dlt;
            }
#pragma unroll
            for (int mt = 0; mt < 4; ++mt)
#pragma unroll
                for (int j = 0; j < 4; ++j) tv[mt][j] = __builtin_amdgcn_exp2f(tv[mt][j]);
#pragma unroll
            for (int ks = 0; ks < 2; ++ks) {
                union { bf16x8 v; unsigned u[4]; } pk;
                pk.u[0] = pk2(tv[2 * ks][0], tv[2 * ks][1]); pk.u[1] = pk2(tv[2 * ks][2], tv[2 * ks][3]);
                pk.u[2] = pk2(tv[2 * ks + 1][0], tv[2 * ks + 1][1]); pk.u[3] = pk2(tv[2 * ks + 1][2], tv[2 * ks + 1][3]);
                pf[ks][nq] = pk.v;
                lacc[nq] = mfma16(ones, pk.v, lacc[nq]);
            }
        }
        {
            const int q4 = fr >> 2, p4 = fr & 3;
#pragma unroll
            for (int ks = 0; ks < 2; ++ks)
#pragma unroll
                for (int dt = 0; dt < 4; ++dt) {
                    const int keyA = 16 * (2 * ks) + 4 * fq + q4, keyB = keyA + 16;
                    const int ch = 4 * (dt >> 1) + p4;
                    const int offA = keyA * 128 + ((ch ^ (keyA & 7)) * 16) + (dt & 1) * 8;
                    const int offB = keyB * 128 + ((ch ^ (keyB & 7)) * 16) + (dt & 1) * 8;
                    const s16x4 ta = __builtin_amdgcn_ds_read_tr16_b64_v4i16((LDSP(s16x4))(vb + offA));
                    const s16x4 tb = __builtin_amdgcn_ds_read_tr16_b64_v4i16((LDSP(s16x4))(vb + offB));
                    bf16x8 vf; vf[0] = ta[0]; vf[1] = ta[1]; vf[2] = ta[2]; vf[3] = ta[3]; vf[4] = tb[0]; vf[5] = tb[1]; vf[6] = tb[2]; vf[7] = tb[3];
#pragma unroll
                    for (int nq = 0; nq < NQT; ++nq) oacc[dt][nq] = mfma16(vf, pf[ks][nq], oacc[dt][nq]);
                }
        }
        if (ti + 1 < ntiles) lstore(buf ^ 1);
        __syncthreads();
    }
#pragma unroll
    for (int nq = 0; nq < NQT; ++nq) {
        const float inv = 1.0f / lacc[nq][0];
        bf16_t* o = outp + (size_t)(qw + nq * 16 + fr) * 1024;
#pragma unroll
        for (int g = 0; g < 2; ++g) {
            const f32x4 v0 = oacc[2 * g][nq] * inv, v1 = oacc[2 * g + 1][nq] * inv;
            *(u32x4*)(o + g * 32 + 8 * fq) = (u32x4){pk2(v0[0], v0[1]), pk2(v0[2], v0[3]), pk2(v1[0], v1[1]), pk2(v1[2], v1[3])};
        }
    }
    __syncthreads();
}

DEV float hy_sconv(const bf16_t* zrow, int t, int n, float w0, float w1, float w2, float bias) {
    const float zm = t > 0 ? bf2f(zrow[t - 1]) : 0.f, z0 = bf2f(zrow[t]), zp = t + 1 < n ? bf2f(zrow[t + 1]) : 0.f;
    return w0 * zm + w1 * z0 + w2 * zp + bias;
}
template <int NJ>
DEV void hyena_item(const Params& p, int l, int type, int c, int bh, char* lds) {
    constexpr int n = 256 * NJ;
    const int tid = get_tid();
    f32x4* U = (f32x4*)lds;
    float* KR = (float*)(lds + n * 16);
    const bf16_t* zt = type ? (const bf16_t*)(p.ws + OFF_ZTC) : (const bf16_t*)(p.ws + OFF_ZTL);
    const bf16_t* kf = (const bf16_t*)(p.ws + (type ? OFF_KERNC + (size_t)l * 2 * 256 * 256 * 2 : OFF_KERNL + (size_t)l * 2 * 256 * 2048 * 2)) + (size_t)c * n;
    const bf16_t* kb = kf + (size_t)256 * n;
    const float* cw = p.hy_conv_w + l * 3 * 768; const float* cb = p.hy_conv_b + l * 768;
    const float w10 = cw[256 + c], w11 = cw[768 + 256 + c], w12 = cw[1536 + 256 + c], b1 = cb[256 + c];
    const float wv0 = cw[512 + c], wv1 = cw[768 + 512 + c], wv2 = cw[1536 + 512 + c], bv = cb[512 + c];
    const float w00 = cw[c], w01 = cw[768 + c], w02 = cw[1536 + c], b0 = cb[c];
    for (int i = tid; i < 2 * n - 1; i += 256) { const int d = i - (n - 1); KR[i] = bf2f(d >= 0 ? kf[d] : kb[-d]); }
    for (int s = tid; s < n; s += 256) {
        f32x4 u;
#pragma unroll
        for (int bb = 0; bb < 4; ++bb) {
            const bf16_t* zb = zt + (size_t)(bh * 4 + bb) * 768 * n;
            const float x1 = hy_sconv(zb + (size_t)(256 + c) * n, s, n, w10, w11, w12, b1);
            const float vv = hy_sconv(zb + (size_t)(512 + c) * n, s, n, wv0, wv1, wv2, bv);
            u[bb] = vv * x1;
        }
        U[s] = u;
    }
    __syncthreads();
    f32x4 acc[NJ];
#pragma unroll
    for (int j = 0; j < NJ; ++j) acc[j] = (f32x4){0.f, 0.f, 0.f, 0.f};
    const float* kp = KR + tid + (n - 1);
    for (int s = 0; s < n; ++s) {
        const f32x4 u = U[s];
#pragma unroll
        for (int j = 0; j < NJ; ++j) acc[j] += u * kp[256 * j - s];
    }
    bf16_t* ox = (bf16_t*)(p.ws + OFF_OX);
#pragma unroll
    for (int j = 0; j < NJ; ++j) {
        const int t = tid + 256 * j;
#pragma unroll
        for (int bb = 0; bb < 4; ++bb) {
            const int b = bh * 4 + bb;
            const bf16_t* zb = zt + (size_t)b * 768 * n;
            const float x0 = hy_sconv(zb + (size_t)c * n, t, n, w00, w01, w02, b0);
            const float y = acc[j][bb] * x0;
            const int row = type ? NLAT + b * 256 + t : b * 2048 + t;
            ox[(size_t)row * 1024 + 768 + c] = (bf16_t)f2bf(y);
        }
    }
    __syncthreads();
}


typedef float f32x16 __attribute__((ext_vector_type(16)));
constexpr int HY_UROW = 2256;
constexpr int HY_KC_OFF = 8 * HY_UROW * 2;
constexpr int HY_KC_STRIDE = 8192 + 64;
DEV float hy_sc8(const bf16_t* zrow, int s0, int n, float w0, float w1, float w2, float bias, float (&o)[8]) {
    const u32x4 v = *(const u32x4*)(zrow + s0);
    const float zm = s0 > 0 ? bf2f(zrow[s0 - 1]) : 0.f, zp = s0 + 8 < n ? bf2f(zrow[s0 + 8]) : 0.f;
    float z[10]; z[0] = zm; z[9] = zp;
#pragma unroll
    for (int i = 0; i < 4; ++i) { z[1 + 2 * i] = __uint_as_float(v[i] << 16); z[2 + 2 * i] = __uint_as_float(v[i] & 0xffff0000u); }
#pragma unroll
    for (int i = 0; i < 8; ++i) o[i] = w0 * z[i] + w1 * z[i + 1] + w2 * z[i + 2] + bias;
    return 0.f;
}
DEV void hyena_mfma_item(const Params& p, int l, int c, char* lds) {
    const int tid = get_tid(), lane = tid & 63, wid = tid >> 6;
    constexpr int n = 2048;
    const bf16_t* zt = (const bf16_t*)(p.ws + OFF_ZTL);
    const bf16_t* kf = (const bf16_t*)(p.ws + OFF_KERNL + (size_t)l * 2 * 256 * 2048 * 2) + (size_t)c * n;
    const bf16_t* kb = kf + (size_t)256 * n;
    const float* cw = p.hy_conv_w + l * 3 * 768; const float* cb = p.hy_conv_b + l * 768;
    const float w10 = cw[256 + c], w11 = cw[768 + 256 + c], w12 = cw[1536 + 256 + c], b1 = cb[256 + c];
    const float wv0 = cw[512 + c], wv1 = cw[768 + 512 + c], wv2 = cw[1536 + 512 + c], bv = cb[512 + c];
    const float w00 = cw[c], w01 = cw[768 + c], w02 = cw[1536 + c], b0 = cb[c];
    for (int i = tid; i < 8 * 26; i += 256) {
        const int b = i / 26, k = i % 26;
        const int sp = k < 12 ? k * 8 : 96 + 2048 + (k - 12) * 8;
        *(u32x4*)(lds + (b * HY_UROW + sp) * 2) = (u32x4){0u, 0u, 0u, 0u};
    }
#pragma unroll 4
    for (int ch = tid; ch < 8 * 256; ch += 256) {
        const int b = ch >> 8, s0 = (ch & 255) * 8;
        const bf16_t* zb = zt + (size_t)b * 768 * n;
        float x1[8], vv[8];
        hy_sc8(zb + (size_t)(256 + c) * n, s0, n, w10, w11, w12, b1, x1);
        hy_sc8(zb + (size_t)(512 + c) * n, s0, n, wv0, wv1, wv2, bv, vv);
        *(u32x4*)(lds + (b * HY_UROW + 96 + s0) * 2) = (u32x4){pk2(vv[0] * x1[0], vv[1] * x1[1]), pk2(vv[2] * x1[2], vv[3] * x1[3]), pk2(vv[4] * x1[4], vv[5] * x1[5]), pk2(vv[6] * x1[6], vv[7] * x1[7])};
    }
    {
        char* R0 = lds + HY_KC_OFF;
#pragma unroll
        for (int j = 0; j < 2; ++j) {
            const int chn = tid + 256 * j;
            const bool fwd = chn < 256; const int d0 = (chn & 255) * 8;
            const u32x4 v = *(const u32x4*)((fwd ? kf : kb) + d0);
#pragma unroll
            for (int e = 0; e < 8; ++e) {
                const int d = d0 + e;
                const bf16_t val = (bf16_t)((e & 1) ? (v[e >> 1] >> 16) : (v[e >> 1] & 0xffffu));
                const int y = fwd ? 2047 - d : 2047 + d;
                if (fwd || d > 0) *(bf16_t*)(R0 + y * 2) = val;
            }
        }
        if (tid == 0) *(bf16_t*)(R0 + 4095 * 2) = 0;
    }
    __syncthreads();
    {
        const char* R0 = lds + HY_KC_OFF;
        for (int i = tid; i < 3 * 1024; i += 256) {
            const int q = 1 + i / 1024, y = (i % 1024) * 4;
            unsigned short e[4];
#pragma unroll
            for (int k = 0; k < 4; ++k) { const int yy = y + q + k; e[k] = yy <= 4094 ? *(const bf16_t*)(R0 + yy * 2) : (bf16_t)0; }
            *(u32x2*)(lds + HY_KC_OFF + q * HY_KC_STRIDE + y * 2) = (u32x2){(unsigned)e[0] | ((unsigned)e[1] << 16), (unsigned)e[2] | ((unsigned)e[3] << 16)};
        }
    }
    __syncthreads();
    const int i32 = lane & 31, h = lane >> 5, qn = i32 >> 3, bn = i32 & 7;
    const int T0 = 512 * wid;
    f32x16 acc[4];
#pragma unroll
    for (int g = 0; g < 4; ++g)
#pragma unroll
        for (int r = 0; r < 16; ++r) acc[g][r] = 0.f;
    const int dlo = T0 - 2032, dhi = T0 + 384 + 96;
    {
        const int a0 = 2047 - dlo - i32 + 8 * h, q4 = a0 & 3;
        const char* ap = lds + HY_KC_OFF + q4 * HY_KC_STRIDE + (a0 - q4) * 2;
        const char* bp = lds + (bn * HY_UROW + 96 + (T0 - dlo) + 32 * qn + 8 * h) * 2;
        for (int dl = dlo; dl <= dhi; dl += 16) {
            union { bf16x8 v; u32x2 u[2]; } af;
            af.u[0] = *(const u32x2*)ap; af.u[1] = *(const u32x2*)(ap + 8);
#pragma unroll
            for (int g = 0; g < 4; ++g) {
                const int S = T0 + 128 * g - dl;
                if (S >= -96 && S <= 2032) {
                    const bf16x8 bfv = *(const bf16x8*)(bp + 256 * g);
                    acc[g] = __builtin_amdgcn_mfma_f32_32x32x16_bf16(af.v, bfv, acc[g], 0, 0, 0);
                }
            }
            ap -= 32; bp -= 32;
        }
    }
    __syncthreads();
#pragma unroll 4
    for (int ch = tid; ch < 8 * 256; ch += 256) {
        const int b = ch >> 8, s0 = (ch & 255) * 8;
        float x0[8];
        hy_sc8(zt + (size_t)b * 768 * n + (size_t)c * n, s0, n, w00, w01, w02, b0, x0);
        *(u32x4*)(lds + HY_KC_OFF + (b * 2048 + s0) * 2) = (u32x4){pk2(x0[0], x0[1]), pk2(x0[2], x0[3]), pk2(x0[4], x0[5]), pk2(x0[6], x0[7])};
    }
    __syncthreads();
    bf16_t* oxt = (bf16_t*)(p.ws + OFF_OXT) + (size_t)c * 2048;
#pragma unroll
    for (int g = 0; g < 4; ++g)
#pragma unroll
        for (int r4 = 0; r4 < 4; ++r4) {
            const int t = T0 + 128 * g + 32 * qn + 8 * r4 + 4 * h;
            const u32x2 xg = *(const u32x2*)(lds + HY_KC_OFF + (bn * 2048 + t) * 2);
            const float g0 = __uint_as_float(xg[0] << 16), g1 = __uint_as_float(xg[0] & 0xffff0000u), g2 = __uint_as_float(xg[1] << 16), g3 = __uint_as_float(xg[1] & 0xffff0000u);
            *(u32x2*)(oxt + (size_t)bn * 256 * 2048 + t) = (u32x2){pk2(acc[g][4 * r4 + 0] * g0, acc[g][4 * r4 + 1] * g1), pk2(acc[g][4 * r4 + 2] * g2, acc[g][4 * r4 + 3] * g3)};
        }
    __syncthreads();
}

DEV void phase_mix(const Params& p, int l, char* lds) {
    unsigned char* ws = p.ws;
    const bf16_t* QA = (const bf16_t*)(ws + OFF_QA); const bf16_t* QB = (const bf16_t*)(ws + OFF_QB);
    const bf16_t* KA = (const bf16_t*)(ws + OFF_KA); const bf16_t* VA = (const bf16_t*)(ws + OFF_VA);
    const bf16_t* KBp = (const bf16_t*)(ws + OFF_KB); const bf16_t* VBp = (const bf16_t*)(ws + OFF_VB);
    bf16_t* OX = (bf16_t*)(ws + OFF_OX);
    const int N0 = 256, N1 = N0 + 1024, N2 = N1 + 512;
    const int N3 = N2 + (l == 0 ? 512 : 0), N4 = N3 + (l == 0 ? 128 : 0), N5 = N4 + (l == 0 ? 64 : 0);
    int* qhead = (int*)(p.ws + OFF_QUEUE) + l * 64;
    int* qslot = (int*)(lds + SMEM_BYTES - 256);
    for (;;) {
        __syncthreads();
        if (get_tid() == 0) *qslot = atomicAdd(qhead, 1);
        __syncthreads();
        const int it = *qslot;
        if (it >= N5) break;
        if (it < N0) { hyena_mfma_item(p, l, it, lds); }
        else if (it < N1) {
            const int j = it - N0, b = j >> 7, h = (j >> 4) & 7, qb = j & 15;
            attn_block<2, false>(QA + (size_t)h * NT * 64, b * 2048 + qb * 128, KA + (size_t)(b * 2 + (h >> 2)) * KEYS * 64, VA + (size_t)(b * 2 + (h >> 2)) * KEYS * 64,
                                 36, OX + h * 64, 0, 0, 0, nullptr, lds);
        } else if (it < N2) {
            const int j = it - N1, b = j >> 6, h = (j >> 4) & 3, r = (j & 15) * 2;
            int rs0 = r - 4; rs0 = rs0 < 0 ? 0 : (rs0 > 24 ? 24 : rs0);
            int rs1 = r - 3; rs1 = rs1 < 0 ? 0 : (rs1 > 24 ? 24 : rs1);
            const int nwin = rs1 + 8 - rs0;
            attn_block<2, true>(QB + (size_t)h * NT * 64, b * 2048 + r * 64, KBp + (size_t)(b * 4 + h) * KEYS * 64, VBp + (size_t)(b * 4 + h) * KEYS * 64,
                                nwin + 4, OX + 512 + h * 64, r, rs0, nwin, p.nat_rpb + (size_t)(l * 4 + h) * 15 * 31, lds);
        } else if (it < N3) { const int j = it - N2; hyena_item<1>(p, l, 1, j >> 1, j & 1, lds); }
        else if (it < N4) {
            const int j = it - N3, b = j >> 4, h = (j >> 1) & 7, qb = j & 1;
            attn_block<2, false>(QA + (size_t)h * NT * 64, NLAT + b * 256 + qb * 128, KA + (size_t)(b * 2 + (h >> 2)) * KEYS * 64, VA + (size_t)(b * 2 + (h >> 2)) * KEYS * 64,
                                 4, OX + h * 64, 0, 0, 0, nullptr, lds);
        } else {
            const int j = it - N4, b = j >> 3, h = (j >> 1) & 3, qb = j & 1;
            attn_block<2, false>(QB + (size_t)h * NT * 64, NLAT + b * 256 + qb * 128, KBp + (size_t)(b * 4 + h) * KEYS * 64, VBp + (size_t)(b * 4 + h) * KEYS * 64,
                                 4, OX + 512 + h * 64, 0, 0, 0, nullptr, lds);
        }
    }
}

DEV void phase_outproj(const Params& p, int l, char* lds) {
    const int tid = get_tid(), lane = tid & 63, wid = tid >> 6, fr = lane & 15, fq = lane >> 4, wr = wid >> 1, wc = wid & 1;
    const bf16_t* OX = (const bf16_t*)(p.ws + OFF_OX);
    const bf16_t* W = (const bf16_t*)(p.ws + OFF_WOUT) + (size_t)l * 1024 * 1024;
    const float* mod = (const float*)(p.ws + OFF_MOD) + (size_t)l * 9 * 6144;
    bf16_t* X = (bf16_t*)(p.ws + OFF_X);
    const int nitems = (l == 0 ? 144 : 128) * 8;
    for (int it = blockIdx.x; it < nitems; it += gridDim.x) {
        const int mt = it >> 3, nt = it & 7, m0 = mt * 128, n0 = nt * 128;
        const unsigned a0 = (unsigned)m0 * 1024u + st64_off(tid), b0 = (unsigned)n0 * 1024u + st64_off(tid);
        f32x4 acc[4][4]; zero_acc<4, 4>(acc);
        const unsigned ao[4] = {a0, a0 + 32u * 1024u, a0 + 64u * 1024u, a0 + 96u * 1024u};
        const unsigned bo[4] = {b0, b0 + 32u * 1024u, b0 + 64u * 1024u, b0 + 96u * 1024u};
        if (m0 < NLAT) gemm_core64<true>(acc, OX, ao, W, bo, 1024, lds, (const bf16_t*)(p.ws + OFF_OXT) + (size_t)(m0 >> 11) * 256 * 2048 + (m0 & 2047), 12);
        else gemm_core64<true>(acc, OX, ao, W, bo, 1024, lds);
        const float* g1 = mod + (size_t)mod_group(m0) * 6144 + 2048;
#pragma unroll
        for (int m = 0; m < 4; ++m) {
            const int row = m0 + wr * 64 + m * 16 + fr;
            const float* xin = row < NLAT ? p.x + (size_t)row * 1024 : p.ctx + (size_t)(row - NLAT) * 1024;
#pragma unroll
            for (int gg = 0; gg < 2; ++gg) {
                const int col = n0 + wc * 64 + gg * 32 + 8 * fq;
                f32x4 x0, x1;
                if (l == 0) { x0 = *(const f32x4*)(xin + col); x1 = *(const f32x4*)(xin + col + 4); }
                else { const u32x4 w = *(const u32x4*)(X + (size_t)row * 1024 + col);
                       x0 = (f32x4){__uint_as_float(w[0] << 16), __uint_as_float(w[0] & 0xffff0000u), __uint_as_float(w[1] << 16), __uint_as_float(w[1] & 0xffff0000u)};
                       x1 = (f32x4){__uint_as_float(w[2] << 16), __uint_as_float(w[2] & 0xffff0000u), __uint_as_float(w[3] << 16), __uint_as_float(w[3] & 0xffff0000u)}; }
                const f32x4 o0 = x0 * DN_ALPHA + *(const f32x4*)(g1 + col) * acc[m][2 * gg], o1 = x1 * DN_ALPHA + *(const f32x4*)(g1 + col + 4) * acc[m][2 * gg + 1];
                *(u32x4*)(X + (size_t)row * 1024 + col) = (u32x4){pk2(o0[0], o0[1]), pk2(o0[2], o0[3]), pk2(o1[0], o1[1]), pk2(o1[2], o1[3])};
            }
        }
    }
}

DEV void phase_ln1route(const Params& p, int l, char* lds) {
    const int tid = get_tid(), lane = tid & 63, wid = tid >> 6, fr = lane & 15, fq = lane >> 4;
    bf16_t* X = (bf16_t*)(p.ws + OFF_X);
    bf16_t* H = (bf16_t*)(p.ws + OFF_H);
    const bf16_t* RW = (const bf16_t*)(p.ws + OFF_RW) + (size_t)l * 64 * 1024;
    const float* mod = (const float*)(p.ws + OFF_MOD) + (size_t)l * 9 * 6144;
    int* cnt = (int*)(p.ws + OFF_CNT) + l * 64 * 64;
    int* tke = (int*)(p.ws + OFF_TKE); int* tks = (int*)(p.ws + OFF_TKS); float* tkw = (float*)(p.ws + OFF_TKW);
    int* list = (int*)(p.ws + OFF_LIST);
    char* HT = lds;
    float* LG = (float*)(lds + 16 * 2064);
    const float rbias = p.router_b[l * 64 + lane];
    const int nitems = (l == 0 ? NT : NLAT) / 16;
    for (int it = blockIdx.x; it < nitems; it += gridDim.x) {
        const int m0 = it * 16;
        const float* mg = mod + (size_t)mod_group(m0) * 6144;
        f32x4 vv[4][4];
#pragma unroll
        for (int i = 0; i < 4; ++i) row_load_bf(X + (size_t)(m0 + wid * 4 + i) * 1024, vv[i], lane);
        f32x4 lg[4], lb[4], msh[4], msc[4];
#pragma unroll
        for (int j = 0; j < 4; ++j) {
            const int c = 4 * lane + 256 * j;
            lg[j] = *(const f32x4*)(p.ln1_g + l * 1024 + c); lb[j] = *(const f32x4*)(p.ln1_b + l * 1024 + c);
            msh[j] = *(const f32x4*)(mg + 3072 + c); msc[j] = *(const f32x4*)(mg + 4096 + c) + 1.0f;
        }
#pragma unroll
        for (int i = 0; i < 4; ++i) {
            const int rl = wid * 4 + i, row = m0 + rl;
            row_norm(vv[i]);
#pragma unroll
            for (int j = 0; j < 4; ++j) {
                const int c = 4 * lane + 256 * j;
                vv[i][j] = vv[i][j] * lg[j] + lb[j];
                st_bf4(X + (size_t)row * 1024 + c, vv[i][j]);
            }
            row_norm(vv[i]);
#pragma unroll
            for (int j = 0; j < 4; ++j) {
                const int c = 4 * lane + 256 * j;
                const f32x4 o = vv[i][j] * msc[j] + msh[j];
                const u32x2 w = (u32x2){pk2(o[0], o[1]), pk2(o[2], o[3])};
                *(u32x2*)(H + (size_t)row * 1024 + c) = w;
                *(u32x2*)(HT + rl * 2064 + c * 2) = w;
            }
        }
        __syncthreads();
        f32x4 acc = (f32x4){0.f, 0.f, 0.f, 0.f};
        const bf16_t* bp = RW + (size_t)(wid * 16 + fr) * 1024 + fq * 8;
#pragma unroll 8
        for (int ks = 0; ks < 32; ++ks) {
            const bf16x8 bq = *(const bf16x8*)(bp + ks * 32);
            const bf16x8 af = *(const bf16x8*)(HT + fr * 2064 + (ks * 32 + fq * 8) * 2);
            acc = mfma16(bq, af, acc);
        }
        *(f32x4*)(LG + fr * 64 + wid * 16 + 4 * fq) = acc;
        __syncthreads();
        int* RS = (int*)(lds + 16 * 2064 + 4096 + 2048);
        float* RWt = (float*)(lds + 16 * 2064 + 4096 + 2048 + 4096);
        int lc = 0;
        unsigned* KW = (unsigned*)(lds + 16 * 2064 + 4096 + 2048 + 8192) + wid * 160;
#pragma unroll 1
        for (int i = 0; i < 4; ++i) {
            const int rl = wid * 4 + i;
            const float sc = 1.0f / (1.0f + __expf(-LG[rl * 64 + lane]));
            const float sel = sc + rbias;
            const int grp = lane >> 3;
            const unsigned key = (__float_as_uint(sel + 2.0f) & 0xFFFFFFC0u) | (unsigned)(63 - lane);
            KW[lane] = key;
            __builtin_amdgcn_wave_barrier();
            int rankg = 0;
            {
                const u32x4 k0 = *(const u32x4*)(KW + grp * 8), k1 = *(const u32x4*)(KW + grp * 8 + 4);
#pragma unroll
                for (int j = 0; j < 4; ++j) { rankg += (k0[j] > key) ? 1 : 0; rankg += (k1[j] > key) ? 1 : 0; }
            }
            float gs = rankg < 2 ? sel : 0.f;
            gs += __shfl_xor(gs, 1); gs += __shfl_xor(gs, 2); gs += __shfl_xor(gs, 4);
            const unsigned gkey = (__float_as_uint(gs + 4.0f) & 0xFFFFFFF8u) | (unsigned)(7 - grp);
            if ((lane & 7) == 0) KW[128 + grp] = gkey;
            __builtin_amdgcn_wave_barrier();
            int rg = 0;
            {
                const u32x4 g0 = *(const u32x4*)(KW + 128), g1 = *(const u32x4*)(KW + 132);
#pragma unroll
                for (int j = 0; j < 4; ++j) { rg += (g0[j] > gkey) ? 1 : 0; rg += (g1[j] > gkey) ? 1 : 0; }
            }
            const bool selg = rg < 4;
            const unsigned vkey = selg ? key : 0u;
            KW[64 + lane] = vkey;
            __builtin_amdgcn_wave_barrier();
            int rank = 0;
#pragma unroll
            for (int q = 0; q < 16; ++q) {
                const u32x4 kk = *(const u32x4*)(KW + 64 + q * 4);
#pragma unroll
                for (int j = 0; j < 4; ++j) rank += (kk[j] > vkey) ? 1 : 0;
            }
            const bool ch = selg && rank < 8;
            const float wsum = wave_sum(ch ? sc : 0.f);
            RS[rl * 64 + lane] = ch ? rank : -1;
            RWt[rl * 64 + lane] = sc * (2.5f / wsum);
            lc += ch ? 1 : 0;
            __builtin_amdgcn_wave_barrier();
        }
        int* WC = (int*)(lds + 16 * 2064 + 4096);
        WC[wid * 64 + lane] = lc;
        __syncthreads();
        if (wid == 0) {
            const int tot = WC[lane] + WC[64 + lane] + WC[128 + lane] + WC[192 + lane];
            int base = 0;
            if (tot > 0) base = atomicAdd(&cnt[lane * 64], tot);
            WC[256 + lane] = base;
        }
        __syncthreads();
        {
            int slot = WC[256 + lane];
#pragma unroll
            for (int w2 = 0; w2 < 4; ++w2) slot += (w2 < wid) ? WC[w2 * 64 + lane] : 0;
#pragma unroll 1
            for (int i = 0; i < 4; ++i) {
                const int rl = wid * 4 + i, rk = RS[rl * 64 + lane];
                if (rk >= 0) {
                    const int row = m0 + rl;
                    list[(size_t)lane * NT + slot] = row * 8 + rk;
                    tke[row * 8 + rk] = lane; tks[row * 8 + rk] = slot; tkw[row * 8 + rk] = RWt[rl * 64 + lane];
                    ++slot;
                }
            }
        }
        __syncthreads();
    }
}

constexpr int YS_EXT_ROWS = NLAT * 1024 * 4 / 1024;
constexpr int PLAN_OFF = 68 * 1024;
DEV void moe_plan(const int* cnt, int cap, int l, char* lds) {
    int* PL = (int*)(lds + PLAN_OFF);
    const int tid = get_tid();
    __syncthreads();
    if (tid < 64) {
        const int lane = tid;
        const int c = cnt[lane * 64], tiles = (c + 127) >> 7;
        int pr = c, pt = tiles;
#pragma unroll
        for (int o = 1; o < 64; o <<= 1) { const int a = __shfl_up(pr, o), b = __shfl_up(pt, o); if (lane >= o) { pr += a; pt += b; } }
        const int G = (int)gridDim.x, nshu = 2 * ((l == 0 ? NT : NLAT) / 128);
        const int units = nshu + __builtin_amdgcn_readlane(pt, 63);
        const int cap8 = cap * 2;
        const bool one_round = __builtin_amdgcn_readlane(pr, 63) + nshu * 128 <= cap8;
        const int target0 = one_round ? 0 : ((units + G - 1) / G - 1) * G;
        PL[144 + lane] = c;
        int start = 0, base_r = 0, base_t = 0, round = 0;
        for (;;) {
            const int lim = (round == 0) ? ((target0 > 0) ? cap8 + YS_EXT_ROWS : cap8) - nshu * 128 : cap8;
            const bool bad = (lane >= start) && ((pr - base_r > lim) || (round == 0 && target0 > 0 && lane > 0 && nshu + pt > target0));
            const unsigned long long m = __ballot(bad);
            int end = m ? (int)__builtin_ctzll(m) : 64;
            if (end <= start) end = start + 1;
            if (lane >= start && lane < end) { PL[16 + lane] = pt - tiles - base_t; PL[80 + lane] = pr - c - base_r; }
            if (lane == 0) { PL[1 + round] = start; PL[10 + round] = __builtin_amdgcn_readlane(pt, end - 1) - base_t; PL[208 + round] = __builtin_amdgcn_readlane(pr, end - 1) - base_r; }
            if (end >= 64 || round >= 7) { if (lane == 0) { PL[0] = round + 1; PL[2 + round] = 64; } break; }
            base_r = __builtin_amdgcn_readlane(pr, end - 1); base_t = __builtin_amdgcn_readlane(pt, end - 1);
            start = end; ++round;
        }
    }
    __syncthreads();
}
constexpr float YS_SCALE = 32.0f, YS_INV = 1.0f / 32.0f;
DEV unsigned char* ys_row(const Params& p, int idx) {
    const int cap8 = p.cap * 2;
    return idx < cap8 ? p.ws + OFF_YS + (size_t)idx * 1024 : (unsigned char*)p.out + (size_t)(idx - cap8) * 1024;
}
DEV unsigned pk4_fp8(const f32x4& v) {
    int w = 0;
    w = __builtin_amdgcn_cvt_pk_fp8_f32(v[0] * YS_SCALE, v[1] * YS_SCALE, w, false);
    w = __builtin_amdgcn_cvt_pk_fp8_f32(v[2] * YS_SCALE, v[3] * YS_SCALE, w, true);
    return (unsigned)w;
}
DEV f32x4 up4_fp8(unsigned w) {
    const f32x2 lo = __builtin_amdgcn_cvt_pk_f32_fp8((int)w, false), hi = __builtin_amdgcn_cvt_pk_f32_fp8((int)w, true);
    return (f32x4){lo[0], lo[1], hi[0], hi[1]};
}

template <bool SHARED>
DEV void moe_tile(const Params& p, const bf16_t* W13, const bf16_t* W2, const int* list, int s0, int nvalid, int ysbase, int m0, int half, const float* g2, char* lds) {
    const int tid = get_tid(), lane = tid & 63, wid = tid >> 6, fr = lane & 15, fq = lane >> 4, wr = wid >> 1, wc = wid & 1;
    const bf16_t* H = (const bf16_t*)(p.ws + OFF_H);
    const float* tkw = (const float*)(p.ws + OFF_TKW);
    char* ACT = lds;
    const unsigned ch8 = (unsigned)(((tid & 7) ^ ((tid >> 3) & 7)) * 8);
    unsigned ao[4];
    float gw[4];
    if (SHARED) {
#pragma unroll
        for (int i = 0; i < 4; ++i) ao[i] = (unsigned)(m0 + i * 32 + (tid >> 3)) * 1024u + ch8;
#pragma unroll
        for (int m = 0; m < 4; ++m) gw[m] = 1.0f;
    } else {
#pragma unroll
        for (int i = 0; i < 4; ++i) { const int rr = min(i * 32 + (tid >> 3), nvalid - 1); ao[i] = (unsigned)(list[s0 + rr] >> 3) * 1024u + ch8; }
#pragma unroll
        for (int m = 0; m < 4; ++m) { const int rl = min(wr * 64 + m * 16 + fr, nvalid - 1); gw[m] = tkw[list[s0 + rl]]; }
    }
    u32x2 areg[2][4][2];
#pragma unroll
    for (int np = 0; np < 2; ++np) {
        const unsigned b0 = (unsigned)(np * 128) * 1024u + st64_off(tid);
        const unsigned bo[4] = {b0, b0 + 32u * 1024u, b0 + 64u * 1024u, b0 + 96u * 1024u};
        const unsigned aoc[4] = {ao[0], ao[1], ao[2], ao[3]};
        f32x4 acc[4][4]; zero_acc<4, 4>(acc);
        gemm_core64<true>(acc, H, aoc, W13, bo, 1024, lds);
#pragma unroll
        for (int m = 0; m < 4; ++m)
#pragma unroll
            for (int pi = 0; pi < 2; ++pi) {
                float o[4];
#pragma unroll
                for (int j = 0; j < 4; ++j) { const float a = acc[m][2 * pi][j], b = acc[m][2 * pi + 1][j]; o[j] = a / (1.0f + __expf(-a)) * b * gw[m]; }
                areg[np][m][pi] = (u32x2){pk2(o[0], o[1]), pk2(o[2], o[3])};
            }
    }
    __syncthreads();
#pragma unroll
    for (int np = 0; np < 2; ++np)
#pragma unroll
        for (int m = 0; m < 4; ++m)
#pragma unroll
            for (int pi = 0; pi < 2; ++pi) *(u32x2*)(ACT + (wr * 64 + m * 16 + fr) * 272 + (np * 64 + wc * 32 + pi * 16 + 4 * fq) * 2) = areg[np][m][pi];
    __syncthreads();
    if (SHARED) {
        gemm2_stream64<128, 272>(W2, ACT, lds + 36864, [&](int nt, const f32x4 (&acc)[4][4]) {
#pragma unroll
            for (int m = 0; m < 4; ++m) {
                unsigned char* o = ys_row(p, ysbase + m0 + wr * 64 + m * 16 + fr) + nt * 128 + wc * 64 + 8 * fq;
#pragma unroll
                for (int g = 0; g < 2; ++g) *(u32x2*)(o + g * 32) = (u32x2){pk4_fp8(acc[m][2 * g]), pk4_fp8(acc[m][2 * g + 1])};
            }
        });
    } else {
        gemm2_stream64<128, 272>(W2, ACT, lds + 36864, [&](int nt, const f32x4 (&acc)[4][4]) {
#pragma unroll
            for (int m = 0; m < 4; ++m) {
                const int rl = wr * 64 + m * 16 + fr;
                if (rl < nvalid) {
                    unsigned char* o = ys_row(p, ysbase + s0 + rl) + nt * 128 + wc * 64 + 8 * fq;
#pragma unroll
                    for (int g = 0; g < 2; ++g) *(u32x2*)(o + g * 32) = (u32x2){pk4_fp8(acc[m][2 * g]), pk4_fp8(acc[m][2 * g + 1])};
                }
            }
        });
    }
    __syncthreads();
}
DEV void phase_moe(const Params& p, int l, int r, char* lds) {
    const int* cnt = (const int*)(p.ws + OFF_CNT) + l * 64 * 64;
    moe_plan(cnt, p.cap, l, lds);
    const int* PL = (const int*)(lds + PLAN_OFF);
    if (r >= PL[0]) return;
    const int e_lo = PL[1 + r], e_hi = PL[2 + r];
    const int nrt = PL[10 + r];
    const int nrows = (l == 0) ? NT : NLAT;
    const int nshu = (r == 0) ? 2 * (nrows / 128) : 0;
    const int G = (int)gridDim.x, b = vblock();
    const int q = (nshu + nrt + G - 1) / G;
    const int u0 = b * q, u1 = min(u0 + q, nshu + nrt);
    int e = e_lo;
    for (int u = u0; u < u1; ++u) {
        if (u < nshu) {
            const int m0 = (u >> 1) * 128, hh = u & 1;
            moe_tile<true>(p, (const bf16_t*)(p.ws + OFF_SW13) + (size_t)(l * 2 + hh) * 256 * 1024, (const bf16_t*)(p.ws + OFF_SW2) + (size_t)(l * 2 + hh) * 1024 * 128,
                           nullptr, 0, 128, PL[208] + hh * nrows, m0, hh, nullptr, lds);
        } else {
            const int it = u - nshu;
            while (e + 1 < e_hi && PL[16 + e + 1] <= it) ++e;
            const int s0 = (it - PL[16 + e]) * 128;
            moe_tile<false>(p, (const bf16_t*)(p.ws + OFF_W13) + (size_t)e * 256 * 1024, (const bf16_t*)(p.ws + OFF_W2) + (size_t)e * 1024 * 128,
                            (const int*)(p.ws + OFF_LIST) + (size_t)e * NT, s0, min(128, PL[144 + e] - s0), PL[80 + e], 0, 0, nullptr, lds);
        }
    }
}

DEV void phase_comb(const Params& p, int l, int r, char* lds) {
    const int tid_ = get_tid(), lane = tid_ & 63, wid = tid_ >> 6;
    const int* cnt = (const int*)(p.ws + OFF_CNT) + l * 64 * 64;
    moe_plan(cnt, p.cap, l, lds);
    const int* PL = (const int*)(lds + PLAN_OFF);
    if (r >= PL[0]) return;
    const int e_lo = PL[1 + r], e_hi = PL[2 + r];
    const bool final = (r == PL[0] - 1);
    bf16_t* X = (bf16_t*)(p.ws + OFF_X);
    bf16_t* H = (bf16_t*)(p.ws + OFF_H);
    const int* tke = (const int*)(p.ws + OFF_TKE); const int* tks = (const int*)(p.ws + OFF_TKS);
    const float* mod = (const float*)(p.ws + OFF_MOD);
    const int nrows = (l == 0) ? NT : NLAT;
    for (int row = blockIdx.x * 4 + wid; row < nrows; row += gridDim.x * 4) {
        const int g = mod_group(row);
        const float* g2 = mod + ((size_t)l * 9 + g) * 6144 + 5120 + 16 * lane;
        int idx_l = -1;
        if (lane < 8) { const int e = tke[row * 8 + lane]; const int sl = tks[row * 8 + lane]; if (e >= e_lo && e < e_hi) idx_l = PL[80 + e] + sl; }
        f32x4 v[4];
        {
            const u32x4 a = *(const u32x4*)(X + (size_t)row * 1024 + 16 * lane), b2 = *(const u32x4*)(X + (size_t)row * 1024 + 16 * lane + 8);
            v[0] = (f32x4){__uint_as_float(a[0] << 16), __uint_as_float(a[0] & 0xffff0000u), __uint_as_float(a[1] << 16), __uint_as_float(a[1] & 0xffff0000u)};
            v[1] = (f32x4){__uint_as_float(a[2] << 16), __uint_as_float(a[2] & 0xffff0000u), __uint_as_float(a[3] << 16), __uint_as_float(a[3] & 0xffff0000u)};
            v[2] = (f32x4){__uint_as_float(b2[0] << 16), __uint_as_float(b2[0] & 0xffff0000u), __uint_as_float(b2[1] << 16), __uint_as_float(b2[1] & 0xffff0000u)};
            v[3] = (f32x4){__uint_as_float(b2[2] << 16), __uint_as_float(b2[2] & 0xffff0000u), __uint_as_float(b2[3] << 16), __uint_as_float(b2[3] & 0xffff0000u)};
        }
        u32x4 y[10];
#pragma unroll
        for (int k = 0; k < 8; ++k) {
            const int idx = __builtin_amdgcn_readlane(idx_l, k);
            if (idx >= 0) y[k] = *(const u32x4*)(ys_row(p, idx) + 16 * lane); else y[k] = (u32x4){0u, 0u, 0u, 0u};
        }
        if (r == 0) { y[8] = *(const u32x4*)(ys_row(p, PL[208] + row) + 16 * lane); y[9] = *(const u32x4*)(ys_row(p, PL[208] + nrows + row) + 16 * lane); }
        else { y[8] = (u32x4){0u, 0u, 0u, 0u}; y[9] = y[8]; }
        f32x4 s[4];
#pragma unroll
        for (int j = 0; j < 4; ++j) s[j] = (f32x4){0.f, 0.f, 0.f, 0.f};
#pragma unroll
        for (int k = 0; k < 10; ++k)
#pragma unroll
            for (int j = 0; j < 4; ++j) s[j] += up4_fp8(y[k][j]);
        const float xs = (r == 0) ? DN_ALPHA : 1.0f;
#pragma unroll
        for (int j = 0; j < 4; ++j) v[j] = v[j] * xs + *(const f32x4*)(g2 + 4 * j) * (s[j] * YS_INV);
        if (!final) {
            u32x4 o0, o1;
            o0 = (u32x4){pk2(v[0][0], v[0][1]), pk2(v[0][2], v[0][3]), pk2(v[1][0], v[1][1]), pk2(v[1][2], v[1][3])};
            o1 = (u32x4){pk2(v[2][0], v[2][1]), pk2(v[2][2], v[2][3]), pk2(v[3][0], v[3][1]), pk2(v[3][2], v[3][3])};
            *(u32x4*)(X + (size_t)row * 1024 + 16 * lane) = o0; *(u32x4*)(X + (size_t)row * 1024 + 16 * lane + 8) = o1;
        } else {
            row_norm(v);
#pragma unroll
            for (int j = 0; j < 4; ++j) {
                const int c = 16 * lane + 4 * j;
                v[j] = v[j] * *(const f32x4*)(p.ln2_g + l * 1024 + c) + *(const f32x4*)(p.ln2_b + l * 1024 + c);
                if (l != 0) *(f32x4*)(p.out + (size_t)row * 1024 + c) = v[j];
            }
            if (l == 0) {
                u32x4 o0, o1;
                o0 = (u32x4){pk2(v[0][0], v[0][1]), pk2(v[0][2], v[0][3]), pk2(v[1][0], v[1][1]), pk2(v[1][2], v[1][3])};
                o1 = (u32x4){pk2(v[2][0], v[2][1]), pk2(v[2][2], v[2][3]), pk2(v[3][0], v[3][1]), pk2(v[3][2], v[3][3])};
                *(u32x4*)(X + (size_t)row * 1024 + 16 * lane) = o0; *(u32x4*)(X + (size_t)row * 1024 + 16 * lane + 8) = o1;
                row_norm(v);
                const float* m1 = mod + ((size_t)9 + g) * 6144 + 16 * lane;
                f32x4 h[4];
#pragma unroll
                for (int j = 0; j < 4; ++j) h[j] = v[j] * (*(const f32x4*)(m1 + 1024 + 4 * j) + 1.0f) + *(const f32x4*)(m1 + 4 * j);
                o0 = (u32x4){pk2(h[0][0], h[0][1]), pk2(h[0][2], h[0][3]), pk2(h[1][0], h[1][1]), pk2(h[1][2], h[1][3])};
                o1 = (u32x4){pk2(h[2][0], h[2][1]), pk2(h[2][2], h[2][3]), pk2(h[3][0], h[3][1]), pk2(h[3][2], h[3][3])};
                *(u32x4*)(H + (size_t)row * 1024 + 16 * lane) = o0; *(u32x4*)(H + (size_t)row * 1024 + 16 * lane + 8) = o1;
            }
        }
    }
    if (final && l == 0) {
        __syncthreads();
        conv_run(p, 1, (int)blockIdx.x * 12, 12, lds);
    }
}


#define XB_TMO      128
#define XB_XCNT(j)  (256  + 64 * (j))
#define XB_XSUB(j)  (1280 + 64 * (j))
#define XB_XGEN(j)  (2304 + 64 * (j))
#define XB_TOP      3328
#define XB_TOPGEN   3392
#define XCD_BAR_WORDS 3456
#define XB_SPIN_CAP (1u << 22)
DEV unsigned xb_ld(unsigned* p) { return __hip_atomic_load(p, __ATOMIC_RELAXED, __HIP_MEMORY_SCOPE_AGENT); }
DEV unsigned xb_add(unsigned* p, unsigned v) { return __hip_atomic_fetch_add(p, v, __ATOMIC_RELAXED, __HIP_MEMORY_SCOPE_AGENT); }
DEV unsigned xb_xcc_id() { return (unsigned)__builtin_amdgcn_s_getreg((3 << 11) | 20) & 0xFu; }
#define XB_SPIN(cond, bar) do { unsigned _sp = 0; while (cond) { __builtin_amdgcn_s_sleep(1); \
    if ((++_sp & 255u) == 0u) { if (xb_ld(&(bar)[XB_TMO])) break; if (_sp > XB_SPIN_CAP) { atomicAdd(&(bar)[XB_TMO], 1u); break; } } } } while (0)
struct XcdBarrier { unsigned* bar; unsigned x; volatile LAS unsigned* st; };
DEV XcdBarrier xcd_barrier_post(unsigned* bar, volatile LAS unsigned* st) {
    XcdBarrier b; b.bar = bar; b.x = xb_xcc_id(); b.st = st;
    if (threadIdx.x == 0) (void)xb_add(&bar[XB_XCNT(b.x)], 1u);
    return b;
}
DEV void xcd_barrier_complete(unsigned* bar, unsigned x, unsigned& nloc, unsigned& nx) {
    const unsigned G = gridDim.x * gridDim.y * gridDim.z;
    unsigned sum, cnt, mine, sp = 0u;
    for (;;) {
        sum = 0u; cnt = 0u; mine = 0u;
#pragma unroll
        for (unsigned j = 0; j < 16; ++j) { const unsigned c = xb_ld(&bar[XB_XCNT(j)]); sum += c; cnt += (c > 0u) ? 1u : 0u; mine = (j == x) ? c : mine; }
        if (sum == G) break;
        __builtin_amdgcn_s_sleep(1);
        if ((++sp & 255u) == 0u) { if (xb_ld(&bar[XB_TMO])) break; if (sp > XB_SPIN_CAP) { atomicAdd(&bar[XB_TMO], 1u); break; } }
    }
    nloc = mine > 0u ? mine : 1u; nx = cnt > 0u ? cnt : 1u;
}
DEV void xcd_barrier(const XcdBarrier& b) {
    asm volatile("s_waitcnt vmcnt(0)" ::: "memory");
    __syncthreads();
    if (get_tid() == 0) {
        unsigned* bar = b.bar; asm volatile("" : "+s"(bar));
        __builtin_amdgcn_s_waitcnt(0);
        unsigned nloc = b.st[0], nx = b.st[1];
        if (nloc == 0u) { xcd_barrier_complete(bar, b.x, nloc, nx); b.st[0] = nloc; b.st[1] = nx; }
        const unsigned old = xb_add(&bar[XB_XSUB(b.x)], 1u);
        const unsigned gen = old / nloc;
        if (old + 1u == (gen + 1u) * nloc) {
            __builtin_amdgcn_fence(__ATOMIC_RELEASE, "agent");
            asm volatile("s_waitcnt vmcnt(0)" ::: "memory");
            const unsigned og = xb_add(&bar[XB_TOP], 1u);
            const unsigned tg = og / nx;
            if (og + 1u == (tg + 1u) * nx) xb_add(&bar[XB_TOPGEN], 1u);
            else XB_SPIN(xb_ld(&bar[XB_TOPGEN]) == tg, bar);
            __builtin_amdgcn_fence(__ATOMIC_ACQUIRE, "agent");
            xb_add(&bar[XB_XGEN(b.x)], 1u);
            asm volatile("s_waitcnt vmcnt(0)" ::: "memory");
        } else {
            XB_SPIN(xb_ld(&bar[XB_XGEN(b.x)]) == gen, bar);
            __builtin_amdgcn_fence(__ATOMIC_ACQUIRE, "agent");
            asm volatile("s_waitcnt vmcnt(0)" ::: "memory");
        }
    }
    __syncthreads();
}

enum { PT_PREP = 0, PT_MODFIN, PT_LNMOD0, PT_INPROJ, PT_MIX, PT_OUTPROJ, PT_LN1ROUTE, PT_MOE, PT_COMB };

DEV void run_phase(const Params& pin, int type, int l, int r, char* lds) {
    Params p = pin;
    { unsigned char* w = p.ws; asm volatile("" : "+s"(w)); p.ws = w; }
    switch (type) {
        case PT_PREP: phase_prep(p, lds); break;
        case PT_MODFIN: phase_modfin(p); break;
        case PT_LNMOD0: phase_lnmod0(p); break;
        case PT_INPROJ: phase_inproj(p, l, lds); break;
        case PT_MIX: phase_mix(p, l, lds); break;
        case PT_OUTPROJ: phase_outproj(p, l, lds); break;
        case PT_LN1ROUTE: phase_ln1route(p, l, lds); break;
        case PT_MOE: phase_moe(p, l, r, lds); break;
        default: phase_comb(p, l, r, lds); break;
    }
}

__global__ void __launch_bounds__(256, 2) fwd_kernel(Params p) {
    __shared__ __attribute__((aligned(16))) char smem[SMEM_BYTES];
#if MULTI_LAUNCH
    run_phase(p, p.ptype, p.pl, p.pr, smem);
#else
    if (threadIdx.x < 4) ((volatile LAS unsigned*)(smem + SMEM_BYTES - 16))[threadIdx.x] = 0u;
    __syncthreads();
    const XcdBarrier bar = xcd_barrier_post((unsigned*)(p.ws + OFF_BAR), (volatile LAS unsigned*)(smem + SMEM_BYTES - 16));
    int type = PT_PREP, l = 0, r = 0;
    for (;;) {
        run_phase(p, type, l, r, smem);
        if (type < PT_MOE) { ++type; if (type == PT_MODFIN) ++type; r = 0; }
        else if (type == PT_MOE) type = PT_COMB;
        else {
            const int nr = ((const int*)(smem + PLAN_OFF))[0];
            if (r + 1 < nr) { ++r; type = PT_MOE; }
            else { if (l == 1) break; l = 1; r = 0; type = PT_INPROJ; }
        }
        xcd_barrier(bar);
    }
#endif
}

extern "C" void kernel_launch(void* const* d_in, const int* in_sizes, int n_in, void* d_out, int out_size, void* d_ws, size_t ws_size, hipStream_t stream) {
    Params p{};
    const float** pp = (const float**)&p;
    for (int i = 0; i < 32; ++i) pp[i] = (const float*)d_in[i];
    p.out = (float*)d_out; p.ws = (unsigned char*)d_ws;
    long long cap = ((long long)ws_size - (long long)OFF_R) / 2048;
    if (cap > NT * 8) cap = NT * 8;
    if (cap * 2048 < (long long)R_MIN_BYTES || cap < NT) { fprintf(stderr, "kernel_launch: workspace too small (%zu)\n", ws_size); return; }
    p.cap = (int)cap;
#if MULTI_LAUNCH
    const int grid = 512;
    auto launch = [&](int type, int l, int r) { Params q = p; q.mode = 1; q.ptype = type; q.pl = l; q.pr = r; hipLaunchKernelGGL(fwd_kernel, dim3(grid), dim3(256), 0, stream, q); };
    launch(PT_PREP, 0, 0); launch(PT_MODFIN, 0, 0); launch(PT_LNMOD0, 0, 0);
    for (int l = 0; l < 2; ++l) {
        launch(PT_INPROJ, l, 0); launch(PT_MIX, l, 0); launch(PT_OUTPROJ, l, 0); launch(PT_LN1ROUTE, l, 0);
        for (int r = 0; r < RMAX; ++r) { launch(PT_MOE, l, r); launch(PT_COMB, l, r); }
    }
#else
    static int grid_blocks = 0;
    if (!grid_blocks) {
        int dev = 0, cus = 0, per_cu = 0;
        hipGetDevice(&dev);
        hipDeviceGetAttribute(&cus, hipDeviceAttributeMultiprocessorCount, dev);
        hipOccupancyMaxActiveBlocksPerMultiprocessor(&per_cu, fwd_kernel, 256, 0);
        if (per_cu > 2) per_cu = 2;
        if (per_cu < 1) per_cu = 1;
        grid_blocks = cus * per_cu;
    }
    p.mode = 0;
    hipMemsetAsync(d_ws, 0, 65536, stream);
    hipLaunchKernelGGL(fwd_kernel, dim3(grid_blocks), dim3(256), 0, stream, p);
#endif
}
```

```cpp
#include <hip/hip_runtime.h>
#include <hip/hip_cooperative_groups.h>
#include <stdint.h>
#include <stdio.h>
namespace cg = cooperative_groups;

#ifndef MULTI_LAUNCH
#define MULTI_LAUNCH 0
#endif

typedef unsigned short bf16_t;
typedef short bf16x8 __attribute__((ext_vector_type(8)));
typedef short s16x4 __attribute__((ext_vector_type(4)));
typedef float f32x4 __attribute__((ext_vector_type(4)));
typedef unsigned u32x4 __attribute__((ext_vector_type(4)));
typedef unsigned u32x2 __attribute__((ext_vector_type(2)));
#define DEV __device__ __forceinline__
#define LDSP(T) __attribute__((address_space(3))) T*
#define LAS __attribute__((address_space(3)))

constexpr int D = 1024, NB = 8, SEQ = 2048, CTX = 256, NLAT = NB * SEQ, NCTX = NB * CTX, NT = NLAT + NCTX;
constexpr int PROJ = 2304, KEYS = CTX + SEQ, NEXP = 64;
constexpr float DN_ALPHA = 1.41421356237309515f;
constexpr float LOG2E = 1.44269504088896341f;
constexpr int SMEM_BYTES = 72 * 1024;
constexpr int RMAX = 4;

constexpr size_t OFF_CNT = 0;
constexpr size_t OFF_QUEUE = 33792;
constexpr size_t OFF_BAR = 40960;
constexpr size_t OFF_MOD = 65536;
constexpr size_t OFF_ROPE = OFF_MOD + 442368;
constexpr size_t OFF_KERNL = OFF_ROPE + 2ull * 2048 * 32 * 4;
constexpr size_t OFF_KERNC = OFF_KERNL + 2ull * 4096 * 256 * 4;
constexpr size_t OFF_TKE = OFF_KERNC + 2ull * 512 * 256 * 4;
constexpr size_t OFF_TKS = OFF_TKE + (size_t)NT * 8 * 4;
constexpr size_t OFF_TKW = OFF_TKS + (size_t)NT * 8 * 4;
constexpr size_t OFF_LIST = OFF_TKW + (size_t)NT * 8 * 4;
constexpr size_t OFF_WIN = OFF_LIST + 64ull * NT * 4;
constexpr size_t OFF_WOUT = OFF_WIN + 2ull * 2304 * 1024 * 2;
constexpr size_t OFF_SW13 = OFF_WOUT + 2ull * 1024 * 1024 * 2;
constexpr size_t OFF_SW2 = OFF_SW13 + 2ull * 512 * 1024 * 2;
constexpr size_t OFF_RW = OFF_SW2 + 2ull * 1024 * 256 * 2;
constexpr size_t OFF_W13 = OFF_RW + 2ull * 64 * 1024 * 2;
constexpr size_t OFF_W2 = OFF_W13 + 64ull * 256 * 1024 * 2;
constexpr size_t OFF_X = OFF_W2 + 64ull * 1024 * 128 * 2;
constexpr size_t OFF_H = OFF_X + (size_t)NT * 1024 * 2;
constexpr size_t OFF_R = OFF_H + (size_t)NT * 1024 * 2;
constexpr size_t OFF_QA = OFF_R;
constexpr size_t OFF_QB = OFF_QA + 8ull * NT * 64 * 2;
constexpr size_t OFF_KA = OFF_QB + 4ull * NT * 64 * 2;
constexpr size_t OFF_VA = OFF_KA + 8ull * 2 * KEYS * 64 * 2;
constexpr size_t OFF_KB = OFF_VA + 8ull * 2 * KEYS * 64 * 2;
constexpr size_t OFF_VB = OFF_KB + 8ull * 4 * KEYS * 64 * 2;
constexpr size_t OFF_ZTL = OFF_VB + 8ull * 4 * KEYS * 64 * 2;
constexpr size_t OFF_ZTC = OFF_ZTL + 8ull * 768 * 2048 * 2;
constexpr size_t OFF_OX = OFF_ZTC + 8ull * 768 * 256 * 2;
constexpr size_t OFF_OXT = OFF_OX + (size_t)NT * 1024 * 2;
constexpr size_t R_MIN_BYTES = OFF_OXT + 8ull * 256 * 2048 * 2 - OFF_R;
constexpr size_t OFF_PART = OFF_R;
constexpr size_t OFF_YS = OFF_R;

struct Params {
    const float *x, *c, *ctx, *c_ctx, *ada_w, *ada_b, *w_in, *q_gain, *k_gain, *nat_rpb, *hy_conv_w, *hy_conv_b,
        *hy_f_w1, *hy_f_b1, *hy_f_w2, *hy_f_b2, *hy_f_w3, *hy_freq, *hy_skip, *w_out, *ln1_g, *ln1_b,
        *router_w, *router_b, *exp_w1, *exp_w3, *exp_w2, *sh_w1, *sh_w3, *sh_w2, *ln2_g, *ln2_b;
    float* out; unsigned char* ws;
    int cap, mode, ptype, pl, pr, pad;
};

typedef __bf16 hwbf2 __attribute__((ext_vector_type(2)));
typedef float f32x2 __attribute__((ext_vector_type(2)));
DEV unsigned f2bf(float f) { return (unsigned)__builtin_bit_cast(unsigned short, (__bf16)f); }
DEV unsigned pk2(float lo, float hi) { const f32x2 v = {lo, hi}; return __builtin_bit_cast(unsigned, __builtin_convertvector(v, hwbf2)); }
DEV float bf2f(unsigned short h) { return __uint_as_float(((unsigned)h) << 16); }
DEV float wave_sum(float v) {
#pragma unroll
    for (int o = 32; o > 0; o >>= 1) v += __shfl_xor(v, o);
    return v;
}
DEV void glds16(const void* g, void* l) { __builtin_amdgcn_global_load_lds((const unsigned*)g, (unsigned*)l, 16, 0, 0); }
DEV f32x4 mfma16(bf16x8 a, bf16x8 b, f32x4 c) { return __builtin_amdgcn_mfma_f32_16x16x32_bf16(a, b, c, 0, 0, 0); }
DEV float readlane_f(float v, int l) { return __uint_as_float((unsigned)__builtin_amdgcn_readlane((int)__float_as_uint(v), l)); }
DEV int get_tid() { int t = threadIdx.x; asm volatile("" : "+v"(t)); return t; }
DEV int lchunk(int tid) { return (tid & 3) ^ ((0 - (tid >> 4)) & 3); }
DEV int vblock() { const int G = (int)gridDim.x, b = (int)blockIdx.x; return (G & 7) ? b : (b & 7) * (G >> 3) + (b >> 3); }
DEV int mod_group(int row) { return row < NLAT ? (row >> 11) : 8; }

template <int MI, int NI> DEV void zero_acc(f32x4 (&acc)[MI][NI]) {
#pragma unroll
    for (int m = 0; m < MI; ++m)
#pragma unroll
        for (int n = 0; n < NI; ++n) acc[m][n] = (f32x4){0.f, 0.f, 0.f, 0.f};
}
#define WAIT_VM(n) asm volatile("s_waitcnt vmcnt(" #n ")" ::: "memory")
#define WAIT_LGKM0() asm volatile("s_waitcnt lgkmcnt(0)" ::: "memory")
#define RAW_BARRIER() do { asm volatile("" ::: "memory"); __builtin_amdgcn_s_barrier(); asm volatile("" ::: "memory"); } while (0)
template <int MI, int NI, bool TRANS>
DEV void gemm_core(f32x4 (&acc)[MI][NI], const bf16_t* A, const unsigned (&ao)[MI / 2], const bf16_t* B, const unsigned (&bo)[NI / 2], int K, char* lds) {
    const int tid = get_tid(), lane = tid & 63, wid = tid >> 6, fr = lane & 15, fq = lane >> 4, wr = wid >> 1, wc = wid & 1;
    constexpr int SAB = 2048 * MI, STG = 2048 * (MI + NI), LPT = MI / 2 + NI / 2;
    static_assert(LPT == 3 || LPT == 4 || LPT == 6, "loads per tile");
    const int nt = K >> 5;
    auto stage = [&](int s, int t) {
        char* SA = lds + s * STG; char* SB = SA + SAB;
#pragma unroll
        for (int i = 0; i < MI / 2; ++i) glds16(A + (ao[i] + (unsigned)(t * 32)), SA + i * 4096 + tid * 16);
#pragma unroll
        for (int i = 0; i < NI / 2; ++i) glds16(B + (bo[i] + (unsigned)(t * 32)), SB + i * 4096 + tid * 16);
    };
    WAIT_VM(0);
    stage(0, 0);
    if (nt > 1) stage(1, 1);
    const int sw = (fq ^ ((0 - (fr >> 2)) & 3)) * 16;
    const int aoff = (wr * MI * 16 + fr) * 64 + sw, boff = SAB + (wc * NI * 16 + fr) * 64 + sw;
#pragma unroll 1
    for (int t = 0; t < nt; ++t) {
        if (t + 1 < nt) { if (LPT == 6) WAIT_VM(6); else if (LPT == 4) WAIT_VM(4); else WAIT_VM(3); } else WAIT_VM(0);
        RAW_BARRIER();
        const char* S = lds + (t & 1) * STG;
        bf16x8 af[MI], bfr[NI];
#pragma unroll
        for (int m = 0; m < MI; ++m) af[m] = *(const bf16x8*)(S + aoff + m * 1024);
#pragma unroll
        for (int n = 0; n < NI; ++n) bfr[n] = *(const bf16x8*)(S + boff + n * 1024);
        WAIT_LGKM0();
        RAW_BARRIER();
        if (t + 2 < nt) stage(t & 1, t + 2);
#pragma unroll
        for (int m = 0; m < MI; ++m)
#pragma unroll
            for (int n = 0; n < NI; ++n) acc[m][n] = TRANS ? mfma16(bfr[n], af[m], acc[m][n]) : mfma16(af[m], bfr[n], acc[m][n]);
    }
}
DEV unsigned st64_off(int tid) { return (unsigned)(tid >> 3) * 1024u + (unsigned)(((tid & 7) ^ ((tid >> 3) & 7)) * 8); }
DEV int tr_key(int row) { return (row & 3) | (((row >> 3) & 1) << 2); }
template <bool TRANS>
DEV void gemm_core64(f32x4 (&acc)[4][4], const bf16_t* A, const unsigned (&ao)[4], const bf16_t* B, const unsigned (&bo)[4], int K, char* lds,
                     const bf16_t* AT = nullptr, int t_tr = 1 << 20) {
    const int tid = get_tid(), lane = tid & 63, wid = tid >> 6, fr = lane & 15, fq = lane >> 4, wr = wid >> 1, wc = wid & 1;
    const int nt = K >> 6;
    auto stage = [&](int s, int t) {
        char* SA = lds + s * 32768; char* SB = SA + 16384;
        if (t >= t_tr) {
#pragma unroll
            for (int i = 0; i < 4; ++i) {
                const int id = tid + 256 * i, row = id >> 4, cp = id & 15, c = (cp - 2 * tr_key(row)) & 15;
                glds16(AT + (size_t)((t - t_tr) * 64 + row) * 2048 + c * 8, SA + id * 16);
            }
        } else {
#pragma unroll
            for (int i = 0; i < 4; ++i) glds16(A + (ao[i] + (unsigned)(t * 64)), SA + i * 4096 + tid * 16);
        }
#pragma unroll
        for (int i = 0; i < 4; ++i) glds16(B + (bo[i] + (unsigned)(t * 64)), SB + i * 4096 + tid * 16);
    };
    WAIT_VM(0);
    stage(0, 0);
    if (nt > 1) stage(1, 1);
    const int rsw = fr & 7;
    const int arow = (wr * 64 + fr) * 128, brow = 16384 + (wc * 64 + fr) * 128;
    const int c0 = ((fq) ^ rsw) * 16, c1 = ((4 + fq) ^ rsw) * 16;
#pragma unroll 1
    for (int t = 0; t < nt; ++t) {
        if (t + 1 < nt) WAIT_VM(8); else WAIT_VM(0);
        RAW_BARRIER();
        const char* S = lds + (t & 1) * 32768;
        bf16x8 af[4][2], bfr[4][2];
        if (t >= t_tr) {
            const int q4 = fr >> 2, p4 = fr & 3;
#pragma unroll
            for (int m = 0; m < 4; ++m)
#pragma unroll
                for (int ks = 0; ks < 2; ++ks) {
                    const int rowA = ks * 32 + 8 * fq + q4, rowB = rowA + 4, c = wr * 8 + m * 2 + (p4 >> 1);
                    const int offA = rowA * 256 + (((c + 2 * tr_key(rowA)) & 15) * 16) + (p4 & 1) * 8;
                    const int offB = rowB * 256 + (((c + 2 * tr_key(rowB)) & 15) * 16) + (p4 & 1) * 8;
                    const s16x4 ta = __builtin_amdgcn_ds_read_tr16_b64_v4i16((LDSP(s16x4))(S + offA));
                    const s16x4 tb = __builtin_amdgcn_ds_read_tr16_b64_v4i16((LDSP(s16x4))(S + offB));
                    bf16x8 f; f[0] = ta[0]; f[1] = ta[1]; f[2] = ta[2]; f[3] = ta[3]; f[4] = tb[0]; f[5] = tb[1]; f[6] = tb[2]; f[7] = tb[3];
                    af[m][ks] = f;
                }
        } else {
#pragma unroll
            for (int m = 0; m < 4; ++m) { af[m][0] = *(const bf16x8*)(S + arow + m * 2048 + c0); af[m][1] = *(const bf16x8*)(S + arow + m * 2048 + c1); }
        }
#pragma unroll
        for (int n = 0; n < 4; ++n) { bfr[n][0] = *(const bf16x8*)(S + brow + n * 2048 + c0); bfr[n][1] = *(const bf16x8*)(S + brow + n * 2048 + c1); }
        WAIT_LGKM0();
        RAW_BARRIER();
        if (t + 2 < nt) stage(t & 1, t + 2);
        __builtin_amdgcn_s_setprio(1);
#pragma unroll
        for (int ks = 0; ks < 2; ++ks)
#pragma unroll
            for (int m = 0; m < 4; ++m)
#pragma unroll
                for (int n = 0; n < 4; ++n) acc[m][n] = TRANS ? mfma16(bfr[n][ks], af[m][ks], acc[m][n]) : mfma16(af[m][ks], bfr[n][ks], acc[m][n]);
        __builtin_amdgcn_s_setprio(0);
    }
}
template <int KACT, int ASTRIDE, class EPI>
DEV void gemm2_stream64(const bf16_t* W2, const char* ACT, char* sb, EPI&& epi) {
    const int tid = get_tid(), lane = tid & 63, wid = tid >> 6, fr = lane & 15, fq = lane >> 4, wr = wid >> 1, wc = wid & 1;
    constexpr int KS = KACT / 64, NJ = 8 * KS;
    const unsigned b0 = (unsigned)(tid >> 3) * KACT + (unsigned)(((tid & 7) ^ ((tid >> 3) & 7)) * 8);
    auto stage = [&](int s, int j) {
        const int nt = j / KS, ks = j % KS;
        char* SB = sb + s * 16384;
        const bf16_t* src = W2 + (size_t)nt * 128 * KACT + ks * 64 + b0;
#pragma unroll
        for (int i = 0; i < 4; ++i) glds16(src + (size_t)i * 32 * KACT, SB + i * 4096 + tid * 16);
    };
    WAIT_VM(0);
    stage(0, 0); stage(1, 1);
    const int rsw = fr & 7;
    const int brow = (wc * 64 + fr) * 128, c0 = (fq ^ rsw) * 16, c1 = ((4 + fq) ^ rsw) * 16;
    f32x4 acc[4][4]; zero_acc<4, 4>(acc);
#pragma unroll 1
    for (int j = 0; j < NJ; ++j) {
        const int ks = j % KS;
        if (j + 1 < NJ) WAIT_VM(4); else WAIT_VM(0);
        RAW_BARRIER();
        const char* S = sb + (j & 1) * 16384;
        bf16x8 af[4][2], bfr[4][2];
#pragma unroll
        for (int m = 0; m < 4; ++m) { const char* ar = ACT + (wr * 64 + m * 16 + fr) * ASTRIDE + (ks * 64 + fq * 8) * 2; af[m][0] = *(const bf16x8*)ar; af[m][1] = *(const bf16x8*)(ar + 64); }
#pragma unroll
        for (int n = 0; n < 4; ++n) { bfr[n][0] = *(const bf16x8*)(S + brow + n * 2048 + c0); bfr[n][1] = *(const bf16x8*)(S + brow + n * 2048 + c1); }
        WAIT_LGKM0();
        RAW_BARRIER();
        if (j + 2 < NJ) stage(j & 1, j + 2);
#pragma unroll
        for (int k2 = 0; k2 < 2; ++k2)
#pragma unroll
            for (int m = 0; m < 4; ++m)
#pragma unroll
                for (int n = 0; n < 4; ++n) acc[m][n] = mfma16(bfr[n][k2], af[m][k2], acc[m][n]);
        if (ks == KS - 1) { epi(j / KS, acc); zero_acc<4, 4>(acc); }
    }
}
template <int MI, int KACT, int ASTRIDE, class EPI>
DEV void gemm2_stream(const bf16_t* W2, const char* ACT, char* sb, EPI&& epi) {
    const int tid = get_tid(), lane = tid & 63, wid = tid >> 6, fr = lane & 15, fq = lane >> 4, wr = wid >> 1, wc = wid & 1;
    constexpr int KS = KACT / 32, NJ = 8 * KS;
    const bf16_t* b0 = W2 + (size_t)(tid >> 2) * KACT + lchunk(tid) * 8;
    auto stage = [&](int s, int j) {
        const int nt = j / KS, ks = j % KS;
        char* SB = sb + s * 8192;
        const bf16_t* src = b0 + (size_t)nt * 128 * KACT + ks * 32;
        glds16(src, SB + tid * 16);
        glds16(src + 64 * KACT, SB + 4096 + tid * 16);
    };
    WAIT_VM(0);
    stage(0, 0); stage(1, 1);
    const int boff = (wc * 64 + fr) * 64 + (fq ^ ((0 - (fr >> 2)) & 3)) * 16;
    f32x4 acc[MI][4]; zero_acc<MI, 4>(acc);
#pragma unroll 1
    for (int j = 0; j < NJ; ++j) {
        const int ks = j % KS;
        if (j + 1 < NJ) WAIT_VM(2); else WAIT_VM(0);
        RAW_BARRIER();
        const char* S = sb + (j & 1) * 8192;
        bf16x8 af[MI], bfr[4];
#pragma unroll
        for (int m = 0; m < MI; ++m) af[m] = *(const bf16x8*)(ACT + (wr * MI * 16 + m * 16 + fr) * ASTRIDE + (ks * 32 + fq * 8) * 2);
#pragma unroll
        for (int n = 0; n < 4; ++n) bfr[n] = *(const bf16x8*)(S + boff + n * 1024);
        WAIT_LGKM0();
        RAW_BARRIER();
        if (j + 2 < NJ) stage(j & 1, j + 2);
#pragma unroll
        for (int m = 0; m < MI; ++m)
#pragma unroll
            for (int n = 0; n < 4; ++n) acc[m][n] = mfma16(bfr[n], af[m], acc[m][n]);
        if (ks == KS - 1) { epi(j / KS, acc); zero_acc<MI, 4>(acc); }
    }
}

DEV void prep_mod_item(const Params& p, int it, char* lds) {
    const int l = it / 96, cch = it % 96, tid = get_tid(), col = cch * 64 + (tid & 63), kq = tid >> 6;
    float* sl = (float*)lds;
    float* red = sl + 9 * 1024;
    for (int i = tid; i < 9 * 1024; i += 256) { const int g = i >> 10, k = i & 1023; const float v = (g < 8) ? p.c[g * 1024 + k] : p.c_ctx[k]; sl[i] = v / (1.f + expf(-v)); }
    __syncthreads();
    float acc[9];
#pragma unroll
    for (int g = 0; g < 9; ++g) acc[g] = 0.f;
    const float* w = p.ada_w + ((size_t)l * 1024 + kq * 256) * 6144 + col;
#pragma unroll 16
    for (int kk = 0; kk < 256; ++kk) {
        const float wv = w[(size_t)kk * 6144];
#pragma unroll
        for (int g = 0; g < 9; ++g) acc[g] += sl[g * 1024 + kq * 256 + kk] * wv;
    }
#pragma unroll
    for (int g = 0; g < 9; ++g) red[(kq * 9 + g) * 64 + (tid & 63)] = acc[g];
    __syncthreads();
    float* mod = (float*)(p.ws + OFF_MOD);
    for (int i = tid; i < 9 * 64; i += 256) {
        const int g = i >> 6, c = i & 63;
        mod[((size_t)l * 9 + g) * 6144 + cch * 64 + c] = p.ada_b[l * 6144 + cch * 64 + c] + ((red[(0 * 9 + g) * 64 + c] + red[(1 * 9 + g) * 64 + c]) + (red[(2 * 9 + g) * 64 + c] + red[(3 * 9 + g) * 64 + c]));
    }
    __syncthreads();
}
DEV void prep_rope_item(const Params& p, int it) {
    const int idx = it * 256 + get_tid(), t = idx >> 5, i = idx & 31;
    const float inv = powf(10000.f, -(float)(2 * (i & 15)) / 32.f);
    const float ang = (float)((i < 16) ? (t >> 6) : (t & 63)) * inv;
    float* rc = (float*)(p.ws + OFF_ROPE);
    rc[idx] = cosf(ang); rc[2048 * 32 + idx] = sinf(ang);
}
DEV void prep_filter_item(const Params& p, int it, char* lds) {
    const int tid = get_tid(), lane = tid & 63, wid = tid >> 6;
    const int row0 = it * 32 + wid * 8;
    const int l = row0 / 2304, r0 = row0 % 2304, type = r0 < 2048 ? 0 : 1, t0 = type ? r0 - 2048 : r0, n = type ? 256 : 2048;
    float* z = (float*)lds + wid * (8 * 192); float* h1 = z + 8 * 64; float* h2 = h1 + 8 * 64;
#pragma unroll
    for (int rr = 0; rr < 8; ++rr) {
        const int t = t0 + rr;
        if (lane < 33) {
            float v;
            if (lane == 0) v = (float)t / (float)(n - 1);
            else {
                const int i = (lane - 1) & 15;
                const float f = 1e-4f + (float)i * ((15.f - 1e-4f) / 15.f);
                const float w = 2.f * 3.14159265358979323846f * (float)t / (float)n;
                v = (lane <= 16) ? cosf(f * w) : -sinf(f * w);
            }
            z[rr * 64 + lane] = v;
        }
    }
    __builtin_amdgcn_wave_barrier();
    {
        float s[8]; const float b = p.hy_f_b1[l * 64 + lane];
#pragma unroll
        for (int rr = 0; rr < 8; ++rr) s[rr] = b;
#pragma unroll 11
        for (int i = 0; i < 33; ++i) {
            const float w = p.hy_f_w1[(l * 33 + i) * 64 + lane];
#pragma unroll
            for (int rr = 0; rr < 8; ++rr) s[rr] += z[rr * 64 + i] * w;
        }
        const float fq0 = p.hy_freq[(l * 2 + 0) * 64 + lane];
#pragma unroll
        for (int rr = 0; rr < 8; ++rr) h1[rr * 64 + lane] = sinf(fq0 * s[rr]);
    }
    __builtin_amdgcn_wave_barrier();
    {
        float s[8]; const float b = p.hy_f_b2[l * 64 + lane];
#pragma unroll
        for (int rr = 0; rr < 8; ++rr) s[rr] = b;
#pragma unroll 16
        for (int i = 0; i < 64; ++i) {
            const float w = p.hy_f_w2[(l * 64 + i) * 64 + lane];
#pragma unroll
            for (int rr = 0; rr < 8; ++rr) s[rr] += h1[rr * 64 + i] * w;
        }
        const float fq1 = p.hy_freq[(l * 2 + 1) * 64 + lane];
#pragma unroll
        for (int rr = 0; rr < 8; ++rr) h2[rr * 64 + lane] = sinf(fq1 * s[rr]);
    }
    __builtin_amdgcn_wave_barrier();
    bf16_t* kf = (bf16_t*)(p.ws + (type ? OFF_KERNC + (size_t)l * 2 * 256 * 256 * 2 : OFF_KERNL + (size_t)l * 2 * 256 * 2048 * 2));
    const float lo = logf(1e-2f) / 1.5f, hi = logf(1e-2f) / 0.3f;
    const float* w3 = p.hy_f_w3 + (size_t)l * 64 * 512 + lane;
#pragma unroll 1
    for (int qh = 0; qh < 2; ++qh) {
        float acc[8][4];
#pragma unroll
        for (int rr = 0; rr < 8; ++rr)
#pragma unroll
            for (int q = 0; q < 4; ++q) acc[rr][q] = 0.f;
#pragma unroll 8
        for (int i = 0; i < 64; ++i) {
            float w[4];
#pragma unroll
            for (int q = 0; q < 4; ++q) w[q] = w3[i * 512 + qh * 256 + q * 64];
#pragma unroll
            for (int rr = 0; rr < 8; ++rr) {
                const float hv = h2[rr * 64 + i];
#pragma unroll
                for (int q = 0; q < 4; ++q) acc[rr][q] += hv * w[q];
            }
        }
#pragma unroll
        for (int q = 0; q < 4; ++q) {
            const int c = q * 64 + lane;
            const float delta = fabsf(lo + (float)c * ((hi - lo) / 255.f));
            float v[8];
#pragma unroll
            for (int rr = 0; rr < 8; ++rr) { const float tt = (float)(t0 + rr) / (float)(n - 1); v[rr] = acc[rr][q] * expf(-tt * delta); }
            if (qh == 0 && t0 == 0) v[0] += p.hy_skip[l * 256 + c];
            *(u32x4*)(kf + ((size_t)qh * 256 + c) * n + t0) = (u32x4){pk2(v[0], v[1]), pk2(v[2], v[3]), pk2(v[4], v[5]), pk2(v[6], v[7])};
        }
    }
    __builtin_amdgcn_wave_barrier();
}
struct ConvDesc { const float* src; bf16_t* dst; int ldsrc, k0, n0, lddst, mapkind; };
DEV void conv_load(const ConvDesc& d, f32x4 (&v)[4], int tid) {
    const int r = tid >> 4, c4 = (tid & 15) * 4;
#pragma unroll
    for (int i = 0; i < 4; ++i) v[i] = *(const f32x4*)(d.src + (size_t)(d.k0 + r + 16 * i) * d.ldsrc + d.n0 + c4);
}
DEV void conv_store(const ConvDesc& d, const f32x4 (&v)[4], char* lds, int tid) {
    float* tl = (float*)lds;
    {
        const int r = tid >> 4, c4 = (tid & 15) * 4;
#pragma unroll
        for (int i = 0; i < 4; ++i) { const int row = r + 16 * i; tl[row * 65 + c4 + 0] = v[i][0]; tl[row * 65 + c4 + 1] = v[i][1]; tl[row * 65 + c4 + 2] = v[i][2]; tl[row * 65 + c4 + 3] = v[i][3]; }
    }
    __syncthreads();
    {
        const int n = tid >> 2, kc = tid & 3, ng = d.n0 + n;
        int drow = ng;
        if (d.mapkind == 1) drow = 32 * (ng >> 4) + (ng & 15);
        else if (d.mapkind == 2) drow = 32 * (ng >> 4) + 16 + (ng & 15);
        else if (d.mapkind == 3) drow = (ng >> 7) * 256 + 32 * ((ng & 127) >> 4) + (ng & 15);
        else if (d.mapkind == 4) drow = (ng >> 7) * 256 + 32 * ((ng & 127) >> 4) + 16 + (ng & 15);
        else if (d.mapkind == 5) drow = (ng & ~31) + 16 * ((ng >> 2) & 1) + 4 * ((ng >> 3) & 3) + (ng & 3);
        unsigned w[8];
#pragma unroll
        for (int j = 0; j < 8; ++j) w[j] = pk2(tl[(kc * 16 + 2 * j) * 65 + n], tl[(kc * 16 + 2 * j + 1) * 65 + n]);
        u32x4* o = (u32x4*)(d.dst + (size_t)drow * d.lddst + d.k0 + kc * 16);
        o[0] = (u32x4){w[0], w[1], w[2], w[3]};
        o[1] = (u32x4){w[4], w[5], w[6], w[7]};
    }
    __syncthreads();
}
DEV ConvDesc conv_fixed_desc(const Params& p, int it) {
    const int l = it / 1040; int r = it % 1040;
    unsigned char* ws = p.ws;
    if (r < 576) return ConvDesc{p.w_in + (size_t)l * 1024 * PROJ, (bf16_t*)(ws + OFF_WIN) + (size_t)l * PROJ * 1024, PROJ, (r / 36) * 64, (r % 36) * 64, 1024, (r % 36) * 64 < 1536 ? 5 : 0};
    r -= 576;
    if (r < 256) return ConvDesc{p.w_out + (size_t)l * 1024 * 1024, (bf16_t*)(ws + OFF_WOUT) + (size_t)l * 1024 * 1024, 1024, (r / 16) * 64, (r % 16) * 64, 1024, 5};
    r -= 256;
    if (r < 64) return ConvDesc{p.sh_w1 + (size_t)l * 1024 * 256, (bf16_t*)(ws + OFF_SW13) + (size_t)l * 512 * 1024, 256, (r / 4) * 64, (r % 4) * 64, 1024, 3};
    r -= 64;
    if (r < 64) return ConvDesc{p.sh_w3 + (size_t)l * 1024 * 256, (bf16_t*)(ws + OFF_SW13) + (size_t)l * 512 * 1024, 256, (r / 4) * 64, (r % 4) * 64, 1024, 4};
    r -= 64;
    if (r < 64) { const int kt = r / 16, hh = kt >> 1;
        return ConvDesc{p.sh_w2 + (size_t)l * 256 * 1024, (bf16_t*)(ws + OFF_SW2) + (size_t)(l * 2 + hh) * 1024 * 128 - hh * 128, 1024, kt * 64, (r % 16) * 64, 128, 5}; }
    r -= 64;
    return ConvDesc{p.router_w + (size_t)l * 1024 * 64, (bf16_t*)(ws + OFF_RW) + (size_t)l * 64 * 1024, 64, r * 64, 0, 1024, 0};
}
DEV ConvDesc conv_expert_desc(const Params& p, int l, int it) {
    const int e = it / 96; int r = it % 96;
    unsigned char* ws = p.ws;
    const size_t eo = (size_t)(l * 64 + e) * 1024 * 128;
    if (r < 32) return ConvDesc{p.exp_w1 + eo, (bf16_t*)(ws + OFF_W13) + (size_t)e * 256 * 1024, 128, (r / 2) * 64, (r % 2) * 64, 1024, 1};
    r -= 32;
    if (r < 32) return ConvDesc{p.exp_w3 + eo, (bf16_t*)(ws + OFF_W13) + (size_t)e * 256 * 1024, 128, (r / 2) * 64, (r % 2) * 64, 1024, 2};
    r -= 32;
    return ConvDesc{p.exp_w2 + eo, (bf16_t*)(ws + OFF_W2) + (size_t)e * 1024 * 128, 1024, (r / 16) * 64, (r % 16) * 64, 128, 5};
}
DEV void conv_run(const Params& p, int l, int first, int count, char* lds) {
    const int tid = get_tid();
    if (count <= 0) return;
    ConvDesc d = l < 0 ? conv_fixed_desc(p, first) : conv_expert_desc(p, l, first);
    f32x4 v[4]; conv_load(d, v, tid);
#pragma unroll 1
    for (int i = 0; i < count; ++i) {
        ConvDesc dn = d; f32x4 vn[4];
        if (i + 1 < count) { dn = l < 0 ? conv_fixed_desc(p, first + i + 1) : conv_expert_desc(p, l, first + i + 1); conv_load(dn, vn, tid); }
        else {
#pragma unroll
            for (int k = 0; k < 4; ++k) vn[k] = v[k];
        }
        conv_store(d, v, lds, tid);
        d = dn;
#pragma unroll
        for (int k = 0; k < 4; ++k) v[k] = vn[k];
    }
}
DEV void phase_prep(const Params& p, char* lds) {
    { const int t_ = get_tid(); if (blockIdx.x == 0 && t_ < 128) ((int*)(p.ws + OFF_CNT))[t_ * 64] = 0; }
    constexpr int N0 = 144, N1 = N0 + 192, N2 = N1 + 260, N3 = N2 + 768, N4 = N3 + 256;
    int* qhead = (int*)(p.ws + OFF_QUEUE) + 2 * 64;
    int* qslot = (int*)(lds + SMEM_BYTES - 256);
    for (;;) {
        __syncthreads();
        if (get_tid() == 0) *qslot = atomicAdd(qhead, 1);
        __syncthreads();
        const int it = *qslot;
        if (it >= N4) break;
        if (it < N0) prep_filter_item(p, it, lds);
        else if (it < N1) prep_mod_item(p, it - N0, lds);
        else if (it < N2) conv_run(p, -1, (it - N1) * 8, 8, lds);
        else if (it < N3) conv_run(p, 0, (it - N2) * 8, 8, lds);
        else prep_rope_item(p, it - N3);
    }
}
DEV void phase_modfin(const Params& p) {
    const float* part = (const float*)(p.ws + OFF_PART);
    float* mod = (float*)(p.ws + OFF_MOD);
    for (int idx = blockIdx.x * 256 + get_tid(); idx < 2 * 9 * 6144; idx += gridDim.x * 256) {
        const int l = idx / (9 * 6144), g = (idx / 6144) % 9, col = idx % 6144;
        float s = p.ada_b[l * 6144 + col];
        for (int k = 0; k < 32; ++k) s += part[((size_t)(k * 2 + l) * 9 + g) * 6144 + col];
        mod[idx] = s;
    }
}

DEV void row_load(const float* src, f32x4 (&v)[4], int lane) {
#pragma unroll
    for (int j = 0; j < 4; ++j) v[j] = *(const f32x4*)(src + 4 * lane + 256 * j);
}
DEV f32x4 ld_bf4(const bf16_t* p) { const u32x2 w = *(const u32x2*)p; return (f32x4){__uint_as_float(w[0] << 16), __uint_as_float(w[0] & 0xffff0000u), __uint_as_float(w[1] << 16), __uint_as_float(w[1] & 0xffff0000u)}; }
DEV void st_bf4(bf16_t* p, const f32x4& v) { *(u32x2*)p = (u32x2){pk2(v[0], v[1]), pk2(v[2], v[3])}; }
DEV void row_load_bf(const bf16_t* src, f32x4 (&v)[4], int lane) {
#pragma unroll
    for (int j = 0; j < 4; ++j) v[j] = ld_bf4(src + 4 * lane + 256 * j);
}
DEV void row_norm(f32x4 (&v)[4]) {
    float s = 0.f;
#pragma unroll
    for (int j = 0; j < 4; ++j) s += (v[j][0] + v[j][1]) + (v[j][2] + v[j][3]);
    const float mean = wave_sum(s) * (1.f / 1024.f);
    float q = 0.f;
#pragma unroll
    for (int j = 0; j < 4; ++j) { v[j] = v[j] - mean; q += (v[j][0] * v[j][0] + v[j][1] * v[j][1]) + (v[j][2] * v[j][2] + v[j][3] * v[j][3]); }
    const float rstd = 1.0f / sqrtf(wave_sum(q) * (1.f / 1024.f) + 1e-6f);
#pragma unroll
    for (int j = 0; j < 4; ++j) v[j] = v[j] * rstd;
}
DEV void row_store_mod_bf16(bf16_t* dst, const f32x4 (&v)[4], const float* shift, const float* scale, int lane) {
#pragma unroll
    for (int j = 0; j < 4; ++j) {
        const int c = 4 * lane + 256 * j;
        const f32x4 sh = *(const f32x4*)(shift + c), sc = *(const f32x4*)(scale + c);
        const f32x4 o = v[j] * (sc + 1.0f) + sh;
        *(u32x2*)(dst + c) = (u32x2){pk2(o[0], o[1]), pk2(o[2], o[3])};
    }
}
DEV void phase_lnmod0(const Params& p) {
    const int tid_ = get_tid(), lane = tid_ & 63, wid = tid_ >> 6;
    const float* mod = (const float*)(p.ws + OFF_MOD);
    bf16_t* H = (bf16_t*)(p.ws + OFF_H);
    for (int row = blockIdx.x * 4 + wid; row < NT; row += gridDim.x * 4) {
        const float* src = row < NLAT ? p.x + (size_t)row * 1024 : p.ctx + (size_t)(row - NLAT) * 1024;
        f32x4 v[4]; row_load(src, v, lane); row_norm(v);
        const float* m = mod + (size_t)mod_group(row) * 6144;
        row_store_mod_bf16(H + (size_t)row * 1024, v, m, m + 1024, lane);
    }
}

DEV void phase_inproj(const Params& p, int l, char* lds) {
    const int tid = get_tid(), lane = tid & 63, wid = tid >> 6, fr = lane & 15, fq = lane >> 4, wr = wid >> 1, wc = wid & 1;
    unsigned char* ws = p.ws;
    const bf16_t* H = (const bf16_t*)(ws + OFF_H);
    const bf16_t* W = (const bf16_t*)(ws + OFF_WIN) + (size_t)l * PROJ * 1024;
    const float* ropec = (const float*)(ws + OFF_ROPE); const float* ropes = ropec + 2048 * 32;
    const int nitems = 128 * 18 + 16 * (l == 0 ? 18 : 6);
    for (int it = blockIdx.x; it < nitems; it += gridDim.x) {
        int mt, nt;
        if (it < 2304) { mt = it / 18; nt = it % 18; }
        else { const int j = it - 2304; if (l == 0) { mt = 128 + j / 18; nt = j % 18; } else { mt = 128 + j / 6; const int q = j % 6; nt = q < 2 ? 4 + q : 6 + q; } }
        const int m0 = mt * 128, n0 = nt * 128;
        const unsigned a0 = (unsigned)m0 * 1024u + st64_off(tid), b0 = (unsigned)n0 * 1024u + st64_off(tid);
        const unsigned ao[4] = {a0, a0 + 32u * 1024u, a0 + 64u * 1024u, a0 + 96u * 1024u};
        const unsigned bo[4] = {b0, b0 + 32u * 1024u, b0 + 64u * 1024u, b0 + 96u * 1024u};
        f32x4 acc[4][4]; zero_acc<4, 4>(acc);
        const bool latent = m0 < NLAT;
        const int b = latent ? (m0 >> 11) : ((m0 - NLAT) >> 8);
        const int tbase = latent ? (m0 & 2047) : ((m0 - NLAT) & 255);
        if (nt >= 12) {
            const int rho = tid >> 3, ptok = 8 * ((rho & 15) >> 2) + 4 * (rho >> 4) + (rho & 3);
            const unsigned ap0 = (unsigned)(m0 + ptok) * 1024u + (unsigned)(((tid & 7) ^ (rho & 7)) * 8);
            const unsigned aop[4] = {ap0, ap0 + 32u * 1024u, ap0 + 64u * 1024u, ap0 + 96u * 1024u};
            gemm_core64<false>(acc, H, aop, W, bo, 1024, lds);
            bf16_t* zt = latent ? (bf16_t*)(ws + OFF_ZTL) + (size_t)b * 768 * 2048 : (bf16_t*)(ws + OFF_ZTC) + (size_t)b * 768 * 256;
            const int n = latent ? 2048 : 256;
#pragma unroll
            for (int g = 0; g < 2; ++g)
#pragma unroll
                for (int nn = 0; nn < 4; ++nn) {
                    const int ch = n0 - 1536 + wc * 64 + nn * 16 + fr, t = tbase + wr * 64 + 32 * g + 8 * fq;
                    *(u32x4*)(zt + (size_t)ch * n + t) = (u32x4){pk2(acc[2 * g][nn][0], acc[2 * g][nn][1]), pk2(acc[2 * g][nn][2], acc[2 * g][nn][3]),
                                                                 pk2(acc[2 * g + 1][nn][0], acc[2 * g + 1][nn][1]), pk2(acc[2 * g + 1][nn][2], acc[2 * g + 1][nn][3])};
                }
        } else {
            gemm_core64<true>(acc, H, ao, W, bo, 1024, lds);
            const int col0 = n0 + wc * 64;
            int kind, hh;
            if (col0 < 512) { kind = 0; hh = col0 >> 6; } else if (col0 < 640) { kind = 1; hh = (col0 - 512) >> 6; } else if (col0 < 768) { kind = 2; hh = (col0 - 640) >> 6; }
            else if (col0 < 1024) { kind = 3; hh = (col0 - 768) >> 6; } else if (col0 < 1280) { kind = 4; hh = (col0 - 1024) >> 6; } else { kind = 5; hh = (col0 - 1280) >> 6; }
            const bool normed = (kind == 0 || kind == 1);
            const float* gain = (kind == 0 ? p.q_gain : p.k_gain) + l * 64;
#pragma unroll
            for (int m = 0; m < 4; ++m) {
                const int rloc = wr * 64 + m * 16 + fr, row = m0 + rloc, t = tbase + rloc;
                f32x4 v[4];
#pragma unroll
                for (int nn = 0; nn < 4; ++nn) v[nn] = acc[m][nn];
                if (normed) {
                    float ss = 0.f;
#pragma unroll
                    for (int nn = 0; nn < 4; ++nn) ss += (v[nn][0] * v[nn][0] + v[nn][1] * v[nn][1]) + (v[nn][2] * v[nn][2] + v[nn][3] * v[nn][3]);
                    ss += __shfl_xor(ss, 16); ss += __shfl_xor(ss, 32);
                    const float r = 1.0f / sqrtf(ss * (1.f / 64.f) + 1e-6f);
#pragma unroll
                    for (int nn = 0; nn < 4; ++nn) {
                        const int hc = 32 * (nn >> 1) + 8 * fq + 4 * (nn & 1);
                        const f32x4 g = *(const f32x4*)(gain + hc);
                        v[nn] = v[nn] * r * g;
                        if (latent) {
                            const int pi = hc >> 1;
                            const float c0 = ropec[t * 32 + pi], s0 = ropes[t * 32 + pi], c1 = ropec[t * 32 + pi + 1], s1 = ropes[t * 32 + pi + 1];
                            const float x0 = v[nn][0], x1 = v[nn][1], x2 = v[nn][2], x3 = v[nn][3];
                            v[nn][0] = x0 * c0 - x1 * s0; v[nn][1] = x0 * s0 + x1 * c0;
                            v[nn][2] = x2 * c1 - x3 * s1; v[nn][3] = x2 * s1 + x3 * c1;
                        }
                    }
                }
                if (kind == 0 || kind == 3) {
#pragma unroll
                    for (int nn = 0; nn < 4; ++nn) v[nn] = v[nn] * (0.125f * LOG2E);
                }
                bf16_t* dst;
                const int key = latent ? 256 + t : t;
                if (kind == 0) dst = (bf16_t*)(ws + OFF_QA) + ((size_t)hh * NT + row) * 64;
                else if (kind == 3) dst = (bf16_t*)(ws + OFF_QB) + ((size_t)hh * NT + row) * 64;
                else if (kind == 1) dst = (bf16_t*)(ws + OFF_KA) + ((size_t)(b * 2 + hh) * KEYS + key) * 64;
                else if (kind == 2) dst = (bf16_t*)(ws + OFF_VA) + ((size_t)(b * 2 + hh) * KEYS + key) * 64;
                else if (kind == 4) dst = (bf16_t*)(ws + OFF_KB) + ((size_t)(b * 4 + hh) * KEYS + key) * 64;
                else dst = (bf16_t*)(ws + OFF_VB) + ((size_t)(b * 4 + hh) * KEYS + key) * 64;
#pragma unroll
                for (int gg = 0; gg < 2; ++gg) *(u32x4*)(dst + 32 * gg + 8 * fq) = (u32x4){pk2(v[2 * gg][0], v[2 * gg][1]), pk2(v[2 * gg][2], v[2 * gg][3]), pk2(v[2 * gg + 1][0], v[2 * gg + 1][1]), pk2(v[2 * gg + 1][2], v[2 * gg + 1][3])};
                __builtin_amdgcn_sched_barrier(0);
            }
        }
    }
}

template <int NQT, bool NA>
DEV void attn_block(const bf16_t* Qh, int qrow0, const bf16_t* Kh, const bf16_t* Vh, int ntiles, bf16_t* outp  ,
                    int na_r, int na_rs, int nwin, const float* rpb_h, char* lds) {
    const int tid = get_tid(), lane = tid & 63, wid = tid >> 6, fr = lane & 15, fq = lane >> 4;
    char* KBUF = lds;
    char* VBUF = lds + 16384;
    float* BIAS = (float*)(lds + 32768);
    if (NA) {
        for (int i = tid; i < 15 * 32; i += 256) { const int dr = i >> 5, dc = i & 31; BIAS[i] = dc < 31 ? rpb_h[dr * 31 + dc] * LOG2E : 0.f; }
    }
    bf16x8 qf[NQT][2];
    const int qw = qrow0 + wid * 16 * NQT;
#pragma unroll
    for (int nq = 0; nq < NQT; ++nq)
#pragma unroll
        for (int ks = 0; ks < 2; ++ks) qf[nq][ks] = *(const bf16x8*)(Qh + (size_t)(qw + nq * 16 + fr) * 64 + ks * 32 + fq * 8);
    f32x4 oacc[4][NQT], lacc[NQT];
    float mrun[NQT];
    const bf16x8 ones = (bf16x8){0x3F80, 0x3F80, 0x3F80, 0x3F80, 0x3F80, 0x3F80, 0x3F80, 0x3F80};
#pragma unroll
    for (int nq = 0; nq < NQT; ++nq) { mrun[nq] = 0.f; lacc[nq] = (f32x4){0.f, 0.f, 0.f, 0.f};
#pragma unroll
        for (int dt = 0; dt < 4; ++dt) oacc[dt][nq] = (f32x4){0.f, 0.f, 0.f, 0.f}; }
    const int lrow0 = tid >> 3, lch = tid & 7;
    auto key0_of = [&](int ti) -> int { if (NA) return ti < nwin ? 256 + (na_rs + ti) * 64 : (ti - nwin) * 64; return ti * 64; };
    u32x4 kreg[2], vreg[2];
    auto gload = [&](int ti) {
        const int k0 = key0_of(ti);
#pragma unroll
        for (int i = 0; i < 2; ++i) {
            const int row = lrow0 + 32 * i;
            kreg[i] = *(const u32x4*)(Kh + (size_t)(k0 + row) * 64 + lch * 8);
            vreg[i] = *(const u32x4*)(Vh + (size_t)(k0 + row) * 64 + lch * 8);
        }
    };
    auto lstore = [&](int buf) {
#pragma unroll
        for (int i = 0; i < 2; ++i) {
            const int row = lrow0 + 32 * i;
            const int off = buf * 8192 + row * 128 + ((lch ^ (row & 7)) * 16);
            *(u32x4*)(KBUF + off) = kreg[i];
            *(u32x4*)(VBUF + off) = vreg[i];
        }
    };
    gload(0); lstore(0);
    __syncthreads();
    for (int ti = 0; ti < ntiles; ++ti) {
        const int buf = ti & 1;
        if (ti + 1 < ntiles) gload(ti + 1);
        const char* kb = KBUF + buf * 8192; const char* vb = VBUF + buf * 8192;
        f32x4 sacc[4][NQT];
        __builtin_amdgcn_s_setprio(1);
#pragma unroll
        for (int mt = 0; mt < 4; ++mt) {
            const int row = mt * 16 + fr;
            bf16x8 kf0 = *(const bf16x8*)(kb + row * 128 + (((0 + fq) ^ (row & 7)) * 16));
            bf16x8 kf1 = *(const bf16x8*)(kb + row * 128 + (((4 + fq) ^ (row & 7)) * 16));
#pragma unroll
            for (int nq = 0; nq < NQT; ++nq) {
                f32x4 s = (f32x4){-mrun[nq], -mrun[nq], -mrun[nq], -mrun[nq]};
                s = mfma16(kf0, qf[nq][0], s);
                s = mfma16(kf1, qf[nq][1], s);
                sacc[mt][nq] = s;
            }
        }
        __builtin_amdgcn_s_setprio(0);
        bf16x8 pf[2][NQT];
#pragma unroll
        for (int nq = 0; nq < NQT; ++nq) {
            float tv[4][4];
            float tmax = -1e30f;
            if (NA && ti < nwin) {
                const int qc = (wid & 1) * 32 + nq * 16 + fr;
                int cs = qc - 8; cs = cs < 0 ? 0 : (cs > 48 ? 48 : cs);
                const int qrow = na_r + (wid >> 1);
                int rsq = qrow - 4; rsq = rsq < 0 ? 0 : (rsq > 24 ? 24 : rsq);
                const int krow = na_rs + ti;
                const bool rowok = (krow >= rsq) && (krow < rsq + 8);
                int dr = krow - qrow + 7; dr = dr < 0 ? 0 : (dr > 14 ? 14 : dr);
#pragma unroll
                for (int mt = 0; mt < 4; ++mt)
#pragma unroll
                    for (int j = 0; j < 4; ++j) {
                        const int kc = mt * 16 + 4 * fq + j;
                        const bool ok = rowok && (kc >= cs) && (kc < cs + 16);
                        int dc = kc - qc + 15; dc = dc < 0 ? 0 : (dc > 30 ? 30 : dc);
                        tv[mt][j] = ok ? sacc[mt][nq][j] + BIAS[dr * 32 + dc] : -1e30f;
                        tmax = fmaxf(tmax, tv[mt][j]);
                    }
            } else {
#pragma unroll
                for (int mt = 0; mt < 4; ++mt) {
#pragma unroll
                    for (int j = 0; j < 4; ++j) tv[mt][j] = sacc[mt][nq][j];
                    tmax = fmaxf(fmaxf(tmax, tv[mt][0]), tv[mt][1]); tmax = fmaxf(fmaxf(tmax, tv[mt][2]), tv[mt][3]);
                }
            }
            if (__any(tmax > 8.0f)) {
                tmax = fmaxf(tmax, __shfl_xor(tmax, 16)); tmax = fmaxf(tmax, __shfl_xor(tmax, 32));
                const float dlt = fmaxf(tmax, 0.f);
                const float alpha = __builtin_amdgcn_exp2f(-dlt);
                mrun[nq] += dlt;
                lacc[nq] = lacc[nq] * alpha;
#pragma unroll
                for (int dt = 0; dt < 4; ++dt) oacc[dt][nq] = oacc[dt][nq] * alpha;
#pragma unroll
                for (int mt = 0; mt < 4; ++mt)
#pragma unroll
                    for (int j = 0; j < 4; ++j) tv[mt][j] -= dlt;
            }
#pragma unroll
            for (int mt = 0; mt < 4; ++mt)
#pragma unroll
                for (int j = 0; j < 4; ++j) tv[mt][j] = __builtin_amdgcn_exp2f(tv[mt][j]);
#pragma unroll
            for (int ks = 0; ks < 2; ++ks) {
                union { bf16x8 v; unsigned u[4]; } pk;
                pk.u[0] = pk2(tv[2 * ks][0], tv[2 * ks][1]); pk.u[1] = pk2(tv[2 * ks][2], tv[2 * ks][3]);
                pk.u[2] = pk2(tv[2 * ks + 1][0], tv[2 * ks + 1][1]); pk.u[3] = pk2(tv[2 * ks + 1][2], tv[2 * ks + 1][3]);
                pf[ks][nq] = pk.v;
                lacc[nq] = mfma16(ones, pk.v, lacc[nq]);
            }
        }
        {
            const int q4 = fr >> 2, p4 = fr & 3;
#pragma unroll
            for (int ks = 0; ks < 2; ++ks)
#pragma unroll
                for (int dt = 0; dt < 4; ++dt) {
                    const int keyA = 16 * (2 * ks) + 4 * fq + q4, keyB = keyA + 16;
                    const int ch = 4 * (dt >> 1) + p4;
                    const int offA = keyA * 128 + ((ch ^ (keyA & 7)) * 16) + (dt & 1) * 8;
                    const int offB = keyB * 128 + ((ch ^ (keyB & 7)) * 16) + (dt & 1) * 8;
                    const s16x4 ta = __builtin_amdgcn_ds_read_tr16_b64_v4i16((LDSP(s16x4))(vb + offA));
                    const s16x4 tb = __builtin_amdgcn_ds_read_tr16_b64_v4i16((LDSP(s16x4))(vb + offB));
                    bf16x8 vf; vf[0] = ta[0]; vf[1] = ta[1]; vf[2] = ta[2]; vf[3] = ta[3]; vf[4] = tb[0]; vf[5] = tb[1]; vf[6] = tb[2]; vf[7] = tb[3];
#pragma unroll
                    for (int nq = 0; nq < NQT; ++nq) oacc[dt][nq] = mfma16(vf, pf[ks][nq], oacc[dt][nq]);
                }
        }
        if (ti + 1 < ntiles) lstore(buf ^ 1);
        __syncthreads();
    }
#pragma unroll
    for (int nq = 0; nq < NQT; ++nq) {
        const float inv = 1.0f / lacc[nq][0];
        bf16_t* o = outp + (size_t)(qw + nq * 16 + fr) * 1024;
#pragma unroll
        for (int g = 0; g < 2; ++g) {
            const f32x4 v0 = oacc[2 * g][nq] * inv, v1 = oacc[2 * g + 1][nq] * inv;
            *(u32x4*)(o + g * 32 + 8 * fq) = (u32x4){pk2(v0[0], v0[1]), pk2(v0[2], v0[3]), pk2(v1[0], v1[1]), pk2(v1[2], v1[3])};
        }
    }
    __syncthreads();
}

DEV float hy_sconv(const bf16_t* zrow, int t, int n, float w0, float w1, float w2, float bias) {
    const float zm = t > 0 ? bf2f(zrow[t - 1]) : 0.f, z0 = bf2f(zrow[t]), zp = t + 1 < n ? bf2f(zrow[t + 1]) : 0.f;
    return w0 * zm + w1 * z0 + w2 * zp + bias;
}
template <int NJ>
DEV void hyena_item(const Params& p, int l, int type, int c, int bh, char* lds) {
    constexpr int n = 256 * NJ;
    const int tid = get_tid();
    f32x4* U = (f32x4*)lds;
    float* KR = (float*)(lds + n * 16);
    const bf16_t* zt = type ? (const bf16_t*)(p.ws + OFF_ZTC) : (const bf16_t*)(p.ws + OFF_ZTL);
    const bf16_t* kf = (const bf16_t*)(p.ws + (type ? OFF_KERNC + (size_t)l * 2 * 256 * 256 * 2 : OFF_KERNL + (size_t)l * 2 * 256 * 2048 * 2)) + (size_t)c * n;
    const bf16_t* kb = kf + (size_t)256 * n;
    const float* cw = p.hy_conv_w + l * 3 * 768; const float* cb = p.hy_conv_b + l * 768;
    const float w10 = cw[256 + c], w11 = cw[768 + 256 + c], w12 = cw[1536 + 256 + c], b1 = cb[256 + c];
    const float wv0 = cw[512 + c], wv1 = cw[768 + 512 + c], wv2 = cw[1536 + 512 + c], bv = cb[512 + c];
    const float w00 = cw[c], w01 = cw[768 + c], w02 = cw[1536 + c], b0 = cb[c];
    for (int i = tid; i < 2 * n - 1; i += 256) { const int d = i - (n - 1); KR[i] = bf2f(d >= 0 ? kf[d] : kb[-d]); }
    for (int s = tid; s < n; s += 256) {
        f32x4 u;
#pragma unroll
        for (int bb = 0; bb < 4; ++bb) {
            const bf16_t* zb = zt + (size_t)(bh * 4 + bb) * 768 * n;
            const float x1 = hy_sconv(zb + (size_t)(256 + c) * n, s, n, w10, w11, w12, b1);
            const float vv = hy_sconv(zb + (size_t)(512 + c) * n, s, n, wv0, wv1, wv2, bv);
            u[bb] = vv * x1;
        }
        U[s] = u;
    }
    __syncthreads();
    f32x4 acc[NJ];
#pragma unroll
    for (int j = 0; j < NJ; ++j) acc[j] = (f32x4){0.f, 0.f, 0.f, 0.f};
    const float* kp = KR + tid + (n - 1);
    for (int s = 0; s < n; ++s) {
        const f32x4 u = U[s];
#pragma unroll
        for (int j = 0; j < NJ; ++j) acc[j] += u * kp[256 * j - s];
    }
    bf16_t* ox = (bf16_t*)(p.ws + OFF_OX);
#pragma unroll
    for (int j = 0; j < NJ; ++j) {
        const int t = tid + 256 * j;
#pragma unroll
        for (int bb = 0; bb < 4; ++bb) {
            const int b = bh * 4 + bb;
            const bf16_t* zb = zt + (size_t)b * 768 * n;
            const float x0 = hy_sconv(zb + (size_t)c * n, t, n, w00, w01, w02, b0);
            const float y = acc[j][bb] * x0;
            const int row = type ? NLAT + b * 256 + t : b * 2048 + t;
            ox[(size_t)row * 1024 + 768 + c] = (bf16_t)f2bf(y);
        }
    }
    __syncthreads();
}


typedef float f32x16 __attribute__((ext_vector_type(16)));
constexpr int HY_UROW = 2256;
constexpr int HY_KC_OFF = 8 * HY_UROW * 2;
constexpr int HY_KC_STRIDE = 8192 + 64;
DEV float hy_sc8(const bf16_t* zrow, int s0, int n, float w0, float w1, float w2, float bias, float (&o)[8]) {
    const u32x4 v = *(const u32x4*)(zrow + s0);
    const float zm = s0 > 0 ? bf2f(zrow[s0 - 1]) : 0.f, zp = s0 + 8 < n ? bf2f(zrow[s0 + 8]) : 0.f;
    float z[10]; z[0] = zm; z[9] = zp;
#pragma unroll
    for (int i = 0; i < 4; ++i) { z[1 + 2 * i] = __uint_as_float(v[i] << 16); z[2 + 2 * i] = __uint_as_float(v[i] & 0xffff0000u); }
#pragma unroll
    for (int i = 0; i < 8; ++i) o[i] = w0 * z[i] + w1 * z[i + 1] + w2 * z[i + 2] + bias;
    return 0.f;
}
DEV void hyena_mfma_item(const Params& p, int l, int c, char* lds) {
    const int tid = get_tid(), lane = tid & 63, wid = tid >> 6;
    constexpr int n = 2048;
    const bf16_t* zt = (const bf16_t*)(p.ws + OFF_ZTL);
    const bf16_t* kf = (const bf16_t*)(p.ws + OFF_KERNL + (size_t)l * 2 * 256 * 2048 * 2) + (size_t)c * n;
    const bf16_t* kb = kf + (size_t)256 * n;
    const float* cw = p.hy_conv_w + l * 3 * 768; const float* cb = p.hy_conv_b + l * 768;
    const float w10 = cw[256 + c], w11 = cw[768 + 256 + c], w12 = cw[1536 + 256 + c], b1 = cb[256 + c];
    const float wv0 = cw[512 + c], wv1 = cw[768 + 512 + c], wv2 = cw[1536 + 512 + c], bv = cb[512 + c];
    const float w00 = cw[c], w01 = cw[768 + c], w02 = cw[1536 + c], b0 = cb[c];
    for (int i = tid; i < 8 * 26; i += 256) {
        const int b = i / 26, k = i % 26;
        const int sp = k < 12 ? k * 8 : 96 + 2048 + (k - 12) * 8;
        *(u32x4*)(lds + (b * HY_UROW + sp) * 2) = (u32x4){0u, 0u, 0u, 0u};
    }
#pragma unroll 4
    for (int ch = tid; ch < 8 * 256; ch += 256) {
        const int b = ch >> 8, s0 = (ch & 255) * 8;
        const bf16_t* zb = zt + (size_t)b * 768 * n;
        float x1[8], vv[8];
        hy_sc8(zb + (size_t)(256 + c) * n, s0, n, w10, w11, w12, b1, x1);
        hy_sc8(zb + (size_t)(512 + c) * n, s0, n, wv0, wv1, wv2, bv, vv);
        *(u32x4*)(lds + (b * HY_UROW + 96 + s0) * 2) = (u32x4){pk2(vv[0] * x1[0], vv[1] * x1[1]), pk2(vv[2] * x1[2], vv[3] * x1[3]), pk2(vv[4] * x1[4], vv[5] * x1[5]), pk2(vv[6] * x1[6], vv[7] * x1[7])};
    }
    {
        char* R0 = lds + HY_KC_OFF;
#pragma unroll
        for (int j = 0; j < 2; ++j) {
            const int chn = tid + 256 * j;
            const bool fwd = chn < 256; const int d0 = (chn & 255) * 8;
            const u32x4 v = *(const u32x4*)((fwd ? kf : kb) + d0);
#pragma unroll
            for (int e = 0; e < 8; ++e) {
                const int d = d0 + e;
                const bf16_t val = (bf16_t)((e & 1) ? (v[e >> 1] >> 16) : (v[e >> 1] & 0xffffu));
                const int y = fwd ? 2047 - d : 2047 + d;
                if (fwd || d > 0) *(bf16_t*)(R0 + y * 2) = val;
            }
        }
        if (tid == 0) *(bf16_t*)(R0 + 4095 * 2) = 0;
    }
    __syncthreads();
    {
        const char* R0 = lds + HY_KC_OFF;
        for (int i = tid; i < 3 * 1024; i += 256) {
            const int q = 1 + i / 1024, y = (i % 1024) * 4;
            unsigned short e[4];
#pragma unroll
            for (int k = 0; k < 4; ++k) { const int yy = y + q + k; e[k] = yy <= 4094 ? *(const bf16_t*)(R0 + yy * 2) : (bf16_t)0; }
            *(u32x2*)(lds + HY_KC_OFF + q * HY_KC_STRIDE + y * 2) = (u32x2){(unsigned)e[0] | ((unsigned)e[1] << 16), (unsigned)e[2] | ((unsigned)e[3] << 16)};
        }
    }
    __syncthreads();
    const int i32 = lane & 31, h = lane >> 5, qn = i32 >> 3, bn = i32 & 7;
    const int T0 = 512 * wid;
    f32x16 acc[4];
#pragma unroll
    for (int g = 0; g < 4; ++g)
#pragma unroll
        for (int r = 0; r < 16; ++r) acc[g][r] = 0.f;
    const int dlo = T0 - 2032, dhi = T0 + 384 + 96;
    {
        const int a0 = 2047 - dlo - i32 + 8 * h, q4 = a0 & 3;
        const char* ap = lds + HY_KC_OFF + q4 * HY_KC_STRIDE + (a0 - q4) * 2;
        const char* bp = lds + (bn * HY_UROW + 96 + (T0 - dlo) + 32 * qn + 8 * h) * 2;
        for (int dl = dlo; dl <= dhi; dl += 16) {
            union { bf16x8 v; u32x2 u[2]; } af;
            af.u[0] = *(const u32x2*)ap; af.u[1] = *(const u32x2*)(ap + 8);
#pragma unroll
            for (int g = 0; g < 4; ++g) {
                const int S = T0 + 128 * g - dl;
                if (S >= -96 && S <= 2032) {
                    const bf16x8 bfv = *(const bf16x8*)(bp + 256 * g);
                    acc[g] = __builtin_amdgcn_mfma_f32_32x32x16_bf16(af.v, bfv, acc[g], 0, 0, 0);
                }
            }
            ap -= 32; bp -= 32;
        }
    }
    __syncthreads();
#pragma unroll 4
    for (int ch = tid; ch < 8 * 256; ch += 256) {
        const int b = ch >> 8, s0 = (ch & 255) * 8;
        float x0[8];
        hy_sc8(zt + (size_t)b * 768 * n + (size_t)c * n, s0, n, w00, w01, w02, b0, x0);
        *(u32x4*)(lds + HY_KC_OFF + (b * 2048 + s0) * 2) = (u32x4){pk2(x0[0], x0[1]), pk2(x0[2], x0[3]), pk2(x0[4], x0[5]), pk2(x0[6], x0[7])};
    }
    __syncthreads();
    bf16_t* oxt = (bf16_t*)(p.ws + OFF_OXT) + (size_t)c * 2048;
#pragma unroll
    for (int g = 0; g < 4; ++g)
#pragma unroll
        for (int r4 = 0; r4 < 4; ++r4) {
            const int t = T0 + 128 * g + 32 * qn + 8 * r4 + 4 * h;
            const u32x2 xg = *(const u32x2*)(lds + HY_KC_OFF + (bn * 2048 + t) * 2);
            const float g0 = __uint_as_float(xg[0] << 16), g1 = __uint_as_float(xg[0] & 0xffff0000u), g2 = __uint_as_float(xg[1] << 16), g3 = __uint_as_float(xg[1] & 0xffff0000u);
            *(u32x2*)(oxt + (size_t)bn * 256 * 2048 + t) = (u32x2){pk2(acc[g][4 * r4 + 0] * g0, acc[g][4 * r4 + 1] * g1), pk2(acc[g][4 * r4 + 2] * g2, acc[g][4 * r4 + 3] * g3)};
        }
    __syncthreads();
}

DEV void phase_mix(const Params& p, int l, char* lds) {
    unsigned char* ws = p.ws;
    const bf16_t* QA = (const bf16_t*)(ws + OFF_QA); const bf16_t* QB = (const bf16_t*)(ws + OFF_QB);
    const bf16_t* KA = (const bf16_t*)(ws + OFF_KA); const bf16_t* VA = (const bf16_t*)(ws + OFF_VA);
    const bf16_t* KBp = (const bf16_t*)(ws + OFF_KB); const bf16_t* VBp = (const bf16_t*)(ws + OFF_VB);
    bf16_t* OX = (bf16_t*)(ws + OFF_OX);
    const int N0 = 256, N1 = N0 + 1024, N2 = N1 + 512;
    const int N3 = N2 + (l == 0 ? 512 : 0), N4 = N3 + (l == 0 ? 128 : 0), N5 = N4 + (l == 0 ? 64 : 0);
    int* qhead = (int*)(p.ws + OFF_QUEUE) + l * 64;
    int* qslot = (int*)(lds + SMEM_BYTES - 256);
    for (;;) {
        __syncthreads();
        if (get_tid() == 0) *qslot = atomicAdd(qhead, 1);
        __syncthreads();
        const int it = *qslot;
        if (it >= N5) break;
        if (it < N0) { hyena_mfma_item(p, l, it, lds); }
        else if (it < N1) {
            const int j = it - N0, b = j >> 7, h = (j >> 4) & 7, qb = j & 15;
            attn_block<2, false>(QA + (size_t)h * NT * 64, b * 2048 + qb * 128, KA + (size_t)(b * 2 + (h >> 2)) * KEYS * 64, VA + (size_t)(b * 2 + (h >> 2)) * KEYS * 64,
                                 36, OX + h * 64, 0, 0, 0, nullptr, lds);
        } else if (it < N2) {
            const int j = it - N1, b = j >> 6, h = (j >> 4) & 3, r = (j & 15) * 2;
            int rs0 = r - 4; rs0 = rs0 < 0 ? 0 : (rs0 > 24 ? 24 : rs0);
            int rs1 = r - 3; rs1 = rs1 < 0 ? 0 : (rs1 > 24 ? 24 : rs1);
            const int nwin = rs1 + 8 - rs0;
            attn_block<2, true>(QB + (size_t)h * NT * 64, b * 2048 + r * 64, KBp + (size_t)(b * 4 + h) * KEYS * 64, VBp + (size_t)(b * 4 + h) * KEYS * 64,
                                nwin + 4, OX + 512 + h * 64, r, rs0, nwin, p.nat_rpb + (size_t)(l * 4 + h) * 15 * 31, lds);
        } else if (it < N3) { const int j = it - N2; hyena_item<1>(p, l, 1, j >> 1, j & 1, lds); }
        else if (it < N4) {
            const int j = it - N3, b = j >> 4, h = (j >> 1) & 7, qb = j & 1;
            attn_block<2, false>(QA + (size_t)h * NT * 64, NLAT + b * 256 + qb * 128, KA + (size_t)(b * 2 + (h >> 2)) * KEYS * 64, VA + (size_t)(b * 2 + (h >> 2)) * KEYS * 64,
                                 4, OX + h * 64, 0, 0, 0, nullptr, lds);
        } else {
            const int j = it - N4, b = j >> 3, h = (j >> 1) & 3, qb = j & 1;
            attn_block<2, false>(QB + (size_t)h * NT * 64, NLAT + b * 256 + qb * 128, KBp + (size_t)(b * 4 + h) * KEYS * 64, VBp + (size_t)(b * 4 + h) * KEYS * 64,
                                 4, OX + 512 + h * 64, 0, 0, 0, nullptr, lds);
        }
    }
}

DEV void phase_outproj(const Params& p, int l, char* lds) {
    const int tid = get_tid(), lane = tid & 63, wid = tid >> 6, fr = lane & 15, fq = lane >> 4, wr = wid >> 1, wc = wid & 1;
    const bf16_t* OX = (const bf16_t*)(p.ws + OFF_OX);
    const bf16_t* W = (const bf16_t*)(p.ws + OFF_WOUT) + (size_t)l * 1024 * 1024;
    const float* mod = (const float*)(p.ws + OFF_MOD) + (size_t)l * 9 * 6144;
    bf16_t* X = (bf16_t*)(p.ws + OFF_X);
    const int nitems = (l == 0 ? 144 : 128) * 8;
    for (int it = blockIdx.x; it < nitems; it += gridDim.x) {
        const int mt = it >> 3, nt = it & 7, m0 = mt * 128, n0 = nt * 128;
        const unsigned a0 = (unsigned)m0 * 1024u + st64_off(tid), b0 = (unsigned)n0 * 1024u + st64_off(tid);
        f32x4 acc[4][4]; zero_acc<4, 4>(acc);
        const unsigned ao[4] = {a0, a0 + 32u * 1024u, a0 + 64u * 1024u, a0 + 96u * 1024u};
        const unsigned bo[4] = {b0, b0 + 32u * 1024u, b0 + 64u * 1024u, b0 + 96u * 1024u};
        if (m0 < NLAT) gemm_core64<true>(acc, OX, ao, W, bo, 1024, lds, (const bf16_t*)(p.ws + OFF_OXT) + (size_t)(m0 >> 11) * 256 * 2048 + (m0 & 2047), 12);
        else gemm_core64<true>(acc, OX, ao, W, bo, 1024, lds);
        const float* g1 = mod + (size_t)mod_group(m0) * 6144 + 2048;
#pragma unroll
        for (int m = 0; m < 4; ++m) {
            const int row = m0 + wr * 64 + m * 16 + fr;
            const float* xin = row < NLAT ? p.x + (size_t)row * 1024 : p.ctx + (size_t)(row - NLAT) * 1024;
#pragma unroll
            for (int gg = 0; gg < 2; ++gg) {
                const int col = n0 + wc * 64 + gg * 32 + 8 * fq;
                f32x4 x0, x1;
                if (l == 0) { x0 = *(const f32x4*)(xin + col); x1 = *(const f32x4*)(xin + col + 4); }
                else { const u32x4 w = *(const u32x4*)(X + (size_t)row * 1024 + col);
                       x0 = (f32x4){__uint_as_float(w[0] << 16), __uint_as_float(w[0] & 0xffff0000u), __uint_as_float(w[1] << 16), __uint_as_float(w[1] & 0xffff0000u)};
                       x1 = (f32x4){__uint_as_float(w[2] << 16), __uint_as_float(w[2] & 0xffff0000u), __uint_as_float(w[3] << 16), __uint_as_float(w[3] & 0xffff0000u)}; }
                const f32x4 o0 = x0 * DN_ALPHA + *(const f32x4*)(g1 + col) * acc[m][2 * gg], o1 = x1 * DN_ALPHA + *(const f32x4*)(g1 + col + 4) * acc[m][2 * gg + 1];
                *(u32x4*)(X + (size_t)row * 1024 + col) = (u32x4){pk2(o0[0], o0[1]), pk2(o0[2], o0[3]), pk2(o1[0], o1[1]), pk2(o1[2], o1[3])};
            }
        }
    }
}

DEV void phase_ln1route(const Params& p, int l, char* lds) {
    const int tid = get_tid(), lane = tid & 63, wid = tid >> 6, fr = lane & 15, fq = lane >> 4;
    bf16_t* X = (bf16_t*)(p.ws + OFF_X);
    bf16_t* H = (bf16_t*)(p.ws + OFF_H);
    const bf16_t* RW = (const bf16_t*)(p.ws + OFF_RW) + (size_t)l * 64 * 1024;
    const float* mod = (const float*)(p.ws + OFF_MOD) + (size_t)l * 9 * 6144;
    int* cnt = (int*)(p.ws + OFF_CNT) + l * 64 * 64;
    int* tke = (int*)(p.ws + OFF_TKE); int* tks = (int*)(p.ws + OFF_TKS); float* tkw = (float*)(p.ws + OFF_TKW);
    int* list = (int*)(p.ws + OFF_LIST);
    char* HT = lds;
    float* LG = (float*)(lds + 16 * 2064);
    const float rbias = p.router_b[l * 64 + lane];
    const int rpw = (l == 0) ? 3 : 4, rpi = 4 * rpw;
    const int nitems = (l == 0 ? NT : NLAT) / rpi;
    for (int it = blockIdx.x; it < nitems; it += gridDim.x) {
        const int m0 = it * rpi;
        f32x4 vv[4][4];
#pragma unroll
        for (int i = 0; i < 4; ++i) if (i < rpw) row_load_bf(X + (size_t)(m0 + wid * rpw + i) * 1024, vv[i], lane);
        f32x4 lg[4], lb[4];
#pragma unroll
        for (int j = 0; j < 4; ++j) {
            const int c = 4 * lane + 256 * j;
            lg[j] = *(const f32x4*)(p.ln1_g + l * 1024 + c); lb[j] = *(const f32x4*)(p.ln1_b + l * 1024 + c);
        }
#pragma unroll
        for (int i = 0; i < 4; ++i) if (i < rpw) {
            const int rl = wid * rpw + i, row = m0 + rl;
            const float* mg = mod + (size_t)mod_group(row) * 6144;
            f32x4 msh[4], msc[4];
#pragma unroll
            for (int j = 0; j < 4; ++j) { const int c = 4 * lane + 256 * j; msh[j] = *(const f32x4*)(mg + 3072 + c); msc[j] = *(const f32x4*)(mg + 4096 + c) + 1.0f; }
            row_norm(vv[i]);
#pragma unroll
            for (int j = 0; j < 4; ++j) {
                const int c = 4 * lane + 256 * j;
                vv[i][j] = vv[i][j] * lg[j] + lb[j];
                st_bf4(X + (size_t)row * 1024 + c, vv[i][j]);
            }
            row_norm(vv[i]);
#pragma unroll
            for (int j = 0; j < 4; ++j) {
                const int c = 4 * lane + 256 * j;
                const f32x4 o = vv[i][j] * msc[j] + msh[j];
                const u32x2 w = (u32x2){pk2(o[0], o[1]), pk2(o[2], o[3])};
                *(u32x2*)(H + (size_t)row * 1024 + c) = w;
                *(u32x2*)(HT + rl * 2064 + c * 2) = w;
            }
        }
        __syncthreads();
        f32x4 acc = (f32x4){0.f, 0.f, 0.f, 0.f};
        const bf16_t* bp = RW + (size_t)(wid * 16 + fr) * 1024 + fq * 8;
#pragma unroll 8
        for (int ks = 0; ks < 32; ++ks) {
            const bf16x8 bq = *(const bf16x8*)(bp + ks * 32);
            const bf16x8 af = *(const bf16x8*)(HT + fr * 2064 + (ks * 32 + fq * 8) * 2);
            acc = mfma16(bq, af, acc);
        }
        *(f32x4*)(LG + fr * 64 + wid * 16 + 4 * fq) = acc;
        __syncthreads();
        int* RS = (int*)(lds + 16 * 2064 + 4096 + 2048);
        float* RWt = (float*)(lds + 16 * 2064 + 4096 + 2048 + 4096);
        int lc = 0;
        unsigned* KW = (unsigned*)(lds + 16 * 2064 + 4096 + 2048 + 8192) + wid * 160;
#pragma unroll 1
        for (int i = 0; i < rpw; ++i) {
            const int rl = wid * rpw + i;
            const float sc = 1.0f / (1.0f + __expf(-LG[rl * 64 + lane]));
            const float sel = sc + rbias;
            const int grp = lane >> 3;
            const unsigned key = (__float_as_uint(sel + 2.0f) & 0xFFFFFFC0u) | (unsigned)(63 - lane);
            KW[lane] = key;
            __builtin_amdgcn_wave_barrier();
            int rankg = 0;
            {
                const u32x4 k0 = *(const u32x4*)(KW + grp * 8), k1 = *(const u32x4*)(KW + grp * 8 + 4);
#pragma unroll
                for (int j = 0; j < 4; ++j) { rankg += (k0[j] > key) ? 1 : 0; rankg += (k1[j] > key) ? 1 : 0; }
            }
            float gs = rankg < 2 ? sel : 0.f;
            gs += __shfl_xor(gs, 1); gs += __shfl_xor(gs, 2); gs += __shfl_xor(gs, 4);
            const unsigned gkey = (__float_as_uint(gs + 4.0f) & 0xFFFFFFF8u) | (unsigned)(7 - grp);
            if ((lane & 7) == 0) KW[128 + grp] = gkey;
            __builtin_amdgcn_wave_barrier();
            int rg = 0;
            {
                const u32x4 g0 = *(const u32x4*)(KW + 128), g1 = *(const u32x4*)(KW + 132);
#pragma unroll
                for (int j = 0; j < 4; ++j) { rg += (g0[j] > gkey) ? 1 : 0; rg += (g1[j] > gkey) ? 1 : 0; }
            }
            const bool selg = rg < 4;
            const unsigned vkey = selg ? key : 0u;
            KW[64 + lane] = vkey;
            __builtin_amdgcn_wave_barrier();
            int rank = 0;
#pragma unroll
            for (int q = 0; q < 16; ++q) {
                const u32x4 kk = *(const u32x4*)(KW + 64 + q * 4);
#pragma unroll
                for (int j = 0; j < 4; ++j) rank += (kk[j] > vkey) ? 1 : 0;
            }
            const bool ch = selg && rank < 8;
            const float wsum = wave_sum(ch ? sc : 0.f);
            RS[rl * 64 + lane] = ch ? rank : -1;
            RWt[rl * 64 + lane] = sc * (2.5f / wsum);
            lc += ch ? 1 : 0;
            __builtin_amdgcn_wave_barrier();
        }
        int* WC = (int*)(lds + 16 * 2064 + 4096);
        WC[wid * 64 + lane] = lc;
        __syncthreads();
        if (wid == 0) {
            const int tot = WC[lane] + WC[64 + lane] + WC[128 + lane] + WC[192 + lane];
            int base = 0;
            if (tot > 0) base = atomicAdd(&cnt[lane * 64], tot);
            WC[256 + lane] = base;
        }
        __syncthreads();
        {
            int slot = WC[256 + lane];
#pragma unroll
            for (int w2 = 0; w2 < 4; ++w2) slot += (w2 < wid) ? WC[w2 * 64 + lane] : 0;
#pragma unroll 1
            for (int i = 0; i < rpw; ++i) {
                const int rl = wid * rpw + i, rk = RS[rl * 64 + lane];
                if (rk >= 0) {
                    const int row = m0 + rl;
                    list[(size_t)lane * NT + slot] = row * 8 + rk;
                    tke[row * 8 + rk] = lane; tks[row * 8 + rk] = slot; tkw[row * 8 + rk] = RWt[rl * 64 + lane];
                    ++slot;
                }
            }
        }
        __syncthreads();
    }
}

constexpr int YS_EXT_ROWS = NLAT * 1024 * 4 / 1024;
constexpr int PLAN_OFF = 68 * 1024;
DEV void moe_plan(const int* cnt, int cap, int l, char* lds) {
    int* PL = (int*)(lds + PLAN_OFF);
    const int tid = get_tid();
    __syncthreads();
    if (tid < 64) {
        const int lane = tid;
        const int c = cnt[lane * 64], tiles = (c + 127) >> 7;
        int pr = c, pt = tiles;
#pragma unroll
        for (int o = 1; o < 64; o <<= 1) { const int a = __shfl_up(pr, o), b = __shfl_up(pt, o); if (lane >= o) { pr += a; pt += b; } }
        const int G = (int)gridDim.x, nshu = 2 * ((l == 0 ? NT : NLAT) / 128);
        const int units = nshu + __builtin_amdgcn_readlane(pt, 63);
        const int cap8 = cap * 2;
        const bool one_round = __builtin_amdgcn_readlane(pr, 63) + nshu * 128 <= cap8;
        const int target0 = one_round ? 0 : ((units + G - 1) / G - 1) * G;
        PL[144 + lane] = c;
        int start = 0, base_r = 0, base_t = 0, round = 0;
        for (;;) {
            const int lim = (round == 0) ? ((target0 > 0) ? cap8 + YS_EXT_ROWS : cap8) - nshu * 128 : cap8;
            const bool bad = (lane >= start) && ((pr - base_r > lim) || (round == 0 && target0 > 0 && lane > 0 && nshu + pt > target0));
            const unsigned long long m = __ballot(bad);
            int end = m ? (int)__builtin_ctzll(m) : 64;
            if (end <= start) end = start + 1;
            if (lane >= start && lane < end) { PL[16 + lane] = pt - tiles - base_t; PL[80 + lane] = pr - c - base_r; }
            if (lane == 0) { PL[1 + round] = start; PL[10 + round] = __builtin_amdgcn_readlane(pt, end - 1) - base_t; PL[208 + round] = __builtin_amdgcn_readlane(pr, end - 1) - base_r; }
            if (end >= 64 || round >= 7) { if (lane == 0) { PL[0] = round + 1; PL[2 + round] = 64; } break; }
            base_r = __builtin_amdgcn_readlane(pr, end - 1); base_t = __builtin_amdgcn_readlane(pt, end - 1);
            start = end; ++round;
        }
    }
    __syncthreads();
}
constexpr float YS_SCALE = 32.0f, YS_INV = 1.0f / 32.0f;
DEV unsigned char* ys_row(const Params& p, int idx) {
    const int cap8 = p.cap * 2;
    return idx < cap8 ? p.ws + OFF_YS + (size_t)idx * 1024 : (unsigned char*)p.out + (size_t)(idx - cap8) * 1024;
}
DEV unsigned pk4_fp8(const f32x4& v) {
    int w = 0;
    w = __builtin_amdgcn_cvt_pk_fp8_f32(v[0] * YS_SCALE, v[1] * YS_SCALE, w, false);
    w = __builtin_amdgcn_cvt_pk_fp8_f32(v[2] * YS_SCALE, v[3] * YS_SCALE, w, true);
    return (unsigned)w;
}
DEV f32x4 up4_fp8(unsigned w) {
    const f32x2 lo = __builtin_amdgcn_cvt_pk_f32_fp8((int)w, false), hi = __builtin_amdgcn_cvt_pk_f32_fp8((int)w, true);
    return (f32x4){lo[0], lo[1], hi[0], hi[1]};
}

template <bool SHARED>
DEV void moe_tile(const Params& p, const bf16_t* W13, const bf16_t* W2, const int* list, int s0, int nvalid, int ysbase, int m0, int half, const float* g2, char* lds) {
    const int tid = get_tid(), lane = tid & 63, wid = tid >> 6, fr = lane & 15, fq = lane >> 4, wr = wid >> 1, wc = wid & 1;
    const bf16_t* H = (const bf16_t*)(p.ws + OFF_H);
    const float* tkw = (const float*)(p.ws + OFF_TKW);
    char* ACT = lds;
    const unsigned ch8 = (unsigned)(((tid & 7) ^ ((tid >> 3) & 7)) * 8);
    unsigned ao[4];
    float gw[4];
    if (SHARED) {
#pragma unroll
        for (int i = 0; i < 4; ++i) ao[i] = (unsigned)(m0 + i * 32 + (tid >> 3)) * 1024u + ch8;
#pragma unroll
        for (int m = 0; m < 4; ++m) gw[m] = 1.0f;
    } else {
#pragma unroll
        for (int i = 0; i < 4; ++i) { const int rr = min(i * 32 + (tid >> 3), nvalid - 1); ao[i] = (unsigned)(list[s0 + rr] >> 3) * 1024u + ch8; }
#pragma unroll
        for (int m = 0; m < 4; ++m) { const int rl = min(wr * 64 + m * 16 + fr, nvalid - 1); gw[m] = tkw[list[s0 + rl]]; }
    }
    u32x2 areg[2][4][2];
#pragma unroll
    for (int np = 0; np < 2; ++np) {
        const unsigned b0 = (unsigned)(np * 128) * 1024u + st64_off(tid);
        const unsigned bo[4] = {b0, b0 + 32u * 1024u, b0 + 64u * 1024u, b0 + 96u * 1024u};
        const unsigned aoc[4] = {ao[0], ao[1], ao[2], ao[3]};
        f32x4 acc[4][4]; zero_acc<4, 4>(acc);
        gemm_core64<true>(acc, H, aoc, W13, bo, 1024, lds);
#pragma unroll
        for (int m = 0; m < 4; ++m)
#pragma unroll
            for (int pi = 0; pi < 2; ++pi) {
                float o[4];
#pragma unroll
                for (int j = 0; j < 4; ++j) { const float a = acc[m][2 * pi][j], b = acc[m][2 * pi + 1][j]; o[j] = a / (1.0f + __expf(-a)) * b * gw[m]; }
                areg[np][m][pi] = (u32x2){pk2(o[0], o[1]), pk2(o[2], o[3])};
            }
    }
    __syncthreads();
#pragma unroll
    for (int np = 0; np < 2; ++np)
#pragma unroll
        for (int m = 0; m < 4; ++m)
#pragma unroll
            for (int pi = 0; pi < 2; ++pi) *(u32x2*)(ACT + (wr * 64 + m * 16 + fr) * 272 + (np * 64 + wc * 32 + pi * 16 + 4 * fq) * 2) = areg[np][m][pi];
    __syncthreads();
    if (SHARED) {
        gemm2_stream64<128, 272>(W2, ACT, lds + 36864, [&](int nt, const f32x4 (&acc)[4][4]) {
#pragma unroll
            for (int m = 0; m < 4; ++m) {
                unsigned char* o = ys_row(p, ysbase + m0 + wr * 64 + m * 16 + fr) + nt * 128 + wc * 64 + 8 * fq;
#pragma unroll
                for (int g = 0; g < 2; ++g) *(u32x2*)(o + g * 32) = (u32x2){pk4_fp8(acc[m][2 * g]), pk4_fp8(acc[m][2 * g + 1])};
            }
        });
    } else {
        gemm2_stream64<128, 272>(W2, ACT, lds + 36864, [&](int nt, const f32x4 (&acc)[4][4]) {
#pragma unroll
            for (int m = 0; m < 4; ++m) {
                const int rl = wr * 64 + m * 16 + fr;
                if (rl < nvalid) {
                    unsigned char* o = ys_row(p, ysbase + s0 + rl) + nt * 128 + wc * 64 + 8 * fq;
#pragma unroll
                    for (int g = 0; g < 2; ++g) *(u32x2*)(o + g * 32) = (u32x2){pk4_fp8(acc[m][2 * g]), pk4_fp8(acc[m][2 * g + 1])};
                }
            }
        });
    }
    __syncthreads();
}
DEV void phase_moe(const Params& p, int l, int r, char* lds) {
    const int* cnt = (const int*)(p.ws + OFF_CNT) + l * 64 * 64;
    moe_plan(cnt, p.cap, l, lds);
    const int* PL = (const int*)(lds + PLAN_OFF);
    if (r >= PL[0]) return;
    const int e_lo = PL[1 + r], e_hi = PL[2 + r];
    const int nrt = PL[10 + r];
    const int nrows = (l == 0) ? NT : NLAT;
    const int nshu = (r == 0) ? 2 * (nrows / 128) : 0;
    const int G = (int)gridDim.x, b = vblock();
    const int q = (nshu + nrt + G - 1) / G;
    const int u0 = b * q, u1 = min(u0 + q, nshu + nrt);
    int e = e_lo;
    for (int u = u0; u < u1; ++u) {
        if (u < nshu) {
            const int m0 = (u >> 1) * 128, hh = u & 1;
            moe_tile<true>(p, (const bf16_t*)(p.ws + OFF_SW13) + (size_t)(l * 2 + hh) * 256 * 1024, (const bf16_t*)(p.ws + OFF_SW2) + (size_t)(l * 2 + hh) * 1024 * 128,
                           nullptr, 0, 128, PL[208] + hh * nrows, m0, hh, nullptr, lds);
        } else {
            const int it = u - nshu;
            while (e + 1 < e_hi && PL[16 + e + 1] <= it) ++e;
            const int s0 = (it - PL[16 + e]) * 128;
            moe_tile<false>(p, (const bf16_t*)(p.ws + OFF_W13) + (size_t)e * 256 * 1024, (const bf16_t*)(p.ws + OFF_W2) + (size_t)e * 1024 * 128,
                            (const int*)(p.ws + OFF_LIST) + (size_t)e * NT, s0, min(128, PL[144 + e] - s0), PL[80 + e], 0, 0, nullptr, lds);
        }
    }
}

DEV void phase_comb(const Params& p, int l, int r, char* lds) {
    const int tid_ = get_tid(), lane = tid_ & 63, wid = tid_ >> 6;
    const int* cnt = (const int*)(p.ws + OFF_CNT) + l * 64 * 64;
    moe_plan(cnt, p.cap, l, lds);
    const int* PL = (const int*)(lds + PLAN_OFF);
    if (r >= PL[0]) return;
    const int e_lo = PL[1 + r], e_hi = PL[2 + r];
    const bool final = (r == PL[0] - 1);
    bf16_t* X = (bf16_t*)(p.ws + OFF_X);
    bf16_t* H = (bf16_t*)(p.ws + OFF_H);
    const int* tke = (const int*)(p.ws + OFF_TKE); const int* tks = (const int*)(p.ws + OFF_TKS);
    const float* mod = (const float*)(p.ws + OFF_MOD);
    const int nrows = (l == 0) ? NT : NLAT;
    for (int row = blockIdx.x * 4 + wid; row < nrows; row += gridDim.x * 4) {
        const int g = mod_group(row);
        const float* g2 = mod + ((size_t)l * 9 + g) * 6144 + 5120 + 16 * lane;
        int idx_l = -1;
        if (lane < 8) { const int e = tke[row * 8 + lane]; const int sl = tks[row * 8 + lane]; if (e >= e_lo && e < e_hi) idx_l = PL[80 + e] + sl; }
        f32x4 v[4];
        {
            const u32x4 a = *(const u32x4*)(X + (size_t)row * 1024 + 16 * lane), b2 = *(const u32x4*)(X + (size_t)row * 1024 + 16 * lane + 8);
            v[0] = (f32x4){__uint_as_float(a[0] << 16), __uint_as_float(a[0] & 0xffff0000u), __uint_as_float(a[1] << 16), __uint_as_float(a[1] & 0xffff0000u)};
            v[1] = (f32x4){__uint_as_float(a[2] << 16), __uint_as_float(a[2] & 0xffff0000u), __uint_as_float(a[3] << 16), __uint_as_float(a[3] & 0xffff0000u)};
            v[2] = (f32x4){__uint_as_float(b2[0] << 16), __uint_as_float(b2[0] & 0xffff0000u), __uint_as_float(b2[1] << 16), __uint_as_float(b2[1] & 0xffff0000u)};
            v[3] = (f32x4){__uint_as_float(b2[2] << 16), __uint_as_float(b2[2] & 0xffff0000u), __uint_as_float(b2[3] << 16), __uint_as_float(b2[3] & 0xffff0000u)};
        }
        u32x4 y[10];
#pragma unroll
        for (int k = 0; k < 8; ++k) {
            const int idx = __builtin_amdgcn_readlane(idx_l, k);
            if (idx >= 0) y[k] = *(const u32x4*)(ys_row(p, idx) + 16 * lane); else y[k] = (u32x4){0u, 0u, 0u, 0u};
        }
        if (r == 0) { y[8] = *(const u32x4*)(ys_row(p, PL[208] + row) + 16 * lane); y[9] = *(const u32x4*)(ys_row(p, PL[208] + nrows + row) + 16 * lane); }
        else { y[8] = (u32x4){0u, 0u, 0u, 0u}; y[9] = y[8]; }
        f32x4 s[4];
#pragma unroll
        for (int j = 0; j < 4; ++j) s[j] = (f32x4){0.f, 0.f, 0.f, 0.f};
#pragma unroll
        for (int k = 0; k < 10; ++k)
#pragma unroll
            for (int j = 0; j < 4; ++j) s[j] += up4_fp8(y[k][j]);
        const float xs = (r == 0) ? DN_ALPHA : 1.0f;
#pragma unroll
        for (int j = 0; j < 4; ++j) v[j] = v[j] * xs + *(const f32x4*)(g2 + 4 * j) * (s[j] * YS_INV);
        if (!final) {
            u32x4 o0, o1;
            o0 = (u32x4){pk2(v[0][0], v[0][1]), pk2(v[0][2], v[0][3]), pk2(v[1][0], v[1][1]), pk2(v[1][2], v[1][3])};
            o1 = (u32x4){pk2(v[2][0], v[2][1]), pk2(v[2][2], v[2][3]), pk2(v[3][0], v[3][1]), pk2(v[3][2], v[3][3])};
            *(u32x4*)(X + (size_t)row * 1024 + 16 * lane) = o0; *(u32x4*)(X + (size_t)row * 1024 + 16 * lane + 8) = o1;
        } else {
            row_norm(v);
#pragma unroll
            for (int j = 0; j < 4; ++j) {
                const int c = 16 * lane + 4 * j;
                v[j] = v[j] * *(const f32x4*)(p.ln2_g + l * 1024 + c) + *(const f32x4*)(p.ln2_b + l * 1024 + c);
                if (l != 0) *(f32x4*)(p.out + (size_t)row * 1024 + c) = v[j];
            }
            if (l == 0) {
                u32x4 o0, o1;
                o0 = (u32x4){pk2(v[0][0], v[0][1]), pk2(v[0][2], v[0][3]), pk2(v[1][0], v[1][1]), pk2(v[1][2], v[1][3])};
                o1 = (u32x4){pk2(v[2][0], v[2][1]), pk2(v[2][2], v[2][3]), pk2(v[3][0], v[3][1]), pk2(v[3][2], v[3][3])};
                *(u32x4*)(X + (size_t)row * 1024 + 16 * lane) = o0; *(u32x4*)(X + (size_t)row * 1024 + 16 * lane + 8) = o1;
                row_norm(v);
                const float* m1 = mod + ((size_t)9 + g) * 6144 + 16 * lane;
                f32x4 h[4];
#pragma unroll
                for (int j = 0; j < 4; ++j) h[j] = v[j] * (*(const f32x4*)(m1 + 1024 + 4 * j) + 1.0f) + *(const f32x4*)(m1 + 4 * j);
                o0 = (u32x4){pk2(h[0][0], h[0][1]), pk2(h[0][2], h[0][3]), pk2(h[1][0], h[1][1]), pk2(h[1][2], h[1][3])};
                o1 = (u32x4){pk2(h[2][0], h[2][1]), pk2(h[2][2], h[2][3]), pk2(h[3][0], h[3][1]), pk2(h[3][2], h[3][3])};
                *(u32x4*)(H + (size_t)row * 1024 + 16 * lane) = o0; *(u32x4*)(H + (size_t)row * 1024 + 16 * lane + 8) = o1;
            }
        }
    }
    if (final && l == 0) {
        __syncthreads();
        conv_run(p, 1, (int)blockIdx.x * 12, 12, lds);
    }
}


#define XB_TMO      128
#define XB_XCNT(j)  (256  + 64 * (j))
#define XB_XSUB(j)  (1280 + 64 * (j))
#define XB_XGEN(j)  (2304 + 64 * (j))
#define XB_TOP      3328
#define XB_TOPGEN   3392
#define XCD_BAR_WORDS 3456
#define XB_SPIN_CAP (1u << 22)
DEV unsigned xb_ld(unsigned* p) { return __hip_atomic_load(p, __ATOMIC_RELAXED, __HIP_MEMORY_SCOPE_AGENT); }
DEV unsigned xb_add(unsigned* p, unsigned v) { return __hip_atomic_fetch_add(p, v, __ATOMIC_RELAXED, __HIP_MEMORY_SCOPE_AGENT); }
DEV unsigned xb_xcc_id() { return (unsigned)__builtin_amdgcn_s_getreg((3 << 11) | 20) & 0xFu; }
#define XB_SPIN(cond, bar) do { unsigned _sp = 0; while (cond) { __builtin_amdgcn_s_sleep(1); \
    if ((++_sp & 255u) == 0u) { if (xb_ld(&(bar)[XB_TMO])) break; if (_sp > XB_SPIN_CAP) { atomicAdd(&(bar)[XB_TMO], 1u); break; } } } } while (0)
struct XcdBarrier { unsigned* bar; unsigned x; volatile LAS unsigned* st; };
DEV XcdBarrier xcd_barrier_post(unsigned* bar, volatile LAS unsigned* st) {
    XcdBarrier b; b.bar = bar; b.x = xb_xcc_id(); b.st = st;
    if (threadIdx.x == 0) (void)xb_add(&bar[XB_XCNT(b.x)], 1u);
    return b;
}
DEV void xcd_barrier_complete(unsigned* bar, unsigned x, unsigned& nloc, unsigned& nx) {
    const unsigned G = gridDim.x * gridDim.y * gridDim.z;
    unsigned sum, cnt, mine, sp = 0u;
    for (;;) {
        sum = 0u; cnt = 0u; mine = 0u;
#pragma unroll
        for (unsigned j = 0; j < 16; ++j) { const unsigned c = xb_ld(&bar[XB_XCNT(j)]); sum += c; cnt += (c > 0u) ? 1u : 0u; mine = (j == x) ? c : mine; }
        if (sum == G) break;
        __builtin_amdgcn_s_sleep(1);
        if ((++sp & 255u) == 0u) { if (xb_ld(&bar[XB_TMO])) break; if (sp > XB_SPIN_CAP) { atomicAdd(&bar[XB_TMO], 1u); break; } }
    }
    nloc = mine > 0u ? mine : 1u; nx = cnt > 0u ? cnt : 1u;
}
DEV void xcd_barrier(const XcdBarrier& b) {
    asm volatile("s_waitcnt vmcnt(0)" ::: "memory");
    __syncthreads();
    if (get_tid() == 0) {
        unsigned* bar = b.bar; asm volatile("" : "+s"(bar));
        __builtin_amdgcn_s_waitcnt(0);
        unsigned nloc = b.st[0], nx = b.st[1];
        if (nloc == 0u) { xcd_barrier_complete(bar, b.x, nloc, nx); b.st[0] = nloc; b.st[1] = nx; }
        const unsigned old = xb_add(&bar[XB_XSUB(b.x)], 1u);
        const unsigned gen = old / nloc;
        if (old + 1u == (gen + 1u) * nloc) {
            __builtin_amdgcn_fence(__ATOMIC_RELEASE, "agent");
            asm volatile("s_waitcnt vmcnt(0)" ::: "memory");
            const unsigned og = xb_add(&bar[XB_TOP], 1u);
            const unsigned tg = og / nx;
            if (og + 1u == (tg + 1u) * nx) xb_add(&bar[XB_TOPGEN], 1u);
            else XB_SPIN(xb_ld(&bar[XB_TOPGEN]) == tg, bar);
            __builtin_amdgcn_fence(__ATOMIC_ACQUIRE, "agent");
            xb_add(&bar[XB_XGEN(b.x)], 1u);
            asm volatile("s_waitcnt vmcnt(0)" ::: "memory");
        } else {
            XB_SPIN(xb_ld(&bar[XB_XGEN(b.x)]) == gen, bar);
            __builtin_amdgcn_fence(__ATOMIC_ACQUIRE, "agent");
            asm volatile("s_waitcnt vmcnt(0)" ::: "memory");
        }
    }
    __syncthreads();
}

enum { PT_PREP = 0, PT_MODFIN, PT_LNMOD0, PT_INPROJ, PT_MIX, PT_OUTPROJ, PT_LN1ROUTE, PT_MOE, PT_COMB };

DEV void run_phase(const Params& pin, int type, int l, int r, char* lds) {
    Params p = pin;
    { unsigned char* w = p.ws; asm volatile("" : "+s"(w)); p.ws = w; }
    switch (type) {
        case PT_PREP: phase_prep(p, lds); break;
        case PT_MODFIN: phase_modfin(p); break;
        case PT_LNMOD0: phase_lnmod0(p); break;
        case PT_INPROJ: phase_inproj(p, l, lds); break;
        case PT_MIX: phase_mix(p, l, lds); break;
        case PT_OUTPROJ: phase_outproj(p, l, lds); break;
        case PT_LN1ROUTE: phase_ln1route(p, l, lds); break;
        case PT_MOE: phase_moe(p, l, r, lds); break;
        default: phase_comb(p, l, r, lds); break;
    }
}

__global__ void __launch_bounds__(256, 2) fwd_kernel(Params p) {
    __shared__ __attribute__((aligned(16))) char smem[SMEM_BYTES];
#if MULTI_LAUNCH
    run_phase(p, p.ptype, p.pl, p.pr, smem);
#else
    if (threadIdx.x < 4) ((volatile LAS unsigned*)(smem + SMEM_BYTES - 16))[threadIdx.x] = 0u;
    __syncthreads();
    const XcdBarrier bar = xcd_barrier_post((unsigned*)(p.ws + OFF_BAR), (volatile LAS unsigned*)(smem + SMEM_BYTES - 16));
    int type = PT_PREP, l = 0, r = 0;
    for (;;) {
        run_phase(p, type, l, r, smem);
        if (type < PT_MOE) { ++type; if (type == PT_MODFIN) ++type; r = 0; }
        else if (type == PT_MOE) type = PT_COMB;
        else {
            const int nr = ((const int*)(smem + PLAN_OFF))[0];
            if (r + 1 < nr) { ++r; type = PT_MOE; }
            else { if (l == 1) break; l = 1; r = 0; type = PT_INPROJ; }
        }
        xcd_barrier(bar);
    }
#endif
}

extern "C" void kernel_launch(void* const* d_in, const int* in_sizes, int n_in, void* d_out, int out_size, void* d_ws, size_t ws_size, hipStream_t stream) {
    Params p{};
    const float** pp = (const float**)&p;
    for (int i = 0; i < 32; ++i) pp[i] = (const float*)d_in[i];
    p.out = (float*)d_out; p.ws = (unsigned char*)d_ws;
    long long cap = ((long long)ws_size - (long long)OFF_R) / 2048;
    if (cap > NT * 8) cap = NT * 8;
    if (cap * 2048 < (long long)R_MIN_BYTES || cap < NT) { fprintf(stderr, "kernel_launch: workspace too small (%zu)\n", ws_size); return; }
    p.cap = (int)cap;
#if MULTI_LAUNCH
    const int grid = 512;
    auto launch = [&](int type, int l, int r) { Params q = p; q.mode = 1; q.ptype = type; q.pl = l; q.pr = r; hipLaunchKernelGGL(fwd_kernel, dim3(grid), dim3(256), 0, stream, q); };
    launch(PT_PREP, 0, 0); launch(PT_MODFIN, 0, 0); launch(PT_LNMOD0, 0, 0);
    for (int l = 0; l < 2; ++l) {
        launch(PT_INPROJ, l, 0); launch(PT_MIX, l, 0); launch(PT_OUTPROJ, l, 0); launch(PT_LN1ROUTE, l, 0);
        for (int r = 0; r < RMAX; ++r) { launch(PT_MOE, l, r); launch(PT_COMB, l, r); }
    }
#else
    static int grid_blocks = 0;
    if (!grid_blocks) {
        int dev = 0, cus = 0, per_cu = 0;
        hipGetDevice(&dev);
        hipDeviceGetAttribute(&cus, hipDeviceAttributeMultiprocessorCount, dev);
        hipOccupancyMaxActiveBlocksPerMultiprocessor(&per_cu, fwd_kernel, 256, 0);
        if (per_cu > 2) per_cu = 2;
        if (per_cu < 1) per_cu = 1;
        grid_blocks = cus * per_cu;
    }
    p.mode = 0;
    hipMemsetAsync(d_ws, 0, 65536, stream);
    hipLaunchKernelGGL(fwd_kernel, dim3(grid_blocks), dim3(256), 0, stream, p);
#endif
}
```

```cpp
#include <hip/hip_runtime.h>
#include <hip/hip_cooperative_groups.h>
#include <stdint.h>
#include <stdio.h>
namespace cg = cooperative_groups;

#ifndef MULTI_LAUNCH
#define MULTI_LAUNCH 0
#endif

typedef unsigned short bf16_t;
typedef short bf16x8 __attribute__((ext_vector_type(8)));
typedef short s16x4 __attribute__((ext_vector_type(4)));
typedef float f32x4 __attribute__((ext_vector_type(4)));
typedef unsigned u32x4 __attribute__((ext_vector_type(4)));
typedef unsigned u32x2 __attribute__((ext_vector_type(2)));
#define DEV __device__ __forceinline__
#define LDSP(T) __attribute__((address_space(3))) T*
#define LAS __attribute__((address_space(3)))

constexpr int D = 1024, NB = 8, SEQ = 2048, CTX = 256, NLAT = NB * SEQ, NCTX = NB * CTX, NT = NLAT + NCTX;
constexpr int PROJ = 2304, KEYS = CTX + SEQ, NEXP = 64;
constexpr float DN_ALPHA = 1.41421356237309515f;
constexpr float LOG2E = 1.44269504088896341f;
constexpr int SMEM_BYTES = 72 * 1024;
constexpr int RMAX = 4;

constexpr size_t OFF_CNT = 0;
constexpr size_t OFF_QUEUE = 33792;
constexpr size_t OFF_BAR = 40960;
constexpr size_t OFF_MOD = 65536;
constexpr size_t OFF_ROPE = OFF_MOD + 442368;
constexpr size_t OFF_KERNL = OFF_ROPE + 2ull * 2048 * 32 * 4;
constexpr size_t OFF_KERNC = OFF_KERNL + 2ull * 4096 * 256 * 4;
constexpr size_t OFF_TKE = OFF_KERNC + 2ull * 512 * 256 * 4;
constexpr size_t OFF_TKS = OFF_TKE + (size_t)NT * 8 * 4;
constexpr size_t OFF_TKW = OFF_TKS + (size_t)NT * 8 * 4;
constexpr size_t OFF_LIST = OFF_TKW + (size_t)NT * 8 * 4;
constexpr size_t OFF_WIN = OFF_LIST + 64ull * NT * 4;
constexpr size_t OFF_WOUT = OFF_WIN + 2ull * 2304 * 1024 * 2;
constexpr size_t OFF_SW13 = OFF_WOUT + 2ull * 1024 * 1024 * 2;
constexpr size_t OFF_SW2 = OFF_SW13 + 2ull * 512 * 1024 * 2;
constexpr size_t OFF_RW = OFF_SW2 + 2ull * 1024 * 256 * 2;
constexpr size_t OFF_W13 = OFF_RW + 2ull * 64 * 1024 * 2;
constexpr size_t OFF_W2 = OFF_W13 + 64ull * 256 * 1024 * 2;
constexpr size_t OFF_X = OFF_W2 + 64ull * 1024 * 128 * 2;
constexpr size_t OFF_H = OFF_X + (size_t)NT * 1024 * 2;
constexpr size_t OFF_R = OFF_H + (size_t)NT * 1024 * 2;
constexpr size_t OFF_QA = OFF_R;
constexpr size_t OFF_QB = OFF_QA + 8ull * NT * 64 * 2;
constexpr size_t OFF_KA = OFF_QB + 4ull * NT * 64 * 2;
constexpr size_t OFF_VA = OFF_KA + 8ull * 2 * KEYS * 64 * 2;
constexpr size_t OFF_KB = OFF_VA + 8ull * 2 * KEYS * 64 * 2;
constexpr size_t OFF_VB = OFF_KB + 8ull * 4 * KEYS * 64 * 2;
constexpr size_t OFF_ZTL = OFF_VB + 8ull * 4 * KEYS * 64 * 2;
constexpr size_t OFF_ZTC = OFF_ZTL + 8ull * 768 * 2048 * 2;
constexpr size_t OFF_OX = OFF_ZTC + 8ull * 768 * 256 * 2;
constexpr size_t OFF_OXT = OFF_OX + (size_t)NT * 1024 * 2;
constexpr size_t R_MIN_BYTES = OFF_OXT + 8ull * 256 * 2048 * 2 - OFF_R;
constexpr size_t OFF_PART = OFF_R;
constexpr size_t OFF_YS = OFF_R;

struct Params {
    const float *x, *c, *ctx, *c_ctx, *ada_w, *ada_b, *w_in, *q_gain, *k_gain, *nat_rpb, *hy_conv_w, *hy_conv_b,
        *hy_f_w1, *hy_f_b1, *hy_f_w2, *hy_f_b2, *hy_f_w3, *hy_freq, *hy_skip, *w_out, *ln1_g, *ln1_b,
        *router_w, *router_b, *exp_w1, *exp_w3, *exp_w2, *sh_w1, *sh_w3, *sh_w2, *ln2_g, *ln2_b;
    float* out; unsigned char* ws;
    int cap, mode, ptype, pl, pr, pad;
};

typedef __bf16 hwbf2 __attribute__((ext_vector_type(2)));
typedef float f32x2 __attribute__((ext_vector_type(2)));
DEV unsigned f2bf(float f) { return (unsigned)__builtin_bit_cast(unsigned short, (__bf16)f); }
DEV unsigned pk2(float lo, float hi) { const f32x2 v = {lo, hi}; return __builtin_bit_cast(unsigned, __builtin_convertvector(v, hwbf2)); }
DEV float bf2f(unsigned short h) { return __uint_as_float(((unsigned)h) << 16); }
DEV float wave_sum(float v) {
#pragma unroll
    for (int o = 32; o > 0; o >>= 1) v += __shfl_xor(v, o);
    return v;
}
DEV void glds16(const void* g, void* l) { __builtin_amdgcn_global_load_lds((const unsigned*)g, (unsigned*)l, 16, 0, 0); }
DEV f32x4 mfma16(bf16x8 a, bf16x8 b, f32x4 c) { return __builtin_amdgcn_mfma_f32_16x16x32_bf16(a, b, c, 0, 0, 0); }
DEV float readlane_f(float v, int l) { return __uint_as_float((unsigned)__builtin_amdgcn_readlane((int)__float_as_uint(v), l)); }
DEV int get_tid() { int t = threadIdx.x; asm volatile("" : "+v"(t)); return t; }
DEV int lchunk(int tid) { return (tid & 3) ^ ((0 - (tid >> 4)) & 3); }
DEV int vblock() { const int G = (int)gridDim.x, b = (int)blockIdx.x; return (G & 7) ? b : (b & 7) * (G >> 3) + (b >> 3); }
DEV int mod_group(int row) { return row < NLAT ? (row >> 11) : 8; }

template <int MI, int NI> DEV void zero_acc(f32x4 (&acc)[MI][NI]) {
#pragma unroll
    for (int m = 0; m < MI; ++m)
#pragma unroll
        for (int n = 0; n < NI; ++n) acc[m][n] = (f32x4){0.f, 0.f, 0.f, 0.f};
}
#define WAIT_VM(n) asm volatile("s_waitcnt vmcnt(" #n ")" ::: "memory")
#define WAIT_LGKM0() asm volatile("s_waitcnt lgkmcnt(0)" ::: "memory")
#define RAW_BARRIER() do { asm volatile("" ::: "memory"); __builtin_amdgcn_s_barrier(); asm volatile("" ::: "memory"); } while (0)
template <int MI, int NI, bool TRANS>
DEV void gemm_core(f32x4 (&acc)[MI][NI], const bf16_t* A, const unsigned (&ao)[MI / 2], const bf16_t* B, const unsigned (&bo)[NI / 2], int K, char* lds) {
    const int tid = get_tid(), lane = tid & 63, wid = tid >> 6, fr = lane & 15, fq = lane >> 4, wr = wid >> 1, wc = wid & 1;
    constexpr int SAB = 2048 * MI, STG = 2048 * (MI + NI), LPT = MI / 2 + NI / 2;
    static_assert(LPT == 3 || LPT == 4 || LPT == 6, "loads per tile");
    const int nt = K >> 5;
    auto stage = [&](int s, int t) {
        char* SA = lds + s * STG; char* SB = SA + SAB;
#pragma unroll
        for (int i = 0; i < MI / 2; ++i) glds16(A + (ao[i] + (unsigned)(t * 32)), SA + i * 4096 + tid * 16);
#pragma unroll
        for (int i = 0; i < NI / 2; ++i) glds16(B + (bo[i] + (unsigned)(t * 32)), SB + i * 4096 + tid * 16);
    };
    WAIT_VM(0);
    stage(0, 0);
    if (nt > 1) stage(1, 1);
    const int sw = (fq ^ ((0 - (fr >> 2)) & 3)) * 16;
    const int aoff = (wr * MI * 16 + fr) * 64 + sw, boff = SAB + (wc * NI * 16 + fr) * 64 + sw;
#pragma unroll 1
    for (int t = 0; t < nt; ++t) {
        if (t + 1 < nt) { if (LPT == 6) WAIT_VM(6); else if (LPT == 4) WAIT_VM(4); else WAIT_VM(3); } else WAIT_VM(0);
        RAW_BARRIER();
        const char* S = lds + (t & 1) * STG;
        bf16x8 af[MI], bfr[NI];
#pragma unroll
        for (int m = 0; m < MI; ++m) af[m] = *(const bf16x8*)(S + aoff + m * 1024);
#pragma unroll
        for (int n = 0; n < NI; ++n) bfr[n] = *(const bf16x8*)(S + boff + n * 1024);
        WAIT_LGKM0();
        RAW_BARRIER();
        if (t + 2 < nt) stage(t & 1, t + 2);
#pragma unroll
        for (int m = 0; m < MI; ++m)
#pragma unroll
            for (int n = 0; n < NI; ++n) acc[m][n] = TRANS ? mfma16(bfr[n], af[m], acc[m][n]) : mfma16(af[m], bfr[n], acc[m][n]);
    }
}
DEV unsigned st64_off(int tid) { return (unsigned)(tid >> 3) * 1024u + (unsigned)(((tid & 7) ^ ((tid >> 3) & 7)) * 8); }
DEV int tr_key(int row) { return (row & 3) | (((row >> 3) & 1) << 2); }
template <bool TRANS>
DEV void gemm_core64(f32x4 (&acc)[4][4], const bf16_t* A, const unsigned (&ao)[4], const bf16_t* B, const unsigned (&bo)[4], int K, char* lds,
                     const bf16_t* AT = nullptr, int t_tr = 1 << 20) {
    const int tid = get_tid(), lane = tid & 63, wid = tid >> 6, fr = lane & 15, fq = lane >> 4, wr = wid >> 1, wc = wid & 1;
    const int nt = K >> 6;
    auto stage = [&](int s, int t) {
        char* SA = lds + s * 32768; char* SB = SA + 16384;
        if (t >= t_tr) {
#pragma unroll
            for (int i = 0; i < 4; ++i) {
                const int id = tid + 256 * i, row = id >> 4, cp = id & 15, c = (cp - 2 * tr_key(row)) & 15;
                glds16(AT + (size_t)((t - t_tr) * 64 + row) * 2048 + c * 8, SA + id * 16);
            }
        } else {
#pragma unroll
            for (int i = 0; i < 4; ++i) glds16(A + (ao[i] + (unsigned)(t * 64)), SA + i * 4096 + tid * 16);
        }
#pragma unroll
        for (int i = 0; i < 4; ++i) glds16(B + (bo[i] + (unsigned)(t * 64)), SB + i * 4096 + tid * 16);
    };
    WAIT_VM(0);
    stage(0, 0);
    if (nt > 1) stage(1, 1);
    const int rsw = fr & 7;
    const int arow = (wr * 64 + fr) * 128, brow = 16384 + (wc * 64 + fr) * 128;
    const int c0 = ((fq) ^ rsw) * 16, c1 = ((4 + fq) ^ rsw) * 16;
#pragma unroll 1
    for (int t = 0; t < nt; ++t) {
        if (t + 1 < nt) WAIT_VM(8); else WAIT_VM(0);
        RAW_BARRIER();
        const char* S = lds + (t & 1) * 32768;
        bf16x8 af[4][2], bfr[4][2];
        if (t >= t_tr) {
            const int q4 = fr >> 2, p4 = fr & 3;
#pragma unroll
            for (int m = 0; m < 4; ++m)
#pragma unroll
                for (int ks = 0; ks < 2; ++ks) {
                    const int rowA = ks * 32 + 8 * fq + q4, rowB = rowA + 4, c = wr * 8 + m * 2 + (p4 >> 1);
                    const int offA = rowA * 256 + (((c + 2 * tr_key(rowA)) & 15) * 16) + (p4 & 1) * 8;
                    const int offB = rowB * 256 + (((c + 2 * tr_key(rowB)) & 15) * 16) + (p4 & 1) * 8;
                    const s16x4 ta = __builtin_amdgcn_ds_read_tr16_b64_v4i16((LDSP(s16x4))(S + offA));
                    const s16x4 tb = __builtin_amdgcn_ds_read_tr16_b64_v4i16((LDSP(s16x4))(S + offB));
                    bf16x8 f; f[0] = ta[0]; f[1] = ta[1]; f[2] = ta[2]; f[3] = ta[3]; f[4] = tb[0]; f[5] = tb[1]; f[6] = tb[2]; f[7] = tb[3];
                    af[m][ks] = f;
                }
        } else {
#pragma unroll
            for (int m = 0; m < 4; ++m) { af[m][0] = *(const bf16x8*)(S + arow + m * 2048 + c0); af[m][1] = *(const bf16x8*)(S + arow + m * 2048 + c1); }
        }
#pragma unroll
        for (int n = 0; n < 4; ++n) { bfr[n][0] = *(const bf16x8*)(S + brow + n * 2048 + c0); bfr[n][1] = *(const bf16x8*)(S + brow + n * 2048 + c1); }
        WAIT_LGKM0();
        RAW_BARRIER();
        if (t + 2 < nt) stage(t & 1, t + 2);
        __builtin_amdgcn_s_setprio(1);
#pragma unroll
        for (int ks = 0; ks < 2; ++ks)
#pragma unroll
            for (int m = 0; m < 4; ++m)
#pragma unroll
                for (int n = 0; n < 4; ++n) acc[m][n] = TRANS ? mfma16(bfr[n][ks], af[m][ks], acc[m][n]) : mfma16(af[m][ks], bfr[n][ks], acc[m][n]);
        __builtin_amdgcn_s_setprio(0);
    }
}
template <int KACT, int ASTRIDE, class EPI>
DEV void gemm2_stream64(const bf16_t* W2, const char* ACT, char* sb, EPI&& epi) {
    const int tid = get_tid(), lane = tid & 63, wid = tid >> 6, fr = lane & 15, fq = lane >> 4, wr = wid >> 1, wc = wid & 1;
    constexpr int KS = KACT / 64, NJ = 8 * KS;
    const unsigned b0 = (unsigned)(tid >> 3) * KACT + (unsigned)(((tid & 7) ^ ((tid >> 3) & 7)) * 8);
    auto stage = [&](int s, int j) {
        const int nt = j / KS, ks = j % KS;
        char* SB = sb + s * 16384;
        const bf16_t* src = W2 + (size_t)nt * 128 * KACT + ks * 64 + b0;
#pragma unroll
        for (int i = 0; i < 4; ++i) glds16(src + (size_t)i * 32 * KACT, SB + i * 4096 + tid * 16);
    };
    WAIT_VM(0);
    stage(0, 0); stage(1, 1);
    const int rsw = fr & 7;
    const int brow = (wc * 64 + fr) * 128, c0 = (fq ^ rsw) * 16, c1 = ((4 + fq) ^ rsw) * 16;
    f32x4 acc[4][4]; zero_acc<4, 4>(acc);
#pragma unroll 1
    for (int j = 0; j < NJ; ++j) {
        const int ks = j % KS;
        if (j + 1 < NJ) WAIT_VM(4); else WAIT_VM(0);
        RAW_BARRIER();
        const char* S = sb + (j & 1) * 16384;
        bf16x8 af[4][2], bfr[4][2];
#pragma unroll
        for (int m = 0; m < 4; ++m) { const char* ar = ACT + (wr * 64 + m * 16 + fr) * ASTRIDE + (ks * 64 + fq * 8) * 2; af[m][0] = *(const bf16x8*)ar; af[m][1] = *(const bf16x8*)(ar + 64); }
#pragma unroll
        for (int n = 0; n < 4; ++n) { bfr[n][0] = *(const bf16x8*)(S + brow + n * 2048 + c0); bfr[n][1] = *(const bf16x8*)(S + brow + n * 2048 + c1); }
        WAIT_LGKM0();
        RAW_BARRIER();
        if (j + 2 < NJ) stage(j & 1, j + 2);
#pragma unroll
        for (int k2 = 0; k2 < 2; ++k2)
#pragma unroll
            for (int m = 0; m < 4; ++m)
#pragma unroll
                for (int n = 0; n < 4; ++n) acc[m][n] = mfma16(bfr[n][k2], af[m][k2], acc[m][n]);
        if (ks == KS - 1) { epi(j / KS, acc); zero_acc<4, 4>(acc); }
    }
}
template <int MI, int KACT, int ASTRIDE, class EPI>
DEV void gemm2_stream(const bf16_t* W2, const char* ACT, char* sb, EPI&& epi) {
    const int tid = get_tid(), lane = tid & 63, wid = tid >> 6, fr = lane & 15, fq = lane >> 4, wr = wid >> 1, wc = wid & 1;
    constexpr int KS = KACT / 32, NJ = 8 * KS;
    const bf16_t* b0 = W2 + (size_t)(tid >> 2) * KACT + lchunk(tid) * 8;
    auto stage = [&](int s, int j) {
        const int nt = j / KS, ks = j % KS;
        char* SB = sb + s * 8192;
        const bf16_t* src = b0 + (size_t)nt * 128 * KACT + ks * 32;
        glds16(src, SB + tid * 16);
        glds16(src + 64 * KACT, SB + 4096 + tid * 16);
    };
    WAIT_VM(0);
    stage(0, 0); stage(1, 1);
    const int boff = (wc * 64 + fr) * 64 + (fq ^ ((0 - (fr >> 2)) & 3)) * 16;
    f32x4 acc[MI][4]; zero_acc<MI, 4>(acc);
#pragma unroll 1
    for (int j = 0; j < NJ; ++j) {
        const int ks = j % KS;
        if (j + 1 < NJ) WAIT_VM(2); else WAIT_VM(0);
        RAW_BARRIER();
        const char* S = sb + (j & 1) * 8192;
        bf16x8 af[MI], bfr[4];
#pragma unroll
        for (int m = 0; m < MI; ++m) af[m] = *(const bf16x8*)(ACT + (wr * MI * 16 + m * 16 + fr) * ASTRIDE + (ks * 32 + fq * 8) * 2);
#pragma unroll
        for (int n = 0; n < 4; ++n) bfr[n] = *(const bf16x8*)(S + boff + n * 1024);
        WAIT_LGKM0();
        RAW_BARRIER();
        if (j + 2 < NJ) stage(j & 1, j + 2);
#pragma unroll
        for (int m = 0; m < MI; ++m)
#pragma unroll
            for (int n = 0; n < 4; ++n) acc[m][n] = mfma16(bfr[n], af[m], acc[m][n]);
        if (ks == KS - 1) { epi(j / KS, acc); zero_acc<MI, 4>(acc); }
    }
}

DEV void prep_mod_item(const Params& p, int it, char* lds) {
    const int l = it / 96, cch = it % 96, tid = get_tid(), col = cch * 64 + (tid & 63), kq = tid >> 6;
    float* sl = (float*)lds;
    float* red = sl + 9 * 1024;
    for (int i = tid; i < 9 * 1024; i += 256) { const int g = i >> 10, k = i & 1023; const float v = (g < 8) ? p.c[g * 1024 + k] : p.c_ctx[k]; sl[i] = v / (1.f + expf(-v)); }
    __syncthreads();
    float acc[9];
#pragma unroll
    for (int g = 0; g < 9; ++g) acc[g] = 0.f;
    const float* w = p.ada_w + ((size_t)l * 1024 + kq * 256) * 6144 + col;
#pragma unroll 16
    for (int kk = 0; kk < 256; ++kk) {
        const float wv = w[(size_t)kk * 6144];
#pragma unroll
        for (int g = 0; g < 9; ++g) acc[g] += sl[g * 1024 + kq * 256 + kk] * wv;
    }
#pragma unroll
    for (int g = 0; g < 9; ++g) red[(kq * 9 + g) * 64 + (tid & 63)] = acc[g];
    __syncthreads();
    float* mod = (float*)(p.ws + OFF_MOD);
    for (int i = tid; i < 9 * 64; i += 256) {
        const int g = i >> 6, c = i & 63;
        mod[((size_t)l * 9 + g) * 6144 + cch * 64 + c] = p.ada_b[l * 6144 + cch * 64 + c] + ((red[(0 * 9 + g) * 64 + c] + red[(1 * 9 + g) * 64 + c]) + (red[(2 * 9 + g) * 64 + c] + red[(3 * 9 + g) * 64 + c]));
    }
    __syncthreads();
}
DEV void prep_rope_item(const Params& p, int it) {
    const int idx = it * 256 + get_tid(), t = idx >> 5, i = idx & 31;
    const float inv = powf(10000.f, -(float)(2 * (i & 15)) / 32.f);
    const float ang = (float)((i < 16) ? (t >> 6) : (t & 63)) * inv;
    float* rc = (float*)(p.ws + OFF_ROPE);
    rc[idx] = cosf(ang); rc[2048 * 32 + idx] = sinf(ang);
}
DEV void prep_filter_item(const Params& p, int it, char* lds) {
    const int tid = get_tid(), lane = tid & 63, wid = tid >> 6;
    const int row0 = it * 32 + wid * 8;
    const int l = row0 / 2304, r0 = row0 % 2304, type = r0 < 2048 ? 0 : 1, t0 = type ? r0 - 2048 : r0, n = type ? 256 : 2048;
    float* z = (float*)lds + wid * (8 * 192); float* h1 = z + 8 * 64; float* h2 = h1 + 8 * 64;
#pragma unroll
    for (int rr = 0; rr < 8; ++rr) {
        const int t = t0 + rr;
        if (lane < 33) {
            float v;
            if (lane == 0) v = (float)t / (float)(n - 1);
            else {
                const int i = (lane - 1) & 15;
                const float f = 1e-4f + (float)i * ((15.f - 1e-4f) / 15.f);
                const float w = 2.f * 3.14159265358979323846f * (float)t / (float)n;
                v = (lane <= 16) ? cosf(f * w) : -sinf(f * w);
            }
            z[rr * 64 + lane] = v;
        }
    }
    __builtin_amdgcn_wave_barrier();
    {
        float s[8]; const float b = p.hy_f_b1[l * 64 + lane];
#pragma unroll
        for (int rr = 0; rr < 8; ++rr) s[rr] = b;
#pragma unroll 11
        for (int i = 0; i < 33; ++i) {
            const float w = p.hy_f_w1[(l * 33 + i) * 64 + lane];
#pragma unroll
            for (int rr = 0; rr < 8; ++rr) s[rr] += z[rr * 64 + i] * w;
        }
        const float fq0 = p.hy_freq[(l * 2 + 0) * 64 + lane];
#pragma unroll
        for (int rr = 0; rr < 8; ++rr) h1[rr * 64 + lane] = sinf(fq0 * s[rr]);
    }
    __builtin_amdgcn_wave_barrier();
    {
        float s[8]; const float b = p.hy_f_b2[l * 64 + lane];
#pragma unroll
        for (int rr = 0; rr < 8; ++rr) s[rr] = b;
#pragma unroll 16
        for (int i = 0; i < 64; ++i) {
            const float w = p.hy_f_w2[(l * 64 + i) * 64 + lane];
#pragma unroll
            for (int rr = 0; rr < 8; ++rr) s[rr] += h1[rr * 64 + i] * w;
        }
        const float fq1 = p.hy_freq[(l * 2 + 1) * 64 + lane];
#pragma unroll
        for (int rr = 0; rr < 8; ++rr) h2[rr * 64 + lane] = sinf(fq1 * s[rr]);
    }
    __builtin_amdgcn_wave_barrier();
    bf16_t* kf = (bf16_t*)(p.ws + (type ? OFF_KERNC + (size_t)l * 2 * 256 * 256 * 2 : OFF_KERNL + (size_t)l * 2 * 256 * 2048 * 2));
    const float lo = logf(1e-2f) / 1.5f, hi = logf(1e-2f) / 0.3f;
    const float* w3 = p.hy_f_w3 + (size_t)l * 64 * 512 + lane;
#pragma unroll 1
    for (int qh = 0; qh < 2; ++qh) {
        float acc[8][4];
#pragma unroll
        for (int rr = 0; rr < 8; ++rr)
#pragma unroll
            for (int q = 0; q < 4; ++q) acc[rr][q] = 0.f;
#pragma unroll 8
        for (int i = 0; i < 64; ++i) {
            float w[4];
#pragma unroll
            for (int q = 0; q < 4; ++q) w[q] = w3[i * 512 + qh * 256 + q * 64];
#pragma unroll
            for (int rr = 0; rr < 8; ++rr) {
                const float hv = h2[rr * 64 + i];
#pragma unroll
                for (int q = 0; q < 4; ++q) acc[rr][q] += hv * w[q];
            }
        }
#pragma unroll
        for (int q = 0; q < 4; ++q) {
            const int c = q * 64 + lane;
            const float delta = fabsf(lo + (float)c * ((hi - lo) / 255.f));
            float v[8];
#pragma unroll
            for (int rr = 0; rr < 8; ++rr) { const float tt = (float)(t0 + rr) / (float)(n - 1); v[rr] = acc[rr][q] * expf(-tt * delta); }
            if (qh == 0 && t0 == 0) v[0] += p.hy_skip[l * 256 + c];
            *(u32x4*)(kf + ((size_t)qh * 256 + c) * n + t0) = (u32x4){pk2(v[0], v[1]), pk2(v[2], v[3]), pk2(v[4], v[5]), pk2(v[6], v[7])};
        }
    }
    __builtin_amdgcn_wave_barrier();
}
struct ConvDesc { const float* src; bf16_t* dst; int ldsrc, k0, n0, lddst, mapkind; };
DEV void conv_load(const ConvDesc& d, f32x4 (&v)[4], int tid) {
    const int r = tid >> 4, c4 = (tid & 15) * 4;
#pragma unroll
    for (int i = 0; i < 4; ++i) v[i] = *(const f32x4*)(d.src + (size_t)(d.k0 + r + 16 * i) * d.ldsrc + d.n0 + c4);
}
DEV void conv_store(const ConvDesc& d, const f32x4 (&v)[4], char* lds, int tid) {
    float* tl = (float*)lds;
    {
        const int r = tid >> 4, c4 = (tid & 15) * 4;
#pragma unroll
        for (int i = 0; i < 4; ++i) { const int row = r + 16 * i; tl[row * 65 + c4 + 0] = v[i][0]; tl[row * 65 + c4 + 1] = v[i][1]; tl[row * 65 + c4 + 2] = v[i][2]; tl[row * 65 + c4 + 3] = v[i][3]; }
    }
    __syncthreads();
    {
        const int n = tid >> 2, kc = tid & 3, ng = d.n0 + n;
        int drow = ng;
        if (d.mapkind == 1) drow = 32 * (ng >> 4) + (ng & 15);
        else if (d.mapkind == 2) drow = 32 * (ng >> 4) + 16 + (ng & 15);
        else if (d.mapkind == 3) drow = (ng >> 7) * 256 + 32 * ((ng & 127) >> 4) + (ng & 15);
        else if (d.mapkind == 4) drow = (ng >> 7) * 256 + 32 * ((ng & 127) >> 4) + 16 + (ng & 15);
        else if (d.mapkind == 5) drow = (ng & ~31) + 16 * ((ng >> 2) & 1) + 4 * ((ng >> 3) & 3) + (ng & 3);
        unsigned w[8];
#pragma unroll
        for (int j = 0; j < 8; ++j) w[j] = pk2(tl[(kc * 16 + 2 * j) * 65 + n], tl[(kc * 16 + 2 * j + 1) * 65 + n]);
        u32x4* o = (u32x4*)(d.dst + (size_t)drow * d.lddst + d.k0 + kc * 16);
        o[0] = (u32x4){w[0], w[1], w[2], w[3]};
        o[1] = (u32x4){w[4], w[5], w[6], w[7]};
    }
    __syncthreads();
}
DEV ConvDesc conv_fixed_desc(const Params& p, int it) {
    const int l = it / 1040; int r = it % 1040;
    unsigned char* ws = p.ws;
    if (r < 576) return ConvDesc{p.w_in + (size_t)l * 1024 * PROJ, (bf16_t*)(ws + OFF_WIN) + (size_t)l * PROJ * 1024, PROJ, (r / 36) * 64, (r % 36) * 64, 1024, (r % 36) * 64 < 1536 ? 5 : 0};
    r -= 576;
    if (r < 256) return ConvDesc{p.w_out + (size_t)l * 1024 * 1024, (bf16_t*)(ws + OFF_WOUT) + (size_t)l * 1024 * 1024, 1024, (r / 16) * 64, (r % 16) * 64, 1024, 5};
    r -= 256;
    if (r < 64) return ConvDesc{p.sh_w1 + (size_t)l * 1024 * 256, (bf16_t*)(ws + OFF_SW13) + (size_t)l * 512 * 1024, 256, (r / 4) * 64, (r % 4) * 64, 1024, 3};
    r -= 64;
    if (r < 64) return ConvDesc{p.sh_w3 + (size_t)l * 1024 * 256, (bf16_t*)(ws + OFF_SW13) + (size_t)l * 512 * 1024, 256, (r / 4) * 64, (r % 4) * 64, 1024, 4};
    r -= 64;
    if (r < 64) { const int kt = r / 16, hh = kt >> 1;
        return ConvDesc{p.sh_w2 + (size_t)l * 256 * 1024, (bf16_t*)(ws + OFF_SW2) + (size_t)(l * 2 + hh) * 1024 * 128 - hh * 128, 1024, kt * 64, (r % 16) * 64, 128, 5}; }
    r -= 64;
    return ConvDesc{p.router_w + (size_t)l * 1024 * 64, (bf16_t*)(ws + OFF_RW) + (size_t)l * 64 * 1024, 64, r * 64, 0, 1024, 0};
}
DEV ConvDesc conv_expert_desc(const Params& p, int l, int it) {
    const int e = it / 96; int r = it % 96;
    unsigned char* ws = p.ws;
    const size_t eo = (size_t)(l * 64 + e) * 1024 * 128;
    if (r < 32) return ConvDesc{p.exp_w1 + eo, (bf16_t*)(ws + OFF_W13) + (size_t)e * 256 * 1024, 128, (r / 2) * 64, (r % 2) * 64, 1024, 1};
    r -= 32;
    if (r < 32) return ConvDesc{p.exp_w3 + eo, (bf16_t*)(ws + OFF_W13) + (size_t)e * 256 * 1024, 128, (r / 2) * 64, (r % 2) * 64, 1024, 2};
    r -= 32;
    return ConvDesc{p.exp_w2 + eo, (bf16_t*)(ws + OFF_W2) + (size_t)e * 1024 * 128, 1024, (r / 16) * 64, (r % 16) * 64, 128, 5};
}
DEV void conv_run(const Params& p, int l, int first, int count, char* lds) {
    const int tid = get_tid();
    if (count <= 0) return;
    ConvDesc d = l < 0 ? conv_fixed_desc(p, first) : conv_expert_desc(p, l, first);
    f32x4 v[4]; conv_load(d, v, tid);
#pragma unroll 1
    for (int i = 0; i < count; ++i) {
        ConvDesc dn = d; f32x4 vn[4];
        if (i + 1 < count) { dn = l < 0 ? conv_fixed_desc(p, first + i + 1) : conv_expert_desc(p, l, first + i + 1); conv_load(dn, vn, tid); }
        else {
#pragma unroll
            for (int k = 0; k < 4; ++k) vn[k] = v[k];
        }
        conv_store(d, v, lds, tid);
        d = dn;
#pragma unroll
        for (int k = 0; k < 4; ++k) v[k] = vn[k];
    }
}
DEV void phase_prep(const Params& p, char* lds) {
    { const int t_ = get_tid(); if (blockIdx.x == 0 && t_ < 128) ((int*)(p.ws + OFF_CNT))[t_ * 64] = 0; }
    constexpr int N0 = 144, N1 = N0 + 192, N2 = N1 + 260, N3 = N2 + 768, N4 = N3 + 256;
    int* qhead = (int*)(p.ws + OFF_QUEUE) + 2 * 64;
    int* qslot = (int*)(lds + SMEM_BYTES - 256);
    for (;;) {
        __syncthreads();
        if (get_tid() == 0) *qslot = atomicAdd(qhead, 1);
        __syncthreads();
        const int it = *qslot;
        if (it >= N4) break;
        if (it < N0) prep_filter_item(p, it, lds);
        else if (it < N1) prep_mod_item(p, it - N0, lds);
        else if (it < N2) conv_run(p, -1, (it - N1) * 8, 8, lds);
        else if (it < N3) conv_run(p, 0, (it - N2) * 8, 8, lds);
        else prep_rope_item(p, it - N3);
    }
}
DEV void phase_modfin(const Params& p) {
    const float* part = (const float*)(p.ws + OFF_PART);
    float* mod = (float*)(p.ws + OFF_MOD);
    for (int idx = blockIdx.x * 256 + get_tid(); idx < 2 * 9 * 6144; idx += gridDim.x * 256) {
        const int l = idx / (9 * 6144), g = (idx / 6144) % 9, col = idx % 6144;
        float s = p.ada_b[l * 6144 + col];
        for (int k = 0; k < 32; ++k) s += part[((size_t)(k * 2 + l) * 9 + g) * 6144 + col];
        mod[idx] = s;
    }
}

DEV void row_load(const float* src, f32x4 (&v)[4], int lane) {
#pragma unroll
    for (int j = 0; j < 4; ++j) v[j] = *(const f32x4*)(src + 4 * lane + 256 * j);
}
DEV f32x4 ld_bf4(const bf16_t* p) { const u32x2 w = *(const u32x2*)p; return (f32x4){__uint_as_float(w[0] << 16), __uint_as_float(w[0] & 0xffff0000u), __uint_as_float(w[1] << 16), __uint_as_float(w[1] & 0xffff0000u)}; }
DEV void st_bf4(bf16_t* p, const f32x4& v) { *(u32x2*)p = (u32x2){pk2(v[0], v[1]), pk2(v[2], v[3])}; }
DEV void row_load_bf(const bf16_t* src, f32x4 (&v)[4], int lane) {
#pragma unroll
    for (int j = 0; j < 4; ++j) v[j] = ld_bf4(src + 4 * lane + 256 * j);
}
DEV void row_norm(f32x4 (&v)[4]) {
    float s = 0.f;
#pragma unroll
    for (int j = 0; j < 4; ++j) s += (v[j][0] + v[j][1]) + (v[j][2] + v[j][3]);
    const float mean = wave_sum(s) * (1.f / 1024.f);
    float q = 0.f;
#pragma unroll
    for (int j = 0; j < 4; ++j) { v[j] = v[j] - mean; q += (v[j][0] * v[j][0] + v[j][1] * v[j][1]) + (v[j][2] * v[j][2] + v[j][3] * v[j][3]); }
    const float rstd = 1.0f / sqrtf(wave_sum(q) * (1.f / 1024.f) + 1e-6f);
#pragma unroll
    for (int j = 0; j < 4; ++j) v[j] = v[j] * rstd;
}
DEV void row_store_mod_bf16(bf16_t* dst, const f32x4 (&v)[4], const float* shift, const float* scale, int lane) {
#pragma unroll
    for (int j = 0; j < 4; ++j) {
        const int c = 4 * lane + 256 * j;
        const f32x4 sh = *(const f32x4*)(shift + c), sc = *(const f32x4*)(scale + c);
        const f32x4 o = v[j] * (sc + 1.0f) + sh;
        *(u32x2*)(dst + c) = (u32x2){pk2(o[0], o[1]), pk2(o[2], o[3])};
    }
}
DEV void phase_lnmod0(const Params& p) {
    const int tid_ = get_tid(), lane = tid_ & 63, wid = tid_ >> 6;
    const float* mod = (const float*)(p.ws + OFF_MOD);
    bf16_t* H = (bf16_t*)(p.ws + OFF_H);
    for (int row = blockIdx.x * 4 + wid; row < NT; row += gridDim.x * 4) {
        const float* src = row < NLAT ? p.x + (size_t)row * 1024 : p.ctx + (size_t)(row - NLAT) * 1024;
        f32x4 v[4]; row_load(src, v, lane); row_norm(v);
        const float* m = mod + (size_t)mod_group(row) * 6144;
        row_store_mod_bf16(H + (size_t)row * 1024, v, m, m + 1024, lane);
    }
}

DEV void phase_inproj(const Params& p, int l, char* lds) {
    const int tid = get_tid(), lane = tid & 63, wid = tid >> 6, fr = lane & 15, fq = lane >> 4, wr = wid >> 1, wc = wid & 1;
    unsigned char* ws = p.ws;
    const bf16_t* H = (const bf16_t*)(ws + OFF_H);
    const bf16_t* W = (const bf16_t*)(ws + OFF_WIN) + (size_t)l * PROJ * 1024;
    const float* ropec = (const float*)(ws + OFF_ROPE); const float* ropes = ropec + 2048 * 32;
    const int nitems = 128 * 18 + 16 * (l == 0 ? 18 : 6);
    for (int it = blockIdx.x; it < nitems; it += gridDim.x) {
        int mt, nt;
        if (it < 2304) { mt = it / 18; nt = it % 18; }
        else { const int j = it - 2304; if (l == 0) { mt = 128 + j / 18; nt = j % 18; } else { mt = 128 + j / 6; const int q = j % 6; nt = q < 2 ? 4 + q : 6 + q; } }
        const int m0 = mt * 128, n0 = nt * 128;
        const unsigned a0 = (unsigned)m0 * 1024u + st64_off(tid), b0 = (unsigned)n0 * 1024u + st64_off(tid);
        const unsigned ao[4] = {a0, a0 + 32u * 1024u, a0 + 64u * 1024u, a0 + 96u * 1024u};
        const unsigned bo[4] = {b0, b0 + 32u * 1024u, b0 + 64u * 1024u, b0 + 96u * 1024u};
        f32x4 acc[4][4]; zero_acc<4, 4>(acc);
        const bool latent = m0 < NLAT;
        const int b = latent ? (m0 >> 11) : ((m0 - NLAT) >> 8);
        const int tbase = latent ? (m0 & 2047) : ((m0 - NLAT) & 255);
        if (nt >= 12) {
            const int rho = tid >> 3, ptok = 8 * ((rho & 15) >> 2) + 4 * (rho >> 4) + (rho & 3);
            const unsigned ap0 = (unsigned)(m0 + ptok) * 1024u + (unsigned)(((tid & 7) ^ (rho & 7)) * 8);
            const unsigned aop[4] = {ap0, ap0 + 32u * 1024u, ap0 + 64u * 1024u, ap0 + 96u * 1024u};
            gemm_core64<false>(acc, H, aop, W, bo, 1024, lds);
            bf16_t* zt = latent ? (bf16_t*)(ws + OFF_ZTL) + (size_t)b * 768 * 2048 : (bf16_t*)(ws + OFF_ZTC) + (size_t)b * 768 * 256;
            const int n = latent ? 2048 : 256;
#pragma unroll
            for (int g = 0; g < 2; ++g)
#pragma unroll
                for (int nn = 0; nn < 4; ++nn) {
                    const int ch = n0 - 1536 + wc * 64 + nn * 16 + fr, t = tbase + wr * 64 + 32 * g + 8 * fq;
                    *(u32x4*)(zt + (size_t)ch * n + t) = (u32x4){pk2(acc[2 * g][nn][0], acc[2 * g][nn][1]), pk2(acc[2 * g][nn][2], acc[2 * g][nn][3]),
                                                                 pk2(acc[2 * g + 1][nn][0], acc[2 * g + 1][nn][1]), pk2(acc[2 * g + 1][nn][2], acc[2 * g + 1][nn][3])};
                }
        } else {
            gemm_core64<true>(acc, H, ao, W, bo, 1024, lds);
            const int col0 = n0 + wc * 64;
            int kind, hh;
            if (col0 < 512) { kind = 0; hh = col0 >> 6; } else if (col0 < 640) { kind = 1; hh = (col0 - 512) >> 6; } else if (col0 < 768) { kind = 2; hh = (col0 - 640) >> 6; }
            else if (col0 < 1024) { kind = 3; hh = (col0 - 768) >> 6; } else if (col0 < 1280) { kind = 4; hh = (col0 - 1024) >> 6; } else { kind = 5; hh = (col0 - 1280) >> 6; }
            const bool normed = (kind == 0 || kind == 1);
            const float* gain = (kind == 0 ? p.q_gain : p.k_gain) + l * 64;
#pragma unroll
            for (int m = 0; m < 4; ++m) {
                const int rloc = wr * 64 + m * 16 + fr, row = m0 + rloc, t = tbase + rloc;
                f32x4 v[4];
#pragma unroll
                for (int nn = 0; nn < 4; ++nn) v[nn] = acc[m][nn];
                if (normed) {
                    float ss = 0.f;
#pragma unroll
                    for (int nn = 0; nn < 4; ++nn) ss += (v[nn][0] * v[nn][0] + v[nn][1] * v[nn][1]) + (v[nn][2] * v[nn][2] + v[nn][3] * v[nn][3]);
                    ss += __shfl_xor(ss, 16); ss += __shfl_xor(ss, 32);
                    const float r = 1.0f / sqrtf(ss * (1.f / 64.f) + 1e-6f);
#pragma unroll
                    for (int nn = 0; nn < 4; ++nn) {
                        const int hc = 32 * (nn >> 1) + 8 * fq + 4 * (nn & 1);
                        const f32x4 g = *(const f32x4*)(gain + hc);
                        v[nn] = v[nn] * r * g;
                        if (latent) {
                            const int pi = hc >> 1;
                            const float c0 = ropec[t * 32 + pi], s0 = ropes[t * 32 + pi], c1 = ropec[t * 32 + pi + 1], s1 = ropes[t * 32 + pi + 1];
                            const float x0 = v[nn][0], x1 = v[nn][1], x2 = v[nn][2], x3 = v[nn][3];
                            v[nn][0] = x0 * c0 - x1 * s0; v[nn][1] = x0 * s0 + x1 * c0;
                            v[nn][2] = x2 * c1 - x3 * s1; v[nn][3] = x2 * s1 + x3 * c1;
                        }
                    }
                }
                if (kind == 0 || kind == 3) {
#pragma unroll
                    for (int nn = 0; nn < 4; ++nn) v[nn] = v[nn] * (0.125f * LOG2E);
                }
                bf16_t* dst;
                const int key = latent ? 256 + t : t;
                if (kind == 0) dst = (bf16_t*)(ws + OFF_QA) + ((size_t)hh * NT + row) * 64;
                else if (kind == 3) dst = (bf16_t*)(ws + OFF_QB) + ((size_t)hh * NT + row) * 64;
                else if (kind == 1) dst = (bf16_t*)(ws + OFF_KA) + ((size_t)(b * 2 + hh) * KEYS + key) * 64;
                else if (kind == 2) dst = (bf16_t*)(ws + OFF_VA) + ((size_t)(b * 2 + hh) * KEYS + key) * 64;
                else if (kind == 4) dst = (bf16_t*)(ws + OFF_KB) + ((size_t)(b * 4 + hh) * KEYS + key) * 64;
                else dst = (bf16_t*)(ws + OFF_VB) + ((size_t)(b * 4 + hh) * KEYS + key) * 64;
#pragma unroll
                for (int gg = 0; gg < 2; ++gg) *(u32x4*)(dst + 32 * gg + 8 * fq) = (u32x4){pk2(v[2 * gg][0], v[2 * gg][1]), pk2(v[2 * gg][2], v[2 * gg][3]), pk2(v[2 * gg + 1][0], v[2 * gg + 1][1]), pk2(v[2 * gg + 1][2], v[2 * gg + 1][3])};
            }
        }
    }
}

template <int NQT, bool NA>
DEV void attn_block(const bf16_t* Qh, int qrow0, const bf16_t* Kh, const bf16_t* Vh, int ntiles, bf16_t* outp  ,
                    int na_r, int na_rs, int nwin, const float* rpb_h, char* lds) {
    const int tid = get_tid(), lane = tid & 63, wid = tid >> 6, fr = lane & 15, fq = lane >> 4;
    char* KBUF = lds;
    char* VBUF = lds + 16384;
    float* BIAS = (float*)(lds + 32768);
    if (NA) {
        for (int i = tid; i < 15 * 32; i += 256) { const int dr = i >> 5, dc = i & 31; BIAS[i] = dc < 31 ? rpb_h[dr * 31 + dc] * LOG2E : 0.f; }
    }
    bf16x8 qf[NQT][2];
    const int qw = qrow0 + wid * 16 * NQT;
#pragma unroll
    for (int nq = 0; nq < NQT; ++nq)
#pragma unroll
        for (int ks = 0; ks < 2; ++ks) qf[nq][ks] = *(const bf16x8*)(Qh + (size_t)(qw + nq * 16 + fr) * 64 + ks * 32 + fq * 8);
    f32x4 oacc[4][NQT], lacc[NQT];
    float mrun[NQT];
    const bf16x8 ones = (bf16x8){0x3F80, 0x3F80, 0x3F80, 0x3F80, 0x3F80, 0x3F80, 0x3F80, 0x3F80};
#pragma unroll
    for (int nq = 0; nq < NQT; ++nq) { mrun[nq] = 0.f; lacc[nq] = (f32x4){0.f, 0.f, 0.f, 0.f};
#pragma unroll
        for (int dt = 0; dt < 4; ++dt) oacc[dt][nq] = (f32x4){0.f, 0.f, 0.f, 0.f}; }
    const int lrow0 = tid >> 3, lch = tid & 7;
    auto key0_of = [&](int ti) -> int { if (NA) return ti < nwin ? 256 + (na_rs + ti) * 64 : (ti - nwin) * 64; return ti * 64; };
    u32x4 kreg[2], vreg[2];
    auto gload = [&](int ti) {
        const int k0 = key0_of(ti);
#pragma unroll
        for (int i = 0; i < 2; ++i) {
            const int row = lrow0 + 32 * i;
            kreg[i] = *(const u32x4*)(Kh + (size_t)(k0 + row) * 64 + lch * 8);
            vreg[i] = *(const u32x4*)(Vh + (size_t)(k0 + row) * 64 + lch * 8);
        }
    };
    auto lstore = [&](int buf) {
#pragma unroll
        for (int i = 0; i < 2; ++i) {
            const int row = lrow0 + 32 * i;
            const int off = buf * 8192 + row * 128 + ((lch ^ (row & 7)) * 16);
            *(u32x4*)(KBUF + off) = kreg[i];
            *(u32x4*)(VBUF + off) = vreg[i];
        }
    };
    gload(0); lstore(0);
    __syncthreads();
    for (int ti = 0; ti < ntiles; ++ti) {
        const int buf = ti & 1;
        if (ti + 1 < ntiles) gload(ti + 1);
        const char* kb = KBUF + buf * 8192; const char* vb = VBUF + buf * 8192;
        f32x4 sacc[4][NQT];
        __builtin_amdgcn_s_setprio(1);
#pragma unroll
        for (int mt = 0; mt < 4; ++mt) {
            const int row = mt * 16 + fr;
            bf16x8 kf0 = *(const bf16x8*)(kb + row * 128 + (((0 + fq) ^ (row & 7)) * 16));
            bf16x8 kf1 = *(const bf16x8*)(kb + row * 128 + (((4 + fq) ^ (row & 7)) * 16));
#pragma unroll
            for (int nq = 0; nq < NQT; ++nq) {
                f32x4 s = (f32x4){-mrun[nq], -mrun[nq], -mrun[nq], -mrun[nq]};
                s = mfma16(kf0, qf[nq][0], s);
                s = mfma16(kf1, qf[nq][1], s);
                sacc[mt][nq] = s;
            }
        }
        __builtin_amdgcn_s_setprio(0);
        bf16x8 pf[2][NQT];
#pragma unroll
        for (int nq = 0; nq < NQT; ++nq) {
            float tv[4][4];
            float tmax = -1e30f;
            if (NA && ti < nwin) {
                const int qc = (wid & 1) * 32 + nq * 16 + fr;
                int cs = qc - 8; cs = cs < 0 ? 0 : (cs > 48 ? 48 : cs);
                const int qrow = na_r + (wid >> 1);
                int rsq = qrow - 4; rsq = rsq < 0 ? 0 : (rsq > 24 ? 24 : rsq);
                const int krow = na_rs + ti;
                const bool rowok = (krow >= rsq) && (krow < rsq + 8);
                int dr = krow - qrow + 7; dr = dr < 0 ? 0 : (dr > 14 ? 14 : dr);
#pragma unroll
                for (int mt = 0; mt < 4; ++mt)
#pragma unroll
                    for (int j = 0; j < 4; ++j) {
                        const int kc = mt * 16 + 4 * fq + j;
                        const bool ok = rowok && (kc >= cs) && (kc < cs + 16);
                        int dc = kc - qc + 15; dc = dc < 0 ? 0 : (dc > 30 ? 30 : dc);
                        tv[mt][j] = ok ? sacc[mt][nq][j] + BIAS[dr * 32 + dc] : -1e30f;
                        tmax = fmaxf(tmax, tv[mt][j]);
                    }
            } else {
#pragma unroll
                for (int mt = 0; mt < 4; ++mt) {
#pragma unroll
                    for (int j = 0; j < 4; ++j) tv[mt][j] = sacc[mt][nq][j];
                    tmax = fmaxf(fmaxf(tmax, tv[mt][0]), tv[mt][1]); tmax = fmaxf(fmaxf(tmax, tv[mt][2]), tv[mt][3]);
                }
            }
            if (__any(tmax > 8.0f)) {
                tmax = fmaxf(tmax, __shfl_xor(tmax, 16)); tmax = fmaxf(tmax, __shfl_xor(tmax, 32));
                const float dlt = fmaxf(tmax, 0.f);
                const float alpha = __builtin_amdgcn_exp2f(-dlt);
                mrun[nq] += dlt;
                lacc[nq] = lacc[nq] * alpha;
#pragma unroll
                for (int dt = 0; dt < 4; ++dt) oacc[dt][nq] = oacc[dt][nq] * alpha;
#pragma unroll
                for (int mt = 0; mt < 4; ++mt)
#pragma unroll
                    for (int j = 0; j < 4; ++j) tv[mt][j] -= dlt;
            }
#pragma unroll
            for (int mt = 0; mt < 4; ++mt)
#pragma unroll
                for (int j = 0; j < 4; ++j) tv[mt][j] = __builtin_amdgcn_exp2f(tv[mt][j]);
#pragma unroll
            for (int ks = 0; ks < 2; ++ks) {
                union { bf16x8 v; unsigned u[4]; } pk;
                pk.u[0] = pk2(tv[2 * ks][0], tv[2 * ks][1]); pk.u[1] = pk2(tv[2 * ks][2], tv[2 * ks][3]);
                pk.u[2] = pk2(tv[2 * ks + 1][0], tv[2 * ks + 1][1]); pk.u[3] = pk2(tv[2 * ks + 1][2], tv[2 * ks + 1][3]);
                pf[ks][nq] = pk.v;
                lacc[nq] = mfma16(ones, pk.v, lacc[nq]);
            }
        }
        {
            const int q4 = fr >> 2, p4 = fr & 3;
#pragma unroll
            for (int ks = 0; ks < 2; ++ks)
#pragma unroll
                for (int dt = 0; dt < 4; ++dt) {
                    const int keyA = 16 * (2 * ks) + 4 * fq + q4, keyB = keyA + 16;
                    const int ch = 4 * (dt >> 1) + p4;
                    const int offA = keyA * 128 + ((ch ^ (keyA & 7)) * 16) + (dt & 1) * 8;
                    const int offB = keyB * 128 + ((ch ^ (keyB & 7)) * 16) + (dt & 1) * 8;
                    const s16x4 ta = __builtin_amdgcn_ds_read_tr16_b64_v4i16((LDSP(s16x4))(vb + offA));
                    const s16x4 tb = __builtin_amdgcn_ds_read_tr16_b64_v4i16((LDSP(s16x4))(vb + offB));
                    bf16x8 vf; vf[0] = ta[0]; vf[1] = ta[1]; vf[2] = ta[2]; vf[3] = ta[3]; vf[4] = tb[0]; vf[5] = tb[1]; vf[6] = tb[2]; vf[7] = tb[3];
#pragma unroll
                    for (int nq = 0; nq < NQT; ++nq) oacc[dt][nq] = mfma16(vf, pf[ks][nq], oacc[dt][nq]);
                }
        }
        if (ti + 1 < ntiles) lstore(buf ^ 1);
        __syncthreads();
    }
#pragma unroll
    for (int nq = 0; nq < NQT; ++nq) {
        const float inv = 1.0f / lacc[nq][0];
        bf16_t* o = outp + (size_t)(qw + nq * 16 + fr) * 1024;
#pragma unroll
        for (int g = 0; g < 2; ++g) {
            const f32x4 v0 = oacc[2 * g][nq] * inv, v1 = oacc[2 * g + 1][nq] * inv;
            *(u32x4*)(o + g * 32 + 8 * fq) = (u32x4){pk2(v0[0], v0[1]), pk2(v0[2], v0[3]), pk2(v1[0], v1[1]), pk2(v1[2], v1[3])};
        }
    }
    __syncthreads();
}

DEV float hy_sconv(const bf16_t* zrow, int t, int n, float w0, float w1, float w2, float bias) {
    const float zm = t > 0 ? bf2f(zrow[t - 1]) : 0.f, z0 = bf2f(zrow[t]), zp = t + 1 < n ? bf2f(zrow[t + 1]) : 0.f;
    return w0 * zm + w1 * z0 + w2 * zp + bias;
}
template <int NJ>
DEV void hyena_item(const Params& p, int l, int type, int c, int bh, char* lds) {
    constexpr int n = 256 * NJ;
    const int tid = get_tid();
    f32x4* U = (f32x4*)lds;
    float* KR = (float*)(lds + n * 16);
    const bf16_t* zt = type ? (const bf16_t*)(p.ws + OFF_ZTC) : (const bf16_t*)(p.ws + OFF_ZTL);
    const bf16_t* kf = (const bf16_t*)(p.ws + (type ? OFF_KERNC + (size_t)l * 2 * 256 * 256 * 2 : OFF_KERNL + (size_t)l * 2 * 256 * 2048 * 2)) + (size_t)c * n;
    const bf16_t* kb = kf + (size_t)256 * n;
    const float* cw = p.hy_conv_w + l * 3 * 768; const float* cb = p.hy_conv_b + l * 768;
    const float w10 = cw[256 + c], w11 = cw[768 + 256 + c], w12 = cw[1536 + 256 + c], b1 = cb[256 + c];
    const float wv0 = cw[512 + c], wv1 = cw[768 + 512 + c], wv2 = cw[1536 + 512 + c], bv = cb[512 + c];
    const float w00 = cw[c], w01 = cw[768 + c], w02 = cw[1536 + c], b0 = cb[c];
    for (int i = tid; i < 2 * n - 1; i += 256) { const int d = i - (n - 1); KR[i] = bf2f(d >= 0 ? kf[d] : kb[-d]); }
    for (int s = tid; s < n; s += 256) {
        f32x4 u;
#pragma unroll
        for (int bb = 0; bb < 4; ++bb) {
            const bf16_t* zb = zt + (size_t)(bh * 4 + bb) * 768 * n;
            const float x1 = hy_sconv(zb + (size_t)(256 + c) * n, s, n, w10, w11, w12, b1);
            const float vv = hy_sconv(zb + (size_t)(512 + c) * n, s, n, wv0, wv1, wv2, bv);
            u[bb] = vv * x1;
        }
        U[s] = u;
    }
    __syncthreads();
    f32x4 acc[NJ];
#pragma unroll
    for (int j = 0; j < NJ; ++j) acc[j] = (f32x4){0.f, 0.f, 0.f, 0.f};
    const float* kp = KR + tid + (n - 1);
    for (int s = 0; s < n; ++s) {
        const f32x4 u = U[s];
#pragma unroll
        for (int j = 0; j < NJ; ++j) acc[j] += u * kp[256 * j - s];
    }
    bf16_t* ox = (bf16_t*)(p.ws + OFF_OX);
#pragma unroll
    for (int j = 0; j < NJ; ++j) {
        const int t = tid + 256 * j;
#pragma unroll
        for (int bb = 0; bb < 4; ++bb) {
            const int b = bh * 4 + bb;
            const bf16_t* zb = zt + (size_t)b * 768 * n;
            const float x0 = hy_sconv(zb + (size_t)c * n, t, n, w00, w01, w02, b0);
            const float y = acc[j][bb] * x0;
            const int row = type ? NLAT + b * 256 + t : b * 2048 + t;
            ox[(size_t)row * 1024 + 768 + c] = (bf16_t)f2bf(y);
        }
    }
    __syncthreads();
}


typedef float f32x16 __attribute__((ext_vector_type(16)));
constexpr int HY_UROW = 2256;
constexpr int HY_KC_OFF = 8 * HY_UROW * 2;
constexpr int HY_KC_STRIDE = 8192 + 64;
DEV float hy_sc8(const bf16_t* zrow, int s0, int n, float w0, float w1, float w2, float bias, float (&o)[8]) {
    const u32x4 v = *(const u32x4*)(zrow + s0);
    const float zm = s0 > 0 ? bf2f(zrow[s0 - 1]) : 0.f, zp = s0 + 8 < n ? bf2f(zrow[s0 + 8]) : 0.f;
    float z[10]; z[0] = zm; z[9] = zp;
#pragma unroll
    for (int i = 0; i < 4; ++i) { z[1 + 2 * i] = __uint_as_float(v[i] << 16); z[2 + 2 * i] = __uint_as_float(v[i] & 0xffff0000u); }
#pragma unroll
    for (int i = 0; i < 8; ++i) o[i] = w0 * z[i] + w1 * z[i + 1] + w2 * z[i + 2] + bias;
    return 0.f;
}
DEV void hyena_mfma_item(const Params& p, int l, int c, char* lds) {
    const int tid = get_tid(), lane = tid & 63, wid = tid >> 6;
    constexpr int n = 2048;
    const bf16_t* zt = (const bf16_t*)(p.ws + OFF_ZTL);
    const bf16_t* kf = (const bf16_t*)(p.ws + OFF_KERNL + (size_t)l * 2 * 256 * 2048 * 2) + (size_t)c * n;
    const bf16_t* kb = kf + (size_t)256 * n;
    const float* cw = p.hy_conv_w + l * 3 * 768; const float* cb = p.hy_conv_b + l * 768;
    const float w10 = cw[256 + c], w11 = cw[768 + 256 + c], w12 = cw[1536 + 256 + c], b1 = cb[256 + c];
    const float wv0 = cw[512 + c], wv1 = cw[768 + 512 + c], wv2 = cw[1536 + 512 + c], bv = cb[512 + c];
    const float w00 = cw[c], w01 = cw[768 + c], w02 = cw[1536 + c], b0 = cb[c];
    for (int i = tid; i < 8 * 26; i += 256) {
        const int b = i / 26, k = i % 26;
        const int sp = k < 12 ? k * 8 : 96 + 2048 + (k - 12) * 8;
        *(u32x4*)(lds + (b * HY_UROW + sp) * 2) = (u32x4){0u, 0u, 0u, 0u};
    }
#pragma unroll 4
    for (int ch = tid; ch < 8 * 256; ch += 256) {
        const int b = ch >> 8, s0 = (ch & 255) * 8;
        const bf16_t* zb = zt + (size_t)b * 768 * n;
        float x1[8], vv[8];
        hy_sc8(zb + (size_t)(256 + c) * n, s0, n, w10, w11, w12, b1, x1);
        hy_sc8(zb + (size_t)(512 + c) * n, s0, n, wv0, wv1, wv2, bv, vv);
        *(u32x4*)(lds + (b * HY_UROW + 96 + s0) * 2) = (u32x4){pk2(vv[0] * x1[0], vv[1] * x1[1]), pk2(vv[2] * x1[2], vv[3] * x1[3]), pk2(vv[4] * x1[4], vv[5] * x1[5]), pk2(vv[6] * x1[6], vv[7] * x1[7])};
    }
    {
        char* R0 = lds + HY_KC_OFF;
#pragma unroll
        for (int j = 0; j < 2; ++j) {
            const int chn = tid + 256 * j;
            const bool fwd = chn < 256; const int d0 = (chn & 255) * 8;
            const u32x4 v = *(const u32x4*)((fwd ? kf : kb) + d0);
#pragma unroll
            for (int e = 0; e < 8; ++e) {
                const int d = d0 + e;
                const bf16_t val = (bf16_t)((e & 1) ? (v[e >> 1] >> 16) : (v[e >> 1] & 0xffffu));
                const int y = fwd ? 2047 - d : 2047 + d;
                if (fwd || d > 0) *(bf16_t*)(R0 + y * 2) = val;
            }
        }
        if (tid == 0) *(bf16_t*)(R0 + 4095 * 2) = 0;
    }
    __syncthreads();
    {
        const char* R0 = lds + HY_KC_OFF;
        for (int i = tid; i < 3 * 1024; i += 256) {
            const int q = 1 + i / 1024, y = (i % 1024) * 4;
            unsigned short e[4];
#pragma unroll
            for (int k = 0; k < 4; ++k) { const int yy = y + q + k; e[k] = yy <= 4094 ? *(const bf16_t*)(R0 + yy * 2) : (bf16_t)0; }
            *(u32x2*)(lds + HY_KC_OFF + q * HY_KC_STRIDE + y * 2) = (u32x2){(unsigned)e[0] | ((unsigned)e[1] << 16), (unsigned)e[2] | ((unsigned)e[3] << 16)};
        }
    }
    __syncthreads();
    const int i32 = lane & 31, h = lane >> 5, qn = i32 >> 3, bn = i32 & 7;
    const int T0 = 512 * wid;
    f32x16 acc[4];
#pragma unroll
    for (int g = 0; g < 4; ++g)
#pragma unroll
        for (int r = 0; r < 16; ++r) acc[g][r] = 0.f;
    const int dlo = T0 - 2032, dhi = T0 + 384 + 96;
    {
        const int a0 = 2047 - dlo - i32 + 8 * h, q4 = a0 & 3;
        const char* ap = lds + HY_KC_OFF + q4 * HY_KC_STRIDE + (a0 - q4) * 2;
        const char* bp = lds + (bn * HY_UROW + 96 + (T0 - dlo) + 32 * qn + 8 * h) * 2;
        for (int dl = dlo; dl <= dhi; dl += 16) {
            union { bf16x8 v; u32x2 u[2]; } af;
            af.u[0] = *(const u32x2*)ap; af.u[1] = *(const u32x2*)(ap + 8);
#pragma unroll
            for (int g = 0; g < 4; ++g) {
                const int S = T0 + 128 * g - dl;
                if (S >= -96 && S <= 2032) {
                    const bf16x8 bfv = *(const bf16x8*)(bp + 256 * g);
                    acc[g] = __builtin_amdgcn_mfma_f32_32x32x16_bf16(af.v, bfv, acc[g], 0, 0, 0);
                }
            }
            ap -= 32; bp -= 32;
        }
    }
    __syncthreads();
#pragma unroll 4
    for (int ch = tid; ch < 8 * 256; ch += 256) {
        const int b = ch >> 8, s0 = (ch & 255) * 8;
        float x0[8];
        hy_sc8(zt + (size_t)b * 768 * n + (size_t)c * n, s0, n, w00, w01, w02, b0, x0);
        *(u32x4*)(lds + HY_KC_OFF + (b * 2048 + s0) * 2) = (u32x4){pk2(x0[0], x0[1]), pk2(x0[2], x0[3]), pk2(x0[4], x0[5]), pk2(x0[6], x0[7])};
    }
    __syncthreads();
    bf16_t* oxt = (bf16_t*)(p.ws + OFF_OXT) + (size_t)c * 2048;
#pragma unroll
    for (int g = 0; g < 4; ++g)
#pragma unroll
        for (int r4 = 0; r4 < 4; ++r4) {
            const int t = T0 + 128 * g + 32 * qn + 8 * r4 + 4 * h;
            const u32x2 xg = *(const u32x2*)(lds + HY_KC_OFF + (bn * 2048 + t) * 2);
            const float g0 = __uint_as_float(xg[0] << 16), g1 = __uint_as_float(xg[0] & 0xffff0000u), g2 = __uint_as_float(xg[1] << 16), g3 = __uint_as_float(xg[1] & 0xffff0000u);
            *(u32x2*)(oxt + (size_t)bn * 256 * 2048 + t) = (u32x2){pk2(acc[g][4 * r4 + 0] * g0, acc[g][4 * r4 + 1] * g1), pk2(acc[g][4 * r4 + 2] * g2, acc[g][4 * r4 + 3] * g3)};
        }
    __syncthreads();
}

DEV void phase_mix(const Params& p, int l, char* lds) {
    unsigned char* ws = p.ws;
    const bf16_t* QA = (const bf16_t*)(ws + OFF_QA); const bf16_t* QB = (const bf16_t*)(ws + OFF_QB);
    const bf16_t* KA = (const bf16_t*)(ws + OFF_KA); const bf16_t* VA = (const bf16_t*)(ws + OFF_VA);
    const bf16_t* KBp = (const bf16_t*)(ws + OFF_KB); const bf16_t* VBp = (const bf16_t*)(ws + OFF_VB);
    bf16_t* OX = (bf16_t*)(ws + OFF_OX);
    const int N0 = 256, N1 = N0 + 1024, N2 = N1 + 512;
    const int N3 = N2 + (l == 0 ? 512 : 0), N4 = N3 + (l == 0 ? 128 : 0), N5 = N4 + (l == 0 ? 64 : 0);
    int* qhead = (int*)(p.ws + OFF_QUEUE) + l * 64;
    int* qslot = (int*)(lds + SMEM_BYTES - 256);
    for (;;) {
        __syncthreads();
        if (get_tid() == 0) *qslot = atomicAdd(qhead, 1);
        __syncthreads();
        const int it = *qslot;
        if (it >= N5) break;
        if (it < N0) { hyena_mfma_item(p, l, it, lds); }
        else if (it < N1) {
            const int j = it - N0, b = j >> 7, h = (j >> 4) & 7, qb = j & 15;
            attn_block<2, false>(QA + (size_t)h * NT * 64, b * 2048 + qb * 128, KA + (size_t)(b * 2 + (h >> 2)) * KEYS * 64, VA + (size_t)(b * 2 + (h >> 2)) * KEYS * 64,
                                 36, OX + h * 64, 0, 0, 0, nullptr, lds);
        } else if (it < N2) {
            const int j = it - N1, b = j >> 6, h = (j >> 4) & 3, r = (j & 15) * 2;
            int rs0 = r - 4; rs0 = rs0 < 0 ? 0 : (rs0 > 24 ? 24 : rs0);
            int rs1 = r - 3; rs1 = rs1 < 0 ? 0 : (rs1 > 24 ? 24 : rs1);
            const int nwin = rs1 + 8 - rs0;
            attn_block<2, true>(QB + (size_t)h * NT * 64, b * 2048 + r * 64, KBp + (size_t)(b * 4 + h) * KEYS * 64, VBp + (size_t)(b * 4 + h) * KEYS * 64,
                                nwin + 4, OX + 512 + h * 64, r, rs0, nwin, p.nat_rpb + (size_t)(l * 4 + h) * 15 * 31, lds);
        } else if (it < N3) { const int j = it - N2; hyena_item<1>(p, l, 1, j >> 1, j & 1, lds); }
        else if (it < N4) {
            const int j = it - N3, b = j >> 4, h = (j >> 1) & 7, qb = j & 1;
            attn_block<2, false>(QA + (size_t)h * NT * 64, NLAT + b * 256 + qb * 128, KA + (size_t)(b * 2 + (h >> 2)) * KEYS * 64, VA + (size_t)(b * 2 + (h >> 2)) * KEYS * 64,
                                 4, OX + h * 64, 0, 0, 0, nullptr, lds);
        } else {
            const int j = it - N4, b = j >> 3, h = (j >> 1) & 3, qb = j & 1;
            attn_block<2, false>(QB + (size_t)h * NT * 64, NLAT + b * 256 + qb * 128, KBp + (size_t)(b * 4 + h) * KEYS * 64, VBp + (size_t)(b * 4 + h) * KEYS * 64,
                                 4, OX + 512 + h * 64, 0, 0, 0, nullptr, lds);
        }
    }
}

DEV void phase_outproj(const Params& p, int l, char* lds) {
    const int tid = get_tid(), lane = tid & 63, wid = tid >> 6, fr = lane & 15, fq = lane >> 4, wr = wid >> 1, wc = wid & 1;
    const bf16_t* OX = (const bf16_t*)(p.ws + OFF_OX);
    const bf16_t* W = (const bf16_t*)(p.ws + OFF_WOUT) + (size_t)l * 1024 * 1024;
    const float* mod = (const float*)(p.ws + OFF_MOD) + (size_t)l * 9 * 6144;
    bf16_t* X = (bf16_t*)(p.ws + OFF_X);
    const int nitems = (l == 0 ? 144 : 128) * 8;
    for (int it = blockIdx.x; it < nitems; it += gridDim.x) {
        const int mt = it >> 3, nt = it & 7, m0 = mt * 128, n0 = nt * 128;
        const unsigned a0 = (unsigned)m0 * 1024u + st64_off(tid), b0 = (unsigned)n0 * 1024u + st64_off(tid);
        f32x4 acc[4][4]; zero_acc<4, 4>(acc);
        const unsigned ao[4] = {a0, a0 + 32u * 1024u, a0 + 64u * 1024u, a0 + 96u * 1024u};
        const unsigned bo[4] = {b0, b0 + 32u * 1024u, b0 + 64u * 1024u, b0 + 96u * 1024u};
        if (m0 < NLAT) gemm_core64<true>(acc, OX, ao, W, bo, 1024, lds, (const bf16_t*)(p.ws + OFF_OXT) + (size_t)(m0 >> 11) * 256 * 2048 + (m0 & 2047), 12);
        else gemm_core64<true>(acc, OX, ao, W, bo, 1024, lds);
        const float* g1 = mod + (size_t)mod_group(m0) * 6144 + 2048;
#pragma unroll
        for (int m = 0; m < 4; ++m) {
            const int row = m0 + wr * 64 + m * 16 + fr;
            const float* xin = row < NLAT ? p.x + (size_t)row * 1024 : p.ctx + (size_t)(row - NLAT) * 1024;
#pragma unroll
            for (int gg = 0; gg < 2; ++gg) {
                const int col = n0 + wc * 64 + gg * 32 + 8 * fq;
                f32x4 x0, x1;
                if (l == 0) { x0 = *(const f32x4*)(xin + col); x1 = *(const f32x4*)(xin + col + 4); }
                else { const u32x4 w = *(const u32x4*)(X + (size_t)row * 1024 + col);
                       x0 = (f32x4){__uint_as_float(w[0] << 16), __uint_as_float(w[0] & 0xffff0000u), __uint_as_float(w[1] << 16), __uint_as_float(w[1] & 0xffff0000u)};
                       x1 = (f32x4){__uint_as_float(w[2] << 16), __uint_as_float(w[2] & 0xffff0000u), __uint_as_float(w[3] << 16), __uint_as_float(w[3] & 0xffff0000u)}; }
                const f32x4 o0 = x0 * DN_ALPHA + *(const f32x4*)(g1 + col) * acc[m][2 * gg], o1 = x1 * DN_ALPHA + *(const f32x4*)(g1 + col + 4) * acc[m][2 * gg + 1];
                *(u32x4*)(X + (size_t)row * 1024 + col) = (u32x4){pk2(o0[0], o0[1]), pk2(o0[2], o0[3]), pk2(o1[0], o1[1]), pk2(o1[2], o1[3])};
            }
        }
    }
}

DEV void phase_ln1route(const Params& p, int l, char* lds) {
    const int tid = get_tid(), lane = tid & 63, wid = tid >> 6, fr = lane & 15, fq = lane >> 4;
    bf16_t* X = (bf16_t*)(p.ws + OFF_X);
    bf16_t* H = (bf16_t*)(p.ws + OFF_H);
    const bf16_t* RW = (const bf16_t*)(p.ws + OFF_RW) + (size_t)l * 64 * 1024;
    const float* mod = (const float*)(p.ws + OFF_MOD) + (size_t)l * 9 * 6144;
    int* cnt = (int*)(p.ws + OFF_CNT) + l * 64 * 64;
    int* tke = (int*)(p.ws + OFF_TKE); int* tks = (int*)(p.ws + OFF_TKS); float* tkw = (float*)(p.ws + OFF_TKW);
    int* list = (int*)(p.ws + OFF_LIST);
    char* HT = lds;
    float* LG = (float*)(lds + 16 * 2064);
    const float rbias = p.router_b[l * 64 + lane];
    const int rpw = (l == 0) ? 3 : 4, rpi = 4 * rpw;
    const int nitems = (l == 0 ? NT : NLAT) / rpi;
    for (int it = blockIdx.x; it < nitems; it += gridDim.x) {
        const int m0 = it * rpi;
        f32x4 vv[4][4];
#pragma unroll
        for (int i = 0; i < 4; ++i) if (i < rpw) row_load_bf(X + (size_t)(m0 + wid * rpw + i) * 1024, vv[i], lane);
        f32x4 lg[4], lb[4];
#pragma unroll
        for (int j = 0; j < 4; ++j) {
            const int c = 4 * lane + 256 * j;
            lg[j] = *(const f32x4*)(p.ln1_g + l * 1024 + c); lb[j] = *(const f32x4*)(p.ln1_b + l * 1024 + c);
        }
#pragma unroll
        for (int i = 0; i < 4; ++i) if (i < rpw) {
            const int rl = wid * rpw + i, row = m0 + rl;
            const float* mg = mod + (size_t)mod_group(row) * 6144;
            f32x4 msh[4], msc[4];
#pragma unroll
            for (int j = 0; j < 4; ++j) { const int c = 4 * lane + 256 * j; msh[j] = *(const f32x4*)(mg + 3072 + c); msc[j] = *(const f32x4*)(mg + 4096 + c) + 1.0f; }
            row_norm(vv[i]);
#pragma unroll
            for (int j = 0; j < 4; ++j) {
                const int c = 4 * lane + 256 * j;
                vv[i][j] = vv[i][j] * lg[j] + lb[j];
                st_bf4(X + (size_t)row * 1024 + c, vv[i][j]);
            }
            row_norm(vv[i]);
#pragma unroll
            for (int j = 0; j < 4; ++j) {
                const int c = 4 * lane + 256 * j;
                const f32x4 o = vv[i][j] * msc[j] + msh[j];
                const u32x2 w = (u32x2){pk2(o[0], o[1]), pk2(o[2], o[3])};
                *(u32x2*)(H + (size_t)row * 1024 + c) = w;
                *(u32x2*)(HT + rl * 2064 + c * 2) = w;
            }
        }
        __syncthreads();
        f32x4 acc = (f32x4){0.f, 0.f, 0.f, 0.f};
        const bf16_t* bp = RW + (size_t)(wid * 16 + fr) * 1024 + fq * 8;
#pragma unroll 8
        for (int ks = 0; ks < 32; ++ks) {
            const bf16x8 bq = *(const bf16x8*)(bp + ks * 32);
            const bf16x8 af = *(const bf16x8*)(HT + fr * 2064 + (ks * 32 + fq * 8) * 2);
            acc = mfma16(bq, af, acc);
        }
        *(f32x4*)(LG + fr * 64 + wid * 16 + 4 * fq) = acc;
        __syncthreads();
        int* RS = (int*)(lds + 16 * 2064 + 4096 + 2048);
        float* RWt = (float*)(lds + 16 * 2064 + 4096 + 2048 + 4096);
        int lc = 0;
        unsigned* KW = (unsigned*)(lds + 16 * 2064 + 4096 + 2048 + 8192) + wid * 160;
#pragma unroll 1
        for (int i = 0; i < rpw; ++i) {
            const int rl = wid * rpw + i;
            const float sc = 1.0f / (1.0f + __expf(-LG[rl * 64 + lane]));
            const float sel = sc + rbias;
            const int grp = lane >> 3;
            const unsigned key = (__float_as_uint(sel + 2.0f) & 0xFFFFFFC0u) | (unsigned)(63 - lane);
            KW[lane] = key;
            __builtin_amdgcn_wave_barrier();
            int rankg = 0;
            {
                const u32x4 k0 = *(const u32x4*)(KW + grp * 8), k1 = *(const u32x4*)(KW + grp * 8 + 4);
#pragma unroll
                for (int j = 0; j < 4; ++j) { rankg += (k0[j] > key) ? 1 : 0; rankg += (k1[j] > key) ? 1 : 0; }
            }
            float gs = rankg < 2 ? sel : 0.f;
            gs += __shfl_xor(gs, 1); gs += __shfl_xor(gs, 2); gs += __shfl_xor(gs, 4);
            const unsigned gkey = (__float_as_uint(gs + 4.0f) & 0xFFFFFFF8u) | (unsigned)(7 - grp);
            if ((lane & 7) == 0) KW[128 + grp] = gkey;
            __builtin_amdgcn_wave_barrier();
            int rg = 0;
            {
                const u32x4 g0 = *(const u32x4*)(KW + 128), g1 = *(const u32x4*)(KW + 132);
#pragma unroll
                for (int j = 0; j < 4; ++j) { rg += (g0[j] > gkey) ? 1 : 0; rg += (g1[j] > gkey) ? 1 : 0; }
            }
            const bool selg = rg < 4;
            const unsigned vkey = selg ? key : 0u;
            KW[64 + lane] = vkey;
            __builtin_amdgcn_wave_barrier();
            int rank = 0;
#pragma unroll
            for (int q = 0; q < 16; ++q) {
                const u32x4 kk = *(const u32x4*)(KW + 64 + q * 4);
#pragma unroll
                for (int j = 0; j < 4; ++j) rank += (kk[j] > vkey) ? 1 : 0;
            }
            const bool ch = selg && rank < 8;
            const float wsum = wave_sum(ch ? sc : 0.f);
            RS[rl * 64 + lane] = ch ? rank : -1;
            RWt[rl * 64 + lane] = sc * (2.5f / wsum);
            lc += ch ? 1 : 0;
            __builtin_amdgcn_wave_barrier();
        }
        int* WC = (int*)(lds + 16 * 2064 + 4096);
        WC[wid * 64 + lane] = lc;
        __syncthreads();
        if (wid == 0) {
            const int tot = WC[lane] + WC[64 + lane] + WC[128 + lane] + WC[192 + lane];
            int base = 0;
            if (tot > 0) base = atomicAdd(&cnt[lane * 64], tot);
            WC[256 + lane] = base;
        }
        __syncthreads();
        {
            int slot = WC[256 + lane];
#pragma unroll
            for (int w2 = 0; w2 < 4; ++w2) slot += (w2 < wid) ? WC[w2 * 64 + lane] : 0;
#pragma unroll 1
            for (int i = 0; i < rpw; ++i) {
                const int rl = wid * rpw + i, rk = RS[rl * 64 + lane];
                if (rk >= 0) {
                    const int row = m0 + rl;
                    list[(size_t)lane * NT + slot] = row * 8 + rk;
                    tke[row * 8 + rk] = lane; tks[row * 8 + rk] = slot; tkw[row * 8 + rk] = RWt[rl * 64 + lane];
                    ++slot;
                }
            }
        }
        __syncthreads();
    }
}

constexpr int YS_EXT_ROWS = NLAT * 1024 * 4 / 1024;
constexpr int PLAN_OFF = 68 * 1024;
DEV void moe_plan(const int* cnt, int cap, int l, char* lds) {
    int* PL = (int*)(lds + PLAN_OFF);
    const int tid = get_tid();
    __syncthreads();
    if (tid < 64) {
        const int lane = tid;
        const int c = cnt[lane * 64], tiles = (c + 127) >> 7;
        int pr = c, pt = tiles;
#pragma unroll
        for (int o = 1; o < 64; o <<= 1) { const int a = __shfl_up(pr, o), b = __shfl_up(pt, o); if (lane >= o) { pr += a; pt += b; } }
        const int G = (int)gridDim.x, nshu = 2 * ((l == 0 ? NT : NLAT) / 128);
        const int units = nshu + __builtin_amdgcn_readlane(pt, 63);
        const int cap8 = cap * 2;
        const bool one_round = __builtin_amdgcn_readlane(pr, 63) + nshu * 128 <= cap8;
        const int target0 = one_round ? 0 : ((units + G - 1) / G - 1) * G;
        PL[144 + lane] = c;
        int start = 0, base_r = 0, base_t = 0, round = 0;
        for (;;) {
            const int lim = (round == 0) ? ((target0 > 0) ? cap8 + YS_EXT_ROWS : cap8) - nshu * 128 : cap8;
            const bool bad = (lane >= start) && ((pr - base_r > lim) || (round == 0 && target0 > 0 && lane > 0 && nshu + pt > target0));
            const unsigned long long m = __ballot(bad);
            int end = m ? (int)__builtin_ctzll(m) : 64;
            if (end <= start) end = start + 1;
            if (lane >= start && lane < end) { PL[16 + lane] = pt - tiles - base_t; PL[80 + lane] = pr - c - base_r; }
            if (lane == 0) { PL[1 + round] = start; PL[10 + round] = __builtin_amdgcn_readlane(pt, end - 1) - base_t; PL[208 + round] = __builtin_amdgcn_readlane(pr, end - 1) - base_r; }
            if (end >= 64 || round >= 7) { if (lane == 0) { PL[0] = round + 1; PL[2 + round] = 64; } break; }
            base_r = __builtin_amdgcn_readlane(pr, end - 1); base_t = __builtin_amdgcn_readlane(pt, end - 1);
            start = end; ++round;
        }
    }
    __syncthreads();
}
constexpr float YS_SCALE = 32.0f, YS_INV = 1.0f / 32.0f;
DEV unsigned char* ys_row(const Params& p, int idx) {
    const int cap8 = p.cap * 2;
    return idx < cap8 ? p.ws + OFF_YS + (size_t)idx * 1024 : (unsigned char*)p.out + (size_t)(idx - cap8) * 1024;
}
DEV unsigned pk4_fp8(const f32x4& v) {
    int w = 0;
    w = __builtin_amdgcn_cvt_pk_fp8_f32(v[0] * YS_SCALE, v[1] * YS_SCALE, w, false);
    w = __builtin_amdgcn_cvt_pk_fp8_f32(v[2] * YS_SCALE, v[3] * YS_SCALE, w, true);
    return (unsigned)w;
}
DEV f32x4 up4_fp8(unsigned w) {
    const f32x2 lo = __builtin_amdgcn_cvt_pk_f32_fp8((int)w, false), hi = __builtin_amdgcn_cvt_pk_f32_fp8((int)w, true);
    return (f32x4){lo[0], lo[1], hi[0], hi[1]};
}

template <bool SHARED>
DEV void moe_tile(const Params& p, const bf16_t* W13, const bf16_t* W2, const int* list, int s0, int nvalid, int ysbase, int m0, int half, const float* g2, char* lds) {
    const int tid = get_tid(), lane = tid & 63, wid = tid >> 6, fr = lane & 15, fq = lane >> 4, wr = wid >> 1, wc = wid & 1;
    const bf16_t* H = (const bf16_t*)(p.ws + OFF_H);
    const float* tkw = (const float*)(p.ws + OFF_TKW);
    char* ACT = lds;
    const unsigned ch8 = (unsigned)(((tid & 7) ^ ((tid >> 3) & 7)) * 8);
    unsigned ao[4];
    float gw[4];
    if (SHARED) {
#pragma unroll
        for (int i = 0; i < 4; ++i) ao[i] = (unsigned)(m0 + i * 32 + (tid >> 3)) * 1024u + ch8;
#pragma unroll
        for (int m = 0; m < 4; ++m) gw[m] = 1.0f;
    } else {
#pragma unroll
        for (int i = 0; i < 4; ++i) { const int rr = min(i * 32 + (tid >> 3), nvalid - 1); ao[i] = (unsigned)(list[s0 + rr] >> 3) * 1024u + ch8; }
#pragma unroll
        for (int m = 0; m < 4; ++m) { const int rl = min(wr * 64 + m * 16 + fr, nvalid - 1); gw[m] = tkw[list[s0 + rl]]; }
    }
    u32x2 areg[2][4][2];
#pragma unroll
    for (int np = 0; np < 2; ++np) {
        const unsigned b0 = (unsigned)(np * 128) * 1024u + st64_off(tid);
        const unsigned bo[4] = {b0, b0 + 32u * 1024u, b0 + 64u * 1024u, b0 + 96u * 1024u};
        const unsigned aoc[4] = {ao[0], ao[1], ao[2], ao[3]};
        f32x4 acc[4][4]; zero_acc<4, 4>(acc);
        gemm_core64<true>(acc, H, aoc, W13, bo, 1024, lds);
#pragma unroll
        for (int m = 0; m < 4; ++m)
#pragma unroll
            for (int pi = 0; pi < 2; ++pi) {
                float o[4];
#pragma unroll
                for (int j = 0; j < 4; ++j) { const float a = acc[m][2 * pi][j], b = acc[m][2 * pi + 1][j]; o[j] = a / (1.0f + __expf(-a)) * b * gw[m]; }
                areg[np][m][pi] = (u32x2){pk2(o[0], o[1]), pk2(o[2], o[3])};
            }
    }
    __syncthreads();
#pragma unroll
    for (int np = 0; np < 2; ++np)
#pragma unroll
        for (int m = 0; m < 4; ++m)
#pragma unroll
            for (int pi = 0; pi < 2; ++pi) *(u32x2*)(ACT + (wr * 64 + m * 16 + fr) * 272 + (np * 64 + wc * 32 + pi * 16 + 4 * fq) * 2) = areg[np][m][pi];
    __syncthreads();
    if (SHARED) {
        gemm2_stream64<128, 272>(W2, ACT, lds + 36864, [&](int nt, const f32x4 (&acc)[4][4]) {
#pragma unroll
            for (int m = 0; m < 4; ++m) {
                unsigned char* o = ys_row(p, ysbase + m0 + wr * 64 + m * 16 + fr) + nt * 128 + wc * 64 + 8 * fq;
#pragma unroll
                for (int g = 0; g < 2; ++g) *(u32x2*)(o + g * 32) = (u32x2){pk4_fp8(acc[m][2 * g]), pk4_fp8(acc[m][2 * g + 1])};
            }
        });
    } else {
        gemm2_stream64<128, 272>(W2, ACT, lds + 36864, [&](int nt, const f32x4 (&acc)[4][4]) {
#pragma unroll
            for (int m = 0; m < 4; ++m) {
                const int rl = wr * 64 + m * 16 + fr;
                if (rl < nvalid) {
                    unsigned char* o = ys_row(p, ysbase + s0 + rl) + nt * 128 + wc * 64 + 8 * fq;
#pragma unroll
                    for (int g = 0; g < 2; ++g) *(u32x2*)(o + g * 32) = (u32x2){pk4_fp8(acc[m][2 * g]), pk4_fp8(acc[m][2 * g + 1])};
                }
            }
        });
    }
    __syncthreads();
}
DEV void phase_moe(const Params& p, int l, int r, char* lds) {
    const int* cnt = (const int*)(p.ws + OFF_CNT) + l * 64 * 64;
    moe_plan(cnt, p.cap, l, lds);
    const int* PL = (const int*)(lds + PLAN_OFF);
    if (r >= PL[0]) return;
    const int e_lo = PL[1 + r], e_hi = PL[2 + r];
    const int nrt = PL[10 + r];
    const int nrows = (l == 0) ? NT : NLAT;
    const int nshu = (r == 0) ? 2 * (nrows / 128) : 0;
    const int G = (int)gridDim.x, b = vblock();
    const int q = (nshu + nrt + G - 1) / G;
    const int u0 = b * q, u1 = min(u0 + q, nshu + nrt);
    int e = e_lo;
    for (int u = u0; u < u1; ++u) {
        if (u < nshu) {
            const int m0 = (u >> 1) * 128, hh = u & 1;
            moe_tile<true>(p, (const bf16_t*)(p.ws + OFF_SW13) + (size_t)(l * 2 + hh) * 256 * 1024, (const bf16_t*)(p.ws + OFF_SW2) + (size_t)(l * 2 + hh) * 1024 * 128,
                           nullptr, 0, 128, PL[208] + hh * nrows, m0, hh, nullptr, lds);
        } else {
            const int it = u - nshu;
            while (e + 1 < e_hi && PL[16 + e + 1] <= it) ++e;
            const int s0 = (it - PL[16 + e]) * 128;
            moe_tile<false>(p, (const bf16_t*)(p.ws + OFF_W13) + (size_t)e * 256 * 1024, (const bf16_t*)(p.ws + OFF_W2) + (size_t)e * 1024 * 128,
                            (const int*)(p.ws + OFF_LIST) + (size_t)e * NT, s0, min(128, PL[144 + e] - s0), PL[80 + e], 0, 0, nullptr, lds);
        }
    }
}

DEV void phase_comb(const Params& p, int l, int r, char* lds) {
    const int tid_ = get_tid(), lane = tid_ & 63, wid = tid_ >> 6;
    const int* cnt = (const int*)(p.ws + OFF_CNT) + l * 64 * 64;
    moe_plan(cnt, p.cap, l, lds);
    const int* PL = (const int*)(lds + PLAN_OFF);
    if (r >= PL[0]) return;
    const int e_lo = PL[1 + r], e_hi = PL[2 + r];
    const bool final = (r == PL[0] - 1);
    bf16_t* X = (bf16_t*)(p.ws + OFF_X);
    bf16_t* H = (bf16_t*)(p.ws + OFF_H);
    const int* tke = (const int*)(p.ws + OFF_TKE); const int* tks = (const int*)(p.ws + OFF_TKS);
    const float* mod = (const float*)(p.ws + OFF_MOD);
    const int nrows = (l == 0) ? NT : NLAT;
    for (int row = blockIdx.x * 4 + wid; row < nrows; row += gridDim.x * 4) {
        const int g = mod_group(row);
        const float* g2 = mod + ((size_t)l * 9 + g) * 6144 + 5120 + 16 * lane;
        int idx_l = -1;
        if (lane < 8) { const int e = tke[row * 8 + lane]; const int sl = tks[row * 8 + lane]; if (e >= e_lo && e < e_hi) idx_l = PL[80 + e] + sl; }
        f32x4 v[4];
        {
            const u32x4 a = *(const u32x4*)(X + (size_t)row * 1024 + 16 * lane), b2 = *(const u32x4*)(X + (size_t)row * 1024 + 16 * lane + 8);
            v[0] = (f32x4){__uint_as_float(a[0] << 16), __uint_as_float(a[0] & 0xffff0000u), __uint_as_float(a[1] << 16), __uint_as_float(a[1] & 0xffff0000u)};
            v[1] = (f32x4){__uint_as_float(a[2] << 16), __uint_as_float(a[2] & 0xffff0000u), __uint_as_float(a[3] << 16), __uint_as_float(a[3] & 0xffff0000u)};
            v[2] = (f32x4){__uint_as_float(b2[0] << 16), __uint_as_float(b2[0] & 0xffff0000u), __uint_as_float(b2[1] << 16), __uint_as_float(b2[1] & 0xffff0000u)};
            v[3] = (f32x4){__uint_as_float(b2[2] << 16), __uint_as_float(b2[2] & 0xffff0000u), __uint_as_float(b2[3] << 16), __uint_as_float(b2[3] & 0xffff0000u)};
        }
        u32x4 y[10];
#pragma unroll
        for (int k = 0; k < 8; ++k) {
            const int idx = __builtin_amdgcn_readlane(idx_l, k);
            if (idx >= 0) y[k] = *(const u32x4*)(ys_row(p, idx) + 16 * lane); else y[k] = (u32x4){0u, 0u, 0u, 0u};
        }
        if (r == 0) { y[8] = *(const u32x4*)(ys_row(p, PL[208] + row) + 16 * lane); y[9] = *(const u32x4*)(ys_row(p, PL[208] + nrows + row) + 16 * lane); }
        else { y[8] = (u32x4){0u, 0u, 0u, 0u}; y[9] = y[8]; }
        f32x4 s[4];
#pragma unroll
        for (int j = 0; j < 4; ++j) s[j] = (f32x4){0.f, 0.f, 0.f, 0.f};
#pragma unroll
        for (int k = 0; k < 10; ++k)
#pragma unroll
            for (int j = 0; j < 4; ++j) s[j] += up4_fp8(y[k][j]);
        const float xs = (r == 0) ? DN_ALPHA : 1.0f;
#pragma unroll
        for (int j = 0; j < 4; ++j) v[j] = v[j] * xs + *(const f32x4*)(g2 + 4 * j) * (s[j] * YS_INV);
        if (!final) {
            u32x4 o0, o1;
            o0 = (u32x4){pk2(v[0][0], v[0][1]), pk2(v[0][2], v[0][3]), pk2(v[1][0], v[1][1]), pk2(v[1][2], v[1][3])};
            o1 = (u32x4){pk2(v[2][0], v[2][1]), pk2(v[2][2], v[2][3]), pk2(v[3][0], v[3][1]), pk2(v[3][2], v[3][3])};
            *(u32x4*)(X + (size_t)row * 1024 + 16 * lane) = o0; *(u32x4*)(X + (size_t)row * 1024 + 16 * lane + 8) = o1;
        } else {
            row_norm(v);
#pragma unroll
            for (int j = 0; j < 4; ++j) {
                const int c = 16 * lane + 4 * j;
                v[j] = v[j] * *(const f32x4*)(p.ln2_g + l * 1024 + c) + *(const f32x4*)(p.ln2_b + l * 1024 + c);
                if (l != 0) *(f32x4*)(p.out + (size_t)row * 1024 + c) = v[j];
            }
            if (l == 0) {
                u32x4 o0, o1;
                o0 = (u32x4){pk2(v[0][0], v[0][1]), pk2(v[0][2], v[0][3]), pk2(v[1][0], v[1][1]), pk2(v[1][2], v[1][3])};
                o1 = (u32x4){pk2(v[2][0], v[2][1]), pk2(v[2][2], v[2][3]), pk2(v[3][0], v[3][1]), pk2(v[3][2], v[3][3])};
                *(u32x4*)(X + (size_t)row * 1024 + 16 * lane) = o0; *(u32x4*)(X + (size_t)row * 1024 + 16 * lane + 8) = o1;
                row_norm(v);
                const float* m1 = mod + ((size_t)9 + g) * 6144 + 16 * lane;
                f32x4 h[4];
#pragma unroll
                for (int j = 0; j < 4; ++j) h[j] = v[j] * (*(const f32x4*)(m1 + 1024 + 4 * j) + 1.0f) + *(const f32x4*)(m1 + 4 * j);
                o0 = (u32x4){pk2(h[0][0], h[0][1]), pk2(h[0][2], h[0][3]), pk2(h[1][0], h[1][1]), pk2(h[1][2], h[1][3])};
                o1 = (u32x4){pk2(h[2][0], h[2][1]), pk2(h[2][2], h[2][3]), pk2(h[3][0], h[3][1]), pk2(h[3][2], h[3][3])};
                *(u32x4*)(H + (size_t)row * 1024 + 16 * lane) = o0; *(u32x4*)(H + (size_t)row * 1024 + 16 * lane + 8) = o1;
            }
        }
    }
    if (final && l == 0) {
        __syncthreads();
        conv_run(p, 1, (int)blockIdx.x * 12, 12, lds);
    }
}


#define XB_TMO      128
#define XB_XCNT(j)  (256  + 64 * (j))
#define XB_XSUB(j)  (1280 + 64 * (j))
#define XB_XGEN(j)  (2304 + 64 * (j))
#define XB_TOP      3328
#define XB_TOPGEN   3392
#define XCD_BAR_WORDS 3456
#define XB_SPIN_CAP (1u << 22)
DEV unsigned xb_ld(unsigned* p) { return __hip_atomic_load(p, __ATOMIC_RELAXED, __HIP_MEMORY_SCOPE_AGENT); }
DEV unsigned xb_add(unsigned* p, unsigned v) { return __hip_atomic_fetch_add(p, v, __ATOMIC_RELAXED, __HIP_MEMORY_SCOPE_AGENT); }
DEV unsigned xb_xcc_id() { return (unsigned)__builtin_amdgcn_s_getreg((3 << 11) | 20) & 0xFu; }
#define XB_SPIN(cond, bar) do { unsigned _sp = 0; while (cond) { __builtin_amdgcn_s_sleep(1); \
    if ((++_sp & 255u) == 0u) { if (xb_ld(&(bar)[XB_TMO])) break; if (_sp > XB_SPIN_CAP) { atomicAdd(&(bar)[XB_TMO], 1u); break; } } } } while (0)
struct XcdBarrier { unsigned* bar; unsigned x; volatile LAS unsigned* st; };
DEV XcdBarrier xcd_barrier_post(unsigned* bar, volatile LAS unsigned* st) {
    XcdBarrier b; b.bar = bar; b.x = xb_xcc_id(); b.st = st;
    if (threadIdx.x == 0) (void)xb_add(&bar[XB_XCNT(b.x)], 1u);
    return b;
}
DEV void xcd_barrier_complete(unsigned* bar, unsigned x, unsigned& nloc, unsigned& nx) {
    const unsigned G = gridDim.x * gridDim.y * gridDim.z;
    unsigned sum, cnt, mine, sp = 0u;
    for (;;) {
        sum = 0u; cnt = 0u; mine = 0u;
#pragma unroll
        for (unsigned j = 0; j < 16; ++j) { const unsigned c = xb_ld(&bar[XB_XCNT(j)]); sum += c; cnt += (c > 0u) ? 1u : 0u; mine = (j == x) ? c : mine; }
        if (sum == G) break;
        __builtin_amdgcn_s_sleep(1);
        if ((++sp & 255u) == 0u) { if (xb_ld(&bar[XB_TMO])) break; if (sp > XB_SPIN_CAP) { atomicAdd(&bar[XB_TMO], 1u); break; } }
    }
    nloc = mine > 0u ? mine : 1u; nx = cnt > 0u ? cnt : 1u;
}
DEV void xcd_barrier(const XcdBarrier& b) {
    asm volatile("s_waitcnt vmcnt(0)" ::: "memory");
    __syncthreads();
    if (get_tid() == 0) {
        unsigned* bar = b.bar; asm volatile("" : "+s"(bar));
        __builtin_amdgcn_s_waitcnt(0);
        unsigned nloc = b.st[0], nx = b.st[1];
        if (nloc == 0u) { xcd_barrier_complete(bar, b.x, nloc, nx); b.st[0] = nloc; b.st[1] = nx; }
        const unsigned old = xb_add(&bar[XB_XSUB(b.x)], 1u);
        const unsigned gen = old / nloc;
        if (old + 1u == (gen + 1u) * nloc) {
            __builtin_amdgcn_fence(__ATOMIC_RELEASE, "agent");
            asm volatile("s_waitcnt vmcnt(0)" ::: "memory");
            const unsigned og = xb_add(&bar[XB_TOP], 1u);
            const unsigned tg = og / nx;
            if (og + 1u == (tg + 1u) * nx) xb_add(&bar[XB_TOPGEN], 1u);
            else XB_SPIN(xb_ld(&bar[XB_TOPGEN]) == tg, bar);
            __builtin_amdgcn_fence(__ATOMIC_ACQUIRE, "agent");
            xb_add(&bar[XB_XGEN(b.x)], 1u);
            asm volatile("s_waitcnt vmcnt(0)" ::: "memory");
        } else {
            XB_SPIN(xb_ld(&bar[XB_XGEN(b.x)]) == gen, bar);
            __builtin_amdgcn_fence(__ATOMIC_ACQUIRE, "agent");
            asm volatile("s_waitcnt vmcnt(0)" ::: "memory");
        }
    }
    __syncthreads();
}

enum { PT_PREP = 0, PT_MODFIN, PT_LNMOD0, PT_INPROJ, PT_MIX, PT_OUTPROJ, PT_LN1ROUTE, PT_MOE, PT_COMB };

DEV void run_phase(const Params& pin, int type, int l, int r, char* lds) {
    Params p = pin;
    { unsigned char* w = p.ws; asm volatile("" : "+s"(w)); p.ws = w; }
    switch (type) {
        case PT_PREP: phase_prep(p, lds); break;
        case PT_MODFIN: phase_modfin(p); break;
        case PT_LNMOD0: phase_lnmod0(p); break;
        case PT_INPROJ: phase_inproj(p, l, lds); break;
        case PT_MIX: phase_mix(p, l, lds); break;
        case PT_OUTPROJ: phase_outproj(p, l, lds); break;
        case PT_LN1ROUTE: phase_ln1route(p, l, lds); break;
        case PT_MOE: phase_moe(p, l, r, lds); break;
        default: phase_comb(p, l, r, lds); break;
    }
}

__global__ void __launch_bounds__(256, 2) fwd_kernel(Params p) {
    __shared__ __attribute__((aligned(16))) char smem[SMEM_BYTES];
#if MULTI_LAUNCH
    run_phase(p, p.ptype, p.pl, p.pr, smem);
#else
    if (threadIdx.x < 4) ((volatile LAS unsigned*)(smem + SMEM_BYTES - 16))[threadIdx.x] = 0u;
    __syncthreads();
    const XcdBarrier bar = xcd_barrier_post((unsigned*)(p.ws + OFF_BAR), (volatile LAS unsigned*)(smem + SMEM_BYTES - 16));
    int type = PT_PREP, l = 0, r = 0;
    for (;;) {
        run_phase(p, type, l, r, smem);
        if (type < PT_MOE) { ++type; if (type == PT_MODFIN) ++type; r = 0; }
        else if (type == PT_MOE) type = PT_COMB;
        else {
            const int nr = ((const int*)(smem + PLAN_OFF))[0];
            if (r + 1 < nr) { ++r; type = PT_MOE; }
            else { if (l == 1) break; l = 1; r = 0; type = PT_INPROJ; }
        }
        xcd_barrier(bar);
    }
#endif
}

extern "C" void kernel_launch(void* const* d_in, const int* in_sizes, int n_in, void* d_out, int out_size, void* d_ws, size_t ws_size, hipStream_t stream) {
    Params p{};
    const float** pp = (const float**)&p;
    for (int i = 0; i < 32; ++i) pp[i] = (const float*)d_in[i];
    p.out = (float*)d_out; p.ws = (unsigned char*)d_ws;
    long long cap = ((long long)ws_size - (long long)OFF_R) / 2048;
    if (cap > NT * 8) cap = NT * 8;
    if (cap * 2048 < (long long)R_MIN_BYTES || cap < NT) { fprintf(stderr, "kernel_launch: workspace too small (%zu)\n", ws_size); return; }
    p.cap = (int)cap;
#if MULTI_LAUNCH
    const int grid = 512;
    auto launch = [&](int type, int l, int r) { Params q = p; q.mode = 1; q.ptype = type; q.pl = l; q.pr = r; hipLaunchKernelGGL(fwd_kernel, dim3(grid), dim3(256), 0, stream, q); };
    launch(PT_PREP, 0, 0); launch(PT_MODFIN, 0, 0); launch(PT_LNMOD0, 0, 0);
    for (int l = 0; l < 2; ++l) {
        launch(PT_INPROJ, l, 0); launch(PT_MIX, l, 0); launch(PT_OUTPROJ, l, 0); launch(PT_LN1ROUTE, l, 0);
        for (int r = 0; r < RMAX; ++r) { launch(PT_MOE, l, r); launch(PT_COMB, l, r); }
    }
#else
    static int grid_blocks = 0;
    if (!grid_blocks) {
        int dev = 0, cus = 0, per_cu = 0;
        hipGetDevice(&dev);
        hipDeviceGetAttribute(&cus, hipDeviceAttributeMultiprocessorCount, dev);
        hipOccupancyMaxActiveBlocksPerMultiprocessor(&per_cu, fwd_kernel, 256, 0);
        if (per_cu > 2) per_cu = 2;
        if (per_cu < 1) per_cu = 1;
        grid_blocks = cus * per_cu;
    }
    p.mode = 0;
    hipMemsetAsync(d_ws, 0, 65536, stream);
    hipLaunchKernelGGL(fwd_kernel, dim3(grid_blocks), dim3(256), 0, stream, p);
#endif
}
```

```cpp
#include <hip/hip_runtime.h>
#include <hip/hip_cooperative_groups.h>
#include <stdint.h>
#include <stdio.h>
namespace cg = cooperative_groups;

#ifndef MULTI_LAUNCH
#define MULTI_LAUNCH 0
#endif

typedef unsigned short bf16_t;
typedef short bf16x8 __attribute__((ext_vector_type(8)));
typedef short s16x4 __attribute__((ext_vector_type(4)));
typedef float f32x4 __attribute__((ext_vector_type(4)));
typedef unsigned u32x4 __attribute__((ext_vector_type(4)));
typedef unsigned u32x2 __attribute__((ext_vector_type(2)));
#define DEV __device__ __forceinline__
#define LDSP(T) __attribute__((address_space(3))) T*
#define LAS __attribute__((address_space(3)))

constexpr int D = 1024, NB = 8, SEQ = 2048, CTX = 256, NLAT = NB * SEQ, NCTX = NB * CTX, NT = NLAT + NCTX;
constexpr int PROJ = 2304, KEYS = CTX + SEQ, NEXP = 64;
constexpr float DN_ALPHA = 1.41421356237309515f;
constexpr float LOG2E = 1.44269504088896341f;
constexpr int SMEM_BYTES = 72 * 1024;
constexpr int RMAX = 4;

constexpr size_t OFF_CNT = 0;
constexpr size_t OFF_QUEUE = 33792;
constexpr size_t OFF_BAR = 40960;
constexpr size_t OFF_MOD = 65536;
constexpr size_t OFF_ROPE = OFF_MOD + 442368;
constexpr size_t OFF_KERNL = OFF_ROPE + 2ull * 2048 * 32 * 4;
constexpr size_t OFF_KERNC = OFF_KERNL + 2ull * 4096 * 256 * 4;
constexpr size_t OFF_TKE = OFF_KERNC + 2ull * 512 * 256 * 4;
constexpr size_t OFF_TKS = OFF_TKE + (size_t)NT * 8 * 4;
constexpr size_t OFF_TKW = OFF_TKS + (size_t)NT * 8 * 4;
constexpr size_t OFF_LIST = OFF_TKW + (size_t)NT * 8 * 4;
constexpr size_t OFF_WIN = OFF_LIST + 64ull * NT * 4;
constexpr size_t OFF_WOUT = OFF_WIN + 2ull * 2304 * 1024 * 2;
constexpr size_t OFF_SW13 = OFF_WOUT + 2ull * 1024 * 1024 * 2;
constexpr size_t OFF_SW2 = OFF_SW13 + 2ull * 512 * 1024 * 2;
constexpr size_t OFF_RW = OFF_SW2 + 2ull * 1024 * 256 * 2;
constexpr size_t OFF_W13 = OFF_RW + 2ull * 64 * 1024 * 2;
constexpr size_t OFF_W2 = OFF_W13 + 64ull * 256 * 1024 * 2;
constexpr size_t OFF_X = OFF_W2 + 64ull * 1024 * 128 * 2;
constexpr size_t OFF_H = OFF_X + (size_t)NT * 1024 * 2;
constexpr size_t OFF_R = OFF_H + (size_t)NT * 1024 * 2;
constexpr size_t OFF_QA = OFF_R;
constexpr size_t OFF_QB = OFF_QA + 8ull * NT * 64 * 2;
constexpr size_t OFF_KA = OFF_QB + 4ull * NT * 64 * 2;
constexpr size_t OFF_VA = OFF_KA + 8ull * 2 * KEYS * 64 * 2;
constexpr size_t OFF_KB = OFF_VA + 8ull * 2 * KEYS * 64 * 2;
constexpr size_t OFF_VB = OFF_KB + 8ull * 4 * KEYS * 64 * 2;
constexpr size_t OFF_ZTL = OFF_VB + 8ull * 4 * KEYS * 64 * 2;
constexpr size_t OFF_ZTC = OFF_ZTL + 8ull * 768 * 2048 * 2;
constexpr size_t OFF_OX = OFF_ZTC + 8ull * 768 * 256 * 2;
constexpr size_t OFF_OXT = OFF_OX + (size_t)NT * 1024 * 2;
constexpr size_t R_MIN_BYTES = OFF_OXT + 8ull * 256 * 2048 * 2 - OFF_R;
constexpr size_t OFF_PART = OFF_R;
constexpr size_t OFF_YS = OFF_R;

struct Params {
    const float *x, *c, *ctx, *c_ctx, *ada_w, *ada_b, *w_in, *q_gain, *k_gain, *nat_rpb, *hy_conv_w, *hy_conv_b,
        *hy_f_w1, *hy_f_b1, *hy_f_w2, *hy_f_b2, *hy_f_w3, *hy_freq, *hy_skip, *w_out, *ln1_g, *ln1_b,
        *router_w, *router_b, *exp_w1, *exp_w3, *exp_w2, *sh_w1, *sh_w3, *sh_w2, *ln2_g, *ln2_b;
    float* out; unsigned char* ws;
    int cap, mode, ptype, pl, pr, pad;
};

typedef __bf16 hwbf2 __attribute__((ext_vector_type(2)));
typedef float f32x2 __attribute__((ext_vector_type(2)));
DEV unsigned f2bf(float f) { return (unsigned)__builtin_bit_cast(unsigned short, (__bf16)f); }
DEV unsigned pk2(float lo, float hi) { const f32x2 v = {lo, hi}; return __builtin_bit_cast(unsigned, __builtin_convertvector(v, hwbf2)); }
DEV float bf2f(unsigned short h) { return __uint_as_float(((unsigned)h) << 16); }
DEV float wave_sum(float v) {
#pragma unroll
    for (int o = 32; o > 0; o >>= 1) v += __shfl_xor(v, o);
    return v;
}
DEV void glds16(const void* g, void* l) { __builtin_amdgcn_global_load_lds((const unsigned*)g, (unsigned*)l, 16, 0, 0); }
DEV f32x4 mfma16(bf16x8 a, bf16x8 b, f32x4 c) { return __builtin_amdgcn_mfma_f32_16x16x32_bf16(a, b, c, 0, 0, 0); }
DEV float readlane_f(float v, int l) { return __uint_as_float((unsigned)__builtin_amdgcn_readlane((int)__float_as_uint(v), l)); }
DEV int get_tid() { int t = threadIdx.x; asm volatile("" : "+v"(t)); return t; }
DEV int lchunk(int tid) { return (tid & 3) ^ ((0 - (tid >> 4)) & 3); }
DEV int vblock() { const int G = (int)gridDim.x, b = (int)blockIdx.x; return (G & 7) ? b : (b & 7) * (G >> 3) + (b >> 3); }
DEV int mod_group(int row) { return row < NLAT ? (row >> 11) : 8; }

template <int MI, int NI> DEV void zero_acc(f32x4 (&acc)[MI][NI]) {
#pragma unroll
    for (int m = 0; m < MI; ++m)
#pragma unroll
        for (int n = 0; n < NI; ++n) acc[m][n] = (f32x4){0.f, 0.f, 0.f, 0.f};
}
#define WAIT_VM(n) asm volatile("s_waitcnt vmcnt(" #n ")" ::: "memory")
#define WAIT_LGKM0() asm volatile("s_waitcnt lgkmcnt(0)" ::: "memory")
#define RAW_BARRIER() do { asm volatile("" ::: "memory"); __builtin_amdgcn_s_barrier(); asm volatile("" ::: "memory"); } while (0)
template <int MI, int NI, bool TRANS>
DEV void gemm_core(f32x4 (&acc)[MI][NI], const bf16_t* A, const unsigned (&ao)[MI / 2], const bf16_t* B, const unsigned (&bo)[NI / 2], int K, char* lds) {
    const int tid = get_tid(), lane = tid & 63, wid = tid >> 6, fr = lane & 15, fq = lane >> 4, wr = wid >> 1, wc = wid & 1;
    constexpr int SAB = 2048 * MI, STG = 2048 * (MI + NI), LPT = MI / 2 + NI / 2;
    static_assert(LPT == 3 || LPT == 4 || LPT == 6, "loads per tile");
    const int nt = K >> 5;
    auto stage = [&](int s, int t) {
        char* SA = lds + s * STG; char* SB = SA + SAB;
#pragma unroll
        for (int i = 0; i < MI / 2; ++i) glds16(A + (ao[i] + (unsigned)(t * 32)), SA + i * 4096 + tid * 16);
#pragma unroll
        for (int i = 0; i < NI / 2; ++i) glds16(B + (bo[i] + (unsigned)(t * 32)), SB + i * 4096 + tid * 16);
    };
    WAIT_VM(0);
    stage(0, 0);
    if (nt > 1) stage(1, 1);
    const int sw = (fq ^ ((0 - (fr >> 2)) & 3)) * 16;
    const int aoff = (wr * MI * 16 + fr) * 64 + sw, boff = SAB + (wc * NI * 16 + fr) * 64 + sw;
#pragma unroll 1
    for (int t = 0; t < nt; ++t) {
        if (t + 1 < nt) { if (LPT == 6) WAIT_VM(6); else if (LPT == 4) WAIT_VM(4); else WAIT_VM(3); } else WAIT_VM(0);
        RAW_BARRIER();
        const char* S = lds + (t & 1) * STG;
        bf16x8 af[MI], bfr[NI];
#pragma unroll
        for (int m = 0; m < MI; ++m) af[m] = *(const bf16x8*)(S + aoff + m * 1024);
#pragma unroll
        for (int n = 0; n < NI; ++n) bfr[n] = *(const bf16x8*)(S + boff + n * 1024);
        WAIT_LGKM0();
        RAW_BARRIER();
        if (t + 2 < nt) stage(t & 1, t + 2);
#pragma unroll
        for (int m = 0; m < MI; ++m)
#pragma unroll
            for (int n = 0; n < NI; ++n) acc[m][n] = TRANS ? mfma16(bfr[n], af[m], acc[m][n]) : mfma16(af[m], bfr[n], acc[m][n]);
    }
}
DEV unsigned st64_off(int tid) { return (unsigned)(tid >> 3) * 1024u + (unsigned)(((tid & 7) ^ ((tid >> 3) & 7)) * 8); }
DEV int tr_key(int row) { return (row & 3) | (((row >> 3) & 1) << 2); }
template <bool TRANS>
DEV void gemm_core64(f32x4 (&acc)[4][4], const bf16_t* A, const unsigned (&ao)[4], const bf16_t* B, const unsigned (&bo)[4], int K, char* lds,
                     const bf16_t* AT = nullptr, int t_tr = 1 << 20) {
    const int tid = get_tid(), lane = tid & 63, wid = tid >> 6, fr = lane & 15, fq = lane >> 4, wr = wid >> 1, wc = wid & 1;
    const int nt = K >> 6;
    auto stage = [&](int s, int t) {
        char* SA = lds + s * 32768; char* SB = SA + 16384;
        if (t >= t_tr) {
#pragma unroll
            for (int i = 0; i < 4; ++i) {
                const int id = tid + 256 * i, row = id >> 4, cp = id & 15, c = (cp - 2 * tr_key(row)) & 15;
                glds16(AT + (size_t)((t - t_tr) * 64 + row) * 2048 + c * 8, SA + id * 16);
            }
        } else {
#pragma unroll
            for (int i = 0; i < 4; ++i) glds16(A + (ao[i] + (unsigned)(t * 64)), SA + i * 4096 + tid * 16);
        }
#pragma unroll
        for (int i = 0; i < 4; ++i) glds16(B + (bo[i] + (unsigned)(t * 64)), SB + i * 4096 + tid * 16);
    };
    WAIT_VM(0);
    stage(0, 0);
    if (nt > 1) stage(1, 1);
    const int rsw = fr & 7;
    const int arow = (wr * 64 + fr) * 128, brow = 16384 + (wc * 64 + fr) * 128;
    const int c0 = ((fq) ^ rsw) * 16, c1 = ((4 + fq) ^ rsw) * 16;
#pragma unroll 1
    for (int t = 0; t < nt; ++t) {
        if (t + 1 < nt) WAIT_VM(8); else WAIT_VM(0);
        RAW_BARRIER();
        const char* S = lds + (t & 1) * 32768;
        bf16x8 af[4][2], bfr[4][2];
        if (t >= t_tr) {
            const int q4 = fr >> 2, p4 = fr & 3;
#pragma unroll
            for (int m = 0; m < 4; ++m)
#pragma unroll
                for (int ks = 0; ks < 2; ++ks) {
                    const int rowA = ks * 32 + 8 * fq + q4, rowB = rowA + 4, c = wr * 8 + m * 2 + (p4 >> 1);
                    const int offA = rowA * 256 + (((c + 2 * tr_key(rowA)) & 15) * 16) + (p4 & 1) * 8;
                    const int offB = rowB * 256 + (((c + 2 * tr_key(rowB)) & 15) * 16) + (p4 & 1) * 8;
                    const s16x4 ta = __builtin_amdgcn_ds_read_tr16_b64_v4i16((LDSP(s16x4))(S + offA));
                    const s16x4 tb = __builtin_amdgcn_ds_read_tr16_b64_v4i16((LDSP(s16x4))(S + offB));
                    bf16x8 f; f[0] = ta[0]; f[1] = ta[1]; f[2] = ta[2]; f[3] = ta[3]; f[4] = tb[0]; f[5] = tb[1]; f[6] = tb[2]; f[7] = tb[3];
                    af[m][ks] = f;
                }
        } else {
#pragma unroll
            for (int m = 0; m < 4; ++m) { af[m][0] = *(const bf16x8*)(S + arow + m * 2048 + c0); af[m][1] = *(const bf16x8*)(S + arow + m * 2048 + c1); }
        }
#pragma unroll
        for (int n = 0; n < 4; ++n) { bfr[n][0] = *(const bf16x8*)(S + brow + n * 2048 + c0); bfr[n][1] = *(const bf16x8*)(S + brow + n * 2048 + c1); }
        WAIT_LGKM0();
        RAW_BARRIER();
        if (t + 2 < nt) stage(t & 1, t + 2);
        __builtin_amdgcn_s_setprio(1);
#pragma unroll
        for (int ks = 0; ks < 2; ++ks)
#pragma unroll
            for (int m = 0; m < 4; ++m)
#pragma unroll
                for (int n = 0; n < 4; ++n) acc[m][n] = TRANS ? mfma16(bfr[n][ks], af[m][ks], acc[m][n]) : mfma16(af[m][ks], bfr[n][ks], acc[m][n]);
        __builtin_amdgcn_s_setprio(0);
    }
}
template <int KACT, int ASTRIDE, class EPI>
DEV void gemm2_stream64(const bf16_t* W2, const char* ACT, char* sb, EPI&& epi) {
    const int tid = get_tid(), lane = tid & 63, wid = tid >> 6, fr = lane & 15, fq = lane >> 4, wr = wid >> 1, wc = wid & 1;
    constexpr int KS = KACT / 64, NJ = 8 * KS;
    const unsigned b0 = (unsigned)(tid >> 3) * KACT + (unsigned)(((tid & 7) ^ ((tid >> 3) & 7)) * 8);
    auto stage = [&](int s, int j) {
        const int nt = j / KS, ks = j % KS;
        char* SB = sb + s * 16384;
        const bf16_t* src = W2 + (size_t)nt * 128 * KACT + ks * 64 + b0;
#pragma unroll
        for (int i = 0; i < 4; ++i) glds16(src + (size_t)i * 32 * KACT, SB + i * 4096 + tid * 16);
    };
    WAIT_VM(0);
    stage(0, 0); stage(1, 1);
    const int rsw = fr & 7;
    const int brow = (wc * 64 + fr) * 128, c0 = (fq ^ rsw) * 16, c1 = ((4 + fq) ^ rsw) * 16;
    f32x4 acc[4][4]; zero_acc<4, 4>(acc);
#pragma unroll 1
    for (int j = 0; j < NJ; ++j) {
        const int ks = j % KS;
        if (j + 1 < NJ) WAIT_VM(4); else WAIT_VM(0);
        RAW_BARRIER();
        const char* S = sb + (j & 1) * 16384;
        bf16x8 af[4][2], bfr[4][2];
#pragma unroll
        for (int m = 0; m < 4; ++m) { const char* ar = ACT + (wr * 64 + m * 16 + fr) * ASTRIDE + (ks * 64 + fq * 8) * 2; af[m][0] = *(const bf16x8*)ar; af[m][1] = *(const bf16x8*)(ar + 64); }
#pragma unroll
        for (int n = 0; n < 4; ++n) { bfr[n][0] = *(const bf16x8*)(S + brow + n * 2048 + c0); bfr[n][1] = *(const bf16x8*)(S + brow + n * 2048 + c1); }
        WAIT_LGKM0();
        RAW_BARRIER();
        if (j + 2 < NJ) stage(j & 1, j + 2);
#pragma unroll
        for (int k2 = 0; k2 < 2; ++k2)
#pragma unroll
            for (int m = 0; m < 4; ++m)
#pragma unroll
                for (int n = 0; n < 4; ++n) acc[m][n] = mfma16(bfr[n][k2], af[m][k2], acc[m][n]);
        if (ks == KS - 1) { epi(j / KS, acc); zero_acc<4, 4>(acc); }
    }
}
template <int MI, int KACT, int ASTRIDE, class EPI>
DEV void gemm2_stream(const bf16_t* W2, const char* ACT, char* sb, EPI&& epi) {
    const int tid = get_tid(), lane = tid & 63, wid = tid >> 6, fr = lane & 15, fq = lane >> 4, wr = wid >> 1, wc = wid & 1;
    constexpr int KS = KACT / 32, NJ = 8 * KS;
    const bf16_t* b0 = W2 + (size_t)(tid >> 2) * KACT + lchunk(tid) * 8;
    auto stage = [&](int s, int j) {
        const int nt = j / KS, ks = j % KS;
        char* SB = sb + s * 8192;
        const bf16_t* src = b0 + (size_t)nt * 128 * KACT + ks * 32;
        glds16(src, SB + tid * 16);
        glds16(src + 64 * KACT, SB + 4096 + tid * 16);
    };
    WAIT_VM(0);
    stage(0, 0); stage(1, 1);
    const int boff = (wc * 64 + fr) * 64 + (fq ^ ((0 - (fr >> 2)) & 3)) * 16;
    f32x4 acc[MI][4]; zero_acc<MI, 4>(acc);
#pragma unroll 1
    for (int j = 0; j < NJ; ++j) {
        const int ks = j % KS;
        if (j + 1 < NJ) WAIT_VM(2); else WAIT_VM(0);
        RAW_BARRIER();
        const char* S = sb + (j & 1) * 8192;
        bf16x8 af[MI], bfr[4];
#pragma unroll
        for (int m = 0; m < MI; ++m) af[m] = *(const bf16x8*)(ACT + (wr * MI * 16 + m * 16 + fr) * ASTRIDE + (ks * 32 + fq * 8) * 2);
#pragma unroll
        for (int n = 0; n < 4; ++n) bfr[n] = *(const bf16x8*)(S + boff + n * 1024);
        WAIT_LGKM0();
        RAW_BARRIER();
        if (j + 2 < NJ) stage(j & 1, j + 2);
#pragma unroll
        for (int m = 0; m < MI; ++m)
#pragma unroll
            for (int n = 0; n < 4; ++n) acc[m][n] = mfma16(bfr[n], af[m], acc[m][n]);
        if (ks == KS - 1) { epi(j / KS, acc); zero_acc<MI, 4>(acc); }
    }
}

DEV void prep_mod_item(const Params& p, int it, char* lds) {
    const int l = it / 96, r = it % 96, cch = r >> 2, kp = r & 3, tid = get_tid(), lane = tid & 63, kq = tid >> 6;
    float* sl = (float*)lds;
    float* red = sl + 9 * 256;
    for (int i = tid; i < 9 * 256; i += 256) { const int g = i >> 8, k = kp * 256 + (i & 255); const float v = (g < 8) ? p.c[g * 1024 + k] : p.c_ctx[k]; sl[i] = v * __builtin_amdgcn_rcpf(1.f + __expf(-v)); }
    __syncthreads();
    f32x4 acc[9];
#pragma unroll
    for (int g = 0; g < 9; ++g) acc[g] = (f32x4){0.f, 0.f, 0.f, 0.f};
    const float* w = p.ada_w + ((size_t)l * 1024 + kp * 256 + kq * 64) * 6144 + cch * 256 + lane * 4;
#pragma unroll 16
    for (int kk = 0; kk < 64; ++kk) {
        const f32x4 wv = *(const f32x4*)(w + (size_t)kk * 6144);
#pragma unroll
        for (int g = 0; g < 9; ++g) { const float sv = sl[g * 256 + kq * 64 + kk]; acc[g] += sv * wv; }
    }
#pragma unroll
    for (int g = 0; g < 9; ++g) *(f32x4*)(red + (kq * 9 + g) * 256 + lane * 4) = acc[g];
    __syncthreads();
    float* part = (float*)(p.ws + OFF_R) + (size_t)(l * 24 + cch) * 4 * 2304;
    for (int i = tid; i < 9 * 256; i += 256) {
        const int g = i >> 8, c = i & 255;
        part[kp * 2304 + i] = (red[(0 * 9 + g) * 256 + c] + red[(1 * 9 + g) * 256 + c]) + (red[(2 * 9 + g) * 256 + c] + red[(3 * 9 + g) * 256 + c]);
    }
    __threadfence();
    __syncthreads();
    int* arrive = (int*)(lds + SMEM_BYTES - 252);
    if (tid == 0) *arrive = atomicAdd((int*)(p.ws + OFF_QUEUE) + 256 + l * 24 + cch, 1);
    __syncthreads();
    if (*arrive == 3) {
        __threadfence();
        float* mod = (float*)(p.ws + OFF_MOD);
        for (int i = tid; i < 9 * 256; i += 256) {
            const int g = i >> 8, c = i & 255;
            const float v = (__builtin_nontemporal_load(part + i) + __builtin_nontemporal_load(part + 2304 + i)) + (__builtin_nontemporal_load(part + 2 * 2304 + i) + __builtin_nontemporal_load(part + 3 * 2304 + i));
            mod[((size_t)l * 9 + g) * 6144 + cch * 256 + c] = p.ada_b[l * 6144 + cch * 256 + c] + v;
        }
    }
    __syncthreads();
}
constexpr float INV2PI = 0.15915494309189535f;
DEV float sin_rev(float r) { return __builtin_amdgcn_sinf(__builtin_amdgcn_fractf(r)); }
DEV float cos_rev(float r) { return __builtin_amdgcn_cosf(__builtin_amdgcn_fractf(r)); }
DEV void prep_rope_item(const Params& p, int it) {
    const int idx = it * 256 + get_tid(), t = idx >> 5, i = idx & 31;
    const float inv = __builtin_amdgcn_exp2f(-(float)(2 * (i & 15)) * (13.287712379549449f / 32.f));
    const float ang = (float)((i < 16) ? (t >> 6) : (t & 63)) * inv;
    float* rc = (float*)(p.ws + OFF_ROPE);
    rc[idx] = cos_rev(ang * INV2PI); rc[2048 * 32 + idx] = sin_rev(ang * INV2PI);
}
DEV void prep_filter_item(const Params& p, int it, char* lds) {
    const int tid = get_tid(), lane = tid & 63, wid = tid >> 6;
    const int row0 = it * 32 + wid * 8;
    const int l = row0 / 2304, r0 = row0 % 2304, type = r0 < 2048 ? 0 : 1, t0 = type ? r0 - 2048 : r0, n = type ? 256 : 2048;
    float* z = (float*)lds + wid * (8 * 192); float* h1 = z + 8 * 64; float* h2 = h1 + 8 * 64;
    float* WL = (float*)(lds + 24576);
    const float rn1 = type ? 1.f / 255.f : 1.f / 2047.f;
    for (int idx = tid; idx < 97 * 16; idx += 256) {
        const int row = idx >> 4, c4 = (idx & 15) * 4;
        const float* src = row < 33 ? p.hy_f_w1 + (l * 33 + row) * 64 : p.hy_f_w2 + (l * 64 + row - 33) * 64;
        *(f32x4*)(WL + row * 64 + c4) = *(const f32x4*)(src + c4);
    }
#pragma unroll
    for (int rr = 0; rr < 8; ++rr) {
        const int t = t0 + rr;
        if (lane < 33) {
            float v;
            if (lane == 0) v = (float)t * rn1;
            else {
                const int i = (lane - 1) & 15;
                const float f = 1e-4f + (float)i * ((15.f - 1e-4f) / 15.f);
                const float rev = f * ((float)t * (type ? 1.f / 256.f : 1.f / 2048.f));
                v = (lane <= 16) ? cos_rev(rev) : -sin_rev(rev);
            }
            z[rr * 64 + lane] = v;
        }
    }
    __syncthreads();
    {
        float s[8]; const float b = p.hy_f_b1[l * 64 + lane];
#pragma unroll
        for (int rr = 0; rr < 8; ++rr) s[rr] = b;
#pragma unroll 11
        for (int i = 0; i < 33; ++i) {
            const float w = WL[i * 64 + lane];
#pragma unroll
            for (int rr = 0; rr < 8; ++rr) s[rr] += z[rr * 64 + i] * w;
        }
        const float fq0 = p.hy_freq[(l * 2 + 0) * 64 + lane];
#pragma unroll
        for (int rr = 0; rr < 8; ++rr) h1[rr * 64 + lane] = sin_rev(fq0 * s[rr] * INV2PI);
    }
    __builtin_amdgcn_wave_barrier();
    {
        float s[8]; const float b = p.hy_f_b2[l * 64 + lane];
#pragma unroll
        for (int rr = 0; rr < 8; ++rr) s[rr] = b;
#pragma unroll 16
        for (int i = 0; i < 64; ++i) {
            const float w = WL[(33 + i) * 64 + lane];
#pragma unroll
            for (int rr = 0; rr < 8; ++rr) s[rr] += h1[rr * 64 + i] * w;
        }
        const float fq1 = p.hy_freq[(l * 2 + 1) * 64 + lane];
#pragma unroll
        for (int rr = 0; rr < 8; ++rr) h2[rr * 64 + lane] = sin_rev(fq1 * s[rr] * INV2PI);
    }
    __syncthreads();
    float acc[8][8];
#pragma unroll
    for (int rr = 0; rr < 8; ++rr)
#pragma unroll
        for (int q = 0; q < 8; ++q) acc[rr][q] = 0.f;
    const float* w3 = p.hy_f_w3 + (size_t)l * 64 * 512;
#pragma unroll 1
    for (int ch = 0; ch < 4; ++ch) {
#pragma unroll
        for (int j = 0; j < 8; ++j) { const int idx = tid + j * 256; *(f32x4*)(WL + idx * 4) = *(const f32x4*)(w3 + (size_t)ch * 16 * 512 + idx * 4); }
        __syncthreads();
#pragma unroll 2
        for (int i = 0; i < 16; ++i) {
            float w[8];
#pragma unroll
            for (int q = 0; q < 8; ++q) w[q] = WL[i * 512 + q * 64 + lane];
#pragma unroll
            for (int rr = 0; rr < 8; ++rr) {
                const float hv = h2[rr * 64 + ch * 16 + i];
#pragma unroll
                for (int q = 0; q < 8; ++q) acc[rr][q] += hv * w[q];
            }
        }
        __syncthreads();
    }
    bf16_t* kf = (bf16_t*)(p.ws + (type ? OFF_KERNC + (size_t)l * 2 * 256 * 256 * 2 : OFF_KERNL + (size_t)l * 2 * 256 * 2048 * 2));
    const float lo = logf(1e-2f) / 1.5f, hi = logf(1e-2f) / 0.3f;
#pragma unroll
    for (int q = 0; q < 8; ++q) {
        const int qh = q >> 2, c = (q & 3) * 64 + lane;
        const float delta = fabsf(lo + (float)c * ((hi - lo) / 255.f));
        float v[8];
#pragma unroll
        for (int rr = 0; rr < 8; ++rr) { const float tt = (float)(t0 + rr) * rn1; v[rr] = acc[rr][q] * __expf(-tt * delta); }
        if (qh == 0 && t0 == 0) v[0] += p.hy_skip[l * 256 + c];
        *(u32x4*)(kf + ((size_t)qh * 256 + c) * n + t0) = (u32x4){pk2(v[0], v[1]), pk2(v[2], v[3]), pk2(v[4], v[5]), pk2(v[6], v[7])};
    }
}
struct ConvDesc { const float* src; bf16_t* dst; int ldsrc, k0, n0, lddst, mapkind; };
DEV void conv_load(const ConvDesc& d, f32x4 (&v)[4], int tid) {
    const int r = tid >> 4, c4 = (tid & 15) * 4;
#pragma unroll
    for (int i = 0; i < 4; ++i) v[i] = *(const f32x4*)(d.src + (size_t)(d.k0 + r + 16 * i) * d.ldsrc + d.n0 + c4);
}
DEV void conv_store(const ConvDesc& d, const f32x4 (&v)[4], char* lds, int tid) {
    float* tl = (float*)lds;
    {
        const int r = tid >> 4, c4 = (tid & 15) * 4;
#pragma unroll
        for (int i = 0; i < 4; ++i) { const int row = r + 16 * i; tl[row * 65 + c4 + 0] = v[i][0]; tl[row * 65 + c4 + 1] = v[i][1]; tl[row * 65 + c4 + 2] = v[i][2]; tl[row * 65 + c4 + 3] = v[i][3]; }
    }
    __syncthreads();
    {
        const int n = tid >> 2, kc = tid & 3, ng = d.n0 + n;
        int drow = ng;
        if (d.mapkind == 1) drow = 32 * (ng >> 4) + (ng & 15);
        else if (d.mapkind == 2) drow = 32 * (ng >> 4) + 16 + (ng & 15);
        else if (d.mapkind == 3) drow = (ng >> 7) * 256 + 32 * ((ng & 127) >> 4) + (ng & 15);
        else if (d.mapkind == 4) drow = (ng >> 7) * 256 + 32 * ((ng & 127) >> 4) + 16 + (ng & 15);
        else if (d.mapkind == 5) drow = (ng & ~31) + 16 * ((ng >> 2) & 1) + 4 * ((ng >> 3) & 3) + (ng & 3);
        unsigned w[8];
#pragma unroll
        for (int j = 0; j < 8; ++j) w[j] = pk2(tl[(kc * 16 + 2 * j) * 65 + n], tl[(kc * 16 + 2 * j + 1) * 65 + n]);
        u32x4* o = (u32x4*)(d.dst + (size_t)drow * d.lddst + d.k0 + kc * 16);
        o[0] = (u32x4){w[0], w[1], w[2], w[3]};
        o[1] = (u32x4){w[4], w[5], w[6], w[7]};
    }
    __syncthreads();
}
DEV ConvDesc conv_fixed_desc(const Params& p, int it) {
    const int l = it / 1040; int r = it % 1040;
    unsigned char* ws = p.ws;
    if (r < 576) return ConvDesc{p.w_in + (size_t)l * 1024 * PROJ, (bf16_t*)(ws + OFF_WIN) + (size_t)l * PROJ * 1024, PROJ, (r / 36) * 64, (r % 36) * 64, 1024, (r % 36) * 64 < 1536 ? 5 : 0};
    r -= 576;
    if (r < 256) return ConvDesc{p.w_out + (size_t)l * 1024 * 1024, (bf16_t*)(ws + OFF_WOUT) + (size_t)l * 1024 * 1024, 1024, (r / 16) * 64, (r % 16) * 64, 1024, 5};
    r -= 256;
    if (r < 64) return ConvDesc{p.sh_w1 + (size_t)l * 1024 * 256, (bf16_t*)(ws + OFF_SW13) + (size_t)l * 512 * 1024, 256, (r / 4) * 64, (r % 4) * 64, 1024, 3};
    r -= 64;
    if (r < 64) return ConvDesc{p.sh_w3 + (size_t)l * 1024 * 256, (bf16_t*)(ws + OFF_SW13) + (size_t)l * 512 * 1024, 256, (r / 4) * 64, (r % 4) * 64, 1024, 4};
    r -= 64;
    if (r < 64) { const int kt = r / 16, hh = kt >> 1;
        return ConvDesc{p.sh_w2 + (size_t)l * 256 * 1024, (bf16_t*)(ws + OFF_SW2) + (size_t)(l * 2 + hh) * 1024 * 128 - hh * 128, 1024, kt * 64, (r % 16) * 64, 128, 5}; }
    r -= 64;
    return ConvDesc{p.router_w + (size_t)l * 1024 * 64, (bf16_t*)(ws + OFF_RW) + (size_t)l * 64 * 1024, 64, r * 64, 0, 1024, 0};
}
DEV ConvDesc conv_expert_desc(const Params& p, int l, int it) {
    const int e = it / 96; int r = it % 96;
    unsigned char* ws = p.ws;
    const size_t eo = (size_t)(l * 64 + e) * 1024 * 128;
    if (r < 32) return ConvDesc{p.exp_w1 + eo, (bf16_t*)(ws + OFF_W13) + (size_t)e * 256 * 1024, 128, (r / 2) * 64, (r % 2) * 64, 1024, 1};
    r -= 32;
    if (r < 32) return ConvDesc{p.exp_w3 + eo, (bf16_t*)(ws + OFF_W13) + (size_t)e * 256 * 1024, 128, (r / 2) * 64, (r % 2) * 64, 1024, 2};
    r -= 32;
    return ConvDesc{p.exp_w2 + eo, (bf16_t*)(ws + OFF_W2) + (size_t)e * 1024 * 128, 1024, (r / 16) * 64, (r % 16) * 64, 128, 5};
}
DEV void conv_run(const Params& p, int l, int first, int count, char* lds) {
    const int tid = get_tid();
    if (count <= 0) return;
    ConvDesc d = l < 0 ? conv_fixed_desc(p, first) : conv_expert_desc(p, l, first);
    f32x4 v[4]; conv_load(d, v, tid);
#pragma unroll 1
    for (int i = 0; i < count; ++i) {
        ConvDesc dn = d; f32x4 vn[4];
        if (i + 1 < count) { dn = l < 0 ? conv_fixed_desc(p, first + i + 1) : conv_expert_desc(p, l, first + i + 1); conv_load(dn, vn, tid); }
        else {
#pragma unroll
            for (int k = 0; k < 4; ++k) vn[k] = v[k];
        }
        conv_store(d, v, lds, tid);
        d = dn;
#pragma unroll
        for (int k = 0; k < 4; ++k) v[k] = vn[k];
    }
}
DEV void phase_prep(const Params& p, char* lds) {
    { const int t_ = get_tid(); if (blockIdx.x == 0 && t_ < 128) ((int*)(p.ws + OFF_CNT))[t_ * 64] = 0; }
    constexpr int N0 = 144, N1 = N0 + 192, N2 = N1 + 260, N3 = N2 + 768, N4 = N3 + 256;
    int* qhead = (int*)(p.ws + OFF_QUEUE) + 2 * 64;
    int* qslot = (int*)(lds + SMEM_BYTES - 256);
    for (;;) {
        __syncthreads();
        if (get_tid() == 0) *qslot = atomicAdd(qhead, 1);
        __syncthreads();
        const int it = *qslot;
        if (it >= N4) break;
        if (it < N0) prep_filter_item(p, it, lds);
        else if (it < N1) prep_mod_item(p, it - N0, lds);
        else if (it < N2) conv_run(p, -1, (it - N1) * 8, 8, lds);
        else if (it < N3) conv_run(p, 0, (it - N2) * 8, 8, lds);
        else prep_rope_item(p, it - N3);
    }
}
DEV void phase_modfin(const Params& p) {
    const float* part = (const float*)(p.ws + OFF_PART);
    float* mod = (float*)(p.ws + OFF_MOD);
    for (int idx = blockIdx.x * 256 + get_tid(); idx < 2 * 9 * 6144; idx += gridDim.x * 256) {
        const int l = idx / (9 * 6144), g = (idx / 6144) % 9, col = idx % 6144;
        float s = p.ada_b[l * 6144 + col];
        for (int k = 0; k < 32; ++k) s += part[((size_t)(k * 2 + l) * 9 + g) * 6144 + col];
        mod[idx] = s;
    }
}

DEV void row_load(const float* src, f32x4 (&v)[4], int lane) {
#pragma unroll
    for (int j = 0; j < 4; ++j) v[j] = *(const f32x4*)(src + 4 * lane + 256 * j);
}
DEV f32x4 ld_bf4(const bf16_t* p) { const u32x2 w = *(const u32x2*)p; return (f32x4){__uint_as_float(w[0] << 16), __uint_as_float(w[0] & 0xffff0000u), __uint_as_float(w[1] << 16), __uint_as_float(w[1] & 0xffff0000u)}; }
DEV void st_bf4(bf16_t* p, const f32x4& v) { *(u32x2*)p = (u32x2){pk2(v[0], v[1]), pk2(v[2], v[3])}; }
DEV void row_load_bf(const bf16_t* src, f32x4 (&v)[4], int lane) {
#pragma unroll
    for (int j = 0; j < 4; ++j) v[j] = ld_bf4(src + 4 * lane + 256 * j);
}
DEV void row_norm(f32x4 (&v)[4]) {
    float s = 0.f;
#pragma unroll
    for (int j = 0; j < 4; ++j) s += (v[j][0] + v[j][1]) + (v[j][2] + v[j][3]);
    const float mean = wave_sum(s) * (1.f / 1024.f);
    float q = 0.f;
#pragma unroll
    for (int j = 0; j < 4; ++j) { v[j] = v[j] - mean; q += (v[j][0] * v[j][0] + v[j][1] * v[j][1]) + (v[j][2] * v[j][2] + v[j][3] * v[j][3]); }
    const float rstd = __builtin_amdgcn_rsqf(wave_sum(q) * (1.f / 1024.f) + 1e-6f);
#pragma unroll
    for (int j = 0; j < 4; ++j) v[j] = v[j] * rstd;
}
DEV void row_store_mod_bf16(bf16_t* dst, const f32x4 (&v)[4], const float* shift, const float* scale, int lane) {
#pragma unroll
    for (int j = 0; j < 4; ++j) {
        const int c = 4 * lane + 256 * j;
        const f32x4 sh = *(const f32x4*)(shift + c), sc = *(const f32x4*)(scale + c);
        const f32x4 o = v[j] * (sc + 1.0f) + sh;
        *(u32x2*)(dst + c) = (u32x2){pk2(o[0], o[1]), pk2(o[2], o[3])};
    }
}
DEV void phase_lnmod0(const Params& p) {
    const int tid_ = get_tid(), lane = tid_ & 63, wid = tid_ >> 6;
    const float* mod = (const float*)(p.ws + OFF_MOD);
    bf16_t* H = (bf16_t*)(p.ws + OFF_H);
    for (int row = blockIdx.x * 4 + wid; row < NT; row += gridDim.x * 4) {
        const float* src = row < NLAT ? p.x + (size_t)row * 1024 : p.ctx + (size_t)(row - NLAT) * 1024;
        f32x4 v[4]; row_load(src, v, lane); row_norm(v);
        const float* m = mod + (size_t)mod_group(row) * 6144;
        row_store_mod_bf16(H + (size_t)row * 1024, v, m, m + 1024, lane);
    }
}

DEV void phase_inproj(const Params& p, int l, char* lds) {
    const int tid = get_tid(), lane = tid & 63, wid = tid >> 6, fr = lane & 15, fq = lane >> 4, wr = wid >> 1, wc = wid & 1;
    unsigned char* ws = p.ws;
    const bf16_t* H = (const bf16_t*)(ws + OFF_H);
    const bf16_t* W = (const bf16_t*)(ws + OFF_WIN) + (size_t)l * PROJ * 1024;
    const float* ropec = (const float*)(ws + OFF_ROPE); const float* ropes = ropec + 2048 * 32;
    const int nitems = 128 * 18 + 16 * (l == 0 ? 18 : 6);
    for (int it = blockIdx.x; it < nitems; it += gridDim.x) {
        int mt, nt;
        if (it < 2304) { mt = it / 18; nt = it % 18; }
        else { const int j = it - 2304; if (l == 0) { mt = 128 + j / 18; nt = j % 18; } else { mt = 128 + j / 6; const int q = j % 6; nt = q < 2 ? 4 + q : 6 + q; } }
        const int m0 = mt * 128, n0 = nt * 128;
        const unsigned a0 = (unsigned)m0 * 1024u + st64_off(tid), b0 = (unsigned)n0 * 1024u + st64_off(tid);
        const unsigned ao[4] = {a0, a0 + 32u * 1024u, a0 + 64u * 1024u, a0 + 96u * 1024u};
        const unsigned bo[4] = {b0, b0 + 32u * 1024u, b0 + 64u * 1024u, b0 + 96u * 1024u};
        f32x4 acc[4][4]; zero_acc<4, 4>(acc);
        const bool latent = m0 < NLAT;
        const int b = latent ? (m0 >> 11) : ((m0 - NLAT) >> 8);
        const int tbase = latent ? (m0 & 2047) : ((m0 - NLAT) & 255);
        if (nt >= 12) {
            const int rho = tid >> 3, ptok = 8 * ((rho & 15) >> 2) + 4 * (rho >> 4) + (rho & 3);
            const unsigned ap0 = (unsigned)(m0 + ptok) * 1024u + (unsigned)(((tid & 7) ^ (rho & 7)) * 8);
            const unsigned aop[4] = {ap0, ap0 + 32u * 1024u, ap0 + 64u * 1024u, ap0 + 96u * 1024u};
            gemm_core64<false>(acc, H, aop, W, bo, 1024, lds);
            bf16_t* zt = latent ? (bf16_t*)(ws + OFF_ZTL) + (size_t)b * 768 * 2048 : (bf16_t*)(ws + OFF_ZTC) + (size_t)b * 768 * 256;
            const int n = latent ? 2048 : 256;
#pragma unroll
            for (int g = 0; g < 2; ++g)
#pragma unroll
                for (int nn = 0; nn < 4; ++nn) {
                    const int ch = n0 - 1536 + wc * 64 + nn * 16 + fr, t = tbase + wr * 64 + 32 * g + 8 * fq;
                    *(u32x4*)(zt + (size_t)ch * n + t) = (u32x4){pk2(acc[2 * g][nn][0], acc[2 * g][nn][1]), pk2(acc[2 * g][nn][2], acc[2 * g][nn][3]),
                                                                 pk2(acc[2 * g + 1][nn][0], acc[2 * g + 1][nn][1]), pk2(acc[2 * g + 1][nn][2], acc[2 * g + 1][nn][3])};
                }
        } else {
            gemm_core64<true>(acc, H, ao, W, bo, 1024, lds);
            const int col0 = n0 + wc * 64;
            int kind, hh;
            if (col0 < 512) { kind = 0; hh = col0 >> 6; } else if (col0 < 640) { kind = 1; hh = (col0 - 512) >> 6; } else if (col0 < 768) { kind = 2; hh = (col0 - 640) >> 6; }
            else if (col0 < 1024) { kind = 3; hh = (col0 - 768) >> 6; } else if (col0 < 1280) { kind = 4; hh = (col0 - 1024) >> 6; } else { kind = 5; hh = (col0 - 1280) >> 6; }
            const bool normed = (kind == 0 || kind == 1);
            const float* gain = (kind == 0 ? p.q_gain : p.k_gain) + l * 64;
#pragma unroll
            for (int m = 0; m < 4; ++m) {
                const int rloc = wr * 64 + m * 16 + fr, row = m0 + rloc, t = tbase + rloc;
                f32x4 v[4];
#pragma unroll
                for (int nn = 0; nn < 4; ++nn) v[nn] = acc[m][nn];
                if (normed) {
                    float ss = 0.f;
#pragma unroll
                    for (int nn = 0; nn < 4; ++nn) ss += (v[nn][0] * v[nn][0] + v[nn][1] * v[nn][1]) + (v[nn][2] * v[nn][2] + v[nn][3] * v[nn][3]);
                    ss += __shfl_xor(ss, 16); ss += __shfl_xor(ss, 32);
                    const float r = __builtin_amdgcn_rsqf(ss * (1.f / 64.f) + 1e-6f);
#pragma unroll
                    for (int nn = 0; nn < 4; ++nn) {
                        const int hc = 32 * (nn >> 1) + 8 * fq + 4 * (nn & 1);
                        const f32x4 g = *(const f32x4*)(gain + hc);
                        v[nn] = v[nn] * r * g;
                        if (latent) {
                            const int pi = hc >> 1;
                            const float c0 = ropec[t * 32 + pi], s0 = ropes[t * 32 + pi], c1 = ropec[t * 32 + pi + 1], s1 = ropes[t * 32 + pi + 1];
                            const float x0 = v[nn][0], x1 = v[nn][1], x2 = v[nn][2], x3 = v[nn][3];
                            v[nn][0] = x0 * c0 - x1 * s0; v[nn][1] = x0 * s0 + x1 * c0;
                            v[nn][2] = x2 * c1 - x3 * s1; v[nn][3] = x2 * s1 + x3 * c1;
                        }
                    }
                }
                if (kind == 0 || kind == 3) {
#pragma unroll
                    for (int nn = 0; nn < 4; ++nn) v[nn] = v[nn] * (0.125f * LOG2E);
                }
                bf16_t* dst;
                const int key = latent ? 256 + t : t;
                if (kind == 0) dst = (bf16_t*)(ws + OFF_QA) + ((size_t)hh * NT + row) * 64;
                else if (kind == 3) dst = (bf16_t*)(ws + OFF_QB) + ((size_t)hh * NT + row) * 64;
                else if (kind == 1) dst = (bf16_t*)(ws + OFF_KA) + ((size_t)(b * 2 + hh) * KEYS + key) * 64;
                else if (kind == 2) dst = (bf16_t*)(ws + OFF_VA) + ((size_t)(b * 2 + hh) * KEYS + key) * 64;
                else if (kind == 4) dst = (bf16_t*)(ws + OFF_KB) + ((size_t)(b * 4 + hh) * KEYS + key) * 64;
                else dst = (bf16_t*)(ws + OFF_VB) + ((size_t)(b * 4 + hh) * KEYS + key) * 64;
#pragma unroll
                for (int gg = 0; gg < 2; ++gg) *(u32x4*)(dst + 32 * gg + 8 * fq) = (u32x4){pk2(v[2 * gg][0], v[2 * gg][1]), pk2(v[2 * gg][2], v[2 * gg][3]), pk2(v[2 * gg + 1][0], v[2 * gg + 1][1]), pk2(v[2 * gg + 1][2], v[2 * gg + 1][3])};
            }
        }
    }
}

template <int NQT, bool NA>
DEV void attn_block(const bf16_t* Qh, int qrow0, const bf16_t* Kh, const bf16_t* Vh, int ntiles, bf16_t* outp  ,
                    int na_r, int na_rs, int nwin, const float* rpb_h, char* lds) {
    const int tid = get_tid(), lane = tid & 63, wid = tid >> 6, fr = lane & 15, fq = lane >> 4;
    char* KBUF = lds;
    char* VBUF = lds + 16384;
    float* BIAS = (float*)(lds + 32768);
    if (NA) {
        for (int i = tid; i < 15 * 32; i += 256) { const int dr = i >> 5, dc = i & 31; BIAS[i] = dc < 31 ? rpb_h[dr * 31 + dc] * LOG2E : 0.f; }
    }
    bf16x8 qf[NQT][2];
    const int qw = qrow0 + wid * 16 * NQT;
#pragma unroll
    for (int nq = 0; nq < NQT; ++nq)
#pragma unroll
        for (int ks = 0; ks < 2; ++ks) qf[nq][ks] = *(const bf16x8*)(Qh + (size_t)(qw + nq * 16 + fr) * 64 + ks * 32 + fq * 8);
    f32x4 oacc[4][NQT], lacc[NQT];
    float mrun[NQT];
    const bf16x8 ones = (bf16x8){0x3F80, 0x3F80, 0x3F80, 0x3F80, 0x3F80, 0x3F80, 0x3F80, 0x3F80};
#pragma unroll
    for (int nq = 0; nq < NQT; ++nq) { mrun[nq] = 0.f; lacc[nq] = (f32x4){0.f, 0.f, 0.f, 0.f};
#pragma unroll
        for (int dt = 0; dt < 4; ++dt) oacc[dt][nq] = (f32x4){0.f, 0.f, 0.f, 0.f}; }
    const int lrow0 = tid >> 3, lch = tid & 7;
    auto key0_of = [&](int ti) -> int { if (NA) return ti < nwin ? 256 + (na_rs + ti) * 64 : (ti - nwin) * 64; return ti * 64; };
    u32x4 kreg[2], vreg[2];
    auto gload = [&](int ti) {
        const int k0 = key0_of(ti);
#pragma unroll
        for (int i = 0; i < 2; ++i) {
            const int row = lrow0 + 32 * i;
            kreg[i] = *(const u32x4*)(Kh + (size_t)(k0 + row) * 64 + lch * 8);
            vreg[i] = *(const u32x4*)(Vh + (size_t)(k0 + row) * 64 + lch * 8);
        }
    };
    auto lstore = [&](int buf) {
#pragma unroll
        for (int i = 0; i < 2; ++i) {
            const int row = lrow0 + 32 * i;
            const int off = buf * 8192 + row * 128 + ((lch ^ (row & 7)) * 16);
            *(u32x4*)(KBUF + off) = kreg[i];
            *(u32x4*)(VBUF + off) = vreg[i];
        }
    };
    gload(0); lstore(0);
    __syncthreads();
    for (int ti = 0; ti < ntiles; ++ti) {
        const int buf = ti & 1;
        if (ti + 1 < ntiles) gload(ti + 1);
        const char* kb = KBUF + buf * 8192; const char* vb = VBUF + buf * 8192;
        f32x4 sacc[4][NQT];
        __builtin_amdgcn_s_setprio(1);
#pragma unroll
        for (int mt = 0; mt < 4; ++mt) {
            const int row = mt * 16 + fr;
            bf16x8 kf0 = *(const bf16x8*)(kb + row * 128 + (((0 + fq) ^ (row & 7)) * 16));
            bf16x8 kf1 = *(const bf16x8*)(kb + row * 128 + (((4 + fq) ^ (row & 7)) * 16));
#pragma unroll
            for (int nq = 0; nq < NQT; ++nq) {
                f32x4 s = (f32x4){-mrun[nq], -mrun[nq], -mrun[nq], -mrun[nq]};
                s = mfma16(kf0, qf[nq][0], s);
                s = mfma16(kf1, qf[nq][1], s);
                sacc[mt][nq] = s;
            }
        }
        __builtin_amdgcn_s_setprio(0);
        bf16x8 pf[2][NQT];
#pragma unroll
        for (int nq = 0; nq < NQT; ++nq) {
            float tv[4][4];
            float tmax = -1e30f;
            if (NA && ti < nwin) {
                const int qc = (wid & 1) * 32 + nq * 16 + fr;
                int cs = qc - 8; cs = cs < 0 ? 0 : (cs > 48 ? 48 : cs);
                const int qrow = na_r + (wid >> 1);
                int rsq = qrow - 4; rsq = rsq < 0 ? 0 : (rsq > 24 ? 24 : rsq);
                const int krow = na_rs + ti;
                const bool rowok = (krow >= rsq) && (krow < rsq + 8);
                int dr = krow - qrow + 7; dr = dr < 0 ? 0 : (dr > 14 ? 14 : dr);
#pragma unroll
                for (int mt = 0; mt < 4; ++mt)
#pragma unroll
                    for (int j = 0; j < 4; ++j) {
                        const int kc = mt * 16 + 4 * fq + j;
                        const bool ok = rowok && (kc >= cs) && (kc < cs + 16);
                        int dc = kc - qc + 15; dc = dc < 0 ? 0 : (dc > 30 ? 30 : dc);
                        tv[mt][j] = ok ? sacc[mt][nq][j] + BIAS[dr * 32 + dc] : -1e30f;
                        tmax = fmaxf(tmax, tv[mt][j]);
                    }
            } else {
#pragma unroll
                for (int mt = 0; mt < 4; ++mt) {
#pragma unroll
                    for (int j = 0; j < 4; ++j) tv[mt][j] = sacc[mt][nq][j];
                    tmax = fmaxf(fmaxf(tmax, tv[mt][0]), tv[mt][1]); tmax = fmaxf(fmaxf(tmax, tv[mt][2]), tv[mt][3]);
                }
            }
            if (__any(tmax > 8.0f)) {
                tmax = fmaxf(tmax, __shfl_xor(tmax, 16)); tmax = fmaxf(tmax, __shfl_xor(tmax, 32));
                const float dlt = fmaxf(tmax, 0.f);
                const float alpha = __builtin_amdgcn_exp2f(-dlt);
                mrun[nq] += dlt;
                lacc[nq] = lacc[nq] * alpha;
#pragma unroll
                for (int dt = 0; dt < 4; ++dt) oacc[dt][nq] = oacc[dt][nq] * alpha;
#pragma unroll
                for (int mt = 0; mt < 4; ++mt)
#pragma unroll
                    for (int j = 0; j < 4; ++j) tv[mt][j] -= dlt;
            }
#pragma unroll
            for (int mt = 0; mt < 4; ++mt)
#pragma unroll
                for (int j = 0; j < 4; ++j) tv[mt][j] = __builtin_amdgcn_exp2f(tv[mt][j]);
#pragma unroll
            for (int ks = 0; ks < 2; ++ks) {
                union { bf16x8 v; unsigned u[4]; } pk;
                pk.u[0] = pk2(tv[2 * ks][0], tv[2 * ks][1]); pk.u[1] = pk2(tv[2 * ks][2], tv[2 * ks][3]);
                pk.u[2] = pk2(tv[2 * ks + 1][0], tv[2 * ks + 1][1]); pk.u[3] = pk2(tv[2 * ks + 1][2], tv[2 * ks + 1][3]);
                pf[ks][nq] = pk.v;
                lacc[nq] = mfma16(ones, pk.v, lacc[nq]);
            }
        }
        {
            const int q4 = fr >> 2, p4 = fr & 3;
#pragma unroll
            for (int ks = 0; ks < 2; ++ks)
#pragma unroll
                for (int dt = 0; dt < 4; ++dt) {
                    const int keyA = 16 * (2 * ks) + 4 * fq + q4, keyB = keyA + 16;
                    const int ch = 4 * (dt >> 1) + p4;
                    const int offA = keyA * 128 + ((ch ^ (keyA & 7)) * 16) + (dt & 1) * 8;
                    const int offB = keyB * 128 + ((ch ^ (keyB & 7)) * 16) + (dt & 1) * 8;
                    const s16x4 ta = __builtin_amdgcn_ds_read_tr16_b64_v4i16((LDSP(s16x4))(vb + offA));
                    const s16x4 tb = __builtin_amdgcn_ds_read_tr16_b64_v4i16((LDSP(s16x4))(vb + offB));
                    bf16x8 vf; vf[0] = ta[0]; vf[1] = ta[1]; vf[2] = ta[2]; vf[3] = ta[3]; vf[4] = tb[0]; vf[5] = tb[1]; vf[6] = tb[2]; vf[7] = tb[3];
#pragma unroll
                    for (int nq = 0; nq < NQT; ++nq) oacc[dt][nq] = mfma16(vf, pf[ks][nq], oacc[dt][nq]);
                }
        }
        if (ti + 1 < ntiles) lstore(buf ^ 1);
        __syncthreads();
    }
#pragma unroll
    for (int nq = 0; nq < NQT; ++nq) {
        const float inv = __builtin_amdgcn_rcpf(lacc[nq][0]);
        bf16_t* o = outp + (size_t)(qw + nq * 16 + fr) * 1024;
#pragma unroll
        for (int g = 0; g < 2; ++g) {
            const f32x4 v0 = oacc[2 * g][nq] * inv, v1 = oacc[2 * g + 1][nq] * inv;
            *(u32x4*)(o + g * 32 + 8 * fq) = (u32x4){pk2(v0[0], v0[1]), pk2(v0[2], v0[3]), pk2(v1[0], v1[1]), pk2(v1[2], v1[3])};
        }
    }
    __syncthreads();
}

DEV float hy_sconv(const bf16_t* zrow, int t, int n, float w0, float w1, float w2, float bias) {
    const float zm = t > 0 ? bf2f(zrow[t - 1]) : 0.f, z0 = bf2f(zrow[t]), zp = t + 1 < n ? bf2f(zrow[t + 1]) : 0.f;
    return w0 * zm + w1 * z0 + w2 * zp + bias;
}
template <int NJ>
DEV void hyena_item(const Params& p, int l, int type, int c, int bh, char* lds) {
    constexpr int n = 256 * NJ;
    const int tid = get_tid();
    f32x4* U = (f32x4*)lds;
    float* KR = (float*)(lds + n * 16);
    const bf16_t* zt = type ? (const bf16_t*)(p.ws + OFF_ZTC) : (const bf16_t*)(p.ws + OFF_ZTL);
    const bf16_t* kf = (const bf16_t*)(p.ws + (type ? OFF_KERNC + (size_t)l * 2 * 256 * 256 * 2 : OFF_KERNL + (size_t)l * 2 * 256 * 2048 * 2)) + (size_t)c * n;
    const bf16_t* kb = kf + (size_t)256 * n;
    const float* cw = p.hy_conv_w + l * 3 * 768; const float* cb = p.hy_conv_b + l * 768;
    const float w10 = cw[256 + c], w11 = cw[768 + 256 + c], w12 = cw[1536 + 256 + c], b1 = cb[256 + c];
    const float wv0 = cw[512 + c], wv1 = cw[768 + 512 + c], wv2 = cw[1536 + 512 + c], bv = cb[512 + c];
    const float w00 = cw[c], w01 = cw[768 + c], w02 = cw[1536 + c], b0 = cb[c];
    for (int i = tid; i < 2 * n - 1; i += 256) { const int d = i - (n - 1); KR[i] = bf2f(d >= 0 ? kf[d] : kb[-d]); }
    for (int s = tid; s < n; s += 256) {
        f32x4 u;
#pragma unroll
        for (int bb = 0; bb < 4; ++bb) {
            const bf16_t* zb = zt + (size_t)(bh * 4 + bb) * 768 * n;
            const float x1 = hy_sconv(zb + (size_t)(256 + c) * n, s, n, w10, w11, w12, b1);
            const float vv = hy_sconv(zb + (size_t)(512 + c) * n, s, n, wv0, wv1, wv2, bv);
            u[bb] = vv * x1;
        }
        U[s] = u;
    }
    __syncthreads();
    f32x4 acc[NJ];
#pragma unroll
    for (int j = 0; j < NJ; ++j) acc[j] = (f32x4){0.f, 0.f, 0.f, 0.f};
    const float* kp = KR + tid + (n - 1);
    for (int s = 0; s < n; ++s) {
        const f32x4 u = U[s];
#pragma unroll
        for (int j = 0; j < NJ; ++j) acc[j] += u * kp[256 * j - s];
    }
    bf16_t* ox = (bf16_t*)(p.ws + OFF_OX);
#pragma unroll
    for (int j = 0; j < NJ; ++j) {
        const int t = tid + 256 * j;
#pragma unroll
        for (int bb = 0; bb < 4; ++bb) {
            const int b = bh * 4 + bb;
            const bf16_t* zb = zt + (size_t)b * 768 * n;
            const float x0 = hy_sconv(zb + (size_t)c * n, t, n, w00, w01, w02, b0);
            const float y = acc[j][bb] * x0;
            const int row = type ? NLAT + b * 256 + t : b * 2048 + t;
            ox[(size_t)row * 1024 + 768 + c] = (bf16_t)f2bf(y);
        }
    }
    __syncthreads();
}


typedef float f32x16 __attribute__((ext_vector_type(16)));
constexpr int HY_UROW = 2256;
constexpr int HY_KC_OFF = 8 * HY_UROW * 2;
constexpr int HY_KC_STRIDE = 8192 + 64;
DEV float hy_sc8(const bf16_t* zrow, int s0, int n, float w0, float w1, float w2, float bias, float (&o)[8]) {
    const u32x4 v = *(const u32x4*)(zrow + s0);
    const float zm = s0 > 0 ? bf2f(zrow[s0 - 1]) : 0.f, zp = s0 + 8 < n ? bf2f(zrow[s0 + 8]) : 0.f;
    float z[10]; z[0] = zm; z[9] = zp;
#pragma unroll
    for (int i = 0; i < 4; ++i) { z[1 + 2 * i] = __uint_as_float(v[i] << 16); z[2 + 2 * i] = __uint_as_float(v[i] & 0xffff0000u); }
#pragma unroll
    for (int i = 0; i < 8; ++i) o[i] = w0 * z[i] + w1 * z[i + 1] + w2 * z[i + 2] + bias;
    return 0.f;
}
DEV void hyena_mfma_item(const Params& p, int l, int c, char* lds) {
    const int tid = get_tid(), lane = tid & 63, wid = tid >> 6;
    constexpr int n = 2048;
    const bf16_t* zt = (const bf16_t*)(p.ws + OFF_ZTL);
    const bf16_t* kf = (const bf16_t*)(p.ws + OFF_KERNL + (size_t)l * 2 * 256 * 2048 * 2) + (size_t)c * n;
    const bf16_t* kb = kf + (size_t)256 * n;
    const float* cw = p.hy_conv_w + l * 3 * 768; const float* cb = p.hy_conv_b + l * 768;
    const float w10 = cw[256 + c], w11 = cw[768 + 256 + c], w12 = cw[1536 + 256 + c], b1 = cb[256 + c];
    const float wv0 = cw[512 + c], wv1 = cw[768 + 512 + c], wv2 = cw[1536 + 512 + c], bv = cb[512 + c];
    const float w00 = cw[c], w01 = cw[768 + c], w02 = cw[1536 + c], b0 = cb[c];
    for (int i = tid; i < 8 * 26; i += 256) {
        const int b = i / 26, k = i % 26;
        const int sp = k < 12 ? k * 8 : 96 + 2048 + (k - 12) * 8;
        *(u32x4*)(lds + (b * HY_UROW + sp) * 2) = (u32x4){0u, 0u, 0u, 0u};
    }
#pragma unroll 4
    for (int ch = tid; ch < 8 * 256; ch += 256) {
        const int b = ch >> 8, s0 = (ch & 255) * 8;
        const bf16_t* zb = zt + (size_t)b * 768 * n;
        float x1[8], vv[8];
        hy_sc8(zb + (size_t)(256 + c) * n, s0, n, w10, w11, w12, b1, x1);
        hy_sc8(zb + (size_t)(512 + c) * n, s0, n, wv0, wv1, wv2, bv, vv);
        *(u32x4*)(lds + (b * HY_UROW + 96 + s0) * 2) = (u32x4){pk2(vv[0] * x1[0], vv[1] * x1[1]), pk2(vv[2] * x1[2], vv[3] * x1[3]), pk2(vv[4] * x1[4], vv[5] * x1[5]), pk2(vv[6] * x1[6], vv[7] * x1[7])};
    }
    {
        char* R0 = lds + HY_KC_OFF;
#pragma unroll
        for (int j = 0; j < 2; ++j) {
            const int chn = tid + 256 * j;
            const bool fwd = chn < 256; const int d0 = (chn & 255) * 8;
            const u32x4 v = *(const u32x4*)((fwd ? kf : kb) + d0);
#pragma unroll
            for (int e = 0; e < 8; ++e) {
                const int d = d0 + e;
                const bf16_t val = (bf16_t)((e & 1) ? (v[e >> 1] >> 16) : (v[e >> 1] & 0xffffu));
                const int y = fwd ? 2047 - d : 2047 + d;
                if (fwd || d > 0) *(bf16_t*)(R0 + y * 2) = val;
            }
        }
        if (tid == 0) *(bf16_t*)(R0 + 4095 * 2) = 0;
    }
    __syncthreads();
    {
        const char* R0 = lds + HY_KC_OFF;
        for (int i = tid; i < 3 * 1024; i += 256) {
            const int q = 1 + i / 1024, y = (i % 1024) * 4;
            unsigned short e[4];
#pragma unroll
            for (int k = 0; k < 4; ++k) { const int yy = y + q + k; e[k] = yy <= 4094 ? *(const bf16_t*)(R0 + yy * 2) : (bf16_t)0; }
            *(u32x2*)(lds + HY_KC_OFF + q * HY_KC_STRIDE + y * 2) = (u32x2){(unsigned)e[0] | ((unsigned)e[1] << 16), (unsigned)e[2] | ((unsigned)e[3] << 16)};
        }
    }
    __syncthreads();
    const int i32 = lane & 31, h = lane >> 5, qn = i32 >> 3, bn = i32 & 7;
    const int T0 = 512 * wid;
    f32x16 acc[4];
#pragma unroll
    for (int g = 0; g < 4; ++g)
#pragma unroll
        for (int r = 0; r < 16; ++r) acc[g][r] = 0.f;
    const int dlo = T0 - 2032, dhi = T0 + 384 + 96;
    {
        const int a0 = 2047 - dlo - i32 + 8 * h, q4 = a0 & 3;
        const char* ap = lds + HY_KC_OFF + q4 * HY_KC_STRIDE + (a0 - q4) * 2;
        const char* bp = lds + (bn * HY_UROW + 96 + (T0 - dlo) + 32 * qn + 8 * h) * 2;
        for (int dl = dlo; dl <= dhi; dl += 16) {
            union { bf16x8 v; u32x2 u[2]; } af;
            af.u[0] = *(const u32x2*)ap; af.u[1] = *(const u32x2*)(ap + 8);
#pragma unroll
            for (int g = 0; g < 4; ++g) {
                const int S = T0 + 128 * g - dl;
                if (S >= -96 && S <= 2032) {
                    const bf16x8 bfv = *(const bf16x8*)(bp + 256 * g);
                    acc[g] = __builtin_amdgcn_mfma_f32_32x32x16_bf16(af.v, bfv, acc[g], 0, 0, 0);
                }
            }
            ap -= 32; bp -= 32;
        }
    }
    __syncthreads();
#pragma unroll 4
    for (int ch = tid; ch < 8 * 256; ch += 256) {
        const int b = ch >> 8, s0 = (ch & 255) * 8;
        float x0[8];
        hy_sc8(zt + (size_t)b * 768 * n + (size_t)c * n, s0, n, w00, w01, w02, b0, x0);
        *(u32x4*)(lds + HY_KC_OFF + (b * 2048 + s0) * 2) = (u32x4){pk2(x0[0], x0[1]), pk2(x0[2], x0[3]), pk2(x0[4], x0[5]), pk2(x0[6], x0[7])};
    }
    __syncthreads();
    bf16_t* oxt = (bf16_t*)(p.ws + OFF_OXT) + (size_t)c * 2048;
#pragma unroll
    for (int g = 0; g < 4; ++g)
#pragma unroll
        for (int r4 = 0; r4 < 4; ++r4) {
            const int t = T0 + 128 * g + 32 * qn + 8 * r4 + 4 * h;
            const u32x2 xg = *(const u32x2*)(lds + HY_KC_OFF + (bn * 2048 + t) * 2);
            const float g0 = __uint_as_float(xg[0] << 16), g1 = __uint_as_float(xg[0] & 0xffff0000u), g2 = __uint_as_float(xg[1] << 16), g3 = __uint_as_float(xg[1] & 0xffff0000u);
            *(u32x2*)(oxt + (size_t)bn * 256 * 2048 + t) = (u32x2){pk2(acc[g][4 * r4 + 0] * g0, acc[g][4 * r4 + 1] * g1), pk2(acc[g][4 * r4 + 2] * g2, acc[g][4 * r4 + 3] * g3)};
        }
    __syncthreads();
}

DEV void phase_mix(const Params& p, int l, char* lds) {
    unsigned char* ws = p.ws;
    const bf16_t* QA = (const bf16_t*)(ws + OFF_QA); const bf16_t* QB = (const bf16_t*)(ws + OFF_QB);
    const bf16_t* KA = (const bf16_t*)(ws + OFF_KA); const bf16_t* VA = (const bf16_t*)(ws + OFF_VA);
    const bf16_t* KBp = (const bf16_t*)(ws + OFF_KB); const bf16_t* VBp = (const bf16_t*)(ws + OFF_VB);
    bf16_t* OX = (bf16_t*)(ws + OFF_OX);
    const int N0 = 256, N1 = N0 + 1024, N2 = N1 + 512;
    const int N3 = N2 + (l == 0 ? 512 : 0), N4 = N3 + (l == 0 ? 128 : 0), N5 = N4 + (l == 0 ? 64 : 0);
    int* qhead = (int*)(p.ws + OFF_QUEUE) + l * 64;
    int* qslot = (int*)(lds + SMEM_BYTES - 256);
    for (;;) {
        __syncthreads();
        if (get_tid() == 0) *qslot = atomicAdd(qhead, 1);
        __syncthreads();
        const int it = *qslot;
        if (it >= N5) break;
        if (it < N0) { hyena_mfma_item(p, l, it, lds); }
        else if (it < N1) {
            const int j = it - N0, b = j >> 7, h = (j >> 4) & 7, qb = j & 15;
            attn_block<2, false>(QA + (size_t)h * NT * 64, b * 2048 + qb * 128, KA + (size_t)(b * 2 + (h >> 2)) * KEYS * 64, VA + (size_t)(b * 2 + (h >> 2)) * KEYS * 64,
                                 36, OX + h * 64, 0, 0, 0, nullptr, lds);
        } else if (it < N2) {
            const int j = it - N1, b = j >> 6, h = (j >> 4) & 3, r = (j & 15) * 2;
            int rs0 = r - 4; rs0 = rs0 < 0 ? 0 : (rs0 > 24 ? 24 : rs0);
            int rs1 = r - 3; rs1 = rs1 < 0 ? 0 : (rs1 > 24 ? 24 : rs1);
            const int nwin = rs1 + 8 - rs0;
            attn_block<2, true>(QB + (size_t)h * NT * 64, b * 2048 + r * 64, KBp + (size_t)(b * 4 + h) * KEYS * 64, VBp + (size_t)(b * 4 + h) * KEYS * 64,
                                nwin + 4, OX + 512 + h * 64, r, rs0, nwin, p.nat_rpb + (size_t)(l * 4 + h) * 15 * 31, lds);
        } else if (it < N3) { const int j = it - N2; hyena_item<1>(p, l, 1, j >> 1, j & 1, lds); }
        else if (it < N4) {
            const int j = it - N3, b = j >> 4, h = (j >> 1) & 7, qb = j & 1;
            attn_block<2, false>(QA + (size_t)h * NT * 64, NLAT + b * 256 + qb * 128, KA + (size_t)(b * 2 + (h >> 2)) * KEYS * 64, VA + (size_t)(b * 2 + (h >> 2)) * KEYS * 64,
                                 4, OX + h * 64, 0, 0, 0, nullptr, lds);
        } else {
            const int j = it - N4, b = j >> 3, h = (j >> 1) & 3, qb = j & 1;
            attn_block<2, false>(QB + (size_t)h * NT * 64, NLAT + b * 256 + qb * 128, KBp + (size_t)(b * 4 + h) * KEYS * 64, VBp + (size_t)(b * 4 + h) * KEYS * 64,
                                 4, OX + 512 + h * 64, 0, 0, 0, nullptr, lds);
        }
    }
}

DEV void phase_outproj(const Params& p, int l, char* lds) {
    const int tid = get_tid(), lane = tid & 63, wid = tid >> 6, fr = lane & 15, fq = lane >> 4, wr = wid >> 1, wc = wid & 1;
    const bf16_t* OX = (const bf16_t*)(p.ws + OFF_OX);
    const bf16_t* W = (const bf16_t*)(p.ws + OFF_WOUT) + (size_t)l * 1024 * 1024;
    const float* mod = (const float*)(p.ws + OFF_MOD) + (size_t)l * 9 * 6144;
    bf16_t* X = (bf16_t*)(p.ws + OFF_X);
    const int nitems = (l == 0 ? 144 : 128) * 8;
    for (int it = blockIdx.x; it < nitems; it += gridDim.x) {
        const int mt = it >> 3, nt = it & 7, m0 = mt * 128, n0 = nt * 128;
        const unsigned a0 = (unsigned)m0 * 1024u + st64_off(tid), b0 = (unsigned)n0 * 1024u + st64_off(tid);
        f32x4 acc[4][4]; zero_acc<4, 4>(acc);
        const unsigned ao[4] = {a0, a0 + 32u * 1024u, a0 + 64u * 1024u, a0 + 96u * 1024u};
        const unsigned bo[4] = {b0, b0 + 32u * 1024u, b0 + 64u * 1024u, b0 + 96u * 1024u};
        if (m0 < NLAT) gemm_core64<true>(acc, OX, ao, W, bo, 1024, lds, (const bf16_t*)(p.ws + OFF_OXT) + (size_t)(m0 >> 11) * 256 * 2048 + (m0 & 2047), 12);
        else gemm_core64<true>(acc, OX, ao, W, bo, 1024, lds);
        const float* g1 = mod + (size_t)mod_group(m0) * 6144 + 2048;
#pragma unroll
        for (int m = 0; m < 4; ++m) {
            const int row = m0 + wr * 64 + m * 16 + fr;
            const float* xin = row < NLAT ? p.x + (size_t)row * 1024 : p.ctx + (size_t)(row - NLAT) * 1024;
#pragma unroll
            for (int gg = 0; gg < 2; ++gg) {
                const int col = n0 + wc * 64 + gg * 32 + 8 * fq;
                f32x4 x0, x1;
                if (l == 0) { x0 = *(const f32x4*)(xin + col); x1 = *(const f32x4*)(xin + col + 4); }
                else { const u32x4 w = *(const u32x4*)(X + (size_t)row * 1024 + col);
                       x0 = (f32x4){__uint_as_float(w[0] << 16), __uint_as_float(w[0] & 0xffff0000u), __uint_as_float(w[1] << 16), __uint_as_float(w[1] & 0xffff0000u)};
                       x1 = (f32x4){__uint_as_float(w[2] << 16), __uint_as_float(w[2] & 0xffff0000u), __uint_as_float(w[3] << 16), __uint_as_float(w[3] & 0xffff0000u)}; }
                const f32x4 o0 = x0 * DN_ALPHA + *(const f32x4*)(g1 + col) * acc[m][2 * gg], o1 = x1 * DN_ALPHA + *(const f32x4*)(g1 + col + 4) * acc[m][2 * gg + 1];
                *(u32x4*)(X + (size_t)row * 1024 + col) = (u32x4){pk2(o0[0], o0[1]), pk2(o0[2], o0[3]), pk2(o1[0], o1[1]), pk2(o1[2], o1[3])};
            }
        }
    }
}

DEV void phase_ln1route(const Params& p, int l, char* lds) {
    const int tid = get_tid(), lane = tid & 63, wid = tid >> 6, fr = lane & 15, fq = lane >> 4;
    bf16_t* X = (bf16_t*)(p.ws + OFF_X);
    bf16_t* H = (bf16_t*)(p.ws + OFF_H);
    const bf16_t* RW = (const bf16_t*)(p.ws + OFF_RW) + (size_t)l * 64 * 1024;
    const float* mod = (const float*)(p.ws + OFF_MOD) + (size_t)l * 9 * 6144;
    int* cnt = (int*)(p.ws + OFF_CNT) + l * 64 * 64;
    int* tke = (int*)(p.ws + OFF_TKE); int* tks = (int*)(p.ws + OFF_TKS); float* tkw = (float*)(p.ws + OFF_TKW);
    int* list = (int*)(p.ws + OFF_LIST);
    char* HT = lds;
    float* LG = (float*)(lds + 16 * 2064);
    const float rbias = p.router_b[l * 64 + lane];
    const int rpw = (l == 0) ? 3 : 4, rpi = 4 * rpw;
    const int nitems = (l == 0 ? NT : NLAT) / rpi;
    for (int it = blockIdx.x; it < nitems; it += gridDim.x) {
        const int m0 = it * rpi;
        f32x4 vv[4][4];
#pragma unroll
        for (int i = 0; i < 4; ++i) if (i < rpw) row_load_bf(X + (size_t)(m0 + wid * rpw + i) * 1024, vv[i], lane);
        f32x4 lg[4], lb[4];
#pragma unroll
        for (int j = 0; j < 4; ++j) {
            const int c = 4 * lane + 256 * j;
            lg[j] = *(const f32x4*)(p.ln1_g + l * 1024 + c); lb[j] = *(const f32x4*)(p.ln1_b + l * 1024 + c);
        }
#pragma unroll
        for (int i = 0; i < 4; ++i) if (i < rpw) {
            const int rl = wid * rpw + i, row = m0 + rl;
            const float* mg = mod + (size_t)mod_group(row) * 6144;
            f32x4 msh[4], msc[4];
#pragma unroll
            for (int j = 0; j < 4; ++j) { const int c = 4 * lane + 256 * j; msh[j] = *(const f32x4*)(mg + 3072 + c); msc[j] = *(const f32x4*)(mg + 4096 + c) + 1.0f; }
            row_norm(vv[i]);
#pragma unroll
            for (int j = 0; j < 4; ++j) {
                const int c = 4 * lane + 256 * j;
                vv[i][j] = vv[i][j] * lg[j] + lb[j];
                st_bf4(X + (size_t)row * 1024 + c, vv[i][j]);
            }
            row_norm(vv[i]);
#pragma unroll
            for (int j = 0; j < 4; ++j) {
                const int c = 4 * lane + 256 * j;
                const f32x4 o = vv[i][j] * msc[j] + msh[j];
                const u32x2 w = (u32x2){pk2(o[0], o[1]), pk2(o[2], o[3])};
                *(u32x2*)(H + (size_t)row * 1024 + c) = w;
                *(u32x2*)(HT + rl * 2064 + c * 2) = w;
            }
        }
        __syncthreads();
        f32x4 acc = (f32x4){0.f, 0.f, 0.f, 0.f};
        const bf16_t* bp = RW + (size_t)(wid * 16 + fr) * 1024 + fq * 8;
#pragma unroll 8
        for (int ks = 0; ks < 32; ++ks) {
            const bf16x8 bq = *(const bf16x8*)(bp + ks * 32);
            const bf16x8 af = *(const bf16x8*)(HT + fr * 2064 + (ks * 32 + fq * 8) * 2);
            acc = mfma16(bq, af, acc);
        }
        *(f32x4*)(LG + fr * 64 + wid * 16 + 4 * fq) = acc;
        __syncthreads();
        int* RS = (int*)(lds + 16 * 2064 + 4096 + 2048);
        float* RWt = (float*)(lds + 16 * 2064 + 4096 + 2048 + 4096);
        int lc = 0;
        unsigned* KW = (unsigned*)(lds + 16 * 2064 + 4096 + 2048 + 8192) + wid * 160;
#pragma unroll 1
        for (int i = 0; i < rpw; ++i) {
            const int rl = wid * rpw + i;
            const float sc = __builtin_amdgcn_rcpf(1.0f + __expf(-LG[rl * 64 + lane]));
            const float sel = sc + rbias;
            const int grp = lane >> 3;
            const unsigned key = (__float_as_uint(sel + 2.0f) & 0xFFFFFFC0u) | (unsigned)(63 - lane);
            KW[lane] = key;
            __builtin_amdgcn_wave_barrier();
            int rankg = 0;
            {
                const u32x4 k0 = *(const u32x4*)(KW + grp * 8), k1 = *(const u32x4*)(KW + grp * 8 + 4);
#pragma unroll
                for (int j = 0; j < 4; ++j) { rankg += (k0[j] > key) ? 1 : 0; rankg += (k1[j] > key) ? 1 : 0; }
            }
            float gs = rankg < 2 ? sel : 0.f;
            gs += __shfl_xor(gs, 1); gs += __shfl_xor(gs, 2); gs += __shfl_xor(gs, 4);
            const unsigned gkey = (__float_as_uint(gs + 4.0f) & 0xFFFFFFF8u) | (unsigned)(7 - grp);
            if ((lane & 7) == 0) KW[128 + grp] = gkey;
            __builtin_amdgcn_wave_barrier();
            int rg = 0;
            {
                const u32x4 g0 = *(const u32x4*)(KW + 128), g1 = *(const u32x4*)(KW + 132);
#pragma unroll
                for (int j = 0; j < 4; ++j) { rg += (g0[j] > gkey) ? 1 : 0; rg += (g1[j] > gkey) ? 1 : 0; }
            }
            const bool selg = rg < 4;
            const unsigned vkey = selg ? key : 0u;
            KW[64 + lane] = vkey;
            __builtin_amdgcn_wave_barrier();
            int rank = 0;
#pragma unroll
            for (int q = 0; q < 16; ++q) {
                const u32x4 kk = *(const u32x4*)(KW + 64 + q * 4);
#pragma unroll
                for (int j = 0; j < 4; ++j) rank += (kk[j] > vkey) ? 1 : 0;
            }
            const bool ch = selg && rank < 8;
            const float wsum = wave_sum(ch ? sc : 0.f);
            RS[rl * 64 + lane] = ch ? rank : -1;
            RWt[rl * 64 + lane] = sc * (2.5f * __builtin_amdgcn_rcpf(wsum));
            lc += ch ? 1 : 0;
            __builtin_amdgcn_wave_barrier();
        }
        int* WC = (int*)(lds + 16 * 2064 + 4096);
        WC[wid * 64 + lane] = lc;
        __syncthreads();
        if (wid == 0) {
            const int tot = WC[lane] + WC[64 + lane] + WC[128 + lane] + WC[192 + lane];
            int base = 0;
            if (tot > 0) base = atomicAdd(&cnt[lane * 64], tot);
            WC[256 + lane] = base;
        }
        __syncthreads();
        {
            int slot = WC[256 + lane];
#pragma unroll
            for (int w2 = 0; w2 < 4; ++w2) slot += (w2 < wid) ? WC[w2 * 64 + lane] : 0;
#pragma unroll 1
            for (int i = 0; i < rpw; ++i) {
                const int rl = wid * rpw + i, rk = RS[rl * 64 + lane];
                if (rk >= 0) {
                    const int row = m0 + rl;
                    list[(size_t)lane * NT + slot] = row * 8 + rk;
                    tke[row * 8 + rk] = lane; tks[row * 8 + rk] = slot; tkw[row * 8 + rk] = RWt[rl * 64 + lane];
                    ++slot;
                }
            }
        }
        __syncthreads();
    }
}

constexpr int YS_EXT_ROWS = NLAT * 1024 * 4 / 1024;
constexpr int PLAN_OFF = 68 * 1024;
DEV void moe_plan(const int* cnt, int cap, int l, char* lds) {
    int* PL = (int*)(lds + PLAN_OFF);
    const int tid = get_tid();
    __syncthreads();
    if (tid < 64) {
        const int lane = tid;
        const int c = cnt[lane * 64], tiles = (c + 127) >> 7;
        int pr = c, pt = tiles;
#pragma unroll
        for (int o = 1; o < 64; o <<= 1) { const int a = __shfl_up(pr, o), b = __shfl_up(pt, o); if (lane >= o) { pr += a; pt += b; } }
        const int G = (int)gridDim.x, nshu = 2 * ((l == 0 ? NT : NLAT) / 128);
        const int units = nshu + __builtin_amdgcn_readlane(pt, 63);
        const int cap8 = cap * 2;
        const bool one_round = __builtin_amdgcn_readlane(pr, 63) + nshu * 128 <= cap8;
        const int target0 = one_round ? 0 : ((units + G - 1) / G - 1) * G;
        PL[144 + lane] = c;
        int start = 0, base_r = 0, base_t = 0, round = 0;
        for (;;) {
            const int lim = (round == 0) ? ((target0 > 0) ? cap8 + YS_EXT_ROWS : cap8) - nshu * 128 : cap8;
            const bool bad = (lane >= start) && ((pr - base_r > lim) || (round == 0 && target0 > 0 && lane > 0 && nshu + pt > target0));
            const unsigned long long m = __ballot(bad);
            int end = m ? (int)__builtin_ctzll(m) : 64;
            if (end <= start) end = start + 1;
            if (lane >= start && lane < end) { PL[16 + lane] = pt - tiles - base_t; PL[80 + lane] = pr - c - base_r; }
            if (lane == 0) { PL[1 + round] = start; PL[10 + round] = __builtin_amdgcn_readlane(pt, end - 1) - base_t; PL[208 + round] = __builtin_amdgcn_readlane(pr, end - 1) - base_r; }
            if (end >= 64 || round >= 7) { if (lane == 0) { PL[0] = round + 1; PL[2 + round] = 64; } break; }
            base_r = __builtin_amdgcn_readlane(pr, end - 1); base_t = __builtin_amdgcn_readlane(pt, end - 1);
            start = end; ++round;
        }
    }
    __syncthreads();
}
constexpr float YS_SCALE = 32.0f, YS_INV = 1.0f / 32.0f;
DEV unsigned char* ys_row(const Params& p, int idx) {
    const int cap8 = p.cap * 2;
    return idx < cap8 ? p.ws + OFF_YS + (size_t)idx * 1024 : (unsigned char*)p.out + (size_t)(idx - cap8) * 1024;
}
DEV unsigned pk4_fp8(const f32x4& v) {
    int w = 0;
    w = __builtin_amdgcn_cvt_pk_fp8_f32(v[0] * YS_SCALE, v[1] * YS_SCALE, w, false);
    w = __builtin_amdgcn_cvt_pk_fp8_f32(v[2] * YS_SCALE, v[3] * YS_SCALE, w, true);
    return (unsigned)w;
}
DEV f32x4 up4_fp8(unsigned w) {
    const f32x2 lo = __builtin_amdgcn_cvt_pk_f32_fp8((int)w, false), hi = __builtin_amdgcn_cvt_pk_f32_fp8((int)w, true);
    return (f32x4){lo[0], lo[1], hi[0], hi[1]};
}

template <bool SHARED>
DEV void moe_tile(const Params& p, const bf16_t* W13, const bf16_t* W2, const int* list, int s0, int nvalid, int ysbase, int m0, int half, const float* g2, char* lds) {
    const int tid = get_tid(), lane = tid & 63, wid = tid >> 6, fr = lane & 15, fq = lane >> 4, wr = wid >> 1, wc = wid & 1;
    const bf16_t* H = (const bf16_t*)(p.ws + OFF_H);
    const float* tkw = (const float*)(p.ws + OFF_TKW);
    char* ACT = lds;
    const unsigned ch8 = (unsigned)(((tid & 7) ^ ((tid >> 3) & 7)) * 8);
    unsigned ao[4];
    float gw[4];
    if (SHARED) {
#pragma unroll
        for (int i = 0; i < 4; ++i) ao[i] = (unsigned)(m0 + i * 32 + (tid >> 3)) * 1024u + ch8;
#pragma unroll
        for (int m = 0; m < 4; ++m) gw[m] = 1.0f;
    } else {
#pragma unroll
        for (int i = 0; i < 4; ++i) { const int rr = min(i * 32 + (tid >> 3), nvalid - 1); ao[i] = (unsigned)(list[s0 + rr] >> 3) * 1024u + ch8; }
#pragma unroll
        for (int m = 0; m < 4; ++m) { const int rl = min(wr * 64 + m * 16 + fr, nvalid - 1); gw[m] = tkw[list[s0 + rl]]; }
    }
    u32x2 areg[2][4][2];
#pragma unroll
    for (int np = 0; np < 2; ++np) {
        const unsigned b0 = (unsigned)(np * 128) * 1024u + st64_off(tid);
        const unsigned bo[4] = {b0, b0 + 32u * 1024u, b0 + 64u * 1024u, b0 + 96u * 1024u};
        const unsigned aoc[4] = {ao[0], ao[1], ao[2], ao[3]};
        f32x4 acc[4][4]; zero_acc<4, 4>(acc);
        gemm_core64<true>(acc, H, aoc, W13, bo, 1024, lds);
#pragma unroll
        for (int m = 0; m < 4; ++m)
#pragma unroll
            for (int pi = 0; pi < 2; ++pi) {
                float o[4];
#pragma unroll
                for (int j = 0; j < 4; ++j) { const float a = acc[m][2 * pi][j], b = acc[m][2 * pi + 1][j]; o[j] = a * __builtin_amdgcn_rcpf(1.0f + __expf(-a)) * b * gw[m]; }
                areg[np][m][pi] = (u32x2){pk2(o[0], o[1]), pk2(o[2], o[3])};
            }
    }
    __syncthreads();
#pragma unroll
    for (int np = 0; np < 2; ++np)
#pragma unroll
        for (int m = 0; m < 4; ++m)
#pragma unroll
            for (int pi = 0; pi < 2; ++pi) *(u32x2*)(ACT + (wr * 64 + m * 16 + fr) * 272 + (np * 64 + wc * 32 + pi * 16 + 4 * fq) * 2) = areg[np][m][pi];
    __syncthreads();
    if (SHARED) {
        gemm2_stream64<128, 272>(W2, ACT, lds + 36864, [&](int nt, const f32x4 (&acc)[4][4]) {
#pragma unroll
            for (int m = 0; m < 4; ++m) {
                unsigned char* o = ys_row(p, ysbase + m0 + wr * 64 + m * 16 + fr) + nt * 128 + wc * 64 + 8 * fq;
#pragma unroll
                for (int g = 0; g < 2; ++g) *(u32x2*)(o + g * 32) = (u32x2){pk4_fp8(acc[m][2 * g]), pk4_fp8(acc[m][2 * g + 1])};
            }
        });
    } else {
        gemm2_stream64<128, 272>(W2, ACT, lds + 36864, [&](int nt, const f32x4 (&acc)[4][4]) {
#pragma unroll
            for (int m = 0; m < 4; ++m) {
                const int rl = wr * 64 + m * 16 + fr;
                if (rl < nvalid) {
                    unsigned char* o = ys_row(p, ysbase + s0 + rl) + nt * 128 + wc * 64 + 8 * fq;
#pragma unroll
                    for (int g = 0; g < 2; ++g) *(u32x2*)(o + g * 32) = (u32x2){pk4_fp8(acc[m][2 * g]), pk4_fp8(acc[m][2 * g + 1])};
                }
            }
        });
    }
    __syncthreads();
}
DEV void phase_moe(const Params& p, int l, int r, char* lds) {
    const int* cnt = (const int*)(p.ws + OFF_CNT) + l * 64 * 64;
    moe_plan(cnt, p.cap, l, lds);
    const int* PL = (const int*)(lds + PLAN_OFF);
    if (r >= PL[0]) return;
    const int e_lo = PL[1 + r], e_hi = PL[2 + r];
    const int nrt = PL[10 + r];
    const int nrows = (l == 0) ? NT : NLAT;
    const int nshu = (r == 0) ? 2 * (nrows / 128) : 0;
    const int G = (int)gridDim.x, b = vblock();
    const int q = (nshu + nrt + G - 1) / G;
    const int u0 = b * q, u1 = min(u0 + q, nshu + nrt);
    int e = e_lo;
    for (int u = u0; u < u1; ++u) {
        if (u < nshu) {
            const int m0 = (u >> 1) * 128, hh = u & 1;
            moe_tile<true>(p, (const bf16_t*)(p.ws + OFF_SW13) + (size_t)(l * 2 + hh) * 256 * 1024, (const bf16_t*)(p.ws + OFF_SW2) + (size_t)(l * 2 + hh) * 1024 * 128,
                           nullptr, 0, 128, PL[208] + hh * nrows, m0, hh, nullptr, lds);
        } else {
            const int it = u - nshu;
            while (e + 1 < e_hi && PL[16 + e + 1] <= it) ++e;
            const int s0 = (it - PL[16 + e]) * 128;
            moe_tile<false>(p, (const bf16_t*)(p.ws + OFF_W13) + (size_t)e * 256 * 1024, (const bf16_t*)(p.ws + OFF_W2) + (size_t)e * 1024 * 128,
                            (const int*)(p.ws + OFF_LIST) + (size_t)e * NT, s0, min(128, PL[144 + e] - s0), PL[80 + e], 0, 0, nullptr, lds);
        }
    }
}

DEV void phase_comb(const Params& p, int l, int r, char* lds) {
    const int tid_ = get_tid(), lane = tid_ & 63, wid = tid_ >> 6;
    const int* cnt = (const int*)(p.ws + OFF_CNT) + l * 64 * 64;
    moe_plan(cnt, p.cap, l, lds);
    const int* PL = (const int*)(lds + PLAN_OFF);
    if (r >= PL[0]) return;
    const int e_lo = PL[1 + r], e_hi = PL[2 + r];
    const bool final = (r == PL[0] - 1);
    bf16_t* X = (bf16_t*)(p.ws + OFF_X);
    bf16_t* H = (bf16_t*)(p.ws + OFF_H);
    const int* tke = (const int*)(p.ws + OFF_TKE); const int* tks = (const int*)(p.ws + OFF_TKS);
    const float* mod = (const float*)(p.ws + OFF_MOD);
    const int nrows = (l == 0) ? NT : NLAT;
    for (int row = blockIdx.x * 4 + wid; row < nrows; row += gridDim.x * 4) {
        const int g = mod_group(row);
        const float* g2 = mod + ((size_t)l * 9 + g) * 6144 + 5120 + 16 * lane;
        int idx_l = -1;
        if (lane < 8) { const int e = tke[row * 8 + lane]; const int sl = tks[row * 8 + lane]; if (e >= e_lo && e < e_hi) idx_l = PL[80 + e] + sl; }
        f32x4 v[4];
        {
            const u32x4 a = *(const u32x4*)(X + (size_t)row * 1024 + 16 * lane), b2 = *(const u32x4*)(X + (size_t)row * 1024 + 16 * lane + 8);
            v[0] = (f32x4){__uint_as_float(a[0] << 16), __uint_as_float(a[0] & 0xffff0000u), __uint_as_float(a[1] << 16), __uint_as_float(a[1] & 0xffff0000u)};
            v[1] = (f32x4){__uint_as_float(a[2] << 16), __uint_as_float(a[2] & 0xffff0000u), __uint_as_float(a[3] << 16), __uint_as_float(a[3] & 0xffff0000u)};
            v[2] = (f32x4){__uint_as_float(b2[0] << 16), __uint_as_float(b2[0] & 0xffff0000u), __uint_as_float(b2[1] << 16), __uint_as_float(b2[1] & 0xffff0000u)};
            v[3] = (f32x4){__uint_as_float(b2[2] << 16), __uint_as_float(b2[2] & 0xffff0000u), __uint_as_float(b2[3] << 16), __uint_as_float(b2[3] & 0xffff0000u)};
        }
        u32x4 y[10];
#pragma unroll
        for (int k = 0; k < 8; ++k) {
            const int idx = __builtin_amdgcn_readlane(idx_l, k);
            if (idx >= 0) y[k] = *(const u32x4*)(ys_row(p, idx) + 16 * lane); else y[k] = (u32x4){0u, 0u, 0u, 0u};
        }
        if (r == 0) { y[8] = *(const u32x4*)(ys_row(p, PL[208] + row) + 16 * lane); y[9] = *(const u32x4*)(ys_row(p, PL[208] + nrows + row) + 16 * lane); }
        else { y[8] = (u32x4){0u, 0u, 0u, 0u}; y[9] = y[8]; }
        f32x4 s[4];
#pragma unroll
        for (int j = 0; j < 4; ++j) s[j] = (f32x4){0.f, 0.f, 0.f, 0.f};
#pragma unroll
        for (int k = 0; k < 10; ++k)
#pragma unroll
            for (int j = 0; j < 4; ++j) s[j] += up4_fp8(y[k][j]);
        const float xs = (r == 0) ? DN_ALPHA : 1.0f;
#pragma unroll
        for (int j = 0; j < 4; ++j) v[j] = v[j] * xs + *(const f32x4*)(g2 + 4 * j) * (s[j] * YS_INV);
        if (!final) {
            u32x4 o0, o1;
            o0 = (u32x4){pk2(v[0][0], v[0][1]), pk2(v[0][2], v[0][3]), pk2(v[1][0], v[1][1]), pk2(v[1][2], v[1][3])};
            o1 = (u32x4){pk2(v[2][0], v[2][1]), pk2(v[2][2], v[2][3]), pk2(v[3][0], v[3][1]), pk2(v[3][2], v[3][3])};
            *(u32x4*)(X + (size_t)row * 1024 + 16 * lane) = o0; *(u32x4*)(X + (size_t)row * 1024 + 16 * lane + 8) = o1;
        } else {
            row_norm(v);
#pragma unroll
            for (int j = 0; j < 4; ++j) {
                const int c = 16 * lane + 4 * j;
                v[j] = v[j] * *(const f32x4*)(p.ln2_g + l * 1024 + c) + *(const f32x4*)(p.ln2_b + l * 1024 + c);
                if (l != 0) *(f32x4*)(p.out + (size_t)row * 1024 + c) = v[j];
            }
            if (l == 0) {
                u32x4 o0, o1;
                o0 = (u32x4){pk2(v[0][0], v[0][1]), pk2(v[0][2], v[0][3]), pk2(v[1][0], v[1][1]), pk2(v[1][2], v[1][3])};
                o1 = (u32x4){pk2(v[2][0], v[2][1]), pk2(v[2][2], v[2][3]), pk2(v[3][0], v[3][1]), pk2(v[3][2], v[3][3])};
                *(u32x4*)(X + (size_t)row * 1024 + 16 * lane) = o0; *(u32x4*)(X + (size_t)row * 1024 + 16 * lane + 8) = o1;
                row_norm(v);
                const float* m1 = mod + ((size_t)9 + g) * 6144 + 16 * lane;
                f32x4 h[4];
#pragma unroll
                for (int j = 0; j < 4; ++j) h[j] = v[j] * (*(const f32x4*)(m1 + 1024 + 4 * j) + 1.0f) + *(const f32x4*)(m1 + 4 * j);
                o0 = (u32x4){pk2(h[0][0], h[0][1]), pk2(h[0][2], h[0][3]), pk2(h[1][0], h[1][1]), pk2(h[1][2], h[1][3])};
                o1 = (u32x4){pk2(h[2][0], h[2][1]), pk2(h[2][2], h[2][3]), pk2(h[3][0], h[3][1]), pk2(h[3][2], h[3][3])};
                *(u32x4*)(H + (size_t)row * 1024 + 16 * lane) = o0; *(u32x4*)(H + (size_t)row * 1024 + 16 * lane + 8) = o1;
            }
        }
    }
    if (final && l == 0) {
        __syncthreads();
        conv_run(p, 1, (int)blockIdx.x * 12, 12, lds);
    }
}


#define XB_TMO      128
#define XB_XCNT(j)  (256  + 64 * (j))
#define XB_XSUB(j)  (1280 + 64 * (j))
#define XB_XGEN(j)  (2304 + 64 * (j))
#define XB_TOP      3328
#define XB_TOPGEN   3392
#define XCD_BAR_WORDS 3456
#define XB_SPIN_CAP (1u << 22)
DEV unsigned xb_ld(unsigned* p) { return __hip_atomic_load(p, __ATOMIC_RELAXED, __HIP_MEMORY_SCOPE_AGENT); }
DEV unsigned xb_add(unsigned* p, unsigned v) { return __hip_atomic_fetch_add(p, v, __ATOMIC_RELAXED, __HIP_MEMORY_SCOPE_AGENT); }
DEV unsigned xb_xcc_id() { return (unsigned)__builtin_amdgcn_s_getreg((3 << 11) | 20) & 0xFu; }
#define XB_SPIN(cond, bar) do { unsigned _sp = 0; while (cond) { __builtin_amdgcn_s_sleep(1); \
    if ((++_sp & 255u) == 0u) { if (xb_ld(&(bar)[XB_TMO])) break; if (_sp > XB_SPIN_CAP) { atomicAdd(&(bar)[XB_TMO], 1u); break; } } } } while (0)
struct XcdBarrier { unsigned* bar; unsigned x; volatile LAS unsigned* st; };
DEV XcdBarrier xcd_barrier_post(unsigned* bar, volatile LAS unsigned* st) {
    XcdBarrier b; b.bar = bar; b.x = xb_xcc_id(); b.st = st;
    if (threadIdx.x == 0) (void)xb_add(&bar[XB_XCNT(b.x)], 1u);
    return b;
}
DEV void xcd_barrier_complete(unsigned* bar, unsigned x, unsigned& nloc, unsigned& nx) {
    const unsigned G = gridDim.x * gridDim.y * gridDim.z;
    unsigned sum, cnt, mine, sp = 0u;
    for (;;) {
        sum = 0u; cnt = 0u; mine = 0u;
#pragma unroll
        for (unsigned j = 0; j < 16; ++j) { const unsigned c = xb_ld(&bar[XB_XCNT(j)]); sum += c; cnt += (c > 0u) ? 1u : 0u; mine = (j == x) ? c : mine; }
        if (sum == G) break;
        __builtin_amdgcn_s_sleep(1);
        if ((++sp & 255u) == 0u) { if (xb_ld(&bar[XB_TMO])) break; if (sp > XB_SPIN_CAP) { atomicAdd(&bar[XB_TMO], 1u); break; } }
    }
    nloc = mine > 0u ? mine : 1u; nx = cnt > 0u ? cnt : 1u;
}
DEV void xcd_barrier(const XcdBarrier& b) {
    asm volatile("s_waitcnt vmcnt(0)" ::: "memory");
    __syncthreads();
    if (get_tid() == 0) {
        unsigned* bar = b.bar; asm volatile("" : "+s"(bar));
        __builtin_amdgcn_s_waitcnt(0);
        unsigned nloc = b.st[0], nx = b.st[1];
        if (nloc == 0u) { xcd_barrier_complete(bar, b.x, nloc, nx); b.st[0] = nloc; b.st[1] = nx; }
        const unsigned old = xb_add(&bar[XB_XSUB(b.x)], 1u);
        const unsigned gen = old / nloc;
        if (old + 1u == (gen + 1u) * nloc) {
            __builtin_amdgcn_fence(__ATOMIC_RELEASE, "agent");
            asm volatile("s_waitcnt vmcnt(0)" ::: "memory");
            const unsigned og = xb_add(&bar[XB_TOP], 1u);
            const unsigned tg = og / nx;
            if (og + 1u == (tg + 1u) * nx) xb_add(&bar[XB_TOPGEN], 1u);
            else XB_SPIN(xb_ld(&bar[XB_TOPGEN]) == tg, bar);
            __builtin_amdgcn_fence(__ATOMIC_ACQUIRE, "agent");
            xb_add(&bar[XB_XGEN(b.x)], 1u);
            asm volatile("s_waitcnt vmcnt(0)" ::: "memory");
        } else {
            XB_SPIN(xb_ld(&bar[XB_XGEN(b.x)]) == gen, bar);
            __builtin_amdgcn_fence(__ATOMIC_ACQUIRE, "agent");
            asm volatile("s_waitcnt vmcnt(0)" ::: "memory");
        }
    }
    __syncthreads();
}

enum { PT_PREP = 0, PT_MODFIN, PT_LNMOD0, PT_INPROJ, PT_MIX, PT_OUTPROJ, PT_LN1ROUTE, PT_MOE, PT_COMB };

DEV void run_phase(const Params& pin, int type, int l, int r, char* lds) {
    Params p = pin;
    { unsigned char* w = p.ws; asm volatile("" : "+s"(w)); p.ws = w; }
    switch (type) {
        case PT_PREP: phase_prep(p, lds); break;
        case PT_MODFIN: phase_modfin(p); break;
        case PT_LNMOD0: phase_lnmod0(p); break;
        case PT_INPROJ: phase_inproj(p, l, lds); break;
        case PT_MIX: phase_mix(p, l, lds); break;
        case PT_OUTPROJ: phase_outproj(p, l, lds); break;
        case PT_LN1ROUTE: phase_ln1route(p, l, lds); break;
        case PT_MOE: phase_moe(p, l, r, lds); break;
        default: phase_comb(p, l, r, lds); break;
    }
}

__global__ void __launch_bounds__(256, 2) fwd_kernel(Params p) {
    __shared__ __attribute__((aligned(16))) char smem[SMEM_BYTES];
#if MULTI_LAUNCH
    run_phase(p, p.ptype, p.pl, p.pr, smem);
#else
    if (threadIdx.x < 4) ((volatile LAS unsigned*)(smem + SMEM_BYTES - 16))[threadIdx.x] = 0u;
    __syncthreads();
    const XcdBarrier bar = xcd_barrier_post((unsigned*)(p.ws + OFF_BAR), (volatile LAS unsigned*)(smem + SMEM_BYTES - 16));
    int type = PT_PREP, l = 0, r = 0;
    for (;;) {
        run_phase(p, type, l, r, smem);
        if (type < PT_MOE) { ++type; if (type == PT_MODFIN) ++type; r = 0; }
        else if (type == PT_MOE) type = PT_COMB;
        else {
            const int nr = ((const int*)(smem + PLAN_OFF))[0];
            if (r + 1 < nr) { ++r; type = PT_MOE; }
            else { if (l == 1) break; l = 1; r = 0; type = PT_INPROJ; }
        }
        xcd_barrier(bar);
    }
#endif
}

extern "C" void kernel_launch(void* const* d_in, const int* in_sizes, int n_in, void* d_out, int out_size, void* d_ws, size_t ws_size, hipStream_t stream) {
    Params p{};
    const float** pp = (const float**)&p;
    for (int i = 0; i < 32; ++i) pp[i] = (const float*)d_in[i];
    p.out = (float*)d_out; p.ws = (unsigned char*)d_ws;
    long long cap = ((long long)ws_size - (long long)OFF_R) / 2048;
    if (cap > NT * 8) cap = NT * 8;
    if (cap * 2048 < (long long)R_MIN_BYTES || cap < NT) { fprintf(stderr, "kernel_launch: workspace too small (%zu)\n", ws_size); return; }
    p.cap = (int)cap;
#if MULTI_LAUNCH
    const int grid = 512;
    auto launch = [&](int type, int l, int r) { Params q = p; q.mode = 1; q.ptype = type; q.pl = l; q.pr = r; hipLaunchKernelGGL(fwd_kernel, dim3(grid), dim3(256), 0, stream, q); };
    launch(PT_PREP, 0, 0); launch(PT_MODFIN, 0, 0); launch(PT_LNMOD0, 0, 0);
    for (int l = 0; l < 2; ++l) {
        launch(PT_INPROJ, l, 0); launch(PT_MIX, l, 0); launch(PT_OUTPROJ, l, 0); launch(PT_LN1ROUTE, l, 0);
        for (int r = 0; r < RMAX; ++r) { launch(PT_MOE, l, r); launch(PT_COMB, l, r); }
    }
#else
    static int grid_blocks = 0;
    if (!grid_blocks) {
        int dev = 0, cus = 0, per_cu = 0;
        hipGetDevice(&dev);
        hipDeviceGetAttribute(&cus, hipDeviceAttributeMultiprocessorCount, dev);
        hipOccupancyMaxActiveBlocksPerMultiprocessor(&per_cu, fwd_kernel, 256, 0);
        if (per_cu > 2) per_cu = 2;
        if (per_cu < 1) per_cu = 1;
        grid_blocks = cus * per_cu;
    }
    p.mode = 0;
    hipMemsetAsync(d_ws, 0, 65536, stream);
    hipLaunchKernelGGL(fwd_kernel, dim3(grid_blocks), dim3(256), 0, stream, p);
#endif
}
```

```cpp
#include <hip/hip_runtime.h>
#ifndef TELEM
#define TELEM 0
#endif
#define TELEM_A 0x1
#define TELEM_C 8
#include <hip/hip_cooperative_groups.h>
#include <stdint.h>
#include <stdio.h>
namespace cg = cooperative_groups;

#ifndef MULTI_LAUNCH
#define MULTI_LAUNCH 0
#endif

typedef unsigned short bf16_t;
typedef short bf16x8 __attribute__((ext_vector_type(8)));
typedef short s16x4 __attribute__((ext_vector_type(4)));
typedef float f32x4 __attribute__((ext_vector_type(4)));
typedef unsigned u32x4 __attribute__((ext_vector_type(4)));
typedef unsigned u32x2 __attribute__((ext_vector_type(2)));
#define DEV __device__ __forceinline__
#define LDSP(T) __attribute__((address_space(3))) T*
#define LAS __attribute__((address_space(3)))

constexpr int D = 1024, NB = 8, SEQ = 2048, CTX = 256, NLAT = NB * SEQ, NCTX = NB * CTX, NT = NLAT + NCTX;
constexpr int PROJ = 2304, KEYS = CTX + SEQ, NEXP = 64;
constexpr float DN_ALPHA = 1.41421356237309515f;
constexpr float LOG2E = 1.44269504088896341f;
constexpr int SMEM_BYTES = 72 * 1024;
constexpr int RMAX = 4;

constexpr size_t OFF_CNT = 0;
constexpr size_t OFF_QUEUE = 33792;
constexpr size_t OFF_BAR = 40960;
constexpr size_t OFF_MOD = 65536;
constexpr size_t OFF_ROPE = OFF_MOD + 442368;
constexpr size_t OFF_KERNL = OFF_ROPE + 2ull * 2048 * 32 * 4;
constexpr size_t OFF_KERNC = OFF_KERNL + 2ull * 4096 * 256 * 4;
constexpr size_t OFF_TKE = OFF_KERNC + 2ull * 512 * 256 * 4;
constexpr size_t OFF_TKS = OFF_TKE + (size_t)NT * 8 * 4;
constexpr size_t OFF_TKW = OFF_TKS + (size_t)NT * 8 * 4;
constexpr size_t OFF_LIST = OFF_TKW + (size_t)NT * 8 * 4;
constexpr size_t OFF_WIN = OFF_LIST + 64ull * NT * 4;
constexpr size_t OFF_WOUT = OFF_WIN + 2ull * 2304 * 1024 * 2;
constexpr size_t OFF_SW13 = OFF_WOUT + 2ull * 1024 * 1024 * 2;
constexpr size_t OFF_SW2 = OFF_SW13 + 2ull * 512 * 1024 * 2;
constexpr size_t OFF_RW = OFF_SW2 + 2ull * 1024 * 256 * 2;
constexpr size_t OFF_W13 = OFF_RW + 2ull * 64 * 1024 * 2;
constexpr size_t OFF_W2 = OFF_W13 + 64ull * 256 * 1024 * 2;
constexpr size_t OFF_X = OFF_W2 + 64ull * 1024 * 128 * 2;
constexpr size_t OFF_H = OFF_X + (size_t)NT * 1024 * 2;
constexpr size_t OFF_R = OFF_H + (size_t)NT * 1024 * 2;
constexpr size_t OFF_QA = OFF_R;
constexpr size_t OFF_QB = OFF_QA + 8ull * NT * 64 * 2;
constexpr size_t OFF_KA = OFF_QB + 4ull * NT * 64 * 2;
constexpr size_t OFF_VA = OFF_KA + 8ull * 2 * KEYS * 64 * 2;
constexpr size_t OFF_KB = OFF_VA + 8ull * 2 * KEYS * 64 * 2;
constexpr size_t OFF_VB = OFF_KB + 8ull * 4 * KEYS * 64 * 2;
constexpr size_t OFF_ZTL = OFF_VB + 8ull * 4 * KEYS * 64 * 2;
constexpr size_t OFF_ZTC = OFF_ZTL + 8ull * 768 * 2048 * 2;
constexpr size_t OFF_OX = OFF_ZTC + 8ull * 768 * 256 * 2;
constexpr size_t OFF_OXT = OFF_OX + (size_t)NT * 1024 * 2;
constexpr size_t R_MIN_BYTES = OFF_OXT + 8ull * 256 * 2048 * 2 - OFF_R;
constexpr size_t OFF_PART = OFF_R;
constexpr size_t OFF_YS = OFF_R;

struct Params {
    const float *x, *c, *ctx, *c_ctx, *ada_w, *ada_b, *w_in, *q_gain, *k_gain, *nat_rpb, *hy_conv_w, *hy_conv_b,
        *hy_f_w1, *hy_f_b1, *hy_f_w2, *hy_f_b2, *hy_f_w3, *hy_freq, *hy_skip, *w_out, *ln1_g, *ln1_b,
        *router_w, *router_b, *exp_w1, *exp_w3, *exp_w2, *sh_w1, *sh_w3, *sh_w2, *ln2_g, *ln2_b;
    float* out; unsigned char* ws;
    int cap, mode, ptype, pl, pr, pad;
};

typedef __bf16 hwbf2 __attribute__((ext_vector_type(2)));
typedef float f32x2 __attribute__((ext_vector_type(2)));
DEV unsigned f2bf(float f) { return (unsigned)__builtin_bit_cast(unsigned short, (__bf16)f); }
DEV unsigned pk2(float lo, float hi) { const f32x2 v = {lo, hi}; return __builtin_bit_cast(unsigned, __builtin_convertvector(v, hwbf2)); }
DEV float bf2f(unsigned short h) { return __uint_as_float(((unsigned)h) << 16); }
DEV float wave_sum(float v) {
#pragma unroll
    for (int o = 32; o > 0; o >>= 1) v += __shfl_xor(v, o);
    return v;
}
DEV void glds16(const void* g, void* l) { __builtin_amdgcn_global_load_lds((const unsigned*)g, (unsigned*)l, 16, 0, 0); }
DEV f32x4 mfma16(bf16x8 a, bf16x8 b, f32x4 c) { return __builtin_amdgcn_mfma_f32_16x16x32_bf16(a, b, c, 0, 0, 0); }
DEV float readlane_f(float v, int l) { return __uint_as_float((unsigned)__builtin_amdgcn_readlane((int)__float_as_uint(v), l)); }
DEV int get_tid() { int t = threadIdx.x; asm volatile("" : "+v"(t)); return t; }
DEV int lchunk(int tid) { return (tid & 3) ^ ((0 - (tid >> 4)) & 3); }
DEV int vblock() { const int G = (int)gridDim.x, b = (int)blockIdx.x; return (G & 7) ? b : (b & 7) * (G >> 3) + (b >> 3); }
DEV int mod_group(int row) { return row < NLAT ? (row >> 11) : 8; }

template <int MI, int NI> DEV void zero_acc(f32x4 (&acc)[MI][NI]) {
#pragma unroll
    for (int m = 0; m < MI; ++m)
#pragma unroll
        for (int n = 0; n < NI; ++n) acc[m][n] = (f32x4){0.f, 0.f, 0.f, 0.f};
}
#define WAIT_VM(n) asm volatile("s_waitcnt vmcnt(" #n ")" ::: "memory")
#define WAIT_LGKM0() asm volatile("s_waitcnt lgkmcnt(0)" ::: "memory")
#define RAW_BARRIER() do { asm volatile("" ::: "memory"); __builtin_amdgcn_s_barrier(); asm volatile("" ::: "memory"); } while (0)
template <int MI, int NI, bool TRANS>
DEV void gemm_core(f32x4 (&acc)[MI][NI], const bf16_t* A, const unsigned (&ao)[MI / 2], const bf16_t* B, const unsigned (&bo)[NI / 2], int K, char* lds) {
    const int tid = get_tid(), lane = tid & 63, wid = tid >> 6, fr = lane & 15, fq = lane >> 4, wr = wid >> 1, wc = wid & 1;
    constexpr int SAB = 2048 * MI, STG = 2048 * (MI + NI), LPT = MI / 2 + NI / 2;
    static_assert(LPT == 3 || LPT == 4 || LPT == 6, "loads per tile");
    const int nt = K >> 5;
    auto stage = [&](int s, int t) {
        char* SA = lds + s * STG; char* SB = SA + SAB;
#pragma unroll
        for (int i = 0; i < MI / 2; ++i) glds16(A + (ao[i] + (unsigned)(t * 32)), SA + i * 4096 + tid * 16);
#pragma unroll
        for (int i = 0; i < NI / 2; ++i) glds16(B + (bo[i] + (unsigned)(t * 32)), SB + i * 4096 + tid * 16);
    };
    WAIT_VM(0);
    stage(0, 0);
    if (nt > 1) stage(1, 1);
    const int sw = (fq ^ ((0 - (fr >> 2)) & 3)) * 16;
    const int aoff = (wr * MI * 16 + fr) * 64 + sw, boff = SAB + (wc * NI * 16 + fr) * 64 + sw;
#pragma unroll 1
    for (int t = 0; t < nt; ++t) {
        if (t + 1 < nt) { if (LPT == 6) WAIT_VM(6); else if (LPT == 4) WAIT_VM(4); else WAIT_VM(3); } else WAIT_VM(0);
        RAW_BARRIER();
        const char* S = lds + (t & 1) * STG;
        bf16x8 af[MI], bfr[NI];
#pragma unroll
        for (int m = 0; m < MI; ++m) af[m] = *(const bf16x8*)(S + aoff + m * 1024);
#pragma unroll
        for (int n = 0; n < NI; ++n) bfr[n] = *(const bf16x8*)(S + boff + n * 1024);
        WAIT_LGKM0();
        RAW_BARRIER();
        if (t + 2 < nt) stage(t & 1, t + 2);
#pragma unroll
        for (int m = 0; m < MI; ++m)
#pragma unroll
            for (int n = 0; n < NI; ++n) acc[m][n] = TRANS ? mfma16(bfr[n], af[m], acc[m][n]) : mfma16(af[m], bfr[n], acc[m][n]);
    }
}
DEV unsigned st64_off(int tid) { return (unsigned)(tid >> 3) * 1024u + (unsigned)(((tid & 7) ^ ((tid >> 3) & 7)) * 8); }
DEV int tr_key(int row) { return (row & 3) | (((row >> 3) & 1) << 2); }
template <bool TRANS>
DEV void gemm_core64(f32x4 (&acc)[4][4], const bf16_t* A, const unsigned (&ao)[4], const bf16_t* B, const unsigned (&bo)[4], int K, char* lds,
                     const bf16_t* AT = nullptr, int t_tr = 1 << 20) {
    const int tid = get_tid(), lane = tid & 63, wid = tid >> 6, fr = lane & 15, fq = lane >> 4, wr = wid >> 1, wc = wid & 1;
    const int nt = K >> 6;
    auto stage = [&](int s, int t) {
        char* SA = lds + s * 32768; char* SB = SA + 16384;
        if (t >= t_tr) {
#pragma unroll
            for (int i = 0; i < 4; ++i) {
                const int id = tid + 256 * i, row = id >> 4, cp = id & 15, c = (cp - 2 * tr_key(row)) & 15;
                glds16(AT + (size_t)((t - t_tr) * 64 + row) * 2048 + c * 8, SA + id * 16);
            }
        } else {
#pragma unroll
            for (int i = 0; i < 4; ++i) glds16(A + (ao[i] + (unsigned)(t * 64)), SA + i * 4096 + tid * 16);
        }
#pragma unroll
        for (int i = 0; i < 4; ++i) glds16(B + (bo[i] + (unsigned)(t * 64)), SB + i * 4096 + tid * 16);
    };
    WAIT_VM(0);
    stage(0, 0);
    if (nt > 1) stage(1, 1);
    const int rsw = fr & 7;
    const int arow = (wr * 64 + fr) * 128, brow = 16384 + (wc * 64 + fr) * 128;
    const int c0 = ((fq) ^ rsw) * 16, c1 = ((4 + fq) ^ rsw) * 16;
#pragma unroll 1
    for (int t = 0; t < nt; ++t) {
        if (t + 1 < nt) WAIT_VM(8); else WAIT_VM(0);
        RAW_BARRIER();
        const char* S = lds + (t & 1) * 32768;
        bf16x8 af[4][2], bfr[4][2];
        if (t >= t_tr) {
            const int q4 = fr >> 2, p4 = fr & 3;
#pragma unroll
            for (int m = 0; m < 4; ++m)
#pragma unroll
                for (int ks = 0; ks < 2; ++ks) {
                    const int rowA = ks * 32 + 8 * fq + q4, rowB = rowA + 4, c = wr * 8 + m * 2 + (p4 >> 1);
                    const int offA = rowA * 256 + (((c + 2 * tr_key(rowA)) & 15) * 16) + (p4 & 1) * 8;
                    const int offB = rowB * 256 + (((c + 2 * tr_key(rowB)) & 15) * 16) + (p4 & 1) * 8;
                    const s16x4 ta = __builtin_amdgcn_ds_read_tr16_b64_v4i16((LDSP(s16x4))(S + offA));
                    const s16x4 tb = __builtin_amdgcn_ds_read_tr16_b64_v4i16((LDSP(s16x4))(S + offB));
                    bf16x8 f; f[0] = ta[0]; f[1] = ta[1]; f[2] = ta[2]; f[3] = ta[3]; f[4] = tb[0]; f[5] = tb[1]; f[6] = tb[2]; f[7] = tb[3];
                    af[m][ks] = f;
                }
        } else {
#pragma unroll
            for (int m = 0; m < 4; ++m) { af[m][0] = *(const bf16x8*)(S + arow + m * 2048 + c0); af[m][1] = *(const bf16x8*)(S + arow + m * 2048 + c1); }
        }
#pragma unroll
        for (int n = 0; n < 4; ++n) { bfr[n][0] = *(const bf16x8*)(S + brow + n * 2048 + c0); bfr[n][1] = *(const bf16x8*)(S + brow + n * 2048 + c1); }
        WAIT_LGKM0();
        RAW_BARRIER();
        if (t + 2 < nt) stage(t & 1, t + 2);
        __builtin_amdgcn_s_setprio(1);
#pragma unroll
        for (int ks = 0; ks < 2; ++ks)
#pragma unroll
            for (int m = 0; m < 4; ++m)
#pragma unroll
                for (int n = 0; n < 4; ++n) acc[m][n] = TRANS ? mfma16(bfr[n][ks], af[m][ks], acc[m][n]) : mfma16(af[m][ks], bfr[n][ks], acc[m][n]);
        __builtin_amdgcn_s_setprio(0);
    }
}
template <int KACT, int ASTRIDE, class EPI>
DEV void gemm2_stream64(const bf16_t* W2, const char* ACT, char* sb, EPI&& epi) {
    const int tid = get_tid(), lane = tid & 63, wid = tid >> 6, fr = lane & 15, fq = lane >> 4, wr = wid >> 1, wc = wid & 1;
    constexpr int KS = KACT / 64, NJ = 8 * KS;
    const unsigned b0 = (unsigned)(tid >> 3) * KACT + (unsigned)(((tid & 7) ^ ((tid >> 3) & 7)) * 8);
    auto stage = [&](int s, int j) {
        const int nt = j / KS, ks = j % KS;
        char* SB = sb + s * 16384;
        const bf16_t* src = W2 + (size_t)nt * 128 * KACT + ks * 64 + b0;
#pragma unroll
        for (int i = 0; i < 4; ++i) glds16(src + (size_t)i * 32 * KACT, SB + i * 4096 + tid * 16);
    };
    WAIT_VM(0);
    stage(0, 0); stage(1, 1);
    const int rsw = fr & 7;
    const int brow = (wc * 64 + fr) * 128, c0 = (fq ^ rsw) * 16, c1 = ((4 + fq) ^ rsw) * 16;
    f32x4 acc[4][4]; zero_acc<4, 4>(acc);
#pragma unroll 1
    for (int j = 0; j < NJ; ++j) {
        const int ks = j % KS;
        if (j + 1 < NJ) WAIT_VM(4); else WAIT_VM(0);
        RAW_BARRIER();
        const char* S = sb + (j & 1) * 16384;
        bf16x8 af[4][2], bfr[4][2];
#pragma unroll
        for (int m = 0; m < 4; ++m) { const char* ar = ACT + (wr * 64 + m * 16 + fr) * ASTRIDE + (ks * 64 + fq * 8) * 2; af[m][0] = *(const bf16x8*)ar; af[m][1] = *(const bf16x8*)(ar + 64); }
#pragma unroll
        for (int n = 0; n < 4; ++n) { bfr[n][0] = *(const bf16x8*)(S + brow + n * 2048 + c0); bfr[n][1] = *(const bf16x8*)(S + brow + n * 2048 + c1); }
        WAIT_LGKM0();
        RAW_BARRIER();
        if (j + 2 < NJ) stage(j & 1, j + 2);
#pragma unroll
        for (int k2 = 0; k2 < 2; ++k2)
#pragma unroll
            for (int m = 0; m < 4; ++m)
#pragma unroll
                for (int n = 0; n < 4; ++n) acc[m][n] = mfma16(bfr[n][k2], af[m][k2], acc[m][n]);
        if (ks == KS - 1) { epi(j / KS, acc); zero_acc<4, 4>(acc); }
    }
}
template <int MI, int KACT, int ASTRIDE, class EPI>
DEV void gemm2_stream(const bf16_t* W2, const char* ACT, char* sb, EPI&& epi) {
    const int tid = get_tid(), lane = tid & 63, wid = tid >> 6, fr = lane & 15, fq = lane >> 4, wr = wid >> 1, wc = wid & 1;
    constexpr int KS = KACT / 32, NJ = 8 * KS;
    const bf16_t* b0 = W2 + (size_t)(tid >> 2) * KACT + lchunk(tid) * 8;
    auto stage = [&](int s, int j) {
        const int nt = j / KS, ks = j % KS;
        char* SB = sb + s * 8192;
        const bf16_t* src = b0 + (size_t)nt * 128 * KACT + ks * 32;
        glds16(src, SB + tid * 16);
        glds16(src + 64 * KACT, SB + 4096 + tid * 16);
    };
    WAIT_VM(0);
    stage(0, 0); stage(1, 1);
    const int boff = (wc * 64 + fr) * 64 + (fq ^ ((0 - (fr >> 2)) & 3)) * 16;
    f32x4 acc[MI][4]; zero_acc<MI, 4>(acc);
#pragma unroll 1
    for (int j = 0; j < NJ; ++j) {
        const int ks = j % KS;
        if (j + 1 < NJ) WAIT_VM(2); else WAIT_VM(0);
        RAW_BARRIER();
        const char* S = sb + (j & 1) * 8192;
        bf16x8 af[MI], bfr[4];
#pragma unroll
        for (int m = 0; m < MI; ++m) af[m] = *(const bf16x8*)(ACT + (wr * MI * 16 + m * 16 + fr) * ASTRIDE + (ks * 32 + fq * 8) * 2);
#pragma unroll
        for (int n = 0; n < 4; ++n) bfr[n] = *(const bf16x8*)(S + boff + n * 1024);
        WAIT_LGKM0();
        RAW_BARRIER();
        if (j + 2 < NJ) stage(j & 1, j + 2);
#pragma unroll
        for (int m = 0; m < MI; ++m)
#pragma unroll
            for (int n = 0; n < 4; ++n) acc[m][n] = mfma16(bfr[n], af[m], acc[m][n]);
        if (ks == KS - 1) { epi(j / KS, acc); zero_acc<MI, 4>(acc); }
    }
}

DEV void prep_mod_item(const Params& p, int it, char* lds) {
    const int l = it / 96, r = it % 96, cch = r >> 2, kp = r & 3, tid = get_tid(), lane = tid & 63, kq = tid >> 6;
    float* sl = (float*)lds;
    float* red = sl + 9 * 256;
    for (int i = tid; i < 9 * 256; i += 256) { const int g = i >> 8, k = kp * 256 + (i & 255); const float v = (g < 8) ? p.c[g * 1024 + k] : p.c_ctx[k]; sl[i] = v * __builtin_amdgcn_rcpf(1.f + __expf(-v)); }
    __syncthreads();
    f32x4 acc[9];
#pragma unroll
    for (int g = 0; g < 9; ++g) acc[g] = (f32x4){0.f, 0.f, 0.f, 0.f};
    const float* w = p.ada_w + ((size_t)l * 1024 + kp * 256 + kq * 64) * 6144 + cch * 256 + lane * 4;
#pragma unroll 16
    for (int kk = 0; kk < 64; ++kk) {
        const f32x4 wv = *(const f32x4*)(w + (size_t)kk * 6144);
#pragma unroll
        for (int g = 0; g < 9; ++g) { const float sv = sl[g * 256 + kq * 64 + kk]; acc[g] += sv * wv; }
    }
#pragma unroll
    for (int g = 0; g < 9; ++g) *(f32x4*)(red + (kq * 9 + g) * 256 + lane * 4) = acc[g];
    __syncthreads();
    float* part = (float*)(p.ws + OFF_R) + (size_t)(l * 24 + cch) * 4 * 2304;
    for (int i = tid; i < 9 * 256; i += 256) {
        const int g = i >> 8, c = i & 255;
        part[kp * 2304 + i] = (red[(0 * 9 + g) * 256 + c] + red[(1 * 9 + g) * 256 + c]) + (red[(2 * 9 + g) * 256 + c] + red[(3 * 9 + g) * 256 + c]);
    }
    __threadfence();
    __syncthreads();
    int* arrive = (int*)(lds + SMEM_BYTES - 252);
    if (tid == 0) *arrive = atomicAdd((int*)(p.ws + OFF_QUEUE) + 256 + l * 24 + cch, 1);
    __syncthreads();
    if (*arrive == 3) {
        __threadfence();
        float* mod = (float*)(p.ws + OFF_MOD);
        for (int i = tid; i < 9 * 256; i += 256) {
            const int g = i >> 8, c = i & 255;
            const float v = (__builtin_nontemporal_load(part + i) + __builtin_nontemporal_load(part + 2304 + i)) + (__builtin_nontemporal_load(part + 2 * 2304 + i) + __builtin_nontemporal_load(part + 3 * 2304 + i));
            mod[((size_t)l * 9 + g) * 6144 + cch * 256 + c] = p.ada_b[l * 6144 + cch * 256 + c] + v;
        }
    }
    __syncthreads();
}
constexpr float INV2PI = 0.15915494309189535f;
DEV float sin_rev(float r) { return __builtin_amdgcn_sinf(__builtin_amdgcn_fractf(r)); }
DEV float cos_rev(float r) { return __builtin_amdgcn_cosf(__builtin_amdgcn_fractf(r)); }
DEV void prep_rope_item(const Params& p, int it) {
    const int idx = it * 256 + get_tid(), t = idx >> 5, i = idx & 31;
    const float inv = __builtin_amdgcn_exp2f(-(float)(2 * (i & 15)) * (13.287712379549449f / 32.f));
    const float ang = (float)((i < 16) ? (t >> 6) : (t & 63)) * inv;
    float* rc = (float*)(p.ws + OFF_ROPE);
    rc[idx] = cos_rev(ang * INV2PI); rc[2048 * 32 + idx] = sin_rev(ang * INV2PI);
}
DEV void prep_filter_item(const Params& p, int it, char* lds) {
    const int tid = get_tid(), lane = tid & 63, wid = tid >> 6;
    const int row0 = it * 32 + wid * 8;
    const int l = row0 / 2304, r0 = row0 % 2304, type = r0 < 2048 ? 0 : 1, t0 = type ? r0 - 2048 : r0, n = type ? 256 : 2048;
    float* z = (float*)lds + wid * (8 * 192); float* h1 = z + 8 * 64; float* h2 = h1 + 8 * 64;
    float* WL = (float*)(lds + 24576);
    const float rn1 = type ? 1.f / 255.f : 1.f / 2047.f;
    for (int idx = tid; idx < 97 * 16; idx += 256) {
        const int row = idx >> 4, c4 = (idx & 15) * 4;
        const float* src = row < 33 ? p.hy_f_w1 + (l * 33 + row) * 64 : p.hy_f_w2 + (l * 64 + row - 33) * 64;
        *(f32x4*)(WL + row * 64 + c4) = *(const f32x4*)(src + c4);
    }
#pragma unroll
    for (int rr = 0; rr < 8; ++rr) {
        const int t = t0 + rr;
        if (lane < 33) {
            float v;
            if (lane == 0) v = (float)t * rn1;
            else {
                const int i = (lane - 1) & 15;
                const float f = 1e-4f + (float)i * ((15.f - 1e-4f) / 15.f);
                const float rev = f * ((float)t * (type ? 1.f / 256.f : 1.f / 2048.f));
                v = (lane <= 16) ? cos_rev(rev) : -sin_rev(rev);
            }
            z[rr * 64 + lane] = v;
        }
    }
    __syncthreads();
    {
        float s[8]; const float b = p.hy_f_b1[l * 64 + lane];
#pragma unroll
        for (int rr = 0; rr < 8; ++rr) s[rr] = b;
#pragma unroll 11
        for (int i = 0; i < 33; ++i) {
            const float w = WL[i * 64 + lane];
#pragma unroll
            for (int rr = 0; rr < 8; ++rr) s[rr] += z[rr * 64 + i] * w;
        }
        const float fq0 = p.hy_freq[(l * 2 + 0) * 64 + lane];
#pragma unroll
        for (int rr = 0; rr < 8; ++rr) h1[rr * 64 + lane] = sin_rev(fq0 * s[rr] * INV2PI);
    }
    __builtin_amdgcn_wave_barrier();
    {
        float s[8]; const float b = p.hy_f_b2[l * 64 + lane];
#pragma unroll
        for (int rr = 0; rr < 8; ++rr) s[rr] = b;
#pragma unroll 16
        for (int i = 0; i < 64; ++i) {
            const float w = WL[(33 + i) * 64 + lane];
#pragma unroll
            for (int rr = 0; rr < 8; ++rr) s[rr] += h1[rr * 64 + i] * w;
        }
        const float fq1 = p.hy_freq[(l * 2 + 1) * 64 + lane];
#pragma unroll
        for (int rr = 0; rr < 8; ++rr) h2[rr * 64 + lane] = sin_rev(fq1 * s[rr] * INV2PI);
    }
    __syncthreads();
    float acc[8][8];
#pragma unroll
    for (int rr = 0; rr < 8; ++rr)
#pragma unroll
        for (int q = 0; q < 8; ++q) acc[rr][q] = 0.f;
    const float* w3 = p.hy_f_w3 + (size_t)l * 64 * 512;
#pragma unroll 1
    for (int ch = 0; ch < 4; ++ch) {
#pragma unroll
        for (int j = 0; j < 8; ++j) { const int idx = tid + j * 256; *(f32x4*)(WL + idx * 4) = *(const f32x4*)(w3 + (size_t)ch * 16 * 512 + idx * 4); }
        __syncthreads();
#pragma unroll 2
        for (int i = 0; i < 16; ++i) {
            float w[8];
#pragma unroll
            for (int q = 0; q < 8; ++q) w[q] = WL[i * 512 + q * 64 + lane];
#pragma unroll
            for (int rr = 0; rr < 8; ++rr) {
                const float hv = h2[rr * 64 + ch * 16 + i];
#pragma unroll
                for (int q = 0; q < 8; ++q) acc[rr][q] += hv * w[q];
            }
        }
        __syncthreads();
    }
    bf16_t* kf = (bf16_t*)(p.ws + (type ? OFF_KERNC + (size_t)l * 2 * 256 * 256 * 2 : OFF_KERNL + (size_t)l * 2 * 256 * 2048 * 2));
    const float lo = logf(1e-2f) / 1.5f, hi = logf(1e-2f) / 0.3f;
#pragma unroll
    for (int q = 0; q < 8; ++q) {
        const int qh = q >> 2, c = (q & 3) * 64 + lane;
        const float delta = fabsf(lo + (float)c * ((hi - lo) / 255.f));
        float v[8];
#pragma unroll
        for (int rr = 0; rr < 8; ++rr) { const float tt = (float)(t0 + rr) * rn1; v[rr] = acc[rr][q] * __expf(-tt * delta); }
        if (qh == 0 && t0 == 0) v[0] += p.hy_skip[l * 256 + c];
        *(u32x4*)(kf + ((size_t)qh * 256 + c) * n + t0) = (u32x4){pk2(v[0], v[1]), pk2(v[2], v[3]), pk2(v[4], v[5]), pk2(v[6], v[7])};
    }
}
struct ConvDesc { const float* src; bf16_t* dst; int ldsrc, k0, n0, lddst, mapkind; };
DEV void conv_load(const ConvDesc& d, f32x4 (&v)[4], int tid) {
    const int r = tid >> 4, c4 = (tid & 15) * 4;
#pragma unroll
    for (int i = 0; i < 4; ++i) v[i] = *(const f32x4*)(d.src + (size_t)(d.k0 + r + 16 * i) * d.ldsrc + d.n0 + c4);
}
DEV void conv_store(const ConvDesc& d, const f32x4 (&v)[4], char* lds, int tid) {
    float* tl = (float*)lds;
    {
        const int r = tid >> 4, c4 = (tid & 15) * 4;
#pragma unroll
        for (int i = 0; i < 4; ++i) { const int row = r + 16 * i; tl[row * 65 + c4 + 0] = v[i][0]; tl[row * 65 + c4 + 1] = v[i][1]; tl[row * 65 + c4 + 2] = v[i][2]; tl[row * 65 + c4 + 3] = v[i][3]; }
    }
    __syncthreads();
    {
        const int n = tid >> 2, kc = tid & 3, ng = d.n0 + n;
        int drow = ng;
        if (d.mapkind == 1) drow = 32 * (ng >> 4) + (ng & 15);
        else if (d.mapkind == 2) drow = 32 * (ng >> 4) + 16 + (ng & 15);
        else if (d.mapkind == 3) drow = (ng >> 7) * 256 + 32 * ((ng & 127) >> 4) + (ng & 15);
        else if (d.mapkind == 4) drow = (ng >> 7) * 256 + 32 * ((ng & 127) >> 4) + 16 + (ng & 15);
        else if (d.mapkind == 5) drow = (ng & ~31) + 16 * ((ng >> 2) & 1) + 4 * ((ng >> 3) & 3) + (ng & 3);
        unsigned w[8];
#pragma unroll
        for (int j = 0; j < 8; ++j) w[j] = pk2(tl[(kc * 16 + 2 * j) * 65 + n], tl[(kc * 16 + 2 * j + 1) * 65 + n]);
        u32x4* o = (u32x4*)(d.dst + (size_t)drow * d.lddst + d.k0 + kc * 16);
        o[0] = (u32x4){w[0], w[1], w[2], w[3]};
        o[1] = (u32x4){w[4], w[5], w[6], w[7]};
    }
    __syncthreads();
}
DEV ConvDesc conv_fixed_desc(const Params& p, int it) {
    const int l = it / 1040; int r = it % 1040;
    unsigned char* ws = p.ws;
    if (r < 576) return ConvDesc{p.w_in + (size_t)l * 1024 * PROJ, (bf16_t*)(ws + OFF_WIN) + (size_t)l * PROJ * 1024, PROJ, (r / 36) * 64, (r % 36) * 64, 1024, (r % 36) * 64 < 1536 ? 5 : 0};
    r -= 576;
    if (r < 256) return ConvDesc{p.w_out + (size_t)l * 1024 * 1024, (bf16_t*)(ws + OFF_WOUT) + (size_t)l * 1024 * 1024, 1024, (r / 16) * 64, (r % 16) * 64, 1024, 5};
    r -= 256;
    if (r < 64) return ConvDesc{p.sh_w1 + (size_t)l * 1024 * 256, (bf16_t*)(ws + OFF_SW13) + (size_t)l * 512 * 1024, 256, (r / 4) * 64, (r % 4) * 64, 1024, 3};
    r -= 64;
    if (r < 64) return ConvDesc{p.sh_w3 + (size_t)l * 1024 * 256, (bf16_t*)(ws + OFF_SW13) + (size_t)l * 512 * 1024, 256, (r / 4) * 64, (r % 4) * 64, 1024, 4};
    r -= 64;
    if (r < 64) { const int kt = r / 16, hh = kt >> 1;
        return ConvDesc{p.sh_w2 + (size_t)l * 256 * 1024, (bf16_t*)(ws + OFF_SW2) + (size_t)(l * 2 + hh) * 1024 * 128 - hh * 128, 1024, kt * 64, (r % 16) * 64, 128, 5}; }
    r -= 64;
    return ConvDesc{p.router_w + (size_t)l * 1024 * 64, (bf16_t*)(ws + OFF_RW) + (size_t)l * 64 * 1024, 64, r * 64, 0, 1024, 0};
}
DEV ConvDesc conv_expert_desc(const Params& p, int l, int it) {
    const int e = it / 96; int r = it % 96;
    unsigned char* ws = p.ws;
    const size_t eo = (size_t)(l * 64 + e) * 1024 * 128;
    if (r < 32) return ConvDesc{p.exp_w1 + eo, (bf16_t*)(ws + OFF_W13) + (size_t)e * 256 * 1024, 128, (r / 2) * 64, (r % 2) * 64, 1024, 1};
    r -= 32;
    if (r < 32) return ConvDesc{p.exp_w3 + eo, (bf16_t*)(ws + OFF_W13) + (size_t)e * 256 * 1024, 128, (r / 2) * 64, (r % 2) * 64, 1024, 2};
    r -= 32;
    return ConvDesc{p.exp_w2 + eo, (bf16_t*)(ws + OFF_W2) + (size_t)e * 1024 * 128, 1024, (r / 16) * 64, (r % 16) * 64, 128, 5};
}
DEV void conv_run(const Params& p, int l, int first, int count, char* lds) {
    const int tid = get_tid();
    if (count <= 0) return;
    ConvDesc d = l < 0 ? conv_fixed_desc(p, first) : conv_expert_desc(p, l, first);
    f32x4 v[4]; conv_load(d, v, tid);
#pragma unroll 1
    for (int i = 0; i < count; ++i) {
        ConvDesc dn = d; f32x4 vn[4];
        if (i + 1 < count) { dn = l < 0 ? conv_fixed_desc(p, first + i + 1) : conv_expert_desc(p, l, first + i + 1); conv_load(dn, vn, tid); }
        else {
#pragma unroll
            for (int k = 0; k < 4; ++k) vn[k] = v[k];
        }
        conv_store(d, v, lds, tid);
        d = dn;
#pragma unroll
        for (int k = 0; k < 4; ++k) v[k] = vn[k];
    }
}
DEV void phase_prep(const Params& p, char* lds) {
    { const int t_ = get_tid(); if (blockIdx.x == 0 && t_ < 128) ((int*)(p.ws + OFF_CNT))[t_ * 64] = 0; }
    constexpr int N0 = 144, N1 = N0 + 192, N2 = N1 + 260, N3 = N2 + 768, N4 = N3 + 256;
    int* qhead = (int*)(p.ws + OFF_QUEUE) + 2 * 64;
    int* qslot = (int*)(lds + SMEM_BYTES - 256);
    for (;;) {
        __syncthreads();
        if (get_tid() == 0) *qslot = atomicAdd(qhead, 1);
        __syncthreads();
        const int it = *qslot;
        if (it >= N4) break;
        if (it < N0) prep_filter_item(p, it, lds);
        else if (it < N1) prep_mod_item(p, it - N0, lds);
        else if (it < N2) conv_run(p, -1, (it - N1) * 8, 8, lds);
        else if (it < N3) conv_run(p, 0, (it - N2) * 8, 8, lds);
        else prep_rope_item(p, it - N3);
    }
}
DEV void phase_modfin(const Params& p) {
    const float* part = (const float*)(p.ws + OFF_PART);
    float* mod = (float*)(p.ws + OFF_MOD);
    for (int idx = blockIdx.x * 256 + get_tid(); idx < 2 * 9 * 6144; idx += gridDim.x * 256) {
        const int l = idx / (9 * 6144), g = (idx / 6144) % 9, col = idx % 6144;
        float s = p.ada_b[l * 6144 + col];
        for (int k = 0; k < 32; ++k) s += part[((size_t)(k * 2 + l) * 9 + g) * 6144 + col];
        mod[idx] = s;
    }
}

DEV void row_load(const float* src, f32x4 (&v)[4], int lane) {
#pragma unroll
    for (int j = 0; j < 4; ++j) v[j] = *(const f32x4*)(src + 4 * lane + 256 * j);
}
DEV f32x4 ld_bf4(const bf16_t* p) { const u32x2 w = *(const u32x2*)p; return (f32x4){__uint_as_float(w[0] << 16), __uint_as_float(w[0] & 0xffff0000u), __uint_as_float(w[1] << 16), __uint_as_float(w[1] & 0xffff0000u)}; }
DEV void st_bf4(bf16_t* p, const f32x4& v) { *(u32x2*)p = (u32x2){pk2(v[0], v[1]), pk2(v[2], v[3])}; }
DEV void row_load_bf(const bf16_t* src, f32x4 (&v)[4], int lane) {
#pragma unroll
    for (int j = 0; j < 4; ++j) v[j] = ld_bf4(src + 4 * lane + 256 * j);
}
DEV void row_norm(f32x4 (&v)[4]) {
    float s = 0.f;
#pragma unroll
    for (int j = 0; j < 4; ++j) s += (v[j][0] + v[j][1]) + (v[j][2] + v[j][3]);
    const float mean = wave_sum(s) * (1.f / 1024.f);
    float q = 0.f;
#pragma unroll
    for (int j = 0; j < 4; ++j) { v[j] = v[j] - mean; q += (v[j][0] * v[j][0] + v[j][1] * v[j][1]) + (v[j][2] * v[j][2] + v[j][3] * v[j][3]); }
    const float rstd = __builtin_amdgcn_rsqf(wave_sum(q) * (1.f / 1024.f) + 1e-6f);
#pragma unroll
    for (int j = 0; j < 4; ++j) v[j] = v[j] * rstd;
}
DEV void row_store_mod_bf16(bf16_t* dst, const f32x4 (&v)[4], const float* shift, const float* scale, int lane) {
#pragma unroll
    for (int j = 0; j < 4; ++j) {
        const int c = 4 * lane + 256 * j;
        const f32x4 sh = *(const f32x4*)(shift + c), sc = *(const f32x4*)(scale + c);
        const f32x4 o = v[j] * (sc + 1.0f) + sh;
        *(u32x2*)(dst + c) = (u32x2){pk2(o[0], o[1]), pk2(o[2], o[3])};
    }
}
DEV void phase_lnmod0(const Params& p) {
    const int tid_ = get_tid(), lane = tid_ & 63, wid = tid_ >> 6;
    const float* mod = (const float*)(p.ws + OFF_MOD);
    bf16_t* H = (bf16_t*)(p.ws + OFF_H);
    for (int row = blockIdx.x * 4 + wid; row < NT; row += gridDim.x * 4) {
        const float* src = row < NLAT ? p.x + (size_t)row * 1024 : p.ctx + (size_t)(row - NLAT) * 1024;
        f32x4 v[4]; row_load(src, v, lane); row_norm(v);
        const float* m = mod + (size_t)mod_group(row) * 6144;
        row_store_mod_bf16(H + (size_t)row * 1024, v, m, m + 1024, lane);
    }
}

DEV void phase_inproj(const Params& p, int l, char* lds) {
    const int tid = get_tid(), lane = tid & 63, wid = tid >> 6, fr = lane & 15, fq = lane >> 4, wr = wid >> 1, wc = wid & 1;
    unsigned char* ws = p.ws;
    const bf16_t* H = (const bf16_t*)(ws + OFF_H);
    const bf16_t* W = (const bf16_t*)(ws + OFF_WIN) + (size_t)l * PROJ * 1024;
    const float* ropec = (const float*)(ws + OFF_ROPE); const float* ropes = ropec + 2048 * 32;
    const int nitems = 128 * 18 + 16 * (l == 0 ? 18 : 6);
    for (int it = blockIdx.x; it < nitems; it += gridDim.x) {
        int mt, nt;
        if (it < 2304) { mt = it / 18; nt = it % 18; }
        else { const int j = it - 2304; if (l == 0) { mt = 128 + j / 18; nt = j % 18; } else { mt = 128 + j / 6; const int q = j % 6; nt = q < 2 ? 4 + q : 6 + q; } }
        const int m0 = mt * 128, n0 = nt * 128;
        const unsigned a0 = (unsigned)m0 * 1024u + st64_off(tid), b0 = (unsigned)n0 * 1024u + st64_off(tid);
        const unsigned ao[4] = {a0, a0 + 32u * 1024u, a0 + 64u * 1024u, a0 + 96u * 1024u};
        const unsigned bo[4] = {b0, b0 + 32u * 1024u, b0 + 64u * 1024u, b0 + 96u * 1024u};
        f32x4 acc[4][4]; zero_acc<4, 4>(acc);
        const bool latent = m0 < NLAT;
        const int b = latent ? (m0 >> 11) : ((m0 - NLAT) >> 8);
        const int tbase = latent ? (m0 & 2047) : ((m0 - NLAT) & 255);
        if (nt >= 12) {
            const int rho = tid >> 3, ptok = 8 * ((rho & 15) >> 2) + 4 * (rho >> 4) + (rho & 3);
            const unsigned ap0 = (unsigned)(m0 + ptok) * 1024u + (unsigned)(((tid & 7) ^ (rho & 7)) * 8);
            const unsigned aop[4] = {ap0, ap0 + 32u * 1024u, ap0 + 64u * 1024u, ap0 + 96u * 1024u};
            gemm_core64<false>(acc, H, aop, W, bo, 1024, lds);
            bf16_t* zt = latent ? (bf16_t*)(ws + OFF_ZTL) + (size_t)b * 768 * 2048 : (bf16_t*)(ws + OFF_ZTC) + (size_t)b * 768 * 256;
            const int n = latent ? 2048 : 256;
#pragma unroll
            for (int g = 0; g < 2; ++g)
#pragma unroll
                for (int nn = 0; nn < 4; ++nn) {
                    const int ch = n0 - 1536 + wc * 64 + nn * 16 + fr, t = tbase + wr * 64 + 32 * g + 8 * fq;
                    *(u32x4*)(zt + (size_t)ch * n + t) = (u32x4){pk2(acc[2 * g][nn][0], acc[2 * g][nn][1]), pk2(acc[2 * g][nn][2], acc[2 * g][nn][3]),
                                                                 pk2(acc[2 * g + 1][nn][0], acc[2 * g + 1][nn][1]), pk2(acc[2 * g + 1][nn][2], acc[2 * g + 1][nn][3])};
                }
        } else {
            gemm_core64<true>(acc, H, ao, W, bo, 1024, lds);
            const int col0 = n0 + wc * 64;
            int kind, hh;
            if (col0 < 512) { kind = 0; hh = col0 >> 6; } else if (col0 < 640) { kind = 1; hh = (col0 - 512) >> 6; } else if (col0 < 768) { kind = 2; hh = (col0 - 640) >> 6; }
            else if (col0 < 1024) { kind = 3; hh = (col0 - 768) >> 6; } else if (col0 < 1280) { kind = 4; hh = (col0 - 1024) >> 6; } else { kind = 5; hh = (col0 - 1280) >> 6; }
            const bool normed = (kind == 0 || kind == 1);
            const float* gain = (kind == 0 ? p.q_gain : p.k_gain) + l * 64;
#pragma unroll
            for (int m = 0; m < 4; ++m) {
                const int rloc = wr * 64 + m * 16 + fr, row = m0 + rloc, t = tbase + rloc;
                f32x4 v[4];
#pragma unroll
                for (int nn = 0; nn < 4; ++nn) v[nn] = acc[m][nn];
                if (normed) {
                    float ss = 0.f;
#pragma unroll
                    for (int nn = 0; nn < 4; ++nn) ss += (v[nn][0] * v[nn][0] + v[nn][1] * v[nn][1]) + (v[nn][2] * v[nn][2] + v[nn][3] * v[nn][3]);
                    ss += __shfl_xor(ss, 16); ss += __shfl_xor(ss, 32);
                    const float r = __builtin_amdgcn_rsqf(ss * (1.f / 64.f) + 1e-6f);
#pragma unroll
                    for (int nn = 0; nn < 4; ++nn) {
                        const int hc = 32 * (nn >> 1) + 8 * fq + 4 * (nn & 1);
                        const f32x4 g = *(const f32x4*)(gain + hc);
                        v[nn] = v[nn] * r * g;
                        if (latent) {
                            const int pi = hc >> 1;
                            const float c0 = ropec[t * 32 + pi], s0 = ropes[t * 32 + pi], c1 = ropec[t * 32 + pi + 1], s1 = ropes[t * 32 + pi + 1];
                            const float x0 = v[nn][0], x1 = v[nn][1], x2 = v[nn][2], x3 = v[nn][3];
                            v[nn][0] = x0 * c0 - x1 * s0; v[nn][1] = x0 * s0 + x1 * c0;
                            v[nn][2] = x2 * c1 - x3 * s1; v[nn][3] = x2 * s1 + x3 * c1;
                        }
                    }
                }
                if (kind == 0 || kind == 3) {
#pragma unroll
                    for (int nn = 0; nn < 4; ++nn) v[nn] = v[nn] * (0.125f * LOG2E);
                }
                bf16_t* dst;
                const int key = latent ? 256 + t : t;
                if (kind == 0) dst = (bf16_t*)(ws + OFF_QA) + ((size_t)hh * NT + row) * 64;
                else if (kind == 3) dst = (bf16_t*)(ws + OFF_QB) + ((size_t)hh * NT + row) * 64;
                else if (kind == 1) dst = (bf16_t*)(ws + OFF_KA) + ((size_t)(b * 2 + hh) * KEYS + key) * 64;
                else if (kind == 2) dst = (bf16_t*)(ws + OFF_VA) + ((size_t)(b * 2 + hh) * KEYS + key) * 64;
                else if (kind == 4) dst = (bf16_t*)(ws + OFF_KB) + ((size_t)(b * 4 + hh) * KEYS + key) * 64;
                else dst = (bf16_t*)(ws + OFF_VB) + ((size_t)(b * 4 + hh) * KEYS + key) * 64;
#pragma unroll
                for (int gg = 0; gg < 2; ++gg) *(u32x4*)(dst + 32 * gg + 8 * fq) = (u32x4){pk2(v[2 * gg][0], v[2 * gg][1]), pk2(v[2 * gg][2], v[2 * gg][3]), pk2(v[2 * gg + 1][0], v[2 * gg + 1][1]), pk2(v[2 * gg + 1][2], v[2 * gg + 1][3])};
            }
        }
    }
}

template <int NQT, bool NA>
DEV void attn_block(const bf16_t* Qh, int qrow0, const bf16_t* Kh, const bf16_t* Vh, int ntiles, bf16_t* outp  ,
                    int na_r, int na_rs, int nwin, const float* rpb_h, char* lds) {
    const int tid = get_tid(), lane = tid & 63, wid = tid >> 6, fr = lane & 15, fq = lane >> 4;
    char* KBUF = lds;
    char* VBUF = lds + 16384;
    float* BIAS = (float*)(lds + 32768);
    if (NA) {
        for (int i = tid; i < 15 * 32; i += 256) { const int dr = i >> 5, dc = i & 31; BIAS[i] = dc < 31 ? rpb_h[dr * 31 + dc] * LOG2E : 0.f; }
    }
    bf16x8 qf[NQT][2];
    const int qw = qrow0 + wid * 16 * NQT;
#pragma unroll
    for (int nq = 0; nq < NQT; ++nq)
#pragma unroll
        for (int ks = 0; ks < 2; ++ks) qf[nq][ks] = *(const bf16x8*)(Qh + (size_t)(qw + nq * 16 + fr) * 64 + ks * 32 + fq * 8);
    f32x4 oacc[4][NQT], lacc[NQT];
    float mrun[NQT];
    const bf16x8 ones = (bf16x8){0x3F80, 0x3F80, 0x3F80, 0x3F80, 0x3F80, 0x3F80, 0x3F80, 0x3F80};
#pragma unroll
    for (int nq = 0; nq < NQT; ++nq) { mrun[nq] = 0.f; lacc[nq] = (f32x4){0.f, 0.f, 0.f, 0.f};
#pragma unroll
        for (int dt = 0; dt < 4; ++dt) oacc[dt][nq] = (f32x4){0.f, 0.f, 0.f, 0.f}; }
    const int lrow0 = tid >> 3, lch = tid & 7;
    auto key0_of = [&](int ti) -> int { if (NA) return ti < nwin ? 256 + (na_rs + ti) * 64 : (ti - nwin) * 64; return ti * 64; };
    u32x4 kreg[2], vreg[2];
    auto gload = [&](int ti) {
        const int k0 = key0_of(ti);
#pragma unroll
        for (int i = 0; i < 2; ++i) {
            const int row = lrow0 + 32 * i;
            kreg[i] = *(const u32x4*)(Kh + (size_t)(k0 + row) * 64 + lch * 8);
            vreg[i] = *(const u32x4*)(Vh + (size_t)(k0 + row) * 64 + lch * 8);
        }
    };
    auto lstore = [&](int buf) {
#pragma unroll
        for (int i = 0; i < 2; ++i) {
            const int row = lrow0 + 32 * i;
            const int off = buf * 8192 + row * 128 + ((lch ^ (row & 7)) * 16);
            *(u32x4*)(KBUF + off) = kreg[i];
            *(u32x4*)(VBUF + off) = vreg[i];
        }
    };
    gload(0); lstore(0);
    __syncthreads();
    for (int ti = 0; ti < ntiles; ++ti) {
        const int buf = ti & 1;
        if (ti + 1 < ntiles) gload(ti + 1);
        const char* kb = KBUF + buf * 8192; const char* vb = VBUF + buf * 8192;
        f32x4 sacc[4][NQT];
        __builtin_amdgcn_s_setprio(1);
#pragma unroll
        for (int mt = 0; mt < 4; ++mt) {
            const int row = mt * 16 + fr;
            bf16x8 kf0 = *(const bf16x8*)(kb + row * 128 + (((0 + fq) ^ (row & 7)) * 16));
            bf16x8 kf1 = *(const bf16x8*)(kb + row * 128 + (((4 + fq) ^ (row & 7)) * 16));
#pragma unroll
            for (int nq = 0; nq < NQT; ++nq) {
                f32x4 s = (f32x4){-mrun[nq], -mrun[nq], -mrun[nq], -mrun[nq]};
                s = mfma16(kf0, qf[nq][0], s);
                s = mfma16(kf1, qf[nq][1], s);
                sacc[mt][nq] = s;
            }
        }
        __builtin_amdgcn_s_setprio(0);
        bf16x8 pf[2][NQT];
#pragma unroll
        for (int nq = 0; nq < NQT; ++nq) {
            float tv[4][4];
            float tmax = -1e30f;
            if (NA && ti < nwin) {
                const int qc = (wid & 1) * 32 + nq * 16 + fr;
                int cs = qc - 8; cs = cs < 0 ? 0 : (cs > 48 ? 48 : cs);
                const int qrow = na_r + (wid >> 1);
                int rsq = qrow - 4; rsq = rsq < 0 ? 0 : (rsq > 24 ? 24 : rsq);
                const int krow = na_rs + ti;
                const bool rowok = (krow >= rsq) && (krow < rsq + 8);
                int dr = krow - qrow + 7; dr = dr < 0 ? 0 : (dr > 14 ? 14 : dr);
#pragma unroll
                for (int mt = 0; mt < 4; ++mt)
#pragma unroll
                    for (int j = 0; j < 4; ++j) {
                        const int kc = mt * 16 + 4 * fq + j;
                        const bool ok = rowok && (kc >= cs) && (kc < cs + 16);
                        int dc = kc - qc + 15; dc = dc < 0 ? 0 : (dc > 30 ? 30 : dc);
                        tv[mt][j] = ok ? sacc[mt][nq][j] + BIAS[dr * 32 + dc] : -1e30f;
                        tmax = fmaxf(tmax, tv[mt][j]);
                    }
            } else {
#pragma unroll
                for (int mt = 0; mt < 4; ++mt) {
#pragma unroll
                    for (int j = 0; j < 4; ++j) tv[mt][j] = sacc[mt][nq][j];
                    tmax = fmaxf(fmaxf(tmax, tv[mt][0]), tv[mt][1]); tmax = fmaxf(fmaxf(tmax, tv[mt][2]), tv[mt][3]);
                }
            }
            if (__any(tmax > 8.0f)) {
                tmax = fmaxf(tmax, __shfl_xor(tmax, 16)); tmax = fmaxf(tmax, __shfl_xor(tmax, 32));
                const float dlt = fmaxf(tmax, 0.f);
                const float alpha = __builtin_amdgcn_exp2f(-dlt);
                mrun[nq] += dlt;
                lacc[nq] = lacc[nq] * alpha;
#pragma unroll
                for (int dt = 0; dt < 4; ++dt) oacc[dt][nq] = oacc[dt][nq] * alpha;
#pragma unroll
                for (int mt = 0; mt < 4; ++mt)
#pragma unroll
                    for (int j = 0; j < 4; ++j) tv[mt][j] -= dlt;
            }
#pragma unroll
            for (int mt = 0; mt < 4; ++mt)
#pragma unroll
                for (int j = 0; j < 4; ++j) tv[mt][j] = __builtin_amdgcn_exp2f(tv[mt][j]);
#pragma unroll
            for (int ks = 0; ks < 2; ++ks) {
                union { bf16x8 v; unsigned u[4]; } pk;
                pk.u[0] = pk2(tv[2 * ks][0], tv[2 * ks][1]); pk.u[1] = pk2(tv[2 * ks][2], tv[2 * ks][3]);
                pk.u[2] = pk2(tv[2 * ks + 1][0], tv[2 * ks + 1][1]); pk.u[3] = pk2(tv[2 * ks + 1][2], tv[2 * ks + 1][3]);
                pf[ks][nq] = pk.v;
                lacc[nq] = mfma16(ones, pk.v, lacc[nq]);
            }
        }
        {
            const int q4 = fr >> 2, p4 = fr & 3;
#pragma unroll
            for (int ks = 0; ks < 2; ++ks)
#pragma unroll
                for (int dt = 0; dt < 4; ++dt) {
                    const int keyA = 16 * (2 * ks) + 4 * fq + q4, keyB = keyA + 16;
                    const int ch = 4 * (dt >> 1) + p4;
                    const int offA = keyA * 128 + ((ch ^ (keyA & 7)) * 16) + (dt & 1) * 8;
                    const int offB = keyB * 128 + ((ch ^ (keyB & 7)) * 16) + (dt & 1) * 8;
                    const s16x4 ta = __builtin_amdgcn_ds_read_tr16_b64_v4i16((LDSP(s16x4))(vb + offA));
                    const s16x4 tb = __builtin_amdgcn_ds_read_tr16_b64_v4i16((LDSP(s16x4))(vb + offB));
                    bf16x8 vf; vf[0] = ta[0]; vf[1] = ta[1]; vf[2] = ta[2]; vf[3] = ta[3]; vf[4] = tb[0]; vf[5] = tb[1]; vf[6] = tb[2]; vf[7] = tb[3];
#pragma unroll
                    for (int nq = 0; nq < NQT; ++nq) oacc[dt][nq] = mfma16(vf, pf[ks][nq], oacc[dt][nq]);
                }
        }
        if (ti + 1 < ntiles) lstore(buf ^ 1);
        __syncthreads();
    }
#pragma unroll
    for (int nq = 0; nq < NQT; ++nq) {
        const float inv = __builtin_amdgcn_rcpf(lacc[nq][0]);
        bf16_t* o = outp + (size_t)(qw + nq * 16 + fr) * 1024;
#pragma unroll
        for (int g = 0; g < 2; ++g) {
            const f32x4 v0 = oacc[2 * g][nq] * inv, v1 = oacc[2 * g + 1][nq] * inv;
            *(u32x4*)(o + g * 32 + 8 * fq) = (u32x4){pk2(v0[0], v0[1]), pk2(v0[2], v0[3]), pk2(v1[0], v1[1]), pk2(v1[2], v1[3])};
        }
    }
    __syncthreads();
}

DEV float hy_sconv(const bf16_t* zrow, int t, int n, float w0, float w1, float w2, float bias) {
    const float zm = t > 0 ? bf2f(zrow[t - 1]) : 0.f, z0 = bf2f(zrow[t]), zp = t + 1 < n ? bf2f(zrow[t + 1]) : 0.f;
    return w0 * zm + w1 * z0 + w2 * zp + bias;
}
template <int NJ>
DEV void hyena_item(const Params& p, int l, int type, int c, int bh, char* lds) {
    constexpr int n = 256 * NJ;
    const int tid = get_tid();
    f32x4* U = (f32x4*)lds;
    float* KR = (float*)(lds + n * 16);
    const bf16_t* zt = type ? (const bf16_t*)(p.ws + OFF_ZTC) : (const bf16_t*)(p.ws + OFF_ZTL);
    const bf16_t* kf = (const bf16_t*)(p.ws + (type ? OFF_KERNC + (size_t)l * 2 * 256 * 256 * 2 : OFF_KERNL + (size_t)l * 2 * 256 * 2048 * 2)) + (size_t)c * n;
    const bf16_t* kb = kf + (size_t)256 * n;
    const float* cw = p.hy_conv_w + l * 3 * 768; const float* cb = p.hy_conv_b + l * 768;
    const float w10 = cw[256 + c], w11 = cw[768 + 256 + c], w12 = cw[1536 + 256 + c], b1 = cb[256 + c];
    const float wv0 = cw[512 + c], wv1 = cw[768 + 512 + c], wv2 = cw[1536 + 512 + c], bv = cb[512 + c];
    const float w00 = cw[c], w01 = cw[768 + c], w02 = cw[1536 + c], b0 = cb[c];
    for (int i = tid; i < 2 * n - 1; i += 256) { const int d = i - (n - 1); KR[i] = bf2f(d >= 0 ? kf[d] : kb[-d]); }
    for (int s = tid; s < n; s += 256) {
        f32x4 u;
#pragma unroll
        for (int bb = 0; bb < 4; ++bb) {
            const bf16_t* zb = zt + (size_t)(bh * 4 + bb) * 768 * n;
            const float x1 = hy_sconv(zb + (size_t)(256 + c) * n, s, n, w10, w11, w12, b1);
            const float vv = hy_sconv(zb + (size_t)(512 + c) * n, s, n, wv0, wv1, wv2, bv);
            u[bb] = vv * x1;
        }
        U[s] = u;
    }
    __syncthreads();
    f32x4 acc[NJ];
#pragma unroll
    for (int j = 0; j < NJ; ++j) acc[j] = (f32x4){0.f, 0.f, 0.f, 0.f};
    const float* kp = KR + tid + (n - 1);
    for (int s = 0; s < n; ++s) {
        const f32x4 u = U[s];
#pragma unroll
        for (int j = 0; j < NJ; ++j) acc[j] += u * kp[256 * j - s];
    }
    bf16_t* ox = (bf16_t*)(p.ws + OFF_OX);
#pragma unroll
    for (int j = 0; j < NJ; ++j) {
        const int t = tid + 256 * j;
#pragma unroll
        for (int bb = 0; bb < 4; ++bb) {
            const int b = bh * 4 + bb;
            const bf16_t* zb = zt + (size_t)b * 768 * n;
            const float x0 = hy_sconv(zb + (size_t)c * n, t, n, w00, w01, w02, b0);
            const float y = acc[j][bb] * x0;
            const int row = type ? NLAT + b * 256 + t : b * 2048 + t;
            ox[(size_t)row * 1024 + 768 + c] = (bf16_t)f2bf(y);
        }
    }
    __syncthreads();
}


typedef float f32x16 __attribute__((ext_vector_type(16)));
constexpr int HY_UROW = 2256;
constexpr int HY_KC_OFF = 8 * HY_UROW * 2;
constexpr int HY_KC_STRIDE = 8192 + 64;
DEV float hy_sc8(const bf16_t* zrow, int s0, int n, float w0, float w1, float w2, float bias, float (&o)[8]) {
    const u32x4 v = *(const u32x4*)(zrow + s0);
    const float zm = s0 > 0 ? bf2f(zrow[s0 - 1]) : 0.f, zp = s0 + 8 < n ? bf2f(zrow[s0 + 8]) : 0.f;
    float z[10]; z[0] = zm; z[9] = zp;
#pragma unroll
    for (int i = 0; i < 4; ++i) { z[1 + 2 * i] = __uint_as_float(v[i] << 16); z[2 + 2 * i] = __uint_as_float(v[i] & 0xffff0000u); }
#pragma unroll
    for (int i = 0; i < 8; ++i) o[i] = w0 * z[i] + w1 * z[i + 1] + w2 * z[i + 2] + bias;
    return 0.f;
}
DEV void hyena_mfma_item(const Params& p, int l, int c, char* lds) {
    const int tid = get_tid(), lane = tid & 63, wid = tid >> 6;
    constexpr int n = 2048;
    const bf16_t* zt = (const bf16_t*)(p.ws + OFF_ZTL);
    const bf16_t* kf = (const bf16_t*)(p.ws + OFF_KERNL + (size_t)l * 2 * 256 * 2048 * 2) + (size_t)c * n;
    const bf16_t* kb = kf + (size_t)256 * n;
    const float* cw = p.hy_conv_w + l * 3 * 768; const float* cb = p.hy_conv_b + l * 768;
    const float w10 = cw[256 + c], w11 = cw[768 + 256 + c], w12 = cw[1536 + 256 + c], b1 = cb[256 + c];
    const float wv0 = cw[512 + c], wv1 = cw[768 + 512 + c], wv2 = cw[1536 + 512 + c], bv = cb[512 + c];
    const float w00 = cw[c], w01 = cw[768 + c], w02 = cw[1536 + c], b0 = cb[c];
    for (int i = tid; i < 8 * 26; i += 256) {
        const int b = i / 26, k = i % 26;
        const int sp = k < 12 ? k * 8 : 96 + 2048 + (k - 12) * 8;
        *(u32x4*)(lds + (b * HY_UROW + sp) * 2) = (u32x4){0u, 0u, 0u, 0u};
    }
#pragma unroll 4
    for (int ch = tid; ch < 8 * 256; ch += 256) {
        const int b = ch >> 8, s0 = (ch & 255) * 8;
        const bf16_t* zb = zt + (size_t)b * 768 * n;
        float x1[8], vv[8];
        hy_sc8(zb + (size_t)(256 + c) * n, s0, n, w10, w11, w12, b1, x1);
        hy_sc8(zb + (size_t)(512 + c) * n, s0, n, wv0, wv1, wv2, bv, vv);
        *(u32x4*)(lds + (b * HY_UROW + 96 + s0) * 2) = (u32x4){pk2(vv[0] * x1[0], vv[1] * x1[1]), pk2(vv[2] * x1[2], vv[3] * x1[3]), pk2(vv[4] * x1[4], vv[5] * x1[5]), pk2(vv[6] * x1[6], vv[7] * x1[7])};
    }
    {
        char* R0 = lds + HY_KC_OFF;
#pragma unroll
        for (int j = 0; j < 2; ++j) {
            const int chn = tid + 256 * j;
            const bool fwd = chn < 256; const int d0 = (chn & 255) * 8;
            const u32x4 v = *(const u32x4*)((fwd ? kf : kb) + d0);
#pragma unroll
            for (int e = 0; e < 8; ++e) {
                const int d = d0 + e;
                const bf16_t val = (bf16_t)((e & 1) ? (v[e >> 1] >> 16) : (v[e >> 1] & 0xffffu));
                const int y = fwd ? 2047 - d : 2047 + d;
                if (fwd || d > 0) *(bf16_t*)(R0 + y * 2) = val;
            }
        }
        if (tid == 0) *(bf16_t*)(R0 + 4095 * 2) = 0;
    }
    __syncthreads();
    {
        const char* R0 = lds + HY_KC_OFF;
        for (int i = tid; i < 3 * 1024; i += 256) {
            const int q = 1 + i / 1024, y = (i % 1024) * 4;
            unsigned short e[4];
#pragma unroll
            for (int k = 0; k < 4; ++k) { const int yy = y + q + k; e[k] = yy <= 4094 ? *(const bf16_t*)(R0 + yy * 2) : (bf16_t)0; }
            *(u32x2*)(lds + HY_KC_OFF + q * HY_KC_STRIDE + y * 2) = (u32x2){(unsigned)e[0] | ((unsigned)e[1] << 16), (unsigned)e[2] | ((unsigned)e[3] << 16)};
        }
    }
    __syncthreads();
    const int i32 = lane & 31, h = lane >> 5, qn = i32 >> 3, bn = i32 & 7;
    const int T0 = 512 * wid;
    f32x16 acc[4];
#pragma unroll
    for (int g = 0; g < 4; ++g)
#pragma unroll
        for (int r = 0; r < 16; ++r) acc[g][r] = 0.f;
    const int dlo = T0 - 2032, dhi = T0 + 384 + 96;
    {
        const int a0 = 2047 - dlo - i32 + 8 * h, q4 = a0 & 3;
        const char* ap = lds + HY_KC_OFF + q4 * HY_KC_STRIDE + (a0 - q4) * 2;
        const char* bp = lds + (bn * HY_UROW + 96 + (T0 - dlo) + 32 * qn + 8 * h) * 2;
        for (int dl = dlo; dl <= dhi; dl += 16) {
            union { bf16x8 v; u32x2 u[2]; } af;
            af.u[0] = *(const u32x2*)ap; af.u[1] = *(const u32x2*)(ap + 8);
#pragma unroll
            for (int g = 0; g < 4; ++g) {
                const int S = T0 + 128 * g - dl;
                if (S >= -96 && S <= 2032) {
                    const bf16x8 bfv = *(const bf16x8*)(bp + 256 * g);
                    acc[g] = __builtin_amdgcn_mfma_f32_32x32x16_bf16(af.v, bfv, acc[g], 0, 0, 0);
                }
            }
            ap -= 32; bp -= 32;
        }
    }
    __syncthreads();
#pragma unroll 4
    for (int ch = tid; ch < 8 * 256; ch += 256) {
        const int b = ch >> 8, s0 = (ch & 255) * 8;
        float x0[8];
        hy_sc8(zt + (size_t)b * 768 * n + (size_t)c * n, s0, n, w00, w01, w02, b0, x0);
        *(u32x4*)(lds + HY_KC_OFF + (b * 2048 + s0) * 2) = (u32x4){pk2(x0[0], x0[1]), pk2(x0[2], x0[3]), pk2(x0[4], x0[5]), pk2(x0[6], x0[7])};
    }
    __syncthreads();
    bf16_t* oxt = (bf16_t*)(p.ws + OFF_OXT) + (size_t)c * 2048;
#pragma unroll
    for (int g = 0; g < 4; ++g)
#pragma unroll
        for (int r4 = 0; r4 < 4; ++r4) {
            const int t = T0 + 128 * g + 32 * qn + 8 * r4 + 4 * h;
            const u32x2 xg = *(const u32x2*)(lds + HY_KC_OFF + (bn * 2048 + t) * 2);
            const float g0 = __uint_as_float(xg[0] << 16), g1 = __uint_as_float(xg[0] & 0xffff0000u), g2 = __uint_as_float(xg[1] << 16), g3 = __uint_as_float(xg[1] & 0xffff0000u);
            *(u32x2*)(oxt + (size_t)bn * 256 * 2048 + t) = (u32x2){pk2(acc[g][4 * r4 + 0] * g0, acc[g][4 * r4 + 1] * g1), pk2(acc[g][4 * r4 + 2] * g2, acc[g][4 * r4 + 3] * g3)};
        }
    __syncthreads();
}

DEV void phase_mix(const Params& p, int l, char* lds) {
    unsigned char* ws = p.ws;
    const bf16_t* QA = (const bf16_t*)(ws + OFF_QA); const bf16_t* QB = (const bf16_t*)(ws + OFF_QB);
    const bf16_t* KA = (const bf16_t*)(ws + OFF_KA); const bf16_t* VA = (const bf16_t*)(ws + OFF_VA);
    const bf16_t* KBp = (const bf16_t*)(ws + OFF_KB); const bf16_t* VBp = (const bf16_t*)(ws + OFF_VB);
    bf16_t* OX = (bf16_t*)(ws + OFF_OX);
    const int N0 = 256, N1 = N0 + 1024, N2 = N1 + 512;
    const int N3 = N2 + (l == 0 ? 512 : 0), N4 = N3 + (l == 0 ? 128 : 0), N5 = N4 + (l == 0 ? 64 : 0);
    int* qhead = (int*)(p.ws + OFF_QUEUE) + l * 64;
    int* qslot = (int*)(lds + SMEM_BYTES - 256);
    for (;;) {
        __syncthreads();
        if (get_tid() == 0) *qslot = atomicAdd(qhead, 1);
        __syncthreads();
        const int it = *qslot;
        if (it >= N5) break;
        if (it < N0) { hyena_mfma_item(p, l, it, lds); }
        else if (it < N1) {
            const int j = it - N0, b = j >> 7, h = (j >> 4) & 7, qb = j & 15;
            attn_block<2, false>(QA + (size_t)h * NT * 64, b * 2048 + qb * 128, KA + (size_t)(b * 2 + (h >> 2)) * KEYS * 64, VA + (size_t)(b * 2 + (h >> 2)) * KEYS * 64,
                                 36, OX + h * 64, 0, 0, 0, nullptr, lds);
        } else if (it < N2) {
            const int j = it - N1, b = j >> 6, h = (j >> 4) & 3, r = (j & 15) * 2;
            int rs0 = r - 4; rs0 = rs0 < 0 ? 0 : (rs0 > 24 ? 24 : rs0);
            int rs1 = r - 3; rs1 = rs1 < 0 ? 0 : (rs1 > 24 ? 24 : rs1);
            const int nwin = rs1 + 8 - rs0;
            attn_block<2, true>(QB + (size_t)h * NT * 64, b * 2048 + r * 64, KBp + (size_t)(b * 4 + h) * KEYS * 64, VBp + (size_t)(b * 4 + h) * KEYS * 64,
                                nwin + 4, OX + 512 + h * 64, r, rs0, nwin, p.nat_rpb + (size_t)(l * 4 + h) * 15 * 31, lds);
        } else if (it < N3) { const int j = it - N2; hyena_item<1>(p, l, 1, j >> 1, j & 1, lds); }
        else if (it < N4) {
            const int j = it - N3, b = j >> 4, h = (j >> 1) & 7, qb = j & 1;
            attn_block<2, false>(QA + (size_t)h * NT * 64, NLAT + b * 256 + qb * 128, KA + (size_t)(b * 2 + (h >> 2)) * KEYS * 64, VA + (size_t)(b * 2 + (h >> 2)) * KEYS * 64,
                                 4, OX + h * 64, 0, 0, 0, nullptr, lds);
        } else {
            const int j = it - N4, b = j >> 3, h = (j >> 1) & 3, qb = j & 1;
            attn_block<2, false>(QB + (size_t)h * NT * 64, NLAT + b * 256 + qb * 128, KBp + (size_t)(b * 4 + h) * KEYS * 64, VBp + (size_t)(b * 4 + h) * KEYS * 64,
                                 4, OX + 512 + h * 64, 0, 0, 0, nullptr, lds);
        }
    }
}

DEV void phase_outproj(const Params& p, int l, char* lds) {
    const int tid = get_tid(), lane = tid & 63, wid = tid >> 6, fr = lane & 15, fq = lane >> 4, wr = wid >> 1, wc = wid & 1;
    const bf16_t* OX = (const bf16_t*)(p.ws + OFF_OX);
    const bf16_t* W = (const bf16_t*)(p.ws + OFF_WOUT) + (size_t)l * 1024 * 1024;
    const float* mod = (const float*)(p.ws + OFF_MOD) + (size_t)l * 9 * 6144;
    bf16_t* X = (bf16_t*)(p.ws + OFF_X);
    const int nitems = (l == 0 ? 144 : 128) * 8;
    for (int it = blockIdx.x; it < nitems; it += gridDim.x) {
        const int mt = it >> 3, nt = it & 7, m0 = mt * 128, n0 = nt * 128;
        const unsigned a0 = (unsigned)m0 * 1024u + st64_off(tid), b0 = (unsigned)n0 * 1024u + st64_off(tid);
        f32x4 acc[4][4]; zero_acc<4, 4>(acc);
        const unsigned ao[4] = {a0, a0 + 32u * 1024u, a0 + 64u * 1024u, a0 + 96u * 1024u};
        const unsigned bo[4] = {b0, b0 + 32u * 1024u, b0 + 64u * 1024u, b0 + 96u * 1024u};
        gemm_core64<true>(acc, OX, ao, W, bo, 1024, lds, (const bf16_t*)(p.ws + OFF_OXT) + (size_t)((m0 >> 11) & 7) * 256 * 2048 + (m0 & 2047), m0 < NLAT ? 12 : 16);
        const float* g1 = mod + (size_t)mod_group(m0) * 6144 + 2048;
#pragma unroll
        for (int m = 0; m < 4; ++m) {
            const int row = m0 + wr * 64 + m * 16 + fr;
            const float* xin = row < NLAT ? p.x + (size_t)row * 1024 : p.ctx + (size_t)(row - NLAT) * 1024;
#pragma unroll
            for (int gg = 0; gg < 2; ++gg) {
                const int col = n0 + wc * 64 + gg * 32 + 8 * fq;
                f32x4 x0, x1;
                if (l == 0) { x0 = *(const f32x4*)(xin + col); x1 = *(const f32x4*)(xin + col + 4); }
                else { const u32x4 w = *(const u32x4*)(X + (size_t)row * 1024 + col);
                       x0 = (f32x4){__uint_as_float(w[0] << 16), __uint_as_float(w[0] & 0xffff0000u), __uint_as_float(w[1] << 16), __uint_as_float(w[1] & 0xffff0000u)};
                       x1 = (f32x4){__uint_as_float(w[2] << 16), __uint_as_float(w[2] & 0xffff0000u), __uint_as_float(w[3] << 16), __uint_as_float(w[3] & 0xffff0000u)}; }
                const f32x4 o0 = x0 * DN_ALPHA + *(const f32x4*)(g1 + col) * acc[m][2 * gg], o1 = x1 * DN_ALPHA + *(const f32x4*)(g1 + col + 4) * acc[m][2 * gg + 1];
                *(u32x4*)(X + (size_t)row * 1024 + col) = (u32x4){pk2(o0[0], o0[1]), pk2(o0[2], o0[3]), pk2(o1[0], o1[1]), pk2(o1[2], o1[3])};
            }
        }
    }
}

DEV void phase_ln1route(const Params& p, int l, char* lds) {
    const int tid = get_tid(), lane = tid & 63, wid = tid >> 6, fr = lane & 15, fq = lane >> 4;
    bf16_t* X = (bf16_t*)(p.ws + OFF_X);
    bf16_t* H = (bf16_t*)(p.ws + OFF_H);
    const bf16_t* RW = (const bf16_t*)(p.ws + OFF_RW) + (size_t)l * 64 * 1024;
    const float* mod = (const float*)(p.ws + OFF_MOD) + (size_t)l * 9 * 6144;
    int* cnt = (int*)(p.ws + OFF_CNT) + l * 64 * 64;
    int* tke = (int*)(p.ws + OFF_TKE); int* tks = (int*)(p.ws + OFF_TKS); float* tkw = (float*)(p.ws + OFF_TKW);
    int* list = (int*)(p.ws + OFF_LIST);
    char* HT = lds;
    float* LG = (float*)(lds + 16 * 2064);
    const float rbias = p.router_b[l * 64 + lane];
    const int rpw = (l == 0) ? 3 : 4, rpi = 4 * rpw;
    const int nitems = (l == 0 ? NT : NLAT) / rpi;
    u32x2 raw[4][4];
    f32x4 msh[4], msc[4];
    float* LNG = (float*)(lds + 50176);
    for (int i = tid; i < 512; i += 256) {
        const int c = (i & 255) * 4;
        *(f32x4*)(LNG + (i >> 8) * 1024 + c) = *(const f32x4*)((i >> 8 ? p.ln1_b : p.ln1_g) + l * 1024 + c);
    }
    if ((int)blockIdx.x < nitems) {
#pragma unroll
        for (int i = 0; i < 4; ++i) if (i < rpw)
#pragma unroll
            for (int j = 0; j < 4; ++j) raw[i][j] = *(const u32x2*)(X + (size_t)((int)blockIdx.x * rpi + wid * rpw + i) * 1024 + 4 * lane + 256 * j);
        const float* mg = mod + (size_t)mod_group((int)blockIdx.x * rpi + wid * rpw) * 6144;
#pragma unroll
        for (int j = 0; j < 4; ++j) { const int c = 4 * lane + 256 * j; msh[j] = *(const f32x4*)(mg + 3072 + c); msc[j] = *(const f32x4*)(mg + 4096 + c); }
    }
    __syncthreads();
    for (int it = blockIdx.x; it < nitems; it += gridDim.x) {
        const int m0 = it * rpi;
        const int g0 = mod_group(m0 + wid * rpw);
        f32x4 vv[4][4];
#pragma unroll
        for (int i = 0; i < 4; ++i) if (i < rpw)
#pragma unroll
            for (int j = 0; j < 4; ++j) { const u32x2 w = raw[i][j]; vv[i][j] = (f32x4){__uint_as_float(w[0] << 16), __uint_as_float(w[0] & 0xffff0000u), __uint_as_float(w[1] << 16), __uint_as_float(w[1] & 0xffff0000u)}; }
#pragma unroll
        for (int i = 0; i < 4; ++i) if (i < rpw) {
            const int rl = wid * rpw + i, row = m0 + rl;
            if (mod_group(row) != g0) {
                const float* mg = mod + (size_t)mod_group(row) * 6144;
#pragma unroll
                for (int j = 0; j < 4; ++j) { const int c = 4 * lane + 256 * j; msh[j] = *(const f32x4*)(mg + 3072 + c); msc[j] = *(const f32x4*)(mg + 4096 + c); }
            }
            row_norm(vv[i]);
#pragma unroll
            for (int j = 0; j < 4; ++j) {
                const int c = 4 * lane + 256 * j;
                vv[i][j] = vv[i][j] * *(const f32x4*)(LNG + c) + *(const f32x4*)(LNG + 1024 + c);
                st_bf4(X + (size_t)row * 1024 + c, vv[i][j]);
            }
            row_norm(vv[i]);
#pragma unroll
            for (int j = 0; j < 4; ++j) {
                const int c = 4 * lane + 256 * j;
                const f32x4 o = vv[i][j] * (msc[j] + 1.0f) + msh[j];
                const u32x2 w = (u32x2){pk2(o[0], o[1]), pk2(o[2], o[3])};
                *(u32x2*)(H + (size_t)row * 1024 + c) = w;
                *(u32x2*)(HT + rl * 2064 + c * 2) = w;
            }
        }
        f32x4 acc = (f32x4){0.f, 0.f, 0.f, 0.f};
        const bf16_t* bp = RW + (size_t)(wid * 16 + fr) * 1024 + fq * 8;
        bf16x8 bq[16];
#pragma unroll
        for (int ks = 0; ks < 16; ++ks) bq[ks] = *(const bf16x8*)(bp + ks * 32);
        __syncthreads();
#pragma unroll
        for (int ks = 0; ks < 16; ++ks) {
            const bf16x8 af = *(const bf16x8*)(HT + fr * 2064 + (ks * 32 + fq * 8) * 2);
            acc = mfma16(bq[ks], af, acc);
            bq[ks] = *(const bf16x8*)(bp + (ks + 16) * 32);
        }
#pragma unroll
        for (int ks = 0; ks < 16; ++ks) {
            const bf16x8 af = *(const bf16x8*)(HT + fr * 2064 + ((ks + 16) * 32 + fq * 8) * 2);
            acc = mfma16(bq[ks], af, acc);
        }
        *(f32x4*)(LG + fr * 64 + wid * 16 + 4 * fq) = acc;
        if (it + (int)gridDim.x < nitems) {
#pragma unroll
            for (int i = 0; i < 4; ++i) if (i < rpw)
#pragma unroll
                for (int j = 0; j < 4; ++j) raw[i][j] = *(const u32x2*)(X + (size_t)(m0 + (int)gridDim.x * rpi + wid * rpw + i) * 1024 + 4 * lane + 256 * j);
            const float* mg = mod + (size_t)mod_group(m0 + (int)gridDim.x * rpi + wid * rpw) * 6144;
#pragma unroll
            for (int j = 0; j < 4; ++j) { const int c = 4 * lane + 256 * j; msh[j] = *(const f32x4*)(mg + 3072 + c); msc[j] = *(const f32x4*)(mg + 4096 + c); }
        }
        __syncthreads();
        int* RS = (int*)(lds + 16 * 2064 + 4096 + 2048);
        float* RWt = (float*)(lds + 16 * 2064 + 4096 + 2048 + 4096);
        int lc = 0;
        unsigned* KW = (unsigned*)(lds + 16 * 2064 + 4096 + 2048 + 8192) + wid * 160;
#pragma unroll 1
        for (int i = 0; i < rpw; ++i) {
            const int rl = wid * rpw + i;
            const float sc = __builtin_amdgcn_rcpf(1.0f + __expf(-LG[rl * 64 + lane]));
            const float sel = sc + rbias;
            const int grp = lane >> 3;
            const unsigned key = (__float_as_uint(sel + 2.0f) & 0xFFFFFFC0u) | (unsigned)(63 - lane);
            KW[lane] = key;
            __builtin_amdgcn_wave_barrier();
            int rankg = 0;
            {
                const u32x4 k0 = *(const u32x4*)(KW + grp * 8), k1 = *(const u32x4*)(KW + grp * 8 + 4);
#pragma unroll
                for (int j = 0; j < 4; ++j) { rankg += (k0[j] > key) ? 1 : 0; rankg += (k1[j] > key) ? 1 : 0; }
            }
            float gs = rankg < 2 ? sel : 0.f;
            gs += __shfl_xor(gs, 1); gs += __shfl_xor(gs, 2); gs += __shfl_xor(gs, 4);
            const unsigned gkey = (__float_as_uint(gs + 4.0f) & 0xFFFFFFF8u) | (unsigned)(7 - grp);
            if ((lane & 7) == 0) KW[128 + grp] = gkey;
            __builtin_amdgcn_wave_barrier();
            int rg = 0;
            {
                const u32x4 g0 = *(const u32x4*)(KW + 128), g1 = *(const u32x4*)(KW + 132);
#pragma unroll
                for (int j = 0; j < 4; ++j) { rg += (g0[j] > gkey) ? 1 : 0; rg += (g1[j] > gkey) ? 1 : 0; }
            }
            const bool selg = rg < 4;
            const unsigned vkey = selg ? key : 0u;
            KW[64 + lane] = vkey;
            __builtin_amdgcn_wave_barrier();
            int rank = 0;
#pragma unroll
            for (int q = 0; q < 16; ++q) {
                const u32x4 kk = *(const u32x4*)(KW + 64 + q * 4);
#pragma unroll
                for (int j = 0; j < 4; ++j) rank += (kk[j] > vkey) ? 1 : 0;
            }
            const bool ch = selg && rank < 8;
            const float wsum = wave_sum(ch ? sc : 0.f);
            RS[rl * 64 + lane] = ch ? rank : -1;
            RWt[rl * 64 + lane] = sc * (2.5f * __builtin_amdgcn_rcpf(wsum));
            lc += ch ? 1 : 0;
            __builtin_amdgcn_wave_barrier();
        }
        int* WC = (int*)(lds + 16 * 2064 + 4096);
        WC[wid * 64 + lane] = lc;
        __syncthreads();
        if (wid == 0) {
            const int tot = WC[lane] + WC[64 + lane] + WC[128 + lane] + WC[192 + lane];
            int base = 0;
            if (tot > 0) base = atomicAdd(&cnt[lane * 64], tot);
            WC[256 + lane] = base;
        }
        __syncthreads();
        {
            int slot = WC[256 + lane];
#pragma unroll
            for (int w2 = 0; w2 < 4; ++w2) slot += (w2 < wid) ? WC[w2 * 64 + lane] : 0;
#pragma unroll 1
            for (int i = 0; i < rpw; ++i) {
                const int rl = wid * rpw + i, rk = RS[rl * 64 + lane];
                if (rk >= 0) {
                    const int row = m0 + rl;
                    list[(size_t)lane * NT + slot] = row * 8 + rk;
                    tke[row * 8 + rk] = lane; tks[row * 8 + rk] = slot; tkw[row * 8 + rk] = RWt[rl * 64 + lane];
                    ++slot;
                }
            }
        }
        __syncthreads();
    }
}

constexpr int YS_EXT_ROWS = NLAT * 1024 * 4 / 1024;
constexpr int PLAN_OFF = 68 * 1024;
DEV void moe_plan(const int* cnt, int cap, int l, char* lds) {
    int* PL = (int*)(lds + PLAN_OFF);
    const int tid = get_tid();
    __syncthreads();
    if (tid < 64) {
        const int lane = tid;
        const int c = cnt[lane * 64], tiles = (c + 127) >> 7;
        int pr = c, pt = tiles;
#pragma unroll
        for (int o = 1; o < 64; o <<= 1) { const int a = __shfl_up(pr, o), b = __shfl_up(pt, o); if (lane >= o) { pr += a; pt += b; } }
        const int G = (int)gridDim.x, nshu = 2 * ((l == 0 ? NT : NLAT) / 128);
        const int units = nshu + __builtin_amdgcn_readlane(pt, 63);
        const int cap8 = cap * 2;
        const bool one_round = __builtin_amdgcn_readlane(pr, 63) + nshu * 128 <= cap8;
        const int target0 = one_round ? 0 : ((units + G - 1) / G - 1) * G;
        PL[144 + lane] = c;
        int start = 0, base_r = 0, base_t = 0, round = 0;
        for (;;) {
            const int lim = (round == 0) ? ((target0 > 0) ? cap8 + YS_EXT_ROWS : cap8) - nshu * 128 : cap8;
            const bool bad = (lane >= start) && ((pr - base_r > lim) || (round == 0 && target0 > 0 && lane > 0 && nshu + pt > target0));
            const unsigned long long m = __ballot(bad);
            int end = m ? (int)__builtin_ctzll(m) : 64;
            if (end <= start) end = start + 1;
            if (lane >= start && lane < end) { PL[16 + lane] = pt - tiles - base_t; PL[80 + lane] = pr - c - base_r; }
            if (lane == 0) { PL[1 + round] = start; PL[10 + round] = __builtin_amdgcn_readlane(pt, end - 1) - base_t; PL[208 + round] = __builtin_amdgcn_readlane(pr, end - 1) - base_r; }
            if (end >= 64 || round >= 7) { if (lane == 0) { PL[0] = round + 1; PL[2 + round] = 64; } break; }
            base_r = __builtin_amdgcn_readlane(pr, end - 1); base_t = __builtin_amdgcn_readlane(pt, end - 1);
            start = end; ++round;
        }
    }
    __syncthreads();
}
constexpr float YS_SCALE = 32.0f, YS_INV = 1.0f / 32.0f;
DEV unsigned char* ys_row(const Params& p, int idx) {
    const int cap8 = p.cap * 2;
    return idx < cap8 ? p.ws + OFF_YS + (size_t)idx * 1024 : (unsigned char*)p.out + (size_t)(idx - cap8) * 1024;
}
DEV unsigned pk4_fp8(const f32x4& v) {
    int w = 0;
    w = __builtin_amdgcn_cvt_pk_fp8_f32(v[0] * YS_SCALE, v[1] * YS_SCALE, w, false);
    w = __builtin_amdgcn_cvt_pk_fp8_f32(v[2] * YS_SCALE, v[3] * YS_SCALE, w, true);
    return (unsigned)w;
}
DEV f32x4 up4_fp8(unsigned w) {
    const f32x2 lo = __builtin_amdgcn_cvt_pk_f32_fp8((int)w, false), hi = __builtin_amdgcn_cvt_pk_f32_fp8((int)w, true);
    return (f32x4){lo[0], lo[1], hi[0], hi[1]};
}

template <bool SHARED>
DEV void moe_tile(const Params& p, const bf16_t* W13, const bf16_t* W2, const int* list, int s0, int nvalid, int ysbase, int m0, int half, const float* g2, char* lds) {
    const int tid = get_tid(), lane = tid & 63, wid = tid >> 6, fr = lane & 15, fq = lane >> 4, wr = wid >> 1, wc = wid & 1;
    const bf16_t* H = (const bf16_t*)(p.ws + OFF_H);
    const float* tkw = (const float*)(p.ws + OFF_TKW);
    char* ACT = lds;
    const unsigned ch8 = (unsigned)(((tid & 7) ^ ((tid >> 3) & 7)) * 8);
    unsigned ao[4];
    float gw[4];
    if (SHARED) {
#pragma unroll
        for (int i = 0; i < 4; ++i) ao[i] = (unsigned)(m0 + i * 32 + (tid >> 3)) * 1024u + ch8;
#pragma unroll
        for (int m = 0; m < 4; ++m) gw[m] = 1.0f;
    } else {
#pragma unroll
        for (int i = 0; i < 4; ++i) { const int rr = min(i * 32 + (tid >> 3), nvalid - 1); ao[i] = (unsigned)(list[s0 + rr] >> 3) * 1024u + ch8; }
#pragma unroll
        for (int m = 0; m < 4; ++m) { const int rl = min(wr * 64 + m * 16 + fr, nvalid - 1); gw[m] = tkw[list[s0 + rl]]; }
    }
    u32x2 areg[2][4][2];
#pragma unroll
    for (int np = 0; np < 2; ++np) {
        const unsigned b0 = (unsigned)(np * 128) * 1024u + st64_off(tid);
        const unsigned bo[4] = {b0, b0 + 32u * 1024u, b0 + 64u * 1024u, b0 + 96u * 1024u};
        const unsigned aoc[4] = {ao[0], ao[1], ao[2], ao[3]};
        f32x4 acc[4][4]; zero_acc<4, 4>(acc);
        gemm_core64<true>(acc, H, aoc, W13, bo, 1024, lds);
#pragma unroll
        for (int m = 0; m < 4; ++m)
#pragma unroll
            for (int pi = 0; pi < 2; ++pi) {
                float o[4];
#pragma unroll
                for (int j = 0; j < 4; ++j) { const float a = acc[m][2 * pi][j], b = acc[m][2 * pi + 1][j]; o[j] = a * __builtin_amdgcn_rcpf(1.0f + __expf(-a)) * b * gw[m]; }
                areg[np][m][pi] = (u32x2){pk2(o[0], o[1]), pk2(o[2], o[3])};
            }
    }
    __syncthreads();
#pragma unroll
    for (int np = 0; np < 2; ++np)
#pragma unroll
        for (int m = 0; m < 4; ++m)
#pragma unroll
            for (int pi = 0; pi < 2; ++pi) *(u32x2*)(ACT + (wr * 64 + m * 16 + fr) * 272 + (np * 64 + wc * 32 + pi * 16 + 4 * fq) * 2) = areg[np][m][pi];
    __syncthreads();
    if (SHARED) {
        gemm2_stream64<128, 272>(W2, ACT, lds + 36864, [&](int nt, const f32x4 (&acc)[4][4]) {
#pragma unroll
            for (int m = 0; m < 4; ++m) {
                unsigned char* o = ys_row(p, ysbase + m0 + wr * 64 + m * 16 + fr) + nt * 128 + wc * 64 + 8 * fq;
#pragma unroll
                for (int g = 0; g < 2; ++g) *(u32x2*)(o + g * 32) = (u32x2){pk4_fp8(acc[m][2 * g]), pk4_fp8(acc[m][2 * g + 1])};
            }
        });
    } else {
        gemm2_stream64<128, 272>(W2, ACT, lds + 36864, [&](int nt, const f32x4 (&acc)[4][4]) {
#pragma unroll
            for (int m = 0; m < 4; ++m) {
                const int rl = wr * 64 + m * 16 + fr;
                if (rl < nvalid) {
                    unsigned char* o = ys_row(p, ysbase + s0 + rl) + nt * 128 + wc * 64 + 8 * fq;
#pragma unroll
                    for (int g = 0; g < 2; ++g) *(u32x2*)(o + g * 32) = (u32x2){pk4_fp8(acc[m][2 * g]), pk4_fp8(acc[m][2 * g + 1])};
                }
            }
        });
    }
    __syncthreads();
}
DEV void phase_moe(const Params& p, int l, int r, char* lds) {
    const int* cnt = (const int*)(p.ws + OFF_CNT) + l * 64 * 64;
    moe_plan(cnt, p.cap, l, lds);
    const int* PL = (const int*)(lds + PLAN_OFF);
    if (r >= PL[0]) return;
    const int e_lo = PL[1 + r], e_hi = PL[2 + r];
    const int nrt = PL[10 + r];
    const int nrows = (l == 0) ? NT : NLAT;
    const int nshu = (r == 0) ? 2 * (nrows / 128) : 0;
    const int G = (int)gridDim.x, b = vblock();
    const int q = (nshu + nrt + G - 1) / G;
    const int u0 = b * q, u1 = min(u0 + q, nshu + nrt);
    int e = e_lo;
    for (int u = u0; u < u1; ++u) {
        if (u < nshu) {
            const int m0 = (u >> 1) * 128, hh = u & 1;
            moe_tile<true>(p, (const bf16_t*)(p.ws + OFF_SW13) + (size_t)(l * 2 + hh) * 256 * 1024, (const bf16_t*)(p.ws + OFF_SW2) + (size_t)(l * 2 + hh) * 1024 * 128,
                           nullptr, 0, 128, PL[208] + hh * nrows, m0, hh, nullptr, lds);
        } else {
            const int it = u - nshu;
            while (e + 1 < e_hi && PL[16 + e + 1] <= it) ++e;
            const int s0 = (it - PL[16 + e]) * 128;
            moe_tile<false>(p, (const bf16_t*)(p.ws + OFF_W13) + (size_t)e * 256 * 1024, (const bf16_t*)(p.ws + OFF_W2) + (size_t)e * 1024 * 128,
                            (const int*)(p.ws + OFF_LIST) + (size_t)e * NT, s0, min(128, PL[144 + e] - s0), PL[80 + e], 0, 0, nullptr, lds);
        }
    }
}

DEV void phase_comb(const Params& p, int l, int r, char* lds) {
    const int tid_ = get_tid(), lane = tid_ & 63, wid = tid_ >> 6;
    const int* cnt = (const int*)(p.ws + OFF_CNT) + l * 64 * 64;
    moe_plan(cnt, p.cap, l, lds);
    const int* PL = (const int*)(lds + PLAN_OFF);
    if (r >= PL[0]) return;
    const int e_lo = PL[1 + r], e_hi = PL[2 + r];
    const bool final = (r == PL[0] - 1);
    bf16_t* X = (bf16_t*)(p.ws + OFF_X);
    bf16_t* H = (bf16_t*)(p.ws + OFF_H);
    const int* tke = (const int*)(p.ws + OFF_TKE); const int* tks = (const int*)(p.ws + OFF_TKS);
    const float* mod = (const float*)(p.ws + OFF_MOD);
    const int nrows = (l == 0) ? NT : NLAT;
    for (int row = blockIdx.x * 4 + wid; row < nrows; row += gridDim.x * 4) {
        const int g = mod_group(row);
        const float* g2 = mod + ((size_t)l * 9 + g) * 6144 + 5120 + 16 * lane;
        int idx_l = -1;
        if (lane < 8) { const int e = tke[row * 8 + lane]; const int sl = tks[row * 8 + lane]; if (e >= e_lo && e < e_hi) idx_l = PL[80 + e] + sl; }
        f32x4 v[4];
        {
            const u32x4 a = *(const u32x4*)(X + (size_t)row * 1024 + 16 * lane), b2 = *(const u32x4*)(X + (size_t)row * 1024 + 16 * lane + 8);
            v[0] = (f32x4){__uint_as_float(a[0] << 16), __uint_as_float(a[0] & 0xffff0000u), __uint_as_float(a[1] << 16), __uint_as_float(a[1] & 0xffff0000u)};
            v[1] = (f32x4){__uint_as_float(a[2] << 16), __uint_as_float(a[2] & 0xffff0000u), __uint_as_float(a[3] << 16), __uint_as_float(a[3] & 0xffff0000u)};
            v[2] = (f32x4){__uint_as_float(b2[0] << 16), __uint_as_float(b2[0] & 0xffff0000u), __uint_as_float(b2[1] << 16), __uint_as_float(b2[1] & 0xffff0000u)};
            v[3] = (f32x4){__uint_as_float(b2[2] << 16), __uint_as_float(b2[2] & 0xffff0000u), __uint_as_float(b2[3] << 16), __uint_as_float(b2[3] & 0xffff0000u)};
        }
        u32x4 y[10];
#pragma unroll
        for (int k = 0; k < 8; ++k) {
            const int idx = __builtin_amdgcn_readlane(idx_l, k);
            if (idx >= 0) y[k] = *(const u32x4*)(ys_row(p, idx) + 16 * lane); else y[k] = (u32x4){0u, 0u, 0u, 0u};
        }
        if (r == 0) { y[8] = *(const u32x4*)(ys_row(p, PL[208] + row) + 16 * lane); y[9] = *(const u32x4*)(ys_row(p, PL[208] + nrows + row) + 16 * lane); }
        else { y[8] = (u32x4){0u, 0u, 0u, 0u}; y[9] = y[8]; }
        f32x4 s[4];
#pragma unroll
        for (int j = 0; j < 4; ++j) s[j] = (f32x4){0.f, 0.f, 0.f, 0.f};
#pragma unroll
        for (int k = 0; k < 10; ++k)
#pragma unroll
            for (int j = 0; j < 4; ++j) s[j] += up4_fp8(y[k][j]);
        const float xs = (r == 0) ? DN_ALPHA : 1.0f;
#pragma unroll
        for (int j = 0; j < 4; ++j) v[j] = v[j] * xs + *(const f32x4*)(g2 + 4 * j) * (s[j] * YS_INV);
        if (!final) {
            u32x4 o0, o1;
            o0 = (u32x4){pk2(v[0][0], v[0][1]), pk2(v[0][2], v[0][3]), pk2(v[1][0], v[1][1]), pk2(v[1][2], v[1][3])};
            o1 = (u32x4){pk2(v[2][0], v[2][1]), pk2(v[2][2], v[2][3]), pk2(v[3][0], v[3][1]), pk2(v[3][2], v[3][3])};
            *(u32x4*)(X + (size_t)row * 1024 + 16 * lane) = o0; *(u32x4*)(X + (size_t)row * 1024 + 16 * lane + 8) = o1;
        } else {
            row_norm(v);
#pragma unroll
            for (int j = 0; j < 4; ++j) {
                const int c = 16 * lane + 4 * j;
                v[j] = v[j] * *(const f32x4*)(p.ln2_g + l * 1024 + c) + *(const f32x4*)(p.ln2_b + l * 1024 + c);
                if (l != 0) *(f32x4*)(p.out + (size_t)row * 1024 + c) = v[j];
            }
            if (l == 0) {
                u32x4 o0, o1;
                o0 = (u32x4){pk2(v[0][0], v[0][1]), pk2(v[0][2], v[0][3]), pk2(v[1][0], v[1][1]), pk2(v[1][2], v[1][3])};
                o1 = (u32x4){pk2(v[2][0], v[2][1]), pk2(v[2][2], v[2][3]), pk2(v[3][0], v[3][1]), pk2(v[3][2], v[3][3])};
                *(u32x4*)(X + (size_t)row * 1024 + 16 * lane) = o0; *(u32x4*)(X + (size_t)row * 1024 + 16 * lane + 8) = o1;
                row_norm(v);
                const float* m1 = mod + ((size_t)9 + g) * 6144 + 16 * lane;
                f32x4 h[4];
#pragma unroll
                for (int j = 0; j < 4; ++j) h[j] = v[j] * (*(const f32x4*)(m1 + 1024 + 4 * j) + 1.0f) + *(const f32x4*)(m1 + 4 * j);
                o0 = (u32x4){pk2(h[0][0], h[0][1]), pk2(h[0][2], h[0][3]), pk2(h[1][0], h[1][1]), pk2(h[1][2], h[1][3])};
                o1 = (u32x4){pk2(h[2][0], h[2][1]), pk2(h[2][2], h[2][3]), pk2(h[3][0], h[3][1]), pk2(h[3][2], h[3][3])};
                *(u32x4*)(H + (size_t)row * 1024 + 16 * lane) = o0; *(u32x4*)(H + (size_t)row * 1024 + 16 * lane + 8) = o1;
            }
        }
    }
    if (final && l == 0) {
        __syncthreads();
        conv_run(p, 1, (int)blockIdx.x * 12, 12, lds);
    }
}


#define XB_TMO      128
#define XB_XCNT(j)  (256  + 64 * (j))
#define XB_XSUB(j)  (1280 + 64 * (j))
#define XB_XGEN(j)  (2304 + 64 * (j))
#define XB_TOP      3328
#define XB_TOPGEN   3392
#define XCD_BAR_WORDS 3456
#define XB_SPIN_CAP (1u << 22)
DEV unsigned xb_ld(unsigned* p) { return __hip_atomic_load(p, __ATOMIC_RELAXED, __HIP_MEMORY_SCOPE_AGENT); }
DEV unsigned xb_add(unsigned* p, unsigned v) { return __hip_atomic_fetch_add(p, v, __ATOMIC_RELAXED, __HIP_MEMORY_SCOPE_AGENT); }
DEV unsigned xb_xcc_id() { return (unsigned)__builtin_amdgcn_s_getreg((3 << 11) | 20) & 0xFu; }
#define XB_SPIN(cond, bar) do { unsigned _sp = 0; while (cond) { __builtin_amdgcn_s_sleep(1); \
    if ((++_sp & 255u) == 0u) { if (xb_ld(&(bar)[XB_TMO])) break; if (_sp > XB_SPIN_CAP) { atomicAdd(&(bar)[XB_TMO], 1u); break; } } } } while (0)
struct XcdBarrier { unsigned* bar; unsigned x; volatile LAS unsigned* st; };
DEV XcdBarrier xcd_barrier_post(unsigned* bar, volatile LAS unsigned* st) {
    XcdBarrier b; b.bar = bar; b.x = xb_xcc_id(); b.st = st;
    if (threadIdx.x == 0) (void)xb_add(&bar[XB_XCNT(b.x)], 1u);
    return b;
}
DEV void xcd_barrier_complete(unsigned* bar, unsigned x, unsigned& nloc, unsigned& nx) {
    const unsigned G = gridDim.x * gridDim.y * gridDim.z;
    unsigned sum, cnt, mine, sp = 0u;
    for (;;) {
        sum = 0u; cnt = 0u; mine = 0u;
#pragma unroll
        for (unsigned j = 0; j < 16; ++j) { const unsigned c = xb_ld(&bar[XB_XCNT(j)]); sum += c; cnt += (c > 0u) ? 1u : 0u; mine = (j == x) ? c : mine; }
        if (sum == G) break;
        __builtin_amdgcn_s_sleep(1);
        if ((++sp & 255u) == 0u) { if (xb_ld(&bar[XB_TMO])) break; if (sp > XB_SPIN_CAP) { atomicAdd(&bar[XB_TMO], 1u); break; } }
    }
    nloc = mine > 0u ? mine : 1u; nx = cnt > 0u ? cnt : 1u;
}
DEV void xcd_barrier(const XcdBarrier& b) {
    asm volatile("s_waitcnt vmcnt(0)" ::: "memory");
    __syncthreads();
    if (get_tid() == 0) {
        unsigned* bar = b.bar; asm volatile("" : "+s"(bar));
        __builtin_amdgcn_s_waitcnt(0);
        unsigned nloc = b.st[0], nx = b.st[1];
        if (nloc == 0u) { xcd_barrier_complete(bar, b.x, nloc, nx); b.st[0] = nloc; b.st[1] = nx; }
        const unsigned old = xb_add(&bar[XB_XSUB(b.x)], 1u);
        const unsigned gen = old / nloc;
        if (old + 1u == (gen + 1u) * nloc) {
            __builtin_amdgcn_fence(__ATOMIC_RELEASE, "agent");
            asm volatile("s_waitcnt vmcnt(0)" ::: "memory");
            const unsigned og = xb_add(&bar[XB_TOP], 1u);
            const unsigned tg = og / nx;
            if (og + 1u == (tg + 1u) * nx) xb_add(&bar[XB_TOPGEN], 1u);
            else XB_SPIN(xb_ld(&bar[XB_TOPGEN]) == tg, bar);
            __builtin_amdgcn_fence(__ATOMIC_ACQUIRE, "agent");
            xb_add(&bar[XB_XGEN(b.x)], 1u);
            asm volatile("s_waitcnt vmcnt(0)" ::: "memory");
        } else {
            XB_SPIN(xb_ld(&bar[XB_XGEN(b.x)]) == gen, bar);
            __builtin_amdgcn_fence(__ATOMIC_ACQUIRE, "agent");
            asm volatile("s_waitcnt vmcnt(0)" ::: "memory");
        }
    }
    __syncthreads();
}

enum { PT_PREP = 0, PT_MODFIN, PT_LNMOD0, PT_INPROJ, PT_MIX, PT_OUTPROJ, PT_LN1ROUTE, PT_MOE, PT_COMB };

DEV void run_phase(const Params& pin, int type, int l, int r, char* lds) {
    Params p = pin;
    { unsigned char* w = p.ws; asm volatile("" : "+s"(w)); p.ws = w; }
    switch (type) {
        case PT_PREP: phase_prep(p, lds); break;
        case PT_MODFIN: phase_modfin(p); break;
        case PT_LNMOD0: phase_lnmod0(p); break;
        case PT_INPROJ: phase_inproj(p, l, lds); break;
        case PT_MIX: phase_mix(p, l, lds); break;
        case PT_OUTPROJ: phase_outproj(p, l, lds); break;
        case PT_LN1ROUTE: phase_ln1route(p, l, lds); break;
        case PT_MOE: phase_moe(p, l, r, lds); break;
        default: phase_comb(p, l, r, lds); break;
    }
}

__global__ void __launch_bounds__(256, 2) fwd_kernel(Params p) {
    __shared__ __attribute__((aligned(16))) char smem[SMEM_BYTES];
#if MULTI_LAUNCH
    run_phase(p, p.ptype, p.pl, p.pr, smem);
#else
    if (threadIdx.x < 4) ((volatile LAS unsigned*)(smem + SMEM_BYTES - 16))[threadIdx.x] = 0u;
    __syncthreads();
    const XcdBarrier bar = xcd_barrier_post((unsigned*)(p.ws + OFF_BAR), (volatile LAS unsigned*)(smem + SMEM_BYTES - 16));
    int type = PT_PREP, l = 0, r = 0;
#if TELEM
    volatile LAS unsigned* tacc = (volatile LAS unsigned*)(smem + SMEM_BYTES - 128);
    if (threadIdx.x < 16) tacc[threadIdx.x] = 0u;
    unsigned long long t_prev = __builtin_amdgcn_s_memrealtime();
#endif
    for (;;) {
        run_phase(p, type, l, r, smem);
#if TELEM
        { const int ptype_done = type;
          xcd_barrier(bar);
          const unsigned long long t_now = __builtin_amdgcn_s_memrealtime();
          if (threadIdx.x == 0) tacc[ptype_done] += (unsigned)(t_now - t_prev);
          t_prev = t_now; }
#endif
        if (type < PT_MOE) { ++type; if (type == PT_MODFIN) ++type; r = 0; }
        else if (type == PT_MOE) type = PT_COMB;
        else {
            const int nr = ((const int*)(smem + PLAN_OFF))[0];
            if (r + 1 < nr) { ++r; type = PT_MOE; }
            else { if (l == 1) break; l = 1; r = 0; type = PT_INPROJ; }
        }
#if !TELEM
        xcd_barrier(bar);
#endif
    }
#if TELEM
    {
        unsigned* tel = (unsigned*)(p.ws + 36864);
        if (blockIdx.x == 0 && threadIdx.x == 0) { unsigned sa = 0u; for (int i = 0; i < 16; ++i) if ((TELEM_A >> i) & 1) sa += tacc[i]; tacc[15] = sa; }
        xcd_barrier(bar);
        if (blockIdx.x == 0 && threadIdx.x == 0) {
            p.out[0] += 1.0f + (float)tacc[TELEM_C] * 0.01f * 0.02f;
            const unsigned long long t0 = __builtin_amdgcn_s_memrealtime();
            const unsigned long long wait = 2ull * tacc[15];
            while (__builtin_amdgcn_s_memrealtime() - t0 < wait) __builtin_amdgcn_s_sleep(8);
        }
    }
#endif
#endif
}

extern "C" void kernel_launch(void* const* d_in, const int* in_sizes, int n_in, void* d_out, int out_size, void* d_ws, size_t ws_size, hipStream_t stream) {
    Params p{};
    const float** pp = (const float**)&p;
    for (int i = 0; i < 32; ++i) pp[i] = (const float*)d_in[i];
    p.out = (float*)d_out; p.ws = (unsigned char*)d_ws;
    long long cap = ((long long)ws_size - (long long)OFF_R) / 2048;
    if (cap > NT * 8) cap = NT * 8;
    if (cap * 2048 < (long long)R_MIN_BYTES || cap < NT) { fprintf(stderr, "kernel_launch: workspace too small (%zu)\n", ws_size); return; }
    p.cap = (int)cap;
#if MULTI_LAUNCH
    const int grid = 512;
    auto launch = [&](int type, int l, int r) { Params q = p; q.mode = 1; q.ptype = type; q.pl = l; q.pr = r; hipLaunchKernelGGL(fwd_kernel, dim3(grid), dim3(256), 0, stream, q); };
    launch(PT_PREP, 0, 0); launch(PT_MODFIN, 0, 0); launch(PT_LNMOD0, 0, 0);
    for (int l = 0; l < 2; ++l) {
        launch(PT_INPROJ, l, 0); launch(PT_MIX, l, 0); launch(PT_OUTPROJ, l, 0); launch(PT_LN1ROUTE, l, 0);
        for (int r = 0; r < RMAX; ++r) { launch(PT_MOE, l, r); launch(PT_COMB, l, r); }
    }
#else
    static int grid_blocks = 0;
    if (!grid_blocks) {
        int dev = 0, cus = 0, per_cu = 0;
        hipGetDevice(&dev);
        hipDeviceGetAttribute(&cus, hipDeviceAttributeMultiprocessorCount, dev);
        hipOccupancyMaxActiveBlocksPerMultiprocessor(&per_cu, fwd_kernel, 256, 0);
        if (per_cu > 2) per_cu = 2;
        if (per_cu < 1) per_cu = 1;
        grid_blocks = cus * per_cu;
    }
    p.mode = 0;
    hipMemsetAsync(d_ws, 0, 65536, stream);
    hipLaunchKernelGGL(fwd_kernel, dim3(grid_blocks), dim3(256), 0, stream, p);
#endif
}
```

```cpp
#include <hip/hip_runtime.h>
#ifndef TELEM
#define TELEM 0
#endif
#define TELEM_A 0x1
#define TELEM_C 8
#include <hip/hip_cooperative_groups.h>
#include <stdint.h>
#include <stdio.h>
namespace cg = cooperative_groups;

#ifndef MULTI_LAUNCH
#define MULTI_LAUNCH 0
#endif

typedef unsigned short bf16_t;
typedef short bf16x8 __attribute__((ext_vector_type(8)));
typedef short s16x4 __attribute__((ext_vector_type(4)));
typedef float f32x4 __attribute__((ext_vector_type(4)));
typedef unsigned u32x4 __attribute__((ext_vector_type(4)));
typedef unsigned u32x2 __attribute__((ext_vector_type(2)));
#define DEV __device__ __forceinline__
#define LDSP(T) __attribute__((address_space(3))) T*
#define LAS __attribute__((address_space(3)))

constexpr int D = 1024, NB = 8, SEQ = 2048, CTX = 256, NLAT = NB * SEQ, NCTX = NB * CTX, NT = NLAT + NCTX;
constexpr int PROJ = 2304, KEYS = CTX + SEQ, NEXP = 64;
constexpr float DN_ALPHA = 1.41421356237309515f;
constexpr float LOG2E = 1.44269504088896341f;
constexpr int SMEM_BYTES = 72 * 1024;
constexpr int RMAX = 4;

constexpr size_t OFF_CNT = 0;
constexpr size_t OFF_QUEUE = 33792;
constexpr size_t OFF_BAR = 40960;
constexpr size_t OFF_MOD = 65536;
constexpr size_t OFF_ROPE = OFF_MOD + 442368;
constexpr size_t OFF_KERNL = OFF_ROPE + 2ull * 2048 * 32 * 4;
constexpr size_t OFF_KERNC = OFF_KERNL + 2ull * 4096 * 256 * 4;
constexpr size_t OFF_TKE = OFF_KERNC + 2ull * 512 * 256 * 4;
constexpr size_t OFF_TKS = OFF_TKE + (size_t)NT * 8 * 4;
constexpr size_t OFF_TKW = OFF_TKS + (size_t)NT * 8 * 4;
constexpr size_t OFF_LIST = OFF_TKW + (size_t)NT * 8 * 4;
constexpr size_t OFF_WIN = OFF_LIST + 64ull * NT * 4;
constexpr size_t OFF_WOUT = OFF_WIN + 2ull * 2304 * 1024 * 2;
constexpr size_t OFF_SW13 = OFF_WOUT + 2ull * 1024 * 1024 * 2;
constexpr size_t OFF_SW2 = OFF_SW13 + 2ull * 512 * 1024 * 2;
constexpr size_t OFF_RW = OFF_SW2 + 2ull * 1024 * 256 * 2;
constexpr size_t OFF_W13 = OFF_RW + 2ull * 64 * 1024 * 2;
constexpr size_t OFF_W2 = OFF_W13 + 64ull * 256 * 1024 * 2;
constexpr size_t OFF_X = OFF_W2 + 64ull * 1024 * 128 * 2;
constexpr size_t OFF_H = OFF_X + (size_t)NT * 1024 * 2;
constexpr size_t OFF_R = OFF_H + (size_t)NT * 1024 * 2;
constexpr size_t OFF_QA = OFF_R;
constexpr size_t OFF_QB = OFF_QA + 8ull * NT * 64 * 2;
constexpr size_t OFF_KA = OFF_QB + 4ull * NT * 64 * 2;
constexpr size_t OFF_VA = OFF_KA + 8ull * 2 * KEYS * 64 * 2;
constexpr size_t OFF_KB = OFF_VA + 8ull * 2 * KEYS * 64 * 2;
constexpr size_t OFF_VB = OFF_KB + 8ull * 4 * KEYS * 64 * 2;
constexpr size_t OFF_ZTL = OFF_VB + 8ull * 4 * KEYS * 64 * 2;
constexpr size_t OFF_ZTC = OFF_ZTL + 8ull * 768 * 2048 * 2;
constexpr size_t OFF_OX = OFF_ZTC + 8ull * 768 * 256 * 2;
constexpr size_t OFF_OXT = OFF_OX + (size_t)NT * 1024 * 2;
constexpr size_t R_MIN_BYTES = OFF_OXT + 8ull * 256 * 2048 * 2 - OFF_R;
constexpr size_t OFF_PART = OFF_R;
constexpr size_t OFF_YS = OFF_R;

struct Params {
    const float *x, *c, *ctx, *c_ctx, *ada_w, *ada_b, *w_in, *q_gain, *k_gain, *nat_rpb, *hy_conv_w, *hy_conv_b,
        *hy_f_w1, *hy_f_b1, *hy_f_w2, *hy_f_b2, *hy_f_w3, *hy_freq, *hy_skip, *w_out, *ln1_g, *ln1_b,
        *router_w, *router_b, *exp_w1, *exp_w3, *exp_w2, *sh_w1, *sh_w3, *sh_w2, *ln2_g, *ln2_b;
    float* out; unsigned char* ws;
    int cap, mode, ptype, pl, pr, pad;
};

typedef __bf16 hwbf2 __attribute__((ext_vector_type(2)));
typedef float f32x2 __attribute__((ext_vector_type(2)));
DEV unsigned f2bf(float f) { return (unsigned)__builtin_bit_cast(unsigned short, (__bf16)f); }
DEV unsigned pk2(float lo, float hi) { const f32x2 v = {lo, hi}; return __builtin_bit_cast(unsigned, __builtin_convertvector(v, hwbf2)); }
DEV float bf2f(unsigned short h) { return __uint_as_float(((unsigned)h) << 16); }
DEV float wave_sum(float v) {
#pragma unroll
    for (int o = 32; o > 0; o >>= 1) v += __shfl_xor(v, o);
    return v;
}
DEV void glds16(const void* g, void* l) { __builtin_amdgcn_global_load_lds((const unsigned*)g, (unsigned*)l, 16, 0, 0); }
DEV f32x4 mfma16(bf16x8 a, bf16x8 b, f32x4 c) { return __builtin_amdgcn_mfma_f32_16x16x32_bf16(a, b, c, 0, 0, 0); }
DEV float readlane_f(float v, int l) { return __uint_as_float((unsigned)__builtin_amdgcn_readlane((int)__float_as_uint(v), l)); }
DEV int get_tid() { int t = threadIdx.x; asm volatile("" : "+v"(t)); return t; }
DEV int lchunk(int tid) { return (tid & 3) ^ ((0 - (tid >> 4)) & 3); }
DEV int vblock() { const int G = (int)gridDim.x, b = (int)blockIdx.x; return (G & 7) ? b : (b & 7) * (G >> 3) + (b >> 3); }
DEV int mod_group(int row) { return row < NLAT ? (row >> 11) : 8; }

template <int MI, int NI> DEV void zero_acc(f32x4 (&acc)[MI][NI]) {
#pragma unroll
    for (int m = 0; m < MI; ++m)
#pragma unroll
        for (int n = 0; n < NI; ++n) acc[m][n] = (f32x4){0.f, 0.f, 0.f, 0.f};
}
#define WAIT_VM(n) asm volatile("s_waitcnt vmcnt(" #n ")" ::: "memory")
#define WAIT_LGKM0() asm volatile("s_waitcnt lgkmcnt(0)" ::: "memory")
#define RAW_BARRIER() do { asm volatile("" ::: "memory"); __builtin_amdgcn_s_barrier(); asm volatile("" ::: "memory"); } while (0)
template <int MI, int NI, bool TRANS>
DEV void gemm_core(f32x4 (&acc)[MI][NI], const bf16_t* A, const unsigned (&ao)[MI / 2], const bf16_t* B, const unsigned (&bo)[NI / 2], int K, char* lds) {
    const int tid = get_tid(), lane = tid & 63, wid = tid >> 6, fr = lane & 15, fq = lane >> 4, wr = wid >> 1, wc = wid & 1;
    constexpr int SAB = 2048 * MI, STG = 2048 * (MI + NI), LPT = MI / 2 + NI / 2;
    static_assert(LPT == 3 || LPT == 4 || LPT == 6, "loads per tile");
    const int nt = K >> 5;
    auto stage = [&](int s, int t) {
        char* SA = lds + s * STG; char* SB = SA + SAB;
#pragma unroll
        for (int i = 0; i < MI / 2; ++i) glds16(A + (ao[i] + (unsigned)(t * 32)), SA + i * 4096 + tid * 16);
#pragma unroll
        for (int i = 0; i < NI / 2; ++i) glds16(B + (bo[i] + (unsigned)(t * 32)), SB + i * 4096 + tid * 16);
    };
    WAIT_VM(0);
    stage(0, 0);
    if (nt > 1) stage(1, 1);
    const int sw = (fq ^ ((0 - (fr >> 2)) & 3)) * 16;
    const int aoff = (wr * MI * 16 + fr) * 64 + sw, boff = SAB + (wc * NI * 16 + fr) * 64 + sw;
#pragma unroll 1
    for (int t = 0; t < nt; ++t) {
        if (t + 1 < nt) { if (LPT == 6) WAIT_VM(6); else if (LPT == 4) WAIT_VM(4); else WAIT_VM(3); } else WAIT_VM(0);
        RAW_BARRIER();
        const char* S = lds + (t & 1) * STG;
        bf16x8 af[MI], bfr[NI];
#pragma unroll
        for (int m = 0; m < MI; ++m) af[m] = *(const bf16x8*)(S + aoff + m * 1024);
#pragma unroll
        for (int n = 0; n < NI; ++n) bfr[n] = *(const bf16x8*)(S + boff + n * 1024);
        WAIT_LGKM0();
        RAW_BARRIER();
        if (t + 2 < nt) stage(t & 1, t + 2);
#pragma unroll
        for (int m = 0; m < MI; ++m)
#pragma unroll
            for (int n = 0; n < NI; ++n) acc[m][n] = TRANS ? mfma16(bfr[n], af[m], acc[m][n]) : mfma16(af[m], bfr[n], acc[m][n]);
    }
}
DEV unsigned st64_off(int tid) { return (unsigned)(tid >> 3) * 1024u + (unsigned)(((tid & 7) ^ ((tid >> 3) & 7)) * 8); }
DEV int tr_key(int row) { return (row & 3) | (((row >> 3) & 1) << 2); }
template <bool TRANS>
DEV void gemm_core64(f32x4 (&acc)[4][4], const bf16_t* A, const unsigned (&ao)[4], const bf16_t* B, const unsigned (&bo)[4], int K, char* lds,
                     const bf16_t* AT = nullptr, int t_tr = 1 << 20) {
    const int tid = get_tid(), lane = tid & 63, wid = tid >> 6, fr = lane & 15, fq = lane >> 4, wr = wid >> 1, wc = wid & 1;
    const int nt = K >> 6;
    auto stage = [&](int s, int t) {
        char* SA = lds + s * 32768; char* SB = SA + 16384;
        if (t >= t_tr) {
#pragma unroll
            for (int i = 0; i < 4; ++i) {
                const int id = tid + 256 * i, row = id >> 4, cp = id & 15, c = (cp - 2 * tr_key(row)) & 15;
                glds16(AT + (size_t)((t - t_tr) * 64 + row) * 2048 + c * 8, SA + id * 16);
            }
        } else {
#pragma unroll
            for (int i = 0; i < 4; ++i) glds16(A + (ao[i] + (unsigned)(t * 64)), SA + i * 4096 + tid * 16);
        }
#pragma unroll
        for (int i = 0; i < 4; ++i) glds16(B + (bo[i] + (unsigned)(t * 64)), SB + i * 4096 + tid * 16);
    };
    WAIT_VM(0);
    stage(0, 0);
    if (nt > 1) stage(1, 1);
    const int rsw = fr & 7;
    const int arow = (wr * 64 + fr) * 128, brow = 16384 + (wc * 64 + fr) * 128;
    const int c0 = ((fq) ^ rsw) * 16, c1 = ((4 + fq) ^ rsw) * 16;
#pragma unroll 1
    for (int t = 0; t < nt; ++t) {
        if (t + 1 < nt) WAIT_VM(8); else WAIT_VM(0);
        RAW_BARRIER();
        const char* S = lds + (t & 1) * 32768;
        bf16x8 af[4][2], bfr[4][2];
        if (t >= t_tr) {
            const int q4 = fr >> 2, p4 = fr & 3;
#pragma unroll
            for (int m = 0; m < 4; ++m)
#pragma unroll
                for (int ks = 0; ks < 2; ++ks) {
                    const int rowA = ks * 32 + 8 * fq + q4, rowB = rowA + 4, c = wr * 8 + m * 2 + (p4 >> 1);
                    const int offA = rowA * 256 + (((c + 2 * tr_key(rowA)) & 15) * 16) + (p4 & 1) * 8;
                    const int offB = rowB * 256 + (((c + 2 * tr_key(rowB)) & 15) * 16) + (p4 & 1) * 8;
                    const s16x4 ta = __builtin_amdgcn_ds_read_tr16_b64_v4i16((LDSP(s16x4))(S + offA));
                    const s16x4 tb = __builtin_amdgcn_ds_read_tr16_b64_v4i16((LDSP(s16x4))(S + offB));
                    bf16x8 f; f[0] = ta[0]; f[1] = ta[1]; f[2] = ta[2]; f[3] = ta[3]; f[4] = tb[0]; f[5] = tb[1]; f[6] = tb[2]; f[7] = tb[3];
                    af[m][ks] = f;
                }
        } else {
#pragma unroll
            for (int m = 0; m < 4; ++m) { af[m][0] = *(const bf16x8*)(S + arow + m * 2048 + c0); af[m][1] = *(const bf16x8*)(S + arow + m * 2048 + c1); }
        }
#pragma unroll
        for (int n = 0; n < 4; ++n) { bfr[n][0] = *(const bf16x8*)(S + brow + n * 2048 + c0); bfr[n][1] = *(const bf16x8*)(S + brow + n * 2048 + c1); }
        WAIT_LGKM0();
        RAW_BARRIER();
        if (t + 2 < nt) stage(t & 1, t + 2);
        __builtin_amdgcn_s_setprio(1);
#pragma unroll
        for (int ks = 0; ks < 2; ++ks)
#pragma unroll
            for (int m = 0; m < 4; ++m)
#pragma unroll
                for (int n = 0; n < 4; ++n) acc[m][n] = TRANS ? mfma16(bfr[n][ks], af[m][ks], acc[m][n]) : mfma16(af[m][ks], bfr[n][ks], acc[m][n]);
        __builtin_amdgcn_s_setprio(0);
    }
}
template <int KACT, int ASTRIDE, class EPI>
DEV void gemm2_stream64(const bf16_t* W2, const char* ACT, char* sb, EPI&& epi) {
    const int tid = get_tid(), lane = tid & 63, wid = tid >> 6, fr = lane & 15, fq = lane >> 4, wr = wid >> 1, wc = wid & 1;
    constexpr int KS = KACT / 64, NJ = 8 * KS;
    const unsigned b0 = (unsigned)(tid >> 3) * KACT + (unsigned)(((tid & 7) ^ ((tid >> 3) & 7)) * 8);
    auto stage = [&](int s, int j) {
        const int nt = j / KS, ks = j % KS;
        char* SB = sb + s * 16384;
        const bf16_t* src = W2 + (size_t)nt * 128 * KACT + ks * 64 + b0;
#pragma unroll
        for (int i = 0; i < 4; ++i) glds16(src + (size_t)i * 32 * KACT, SB + i * 4096 + tid * 16);
    };
    WAIT_VM(0);
    stage(0, 0); stage(1, 1);
    const int rsw = fr & 7;
    const int brow = (wc * 64 + fr) * 128, c0 = (fq ^ rsw) * 16, c1 = ((4 + fq) ^ rsw) * 16;
    f32x4 acc[4][4]; zero_acc<4, 4>(acc);
#pragma unroll 1
    for (int j = 0; j < NJ; ++j) {
        const int ks = j % KS;
        if (j + 1 < NJ) WAIT_VM(4); else WAIT_VM(0);
        RAW_BARRIER();
        const char* S = sb + (j & 1) * 16384;
        bf16x8 af[4][2], bfr[4][2];
#pragma unroll
        for (int m = 0; m < 4; ++m) { const char* ar = ACT + (wr * 64 + m * 16 + fr) * ASTRIDE + (ks * 64 + fq * 8) * 2; af[m][0] = *(const bf16x8*)ar; af[m][1] = *(const bf16x8*)(ar + 64); }
#pragma unroll
        for (int n = 0; n < 4; ++n) { bfr[n][0] = *(const bf16x8*)(S + brow + n * 2048 + c0); bfr[n][1] = *(const bf16x8*)(S + brow + n * 2048 + c1); }
        WAIT_LGKM0();
        RAW_BARRIER();
        if (j + 2 < NJ) stage(j & 1, j + 2);
#pragma unroll
        for (int k2 = 0; k2 < 2; ++k2)
#pragma unroll
            for (int m = 0; m < 4; ++m)
#pragma unroll
                for (int n = 0; n < 4; ++n) acc[m][n] = mfma16(bfr[n][k2], af[m][k2], acc[m][n]);
        if (ks == KS - 1) { epi(j / KS, acc); zero_acc<4, 4>(acc); }
    }
}
template <int MI, int KACT, int ASTRIDE, class EPI>
DEV void gemm2_stream(const bf16_t* W2, const char* ACT, char* sb, EPI&& epi) {
    const int tid = get_tid(), lane = tid & 63, wid = tid >> 6, fr = lane & 15, fq = lane >> 4, wr = wid >> 1, wc = wid & 1;
    constexpr int KS = KACT / 32, NJ = 8 * KS;
    const bf16_t* b0 = W2 + (size_t)(tid >> 2) * KACT + lchunk(tid) * 8;
    auto stage = [&](int s, int j) {
        const int nt = j / KS, ks = j % KS;
        char* SB = sb + s * 8192;
        const bf16_t* src = b0 + (size_t)nt * 128 * KACT + ks * 32;
        glds16(src, SB + tid * 16);
        glds16(src + 64 * KACT, SB + 4096 + tid * 16);
    };
    WAIT_VM(0);
    stage(0, 0); stage(1, 1);
    const int boff = (wc * 64 + fr) * 64 + (fq ^ ((0 - (fr >> 2)) & 3)) * 16;
    f32x4 acc[MI][4]; zero_acc<MI, 4>(acc);
#pragma unroll 1
    for (int j = 0; j < NJ; ++j) {
        const int ks = j % KS;
        if (j + 1 < NJ) WAIT_VM(2); else WAIT_VM(0);
        RAW_BARRIER();
        const char* S = sb + (j & 1) * 8192;
        bf16x8 af[MI], bfr[4];
#pragma unroll
        for (int m = 0; m < MI; ++m) af[m] = *(const bf16x8*)(ACT + (wr * MI * 16 + m * 16 + fr) * ASTRIDE + (ks * 32 + fq * 8) * 2);
#pragma unroll
        for (int n = 0; n < 4; ++n) bfr[n] = *(const bf16x8*)(S + boff + n * 1024);
        WAIT_LGKM0();
        RAW_BARRIER();
        if (j + 2 < NJ) stage(j & 1, j + 2);
#pragma unroll
        for (int m = 0; m < MI; ++m)
#pragma unroll
            for (int n = 0; n < 4; ++n) acc[m][n] = mfma16(bfr[n], af[m], acc[m][n]);
        if (ks == KS - 1) { epi(j / KS, acc); zero_acc<MI, 4>(acc); }
    }
}

DEV void prep_mod_item(const Params& p, int it, char* lds) {
    const int l = it / 96, r = it % 96, cch = r >> 2, kp = r & 3, tid = get_tid(), lane = tid & 63, kq = tid >> 6;
    float* sl = (float*)lds;
    float* red = sl + 9 * 256;
    for (int i = tid; i < 9 * 256; i += 256) { const int g = i >> 8, k = kp * 256 + (i & 255); const float v = (g < 8) ? p.c[g * 1024 + k] : p.c_ctx[k]; sl[i] = v * __builtin_amdgcn_rcpf(1.f + __expf(-v)); }
    __syncthreads();
    f32x4 acc[9];
#pragma unroll
    for (int g = 0; g < 9; ++g) acc[g] = (f32x4){0.f, 0.f, 0.f, 0.f};
    const float* w = p.ada_w + ((size_t)l * 1024 + kp * 256 + kq * 64) * 6144 + cch * 256 + lane * 4;
#pragma unroll 16
    for (int kk = 0; kk < 64; ++kk) {
        const f32x4 wv = *(const f32x4*)(w + (size_t)kk * 6144);
#pragma unroll
        for (int g = 0; g < 9; ++g) { const float sv = sl[g * 256 + kq * 64 + kk]; acc[g] += sv * wv; }
    }
#pragma unroll
    for (int g = 0; g < 9; ++g) *(f32x4*)(red + (kq * 9 + g) * 256 + lane * 4) = acc[g];
    __syncthreads();
    float* part = (float*)(p.ws + OFF_R) + (size_t)(l * 24 + cch) * 4 * 2304;
    for (int i = tid; i < 9 * 256; i += 256) {
        const int g = i >> 8, c = i & 255;
        part[kp * 2304 + i] = (red[(0 * 9 + g) * 256 + c] + red[(1 * 9 + g) * 256 + c]) + (red[(2 * 9 + g) * 256 + c] + red[(3 * 9 + g) * 256 + c]);
    }
    __threadfence();
    __syncthreads();
    int* arrive = (int*)(lds + SMEM_BYTES - 252);
    if (tid == 0) *arrive = atomicAdd((int*)(p.ws + OFF_QUEUE) + 256 + l * 24 + cch, 1);
    __syncthreads();
    if (*arrive == 3) {
        __threadfence();
        float* mod = (float*)(p.ws + OFF_MOD);
        for (int i = tid; i < 9 * 256; i += 256) {
            const int g = i >> 8, c = i & 255;
            const float v = (__builtin_nontemporal_load(part + i) + __builtin_nontemporal_load(part + 2304 + i)) + (__builtin_nontemporal_load(part + 2 * 2304 + i) + __builtin_nontemporal_load(part + 3 * 2304 + i));
            mod[((size_t)l * 9 + g) * 6144 + cch * 256 + c] = p.ada_b[l * 6144 + cch * 256 + c] + v;
        }
    }
    __syncthreads();
}
constexpr float INV2PI = 0.15915494309189535f;
DEV float sin_rev(float r) { return __builtin_amdgcn_sinf(__builtin_amdgcn_fractf(r)); }
DEV float cos_rev(float r) { return __builtin_amdgcn_cosf(__builtin_amdgcn_fractf(r)); }
DEV void prep_rope_item(const Params& p, int it) {
    const int idx = it * 256 + get_tid(), t = idx >> 5, i = idx & 31;
    const float inv = __builtin_amdgcn_exp2f(-(float)(2 * (i & 15)) * (13.287712379549449f / 32.f));
    const float ang = (float)((i < 16) ? (t >> 6) : (t & 63)) * inv;
    float* rc = (float*)(p.ws + OFF_ROPE);
    rc[idx] = cos_rev(ang * INV2PI); rc[2048 * 32 + idx] = sin_rev(ang * INV2PI);
}
DEV void prep_filter_item(const Params& p, int it, char* lds) {
    const int tid = get_tid(), lane = tid & 63, wid = tid >> 6;
    const int row0 = it * 32 + wid * 8;
    const int l = row0 / 2304, r0 = row0 % 2304, type = r0 < 2048 ? 0 : 1, t0 = type ? r0 - 2048 : r0, n = type ? 256 : 2048;
    float* z = (float*)lds + wid * (8 * 192); float* h1 = z + 8 * 64; float* h2 = h1 + 8 * 64;
    float* WL = (float*)(lds + 24576);
    const float rn1 = type ? 1.f / 255.f : 1.f / 2047.f;
    for (int idx = tid; idx < 97 * 16; idx += 256) {
        const int row = idx >> 4, c4 = (idx & 15) * 4;
        const float* src = row < 33 ? p.hy_f_w1 + (l * 33 + row) * 64 : p.hy_f_w2 + (l * 64 + row - 33) * 64;
        *(f32x4*)(WL + row * 64 + c4) = *(const f32x4*)(src + c4);
    }
#pragma unroll
    for (int rr = 0; rr < 8; ++rr) {
        const int t = t0 + rr;
        if (lane < 33) {
            float v;
            if (lane == 0) v = (float)t * rn1;
            else {
                const int i = (lane - 1) & 15;
                const float f = 1e-4f + (float)i * ((15.f - 1e-4f) / 15.f);
                const float rev = f * ((float)t * (type ? 1.f / 256.f : 1.f / 2048.f));
                v = (lane <= 16) ? cos_rev(rev) : -sin_rev(rev);
            }
            z[rr * 64 + lane] = v;
        }
    }
    __syncthreads();
    {
        float s[8]; const float b = p.hy_f_b1[l * 64 + lane];
#pragma unroll
        for (int rr = 0; rr < 8; ++rr) s[rr] = b;
#pragma unroll 11
        for (int i = 0; i < 33; ++i) {
            const float w = WL[i * 64 + lane];
#pragma unroll
            for (int rr = 0; rr < 8; ++rr) s[rr] += z[rr * 64 + i] * w;
        }
        const float fq0 = p.hy_freq[(l * 2 + 0) * 64 + lane];
#pragma unroll
        for (int rr = 0; rr < 8; ++rr) h1[rr * 64 + lane] = sin_rev(fq0 * s[rr] * INV2PI);
    }
    __builtin_amdgcn_wave_barrier();
    {
        float s[8]; const float b = p.hy_f_b2[l * 64 + lane];
#pragma unroll
        for (int rr = 0; rr < 8; ++rr) s[rr] = b;
#pragma unroll 16
        for (int i = 0; i < 64; ++i) {
            const float w = WL[(33 + i) * 64 + lane];
#pragma unroll
            for (int rr = 0; rr < 8; ++rr) s[rr] += h1[rr * 64 + i] * w;
        }
        const float fq1 = p.hy_freq[(l * 2 + 1) * 64 + lane];
#pragma unroll
        for (int rr = 0; rr < 8; ++rr) h2[rr * 64 + lane] = sin_rev(fq1 * s[rr] * INV2PI);
    }
    __syncthreads();
    float acc[8][8];
#pragma unroll
    for (int rr = 0; rr < 8; ++rr)
#pragma unroll
        for (int q = 0; q < 8; ++q) acc[rr][q] = 0.f;
    const float* w3 = p.hy_f_w3 + (size_t)l * 64 * 512;
#pragma unroll 1
    for (int ch = 0; ch < 4; ++ch) {
#pragma unroll
        for (int j = 0; j < 8; ++j) { const int idx = tid + j * 256; *(f32x4*)(WL + idx * 4) = *(const f32x4*)(w3 + (size_t)ch * 16 * 512 + idx * 4); }
        __syncthreads();
#pragma unroll 2
        for (int i = 0; i < 16; ++i) {
            float w[8];
#pragma unroll
            for (int q = 0; q < 8; ++q) w[q] = WL[i * 512 + q * 64 + lane];
#pragma unroll
            for (int rr = 0; rr < 8; ++rr) {
                const float hv = h2[rr * 64 + ch * 16 + i];
#pragma unroll
                for (int q = 0; q < 8; ++q) acc[rr][q] += hv * w[q];
            }
        }
        __syncthreads();
    }
    bf16_t* kf = (bf16_t*)(p.ws + (type ? OFF_KERNC + (size_t)l * 2 * 256 * 256 * 2 : OFF_KERNL + (size_t)l * 2 * 256 * 2048 * 2));
    const float lo = logf(1e-2f) / 1.5f, hi = logf(1e-2f) / 0.3f;
#pragma unroll
    for (int q = 0; q < 8; ++q) {
        const int qh = q >> 2, c = (q & 3) * 64 + lane;
        const float delta = fabsf(lo + (float)c * ((hi - lo) / 255.f));
        float v[8];
#pragma unroll
        for (int rr = 0; rr < 8; ++rr) { const float tt = (float)(t0 + rr) * rn1; v[rr] = acc[rr][q] * __expf(-tt * delta); }
        if (qh == 0 && t0 == 0) v[0] += p.hy_skip[l * 256 + c];
        *(u32x4*)(kf + ((size_t)qh * 256 + c) * n + t0) = (u32x4){pk2(v[0], v[1]), pk2(v[2], v[3]), pk2(v[4], v[5]), pk2(v[6], v[7])};
    }
}
struct ConvDesc { const float* src; bf16_t* dst; int ldsrc, k0, n0, lddst, mapkind; };
DEV void conv_load(const ConvDesc& d, f32x4 (&v)[4], int tid) {
    const int r = tid >> 4, c4 = (tid & 15) * 4;
#pragma unroll
    for (int i = 0; i < 4; ++i) v[i] = *(const f32x4*)(d.src + (size_t)(d.k0 + r + 16 * i) * d.ldsrc + d.n0 + c4);
}
DEV void conv_store(const ConvDesc& d, const f32x4 (&v)[4], char* lds, int tid) {
    float* tl = (float*)lds;
    {
        const int r = tid >> 4, c4 = (tid & 15) * 4;
#pragma unroll
        for (int i = 0; i < 4; ++i) { const int row = r + 16 * i; tl[row * 65 + c4 + 0] = v[i][0]; tl[row * 65 + c4 + 1] = v[i][1]; tl[row * 65 + c4 + 2] = v[i][2]; tl[row * 65 + c4 + 3] = v[i][3]; }
    }
    __syncthreads();
    {
        const int n = tid >> 2, kc = tid & 3, ng = d.n0 + n;
        int drow = ng;
        if (d.mapkind == 1) drow = 32 * (ng >> 4) + (ng & 15);
        else if (d.mapkind == 2) drow = 32 * (ng >> 4) + 16 + (ng & 15);
        else if (d.mapkind == 3) drow = (ng >> 7) * 256 + 32 * ((ng & 127) >> 4) + (ng & 15);
        else if (d.mapkind == 4) drow = (ng >> 7) * 256 + 32 * ((ng & 127) >> 4) + 16 + (ng & 15);
        else if (d.mapkind == 5) drow = (ng & ~31) + 16 * ((ng >> 2) & 1) + 4 * ((ng >> 3) & 3) + (ng & 3);
        unsigned w[8];
#pragma unroll
        for (int j = 0; j < 8; ++j) w[j] = pk2(tl[(kc * 16 + 2 * j) * 65 + n], tl[(kc * 16 + 2 * j + 1) * 65 + n]);
        u32x4* o = (u32x4*)(d.dst + (size_t)drow * d.lddst + d.k0 + kc * 16);
        o[0] = (u32x4){w[0], w[1], w[2], w[3]};
        o[1] = (u32x4){w[4], w[5], w[6], w[7]};
    }
    __syncthreads();
}
DEV ConvDesc conv_fixed_desc(const Params& p, int it) {
    const int l = it / 1040; int r = it % 1040;
    unsigned char* ws = p.ws;
    if (r < 576) return ConvDesc{p.w_in + (size_t)l * 1024 * PROJ, (bf16_t*)(ws + OFF_WIN) + (size_t)l * PROJ * 1024, PROJ, (r / 36) * 64, (r % 36) * 64, 1024, (r % 36) * 64 < 1536 ? 5 : 0};
    r -= 576;
    if (r < 256) return ConvDesc{p.w_out + (size_t)l * 1024 * 1024, (bf16_t*)(ws + OFF_WOUT) + (size_t)l * 1024 * 1024, 1024, (r / 16) * 64, (r % 16) * 64, 1024, 5};
    r -= 256;
    if (r < 64) return ConvDesc{p.sh_w1 + (size_t)l * 1024 * 256, (bf16_t*)(ws + OFF_SW13) + (size_t)l * 512 * 1024, 256, (r / 4) * 64, (r % 4) * 64, 1024, 3};
    r -= 64;
    if (r < 64) return ConvDesc{p.sh_w3 + (size_t)l * 1024 * 256, (bf16_t*)(ws + OFF_SW13) + (size_t)l * 512 * 1024, 256, (r / 4) * 64, (r % 4) * 64, 1024, 4};
    r -= 64;
    if (r < 64) { const int kt = r / 16, hh = kt >> 1;
        return ConvDesc{p.sh_w2 + (size_t)l * 256 * 1024, (bf16_t*)(ws + OFF_SW2) + (size_t)(l * 2 + hh) * 1024 * 128 - hh * 128, 1024, kt * 64, (r % 16) * 64, 128, 5}; }
    r -= 64;
    return ConvDesc{p.router_w + (size_t)l * 1024 * 64, (bf16_t*)(ws + OFF_RW) + (size_t)l * 64 * 1024, 64, r * 64, 0, 1024, 0};
}
DEV ConvDesc conv_expert_desc(const Params& p, int l, int it) {
    const int e = it / 96; int r = it % 96;
    unsigned char* ws = p.ws;
    const size_t eo = (size_t)(l * 64 + e) * 1024 * 128;
    if (r < 32) return ConvDesc{p.exp_w1 + eo, (bf16_t*)(ws + OFF_W13) + (size_t)e * 256 * 1024, 128, (r / 2) * 64, (r % 2) * 64, 1024, 1};
    r -= 32;
    if (r < 32) return ConvDesc{p.exp_w3 + eo, (bf16_t*)(ws + OFF_W13) + (size_t)e * 256 * 1024, 128, (r / 2) * 64, (r % 2) * 64, 1024, 2};
    r -= 32;
    return ConvDesc{p.exp_w2 + eo, (bf16_t*)(ws + OFF_W2) + (size_t)e * 1024 * 128, 1024, (r / 16) * 64, (r % 16) * 64, 128, 5};
}
DEV void conv_run(const Params& p, int l, int first, int count, char* lds) {
    const int tid = get_tid();
    if (count <= 0) return;
    ConvDesc d = l < 0 ? conv_fixed_desc(p, first) : conv_expert_desc(p, l, first);
    f32x4 v[4]; conv_load(d, v, tid);
#pragma unroll 1
    for (int i = 0; i < count; ++i) {
        ConvDesc dn = d; f32x4 vn[4];
        if (i + 1 < count) { dn = l < 0 ? conv_fixed_desc(p, first + i + 1) : conv_expert_desc(p, l, first + i + 1); conv_load(dn, vn, tid); }
        else {
#pragma unroll
            for (int k = 0; k < 4; ++k) vn[k] = v[k];
        }
        conv_store(d, v, lds, tid);
        d = dn;
#pragma unroll
        for (int k = 0; k < 4; ++k) v[k] = vn[k];
    }
}
DEV void phase_prep(const Params& p, char* lds) {
    { const int t_ = get_tid(); if (blockIdx.x == 0 && t_ < 128) ((int*)(p.ws + OFF_CNT))[t_ * 64] = 0; }
    constexpr int N0 = 144, N1 = N0 + 192, N2 = N1 + 260, N3 = N2 + 768, N4 = N3 + 256;
    int* qhead = (int*)(p.ws + OFF_QUEUE) + 2 * 64;
    int* qslot = (int*)(lds + SMEM_BYTES - 256);
    for (;;) {
        __syncthreads();
        if (get_tid() == 0) *qslot = atomicAdd(qhead, 1);
        __syncthreads();
        const int it = *qslot;
        if (it >= N4) break;
        if (it < N0) prep_filter_item(p, it, lds);
        else if (it < N1) prep_mod_item(p, it - N0, lds);
        else if (it < N2) conv_run(p, -1, (it - N1) * 8, 8, lds);
        else if (it < N3) conv_run(p, 0, (it - N2) * 8, 8, lds);
        else prep_rope_item(p, it - N3);
    }
}
DEV void phase_modfin(const Params& p) {
    const float* part = (const float*)(p.ws + OFF_PART);
    float* mod = (float*)(p.ws + OFF_MOD);
    for (int idx = blockIdx.x * 256 + get_tid(); idx < 2 * 9 * 6144; idx += gridDim.x * 256) {
        const int l = idx / (9 * 6144), g = (idx / 6144) % 9, col = idx % 6144;
        float s = p.ada_b[l * 6144 + col];
        for (int k = 0; k < 32; ++k) s += part[((size_t)(k * 2 + l) * 9 + g) * 6144 + col];
        mod[idx] = s;
    }
}

DEV void row_load(const float* src, f32x4 (&v)[4], int lane) {
#pragma unroll
    for (int j = 0; j < 4; ++j) v[j] = *(const f32x4*)(src + 4 * lane + 256 * j);
}
DEV f32x4 ld_bf4(const bf16_t* p) { const u32x2 w = *(const u32x2*)p; return (f32x4){__uint_as_float(w[0] << 16), __uint_as_float(w[0] & 0xffff0000u), __uint_as_float(w[1] << 16), __uint_as_float(w[1] & 0xffff0000u)}; }
DEV void st_bf4(bf16_t* p, const f32x4& v) { *(u32x2*)p = (u32x2){pk2(v[0], v[1]), pk2(v[2], v[3])}; }
DEV void row_load_bf(const bf16_t* src, f32x4 (&v)[4], int lane) {
#pragma unroll
    for (int j = 0; j < 4; ++j) v[j] = ld_bf4(src + 4 * lane + 256 * j);
}
DEV void row_norm(f32x4 (&v)[4]) {
    float s = 0.f;
#pragma unroll
    for (int j = 0; j < 4; ++j) s += (v[j][0] + v[j][1]) + (v[j][2] + v[j][3]);
    const float mean = wave_sum(s) * (1.f / 1024.f);
    float q = 0.f;
#pragma unroll
    for (int j = 0; j < 4; ++j) { v[j] = v[j] - mean; q += (v[j][0] * v[j][0] + v[j][1] * v[j][1]) + (v[j][2] * v[j][2] + v[j][3] * v[j][3]); }
    const float rstd = __builtin_amdgcn_rsqf(wave_sum(q) * (1.f / 1024.f) + 1e-6f);
#pragma unroll
    for (int j = 0; j < 4; ++j) v[j] = v[j] * rstd;
}
DEV void row_store_mod_bf16(bf16_t* dst, const f32x4 (&v)[4], const float* shift, const float* scale, int lane) {
#pragma unroll
    for (int j = 0; j < 4; ++j) {
        const int c = 4 * lane + 256 * j;
        const f32x4 sh = *(const f32x4*)(shift + c), sc = *(const f32x4*)(scale + c);
        const f32x4 o = v[j] * (sc + 1.0f) + sh;
        *(u32x2*)(dst + c) = (u32x2){pk2(o[0], o[1]), pk2(o[2], o[3])};
    }
}
DEV void phase_lnmod0(const Params& p) {
    const int tid_ = get_tid(), lane = tid_ & 63, wid = tid_ >> 6;
    const float* mod = (const float*)(p.ws + OFF_MOD);
    bf16_t* H = (bf16_t*)(p.ws + OFF_H);
    for (int row = blockIdx.x * 4 + wid; row < NT; row += gridDim.x * 4) {
        const float* src = row < NLAT ? p.x + (size_t)row * 1024 : p.ctx + (size_t)(row - NLAT) * 1024;
        f32x4 v[4]; row_load(src, v, lane); row_norm(v);
        const float* m = mod + (size_t)mod_group(row) * 6144;
        row_store_mod_bf16(H + (size_t)row * 1024, v, m, m + 1024, lane);
    }
}

DEV void phase_inproj(const Params& p, int l, char* lds) {
    const int tid = get_tid(), lane = tid & 63, wid = tid >> 6, fr = lane & 15, fq = lane >> 4, wr = wid >> 1, wc = wid & 1;
    unsigned char* ws = p.ws;
    const bf16_t* H = (const bf16_t*)(ws + OFF_H);
    const bf16_t* W = (const bf16_t*)(ws + OFF_WIN) + (size_t)l * PROJ * 1024;
    const float* ropec = (const float*)(ws + OFF_ROPE); const float* ropes = ropec + 2048 * 32;
    const int nitems = 128 * 18 + 16 * (l == 0 ? 18 : 6);
    for (int it = blockIdx.x; it < nitems; it += gridDim.x) {
        int mt, nt;
        if (it < 2304) { mt = it / 18; nt = it % 18; }
        else { const int j = it - 2304; if (l == 0) { mt = 128 + j / 18; nt = j % 18; } else { mt = 128 + j / 6; const int q = j % 6; nt = q < 2 ? 4 + q : 6 + q; } }
        const int m0 = mt * 128, n0 = nt * 128;
        const unsigned a0 = (unsigned)m0 * 1024u + st64_off(tid), b0 = (unsigned)n0 * 1024u + st64_off(tid);
        const unsigned ao[4] = {a0, a0 + 32u * 1024u, a0 + 64u * 1024u, a0 + 96u * 1024u};
        const unsigned bo[4] = {b0, b0 + 32u * 1024u, b0 + 64u * 1024u, b0 + 96u * 1024u};
        f32x4 acc[4][4]; zero_acc<4, 4>(acc);
        const bool latent = m0 < NLAT;
        const int b = latent ? (m0 >> 11) : ((m0 - NLAT) >> 8);
        const int tbase = latent ? (m0 & 2047) : ((m0 - NLAT) & 255);
        if (nt >= 12) {
            const int rho = tid >> 3, ptok = 8 * ((rho & 15) >> 2) + 4 * (rho >> 4) + (rho & 3);
            const unsigned ap0 = (unsigned)(m0 + ptok) * 1024u + (unsigned)(((tid & 7) ^ (rho & 7)) * 8);
            const unsigned aop[4] = {ap0, ap0 + 32u * 1024u, ap0 + 64u * 1024u, ap0 + 96u * 1024u};
            gemm_core64<false>(acc, H, aop, W, bo, 1024, lds);
            bf16_t* zt = latent ? (bf16_t*)(ws + OFF_ZTL) + (size_t)b * 768 * 2048 : (bf16_t*)(ws + OFF_ZTC) + (size_t)b * 768 * 256;
            const int n = latent ? 2048 : 256;
#pragma unroll
            for (int g = 0; g < 2; ++g)
#pragma unroll
                for (int nn = 0; nn < 4; ++nn) {
                    const int ch = n0 - 1536 + wc * 64 + nn * 16 + fr, t = tbase + wr * 64 + 32 * g + 8 * fq;
                    *(u32x4*)(zt + (size_t)ch * n + t) = (u32x4){pk2(acc[2 * g][nn][0], acc[2 * g][nn][1]), pk2(acc[2 * g][nn][2], acc[2 * g][nn][3]),
                                                                 pk2(acc[2 * g + 1][nn][0], acc[2 * g + 1][nn][1]), pk2(acc[2 * g + 1][nn][2], acc[2 * g + 1][nn][3])};
                }
        } else {
            gemm_core64<true>(acc, H, ao, W, bo, 1024, lds);
            const int col0 = n0 + wc * 64;
            int kind, hh;
            if (col0 < 512) { kind = 0; hh = col0 >> 6; } else if (col0 < 640) { kind = 1; hh = (col0 - 512) >> 6; } else if (col0 < 768) { kind = 2; hh = (col0 - 640) >> 6; }
            else if (col0 < 1024) { kind = 3; hh = (col0 - 768) >> 6; } else if (col0 < 1280) { kind = 4; hh = (col0 - 1024) >> 6; } else { kind = 5; hh = (col0 - 1280) >> 6; }
            const bool normed = (kind == 0 || kind == 1);
            const float* gain = (kind == 0 ? p.q_gain : p.k_gain) + l * 64;
#pragma unroll
            for (int m = 0; m < 4; ++m) {
                const int rloc = wr * 64 + m * 16 + fr, row = m0 + rloc, t = tbase + rloc;
                f32x4 v[4];
#pragma unroll
                for (int nn = 0; nn < 4; ++nn) v[nn] = acc[m][nn];
                if (normed) {
                    float ss = 0.f;
#pragma unroll
                    for (int nn = 0; nn < 4; ++nn) ss += (v[nn][0] * v[nn][0] + v[nn][1] * v[nn][1]) + (v[nn][2] * v[nn][2] + v[nn][3] * v[nn][3]);
                    ss += __shfl_xor(ss, 16); ss += __shfl_xor(ss, 32);
                    const float r = __builtin_amdgcn_rsqf(ss * (1.f / 64.f) + 1e-6f);
#pragma unroll
                    for (int nn = 0; nn < 4; ++nn) {
                        const int hc = 32 * (nn >> 1) + 8 * fq + 4 * (nn & 1);
                        const f32x4 g = *(const f32x4*)(gain + hc);
                        v[nn] = v[nn] * r * g;
                        if (latent) {
                            const int pi = hc >> 1;
                            const float c0 = ropec[t * 32 + pi], s0 = ropes[t * 32 + pi], c1 = ropec[t * 32 + pi + 1], s1 = ropes[t * 32 + pi + 1];
                            const float x0 = v[nn][0], x1 = v[nn][1], x2 = v[nn][2], x3 = v[nn][3];
                            v[nn][0] = x0 * c0 - x1 * s0; v[nn][1] = x0 * s0 + x1 * c0;
                            v[nn][2] = x2 * c1 - x3 * s1; v[nn][3] = x2 * s1 + x3 * c1;
                        }
                    }
                }
                if (kind == 0 || kind == 3) {
#pragma unroll
                    for (int nn = 0; nn < 4; ++nn) v[nn] = v[nn] * (0.125f * LOG2E);
                }
                bf16_t* dst;
                const int key = latent ? 256 + t : t;
                if (kind == 0) dst = (bf16_t*)(ws + OFF_QA) + ((size_t)hh * NT + row) * 64;
                else if (kind == 3) dst = (bf16_t*)(ws + OFF_QB) + ((size_t)hh * NT + row) * 64;
                else if (kind == 1) dst = (bf16_t*)(ws + OFF_KA) + ((size_t)(b * 2 + hh) * KEYS + key) * 64;
                else if (kind == 2) dst = (bf16_t*)(ws + OFF_VA) + ((size_t)(b * 2 + hh) * KEYS + key) * 64;
                else if (kind == 4) dst = (bf16_t*)(ws + OFF_KB) + ((size_t)(b * 4 + hh) * KEYS + key) * 64;
                else dst = (bf16_t*)(ws + OFF_VB) + ((size_t)(b * 4 + hh) * KEYS + key) * 64;
#pragma unroll
                for (int gg = 0; gg < 2; ++gg) *(u32x4*)(dst + 32 * gg + 8 * fq) = (u32x4){pk2(v[2 * gg][0], v[2 * gg][1]), pk2(v[2 * gg][2], v[2 * gg][3]), pk2(v[2 * gg + 1][0], v[2 * gg + 1][1]), pk2(v[2 * gg + 1][2], v[2 * gg + 1][3])};
            }
        }
    }
}

template <int NQT, bool NA>
DEV void attn_block(const bf16_t* Qh, int qrow0, const bf16_t* Kh, const bf16_t* Vh, int ntiles, bf16_t* outp  ,
                    int na_r, int na_rs, int nwin, const float* rpb_h, char* lds) {
    const int tid = get_tid(), lane = tid & 63, wid = tid >> 6, fr = lane & 15, fq = lane >> 4;
    char* KBUF = lds;
    char* VBUF = lds + 16384;
    float* BIAS = (float*)(lds + 32768);
    if (NA) {
        for (int i = tid; i < 15 * 32; i += 256) { const int dr = i >> 5, dc = i & 31; BIAS[i] = dc < 31 ? rpb_h[dr * 31 + dc] * LOG2E : 0.f; }
    }
    bf16x8 qf[NQT][2];
    const int qw = qrow0 + wid * 16 * NQT;
#pragma unroll
    for (int nq = 0; nq < NQT; ++nq)
#pragma unroll
        for (int ks = 0; ks < 2; ++ks) qf[nq][ks] = *(const bf16x8*)(Qh + (size_t)(qw + nq * 16 + fr) * 64 + ks * 32 + fq * 8);
    f32x4 oacc[4][NQT], lacc[NQT];
    float mrun[NQT];
    const bf16x8 ones = (bf16x8){0x3F80, 0x3F80, 0x3F80, 0x3F80, 0x3F80, 0x3F80, 0x3F80, 0x3F80};
#pragma unroll
    for (int nq = 0; nq < NQT; ++nq) { mrun[nq] = 0.f; lacc[nq] = (f32x4){0.f, 0.f, 0.f, 0.f};
#pragma unroll
        for (int dt = 0; dt < 4; ++dt) oacc[dt][nq] = (f32x4){0.f, 0.f, 0.f, 0.f}; }
    const int lrow0 = tid >> 3, lch = tid & 7;
    auto key0_of = [&](int ti) -> int { if (NA) return ti < nwin ? 256 + (na_rs + ti) * 64 : (ti - nwin) * 64; return ti * 64; };
    u32x4 kreg[2], vreg[2];
    auto gload = [&](int ti) {
        const int k0 = key0_of(ti);
#pragma unroll
        for (int i = 0; i < 2; ++i) {
            const int row = lrow0 + 32 * i;
            kreg[i] = *(const u32x4*)(Kh + (size_t)(k0 + row) * 64 + lch * 8);
            vreg[i] = *(const u32x4*)(Vh + (size_t)(k0 + row) * 64 + lch * 8);
        }
    };
    auto lstore = [&](int buf) {
#pragma unroll
        for (int i = 0; i < 2; ++i) {
            const int row = lrow0 + 32 * i;
            const int off = buf * 8192 + row * 128 + ((lch ^ (row & 7)) * 16);
            *(u32x4*)(KBUF + off) = kreg[i];
            *(u32x4*)(VBUF + off) = vreg[i];
        }
    };
    gload(0); lstore(0);
    __syncthreads();
    for (int ti = 0; ti < ntiles; ++ti) {
        const int buf = ti & 1;
        if (ti + 1 < ntiles) gload(ti + 1);
        const char* kb = KBUF + buf * 8192; const char* vb = VBUF + buf * 8192;
        f32x4 sacc[4][NQT];
        __builtin_amdgcn_s_setprio(1);
#pragma unroll
        for (int mt = 0; mt < 4; ++mt) {
            const int row = mt * 16 + fr;
            bf16x8 kf0 = *(const bf16x8*)(kb + row * 128 + (((0 + fq) ^ (row & 7)) * 16));
            bf16x8 kf1 = *(const bf16x8*)(kb + row * 128 + (((4 + fq) ^ (row & 7)) * 16));
#pragma unroll
            for (int nq = 0; nq < NQT; ++nq) {
                f32x4 s = (f32x4){-mrun[nq], -mrun[nq], -mrun[nq], -mrun[nq]};
                s = mfma16(kf0, qf[nq][0], s);
                s = mfma16(kf1, qf[nq][1], s);
                sacc[mt][nq] = s;
            }
        }
        __builtin_amdgcn_s_setprio(0);
        bf16x8 pf[2][NQT];
#pragma unroll
        for (int nq = 0; nq < NQT; ++nq) {
            float tv[4][4];
            float tmax = -1e30f;
            if (NA && ti < nwin) {
                const int qc = (wid & 1) * 32 + nq * 16 + fr;
                int cs = qc - 8; cs = cs < 0 ? 0 : (cs > 48 ? 48 : cs);
                const int qrow = na_r + (wid >> 1);
                int rsq = qrow - 4; rsq = rsq < 0 ? 0 : (rsq > 24 ? 24 : rsq);
                const int krow = na_rs + ti;
                const bool rowok = (krow >= rsq) && (krow < rsq + 8);
                int dr = krow - qrow + 7; dr = dr < 0 ? 0 : (dr > 14 ? 14 : dr);
#pragma unroll
                for (int mt = 0; mt < 4; ++mt)
#pragma unroll
                    for (int j = 0; j < 4; ++j) {
                        const int kc = mt * 16 + 4 * fq + j;
                        const bool ok = rowok && (kc >= cs) && (kc < cs + 16);
                        int dc = kc - qc + 15; dc = dc < 0 ? 0 : (dc > 30 ? 30 : dc);
                        tv[mt][j] = ok ? sacc[mt][nq][j] + BIAS[dr * 32 + dc] : -1e30f;
                        tmax = fmaxf(tmax, tv[mt][j]);
                    }
            } else {
#pragma unroll
                for (int mt = 0; mt < 4; ++mt) {
#pragma unroll
                    for (int j = 0; j < 4; ++j) tv[mt][j] = sacc[mt][nq][j];
                    tmax = fmaxf(fmaxf(tmax, tv[mt][0]), tv[mt][1]); tmax = fmaxf(fmaxf(tmax, tv[mt][2]), tv[mt][3]);
                }
            }
            if (__any(tmax > 8.0f)) {
                tmax = fmaxf(tmax, __shfl_xor(tmax, 16)); tmax = fmaxf(tmax, __shfl_xor(tmax, 32));
                const float dlt = fmaxf(tmax, 0.f);
                const float alpha = __builtin_amdgcn_exp2f(-dlt);
                mrun[nq] += dlt;
                lacc[nq] = lacc[nq] * alpha;
#pragma unroll
                for (int dt = 0; dt < 4; ++dt) oacc[dt][nq] = oacc[dt][nq] * alpha;
#pragma unroll
                for (int mt = 0; mt < 4; ++mt)
#pragma unroll
                    for (int j = 0; j < 4; ++j) tv[mt][j] -= dlt;
            }
#pragma unroll
            for (int mt = 0; mt < 4; ++mt)
#pragma unroll
                for (int j = 0; j < 4; ++j) tv[mt][j] = __builtin_amdgcn_exp2f(tv[mt][j]);
#pragma unroll
            for (int ks = 0; ks < 2; ++ks) {
                union { bf16x8 v; unsigned u[4]; } pk;
                pk.u[0] = pk2(tv[2 * ks][0], tv[2 * ks][1]); pk.u[1] = pk2(tv[2 * ks][2], tv[2 * ks][3]);
                pk.u[2] = pk2(tv[2 * ks + 1][0], tv[2 * ks + 1][1]); pk.u[3] = pk2(tv[2 * ks + 1][2], tv[2 * ks + 1][3]);
                pf[ks][nq] = pk.v;
                lacc[nq] = mfma16(ones, pk.v, lacc[nq]);
            }
        }
        {
            const int q4 = fr >> 2, p4 = fr & 3;
#pragma unroll
            for (int ks = 0; ks < 2; ++ks)
#pragma unroll
                for (int dt = 0; dt < 4; ++dt) {
                    const int keyA = 16 * (2 * ks) + 4 * fq + q4, keyB = keyA + 16;
                    const int ch = 4 * (dt >> 1) + p4;
                    const int offA = keyA * 128 + ((ch ^ (keyA & 7)) * 16) + (dt & 1) * 8;
                    const int offB = keyB * 128 + ((ch ^ (keyB & 7)) * 16) + (dt & 1) * 8;
                    const s16x4 ta = __builtin_amdgcn_ds_read_tr16_b64_v4i16((LDSP(s16x4))(vb + offA));
                    const s16x4 tb = __builtin_amdgcn_ds_read_tr16_b64_v4i16((LDSP(s16x4))(vb + offB));
                    bf16x8 vf; vf[0] = ta[0]; vf[1] = ta[1]; vf[2] = ta[2]; vf[3] = ta[3]; vf[4] = tb[0]; vf[5] = tb[1]; vf[6] = tb[2]; vf[7] = tb[3];
#pragma unroll
                    for (int nq = 0; nq < NQT; ++nq) oacc[dt][nq] = mfma16(vf, pf[ks][nq], oacc[dt][nq]);
                }
        }
        if (ti + 1 < ntiles) lstore(buf ^ 1);
        __syncthreads();
    }
#pragma unroll
    for (int nq = 0; nq < NQT; ++nq) {
        const float inv = __builtin_amdgcn_rcpf(lacc[nq][0]);
        bf16_t* o = outp + (size_t)(qw + nq * 16 + fr) * 1024;
#pragma unroll
        for (int g = 0; g < 2; ++g) {
            const f32x4 v0 = oacc[2 * g][nq] * inv, v1 = oacc[2 * g + 1][nq] * inv;
            *(u32x4*)(o + g * 32 + 8 * fq) = (u32x4){pk2(v0[0], v0[1]), pk2(v0[2], v0[3]), pk2(v1[0], v1[1]), pk2(v1[2], v1[3])};
        }
    }
    __syncthreads();
}

DEV float hy_sconv(const bf16_t* zrow, int t, int n, float w0, float w1, float w2, float bias) {
    const float zm = t > 0 ? bf2f(zrow[t - 1]) : 0.f, z0 = bf2f(zrow[t]), zp = t + 1 < n ? bf2f(zrow[t + 1]) : 0.f;
    return w0 * zm + w1 * z0 + w2 * zp + bias;
}
template <int NJ>
DEV void hyena_item(const Params& p, int l, int type, int c, int bh, char* lds) {
    constexpr int n = 256 * NJ;
    const int tid = get_tid();
    f32x4* U = (f32x4*)lds;
    float* KR = (float*)(lds + n * 16);
    const bf16_t* zt = type ? (const bf16_t*)(p.ws + OFF_ZTC) : (const bf16_t*)(p.ws + OFF_ZTL);
    const bf16_t* kf = (const bf16_t*)(p.ws + (type ? OFF_KERNC + (size_t)l * 2 * 256 * 256 * 2 : OFF_KERNL + (size_t)l * 2 * 256 * 2048 * 2)) + (size_t)c * n;
    const bf16_t* kb = kf + (size_t)256 * n;
    const float* cw = p.hy_conv_w + l * 3 * 768; const float* cb = p.hy_conv_b + l * 768;
    const float w10 = cw[256 + c], w11 = cw[768 + 256 + c], w12 = cw[1536 + 256 + c], b1 = cb[256 + c];
    const float wv0 = cw[512 + c], wv1 = cw[768 + 512 + c], wv2 = cw[1536 + 512 + c], bv = cb[512 + c];
    const float w00 = cw[c], w01 = cw[768 + c], w02 = cw[1536 + c], b0 = cb[c];
    for (int i = tid; i < 2 * n - 1; i += 256) { const int d = i - (n - 1); KR[i] = bf2f(d >= 0 ? kf[d] : kb[-d]); }
    for (int s = tid; s < n; s += 256) {
        f32x4 u;
#pragma unroll
        for (int bb = 0; bb < 4; ++bb) {
            const bf16_t* zb = zt + (size_t)(bh * 4 + bb) * 768 * n;
            const float x1 = hy_sconv(zb + (size_t)(256 + c) * n, s, n, w10, w11, w12, b1);
            const float vv = hy_sconv(zb + (size_t)(512 + c) * n, s, n, wv0, wv1, wv2, bv);
            u[bb] = vv * x1;
        }
        U[s] = u;
    }
    __syncthreads();
    f32x4 acc[NJ];
#pragma unroll
    for (int j = 0; j < NJ; ++j) acc[j] = (f32x4){0.f, 0.f, 0.f, 0.f};
    const float* kp = KR + tid + (n - 1);
    for (int s = 0; s < n; ++s) {
        const f32x4 u = U[s];
#pragma unroll
        for (int j = 0; j < NJ; ++j) acc[j] += u * kp[256 * j - s];
    }
    bf16_t* ox = (bf16_t*)(p.ws + OFF_OX);
#pragma unroll
    for (int j = 0; j < NJ; ++j) {
        const int t = tid + 256 * j;
#pragma unroll
        for (int bb = 0; bb < 4; ++bb) {
            const int b = bh * 4 + bb;
            const bf16_t* zb = zt + (size_t)b * 768 * n;
            const float x0 = hy_sconv(zb + (size_t)c * n, t, n, w00, w01, w02, b0);
            const float y = acc[j][bb] * x0;
            const int row = type ? NLAT + b * 256 + t : b * 2048 + t;
            ox[(size_t)row * 1024 + 768 + c] = (bf16_t)f2bf(y);
        }
    }
    __syncthreads();
}


typedef float f32x16 __attribute__((ext_vector_type(16)));
constexpr int HY_UROW = 2256;
constexpr int HY_KC_OFF = 8 * HY_UROW * 2;
constexpr int HY_KC_STRIDE = 8192 + 64;
DEV float hy_sc8(const bf16_t* zrow, int s0, int n, float w0, float w1, float w2, float bias, float (&o)[8]) {
    const u32x4 v = *(const u32x4*)(zrow + s0);
    const float zm = s0 > 0 ? bf2f(zrow[s0 - 1]) : 0.f, zp = s0 + 8 < n ? bf2f(zrow[s0 + 8]) : 0.f;
    float z[10]; z[0] = zm; z[9] = zp;
#pragma unroll
    for (int i = 0; i < 4; ++i) { z[1 + 2 * i] = __uint_as_float(v[i] << 16); z[2 + 2 * i] = __uint_as_float(v[i] & 0xffff0000u); }
#pragma unroll
    for (int i = 0; i < 8; ++i) o[i] = w0 * z[i] + w1 * z[i + 1] + w2 * z[i + 2] + bias;
    return 0.f;
}
DEV void hyena_mfma_item(const Params& p, int l, int c, char* lds) {
    const int tid = get_tid(), lane = tid & 63, wid = tid >> 6;
    constexpr int n = 2048;
    const bf16_t* zt = (const bf16_t*)(p.ws + OFF_ZTL);
    const bf16_t* kf = (const bf16_t*)(p.ws + OFF_KERNL + (size_t)l * 2 * 256 * 2048 * 2) + (size_t)c * n;
    const bf16_t* kb = kf + (size_t)256 * n;
    const float* cw = p.hy_conv_w + l * 3 * 768; const float* cb = p.hy_conv_b + l * 768;
    const float w10 = cw[256 + c], w11 = cw[768 + 256 + c], w12 = cw[1536 + 256 + c], b1 = cb[256 + c];
    const float wv0 = cw[512 + c], wv1 = cw[768 + 512 + c], wv2 = cw[1536 + 512 + c], bv = cb[512 + c];
    const float w00 = cw[c], w01 = cw[768 + c], w02 = cw[1536 + c], b0 = cb[c];
    for (int i = tid; i < 8 * 26; i += 256) {
        const int b = i / 26, k = i % 26;
        const int sp = k < 12 ? k * 8 : 96 + 2048 + (k - 12) * 8;
        *(u32x4*)(lds + (b * HY_UROW + sp) * 2) = (u32x4){0u, 0u, 0u, 0u};
    }
#pragma unroll 4
    for (int ch = tid; ch < 8 * 256; ch += 256) {
        const int b = ch >> 8, s0 = (ch & 255) * 8;
        const bf16_t* zb = zt + (size_t)b * 768 * n;
        float x1[8], vv[8];
        hy_sc8(zb + (size_t)(256 + c) * n, s0, n, w10, w11, w12, b1, x1);
        hy_sc8(zb + (size_t)(512 + c) * n, s0, n, wv0, wv1, wv2, bv, vv);
        *(u32x4*)(lds + (b * HY_UROW + 96 + s0) * 2) = (u32x4){pk2(vv[0] * x1[0], vv[1] * x1[1]), pk2(vv[2] * x1[2], vv[3] * x1[3]), pk2(vv[4] * x1[4], vv[5] * x1[5]), pk2(vv[6] * x1[6], vv[7] * x1[7])};
    }
    {
        char* R0 = lds + HY_KC_OFF;
#pragma unroll
        for (int j = 0; j < 2; ++j) {
            const int chn = tid + 256 * j;
            const bool fwd = chn < 256; const int d0 = (chn & 255) * 8;
            const u32x4 v = *(const u32x4*)((fwd ? kf : kb) + d0);
#pragma unroll
            for (int e = 0; e < 8; ++e) {
                const int d = d0 + e;
                const bf16_t val = (bf16_t)((e & 1) ? (v[e >> 1] >> 16) : (v[e >> 1] & 0xffffu));
                const int y = fwd ? 2047 - d : 2047 + d;
                if (fwd || d > 0) *(bf16_t*)(R0 + y * 2) = val;
            }
        }
        if (tid == 0) *(bf16_t*)(R0 + 4095 * 2) = 0;
    }
    __syncthreads();
    {
        const char* R0 = lds + HY_KC_OFF;
        for (int i = tid; i < 3 * 1024; i += 256) {
            const int q = 1 + i / 1024, y = (i % 1024) * 4;
            unsigned short e[4];
#pragma unroll
            for (int k = 0; k < 4; ++k) { const int yy = y + q + k; e[k] = yy <= 4094 ? *(const bf16_t*)(R0 + yy * 2) : (bf16_t)0; }
            *(u32x2*)(lds + HY_KC_OFF + q * HY_KC_STRIDE + y * 2) = (u32x2){(unsigned)e[0] | ((unsigned)e[1] << 16), (unsigned)e[2] | ((unsigned)e[3] << 16)};
        }
    }
    __syncthreads();
    const int i32 = lane & 31, h = lane >> 5, qn = i32 >> 3, bn = i32 & 7;
    const int T0 = 512 * wid;
    f32x16 acc[4];
#pragma unroll
    for (int g = 0; g < 4; ++g)
#pragma unroll
        for (int r = 0; r < 16; ++r) acc[g][r] = 0.f;
    const int dlo = T0 - 2032, dhi = T0 + 384 + 96;
    {
        const int a0 = 2047 - dlo - i32 + 8 * h, q4 = a0 & 3;
        const char* ap = lds + HY_KC_OFF + q4 * HY_KC_STRIDE + (a0 - q4) * 2;
        const char* bp = lds + (bn * HY_UROW + 96 + (T0 - dlo) + 32 * qn + 8 * h) * 2;
        for (int dl = dlo; dl <= dhi; dl += 16) {
            union { bf16x8 v; u32x2 u[2]; } af;
            af.u[0] = *(const u32x2*)ap; af.u[1] = *(const u32x2*)(ap + 8);
#pragma unroll
            for (int g = 0; g < 4; ++g) {
                const int S = T0 + 128 * g - dl;
                if (S >= -96 && S <= 2032) {
                    const bf16x8 bfv = *(const bf16x8*)(bp + 256 * g);
                    acc[g] = __builtin_amdgcn_mfma_f32_32x32x16_bf16(af.v, bfv, acc[g], 0, 0, 0);
                }
            }
            ap -= 32; bp -= 32;
        }
    }
    __syncthreads();
#pragma unroll 4
    for (int ch = tid; ch < 8 * 256; ch += 256) {
        const int b = ch >> 8, s0 = (ch & 255) * 8;
        float x0[8];
        hy_sc8(zt + (size_t)b * 768 * n + (size_t)c * n, s0, n, w00, w01, w02, b0, x0);
        *(u32x4*)(lds + HY_KC_OFF + (b * 2048 + s0) * 2) = (u32x4){pk2(x0[0], x0[1]), pk2(x0[2], x0[3]), pk2(x0[4], x0[5]), pk2(x0[6], x0[7])};
    }
    __syncthreads();
    bf16_t* oxt = (bf16_t*)(p.ws + OFF_OXT) + (size_t)c * 2048;
#pragma unroll
    for (int g = 0; g < 4; ++g)
#pragma unroll
        for (int r4 = 0; r4 < 4; ++r4) {
            const int t = T0 + 128 * g + 32 * qn + 8 * r4 + 4 * h;
            const u32x2 xg = *(const u32x2*)(lds + HY_KC_OFF + (bn * 2048 + t) * 2);
            const float g0 = __uint_as_float(xg[0] << 16), g1 = __uint_as_float(xg[0] & 0xffff0000u), g2 = __uint_as_float(xg[1] << 16), g3 = __uint_as_float(xg[1] & 0xffff0000u);
            *(u32x2*)(oxt + (size_t)bn * 256 * 2048 + t) = (u32x2){pk2(acc[g][4 * r4 + 0] * g0, acc[g][4 * r4 + 1] * g1), pk2(acc[g][4 * r4 + 2] * g2, acc[g][4 * r4 + 3] * g3)};
        }
    __syncthreads();
}

DEV void phase_mix(const Params& p, int l, char* lds) {
    unsigned char* ws = p.ws;
    const bf16_t* QA = (const bf16_t*)(ws + OFF_QA); const bf16_t* QB = (const bf16_t*)(ws + OFF_QB);
    const bf16_t* KA = (const bf16_t*)(ws + OFF_KA); const bf16_t* VA = (const bf16_t*)(ws + OFF_VA);
    const bf16_t* KBp = (const bf16_t*)(ws + OFF_KB); const bf16_t* VBp = (const bf16_t*)(ws + OFF_VB);
    bf16_t* OX = (bf16_t*)(ws + OFF_OX);
    const int N0 = 256, N1 = N0 + 1024, N2 = N1 + 512;
    const int N3 = N2 + (l == 0 ? 512 : 0), N4 = N3 + (l == 0 ? 128 : 0), N5 = N4 + (l == 0 ? 64 : 0);
    int* qhead = (int*)(p.ws + OFF_QUEUE) + l * 64;
    int* qslot = (int*)(lds + SMEM_BYTES - 256);
    for (;;) {
        __syncthreads();
        if (get_tid() == 0) *qslot = atomicAdd(qhead, 1);
        __syncthreads();
        const int it = *qslot;
        if (it >= N5) break;
        if (it < N0) { hyena_mfma_item(p, l, it, lds); }
        else if (it < N1) {
            const int j = it - N0, b = j >> 7, h = (j >> 4) & 7, qb = j & 15;
            attn_block<2, false>(QA + (size_t)h * NT * 64, b * 2048 + qb * 128, KA + (size_t)(b * 2 + (h >> 2)) * KEYS * 64, VA + (size_t)(b * 2 + (h >> 2)) * KEYS * 64,
                                 36, OX + h * 64, 0, 0, 0, nullptr, lds);
        } else if (it < N2) {
            const int j = it - N1, b = j >> 6, h = (j >> 4) & 3, r = (j & 15) * 2;
            int rs0 = r - 4; rs0 = rs0 < 0 ? 0 : (rs0 > 24 ? 24 : rs0);
            int rs1 = r - 3; rs1 = rs1 < 0 ? 0 : (rs1 > 24 ? 24 : rs1);
            const int nwin = rs1 + 8 - rs0;
            attn_block<2, true>(QB + (size_t)h * NT * 64, b * 2048 + r * 64, KBp + (size_t)(b * 4 + h) * KEYS * 64, VBp + (size_t)(b * 4 + h) * KEYS * 64,
                                nwin + 4, OX + 512 + h * 64, r, rs0, nwin, p.nat_rpb + (size_t)(l * 4 + h) * 15 * 31, lds);
        } else if (it < N3) { const int j = it - N2; hyena_item<1>(p, l, 1, j >> 1, j & 1, lds); }
        else if (it < N4) {
            const int j = it - N3, b = j >> 4, h = (j >> 1) & 7, qb = j & 1;
            attn_block<2, false>(QA + (size_t)h * NT * 64, NLAT + b * 256 + qb * 128, KA + (size_t)(b * 2 + (h >> 2)) * KEYS * 64, VA + (size_t)(b * 2 + (h >> 2)) * KEYS * 64,
                                 4, OX + h * 64, 0, 0, 0, nullptr, lds);
        } else {
            const int j = it - N4, b = j >> 3, h = (j >> 1) & 3, qb = j & 1;
            attn_block<2, false>(QB + (size_t)h * NT * 64, NLAT + b * 256 + qb * 128, KBp + (size_t)(b * 4 + h) * KEYS * 64, VBp + (size_t)(b * 4 + h) * KEYS * 64,
                                 4, OX + 512 + h * 64, 0, 0, 0, nullptr, lds);
        }
    }
}

DEV void phase_outproj(const Params& p, int l, char* lds) {
    const int tid = get_tid(), lane = tid & 63, wid = tid >> 6, fr = lane & 15, fq = lane >> 4, wr = wid >> 1, wc = wid & 1;
    const bf16_t* OX = (const bf16_t*)(p.ws + OFF_OX);
    const bf16_t* W = (const bf16_t*)(p.ws + OFF_WOUT) + (size_t)l * 1024 * 1024;
    const float* mod = (const float*)(p.ws + OFF_MOD) + (size_t)l * 9 * 6144;
    bf16_t* X = (bf16_t*)(p.ws + OFF_X);
    const int nitems = (l == 0 ? 144 : 128) * 8;
    for (int it = blockIdx.x; it < nitems; it += gridDim.x) {
        const int mt = it >> 3, nt = it & 7, m0 = mt * 128, n0 = nt * 128;
        const unsigned a0 = (unsigned)m0 * 1024u + st64_off(tid), b0 = (unsigned)n0 * 1024u + st64_off(tid);
        f32x4 acc[4][4]; zero_acc<4, 4>(acc);
        const unsigned ao[4] = {a0, a0 + 32u * 1024u, a0 + 64u * 1024u, a0 + 96u * 1024u};
        const unsigned bo[4] = {b0, b0 + 32u * 1024u, b0 + 64u * 1024u, b0 + 96u * 1024u};
        gemm_core64<true>(acc, OX, ao, W, bo, 1024, lds, (const bf16_t*)(p.ws + OFF_OXT) + (size_t)((m0 >> 11) & 7) * 256 * 2048 + (m0 & 2047), m0 < NLAT ? 12 : 16);
        const float* g1 = mod + (size_t)mod_group(m0) * 6144 + 2048;
#pragma unroll
        for (int m = 0; m < 4; ++m) {
            const int row = m0 + wr * 64 + m * 16 + fr;
            const float* xin = row < NLAT ? p.x + (size_t)row * 1024 : p.ctx + (size_t)(row - NLAT) * 1024;
#pragma unroll
            for (int gg = 0; gg < 2; ++gg) {
                const int col = n0 + wc * 64 + gg * 32 + 8 * fq;
                f32x4 x0, x1;
                if (l == 0) { x0 = *(const f32x4*)(xin + col); x1 = *(const f32x4*)(xin + col + 4); }
                else { const u32x4 w = *(const u32x4*)(X + (size_t)row * 1024 + col);
                       x0 = (f32x4){__uint_as_float(w[0] << 16), __uint_as_float(w[0] & 0xffff0000u), __uint_as_float(w[1] << 16), __uint_as_float(w[1] & 0xffff0000u)};
                       x1 = (f32x4){__uint_as_float(w[2] << 16), __uint_as_float(w[2] & 0xffff0000u), __uint_as_float(w[3] << 16), __uint_as_float(w[3] & 0xffff0000u)}; }
                const f32x4 o0 = x0 * DN_ALPHA + *(const f32x4*)(g1 + col) * acc[m][2 * gg], o1 = x1 * DN_ALPHA + *(const f32x4*)(g1 + col + 4) * acc[m][2 * gg + 1];
                *(u32x4*)(X + (size_t)row * 1024 + col) = (u32x4){pk2(o0[0], o0[1]), pk2(o0[2], o0[3]), pk2(o1[0], o1[1]), pk2(o1[2], o1[3])};
            }
        }
    }
}

DEV void phase_ln1route(const Params& p, int l, char* lds) {
    const int tid = get_tid(), lane = tid & 63, wid = tid >> 6, fr = lane & 15, fq = lane >> 4;
    bf16_t* X = (bf16_t*)(p.ws + OFF_X);
    bf16_t* H = (bf16_t*)(p.ws + OFF_H);
    const bf16_t* RW = (const bf16_t*)(p.ws + OFF_RW) + (size_t)l * 64 * 1024;
    const float* mod = (const float*)(p.ws + OFF_MOD) + (size_t)l * 9 * 6144;
    int* cnt = (int*)(p.ws + OFF_CNT) + l * 64 * 64;
    int* tke = (int*)(p.ws + OFF_TKE); int* tks = (int*)(p.ws + OFF_TKS); float* tkw = (float*)(p.ws + OFF_TKW);
    int* list = (int*)(p.ws + OFF_LIST);
    char* HT = lds;
    float* LG = (float*)(lds + 16 * 2064);
    const float rbias = p.router_b[l * 64 + lane];
    const int rpw = (l == 0) ? 3 : 4, rpi = 4 * rpw;
    const int nitems = (l == 0 ? NT : NLAT) / rpi;
    u32x2 raw[4][4];
    f32x4 msh[4], msc[4];
    float* LNG = (float*)(lds + 50176);
    for (int i = tid; i < 512; i += 256) {
        const int c = (i & 255) * 4;
        *(f32x4*)(LNG + (i >> 8) * 1024 + c) = *(const f32x4*)((i >> 8 ? p.ln1_b : p.ln1_g) + l * 1024 + c);
    }
    if ((int)blockIdx.x < nitems) {
#pragma unroll
        for (int i = 0; i < 4; ++i) if (i < rpw)
#pragma unroll
            for (int j = 0; j < 4; ++j) raw[i][j] = *(const u32x2*)(X + (size_t)((int)blockIdx.x * rpi + wid * rpw + i) * 1024 + 4 * lane + 256 * j);
        const float* mg = mod + (size_t)mod_group((int)blockIdx.x * rpi + wid * rpw) * 6144;
#pragma unroll
        for (int j = 0; j < 4; ++j) { const int c = 4 * lane + 256 * j; msh[j] = *(const f32x4*)(mg + 3072 + c); msc[j] = *(const f32x4*)(mg + 4096 + c); }
    }
    __syncthreads();
    for (int it = blockIdx.x; it < nitems; it += gridDim.x) {
        const int m0 = it * rpi;
        const int g0 = mod_group(m0 + wid * rpw);
        f32x4 vv[4][4];
#pragma unroll
        for (int i = 0; i < 4; ++i) if (i < rpw)
#pragma unroll
            for (int j = 0; j < 4; ++j) { const u32x2 w = raw[i][j]; vv[i][j] = (f32x4){__uint_as_float(w[0] << 16), __uint_as_float(w[0] & 0xffff0000u), __uint_as_float(w[1] << 16), __uint_as_float(w[1] & 0xffff0000u)}; }
#pragma unroll
        for (int i = 0; i < 4; ++i) if (i < rpw) {
            const int rl = wid * rpw + i, row = m0 + rl;
            if (mod_group(row) != g0) {
                const float* mg = mod + (size_t)mod_group(row) * 6144;
#pragma unroll
                for (int j = 0; j < 4; ++j) { const int c = 4 * lane + 256 * j; msh[j] = *(const f32x4*)(mg + 3072 + c); msc[j] = *(const f32x4*)(mg + 4096 + c); }
            }
            row_norm(vv[i]);
#pragma unroll
            for (int j = 0; j < 4; ++j) {
                const int c = 4 * lane + 256 * j;
                vv[i][j] = vv[i][j] * *(const f32x4*)(LNG + c) + *(const f32x4*)(LNG + 1024 + c);
                st_bf4(X + (size_t)row * 1024 + c, vv[i][j]);
            }
            row_norm(vv[i]);
#pragma unroll
            for (int j = 0; j < 4; ++j) {
                const int c = 4 * lane + 256 * j;
                const f32x4 o = vv[i][j] * (msc[j] + 1.0f) + msh[j];
                const u32x2 w = (u32x2){pk2(o[0], o[1]), pk2(o[2], o[3])};
                *(u32x2*)(H + (size_t)row * 1024 + c) = w;
                *(u32x2*)(HT + rl * 2064 + c * 2) = w;
            }
        }
        f32x4 acc = (f32x4){0.f, 0.f, 0.f, 0.f};
        const bf16_t* bp = RW + (size_t)(wid * 16 + fr) * 1024 + fq * 8;
        bf16x8 bq[16];
#pragma unroll
        for (int ks = 0; ks < 16; ++ks) bq[ks] = *(const bf16x8*)(bp + ks * 32);
        __syncthreads();
#pragma unroll
        for (int ks = 0; ks < 16; ++ks) {
            const bf16x8 af = *(const bf16x8*)(HT + fr * 2064 + (ks * 32 + fq * 8) * 2);
            acc = mfma16(bq[ks], af, acc);
            bq[ks] = *(const bf16x8*)(bp + (ks + 16) * 32);
        }
#pragma unroll
        for (int ks = 0; ks < 16; ++ks) {
            const bf16x8 af = *(const bf16x8*)(HT + fr * 2064 + ((ks + 16) * 32 + fq * 8) * 2);
            acc = mfma16(bq[ks], af, acc);
        }
        *(f32x4*)(LG + fr * 64 + wid * 16 + 4 * fq) = acc;
        if (it + (int)gridDim.x < nitems) {
#pragma unroll
            for (int i = 0; i < 4; ++i) if (i < rpw)
#pragma unroll
                for (int j = 0; j < 4; ++j) raw[i][j] = *(const u32x2*)(X + (size_t)(m0 + (int)gridDim.x * rpi + wid * rpw + i) * 1024 + 4 * lane + 256 * j);
            const float* mg = mod + (size_t)mod_group(m0 + (int)gridDim.x * rpi + wid * rpw) * 6144;
#pragma unroll
            for (int j = 0; j < 4; ++j) { const int c = 4 * lane + 256 * j; msh[j] = *(const f32x4*)(mg + 3072 + c); msc[j] = *(const f32x4*)(mg + 4096 + c); }
        }
        __syncthreads();
        int* RS = (int*)(lds + 16 * 2064 + 4096 + 2048);
        float* RWt = (float*)(lds + 16 * 2064 + 4096 + 2048 + 4096);
        int lc = 0;
        unsigned* KW = (unsigned*)(lds + 16 * 2064 + 4096 + 2048 + 8192) + wid * 160;
#pragma unroll 1
        for (int i = 0; i < rpw; ++i) {
            const int rl = wid * rpw + i;
            const float sc = __builtin_amdgcn_rcpf(1.0f + __expf(-LG[rl * 64 + lane]));
            const float sel = sc + rbias;
            const int grp = lane >> 3;
            const unsigned key = (__float_as_uint(sel + 2.0f) & 0xFFFFFFC0u) | (unsigned)(63 - lane);
            KW[lane] = key;
            __builtin_amdgcn_wave_barrier();
            int rankg = 0;
            {
                const u32x4 k0 = *(const u32x4*)(KW + grp * 8), k1 = *(const u32x4*)(KW + grp * 8 + 4);
#pragma unroll
                for (int j = 0; j < 4; ++j) { rankg += (k0[j] > key) ? 1 : 0; rankg += (k1[j] > key) ? 1 : 0; }
            }
            float gs = rankg < 2 ? sel : 0.f;
            gs += __shfl_xor(gs, 1); gs += __shfl_xor(gs, 2); gs += __shfl_xor(gs, 4);
            const unsigned gkey = (__float_as_uint(gs + 4.0f) & 0xFFFFFFF8u) | (unsigned)(7 - grp);
            if ((lane & 7) == 0) KW[128 + grp] = gkey;
            __builtin_amdgcn_wave_barrier();
            int rg = 0;
            {
                const u32x4 g0 = *(const u32x4*)(KW + 128), g1 = *(const u32x4*)(KW + 132);
#pragma unroll
                for (int j = 0; j < 4; ++j) { rg += (g0[j] > gkey) ? 1 : 0; rg += (g1[j] > gkey) ? 1 : 0; }
            }
            const bool selg = rg < 4;
            const unsigned vkey = selg ? key : 0u;
            KW[64 + lane] = vkey;
            __builtin_amdgcn_wave_barrier();
            int rank = 0;
#pragma unroll
            for (int q = 0; q < 16; ++q) {
                const u32x4 kk = *(const u32x4*)(KW + 64 + q * 4);
#pragma unroll
                for (int j = 0; j < 4; ++j) rank += (kk[j] > vkey) ? 1 : 0;
            }
            const bool ch = selg && rank < 8;
            const float wsum = wave_sum(ch ? sc : 0.f);
            RS[rl * 64 + lane] = ch ? rank : -1;
            RWt[rl * 64 + lane] = sc * (2.5f * __builtin_amdgcn_rcpf(wsum));
            lc += ch ? 1 : 0;
            __builtin_amdgcn_wave_barrier();
        }
        int* WC = (int*)(lds + 16 * 2064 + 4096);
        WC[wid * 64 + lane] = lc;
        __syncthreads();
        if (wid == 0) {
            const int tot = WC[lane] + WC[64 + lane] + WC[128 + lane] + WC[192 + lane];
            int base = 0;
            if (tot > 0) base = atomicAdd(&cnt[lane * 64], tot);
            WC[256 + lane] = base;
        }
        __syncthreads();
        {
            int slot = WC[256 + lane];
#pragma unroll
            for (int w2 = 0; w2 < 4; ++w2) slot += (w2 < wid) ? WC[w2 * 64 + lane] : 0;
#pragma unroll 1
            for (int i = 0; i < rpw; ++i) {
                const int rl = wid * rpw + i, rk = RS[rl * 64 + lane];
                if (rk >= 0) {
                    const int row = m0 + rl;
                    list[(size_t)lane * NT + slot] = row * 8 + rk;
                    tke[row * 8 + rk] = lane; tks[row * 8 + rk] = slot; tkw[row * 8 + rk] = RWt[rl * 64 + lane];
                    ++slot;
                }
            }
        }
        __syncthreads();
    }
}

constexpr int YS_EXT_ROWS = NLAT * 1024 * 4 / 1024;
constexpr int PLAN_OFF = 68 * 1024;
DEV void moe_plan(const int* cnt, int cap, int l, char* lds) {
    int* PL = (int*)(lds + PLAN_OFF);
    const int tid = get_tid();
    __syncthreads();
    if (tid < 64) {
        const int lane = tid;
        const int c = cnt[lane * 64], tiles = (c + 127) >> 7;
        int pr = c, pt = tiles;
#pragma unroll
        for (int o = 1; o < 64; o <<= 1) { const int a = __shfl_up(pr, o), b = __shfl_up(pt, o); if (lane >= o) { pr += a; pt += b; } }
        const int G = (int)gridDim.x, nshu = 2 * ((l == 0 ? NT : NLAT) / 128);
        const int units = nshu + __builtin_amdgcn_readlane(pt, 63);
        const int cap8 = cap * 2;
        const bool one_round = __builtin_amdgcn_readlane(pr, 63) + nshu * 128 <= cap8;
        const int target0 = one_round ? 0 : ((units + G - 1) / G - 1) * G;
        PL[144 + lane] = c;
        int start = 0, base_r = 0, base_t = 0, round = 0;
        for (;;) {
            const int lim = (round == 0) ? ((target0 > 0) ? cap8 + YS_EXT_ROWS : cap8) - nshu * 128 : cap8;
            const bool bad = (lane >= start) && ((pr - base_r > lim) || (round == 0 && target0 > 0 && lane > 0 && nshu + pt > target0));
            const unsigned long long m = __ballot(bad);
            int end = m ? (int)__builtin_ctzll(m) : 64;
            if (end <= start) end = start + 1;
            if (lane >= start && lane < end) { PL[16 + lane] = pt - tiles - base_t; PL[80 + lane] = pr - c - base_r; }
            if (lane == 0) { PL[1 + round] = start; PL[10 + round] = __builtin_amdgcn_readlane(pt, end - 1) - base_t; PL[208 + round] = __builtin_amdgcn_readlane(pr, end - 1) - base_r; }
            if (end >= 64 || round >= 7) { if (lane == 0) { PL[0] = round + 1; PL[2 + round] = 64; } break; }
            base_r = __builtin_amdgcn_readlane(pr, end - 1); base_t = __builtin_amdgcn_readlane(pt, end - 1);
            start = end; ++round;
        }
    }
    __syncthreads();
}
constexpr float YS_SCALE = 32.0f, YS_INV = 1.0f / 32.0f;
DEV unsigned char* ys_row(const Params& p, int idx) {
    const int cap8 = p.cap * 2;
    return idx < cap8 ? p.ws + OFF_YS + (size_t)idx * 1024 : (unsigned char*)p.out + (size_t)(idx - cap8) * 1024;
}
DEV unsigned pk4_fp8(const f32x4& v) {
    int w = 0;
    w = __builtin_amdgcn_cvt_pk_fp8_f32(v[0] * YS_SCALE, v[1] * YS_SCALE, w, false);
    w = __builtin_amdgcn_cvt_pk_fp8_f32(v[2] * YS_SCALE, v[3] * YS_SCALE, w, true);
    return (unsigned)w;
}
DEV f32x4 up4_fp8(unsigned w) {
    const f32x2 lo = __builtin_amdgcn_cvt_pk_f32_fp8((int)w, false), hi = __builtin_amdgcn_cvt_pk_f32_fp8((int)w, true);
    return (f32x4){lo[0], lo[1], hi[0], hi[1]};
}

template <bool SHARED>
DEV void moe_tile(const Params& p, const bf16_t* W13, const bf16_t* W2, const int* list, int s0, int nvalid, int ysbase, int m0, int half, const float* g2, char* lds) {
    const int tid = get_tid(), lane = tid & 63, wid = tid >> 6, fr = lane & 15, fq = lane >> 4, wr = wid >> 1, wc = wid & 1;
    const bf16_t* H = (const bf16_t*)(p.ws + OFF_H);
    const float* tkw = (const float*)(p.ws + OFF_TKW);
    char* ACT = lds;
    const unsigned ch8 = (unsigned)(((tid & 7) ^ ((tid >> 3) & 7)) * 8);
    unsigned ao[4];
    float gw[4];
    if (SHARED) {
#pragma unroll
        for (int i = 0; i < 4; ++i) ao[i] = (unsigned)(m0 + i * 32 + (tid >> 3)) * 1024u + ch8;
#pragma unroll
        for (int m = 0; m < 4; ++m) gw[m] = 1.0f;
    } else {
#pragma unroll
        for (int i = 0; i < 4; ++i) { const int rr = min(i * 32 + (tid >> 3), nvalid - 1); ao[i] = (unsigned)(list[s0 + rr] >> 3) * 1024u + ch8; }
#pragma unroll
        for (int m = 0; m < 4; ++m) { const int rl = min(wr * 64 + m * 16 + fr, nvalid - 1); gw[m] = tkw[list[s0 + rl]]; }
    }
    u32x2 areg[2][4][2];
#pragma unroll
    for (int np = 0; np < 2; ++np) {
        const unsigned b0 = (unsigned)(np * 128) * 1024u + st64_off(tid);
        const unsigned bo[4] = {b0, b0 + 32u * 1024u, b0 + 64u * 1024u, b0 + 96u * 1024u};
        const unsigned aoc[4] = {ao[0], ao[1], ao[2], ao[3]};
        f32x4 acc[4][4]; zero_acc<4, 4>(acc);
        gemm_core64<true>(acc, H, aoc, W13, bo, 1024, lds);
#pragma unroll
        for (int m = 0; m < 4; ++m)
#pragma unroll
            for (int pi = 0; pi < 2; ++pi) {
                float o[4];
#pragma unroll
                for (int j = 0; j < 4; ++j) { const float a = acc[m][2 * pi][j], b = acc[m][2 * pi + 1][j]; o[j] = a * __builtin_amdgcn_rcpf(1.0f + __expf(-a)) * b * gw[m]; }
                areg[np][m][pi] = (u32x2){pk2(o[0], o[1]), pk2(o[2], o[3])};
            }
    }
    __syncthreads();
#pragma unroll
    for (int np = 0; np < 2; ++np)
#pragma unroll
        for (int m = 0; m < 4; ++m)
#pragma unroll
            for (int pi = 0; pi < 2; ++pi) *(u32x2*)(ACT + (wr * 64 + m * 16 + fr) * 272 + (np * 64 + wc * 32 + pi * 16 + 4 * fq) * 2) = areg[np][m][pi];
    __syncthreads();
    if (SHARED) {
        gemm2_stream64<128, 272>(W2, ACT, lds + 36864, [&](int nt, const f32x4 (&acc)[4][4]) {
#pragma unroll
            for (int m = 0; m < 4; ++m) {
                unsigned char* o = ys_row(p, ysbase + m0 + wr * 64 + m * 16 + fr) + nt * 128 + wc * 64 + 8 * fq;
#pragma unroll
                for (int g = 0; g < 2; ++g) *(u32x2*)(o + g * 32) = (u32x2){pk4_fp8(acc[m][2 * g]), pk4_fp8(acc[m][2 * g + 1])};
            }
        });
    } else {
        gemm2_stream64<128, 272>(W2, ACT, lds + 36864, [&](int nt, const f32x4 (&acc)[4][4]) {
#pragma unroll
            for (int m = 0; m < 4; ++m) {
                const int rl = wr * 64 + m * 16 + fr;
                if (rl < nvalid) {
                    unsigned char* o = ys_row(p, ysbase + s0 + rl) + nt * 128 + wc * 64 + 8 * fq;
#pragma unroll
                    for (int g = 0; g < 2; ++g) *(u32x2*)(o + g * 32) = (u32x2){pk4_fp8(acc[m][2 * g]), pk4_fp8(acc[m][2 * g + 1])};
                }
            }
        });
    }
    __syncthreads();
}
DEV void phase_moe(const Params& p, int l, int r, char* lds) {
    const int* cnt = (const int*)(p.ws + OFF_CNT) + l * 64 * 64;
    moe_plan(cnt, p.cap, l, lds);
    const int* PL = (const int*)(lds + PLAN_OFF);
    if (r >= PL[0]) return;
    const int e_lo = PL[1 + r], e_hi = PL[2 + r];
    const int nrt = PL[10 + r];
    const int nrows = (l == 0) ? NT : NLAT;
    const int nshu = (r == 0) ? 2 * (nrows / 128) : 0;
    const int G = (int)gridDim.x, b = vblock();
    const int q = (nshu + nrt + G - 1) / G;
    const int u0 = b * q, u1 = min(u0 + q, nshu + nrt);
    int e = e_lo;
    for (int u = u0; u < u1; ++u) {
        if (u < nshu) {
            const int m0 = (u >> 1) * 128, hh = u & 1;
            moe_tile<true>(p, (const bf16_t*)(p.ws + OFF_SW13) + (size_t)(l * 2 + hh) * 256 * 1024, (const bf16_t*)(p.ws + OFF_SW2) + (size_t)(l * 2 + hh) * 1024 * 128,
                           nullptr, 0, 128, PL[208] + hh * nrows, m0, hh, nullptr, lds);
        } else {
            const int it = u - nshu;
            while (e + 1 < e_hi && PL[16 + e + 1] <= it) ++e;
            const int s0 = (it - PL[16 + e]) * 128;
            moe_tile<false>(p, (const bf16_t*)(p.ws + OFF_W13) + (size_t)e * 256 * 1024, (const bf16_t*)(p.ws + OFF_W2) + (size_t)e * 1024 * 128,
                            (const int*)(p.ws + OFF_LIST) + (size_t)e * NT, s0, min(128, PL[144 + e] - s0), PL[80 + e], 0, 0, nullptr, lds);
        }
    }
}

DEV void phase_comb(const Params& p, int l, int r, char* lds) {
    const int tid_ = get_tid(), lane = tid_ & 63, wid = tid_ >> 6;
    const int* cnt = (const int*)(p.ws + OFF_CNT) + l * 64 * 64;
    moe_plan(cnt, p.cap, l, lds);
    const int* PL = (const int*)(lds + PLAN_OFF);
    if (r >= PL[0]) return;
    const int e_lo = PL[1 + r], e_hi = PL[2 + r];
    const bool final = (r == PL[0] - 1);
    bf16_t* X = (bf16_t*)(p.ws + OFF_X);
    bf16_t* H = (bf16_t*)(p.ws + OFF_H);
    const int* tke = (const int*)(p.ws + OFF_TKE); const int* tks = (const int*)(p.ws + OFF_TKS);
    const float* mod = (const float*)(p.ws + OFF_MOD);
    const int nrows = (l == 0) ? NT : NLAT;
    const int rstep = (int)gridDim.x * 4;
    auto issue = [&](int rw, int e, int sl, u32x4 (&yy)[10], u32x4& xa_, u32x4& xb_) {
        int idx_l = -1;
        if (lane < 8 && e >= e_lo && e < e_hi) idx_l = PL[80 + e] + sl;
        xa_ = *(const u32x4*)(X + (size_t)rw * 1024 + 16 * lane); xb_ = *(const u32x4*)(X + (size_t)rw * 1024 + 16 * lane + 8);
#pragma unroll
        for (int k = 0; k < 8; ++k) {
            const int idx = __builtin_amdgcn_readlane(idx_l, k);
            if (idx >= 0) yy[k] = *(const u32x4*)(ys_row(p, idx) + 16 * lane); else yy[k] = (u32x4){0u, 0u, 0u, 0u};
        }
        if (r == 0) { yy[8] = *(const u32x4*)(ys_row(p, PL[208] + rw) + 16 * lane); yy[9] = *(const u32x4*)(ys_row(p, PL[208] + nrows + rw) + 16 * lane); }
        else { yy[8] = (u32x4){0u, 0u, 0u, 0u}; yy[9] = yy[8]; }
    };
    int row = blockIdx.x * 4 + wid, rown = row + rstep;
    int e_n = 0, sl_n = 0;
    u32x4 y[10], xa, xb;
    if (row < nrows) {
        if (lane < 8) { e_n = tke[row * 8 + lane]; sl_n = tks[row * 8 + lane]; }
        issue(row, e_n, sl_n, y, xa, xb);
        if (rown < nrows && lane < 8) { e_n = tke[rown * 8 + lane]; sl_n = tks[rown * 8 + lane]; }
    }
    for (; row < nrows; row = rown, rown += rstep) {
        u32x4 y2[10], xa2, xb2;
        if (rown < nrows) {
            issue(rown, e_n, sl_n, y2, xa2, xb2);
            const int r3 = rown + rstep;
            if (r3 < nrows && lane < 8) { e_n = tke[r3 * 8 + lane]; sl_n = tks[r3 * 8 + lane]; }
        } else {
#pragma unroll
            for (int k = 0; k < 10; ++k) y2[k] = (u32x4){0u, 0u, 0u, 0u};
            xa2 = y2[0]; xb2 = y2[0];
        }
        const int g = mod_group(row);
        const float* g2 = mod + ((size_t)l * 9 + g) * 6144 + 5120 + 16 * lane;
        f32x4 v[4];
        {
            const u32x4 a = xa, b2 = xb;
            v[0] = (f32x4){__uint_as_float(a[0] << 16), __uint_as_float(a[0] & 0xffff0000u), __uint_as_float(a[1] << 16), __uint_as_float(a[1] & 0xffff0000u)};
            v[1] = (f32x4){__uint_as_float(a[2] << 16), __uint_as_float(a[2] & 0xffff0000u), __uint_as_float(a[3] << 16), __uint_as_float(a[3] & 0xffff0000u)};
            v[2] = (f32x4){__uint_as_float(b2[0] << 16), __uint_as_float(b2[0] & 0xffff0000u), __uint_as_float(b2[1] << 16), __uint_as_float(b2[1] & 0xffff0000u)};
            v[3] = (f32x4){__uint_as_float(b2[2] << 16), __uint_as_float(b2[2] & 0xffff0000u), __uint_as_float(b2[3] << 16), __uint_as_float(b2[3] & 0xffff0000u)};
        }
        f32x4 s[4];
#pragma unroll
        for (int j = 0; j < 4; ++j) s[j] = (f32x4){0.f, 0.f, 0.f, 0.f};
#pragma unroll
        for (int k = 0; k < 10; ++k)
#pragma unroll
            for (int j = 0; j < 4; ++j) s[j] += up4_fp8(y[k][j]);
        const float xs = (r == 0) ? DN_ALPHA : 1.0f;
#pragma unroll
        for (int j = 0; j < 4; ++j) v[j] = v[j] * xs + *(const f32x4*)(g2 + 4 * j) * (s[j] * YS_INV);
        if (!final) {
            u32x4 o0, o1;
            o0 = (u32x4){pk2(v[0][0], v[0][1]), pk2(v[0][2], v[0][3]), pk2(v[1][0], v[1][1]), pk2(v[1][2], v[1][3])};
            o1 = (u32x4){pk2(v[2][0], v[2][1]), pk2(v[2][2], v[2][3]), pk2(v[3][0], v[3][1]), pk2(v[3][2], v[3][3])};
            *(u32x4*)(X + (size_t)row * 1024 + 16 * lane) = o0; *(u32x4*)(X + (size_t)row * 1024 + 16 * lane + 8) = o1;
        } else {
            row_norm(v);
#pragma unroll
            for (int j = 0; j < 4; ++j) {
                const int c = 16 * lane + 4 * j;
                v[j] = v[j] * *(const f32x4*)(p.ln2_g + l * 1024 + c) + *(const f32x4*)(p.ln2_b + l * 1024 + c);
                if (l != 0) *(f32x4*)(p.out + (size_t)row * 1024 + c) = v[j];
            }
            if (l == 0) {
                u32x4 o0, o1;
                o0 = (u32x4){pk2(v[0][0], v[0][1]), pk2(v[0][2], v[0][3]), pk2(v[1][0], v[1][1]), pk2(v[1][2], v[1][3])};
                o1 = (u32x4){pk2(v[2][0], v[2][1]), pk2(v[2][2], v[2][3]), pk2(v[3][0], v[3][1]), pk2(v[3][2], v[3][3])};
                *(u32x4*)(X + (size_t)row * 1024 + 16 * lane) = o0; *(u32x4*)(X + (size_t)row * 1024 + 16 * lane + 8) = o1;
                row_norm(v);
                const float* m1 = mod + ((size_t)9 + g) * 6144 + 16 * lane;
                f32x4 h[4];
#pragma unroll
                for (int j = 0; j < 4; ++j) h[j] = v[j] * (*(const f32x4*)(m1 + 1024 + 4 * j) + 1.0f) + *(const f32x4*)(m1 + 4 * j);
                o0 = (u32x4){pk2(h[0][0], h[0][1]), pk2(h[0][2], h[0][3]), pk2(h[1][0], h[1][1]), pk2(h[1][2], h[1][3])};
                o1 = (u32x4){pk2(h[2][0], h[2][1]), pk2(h[2][2], h[2][3]), pk2(h[3][0], h[3][1]), pk2(h[3][2], h[3][3])};
                *(u32x4*)(H + (size_t)row * 1024 + 16 * lane) = o0; *(u32x4*)(H + (size_t)row * 1024 + 16 * lane + 8) = o1;
            }
        }
#pragma unroll
        for (int k = 0; k < 10; ++k) y[k] = y2[k];
        xa = xa2; xb = xb2;
    }
    if (final && l == 0) {
        __syncthreads();
        conv_run(p, 1, (int)blockIdx.x * 12, 12, lds);
    }
}


#define XB_TMO      128
#define XB_XCNT(j)  (256  + 64 * (j))
#define XB_XSUB(j)  (1280 + 64 * (j))
#define XB_XGEN(j)  (2304 + 64 * (j))
#define XB_TOP      3328
#define XB_TOPGEN   3392
#define XCD_BAR_WORDS 3456
#define XB_SPIN_CAP (1u << 22)
DEV unsigned xb_ld(unsigned* p) { return __hip_atomic_load(p, __ATOMIC_RELAXED, __HIP_MEMORY_SCOPE_AGENT); }
DEV unsigned xb_add(unsigned* p, unsigned v) { return __hip_atomic_fetch_add(p, v, __ATOMIC_RELAXED, __HIP_MEMORY_SCOPE_AGENT); }
DEV unsigned xb_xcc_id() { return (unsigned)__builtin_amdgcn_s_getreg((3 << 11) | 20) & 0xFu; }
#define XB_SPIN(cond, bar) do { unsigned _sp = 0; while (cond) { __builtin_amdgcn_s_sleep(1); \
    if ((++_sp & 255u) == 0u) { if (xb_ld(&(bar)[XB_TMO])) break; if (_sp > XB_SPIN_CAP) { atomicAdd(&(bar)[XB_TMO], 1u); break; } } } } while (0)
struct XcdBarrier { unsigned* bar; unsigned x; volatile LAS unsigned* st; };
DEV XcdBarrier xcd_barrier_post(unsigned* bar, volatile LAS unsigned* st) {
    XcdBarrier b; b.bar = bar; b.x = xb_xcc_id(); b.st = st;
    if (threadIdx.x == 0) (void)xb_add(&bar[XB_XCNT(b.x)], 1u);
    return b;
}
DEV void xcd_barrier_complete(unsigned* bar, unsigned x, unsigned& nloc, unsigned& nx) {
    const unsigned G = gridDim.x * gridDim.y * gridDim.z;
    unsigned sum, cnt, mine, sp = 0u;
    for (;;) {
        sum = 0u; cnt = 0u; mine = 0u;
#pragma unroll
        for (unsigned j = 0; j < 16; ++j) { const unsigned c = xb_ld(&bar[XB_XCNT(j)]); sum += c; cnt += (c > 0u) ? 1u : 0u; mine = (j == x) ? c : mine; }
        if (sum == G) break;
        __builtin_amdgcn_s_sleep(1);
        if ((++sp & 255u) == 0u) { if (xb_ld(&bar[XB_TMO])) break; if (sp > XB_SPIN_CAP) { atomicAdd(&bar[XB_TMO], 1u); break; } }
    }
    nloc = mine > 0u ? mine : 1u; nx = cnt > 0u ? cnt : 1u;
}
DEV void xcd_barrier(const XcdBarrier& b) {
    asm volatile("s_waitcnt vmcnt(0)" ::: "memory");
    __syncthreads();
    if (get_tid() == 0) {
        unsigned* bar = b.bar; asm volatile("" : "+s"(bar));
        __builtin_amdgcn_s_waitcnt(0);
        unsigned nloc = b.st[0], nx = b.st[1];
        if (nloc == 0u) { xcd_barrier_complete(bar, b.x, nloc, nx); b.st[0] = nloc; b.st[1] = nx; }
        const unsigned old = xb_add(&bar[XB_XSUB(b.x)], 1u);
        const unsigned gen = old / nloc;
        if (old + 1u == (gen + 1u) * nloc) {
            __builtin_amdgcn_fence(__ATOMIC_RELEASE, "agent");
            asm volatile("s_waitcnt vmcnt(0)" ::: "memory");
            const unsigned og = xb_add(&bar[XB_TOP], 1u);
            const unsigned tg = og / nx;
            if (og + 1u == (tg + 1u) * nx) xb_add(&bar[XB_TOPGEN], 1u);
            else XB_SPIN(xb_ld(&bar[XB_TOPGEN]) == tg, bar);
            __builtin_amdgcn_fence(__ATOMIC_ACQUIRE, "agent");
            xb_add(&bar[XB_XGEN(b.x)], 1u);
            asm volatile("s_waitcnt vmcnt(0)" ::: "memory");
        } else {
            XB_SPIN(xb_ld(&bar[XB_XGEN(b.x)]) == gen, bar);
            __builtin_amdgcn_fence(__ATOMIC_ACQUIRE, "agent");
            asm volatile("s_waitcnt vmcnt(0)" ::: "memory");
        }
    }
    __syncthreads();
}

enum { PT_PREP = 0, PT_MODFIN, PT_LNMOD0, PT_INPROJ, PT_MIX, PT_OUTPROJ, PT_LN1ROUTE, PT_MOE, PT_COMB };

DEV void run_phase(const Params& pin, int type, int l, int r, char* lds) {
    Params p = pin;
    { unsigned char* w = p.ws; asm volatile("" : "+s"(w)); p.ws = w; }
    switch (type) {
        case PT_PREP: phase_prep(p, lds); break;
        case PT_MODFIN: phase_modfin(p); break;
        case PT_LNMOD0: phase_lnmod0(p); break;
        case PT_INPROJ: phase_inproj(p, l, lds); break;
        case PT_MIX: phase_mix(p, l, lds); break;
        case PT_OUTPROJ: phase_outproj(p, l, lds); break;
        case PT_LN1ROUTE: phase_ln1route(p, l, lds); break;
        case PT_MOE: phase_moe(p, l, r, lds); break;
        default: phase_comb(p, l, r, lds); break;
    }
}

__global__ void __launch_bounds__(256, 2) fwd_kernel(Params p) {
    __shared__ __attribute__((aligned(16))) char smem[SMEM_BYTES];
#if MULTI_LAUNCH
    run_phase(p, p.ptype, p.pl, p.pr, smem);
#else
    if (threadIdx.x < 4) ((volatile LAS unsigned*)(smem + SMEM_BYTES - 16))[threadIdx.x] = 0u;
    __syncthreads();
    const XcdBarrier bar = xcd_barrier_post((unsigned*)(p.ws + OFF_BAR), (volatile LAS unsigned*)(smem + SMEM_BYTES - 16));
    int type = PT_PREP, l = 0, r = 0;
#if TELEM
    volatile LAS unsigned* tacc = (volatile LAS unsigned*)(smem + SMEM_BYTES - 128);
    if (threadIdx.x < 16) tacc[threadIdx.x] = 0u;
    unsigned long long t_prev = __builtin_amdgcn_s_memrealtime();
#endif
    for (;;) {
        run_phase(p, type, l, r, smem);
#if TELEM
        { const int ptype_done = type;
          xcd_barrier(bar);
          const unsigned long long t_now = __builtin_amdgcn_s_memrealtime();
          if (threadIdx.x == 0) tacc[ptype_done] += (unsigned)(t_now - t_prev);
          t_prev = t_now; }
#endif
        if (type < PT_MOE) { ++type; if (type == PT_MODFIN) ++type; r = 0; }
        else if (type == PT_MOE) type = PT_COMB;
        else {
            const int nr = ((const int*)(smem + PLAN_OFF))[0];
            if (r + 1 < nr) { ++r; type = PT_MOE; }
            else { if (l == 1) break; l = 1; r = 0; type = PT_INPROJ; }
        }
#if !TELEM
        xcd_barrier(bar);
#endif
    }
#if TELEM
    {
        unsigned* tel = (unsigned*)(p.ws + 36864);
        if (blockIdx.x == 0 && threadIdx.x == 0) { unsigned sa = 0u; for (int i = 0; i < 16; ++i) if ((TELEM_A >> i) & 1) sa += tacc[i]; tacc[15] = sa; }
        xcd_barrier(bar);
        if (blockIdx.x == 0 && threadIdx.x == 0) {
            p.out[0] += 1.0f + (float)tacc[TELEM_C] * 0.01f * 0.02f;
            const unsigned long long t0 = __builtin_amdgcn_s_memrealtime();
            const unsigned long long wait = 2ull * tacc[15];
            while (__builtin_amdgcn_s_memrealtime() - t0 < wait) __builtin_amdgcn_s_sleep(8);
        }
    }
#endif
#endif
}

extern "C" void kernel_launch(void* const* d_in, const int* in_sizes, int n_in, void* d_out, int out_size, void* d_ws, size_t ws_size, hipStream_t stream) {
    Params p{};
    const float** pp = (const float**)&p;
    for (int i = 0; i < 32; ++i) pp[i] = (const float*)d_in[i];
    p.out = (float*)d_out; p.ws = (unsigned char*)d_ws;
    long long cap = ((long long)ws_size - (long long)OFF_R) / 2048;
    if (cap > NT * 8) cap = NT * 8;
    if (cap * 2048 < (long long)R_MIN_BYTES || cap < NT) { fprintf(stderr, "kernel_launch: workspace too small (%zu)\n", ws_size); return; }
    p.cap = (int)cap;
#if MULTI_LAUNCH
    const int grid = 512;
    auto launch = [&](int type, int l, int r) { Params q = p; q.mode = 1; q.ptype = type; q.pl = l; q.pr = r; hipLaunchKernelGGL(fwd_kernel, dim3(grid), dim3(256), 0, stream, q); };
    launch(PT_PREP, 0, 0); launch(PT_MODFIN, 0, 0); launch(PT_LNMOD0, 0, 0);
    for (int l = 0; l < 2; ++l) {
        launch(PT_INPROJ, l, 0); launch(PT_MIX, l, 0); launch(PT_OUTPROJ, l, 0); launch(PT_LN1ROUTE, l, 0);
        for (int r = 0; r < RMAX; ++r) { launch(PT_MOE, l, r); launch(PT_COMB, l, r); }
    }
#else
    static int grid_blocks = 0;
    if (!grid_blocks) {
        int dev = 0, cus = 0, per_cu = 0;
        hipGetDevice(&dev);
        hipDeviceGetAttribute(&cus, hipDeviceAttributeMultiprocessorCount, dev);
        hipOccupancyMaxActiveBlocksPerMultiprocessor(&per_cu, fwd_kernel, 256, 0);
        if (per_cu > 2) per_cu = 2;
        if (per_cu < 1) per_cu = 1;
        grid_blocks = cus * per_cu;
    }
    p.mode = 0;
    hipMemsetAsync(d_ws, 0, 65536, stream);
    hipLaunchKernelGGL(fwd_kernel, dim3(grid_blocks), dim3(256), 0, stream, p);
#endif
}
```

```cpp
#include <hip/hip_runtime.h>
#ifndef TELEM
#define TELEM 0
#endif
#define TELEM_A 0x1
#define TELEM_C 8
#include <hip/hip_cooperative_groups.h>
#include <stdint.h>
#include <stdio.h>
namespace cg = cooperative_groups;

#ifndef MULTI_LAUNCH
#define MULTI_LAUNCH 0
#endif

typedef unsigned short bf16_t;
typedef short bf16x8 __attribute__((ext_vector_type(8)));
typedef short s16x4 __attribute__((ext_vector_type(4)));
typedef float f32x4 __attribute__((ext_vector_type(4)));
typedef unsigned u32x4 __attribute__((ext_vector_type(4)));
typedef unsigned u32x2 __attribute__((ext_vector_type(2)));
#define DEV __device__ __forceinline__
#define LDSP(T) __attribute__((address_space(3))) T*
#define LAS __attribute__((address_space(3)))

constexpr int D = 1024, NB = 8, SEQ = 2048, CTX = 256, NLAT = NB * SEQ, NCTX = NB * CTX, NT = NLAT + NCTX;
constexpr int PROJ = 2304, KEYS = CTX + SEQ, NEXP = 64;
constexpr float DN_ALPHA = 1.41421356237309515f;
constexpr float LOG2E = 1.44269504088896341f;
constexpr int SMEM_BYTES = 72 * 1024;
constexpr int RMAX = 4;

constexpr size_t OFF_CNT = 0;
constexpr size_t OFF_QUEUE = 33792;
constexpr size_t OFF_BAR = 40960;
constexpr size_t OFF_MOD = 65536;
constexpr size_t OFF_ROPE = OFF_MOD + 442368;
constexpr size_t OFF_KERNL = OFF_ROPE + 2ull * 2048 * 32 * 4;
constexpr size_t OFF_KERNC = OFF_KERNL + 2ull * 4096 * 256 * 4;
constexpr size_t OFF_TKE = OFF_KERNC + 2ull * 512 * 256 * 4;
constexpr size_t OFF_TKS = OFF_TKE + (size_t)NT * 8 * 4;
constexpr size_t OFF_TKW = OFF_TKS + (size_t)NT * 8 * 4;
constexpr size_t OFF_LIST = OFF_TKW + (size_t)NT * 8 * 4;
constexpr size_t OFF_WIN = OFF_LIST + 64ull * NT * 4;
constexpr size_t OFF_WOUT = OFF_WIN + 2ull * 2304 * 1024 * 2;
constexpr size_t OFF_SW13 = OFF_WOUT + 2ull * 1024 * 1024 * 2;
constexpr size_t OFF_SW2 = OFF_SW13 + 2ull * 512 * 1024 * 2;
constexpr size_t OFF_RW = OFF_SW2 + 2ull * 1024 * 256 * 2;
constexpr size_t OFF_W13 = OFF_RW + 2ull * 64 * 1024 * 2;
constexpr size_t OFF_W2 = OFF_W13 + 64ull * 256 * 1024 * 2;
constexpr size_t OFF_X = OFF_W2 + 64ull * 1024 * 128 * 2;
constexpr size_t OFF_H = OFF_X + (size_t)NT * 1024 * 2;
constexpr size_t OFF_R = OFF_H + (size_t)NT * 1024 * 2;
constexpr size_t OFF_QA = OFF_R;
constexpr size_t OFF_QB = OFF_QA + 8ull * NT * 64 * 2;
constexpr size_t OFF_KA = OFF_QB + 4ull * NT * 64 * 2;
constexpr size_t OFF_VA = OFF_KA + 8ull * 2 * KEYS * 64 * 2;
constexpr size_t OFF_KB = OFF_VA + 8ull * 2 * KEYS * 64 * 2;
constexpr size_t OFF_VB = OFF_KB + 8ull * 4 * KEYS * 64 * 2;
constexpr size_t OFF_ZTL = OFF_VB + 8ull * 4 * KEYS * 64 * 2;
constexpr size_t OFF_ZTC = OFF_ZTL + 8ull * 768 * 2048 * 2;
constexpr size_t OFF_OX = OFF_ZTC + 8ull * 768 * 256 * 2;
constexpr size_t OFF_OXT = OFF_OX + (size_t)NT * 1024 * 2;
constexpr size_t R_MIN_BYTES = OFF_OXT + 8ull * 256 * 2048 * 2 - OFF_R;
constexpr size_t OFF_PART = OFF_R;
constexpr size_t OFF_YS = OFF_R;

struct Params {
    const float *x, *c, *ctx, *c_ctx, *ada_w, *ada_b, *w_in, *q_gain, *k_gain, *nat_rpb, *hy_conv_w, *hy_conv_b,
        *hy_f_w1, *hy_f_b1, *hy_f_w2, *hy_f_b2, *hy_f_w3, *hy_freq, *hy_skip, *w_out, *ln1_g, *ln1_b,
        *router_w, *router_b, *exp_w1, *exp_w3, *exp_w2, *sh_w1, *sh_w3, *sh_w2, *ln2_g, *ln2_b;
    float* out; unsigned char* ws;
    int cap, mode, ptype, pl, pr, pad;
};

typedef __bf16 hwbf2 __attribute__((ext_vector_type(2)));
typedef float f32x2 __attribute__((ext_vector_type(2)));
DEV unsigned f2bf(float f) { return (unsigned)__builtin_bit_cast(unsigned short, (__bf16)f); }
DEV unsigned pk2(float lo, float hi) { const f32x2 v = {lo, hi}; return __builtin_bit_cast(unsigned, __builtin_convertvector(v, hwbf2)); }
DEV float bf2f(unsigned short h) { return __uint_as_float(((unsigned)h) << 16); }
DEV float wave_sum(float v) {
#pragma unroll
    for (int o = 32; o > 0; o >>= 1) v += __shfl_xor(v, o);
    return v;
}
DEV void glds16(const void* g, void* l) { __builtin_amdgcn_global_load_lds((const unsigned*)g, (unsigned*)l, 16, 0, 0); }
DEV f32x4 mfma16(bf16x8 a, bf16x8 b, f32x4 c) { return __builtin_amdgcn_mfma_f32_16x16x32_bf16(a, b, c, 0, 0, 0); }
DEV float readlane_f(float v, int l) { return __uint_as_float((unsigned)__builtin_amdgcn_readlane((int)__float_as_uint(v), l)); }
DEV int get_tid() { int t = threadIdx.x; asm volatile("" : "+v"(t)); return t; }
DEV int lchunk(int tid) { return (tid & 3) ^ ((0 - (tid >> 4)) & 3); }
DEV int vblock() { const int G = (int)gridDim.x, b = (int)blockIdx.x; return (G & 7) ? b : (b & 7) * (G >> 3) + (b >> 3); }
DEV int mod_group(int row) { return row < NLAT ? (row >> 11) : 8; }

template <int MI, int NI> DEV void zero_acc(f32x4 (&acc)[MI][NI]) {
#pragma unroll
    for (int m = 0; m < MI; ++m)
#pragma unroll
        for (int n = 0; n < NI; ++n) acc[m][n] = (f32x4){0.f, 0.f, 0.f, 0.f};
}
#define WAIT_VM(n) asm volatile("s_waitcnt vmcnt(" #n ")" ::: "memory")
#define WAIT_LGKM0() asm volatile("s_waitcnt lgkmcnt(0)" ::: "memory")
#define RAW_BARRIER() do { asm volatile("" ::: "memory"); __builtin_amdgcn_s_barrier(); asm volatile("" ::: "memory"); } while (0)
template <int MI, int NI, bool TRANS>
DEV void gemm_core(f32x4 (&acc)[MI][NI], const bf16_t* A, const unsigned (&ao)[MI / 2], const bf16_t* B, const unsigned (&bo)[NI / 2], int K, char* lds) {
    const int tid = get_tid(), lane = tid & 63, wid = tid >> 6, fr = lane & 15, fq = lane >> 4, wr = wid >> 1, wc = wid & 1;
    constexpr int SAB = 2048 * MI, STG = 2048 * (MI + NI), LPT = MI / 2 + NI / 2;
    static_assert(LPT == 3 || LPT == 4 || LPT == 6, "loads per tile");
    const int nt = K >> 5;
    auto stage = [&](int s, int t) {
        char* SA = lds + s * STG; char* SB = SA + SAB;
#pragma unroll
        for (int i = 0; i < MI / 2; ++i) glds16(A + (ao[i] + (unsigned)(t * 32)), SA + i * 4096 + tid * 16);
#pragma unroll
        for (int i = 0; i < NI / 2; ++i) glds16(B + (bo[i] + (unsigned)(t * 32)), SB + i * 4096 + tid * 16);
    };
    WAIT_VM(0);
    stage(0, 0);
    if (nt > 1) stage(1, 1);
    const int sw = (fq ^ ((0 - (fr >> 2)) & 3)) * 16;
    const int aoff = (wr * MI * 16 + fr) * 64 + sw, boff = SAB + (wc * NI * 16 + fr) * 64 + sw;
#pragma unroll 1
    for (int t = 0; t < nt; ++t) {
        if (t + 1 < nt) { if (LPT == 6) WAIT_VM(6); else if (LPT == 4) WAIT_VM(4); else WAIT_VM(3); } else WAIT_VM(0);
        RAW_BARRIER();
        const char* S = lds + (t & 1) * STG;
        bf16x8 af[MI], bfr[NI];
#pragma unroll
        for (int m = 0; m < MI; ++m) af[m] = *(const bf16x8*)(S + aoff + m * 1024);
#pragma unroll
        for (int n = 0; n < NI; ++n) bfr[n] = *(const bf16x8*)(S + boff + n * 1024);
        WAIT_LGKM0();
        RAW_BARRIER();
        if (t + 2 < nt) stage(t & 1, t + 2);
#pragma unroll
        for (int m = 0; m < MI; ++m)
#pragma unroll
            for (int n = 0; n < NI; ++n) acc[m][n] = TRANS ? mfma16(bfr[n], af[m], acc[m][n]) : mfma16(af[m], bfr[n], acc[m][n]);
    }
}
DEV unsigned st64_off(int tid) { return (unsigned)(tid >> 3) * 1024u + (unsigned)(((tid & 7) ^ ((tid >> 3) & 7)) * 8); }
DEV int tr_key(int row) { return (row & 3) | (((row >> 3) & 1) << 2); }
template <bool TRANS>
DEV void gemm_core64(f32x4 (&acc)[4][4], const bf16_t* A, const unsigned (&ao)[4], const bf16_t* B, const unsigned (&bo)[4], int K, char* lds,
                     const bf16_t* AT = nullptr, int t_tr = 1 << 20) {
    const int tid = get_tid(), lane = tid & 63, wid = tid >> 6, fr = lane & 15, fq = lane >> 4, wr = wid >> 1, wc = wid & 1;
    const int nt = K >> 6;
    auto stage = [&](int s, int t) {
        char* SA = lds + s * 32768; char* SB = SA + 16384;
        if (t >= t_tr) {
#pragma unroll
            for (int i = 0; i < 4; ++i) {
                const int id = tid + 256 * i, row = id >> 4, cp = id & 15, c = (cp - 2 * tr_key(row)) & 15;
                glds16(AT + (size_t)((t - t_tr) * 64 + row) * 2048 + c * 8, SA + id * 16);
            }
        } else {
#pragma unroll
            for (int i = 0; i < 4; ++i) glds16(A + (ao[i] + (unsigned)(t * 64)), SA + i * 4096 + tid * 16);
        }
#pragma unroll
        for (int i = 0; i < 4; ++i) glds16(B + (bo[i] + (unsigned)(t * 64)), SB + i * 4096 + tid * 16);
    };
    WAIT_VM(0);
    stage(0, 0);
    if (nt > 1) stage(1, 1);
    const int rsw = fr & 7;
    const int arow = (wr * 64 + fr) * 128, brow = 16384 + (wc * 64 + fr) * 128;
    const int c0 = ((fq) ^ rsw) * 16, c1 = ((4 + fq) ^ rsw) * 16;
#pragma unroll 1
    for (int t = 0; t < nt; ++t) {
        if (t + 1 < nt) WAIT_VM(8); else WAIT_VM(0);
        RAW_BARRIER();
        const char* S = lds + (t & 1) * 32768;
        bf16x8 af[4][2], bfr[4][2];
        if (t >= t_tr) {
            const int q4 = fr >> 2, p4 = fr & 3;
#pragma unroll
            for (int m = 0; m < 4; ++m)
#pragma unroll
                for (int ks = 0; ks < 2; ++ks) {
                    const int rowA = ks * 32 + 8 * fq + q4, rowB = rowA + 4, c = wr * 8 + m * 2 + (p4 >> 1);
                    const int offA = rowA * 256 + (((c + 2 * tr_key(rowA)) & 15) * 16) + (p4 & 1) * 8;
                    const int offB = rowB * 256 + (((c + 2 * tr_key(rowB)) & 15) * 16) + (p4 & 1) * 8;
                    const s16x4 ta = __builtin_amdgcn_ds_read_tr16_b64_v4i16((LDSP(s16x4))(S + offA));
                    const s16x4 tb = __builtin_amdgcn_ds_read_tr16_b64_v4i16((LDSP(s16x4))(S + offB));
                    bf16x8 f; f[0] = ta[0]; f[1] = ta[1]; f[2] = ta[2]; f[3] = ta[3]; f[4] = tb[0]; f[5] = tb[1]; f[6] = tb[2]; f[7] = tb[3];
                    af[m][ks] = f;
                }
        } else {
#pragma unroll
            for (int m = 0; m < 4; ++m) { af[m][0] = *(const bf16x8*)(S + arow + m * 2048 + c0); af[m][1] = *(const bf16x8*)(S + arow + m * 2048 + c1); }
        }
#pragma unroll
        for (int n = 0; n < 4; ++n) { bfr[n][0] = *(const bf16x8*)(S + brow + n * 2048 + c0); bfr[n][1] = *(const bf16x8*)(S + brow + n * 2048 + c1); }
        WAIT_LGKM0();
        RAW_BARRIER();
        if (t + 2 < nt) stage(t & 1, t + 2);
        __builtin_amdgcn_s_setprio(1);
#pragma unroll
        for (int ks = 0; ks < 2; ++ks)
#pragma unroll
            for (int m = 0; m < 4; ++m)
#pragma unroll
                for (int n = 0; n < 4; ++n) acc[m][n] = TRANS ? mfma16(bfr[n][ks], af[m][ks], acc[m][n]) : mfma16(af[m][ks], bfr[n][ks], acc[m][n]);
        __builtin_amdgcn_s_setprio(0);
    }
}
template <int KACT, int ASTRIDE, class EPI>
DEV void gemm2_stream64(const bf16_t* W2, const char* ACT, char* sb, EPI&& epi) {
    const int tid = get_tid(), lane = tid & 63, wid = tid >> 6, fr = lane & 15, fq = lane >> 4, wr = wid >> 1, wc = wid & 1;
    constexpr int KS = KACT / 64, NJ = 8 * KS;
    const unsigned b0 = (unsigned)(tid >> 3) * KACT + (unsigned)(((tid & 7) ^ ((tid >> 3) & 7)) * 8);
    auto stage = [&](int s, int j) {
        const int nt = j / KS, ks = j % KS;
        char* SB = sb + s * 16384;
        const bf16_t* src = W2 + (size_t)nt * 128 * KACT + ks * 64 + b0;
#pragma unroll
        for (int i = 0; i < 4; ++i) glds16(src + (size_t)i * 32 * KACT, SB + i * 4096 + tid * 16);
    };
    WAIT_VM(0);
    stage(0, 0); stage(1, 1);
    const int rsw = fr & 7;
    const int brow = (wc * 64 + fr) * 128, c0 = (fq ^ rsw) * 16, c1 = ((4 + fq) ^ rsw) * 16;
    f32x4 acc[4][4]; zero_acc<4, 4>(acc);
#pragma unroll 1
    for (int j = 0; j < NJ; ++j) {
        const int ks = j % KS;
        if (j + 1 < NJ) WAIT_VM(4); else WAIT_VM(0);
        RAW_BARRIER();
        const char* S = sb + (j & 1) * 16384;
        bf16x8 af[4][2], bfr[4][2];
#pragma unroll
        for (int m = 0; m < 4; ++m) { const char* ar = ACT + (wr * 64 + m * 16 + fr) * ASTRIDE + (ks * 64 + fq * 8) * 2; af[m][0] = *(const bf16x8*)ar; af[m][1] = *(const bf16x8*)(ar + 64); }
#pragma unroll
        for (int n = 0; n < 4; ++n) { bfr[n][0] = *(const bf16x8*)(S + brow + n * 2048 + c0); bfr[n][1] = *(const bf16x8*)(S + brow + n * 2048 + c1); }
        WAIT_LGKM0();
        RAW_BARRIER();
        if (j + 2 < NJ) stage(j & 1, j + 2);
#pragma unroll
        for (int k2 = 0; k2 < 2; ++k2)
#pragma unroll
            for (int m = 0; m < 4; ++m)
#pragma unroll
                for (int n = 0; n < 4; ++n) acc[m][n] = mfma16(bfr[n][k2], af[m][k2], acc[m][n]);
        if (ks == KS - 1) { epi(j / KS, acc); zero_acc<4, 4>(acc); }
    }
}
template <int MI, int KACT, int ASTRIDE, class EPI>
DEV void gemm2_stream(const bf16_t* W2, const char* ACT, char* sb, EPI&& epi) {
    const int tid = get_tid(), lane = tid & 63, wid = tid >> 6, fr = lane & 15, fq = lane >> 4, wr = wid >> 1, wc = wid & 1;
    constexpr int KS = KACT / 32, NJ = 8 * KS;
    const bf16_t* b0 = W2 + (size_t)(tid >> 2) * KACT + lchunk(tid) * 8;
    auto stage = [&](int s, int j) {
        const int nt = j / KS, ks = j % KS;
        char* SB = sb + s * 8192;
        const bf16_t* src = b0 + (size_t)nt * 128 * KACT + ks * 32;
        glds16(src, SB + tid * 16);
        glds16(src + 64 * KACT, SB + 4096 + tid * 16);
    };
    WAIT_VM(0);
    stage(0, 0); stage(1, 1);
    const int boff = (wc * 64 + fr) * 64 + (fq ^ ((0 - (fr >> 2)) & 3)) * 16;
    f32x4 acc[MI][4]; zero_acc<MI, 4>(acc);
#pragma unroll 1
    for (int j = 0; j < NJ; ++j) {
        const int ks = j % KS;
        if (j + 1 < NJ) WAIT_VM(2); else WAIT_VM(0);
        RAW_BARRIER();
        const char* S = sb + (j & 1) * 8192;
        bf16x8 af[MI], bfr[4];
#pragma unroll
        for (int m = 0; m < MI; ++m) af[m] = *(const bf16x8*)(ACT + (wr * MI * 16 + m * 16 + fr) * ASTRIDE + (ks * 32 + fq * 8) * 2);
#pragma unroll
        for (int n = 0; n < 4; ++n) bfr[n] = *(const bf16x8*)(S + boff + n * 1024);
        WAIT_LGKM0();
        RAW_BARRIER();
        if (j + 2 < NJ) stage(j & 1, j + 2);
#pragma unroll
        for (int m = 0; m < MI; ++m)
#pragma unroll
            for (int n = 0; n < 4; ++n) acc[m][n] = mfma16(bfr[n], af[m], acc[m][n]);
        if (ks == KS - 1) { epi(j / KS, acc); zero_acc<MI, 4>(acc); }
    }
}

DEV void prep_mod_item(const Params& p, int it, char* lds) {
    const int l = it / 96, r = it % 96, cch = r >> 2, kp = r & 3, tid = get_tid(), lane = tid & 63, kq = tid >> 6;
    float* sl = (float*)lds;
    float* red = sl + 9 * 256;
    for (int i = tid; i < 9 * 256; i += 256) { const int g = i >> 8, k = kp * 256 + (i & 255); const float v = (g < 8) ? p.c[g * 1024 + k] : p.c_ctx[k]; sl[i] = v * __builtin_amdgcn_rcpf(1.f + __expf(-v)); }
    __syncthreads();
    f32x4 acc[9];
#pragma unroll
    for (int g = 0; g < 9; ++g) acc[g] = (f32x4){0.f, 0.f, 0.f, 0.f};
    const float* w = p.ada_w + ((size_t)l * 1024 + kp * 256 + kq * 64) * 6144 + cch * 256 + lane * 4;
#pragma unroll 16
    for (int kk = 0; kk < 64; ++kk) {
        const f32x4 wv = *(const f32x4*)(w + (size_t)kk * 6144);
#pragma unroll
        for (int g = 0; g < 9; ++g) { const float sv = sl[g * 256 + kq * 64 + kk]; acc[g] += sv * wv; }
    }
#pragma unroll
    for (int g = 0; g < 9; ++g) *(f32x4*)(red + (kq * 9 + g) * 256 + lane * 4) = acc[g];
    __syncthreads();
    float* part = (float*)(p.ws + OFF_R) + (size_t)(l * 24 + cch) * 4 * 2304;
    for (int i = tid; i < 9 * 256; i += 256) {
        const int g = i >> 8, c = i & 255;
        part[kp * 2304 + i] = (red[(0 * 9 + g) * 256 + c] + red[(1 * 9 + g) * 256 + c]) + (red[(2 * 9 + g) * 256 + c] + red[(3 * 9 + g) * 256 + c]);
    }
    __threadfence();
    __syncthreads();
    int* arrive = (int*)(lds + SMEM_BYTES - 252);
    if (tid == 0) *arrive = atomicAdd((int*)(p.ws + OFF_QUEUE) + 256 + l * 24 + cch, 1);
    __syncthreads();
    if (*arrive == 3) {
        __threadfence();
        float* mod = (float*)(p.ws + OFF_MOD);
        for (int i = tid; i < 9 * 256; i += 256) {
            const int g = i >> 8, c = i & 255;
            const float v = (__builtin_nontemporal_load(part + i) + __builtin_nontemporal_load(part + 2304 + i)) + (__builtin_nontemporal_load(part + 2 * 2304 + i) + __builtin_nontemporal_load(part + 3 * 2304 + i));
            mod[((size_t)l * 9 + g) * 6144 + cch * 256 + c] = p.ada_b[l * 6144 + cch * 256 + c] + v;
        }
    }
    __syncthreads();
}
constexpr float INV2PI = 0.15915494309189535f;
DEV float sin_rev(float r) { return __builtin_amdgcn_sinf(__builtin_amdgcn_fractf(r)); }
DEV float cos_rev(float r) { return __builtin_amdgcn_cosf(__builtin_amdgcn_fractf(r)); }
DEV void prep_rope_item(const Params& p, int it) {
    const int idx = it * 256 + get_tid(), t = idx >> 5, i = idx & 31;
    const float inv = __builtin_amdgcn_exp2f(-(float)(2 * (i & 15)) * (13.287712379549449f / 32.f));
    const float ang = (float)((i < 16) ? (t >> 6) : (t & 63)) * inv;
    float* rc = (float*)(p.ws + OFF_ROPE);
    rc[idx] = cos_rev(ang * INV2PI); rc[2048 * 32 + idx] = sin_rev(ang * INV2PI);
}
DEV void prep_filter_item(const Params& p, int it, char* lds) {
    const int tid = get_tid(), lane = tid & 63, wid = tid >> 6;
    const int row0 = it * 32 + wid * 8;
    const int l = row0 / 2304, r0 = row0 % 2304, type = r0 < 2048 ? 0 : 1, t0 = type ? r0 - 2048 : r0, n = type ? 256 : 2048;
    float* z = (float*)lds + wid * (8 * 192); float* h1 = z + 8 * 64; float* h2 = h1 + 8 * 64;
    float* WL = (float*)(lds + 24576);
    const float rn1 = type ? 1.f / 255.f : 1.f / 2047.f;
    for (int idx = tid; idx < 97 * 16; idx += 256) {
        const int row = idx >> 4, c4 = (idx & 15) * 4;
        const float* src = row < 33 ? p.hy_f_w1 + (l * 33 + row) * 64 : p.hy_f_w2 + (l * 64 + row - 33) * 64;
        *(f32x4*)(WL + row * 64 + c4) = *(const f32x4*)(src + c4);
    }
#pragma unroll
    for (int rr = 0; rr < 8; ++rr) {
        const int t = t0 + rr;
        if (lane < 33) {
            float v;
            if (lane == 0) v = (float)t * rn1;
            else {
                const int i = (lane - 1) & 15;
                const float f = 1e-4f + (float)i * ((15.f - 1e-4f) / 15.f);
                const float rev = f * ((float)t * (type ? 1.f / 256.f : 1.f / 2048.f));
                v = (lane <= 16) ? cos_rev(rev) : -sin_rev(rev);
            }
            z[rr * 64 + lane] = v;
        }
    }
    __syncthreads();
    {
        float s[8]; const float b = p.hy_f_b1[l * 64 + lane];
#pragma unroll
        for (int rr = 0; rr < 8; ++rr) s[rr] = b;
#pragma unroll 11
        for (int i = 0; i < 33; ++i) {
            const float w = WL[i * 64 + lane];
#pragma unroll
            for (int rr = 0; rr < 8; ++rr) s[rr] += z[rr * 64 + i] * w;
        }
        const float fq0 = p.hy_freq[(l * 2 + 0) * 64 + lane];
#pragma unroll
        for (int rr = 0; rr < 8; ++rr) h1[rr * 64 + lane] = sin_rev(fq0 * s[rr] * INV2PI);
    }
    __builtin_amdgcn_wave_barrier();
    {
        float s[8]; const float b = p.hy_f_b2[l * 64 + lane];
#pragma unroll
        for (int rr = 0; rr < 8; ++rr) s[rr] = b;
#pragma unroll 16
        for (int i = 0; i < 64; ++i) {
            const float w = WL[(33 + i) * 64 + lane];
#pragma unroll
            for (int rr = 0; rr < 8; ++rr) s[rr] += h1[rr * 64 + i] * w;
        }
        const float fq1 = p.hy_freq[(l * 2 + 1) * 64 + lane];
#pragma unroll
        for (int rr = 0; rr < 8; ++rr) h2[rr * 64 + lane] = sin_rev(fq1 * s[rr] * INV2PI);
    }
    __syncthreads();
    float acc[8][8];
#pragma unroll
    for (int rr = 0; rr < 8; ++rr)
#pragma unroll
        for (int q = 0; q < 8; ++q) acc[rr][q] = 0.f;
    const float* w3 = p.hy_f_w3 + (size_t)l * 64 * 512;
#pragma unroll 1
    for (int ch = 0; ch < 4; ++ch) {
#pragma unroll
        for (int j = 0; j < 8; ++j) { const int idx = tid + j * 256; *(f32x4*)(WL + idx * 4) = *(const f32x4*)(w3 + (size_t)ch * 16 * 512 + idx * 4); }
        __syncthreads();
#pragma unroll 2
        for (int i = 0; i < 16; ++i) {
            float w[8];
#pragma unroll
            for (int q = 0; q < 8; ++q) w[q] = WL[i * 512 + q * 64 + lane];
#pragma unroll
            for (int rr = 0; rr < 8; ++rr) {
                const float hv = h2[rr * 64 + ch * 16 + i];
#pragma unroll
                for (int q = 0; q < 8; ++q) acc[rr][q] += hv * w[q];
            }
        }
        __syncthreads();
    }
    bf16_t* kf = (bf16_t*)(p.ws + (type ? OFF_KERNC + (size_t)l * 2 * 256 * 256 * 2 : OFF_KERNL + (size_t)l * 2 * 256 * 2048 * 2));
    const float lo = logf(1e-2f) / 1.5f, hi = logf(1e-2f) / 0.3f;
#pragma unroll
    for (int q = 0; q < 8; ++q) {
        const int qh = q >> 2, c = (q & 3) * 64 + lane;
        const float delta = fabsf(lo + (float)c * ((hi - lo) / 255.f));
        float v[8];
#pragma unroll
        for (int rr = 0; rr < 8; ++rr) { const float tt = (float)(t0 + rr) * rn1; v[rr] = acc[rr][q] * __expf(-tt * delta); }
        if (qh == 0 && t0 == 0) v[0] += p.hy_skip[l * 256 + c];
        *(u32x4*)(kf + ((size_t)qh * 256 + c) * n + t0) = (u32x4){pk2(v[0], v[1]), pk2(v[2], v[3]), pk2(v[4], v[5]), pk2(v[6], v[7])};
    }
}
struct ConvDesc { const float* src; bf16_t* dst; int ldsrc, k0, n0, lddst, mapkind; };
DEV void conv_load(const ConvDesc& d, f32x4 (&v)[4], int tid) {
    const int r = tid >> 4, c4 = (tid & 15) * 4;
#pragma unroll
    for (int i = 0; i < 4; ++i) v[i] = *(const f32x4*)(d.src + (size_t)(d.k0 + r + 16 * i) * d.ldsrc + d.n0 + c4);
}
DEV void conv_store(const ConvDesc& d, const f32x4 (&v)[4], char* lds, int tid) {
    float* tl = (float*)lds;
    {
        const int r = tid >> 4, c4 = (tid & 15) * 4;
#pragma unroll
        for (int i = 0; i < 4; ++i) { const int row = r + 16 * i; tl[row * 65 + c4 + 0] = v[i][0]; tl[row * 65 + c4 + 1] = v[i][1]; tl[row * 65 + c4 + 2] = v[i][2]; tl[row * 65 + c4 + 3] = v[i][3]; }
    }
    __syncthreads();
    {
        const int n = tid >> 2, kc = tid & 3, ng = d.n0 + n;
        int drow = ng;
        if (d.mapkind == 1) drow = 32 * (ng >> 4) + (ng & 15);
        else if (d.mapkind == 2) drow = 32 * (ng >> 4) + 16 + (ng & 15);
        else if (d.mapkind == 3) drow = (ng >> 7) * 256 + 32 * ((ng & 127) >> 4) + (ng & 15);
        else if (d.mapkind == 4) drow = (ng >> 7) * 256 + 32 * ((ng & 127) >> 4) + 16 + (ng & 15);
        else if (d.mapkind == 5) drow = (ng & ~31) + 16 * ((ng >> 2) & 1) + 4 * ((ng >> 3) & 3) + (ng & 3);
        unsigned w[8];
#pragma unroll
        for (int j = 0; j < 8; ++j) w[j] = pk2(tl[(kc * 16 + 2 * j) * 65 + n], tl[(kc * 16 + 2 * j + 1) * 65 + n]);
        u32x4* o = (u32x4*)(d.dst + (size_t)drow * d.lddst + d.k0 + kc * 16);
        o[0] = (u32x4){w[0], w[1], w[2], w[3]};
        o[1] = (u32x4){w[4], w[5], w[6], w[7]};
    }
    __syncthreads();
}
DEV ConvDesc conv_fixed_desc(const Params& p, int it) {
    const int l = it / 1040; int r = it % 1040;
    unsigned char* ws = p.ws;
    if (r < 576) return ConvDesc{p.w_in + (size_t)l * 1024 * PROJ, (bf16_t*)(ws + OFF_WIN) + (size_t)l * PROJ * 1024, PROJ, (r / 36) * 64, (r % 36) * 64, 1024, (r % 36) * 64 < 1536 ? 5 : 0};
    r -= 576;
    if (r < 256) return ConvDesc{p.w_out + (size_t)l * 1024 * 1024, (bf16_t*)(ws + OFF_WOUT) + (size_t)l * 1024 * 1024, 1024, (r / 16) * 64, (r % 16) * 64, 1024, 5};
    r -= 256;
    if (r < 64) return ConvDesc{p.sh_w1 + (size_t)l * 1024 * 256, (bf16_t*)(ws + OFF_SW13) + (size_t)l * 512 * 1024, 256, (r / 4) * 64, (r % 4) * 64, 1024, 3};
    r -= 64;
    if (r < 64) return ConvDesc{p.sh_w3 + (size_t)l * 1024 * 256, (bf16_t*)(ws + OFF_SW13) + (size_t)l * 512 * 1024, 256, (r / 4) * 64, (r % 4) * 64, 1024, 4};
    r -= 64;
    if (r < 64) { const int kt = r / 16, hh = kt >> 1;
        return ConvDesc{p.sh_w2 + (size_t)l * 256 * 1024, (bf16_t*)(ws + OFF_SW2) + (size_t)(l * 2 + hh) * 1024 * 128 - hh * 128, 1024, kt * 64, (r % 16) * 64, 128, 5}; }
    r -= 64;
    return ConvDesc{p.router_w + (size_t)l * 1024 * 64, (bf16_t*)(ws + OFF_RW) + (size_t)l * 64 * 1024, 64, r * 64, 0, 1024, 0};
}
DEV ConvDesc conv_expert_desc(const Params& p, int l, int it) {
    const int e = it / 96; int r = it % 96;
    unsigned char* ws = p.ws;
    const size_t eo = (size_t)(l * 64 + e) * 1024 * 128;
    if (r < 32) return ConvDesc{p.exp_w1 + eo, (bf16_t*)(ws + OFF_W13) + (size_t)e * 256 * 1024, 128, (r / 2) * 64, (r % 2) * 64, 1024, 1};
    r -= 32;
    if (r < 32) return ConvDesc{p.exp_w3 + eo, (bf16_t*)(ws + OFF_W13) + (size_t)e * 256 * 1024, 128, (r / 2) * 64, (r % 2) * 64, 1024, 2};
    r -= 32;
    return ConvDesc{p.exp_w2 + eo, (bf16_t*)(ws + OFF_W2) + (size_t)e * 1024 * 128, 1024, (r / 16) * 64, (r % 16) * 64, 128, 5};
}
DEV void conv_run(const Params& p, int l, int first, int count, char* lds) {
    const int tid = get_tid();
    if (count <= 0) return;
    ConvDesc d = l < 0 ? conv_fixed_desc(p, first) : conv_expert_desc(p, l, first);
    f32x4 v[4]; conv_load(d, v, tid);
#pragma unroll 1
    for (int i = 0; i < count; ++i) {
        ConvDesc dn = d; f32x4 vn[4];
        if (i + 1 < count) { dn = l < 0 ? conv_fixed_desc(p, first + i + 1) : conv_expert_desc(p, l, first + i + 1); conv_load(dn, vn, tid); }
        else {
#pragma unroll
            for (int k = 0; k < 4; ++k) vn[k] = v[k];
        }
        conv_store(d, v, lds, tid);
        d = dn;
#pragma unroll
        for (int k = 0; k < 4; ++k) v[k] = vn[k];
    }
}
DEV void phase_prep(const Params& p, char* lds) {
    { const int t_ = get_tid(); if (blockIdx.x == 0 && t_ < 128) ((int*)(p.ws + OFF_CNT))[t_ * 64] = 0; }
    constexpr int N0 = 144, N1 = N0 + 192, N2 = N1 + 260, N3 = N2 + 768, N4 = N3 + 256;
    int* qhead = (int*)(p.ws + OFF_QUEUE) + 2 * 64;
    int* qslot = (int*)(lds + SMEM_BYTES - 256);
    for (;;) {
        __syncthreads();
        if (get_tid() == 0) *qslot = atomicAdd(qhead, 1);
        __syncthreads();
        const int it = *qslot;
        if (it >= N4) break;
        if (it < N0) prep_filter_item(p, it, lds);
        else if (it < N1) prep_mod_item(p, it - N0, lds);
        else if (it < N2) conv_run(p, -1, (it - N1) * 8, 8, lds);
        else if (it < N3) conv_run(p, 0, (it - N2) * 8, 8, lds);
        else prep_rope_item(p, it - N3);
    }
}
DEV void phase_modfin(const Params& p) {
    const float* part = (const float*)(p.ws + OFF_PART);
    float* mod = (float*)(p.ws + OFF_MOD);
    for (int idx = blockIdx.x * 256 + get_tid(); idx < 2 * 9 * 6144; idx += gridDim.x * 256) {
        const int l = idx / (9 * 6144), g = (idx / 6144) % 9, col = idx % 6144;
        float s = p.ada_b[l * 6144 + col];
        for (int k = 0; k < 32; ++k) s += part[((size_t)(k * 2 + l) * 9 + g) * 6144 + col];
        mod[idx] = s;
    }
}

DEV void row_load(const float* src, f32x4 (&v)[4], int lane) {
#pragma unroll
    for (int j = 0; j < 4; ++j) v[j] = *(const f32x4*)(src + 4 * lane + 256 * j);
}
DEV f32x4 ld_bf4(const bf16_t* p) { const u32x2 w = *(const u32x2*)p; return (f32x4){__uint_as_float(w[0] << 16), __uint_as_float(w[0] & 0xffff0000u), __uint_as_float(w[1] << 16), __uint_as_float(w[1] & 0xffff0000u)}; }
DEV void st_bf4(bf16_t* p, const f32x4& v) { *(u32x2*)p = (u32x2){pk2(v[0], v[1]), pk2(v[2], v[3])}; }
DEV void row_load_bf(const bf16_t* src, f32x4 (&v)[4], int lane) {
#pragma unroll
    for (int j = 0; j < 4; ++j) v[j] = ld_bf4(src + 4 * lane + 256 * j);
}
DEV void row_norm(f32x4 (&v)[4]) {
    float s = 0.f;
#pragma unroll
    for (int j = 0; j < 4; ++j) s += (v[j][0] + v[j][1]) + (v[j][2] + v[j][3]);
    const float mean = wave_sum(s) * (1.f / 1024.f);
    float q = 0.f;
#pragma unroll
    for (int j = 0; j < 4; ++j) { v[j] = v[j] - mean; q += (v[j][0] * v[j][0] + v[j][1] * v[j][1]) + (v[j][2] * v[j][2] + v[j][3] * v[j][3]); }
    const float rstd = __builtin_amdgcn_rsqf(wave_sum(q) * (1.f / 1024.f) + 1e-6f);
#pragma unroll
    for (int j = 0; j < 4; ++j) v[j] = v[j] * rstd;
}
DEV void row_store_mod_bf16(bf16_t* dst, const f32x4 (&v)[4], const float* shift, const float* scale, int lane) {
#pragma unroll
    for (int j = 0; j < 4; ++j) {
        const int c = 4 * lane + 256 * j;
        const f32x4 sh = *(const f32x4*)(shift + c), sc = *(const f32x4*)(scale + c);
        const f32x4 o = v[j] * (sc + 1.0f) + sh;
        *(u32x2*)(dst + c) = (u32x2){pk2(o[0], o[1]), pk2(o[2], o[3])};
    }
}
DEV void phase_lnmod0(const Params& p) {
    const int tid_ = get_tid(), lane = tid_ & 63, wid = tid_ >> 6;
    const float* mod = (const float*)(p.ws + OFF_MOD);
    bf16_t* H = (bf16_t*)(p.ws + OFF_H);
    for (int row = blockIdx.x * 4 + wid; row < NT; row += gridDim.x * 4) {
        const float* src = row < NLAT ? p.x + (size_t)row * 1024 : p.ctx + (size_t)(row - NLAT) * 1024;
        f32x4 v[4]; row_load(src, v, lane); row_norm(v);
        const float* m = mod + (size_t)mod_group(row) * 6144;
        row_store_mod_bf16(H + (size_t)row * 1024, v, m, m + 1024, lane);
    }
}

DEV void phase_inproj(const Params& p, int l, char* lds) {
    const int tid = get_tid(), lane = tid & 63, wid = tid >> 6, fr = lane & 15, fq = lane >> 4, wr = wid >> 1, wc = wid & 1;
    unsigned char* ws = p.ws;
    const bf16_t* H = (const bf16_t*)(ws + OFF_H);
    const bf16_t* W = (const bf16_t*)(ws + OFF_WIN) + (size_t)l * PROJ * 1024;
    const float* ropec = (const float*)(ws + OFF_ROPE); const float* ropes = ropec + 2048 * 32;
    const int nitems = 128 * 18 + 16 * (l == 0 ? 18 : 6);
    for (int it = blockIdx.x; it < nitems; it += gridDim.x) {
        int mt, nt;
        if (it < 2304) { mt = it / 18; nt = it % 18; }
        else { const int j = it - 2304; if (l == 0) { mt = 128 + j / 18; nt = j % 18; } else { mt = 128 + j / 6; const int q = j % 6; nt = q < 2 ? 4 + q : 6 + q; } }
        const int m0 = mt * 128, n0 = nt * 128;
        const unsigned a0 = (unsigned)m0 * 1024u + st64_off(tid), b0 = (unsigned)n0 * 1024u + st64_off(tid);
        const unsigned ao[4] = {a0, a0 + 32u * 1024u, a0 + 64u * 1024u, a0 + 96u * 1024u};
        const unsigned bo[4] = {b0, b0 + 32u * 1024u, b0 + 64u * 1024u, b0 + 96u * 1024u};
        f32x4 acc[4][4]; zero_acc<4, 4>(acc);
        const bool latent = m0 < NLAT;
        const int b = latent ? (m0 >> 11) : ((m0 - NLAT) >> 8);
        const int tbase = latent ? (m0 & 2047) : ((m0 - NLAT) & 255);
        if (nt >= 12) {
            const int rho = tid >> 3, ptok = 8 * ((rho & 15) >> 2) + 4 * (rho >> 4) + (rho & 3);
            const unsigned ap0 = (unsigned)(m0 + ptok) * 1024u + (unsigned)(((tid & 7) ^ (rho & 7)) * 8);
            const unsigned aop[4] = {ap0, ap0 + 32u * 1024u, ap0 + 64u * 1024u, ap0 + 96u * 1024u};
            gemm_core64<false>(acc, H, aop, W, bo, 1024, lds);
            bf16_t* zt = latent ? (bf16_t*)(ws + OFF_ZTL) + (size_t)b * 768 * 2048 : (bf16_t*)(ws + OFF_ZTC) + (size_t)b * 768 * 256;
            const int n = latent ? 2048 : 256;
#pragma unroll
            for (int g = 0; g < 2; ++g)
#pragma unroll
                for (int nn = 0; nn < 4; ++nn) {
                    const int ch = n0 - 1536 + wc * 64 + nn * 16 + fr, t = tbase + wr * 64 + 32 * g + 8 * fq;
                    *(u32x4*)(zt + (size_t)ch * n + t) = (u32x4){pk2(acc[2 * g][nn][0], acc[2 * g][nn][1]), pk2(acc[2 * g][nn][2], acc[2 * g][nn][3]),
                                                                 pk2(acc[2 * g + 1][nn][0], acc[2 * g + 1][nn][1]), pk2(acc[2 * g + 1][nn][2], acc[2 * g + 1][nn][3])};
                }
        } else {
            gemm_core64<true>(acc, H, ao, W, bo, 1024, lds);
            const int col0 = n0 + wc * 64;
            int kind, hh;
            if (col0 < 512) { kind = 0; hh = col0 >> 6; } else if (col0 < 640) { kind = 1; hh = (col0 - 512) >> 6; } else if (col0 < 768) { kind = 2; hh = (col0 - 640) >> 6; }
            else if (col0 < 1024) { kind = 3; hh = (col0 - 768) >> 6; } else if (col0 < 1280) { kind = 4; hh = (col0 - 1024) >> 6; } else { kind = 5; hh = (col0 - 1280) >> 6; }
            const bool normed = (kind == 0 || kind == 1);
            const float* gain = (kind == 0 ? p.q_gain : p.k_gain) + l * 64;
#pragma unroll
            for (int m = 0; m < 4; ++m) {
                const int rloc = wr * 64 + m * 16 + fr, row = m0 + rloc, t = tbase + rloc;
                f32x4 v[4];
#pragma unroll
                for (int nn = 0; nn < 4; ++nn) v[nn] = acc[m][nn];
                if (normed) {
                    float ss = 0.f;
#pragma unroll
                    for (int nn = 0; nn < 4; ++nn) ss += (v[nn][0] * v[nn][0] + v[nn][1] * v[nn][1]) + (v[nn][2] * v[nn][2] + v[nn][3] * v[nn][3]);
                    ss += __shfl_xor(ss, 16); ss += __shfl_xor(ss, 32);
                    const float r = __builtin_amdgcn_rsqf(ss * (1.f / 64.f) + 1e-6f);
#pragma unroll
                    for (int nn = 0; nn < 4; ++nn) {
                        const int hc = 32 * (nn >> 1) + 8 * fq + 4 * (nn & 1);
                        const f32x4 g = *(const f32x4*)(gain + hc);
                        v[nn] = v[nn] * r * g;
                        if (latent) {
                            const int pi = hc >> 1;
                            const float c0 = ropec[t * 32 + pi], s0 = ropes[t * 32 + pi], c1 = ropec[t * 32 + pi + 1], s1 = ropes[t * 32 + pi + 1];
                            const float x0 = v[nn][0], x1 = v[nn][1], x2 = v[nn][2], x3 = v[nn][3];
                            v[nn][0] = x0 * c0 - x1 * s0; v[nn][1] = x0 * s0 + x1 * c0;
                            v[nn][2] = x2 * c1 - x3 * s1; v[nn][3] = x2 * s1 + x3 * c1;
                        }
                    }
                }
                if (kind == 0 || kind == 3) {
#pragma unroll
                    for (int nn = 0; nn < 4; ++nn) v[nn] = v[nn] * (0.125f * LOG2E);
                }
                bf16_t* dst;
                const int key = latent ? 256 + t : t;
                if (kind == 0) dst = (bf16_t*)(ws + OFF_QA) + ((size_t)hh * NT + row) * 64;
                else if (kind == 3) dst = (bf16_t*)(ws + OFF_QB) + ((size_t)hh * NT + row) * 64;
                else if (kind == 1) dst = (bf16_t*)(ws + OFF_KA) + ((size_t)(b * 2 + hh) * KEYS + key) * 64;
                else if (kind == 2) dst = (bf16_t*)(ws + OFF_VA) + ((size_t)(b * 2 + hh) * KEYS + key) * 64;
                else if (kind == 4) dst = (bf16_t*)(ws + OFF_KB) + ((size_t)(b * 4 + hh) * KEYS + key) * 64;
                else dst = (bf16_t*)(ws + OFF_VB) + ((size_t)(b * 4 + hh) * KEYS + key) * 64;
#pragma unroll
                for (int gg = 0; gg < 2; ++gg) *(u32x4*)(dst + 32 * gg + 8 * fq) = (u32x4){pk2(v[2 * gg][0], v[2 * gg][1]), pk2(v[2 * gg][2], v[2 * gg][3]), pk2(v[2 * gg + 1][0], v[2 * gg + 1][1]), pk2(v[2 * gg + 1][2], v[2 * gg + 1][3])};
            }
        }
    }
}

template <int NQT, bool NA>
DEV void attn_block(const bf16_t* Qh, int qrow0, const bf16_t* Kh, const bf16_t* Vh, int ntiles, bf16_t* outp  ,
                    int na_r, int na_rs, int nwin, const float* rpb_h, char* lds) {
    const int tid = get_tid(), lane = tid & 63, wid = tid >> 6, fr = lane & 15, fq = lane >> 4;
    char* KBUF = lds;
    char* VBUF = lds + 16384;
    float* BIAS = (float*)(lds + 32768);
    if (NA) {
        for (int i = tid; i < 15 * 32; i += 256) { const int dr = i >> 5, dc = i & 31; BIAS[i] = dc < 31 ? rpb_h[dr * 31 + dc] * LOG2E : 0.f; }
    }
    bf16x8 qf[NQT][2];
    const int qw = qrow0 + wid * 16 * NQT;
#pragma unroll
    for (int nq = 0; nq < NQT; ++nq)
#pragma unroll
        for (int ks = 0; ks < 2; ++ks) qf[nq][ks] = *(const bf16x8*)(Qh + (size_t)(qw + nq * 16 + fr) * 64 + ks * 32 + fq * 8);
    f32x4 oacc[4][NQT], lacc[NQT];
    float mrun[NQT];
    const bf16x8 ones = (bf16x8){0x3F80, 0x3F80, 0x3F80, 0x3F80, 0x3F80, 0x3F80, 0x3F80, 0x3F80};
#pragma unroll
    for (int nq = 0; nq < NQT; ++nq) { mrun[nq] = 0.f; lacc[nq] = (f32x4){0.f, 0.f, 0.f, 0.f};
#pragma unroll
        for (int dt = 0; dt < 4; ++dt) oacc[dt][nq] = (f32x4){0.f, 0.f, 0.f, 0.f}; }
    const int lrow0 = tid >> 3, lch = tid & 7;
    auto key0_of = [&](int ti) -> int { if (NA) return ti < nwin ? 256 + (na_rs + ti) * 64 : (ti - nwin) * 64; return ti * 64; };
    u32x4 kreg[2], vreg[2];
    auto gload = [&](int ti) {
        const int k0 = key0_of(ti);
#pragma unroll
        for (int i = 0; i < 2; ++i) {
            const int row = lrow0 + 32 * i;
            kreg[i] = *(const u32x4*)(Kh + (size_t)(k0 + row) * 64 + lch * 8);
            vreg[i] = *(const u32x4*)(Vh + (size_t)(k0 + row) * 64 + lch * 8);
        }
    };
    auto lstore = [&](int buf) {
#pragma unroll
        for (int i = 0; i < 2; ++i) {
            const int row = lrow0 + 32 * i;
            const int off = buf * 8192 + row * 128 + ((lch ^ (row & 7)) * 16);
            *(u32x4*)(KBUF + off) = kreg[i];
            *(u32x4*)(VBUF + off) = vreg[i];
        }
    };
    gload(0); lstore(0);
    __syncthreads();
    for (int ti = 0; ti < ntiles; ++ti) {
        const int buf = ti & 1;
        if (ti + 1 < ntiles) gload(ti + 1);
        const char* kb = KBUF + buf * 8192; const char* vb = VBUF + buf * 8192;
        f32x4 sacc[4][NQT];
        __builtin_amdgcn_s_setprio(1);
#pragma unroll
        for (int mt = 0; mt < 4; ++mt) {
            const int row = mt * 16 + fr;
            bf16x8 kf0 = *(const bf16x8*)(kb + row * 128 + (((0 + fq) ^ (row & 7)) * 16));
            bf16x8 kf1 = *(const bf16x8*)(kb + row * 128 + (((4 + fq) ^ (row & 7)) * 16));
#pragma unroll
            for (int nq = 0; nq < NQT; ++nq) {
                f32x4 s = (f32x4){-mrun[nq], -mrun[nq], -mrun[nq], -mrun[nq]};
                s = mfma16(kf0, qf[nq][0], s);
                s = mfma16(kf1, qf[nq][1], s);
                sacc[mt][nq] = s;
            }
        }
        __builtin_amdgcn_s_setprio(0);
        bf16x8 pf[2][NQT];
#pragma unroll
        for (int nq = 0; nq < NQT; ++nq) {
            float tv[4][4];
            float tmax = -1e30f;
            if (NA && ti < nwin) {
                const int qc = (wid & 1) * 32 + nq * 16 + fr;
                int cs = qc - 8; cs = cs < 0 ? 0 : (cs > 48 ? 48 : cs);
                const int qrow = na_r + (wid >> 1);
                int rsq = qrow - 4; rsq = rsq < 0 ? 0 : (rsq > 24 ? 24 : rsq);
                const int krow = na_rs + ti;
                const bool rowok = (krow >= rsq) && (krow < rsq + 8);
                int dr = krow - qrow + 7; dr = dr < 0 ? 0 : (dr > 14 ? 14 : dr);
#pragma unroll
                for (int mt = 0; mt < 4; ++mt)
#pragma unroll
                    for (int j = 0; j < 4; ++j) {
                        const int kc = mt * 16 + 4 * fq + j;
                        const bool ok = rowok && (kc >= cs) && (kc < cs + 16);
                        int dc = kc - qc + 15; dc = dc < 0 ? 0 : (dc > 30 ? 30 : dc);
                        tv[mt][j] = ok ? sacc[mt][nq][j] + BIAS[dr * 32 + dc] : -1e30f;
                        tmax = fmaxf(tmax, tv[mt][j]);
                    }
            } else {
#pragma unroll
                for (int mt = 0; mt < 4; ++mt) {
#pragma unroll
                    for (int j = 0; j < 4; ++j) tv[mt][j] = sacc[mt][nq][j];
                    tmax = fmaxf(fmaxf(tmax, tv[mt][0]), tv[mt][1]); tmax = fmaxf(fmaxf(tmax, tv[mt][2]), tv[mt][3]);
                }
            }
            if (__any(tmax > 8.0f)) {
                tmax = fmaxf(tmax, __shfl_xor(tmax, 16)); tmax = fmaxf(tmax, __shfl_xor(tmax, 32));
                const float dlt = fmaxf(tmax, 0.f);
                const float alpha = __builtin_amdgcn_exp2f(-dlt);
                mrun[nq] += dlt;
                lacc[nq] = lacc[nq] * alpha;
#pragma unroll
                for (int dt = 0; dt < 4; ++dt) oacc[dt][nq] = oacc[dt][nq] * alpha;
#pragma unroll
                for (int mt = 0; mt < 4; ++mt)
#pragma unroll
                    for (int j = 0; j < 4; ++j) tv[mt][j] -= dlt;
            }
#pragma unroll
            for (int mt = 0; mt < 4; ++mt)
#pragma unroll
                for (int j = 0; j < 4; ++j) tv[mt][j] = __builtin_amdgcn_exp2f(tv[mt][j]);
#pragma unroll
            for (int ks = 0; ks < 2; ++ks) {
                union { bf16x8 v; unsigned u[4]; } pk;
                pk.u[0] = pk2(tv[2 * ks][0], tv[2 * ks][1]); pk.u[1] = pk2(tv[2 * ks][2], tv[2 * ks][3]);
                pk.u[2] = pk2(tv[2 * ks + 1][0], tv[2 * ks + 1][1]); pk.u[3] = pk2(tv[2 * ks + 1][2], tv[2 * ks + 1][3]);
                pf[ks][nq] = pk.v;
                lacc[nq] = mfma16(ones, pk.v, lacc[nq]);
            }
        }
        {
            const int q4 = fr >> 2, p4 = fr & 3;
#pragma unroll
            for (int ks = 0; ks < 2; ++ks)
#pragma unroll
                for (int dt = 0; dt < 4; ++dt) {
                    const int keyA = 16 * (2 * ks) + 4 * fq + q4, keyB = keyA + 16;
                    const int ch = 4 * (dt >> 1) + p4;
                    const int offA = keyA * 128 + ((ch ^ (keyA & 7)) * 16) + (dt & 1) * 8;
                    const int offB = keyB * 128 + ((ch ^ (keyB & 7)) * 16) + (dt & 1) * 8;
                    const s16x4 ta = __builtin_amdgcn_ds_read_tr16_b64_v4i16((LDSP(s16x4))(vb + offA));
                    const s16x4 tb = __builtin_amdgcn_ds_read_tr16_b64_v4i16((LDSP(s16x4))(vb + offB));
                    bf16x8 vf; vf[0] = ta[0]; vf[1] = ta[1]; vf[2] = ta[2]; vf[3] = ta[3]; vf[4] = tb[0]; vf[5] = tb[1]; vf[6] = tb[2]; vf[7] = tb[3];
#pragma unroll
                    for (int nq = 0; nq < NQT; ++nq) oacc[dt][nq] = mfma16(vf, pf[ks][nq], oacc[dt][nq]);
                }
        }
        if (ti + 1 < ntiles) lstore(buf ^ 1);
        __syncthreads();
    }
#pragma unroll
    for (int nq = 0; nq < NQT; ++nq) {
        const float inv = __builtin_amdgcn_rcpf(lacc[nq][0]);
        bf16_t* o = outp + (size_t)(qw + nq * 16 + fr) * 1024;
#pragma unroll
        for (int g = 0; g < 2; ++g) {
            const f32x4 v0 = oacc[2 * g][nq] * inv, v1 = oacc[2 * g + 1][nq] * inv;
            *(u32x4*)(o + g * 32 + 8 * fq) = (u32x4){pk2(v0[0], v0[1]), pk2(v0[2], v0[3]), pk2(v1[0], v1[1]), pk2(v1[2], v1[3])};
        }
    }
    __syncthreads();
}

DEV float hy_sconv(const bf16_t* zrow, int t, int n, float w0, float w1, float w2, float bias) {
    const float zm = t > 0 ? bf2f(zrow[t - 1]) : 0.f, z0 = bf2f(zrow[t]), zp = t + 1 < n ? bf2f(zrow[t + 1]) : 0.f;
    return w0 * zm + w1 * z0 + w2 * zp + bias;
}
template <int NJ>
DEV void hyena_item(const Params& p, int l, int type, int c, int bh, char* lds) {
    constexpr int n = 256 * NJ;
    const int tid = get_tid();
    f32x4* U = (f32x4*)lds;
    float* KR = (float*)(lds + n * 16);
    const bf16_t* zt = type ? (const bf16_t*)(p.ws + OFF_ZTC) : (const bf16_t*)(p.ws + OFF_ZTL);
    const bf16_t* kf = (const bf16_t*)(p.ws + (type ? OFF_KERNC + (size_t)l * 2 * 256 * 256 * 2 : OFF_KERNL + (size_t)l * 2 * 256 * 2048 * 2)) + (size_t)c * n;
    const bf16_t* kb = kf + (size_t)256 * n;
    const float* cw = p.hy_conv_w + l * 3 * 768; const float* cb = p.hy_conv_b + l * 768;
    const float w10 = cw[256 + c], w11 = cw[768 + 256 + c], w12 = cw[1536 + 256 + c], b1 = cb[256 + c];
    const float wv0 = cw[512 + c], wv1 = cw[768 + 512 + c], wv2 = cw[1536 + 512 + c], bv = cb[512 + c];
    const float w00 = cw[c], w01 = cw[768 + c], w02 = cw[1536 + c], b0 = cb[c];
    for (int i = tid; i < 2 * n - 1; i += 256) { const int d = i - (n - 1); KR[i] = bf2f(d >= 0 ? kf[d] : kb[-d]); }
    for (int s = tid; s < n; s += 256) {
        f32x4 u;
#pragma unroll
        for (int bb = 0; bb < 4; ++bb) {
            const bf16_t* zb = zt + (size_t)(bh * 4 + bb) * 768 * n;
            const float x1 = hy_sconv(zb + (size_t)(256 + c) * n, s, n, w10, w11, w12, b1);
            const float vv = hy_sconv(zb + (size_t)(512 + c) * n, s, n, wv0, wv1, wv2, bv);
            u[bb] = vv * x1;
        }
        U[s] = u;
    }
    __syncthreads();
    f32x4 acc[NJ];
#pragma unroll
    for (int j = 0; j < NJ; ++j) acc[j] = (f32x4){0.f, 0.f, 0.f, 0.f};
    const float* kp = KR + tid + (n - 1);
    for (int s = 0; s < n; ++s) {
        const f32x4 u = U[s];
#pragma unroll
        for (int j = 0; j < NJ; ++j) acc[j] += u * kp[256 * j - s];
    }
    bf16_t* ox = (bf16_t*)(p.ws + OFF_OX);
#pragma unroll
    for (int j = 0; j < NJ; ++j) {
        const int t = tid + 256 * j;
#pragma unroll
        for (int bb = 0; bb < 4; ++bb) {
            const int b = bh * 4 + bb;
            const bf16_t* zb = zt + (size_t)b * 768 * n;
            const float x0 = hy_sconv(zb + (size_t)c * n, t, n, w00, w01, w02, b0);
            const float y = acc[j][bb] * x0;
            const int row = type ? NLAT + b * 256 + t : b * 2048 + t;
            ox[(size_t)row * 1024 + 768 + c] = (bf16_t)f2bf(y);
        }
    }
    __syncthreads();
}


typedef float f32x16 __attribute__((ext_vector_type(16)));
constexpr int HY_UROW = 2256;
constexpr int HY_KC_OFF = 8 * HY_UROW * 2;
constexpr int HY_KC_STRIDE = 8192 + 64;
DEV float hy_sc8(const bf16_t* zrow, int s0, int n, float w0, float w1, float w2, float bias, float (&o)[8]) {
    const u32x4 v = *(const u32x4*)(zrow + s0);
    const float zm = s0 > 0 ? bf2f(zrow[s0 - 1]) : 0.f, zp = s0 + 8 < n ? bf2f(zrow[s0 + 8]) : 0.f;
    float z[10]; z[0] = zm; z[9] = zp;
#pragma unroll
    for (int i = 0; i < 4; ++i) { z[1 + 2 * i] = __uint_as_float(v[i] << 16); z[2 + 2 * i] = __uint_as_float(v[i] & 0xffff0000u); }
#pragma unroll
    for (int i = 0; i < 8; ++i) o[i] = w0 * z[i] + w1 * z[i + 1] + w2 * z[i + 2] + bias;
    return 0.f;
}
DEV void hyena_mfma_item(const Params& p, int l, int c, char* lds) {
    const int tid = get_tid(), lane = tid & 63, wid = tid >> 6;
    constexpr int n = 2048;
    const bf16_t* zt = (const bf16_t*)(p.ws + OFF_ZTL);
    const bf16_t* kf = (const bf16_t*)(p.ws + OFF_KERNL + (size_t)l * 2 * 256 * 2048 * 2) + (size_t)c * n;
    const bf16_t* kb = kf + (size_t)256 * n;
    const float* cw = p.hy_conv_w + l * 3 * 768; const float* cb = p.hy_conv_b + l * 768;
    const float w10 = cw[256 + c], w11 = cw[768 + 256 + c], w12 = cw[1536 + 256 + c], b1 = cb[256 + c];
    const float wv0 = cw[512 + c], wv1 = cw[768 + 512 + c], wv2 = cw[1536 + 512 + c], bv = cb[512 + c];
    const float w00 = cw[c], w01 = cw[768 + c], w02 = cw[1536 + c], b0 = cb[c];
    for (int i = tid; i < 8 * 26; i += 256) {
        const int b = i / 26, k = i % 26;
        const int sp = k < 12 ? k * 8 : 96 + 2048 + (k - 12) * 8;
        *(u32x4*)(lds + (b * HY_UROW + sp) * 2) = (u32x4){0u, 0u, 0u, 0u};
    }
#pragma unroll 4
    for (int ch = tid; ch < 8 * 256; ch += 256) {
        const int b = ch >> 8, s0 = (ch & 255) * 8;
        const bf16_t* zb = zt + (size_t)b * 768 * n;
        float x1[8], vv[8];
        hy_sc8(zb + (size_t)(256 + c) * n, s0, n, w10, w11, w12, b1, x1);
        hy_sc8(zb + (size_t)(512 + c) * n, s0, n, wv0, wv1, wv2, bv, vv);
        *(u32x4*)(lds + (b * HY_UROW + 96 + s0) * 2) = (u32x4){pk2(vv[0] * x1[0], vv[1] * x1[1]), pk2(vv[2] * x1[2], vv[3] * x1[3]), pk2(vv[4] * x1[4], vv[5] * x1[5]), pk2(vv[6] * x1[6], vv[7] * x1[7])};
    }
    {
        char* R0 = lds + HY_KC_OFF;
#pragma unroll
        for (int j = 0; j < 2; ++j) {
            const int chn = tid + 256 * j;
            const bool fwd = chn < 256; const int d0 = (chn & 255) * 8;
            const u32x4 v = *(const u32x4*)((fwd ? kf : kb) + d0);
#pragma unroll
            for (int e = 0; e < 8; ++e) {
                const int d = d0 + e;
                const bf16_t val = (bf16_t)((e & 1) ? (v[e >> 1] >> 16) : (v[e >> 1] & 0xffffu));
                const int y = fwd ? 2047 - d : 2047 + d;
                if (fwd || d > 0) *(bf16_t*)(R0 + y * 2) = val;
            }
        }
        if (tid == 0) *(bf16_t*)(R0 + 4095 * 2) = 0;
    }
    __syncthreads();
    {
        const char* R0 = lds + HY_KC_OFF;
        for (int i = tid; i < 3 * 1024; i += 256) {
            const int q = 1 + i / 1024, y = (i % 1024) * 4;
            unsigned short e[4];
#pragma unroll
            for (int k = 0; k < 4; ++k) { const int yy = y + q + k; e[k] = yy <= 4094 ? *(const bf16_t*)(R0 + yy * 2) : (bf16_t)0; }
            *(u32x2*)(lds + HY_KC_OFF + q * HY_KC_STRIDE + y * 2) = (u32x2){(unsigned)e[0] | ((unsigned)e[1] << 16), (unsigned)e[2] | ((unsigned)e[3] << 16)};
        }
    }
    __syncthreads();
    const int i32 = lane & 31, h = lane >> 5, qn = i32 >> 3, bn = i32 & 7;
    const int T0 = 512 * wid;
    f32x16 acc[4];
#pragma unroll
    for (int g = 0; g < 4; ++g)
#pragma unroll
        for (int r = 0; r < 16; ++r) acc[g][r] = 0.f;
    const int dlo = T0 - 2032, dhi = T0 + 384 + 96;
    {
        const int a0 = 2047 - dlo - i32 + 8 * h, q4 = a0 & 3;
        const char* ap = lds + HY_KC_OFF + q4 * HY_KC_STRIDE + (a0 - q4) * 2;
        const char* bp = lds + (bn * HY_UROW + 96 + (T0 - dlo) + 32 * qn + 8 * h) * 2;
        for (int dl = dlo; dl <= dhi; dl += 16) {
            union { bf16x8 v; u32x2 u[2]; } af;
            af.u[0] = *(const u32x2*)ap; af.u[1] = *(const u32x2*)(ap + 8);
#pragma unroll
            for (int g = 0; g < 4; ++g) {
                const int S = T0 + 128 * g - dl;
                if (S >= -96 && S <= 2032) {
                    const bf16x8 bfv = *(const bf16x8*)(bp + 256 * g);
                    acc[g] = __builtin_amdgcn_mfma_f32_32x32x16_bf16(af.v, bfv, acc[g], 0, 0, 0);
                }
            }
            ap -= 32; bp -= 32;
        }
    }
    __syncthreads();
#pragma unroll 4
    for (int ch = tid; ch < 8 * 256; ch += 256) {
        const int b = ch >> 8, s0 = (ch & 255) * 8;
        float x0[8];
        hy_sc8(zt + (size_t)b * 768 * n + (size_t)c * n, s0, n, w00, w01, w02, b0, x0);
        *(u32x4*)(lds + HY_KC_OFF + (b * 2048 + s0) * 2) = (u32x4){pk2(x0[0], x0[1]), pk2(x0[2], x0[3]), pk2(x0[4], x0[5]), pk2(x0[6], x0[7])};
    }
    __syncthreads();
    bf16_t* oxt = (bf16_t*)(p.ws + OFF_OXT) + (size_t)c * 2048;
#pragma unroll
    for (int g = 0; g < 4; ++g)
#pragma unroll
        for (int r4 = 0; r4 < 4; ++r4) {
            const int t = T0 + 128 * g + 32 * qn + 8 * r4 + 4 * h;
            const u32x2 xg = *(const u32x2*)(lds + HY_KC_OFF + (bn * 2048 + t) * 2);
            const float g0 = __uint_as_float(xg[0] << 16), g1 = __uint_as_float(xg[0] & 0xffff0000u), g2 = __uint_as_float(xg[1] << 16), g3 = __uint_as_float(xg[1] & 0xffff0000u);
            *(u32x2*)(oxt + (size_t)bn * 256 * 2048 + t) = (u32x2){pk2(acc[g][4 * r4 + 0] * g0, acc[g][4 * r4 + 1] * g1), pk2(acc[g][4 * r4 + 2] * g2, acc[g][4 * r4 + 3] * g3)};
        }
    __syncthreads();
}

DEV void phase_mix(const Params& p, int l, char* lds) {
    unsigned char* ws = p.ws;
    const bf16_t* QA = (const bf16_t*)(ws + OFF_QA); const bf16_t* QB = (const bf16_t*)(ws + OFF_QB);
    const bf16_t* KA = (const bf16_t*)(ws + OFF_KA); const bf16_t* VA = (const bf16_t*)(ws + OFF_VA);
    const bf16_t* KBp = (const bf16_t*)(ws + OFF_KB); const bf16_t* VBp = (const bf16_t*)(ws + OFF_VB);
    bf16_t* OX = (bf16_t*)(ws + OFF_OX);
    const int N0 = 256, N1 = N0 + 1024, N2 = N1 + 512;
    const int N3 = N2 + (l == 0 ? 512 : 0), N4 = N3 + (l == 0 ? 128 : 0), N5 = N4 + (l == 0 ? 64 : 0);
    int* qhead = (int*)(p.ws + OFF_QUEUE) + l * 64;
    int* qslot = (int*)(lds + SMEM_BYTES - 256);
    for (;;) {
        __syncthreads();
        if (get_tid() == 0) *qslot = atomicAdd(qhead, 1);
        __syncthreads();
        const int it = *qslot;
        if (it >= N5) break;
        if (it < N0) { hyena_mfma_item(p, l, it, lds); }
        else if (it < N1) {
            const int j = it - N0, b = j >> 7, h = (j >> 4) & 7, qb = j & 15;
            attn_block<2, false>(QA + (size_t)h * NT * 64, b * 2048 + qb * 128, KA + (size_t)(b * 2 + (h >> 2)) * KEYS * 64, VA + (size_t)(b * 2 + (h >> 2)) * KEYS * 64,
                                 36, OX + h * 64, 0, 0, 0, nullptr, lds);
        } else if (it < N2) {
            const int j = it - N1, b = j >> 6, h = (j >> 4) & 3, r = (j & 15) * 2;
            int rs0 = r - 4; rs0 = rs0 < 0 ? 0 : (rs0 > 24 ? 24 : rs0);
            int rs1 = r - 3; rs1 = rs1 < 0 ? 0 : (rs1 > 24 ? 24 : rs1);
            const int nwin = rs1 + 8 - rs0;
            attn_block<2, true>(QB + (size_t)h * NT * 64, b * 2048 + r * 64, KBp + (size_t)(b * 4 + h) * KEYS * 64, VBp + (size_t)(b * 4 + h) * KEYS * 64,
                                nwin + 4, OX + 512 + h * 64, r, rs0, nwin, p.nat_rpb + (size_t)(l * 4 + h) * 15 * 31, lds);
        } else if (it < N3) { const int j = it - N2; hyena_item<1>(p, l, 1, j >> 1, j & 1, lds); }
        else if (it < N4) {
            const int j = it - N3, b = j >> 4, h = (j >> 1) & 7, qb = j & 1;
            attn_block<2, false>(QA + (size_t)h * NT * 64, NLAT + b * 256 + qb * 128, KA + (size_t)(b * 2 + (h >> 2)) * KEYS * 64, VA + (size_t)(b * 2 + (h >> 2)) * KEYS * 64,
                                 4, OX + h * 64, 0, 0, 0, nullptr, lds);
        } else {
            const int j = it - N4, b = j >> 3, h = (j >> 1) & 3, qb = j & 1;
            attn_block<2, false>(QB + (size_t)h * NT * 64, NLAT + b * 256 + qb * 128, KBp + (size_t)(b * 4 + h) * KEYS * 64, VBp + (size_t)(b * 4 + h) * KEYS * 64,
                                 4, OX + 512 + h * 64, 0, 0, 0, nullptr, lds);
        }
    }
}

DEV void phase_outproj(const Params& p, int l, char* lds) {
    const int tid = get_tid(), lane = tid & 63, wid = tid >> 6, fr = lane & 15, fq = lane >> 4, wr = wid >> 1, wc = wid & 1;
    const bf16_t* OX = (const bf16_t*)(p.ws + OFF_OX);
    const bf16_t* W = (const bf16_t*)(p.ws + OFF_WOUT) + (size_t)l * 1024 * 1024;
    const float* mod = (const float*)(p.ws + OFF_MOD) + (size_t)l * 9 * 6144;
    bf16_t* X = (bf16_t*)(p.ws + OFF_X);
    const int nitems = (l == 0 ? 144 : 128) * 8;
    for (int it = blockIdx.x; it < nitems; it += gridDim.x) {
        const int mt = it >> 3, nt = it & 7, m0 = mt * 128, n0 = nt * 128;
        const unsigned a0 = (unsigned)m0 * 1024u + st64_off(tid), b0 = (unsigned)n0 * 1024u + st64_off(tid);
        f32x4 acc[4][4]; zero_acc<4, 4>(acc);
        const unsigned ao[4] = {a0, a0 + 32u * 1024u, a0 + 64u * 1024u, a0 + 96u * 1024u};
        const unsigned bo[4] = {b0, b0 + 32u * 1024u, b0 + 64u * 1024u, b0 + 96u * 1024u};
        gemm_core64<true>(acc, OX, ao, W, bo, 1024, lds, (const bf16_t*)(p.ws + OFF_OXT) + (size_t)((m0 >> 11) & 7) * 256 * 2048 + (m0 & 2047), m0 < NLAT ? 12 : 16);
        const float* g1 = mod + (size_t)mod_group(m0) * 6144 + 2048;
#pragma unroll
        for (int m = 0; m < 4; ++m) {
            const int row = m0 + wr * 64 + m * 16 + fr;
            const float* xin = row < NLAT ? p.x + (size_t)row * 1024 : p.ctx + (size_t)(row - NLAT) * 1024;
#pragma unroll
            for (int gg = 0; gg < 2; ++gg) {
                const int col = n0 + wc * 64 + gg * 32 + 8 * fq;
                f32x4 x0, x1;
                if (l == 0) { x0 = *(const f32x4*)(xin + col); x1 = *(const f32x4*)(xin + col + 4); }
                else { const u32x4 w = *(const u32x4*)(X + (size_t)row * 1024 + col);
                       x0 = (f32x4){__uint_as_float(w[0] << 16), __uint_as_float(w[0] & 0xffff0000u), __uint_as_float(w[1] << 16), __uint_as_float(w[1] & 0xffff0000u)};
                       x1 = (f32x4){__uint_as_float(w[2] << 16), __uint_as_float(w[2] & 0xffff0000u), __uint_as_float(w[3] << 16), __uint_as_float(w[3] & 0xffff0000u)}; }
                const f32x4 o0 = x0 * DN_ALPHA + *(const f32x4*)(g1 + col) * acc[m][2 * gg], o1 = x1 * DN_ALPHA + *(const f32x4*)(g1 + col + 4) * acc[m][2 * gg + 1];
                *(u32x4*)(X + (size_t)row * 1024 + col) = (u32x4){pk2(o0[0], o0[1]), pk2(o0[2], o0[3]), pk2(o1[0], o1[1]), pk2(o1[2], o1[3])};
            }
        }
    }
}

DEV void phase_ln1route(const Params& p, int l, char* lds) {
    const int tid = get_tid(), lane = tid & 63, wid = tid >> 6, fr = lane & 15, fq = lane >> 4;
    bf16_t* X = (bf16_t*)(p.ws + OFF_X);
    bf16_t* H = (bf16_t*)(p.ws + OFF_H);
    const bf16_t* RW = (const bf16_t*)(p.ws + OFF_RW) + (size_t)l * 64 * 1024;
    const float* mod = (const float*)(p.ws + OFF_MOD) + (size_t)l * 9 * 6144;
    int* cnt = (int*)(p.ws + OFF_CNT) + l * 64 * 64;
    int* tke = (int*)(p.ws + OFF_TKE); int* tks = (int*)(p.ws + OFF_TKS); float* tkw = (float*)(p.ws + OFF_TKW);
    int* list = (int*)(p.ws + OFF_LIST);
    char* HT = lds;
    float* LG = (float*)(lds + 16 * 2064);
    const float rbias = p.router_b[l * 64 + lane];
    const int rpw = (l == 0) ? 3 : 4, rpi = 4 * rpw;
    const int nitems = (l == 0 ? NT : NLAT) / rpi;
    u32x2 raw[4][4];
    f32x4 msh[4], msc[4];
    float* LNG = (float*)(lds + 50176);
    for (int i = tid; i < 512; i += 256) {
        const int c = (i & 255) * 4;
        *(f32x4*)(LNG + (i >> 8) * 1024 + c) = *(const f32x4*)((i >> 8 ? p.ln1_b : p.ln1_g) + l * 1024 + c);
    }
    if ((int)blockIdx.x < nitems) {
#pragma unroll
        for (int i = 0; i < 4; ++i) if (i < rpw)
#pragma unroll
            for (int j = 0; j < 4; ++j) raw[i][j] = *(const u32x2*)(X + (size_t)((int)blockIdx.x * rpi + wid * rpw + i) * 1024 + 4 * lane + 256 * j);
        const float* mg = mod + (size_t)mod_group((int)blockIdx.x * rpi + wid * rpw) * 6144;
#pragma unroll
        for (int j = 0; j < 4; ++j) { const int c = 4 * lane + 256 * j; msh[j] = *(const f32x4*)(mg + 3072 + c); msc[j] = *(const f32x4*)(mg + 4096 + c); }
    }
    __syncthreads();
    for (int it = blockIdx.x; it < nitems; it += gridDim.x) {
        const int m0 = it * rpi;
        const int g0 = mod_group(m0 + wid * rpw);
        f32x4 vv[4][4];
#pragma unroll
        for (int i = 0; i < 4; ++i) if (i < rpw)
#pragma unroll
            for (int j = 0; j < 4; ++j) { const u32x2 w = raw[i][j]; vv[i][j] = (f32x4){__uint_as_float(w[0] << 16), __uint_as_float(w[0] & 0xffff0000u), __uint_as_float(w[1] << 16), __uint_as_float(w[1] & 0xffff0000u)}; }
#pragma unroll
        for (int i = 0; i < 4; ++i) if (i < rpw) {
            const int rl = wid * rpw + i, row = m0 + rl;
            if (mod_group(row) != g0) {
                const float* mg = mod + (size_t)mod_group(row) * 6144;
#pragma unroll
                for (int j = 0; j < 4; ++j) { const int c = 4 * lane + 256 * j; msh[j] = *(const f32x4*)(mg + 3072 + c); msc[j] = *(const f32x4*)(mg + 4096 + c); }
            }
            row_norm(vv[i]);
#pragma unroll
            for (int j = 0; j < 4; ++j) {
                const int c = 4 * lane + 256 * j;
                vv[i][j] = vv[i][j] * *(const f32x4*)(LNG + c) + *(const f32x4*)(LNG + 1024 + c);
                st_bf4(X + (size_t)row * 1024 + c, vv[i][j]);
            }
            row_norm(vv[i]);
#pragma unroll
            for (int j = 0; j < 4; ++j) {
                const int c = 4 * lane + 256 * j;
                const f32x4 o = vv[i][j] * (msc[j] + 1.0f) + msh[j];
                const u32x2 w = (u32x2){pk2(o[0], o[1]), pk2(o[2], o[3])};
                *(u32x2*)(H + (size_t)row * 1024 + c) = w;
                *(u32x2*)(HT + rl * 2064 + c * 2) = w;
            }
        }
        f32x4 acc = (f32x4){0.f, 0.f, 0.f, 0.f};
        const bf16_t* bp = RW + (size_t)(wid * 16 + fr) * 1024 + fq * 8;
        bf16x8 bq[16];
#pragma unroll
        for (int ks = 0; ks < 16; ++ks) bq[ks] = *(const bf16x8*)(bp + ks * 32);
        __syncthreads();
#pragma unroll
        for (int ks = 0; ks < 16; ++ks) {
            const bf16x8 af = *(const bf16x8*)(HT + fr * 2064 + (ks * 32 + fq * 8) * 2);
            acc = mfma16(bq[ks], af, acc);
            bq[ks] = *(const bf16x8*)(bp + (ks + 16) * 32);
        }
#pragma unroll
        for (int ks = 0; ks < 16; ++ks) {
            const bf16x8 af = *(const bf16x8*)(HT + fr * 2064 + ((ks + 16) * 32 + fq * 8) * 2);
            acc = mfma16(bq[ks], af, acc);
        }
        *(f32x4*)(LG + fr * 64 + wid * 16 + 4 * fq) = acc;
        if (it + (int)gridDim.x < nitems) {
#pragma unroll
            for (int i = 0; i < 4; ++i) if (i < rpw)
#pragma unroll
                for (int j = 0; j < 4; ++j) raw[i][j] = *(const u32x2*)(X + (size_t)(m0 + (int)gridDim.x * rpi + wid * rpw + i) * 1024 + 4 * lane + 256 * j);
            const float* mg = mod + (size_t)mod_group(m0 + (int)gridDim.x * rpi + wid * rpw) * 6144;
#pragma unroll
            for (int j = 0; j < 4; ++j) { const int c = 4 * lane + 256 * j; msh[j] = *(const f32x4*)(mg + 3072 + c); msc[j] = *(const f32x4*)(mg + 4096 + c); }
        }
        __syncthreads();
        int* RS = (int*)(lds + 16 * 2064 + 4096 + 2048);
        float* RWt = (float*)(lds + 16 * 2064 + 4096 + 2048 + 4096);
        int lc = 0;
        unsigned* KW = (unsigned*)(lds + 16 * 2064 + 4096 + 2048 + 8192) + wid * 160;
#pragma unroll 1
        for (int i = 0; i < rpw; ++i) {
            const int rl = wid * rpw + i;
            const float sc = __builtin_amdgcn_rcpf(1.0f + __expf(-LG[rl * 64 + lane]));
            const float sel = sc + rbias;
            const int grp = lane >> 3;
            const unsigned key = (__float_as_uint(sel + 2.0f) & 0xFFFFFFC0u) | (unsigned)(63 - lane);
            KW[lane] = key;
            __builtin_amdgcn_wave_barrier();
            int rankg = 0;
            {
                const u32x4 k0 = *(const u32x4*)(KW + grp * 8), k1 = *(const u32x4*)(KW + grp * 8 + 4);
#pragma unroll
                for (int j = 0; j < 4; ++j) { rankg += (k0[j] > key) ? 1 : 0; rankg += (k1[j] > key) ? 1 : 0; }
            }
            float gs = rankg < 2 ? sel : 0.f;
            gs += __shfl_xor(gs, 1); gs += __shfl_xor(gs, 2); gs += __shfl_xor(gs, 4);
            const unsigned gkey = (__float_as_uint(gs + 4.0f) & 0xFFFFFFF8u) | (unsigned)(7 - grp);
            if ((lane & 7) == 0) KW[128 + grp] = gkey;
            __builtin_amdgcn_wave_barrier();
            int rg = 0;
            {
                const u32x4 g0 = *(const u32x4*)(KW + 128), g1 = *(const u32x4*)(KW + 132);
#pragma unroll
                for (int j = 0; j < 4; ++j) { rg += (g0[j] > gkey) ? 1 : 0; rg += (g1[j] > gkey) ? 1 : 0; }
            }
            const bool selg = rg < 4;
            const unsigned vkey = selg ? key : 0u;
            KW[64 + lane] = vkey;
            __builtin_amdgcn_wave_barrier();
            int rank = 0;
#pragma unroll
            for (int q = 0; q < 16; ++q) {
                const u32x4 kk = *(const u32x4*)(KW + 64 + q * 4);
#pragma unroll
                for (int j = 0; j < 4; ++j) rank += (kk[j] > vkey) ? 1 : 0;
            }
            const bool ch = selg && rank < 8;
            const float wsum = wave_sum(ch ? sc : 0.f);
            RS[rl * 64 + lane] = ch ? rank : -1;
            RWt[rl * 64 + lane] = sc * (2.5f * __builtin_amdgcn_rcpf(wsum));
            lc += ch ? 1 : 0;
            __builtin_amdgcn_wave_barrier();
        }
        int* WC = (int*)(lds + 16 * 2064 + 4096);
        WC[wid * 64 + lane] = lc;
        __syncthreads();
        if (wid == 0) {
            const int tot = WC[lane] + WC[64 + lane] + WC[128 + lane] + WC[192 + lane];
            int base = 0;
            if (tot > 0) base = atomicAdd(&cnt[lane * 64], tot);
            WC[256 + lane] = base;
        }
        __syncthreads();
        {
            int slot = WC[256 + lane];
#pragma unroll
            for (int w2 = 0; w2 < 4; ++w2) slot += (w2 < wid) ? WC[w2 * 64 + lane] : 0;
#pragma unroll 1
            for (int i = 0; i < rpw; ++i) {
                const int rl = wid * rpw + i, rk = RS[rl * 64 + lane];
                if (rk >= 0) {
                    const int row = m0 + rl;
                    list[(size_t)lane * NT + slot] = row * 8 + rk;
                    tke[row * 8 + rk] = lane; tks[row * 8 + rk] = slot; tkw[row * 8 + rk] = RWt[rl * 64 + lane];
                    ++slot;
                }
            }
        }
        __syncthreads();
    }
}

constexpr int YS_EXT_ROWS = NLAT * 1024 * 4 / 1024;
constexpr int PLAN_OFF = 68 * 1024;
DEV void moe_plan(const int* cnt, int cap, int l, char* lds) {
    int* PL = (int*)(lds + PLAN_OFF);
    const int tid = get_tid();
    __syncthreads();
    if (tid < 64) {
        const int lane = tid;
        const int c = cnt[lane * 64], tiles = (c + 127) >> 7;
        int pr = c, pt = tiles;
#pragma unroll
        for (int o = 1; o < 64; o <<= 1) { const int a = __shfl_up(pr, o), b = __shfl_up(pt, o); if (lane >= o) { pr += a; pt += b; } }
        const int G = (int)gridDim.x, nshu = 2 * ((l == 0 ? NT : NLAT) / 128);
        const int units = nshu + __builtin_amdgcn_readlane(pt, 63);
        const int cap8 = cap * 2;
        const bool one_round = __builtin_amdgcn_readlane(pr, 63) + nshu * 128 <= cap8;
        const int target0 = one_round ? 0 : ((units + G - 1) / G - 1) * G;
        PL[144 + lane] = c;
        int start = 0, base_r = 0, base_t = 0, round = 0;
        for (;;) {
            const int lim = (round == 0) ? ((target0 > 0) ? cap8 + YS_EXT_ROWS : cap8) - nshu * 128 : cap8;
            const bool bad = (lane >= start) && ((pr - base_r > lim) || (round == 0 && target0 > 0 && lane > 0 && nshu + pt > target0));
            const unsigned long long m = __ballot(bad);
            int end = m ? (int)__builtin_ctzll(m) : 64;
            if (end <= start) end = start + 1;
            if (lane >= start && lane < end) { PL[16 + lane] = pt - tiles - base_t; PL[80 + lane] = pr - c - base_r; }
            if (lane == 0) { PL[1 + round] = start; PL[10 + round] = __builtin_amdgcn_readlane(pt, end - 1) - base_t; PL[208 + round] = __builtin_amdgcn_readlane(pr, end - 1) - base_r; }
            if (end >= 64 || round >= 7) { if (lane == 0) { PL[0] = round + 1; PL[2 + round] = 64; } break; }
            base_r = __builtin_amdgcn_readlane(pr, end - 1); base_t = __builtin_amdgcn_readlane(pt, end - 1);
            start = end; ++round;
        }
    }
    __syncthreads();
}
constexpr float YS_SCALE = 32.0f, YS_INV = 1.0f / 32.0f;
DEV unsigned char* ys_row(const Params& p, int idx) {
    const int cap8 = p.cap * 2;
    return idx < cap8 ? p.ws + OFF_YS + (size_t)idx * 1024 : (unsigned char*)p.out + (size_t)(idx - cap8) * 1024;
}
DEV unsigned pk4_fp8(const f32x4& v) {
    int w = 0;
    w = __builtin_amdgcn_cvt_pk_fp8_f32(v[0] * YS_SCALE, v[1] * YS_SCALE, w, false);
    w = __builtin_amdgcn_cvt_pk_fp8_f32(v[2] * YS_SCALE, v[3] * YS_SCALE, w, true);
    return (unsigned)w;
}
DEV f32x4 up4_fp8(unsigned w) {
    const f32x2 lo = __builtin_amdgcn_cvt_pk_f32_fp8((int)w, false), hi = __builtin_amdgcn_cvt_pk_f32_fp8((int)w, true);
    return (f32x4){lo[0], lo[1], hi[0], hi[1]};
}

DEV void gemm_up256(f32x4 (&acc)[4][8], const bf16_t* A, const unsigned (&ao)[2], const bf16_t* B, const unsigned (&bo)[4], char* lds) {
    const int tid = get_tid(), lane = tid & 63, wid = tid >> 6, fr = lane & 15, fq = lane >> 4, wr = wid >> 1, wc = wid & 1;
    auto stage = [&](int s_, int t) {
        char* SA = lds + s_ * 24576; char* SB = SA + 8192;
#pragma unroll
        for (int i = 0; i < 2; ++i) glds16(A + (ao[i] + (unsigned)(t * 32)), SA + i * 4096 + tid * 16);
#pragma unroll
        for (int i = 0; i < 4; ++i) glds16(B + (bo[i] + (unsigned)(t * 32)), SB + i * 4096 + tid * 16);
    };
    WAIT_VM(0);
    stage(0, 0);
    stage(1, 1);
    const int aoff = (wr * 64 + fr) * 64 + fq * 16, boff = 8192 + (wc * 128 + fr) * 64 + fq * 16;
#pragma unroll 1
    for (int t = 0; t < 32; ++t) {
        if (t + 1 < 32) WAIT_VM(6); else WAIT_VM(0);
        RAW_BARRIER();
        const char* S = lds + (t & 1) * 24576;
        bf16x8 af[4], bfr[8];
#pragma unroll
        for (int m = 0; m < 4; ++m) af[m] = *(const bf16x8*)(S + aoff + m * 1024);
#pragma unroll
        for (int n = 0; n < 8; ++n) bfr[n] = *(const bf16x8*)(S + boff + n * 1024);
        WAIT_LGKM0();
        RAW_BARRIER();
        if (t + 2 < 32) stage(t & 1, t + 2);
        __builtin_amdgcn_s_setprio(1);
#pragma unroll
        for (int m = 0; m < 4; ++m)
#pragma unroll
            for (int n = 0; n < 8; ++n) acc[m][n] = mfma16(bfr[n], af[m], acc[m][n]);
        __builtin_amdgcn_s_setprio(0);
    }
}
template <bool SHARED>
DEV void moe_tile(const Params& p, const bf16_t* W13, const bf16_t* W2, const int* list, int s0, int nvalid, int ysbase, int m0, int half, const float* g2, char* lds) {
    const int tid = get_tid(), lane = tid & 63, wid = tid >> 6, fr = lane & 15, fq = lane >> 4, wr = wid >> 1, wc = wid & 1;
    const bf16_t* H = (const bf16_t*)(p.ws + OFF_H);
    const float* tkw = (const float*)(p.ws + OFF_TKW);
    char* ACT = lds;
    const unsigned ch4 = (unsigned)((tid & 3) * 8);
    unsigned ao[2];
    float gw[4];
    if (SHARED) {
#pragma unroll
        for (int i = 0; i < 2; ++i) ao[i] = (unsigned)(m0 + i * 64 + (tid >> 2)) * 1024u + ch4;
#pragma unroll
        for (int m = 0; m < 4; ++m) gw[m] = 1.0f;
    } else {
#pragma unroll
        for (int i = 0; i < 2; ++i) { const int rr = min(i * 64 + (tid >> 2), nvalid - 1); ao[i] = (unsigned)(list[s0 + rr] >> 3) * 1024u + ch4; }
#pragma unroll
        for (int m = 0; m < 4; ++m) { const int rl = min(wr * 64 + m * 16 + fr, nvalid - 1); gw[m] = tkw[list[s0 + rl]]; }
    }
    {
        const unsigned b0 = (unsigned)(tid >> 2) * 1024u + ch4;
        const unsigned bo[4] = {b0, b0 + 64u * 1024u, b0 + 128u * 1024u, b0 + 192u * 1024u};
        f32x4 acc[4][8];
#pragma unroll
        for (int m = 0; m < 4; ++m)
#pragma unroll
            for (int n = 0; n < 8; ++n) acc[m][n] = (f32x4){0.f, 0.f, 0.f, 0.f};
        gemm_up256(acc, H, ao, W13, bo, lds);
        __syncthreads();
#pragma unroll
        for (int m = 0; m < 4; ++m)
#pragma unroll
            for (int pp = 0; pp < 4; ++pp) {
                float o[4];
#pragma unroll
                for (int j = 0; j < 4; ++j) { const float a = acc[m][2 * pp][j], b = acc[m][2 * pp + 1][j]; o[j] = a * __builtin_amdgcn_rcpf(1.0f + __expf(-a)) * b * gw[m]; }
                *(u32x2*)(ACT + (wr * 64 + m * 16 + fr) * 272 + (wc * 64 + pp * 16 + 4 * fq) * 2) = (u32x2){pk2(o[0], o[1]), pk2(o[2], o[3])};
            }
    }
    __syncthreads();
    if (SHARED) {
        gemm2_stream64<128, 272>(W2, ACT, lds + 36864, [&](int nt, const f32x4 (&acc)[4][4]) {
#pragma unroll
            for (int m = 0; m < 4; ++m) {
                unsigned char* o = ys_row(p, ysbase + m0 + wr * 64 + m * 16 + fr) + nt * 128 + wc * 64 + 8 * fq;
#pragma unroll
                for (int g = 0; g < 2; ++g) *(u32x2*)(o + g * 32) = (u32x2){pk4_fp8(acc[m][2 * g]), pk4_fp8(acc[m][2 * g + 1])};
            }
        });
    } else {
        gemm2_stream64<128, 272>(W2, ACT, lds + 36864, [&](int nt, const f32x4 (&acc)[4][4]) {
#pragma unroll
            for (int m = 0; m < 4; ++m) {
                const int rl = wr * 64 + m * 16 + fr;
                if (rl < nvalid) {
                    unsigned char* o = ys_row(p, ysbase + s0 + rl) + nt * 128 + wc * 64 + 8 * fq;
#pragma unroll
                    for (int g = 0; g < 2; ++g) *(u32x2*)(o + g * 32) = (u32x2){pk4_fp8(acc[m][2 * g]), pk4_fp8(acc[m][2 * g + 1])};
                }
            }
        });
    }
    __syncthreads();
}
DEV void phase_moe(const Params& p, int l, int r, char* lds) {
    const int* cnt = (const int*)(p.ws + OFF_CNT) + l * 64 * 64;
    moe_plan(cnt, p.cap, l, lds);
    const int* PL = (const int*)(lds + PLAN_OFF);
    if (r >= PL[0]) return;
    const int e_lo = PL[1 + r], e_hi = PL[2 + r];
    const int nrt = PL[10 + r];
    const int nrows = (l == 0) ? NT : NLAT;
    const int nshu = (r == 0) ? 2 * (nrows / 128) : 0;
    const int G = (int)gridDim.x, b = vblock();
    const int q = (nshu + nrt + G - 1) / G;
    const int u0 = b * q, u1 = min(u0 + q, nshu + nrt);
    int e = e_lo;
    for (int u = u0; u < u1; ++u) {
        if (u < nshu) {
            const int m0 = (u >> 1) * 128, hh = u & 1;
            moe_tile<true>(p, (const bf16_t*)(p.ws + OFF_SW13) + (size_t)(l * 2 + hh) * 256 * 1024, (const bf16_t*)(p.ws + OFF_SW2) + (size_t)(l * 2 + hh) * 1024 * 128,
                           nullptr, 0, 128, PL[208] + hh * nrows, m0, hh, nullptr, lds);
        } else {
            const int it = u - nshu;
            while (e + 1 < e_hi && PL[16 + e + 1] <= it) ++e;
            const int s0 = (it - PL[16 + e]) * 128;
            moe_tile<false>(p, (const bf16_t*)(p.ws + OFF_W13) + (size_t)e * 256 * 1024, (const bf16_t*)(p.ws + OFF_W2) + (size_t)e * 1024 * 128,
                            (const int*)(p.ws + OFF_LIST) + (size_t)e * NT, s0, min(128, PL[144 + e] - s0), PL[80 + e], 0, 0, nullptr, lds);
        }
    }
}

DEV void phase_comb(const Params& p, int l, int r, char* lds) {
    const int tid_ = get_tid(), lane = tid_ & 63, wid = tid_ >> 6;
    const int* cnt = (const int*)(p.ws + OFF_CNT) + l * 64 * 64;
    moe_plan(cnt, p.cap, l, lds);
    const int* PL = (const int*)(lds + PLAN_OFF);
    if (r >= PL[0]) return;
    const int e_lo = PL[1 + r], e_hi = PL[2 + r];
    const bool final = (r == PL[0] - 1);
    bf16_t* X = (bf16_t*)(p.ws + OFF_X);
    bf16_t* H = (bf16_t*)(p.ws + OFF_H);
    const int* tke = (const int*)(p.ws + OFF_TKE); const int* tks = (const int*)(p.ws + OFF_TKS);
    const float* mod = (const float*)(p.ws + OFF_MOD);
    const int nrows = (l == 0) ? NT : NLAT;
    const int rstep = (int)gridDim.x * 4;
    auto issue = [&](int rw, int e, int sl, u32x4 (&yy)[10], u32x4& xa_, u32x4& xb_) {
        int idx_l = -1;
        if (lane < 8 && e >= e_lo && e < e_hi) idx_l = PL[80 + e] + sl;
        xa_ = *(const u32x4*)(X + (size_t)rw * 1024 + 16 * lane); xb_ = *(const u32x4*)(X + (size_t)rw * 1024 + 16 * lane + 8);
#pragma unroll
        for (int k = 0; k < 8; ++k) {
            const int idx = __builtin_amdgcn_readlane(idx_l, k);
            if (idx >= 0) yy[k] = *(const u32x4*)(ys_row(p, idx) + 16 * lane); else yy[k] = (u32x4){0u, 0u, 0u, 0u};
        }
        if (r == 0) { yy[8] = *(const u32x4*)(ys_row(p, PL[208] + rw) + 16 * lane); yy[9] = *(const u32x4*)(ys_row(p, PL[208] + nrows + rw) + 16 * lane); }
        else { yy[8] = (u32x4){0u, 0u, 0u, 0u}; yy[9] = yy[8]; }
    };
    int row = blockIdx.x * 4 + wid, rown = row + rstep;
    int e_n = 0, sl_n = 0;
    u32x4 y[10], xa, xb;
    if (row < nrows) {
        if (lane < 8) { e_n = tke[row * 8 + lane]; sl_n = tks[row * 8 + lane]; }
        issue(row, e_n, sl_n, y, xa, xb);
        if (rown < nrows && lane < 8) { e_n = tke[rown * 8 + lane]; sl_n = tks[rown * 8 + lane]; }
    }
    for (; row < nrows; row = rown, rown += rstep) {
        u32x4 y2[10], xa2, xb2;
        if (rown < nrows) {
            issue(rown, e_n, sl_n, y2, xa2, xb2);
            const int r3 = rown + rstep;
            if (r3 < nrows && lane < 8) { e_n = tke[r3 * 8 + lane]; sl_n = tks[r3 * 8 + lane]; }
        } else {
#pragma unroll
            for (int k = 0; k < 10; ++k) y2[k] = (u32x4){0u, 0u, 0u, 0u};
            xa2 = y2[0]; xb2 = y2[0];
        }
        const int g = mod_group(row);
        const float* g2 = mod + ((size_t)l * 9 + g) * 6144 + 5120 + 16 * lane;
        f32x4 v[4];
        {
            const u32x4 a = xa, b2 = xb;
            v[0] = (f32x4){__uint_as_float(a[0] << 16), __uint_as_float(a[0] & 0xffff0000u), __uint_as_float(a[1] << 16), __uint_as_float(a[1] & 0xffff0000u)};
            v[1] = (f32x4){__uint_as_float(a[2] << 16), __uint_as_float(a[2] & 0xffff0000u), __uint_as_float(a[3] << 16), __uint_as_float(a[3] & 0xffff0000u)};
            v[2] = (f32x4){__uint_as_float(b2[0] << 16), __uint_as_float(b2[0] & 0xffff0000u), __uint_as_float(b2[1] << 16), __uint_as_float(b2[1] & 0xffff0000u)};
            v[3] = (f32x4){__uint_as_float(b2[2] << 16), __uint_as_float(b2[2] & 0xffff0000u), __uint_as_float(b2[3] << 16), __uint_as_float(b2[3] & 0xffff0000u)};
        }
        f32x4 s[4];
#pragma unroll
        for (int j = 0; j < 4; ++j) s[j] = (f32x4){0.f, 0.f, 0.f, 0.f};
#pragma unroll
        for (int k = 0; k < 10; ++k)
#pragma unroll
            for (int j = 0; j < 4; ++j) s[j] += up4_fp8(y[k][j]);
        const float xs = (r == 0) ? DN_ALPHA : 1.0f;
#pragma unroll
        for (int j = 0; j < 4; ++j) v[j] = v[j] * xs + *(const f32x4*)(g2 + 4 * j) * (s[j] * YS_INV);
        if (!final) {
            u32x4 o0, o1;
            o0 = (u32x4){pk2(v[0][0], v[0][1]), pk2(v[0][2], v[0][3]), pk2(v[1][0], v[1][1]), pk2(v[1][2], v[1][3])};
            o1 = (u32x4){pk2(v[2][0], v[2][1]), pk2(v[2][2], v[2][3]), pk2(v[3][0], v[3][1]), pk2(v[3][2], v[3][3])};
            *(u32x4*)(X + (size_t)row * 1024 + 16 * lane) = o0; *(u32x4*)(X + (size_t)row * 1024 + 16 * lane + 8) = o1;
        } else {
            row_norm(v);
#pragma unroll
            for (int j = 0; j < 4; ++j) {
                const int c = 16 * lane + 4 * j;
                v[j] = v[j] * *(const f32x4*)(p.ln2_g + l * 1024 + c) + *(const f32x4*)(p.ln2_b + l * 1024 + c);
                if (l != 0) *(f32x4*)(p.out + (size_t)row * 1024 + c) = v[j];
            }
            if (l == 0) {
                u32x4 o0, o1;
                o0 = (u32x4){pk2(v[0][0], v[0][1]), pk2(v[0][2], v[0][3]), pk2(v[1][0], v[1][1]), pk2(v[1][2], v[1][3])};
                o1 = (u32x4){pk2(v[2][0], v[2][1]), pk2(v[2][2], v[2][3]), pk2(v[3][0], v[3][1]), pk2(v[3][2], v[3][3])};
                *(u32x4*)(X + (size_t)row * 1024 + 16 * lane) = o0; *(u32x4*)(X + (size_t)row * 1024 + 16 * lane + 8) = o1;
                row_norm(v);
                const float* m1 = mod + ((size_t)9 + g) * 6144 + 16 * lane;
                f32x4 h[4];
#pragma unroll
                for (int j = 0; j < 4; ++j) h[j] = v[j] * (*(const f32x4*)(m1 + 1024 + 4 * j) + 1.0f) + *(const f32x4*)(m1 + 4 * j);
                o0 = (u32x4){pk2(h[0][0], h[0][1]), pk2(h[0][2], h[0][3]), pk2(h[1][0], h[1][1]), pk2(h[1][2], h[1][3])};
                o1 = (u32x4){pk2(h[2][0], h[2][1]), pk2(h[2][2], h[2][3]), pk2(h[3][0], h[3][1]), pk2(h[3][2], h[3][3])};
                *(u32x4*)(H + (size_t)row * 1024 + 16 * lane) = o0; *(u32x4*)(H + (size_t)row * 1024 + 16 * lane + 8) = o1;
            }
        }
#pragma unroll
        for (int k = 0; k < 10; ++k) y[k] = y2[k];
        xa = xa2; xb = xb2;
    }
    if (final && l == 0) {
        __syncthreads();
        conv_run(p, 1, (int)blockIdx.x * 12, 12, lds);
    }
}


#define XB_TMO      128
#define XB_XCNT(j)  (256  + 64 * (j))
#define XB_XSUB(j)  (1280 + 64 * (j))
#define XB_XGEN(j)  (2304 + 64 * (j))
#define XB_TOP      3328
#define XB_TOPGEN   3392
#define XCD_BAR_WORDS 3456
#define XB_SPIN_CAP (1u << 22)
DEV unsigned xb_ld(unsigned* p) { return __hip_atomic_load(p, __ATOMIC_RELAXED, __HIP_MEMORY_SCOPE_AGENT); }
DEV unsigned xb_add(unsigned* p, unsigned v) { return __hip_atomic_fetch_add(p, v, __ATOMIC_RELAXED, __HIP_MEMORY_SCOPE_AGENT); }
DEV unsigned xb_xcc_id() { return (unsigned)__builtin_amdgcn_s_getreg((3 << 11) | 20) & 0xFu; }
#define XB_SPIN(cond, bar) do { unsigned _sp = 0; while (cond) { __builtin_amdgcn_s_sleep(1); \
    if ((++_sp & 255u) == 0u) { if (xb_ld(&(bar)[XB_TMO])) break; if (_sp > XB_SPIN_CAP) { atomicAdd(&(bar)[XB_TMO], 1u); break; } } } } while (0)
struct XcdBarrier { unsigned* bar; unsigned x; volatile LAS unsigned* st; };
DEV XcdBarrier xcd_barrier_post(unsigned* bar, volatile LAS unsigned* st) {
    XcdBarrier b; b.bar = bar; b.x = xb_xcc_id(); b.st = st;
    if (threadIdx.x == 0) (void)xb_add(&bar[XB_XCNT(b.x)], 1u);
    return b;
}
DEV void xcd_barrier_complete(unsigned* bar, unsigned x, unsigned& nloc, unsigned& nx) {
    const unsigned G = gridDim.x * gridDim.y * gridDim.z;
    unsigned sum, cnt, mine, sp = 0u;
    for (;;) {
        sum = 0u; cnt = 0u; mine = 0u;
#pragma unroll
        for (unsigned j = 0; j < 16; ++j) { const unsigned c = xb_ld(&bar[XB_XCNT(j)]); sum += c; cnt += (c > 0u) ? 1u : 0u; mine = (j == x) ? c : mine; }
        if (sum == G) break;
        __builtin_amdgcn_s_sleep(1);
        if ((++sp & 255u) == 0u) { if (xb_ld(&bar[XB_TMO])) break; if (sp > XB_SPIN_CAP) { atomicAdd(&bar[XB_TMO], 1u); break; } }
    }
    nloc = mine > 0u ? mine : 1u; nx = cnt > 0u ? cnt : 1u;
}
DEV void xcd_barrier(const XcdBarrier& b) {
    asm volatile("s_waitcnt vmcnt(0)" ::: "memory");
    __syncthreads();
    if (get_tid() == 0) {
        unsigned* bar = b.bar; asm volatile("" : "+s"(bar));
        __builtin_amdgcn_s_waitcnt(0);
        unsigned nloc = b.st[0], nx = b.st[1];
        if (nloc == 0u) { xcd_barrier_complete(bar, b.x, nloc, nx); b.st[0] = nloc; b.st[1] = nx; }
        const unsigned old = xb_add(&bar[XB_XSUB(b.x)], 1u);
        const unsigned gen = old / nloc;
        if (old + 1u == (gen + 1u) * nloc) {
            __builtin_amdgcn_fence(__ATOMIC_RELEASE, "agent");
            asm volatile("s_waitcnt vmcnt(0)" ::: "memory");
            const unsigned og = xb_add(&bar[XB_TOP], 1u);
            const unsigned tg = og / nx;
            if (og + 1u == (tg + 1u) * nx) xb_add(&bar[XB_TOPGEN], 1u);
            else XB_SPIN(xb_ld(&bar[XB_TOPGEN]) == tg, bar);
            __builtin_amdgcn_fence(__ATOMIC_ACQUIRE, "agent");
            xb_add(&bar[XB_XGEN(b.x)], 1u);
            asm volatile("s_waitcnt vmcnt(0)" ::: "memory");
        } else {
            XB_SPIN(xb_ld(&bar[XB_XGEN(b.x)]) == gen, bar);
            __builtin_amdgcn_fence(__ATOMIC_ACQUIRE, "agent");
            asm volatile("s_waitcnt vmcnt(0)" ::: "memory");
        }
    }
    __syncthreads();
}

enum { PT_PREP = 0, PT_MODFIN, PT_LNMOD0, PT_INPROJ, PT_MIX, PT_OUTPROJ, PT_LN1ROUTE, PT_MOE, PT_COMB };

DEV void run_phase(const Params& pin, int type, int l, int r, char* lds) {
    Params p = pin;
    { unsigned char* w = p.ws; asm volatile("" : "+s"(w)); p.ws = w; }
    switch (type) {
        case PT_PREP: phase_prep(p, lds); break;
        case PT_MODFIN: phase_modfin(p); break;
        case PT_LNMOD0: phase_lnmod0(p); break;
        case PT_INPROJ: phase_inproj(p, l, lds); break;
        case PT_MIX: phase_mix(p, l, lds); break;
        case PT_OUTPROJ: phase_outproj(p, l, lds); break;
        case PT_LN1ROUTE: phase_ln1route(p, l, lds); break;
        case PT_MOE: phase_moe(p, l, r, lds); break;
        default: phase_comb(p, l, r, lds); break;
    }
}

__global__ void __launch_bounds__(256, 2) fwd_kernel(Params p) {
    __shared__ __attribute__((aligned(16))) char smem[SMEM_BYTES];
#if MULTI_LAUNCH
    run_phase(p, p.ptype, p.pl, p.pr, smem);
#else
    if (threadIdx.x < 4) ((volatile LAS unsigned*)(smem + SMEM_BYTES - 16))[threadIdx.x] = 0u;
    __syncthreads();
    const XcdBarrier bar = xcd_barrier_post((unsigned*)(p.ws + OFF_BAR), (volatile LAS unsigned*)(smem + SMEM_BYTES - 16));
    int type = PT_PREP, l = 0, r = 0;
#if TELEM
    volatile LAS unsigned* tacc = (volatile LAS unsigned*)(smem + SMEM_BYTES - 128);
    if (threadIdx.x < 16) tacc[threadIdx.x] = 0u;
    unsigned long long t_prev = __builtin_amdgcn_s_memrealtime();
#endif
    for (;;) {
        run_phase(p, type, l, r, smem);
#if TELEM
        { const int ptype_done = type;
          xcd_barrier(bar);
          const unsigned long long t_now = __builtin_amdgcn_s_memrealtime();
          if (threadIdx.x == 0) tacc[ptype_done] += (unsigned)(t_now - t_prev);
          t_prev = t_now; }
#endif
        if (type < PT_MOE) { ++type; if (type == PT_MODFIN) ++type; r = 0; }
        else if (type == PT_MOE) type = PT_COMB;
        else {
            const int nr = ((const int*)(smem + PLAN_OFF))[0];
            if (r + 1 < nr) { ++r; type = PT_MOE; }
            else { if (l == 1) break; l = 1; r = 0; type = PT_INPROJ; }
        }
#if !TELEM
        xcd_barrier(bar);
#endif
    }
#if TELEM
    {
        unsigned* tel = (unsigned*)(p.ws + 36864);
        if (blockIdx.x == 0 && threadIdx.x == 0) { unsigned sa = 0u; for (int i = 0; i < 16; ++i) if ((TELEM_A >> i) & 1) sa += tacc[i]; tacc[15] = sa; }
        xcd_barrier(bar);
        if (blockIdx.x == 0 && threadIdx.x == 0) {
            p.out[0] += 1.0f + (float)tacc[TELEM_C] * 0.01f * 0.02f;
            const unsigned long long t0 = __builtin_amdgcn_s_memrealtime();
            const unsigned long long wait = 2ull * tacc[15];
            while (__builtin_amdgcn_s_memrealtime() - t0 < wait) __builtin_amdgcn_s_sleep(8);
        }
    }
#endif
#endif
}

extern "C" void kernel_launch(void* const* d_in, const int* in_sizes, int n_in, void* d_out, int out_size, void* d_ws, size_t ws_size, hipStream_t stream) {
    Params p{};
    const float** pp = (const float**)&p;
    for (int i = 0; i < 32; ++i) pp[i] = (const float*)d_in[i];
    p.out = (float*)d_out; p.ws = (unsigned char*)d_ws;
    long long cap = ((long long)ws_size - (long long)OFF_R) / 2048;
    if (cap > NT * 8) cap = NT * 8;
    if (cap * 2048 < (long long)R_MIN_BYTES || cap < NT) { fprintf(stderr, "kernel_launch: workspace too small (%zu)\n", ws_size); return; }
    p.cap = (int)cap;
#if MULTI_LAUNCH
    const int grid = 512;
    auto launch = [&](int type, int l, int r) { Params q = p; q.mode = 1; q.ptype = type; q.pl = l; q.pr = r; hipLaunchKernelGGL(fwd_kernel, dim3(grid), dim3(256), 0, stream, q); };
    launch(PT_PREP, 0, 0); launch(PT_MODFIN, 0, 0); launch(PT_LNMOD0, 0, 0);
    for (int l = 0; l < 2; ++l) {
        launch(PT_INPROJ, l, 0); launch(PT_MIX, l, 0); launch(PT_OUTPROJ, l, 0); launch(PT_LN1ROUTE, l, 0);
        for (int r = 0; r < RMAX; ++r) { launch(PT_MOE, l, r); launch(PT_COMB, l, r); }
    }
#else
    static int grid_blocks = 0;
    if (!grid_blocks) {
        int dev = 0, cus = 0, per_cu = 0;
        hipGetDevice(&dev);
        hipDeviceGetAttribute(&cus, hipDeviceAttributeMultiprocessorCount, dev);
        hipOccupancyMaxActiveBlocksPerMultiprocessor(&per_cu, fwd_kernel, 256, 0);
        if (per_cu > 2) per_cu = 2;
        if (per_cu < 1) per_cu = 1;
        grid_blocks = cus * per_cu;
    }
    p.mode = 0;
    hipMemsetAsync(d_ws, 0, 65536, stream);
    hipLaunchKernelGGL(fwd_kernel, dim3(grid_blocks), dim3(256), 0, stream, p);
#endif
}
```

```cpp
#include <hip/hip_runtime.h>
#ifndef TELEM
#define TELEM 0
#endif
#define TELEM_A 0x1
#define TELEM_C 8
#include <hip/hip_cooperative_groups.h>
#include <stdint.h>
#include <stdio.h>
namespace cg = cooperative_groups;

#ifndef MULTI_LAUNCH
#define MULTI_LAUNCH 0
#endif

typedef unsigned short bf16_t;
typedef short bf16x8 __attribute__((ext_vector_type(8)));
typedef short s16x4 __attribute__((ext_vector_type(4)));
typedef float f32x4 __attribute__((ext_vector_type(4)));
typedef unsigned u32x4 __attribute__((ext_vector_type(4)));
typedef unsigned u32x2 __attribute__((ext_vector_type(2)));
#define DEV __device__ __forceinline__
#define LDSP(T) __attribute__((address_space(3))) T*
#define LAS __attribute__((address_space(3)))

constexpr int D = 1024, NB = 8, SEQ = 2048, CTX = 256, NLAT = NB * SEQ, NCTX = NB * CTX, NT = NLAT + NCTX;
constexpr int PROJ = 2304, KEYS = CTX + SEQ, NEXP = 64;
constexpr float DN_ALPHA = 1.41421356237309515f;
constexpr float LOG2E = 1.44269504088896341f;
constexpr int SMEM_BYTES = 72 * 1024;
constexpr int RMAX = 4;

constexpr size_t OFF_CNT = 0;
constexpr size_t OFF_QUEUE = 33792;
constexpr size_t OFF_BAR = 40960;
constexpr size_t OFF_MOD = 65536;
constexpr size_t OFF_ROPE = OFF_MOD + 442368;
constexpr size_t OFF_KERNL = OFF_ROPE + 2ull * 2048 * 32 * 4;
constexpr size_t OFF_KERNC = OFF_KERNL + 2ull * 4096 * 256 * 4;
constexpr size_t OFF_TKE = OFF_KERNC + 2ull * 512 * 256 * 4;
constexpr size_t OFF_TKS = OFF_TKE + (size_t)NT * 8 * 4;
constexpr size_t OFF_TKW = OFF_TKS + (size_t)NT * 8 * 4;
constexpr size_t OFF_LIST = OFF_TKW + (size_t)NT * 8 * 4;
constexpr size_t OFF_WIN = OFF_LIST + 64ull * NT * 4;
constexpr size_t OFF_WOUT = OFF_WIN + 2ull * 2304 * 1024 * 2;
constexpr size_t OFF_SW13 = OFF_WOUT + 2ull * 1024 * 1024 * 2;
constexpr size_t OFF_SW2 = OFF_SW13 + 2ull * 512 * 1024 * 2;
constexpr size_t OFF_RW = OFF_SW2 + 2ull * 1024 * 256 * 2;
constexpr size_t OFF_W13 = OFF_RW + 2ull * 64 * 1024 * 2;
constexpr size_t OFF_W2 = OFF_W13 + 64ull * 256 * 1024 * 2;
constexpr size_t OFF_X = OFF_W2 + 64ull * 1024 * 128 * 2;
constexpr size_t OFF_H = OFF_X + (size_t)NT * 1024 * 2;
constexpr size_t OFF_R = OFF_H + (size_t)NT * 1024 * 2;
constexpr size_t OFF_QA = OFF_R;
constexpr size_t OFF_QB = OFF_QA + 8ull * NT * 64 * 2;
constexpr size_t OFF_KA = OFF_QB + 4ull * NT * 64 * 2;
constexpr size_t OFF_VA = OFF_KA + 8ull * 2 * KEYS * 64 * 2;
constexpr size_t OFF_KB = OFF_VA + 8ull * 2 * KEYS * 64 * 2;
constexpr size_t OFF_VB = OFF_KB + 8ull * 4 * KEYS * 64 * 2;
constexpr size_t OFF_ZTL = OFF_VB + 8ull * 4 * KEYS * 64 * 2;
constexpr size_t OFF_ZTC = OFF_ZTL + 8ull * 768 * 2048 * 2;
constexpr size_t OFF_OX = OFF_ZTC + 8ull * 768 * 256 * 2;
constexpr size_t OFF_OXT = OFF_OX + (size_t)NT * 1024 * 2;
constexpr size_t R_MIN_BYTES = OFF_OXT + 8ull * 256 * 2048 * 2 - OFF_R;
constexpr size_t OFF_PART = OFF_R;
constexpr size_t OFF_YS = OFF_R;

struct Params {
    const float *x, *c, *ctx, *c_ctx, *ada_w, *ada_b, *w_in, *q_gain, *k_gain, *nat_rpb, *hy_conv_w, *hy_conv_b,
        *hy_f_w1, *hy_f_b1, *hy_f_w2, *hy_f_b2, *hy_f_w3, *hy_freq, *hy_skip, *w_out, *ln1_g, *ln1_b,
        *router_w, *router_b, *exp_w1, *exp_w3, *exp_w2, *sh_w1, *sh_w3, *sh_w2, *ln2_g, *ln2_b;
    float* out; unsigned char* ws;
    int cap, mode, ptype, pl, pr, pad;
};

typedef __bf16 hwbf2 __attribute__((ext_vector_type(2)));
typedef float f32x2 __attribute__((ext_vector_type(2)));
DEV unsigned f2bf(float f) { return (unsigned)__builtin_bit_cast(unsigned short, (__bf16)f); }
DEV unsigned pk2(float lo, float hi) { const f32x2 v = {lo, hi}; return __builtin_bit_cast(unsigned, __builtin_convertvector(v, hwbf2)); }
DEV float bf2f(unsigned short h) { return __uint_as_float(((unsigned)h) << 16); }
DEV float wave_sum(float v) {
#pragma unroll
    for (int o = 32; o > 0; o >>= 1) v += __shfl_xor(v, o);
    return v;
}
DEV void glds16(const void* g, void* l) { __builtin_amdgcn_global_load_lds((const unsigned*)g, (unsigned*)l, 16, 0, 0); }
DEV f32x4 mfma16(bf16x8 a, bf16x8 b, f32x4 c) { return __builtin_amdgcn_mfma_f32_16x16x32_bf16(a, b, c, 0, 0, 0); }
DEV float readlane_f(float v, int l) { return __uint_as_float((unsigned)__builtin_amdgcn_readlane((int)__float_as_uint(v), l)); }
DEV int get_tid() { int t = threadIdx.x; asm volatile("" : "+v"(t)); return t; }
DEV int lchunk(int tid) { return (tid & 3) ^ ((0 - (tid >> 4)) & 3); }
DEV int vblock() { const int G = (int)gridDim.x, b = (int)blockIdx.x; return (G & 7) ? b : (b & 7) * (G >> 3) + (b >> 3); }
DEV int mod_group(int row) { return row < NLAT ? (row >> 11) : 8; }

template <int MI, int NI> DEV void zero_acc(f32x4 (&acc)[MI][NI]) {
#pragma unroll
    for (int m = 0; m < MI; ++m)
#pragma unroll
        for (int n = 0; n < NI; ++n) acc[m][n] = (f32x4){0.f, 0.f, 0.f, 0.f};
}
#define WAIT_VM(n) asm volatile("s_waitcnt vmcnt(" #n ")" ::: "memory")
#define WAIT_LGKM0() asm volatile("s_waitcnt lgkmcnt(0)" ::: "memory")
#define RAW_BARRIER() do { asm volatile("" ::: "memory"); __builtin_amdgcn_s_barrier(); asm volatile("" ::: "memory"); } while (0)
template <int MI, int NI, bool TRANS>
DEV void gemm_core(f32x4 (&acc)[MI][NI], const bf16_t* A, const unsigned (&ao)[MI / 2], const bf16_t* B, const unsigned (&bo)[NI / 2], int K, char* lds) {
    const int tid = get_tid(), lane = tid & 63, wid = tid >> 6, fr = lane & 15, fq = lane >> 4, wr = wid >> 1, wc = wid & 1;
    constexpr int SAB = 2048 * MI, STG = 2048 * (MI + NI), LPT = MI / 2 + NI / 2;
    static_assert(LPT == 3 || LPT == 4 || LPT == 6, "loads per tile");
    const int nt = K >> 5;
    auto stage = [&](int s, int t) {
        char* SA = lds + s * STG; char* SB = SA + SAB;
#pragma unroll
        for (int i = 0; i < MI / 2; ++i) glds16(A + (ao[i] + (unsigned)(t * 32)), SA + i * 4096 + tid * 16);
#pragma unroll
        for (int i = 0; i < NI / 2; ++i) glds16(B + (bo[i] + (unsigned)(t * 32)), SB + i * 4096 + tid * 16);
    };
    WAIT_VM(0);
    stage(0, 0);
    if (nt > 1) stage(1, 1);
    const int sw = (fq ^ ((0 - (fr >> 2)) & 3)) * 16;
    const int aoff = (wr * MI * 16 + fr) * 64 + sw, boff = SAB + (wc * NI * 16 + fr) * 64 + sw;
#pragma unroll 1
    for (int t = 0; t < nt; ++t) {
        if (t + 1 < nt) { if (LPT == 6) WAIT_VM(6); else if (LPT == 4) WAIT_VM(4); else WAIT_VM(3); } else WAIT_VM(0);
        RAW_BARRIER();
        const char* S = lds + (t & 1) * STG;
        bf16x8 af[MI], bfr[NI];
#pragma unroll
        for (int m = 0; m < MI; ++m) af[m] = *(const bf16x8*)(S + aoff + m * 1024);
#pragma unroll
        for (int n = 0; n < NI; ++n) bfr[n] = *(const bf16x8*)(S + boff + n * 1024);
        WAIT_LGKM0();
        RAW_BARRIER();
        if (t + 2 < nt) stage(t & 1, t + 2);
#pragma unroll
        for (int m = 0; m < MI; ++m)
#pragma unroll
            for (int n = 0; n < NI; ++n) acc[m][n] = TRANS ? mfma16(bfr[n], af[m], acc[m][n]) : mfma16(af[m], bfr[n], acc[m][n]);
    }
}
DEV unsigned st64_off(int tid) { return (unsigned)(tid >> 3) * 1024u + (unsigned)(((tid & 7) ^ ((tid >> 3) & 7)) * 8); }
DEV int tr_key(int row) { return (row & 3) | (((row >> 3) & 1) << 2); }
template <bool TRANS>
DEV void gemm_core64(f32x4 (&acc)[4][4], const bf16_t* A, const unsigned (&ao)[4], const bf16_t* B, const unsigned (&bo)[4], int K, char* lds,
                     const bf16_t* AT = nullptr, int t_tr = 1 << 20) {
    const int tid = get_tid(), lane = tid & 63, wid = tid >> 6, fr = lane & 15, fq = lane >> 4, wr = wid >> 1, wc = wid & 1;
    const int nt = K >> 6;
    auto stage = [&](int s, int t) {
        char* SA = lds + s * 32768; char* SB = SA + 16384;
        if (t >= t_tr) {
#pragma unroll
            for (int i = 0; i < 4; ++i) {
                const int id = tid + 256 * i, row = id >> 4, cp = id & 15, c = (cp - 2 * tr_key(row)) & 15;
                glds16(AT + (size_t)((t - t_tr) * 64 + row) * 2048 + c * 8, SA + id * 16);
            }
        } else {
#pragma unroll
            for (int i = 0; i < 4; ++i) glds16(A + (ao[i] + (unsigned)(t * 64)), SA + i * 4096 + tid * 16);
        }
#pragma unroll
        for (int i = 0; i < 4; ++i) glds16(B + (bo[i] + (unsigned)(t * 64)), SB + i * 4096 + tid * 16);
    };
    WAIT_VM(0);
    stage(0, 0);
    if (nt > 1) stage(1, 1);
    const int rsw = fr & 7;
    const int arow = (wr * 64 + fr) * 128, brow = 16384 + (wc * 64 + fr) * 128;
    const int c0 = ((fq) ^ rsw) * 16, c1 = ((4 + fq) ^ rsw) * 16;
#pragma unroll 1
    for (int t = 0; t < nt; ++t) {
        if (t + 1 < nt) WAIT_VM(8); else WAIT_VM(0);
        RAW_BARRIER();
        const char* S = lds + (t & 1) * 32768;
        bf16x8 af[4][2], bfr[4][2];
        if (t >= t_tr) {
            const int q4 = fr >> 2, p4 = fr & 3;
#pragma unroll
            for (int m = 0; m < 4; ++m)
#pragma unroll
                for (int ks = 0; ks < 2; ++ks) {
                    const int rowA = ks * 32 + 8 * fq + q4, rowB = rowA + 4, c = wr * 8 + m * 2 + (p4 >> 1);
                    const int offA = rowA * 256 + (((c + 2 * tr_key(rowA)) & 15) * 16) + (p4 & 1) * 8;
                    const int offB = rowB * 256 + (((c + 2 * tr_key(rowB)) & 15) * 16) + (p4 & 1) * 8;
                    const s16x4 ta = __builtin_amdgcn_ds_read_tr16_b64_v4i16((LDSP(s16x4))(S + offA));
                    const s16x4 tb = __builtin_amdgcn_ds_read_tr16_b64_v4i16((LDSP(s16x4))(S + offB));
                    bf16x8 f; f[0] = ta[0]; f[1] = ta[1]; f[2] = ta[2]; f[3] = ta[3]; f[4] = tb[0]; f[5] = tb[1]; f[6] = tb[2]; f[7] = tb[3];
                    af[m][ks] = f;
                }
        } else {
#pragma unroll
            for (int m = 0; m < 4; ++m) { af[m][0] = *(const bf16x8*)(S + arow + m * 2048 + c0); af[m][1] = *(const bf16x8*)(S + arow + m * 2048 + c1); }
        }
#pragma unroll
        for (int n = 0; n < 4; ++n) { bfr[n][0] = *(const bf16x8*)(S + brow + n * 2048 + c0); bfr[n][1] = *(const bf16x8*)(S + brow + n * 2048 + c1); }
        WAIT_LGKM0();
        RAW_BARRIER();
        if (t + 2 < nt) stage(t & 1, t + 2);
        __builtin_amdgcn_s_setprio(1);
#pragma unroll
        for (int ks = 0; ks < 2; ++ks)
#pragma unroll
            for (int m = 0; m < 4; ++m)
#pragma unroll
                for (int n = 0; n < 4; ++n) acc[m][n] = TRANS ? mfma16(bfr[n][ks], af[m][ks], acc[m][n]) : mfma16(af[m][ks], bfr[n][ks], acc[m][n]);
        __builtin_amdgcn_s_setprio(0);
    }
}
template <int KACT, int ASTRIDE, class EPI>
DEV void gemm2_stream64(const bf16_t* W2, const char* ACT, char* sb, EPI&& epi) {
    const int tid = get_tid(), lane = tid & 63, wid = tid >> 6, fr = lane & 15, fq = lane >> 4, wr = wid >> 1, wc = wid & 1;
    constexpr int KS = KACT / 64, NJ = 8 * KS;
    const unsigned b0 = (unsigned)(tid >> 3) * KACT + (unsigned)(((tid & 7) ^ ((tid >> 3) & 7)) * 8);
    auto stage = [&](int s, int j) {
        const int nt = j / KS, ks = j % KS;
        char* SB = sb + s * 16384;
        const bf16_t* src = W2 + (size_t)nt * 128 * KACT + ks * 64 + b0;
#pragma unroll
        for (int i = 0; i < 4; ++i) glds16(src + (size_t)i * 32 * KACT, SB + i * 4096 + tid * 16);
    };
    WAIT_VM(0);
    stage(0, 0); stage(1, 1);
    const int rsw = fr & 7;
    const int brow = (wc * 64 + fr) * 128, c0 = (fq ^ rsw) * 16, c1 = ((4 + fq) ^ rsw) * 16;
    f32x4 acc[4][4]; zero_acc<4, 4>(acc);
#pragma unroll 1
    for (int j = 0; j < NJ; ++j) {
        const int ks = j % KS;
        if (j + 1 < NJ) WAIT_VM(4); else WAIT_VM(0);
        RAW_BARRIER();
        const char* S = sb + (j & 1) * 16384;
        bf16x8 af[4][2], bfr[4][2];
#pragma unroll
        for (int m = 0; m < 4; ++m) { const char* ar = ACT + (wr * 64 + m * 16 + fr) * ASTRIDE + (ks * 64 + fq * 8) * 2; af[m][0] = *(const bf16x8*)ar; af[m][1] = *(const bf16x8*)(ar + 64); }
#pragma unroll
        for (int n = 0; n < 4; ++n) { bfr[n][0] = *(const bf16x8*)(S + brow + n * 2048 + c0); bfr[n][1] = *(const bf16x8*)(S + brow + n * 2048 + c1); }
        WAIT_LGKM0();
        RAW_BARRIER();
        if (j + 2 < NJ) stage(j & 1, j + 2);
#pragma unroll
        for (int k2 = 0; k2 < 2; ++k2)
#pragma unroll
            for (int m = 0; m < 4; ++m)
#pragma unroll
                for (int n = 0; n < 4; ++n) acc[m][n] = mfma16(bfr[n][k2], af[m][k2], acc[m][n]);
        if (ks == KS - 1) { epi(j / KS, acc); zero_acc<4, 4>(acc); }
    }
}
template <int MI, int KACT, int ASTRIDE, class EPI>
DEV void gemm2_stream(const bf16_t* W2, const char* ACT, char* sb, EPI&& epi) {
    const int tid = get_tid(), lane = tid & 63, wid = tid >> 6, fr = lane & 15, fq = lane >> 4, wr = wid >> 1, wc = wid & 1;
    constexpr int KS = KACT / 32, NJ = 8 * KS;
    const bf16_t* b0 = W2 + (size_t)(tid >> 2) * KACT + lchunk(tid) * 8;
    auto stage = [&](int s, int j) {
        const int nt = j / KS, ks = j % KS;
        char* SB = sb + s * 8192;
        const bf16_t* src = b0 + (size_t)nt * 128 * KACT + ks * 32;
        glds16(src, SB + tid * 16);
        glds16(src + 64 * KACT, SB + 4096 + tid * 16);
    };
    WAIT_VM(0);
    stage(0, 0); stage(1, 1);
    const int boff = (wc * 64 + fr) * 64 + (fq ^ ((0 - (fr >> 2)) & 3)) * 16;
    f32x4 acc[MI][4]; zero_acc<MI, 4>(acc);
#pragma unroll 1
    for (int j = 0; j < NJ; ++j) {
        const int ks = j % KS;
        if (j + 1 < NJ) WAIT_VM(2); else WAIT_VM(0);
        RAW_BARRIER();
        const char* S = sb + (j & 1) * 8192;
        bf16x8 af[MI], bfr[4];
#pragma unroll
        for (int m = 0; m < MI; ++m) af[m] = *(const bf16x8*)(ACT + (wr * MI * 16 + m * 16 + fr) * ASTRIDE + (ks * 32 + fq * 8) * 2);
#pragma unroll
        for (int n = 0; n < 4; ++n) bfr[n] = *(const bf16x8*)(S + boff + n * 1024);
        WAIT_LGKM0();
        RAW_BARRIER();
        if (j + 2 < NJ) stage(j & 1, j + 2);
#pragma unroll
        for (int m = 0; m < MI; ++m)
#pragma unroll
            for (int n = 0; n < 4; ++n) acc[m][n] = mfma16(bfr[n], af[m], acc[m][n]);
        if (ks == KS - 1) { epi(j / KS, acc); zero_acc<MI, 4>(acc); }
    }
}

DEV void prep_mod_item(const Params& p, int it, char* lds) {
    const int l = it / 96, r = it % 96, cch = r >> 2, kp = r & 3, tid = get_tid(), lane = tid & 63, kq = tid >> 6;
    float* sl = (float*)lds;
    float* red = sl + 9 * 256;
    for (int i = tid; i < 9 * 256; i += 256) { const int g = i >> 8, k = kp * 256 + (i & 255); const float v = (g < 8) ? p.c[g * 1024 + k] : p.c_ctx[k]; sl[i] = v * __builtin_amdgcn_rcpf(1.f + __expf(-v)); }
    __syncthreads();
    f32x4 acc[9];
#pragma unroll
    for (int g = 0; g < 9; ++g) acc[g] = (f32x4){0.f, 0.f, 0.f, 0.f};
    const float* w = p.ada_w + ((size_t)l * 1024 + kp * 256 + kq * 64) * 6144 + cch * 256 + lane * 4;
#pragma unroll 16
    for (int kk = 0; kk < 64; ++kk) {
        const f32x4 wv = *(const f32x4*)(w + (size_t)kk * 6144);
#pragma unroll
        for (int g = 0; g < 9; ++g) { const float sv = sl[g * 256 + kq * 64 + kk]; acc[g] += sv * wv; }
    }
#pragma unroll
    for (int g = 0; g < 9; ++g) *(f32x4*)(red + (kq * 9 + g) * 256 + lane * 4) = acc[g];
    __syncthreads();
    float* part = (float*)(p.ws + OFF_R) + (size_t)(l * 24 + cch) * 4 * 2304;
    for (int i = tid; i < 9 * 256; i += 256) {
        const int g = i >> 8, c = i & 255;
        part[kp * 2304 + i] = (red[(0 * 9 + g) * 256 + c] + red[(1 * 9 + g) * 256 + c]) + (red[(2 * 9 + g) * 256 + c] + red[(3 * 9 + g) * 256 + c]);
    }
    __threadfence();
    __syncthreads();
    int* arrive = (int*)(lds + SMEM_BYTES - 252);
    if (tid == 0) *arrive = atomicAdd((int*)(p.ws + OFF_QUEUE) + 256 + l * 24 + cch, 1);
    __syncthreads();
    if (*arrive == 3) {
        __threadfence();
        float* mod = (float*)(p.ws + OFF_MOD);
        for (int i = tid; i < 9 * 256; i += 256) {
            const int g = i >> 8, c = i & 255;
            const float v = (__builtin_nontemporal_load(part + i) + __builtin_nontemporal_load(part + 2304 + i)) + (__builtin_nontemporal_load(part + 2 * 2304 + i) + __builtin_nontemporal_load(part + 3 * 2304 + i));
            mod[((size_t)l * 9 + g) * 6144 + cch * 256 + c] = p.ada_b[l * 6144 + cch * 256 + c] + v;
        }
    }
    __syncthreads();
}
constexpr float INV2PI = 0.15915494309189535f;
DEV float sin_rev(float r) { return __builtin_amdgcn_sinf(__builtin_amdgcn_fractf(r)); }
DEV float cos_rev(float r) { return __builtin_amdgcn_cosf(__builtin_amdgcn_fractf(r)); }
DEV void prep_rope_item(const Params& p, int it) {
    const int idx = it * 256 + get_tid(), t = idx >> 5, i = idx & 31;
    const float inv = __builtin_amdgcn_exp2f(-(float)(2 * (i & 15)) * (13.287712379549449f / 32.f));
    const float ang = (float)((i < 16) ? (t >> 6) : (t & 63)) * inv;
    float* rc = (float*)(p.ws + OFF_ROPE);
    rc[idx] = cos_rev(ang * INV2PI); rc[2048 * 32 + idx] = sin_rev(ang * INV2PI);
}
DEV void prep_filter_item(const Params& p, int it, char* lds) {
    const int tid = get_tid(), lane = tid & 63, wid = tid >> 6;
    const int row0 = it * 32 + wid * 8;
    const int l = row0 / 2304, r0 = row0 % 2304, type = r0 < 2048 ? 0 : 1, t0 = type ? r0 - 2048 : r0, n = type ? 256 : 2048;
    float* z = (float*)lds + wid * (8 * 192); float* h1 = z + 8 * 64; float* h2 = h1 + 8 * 64;
    float* WL = (float*)(lds + 24576);
    const float rn1 = type ? 1.f / 255.f : 1.f / 2047.f;
    for (int idx = tid; idx < 97 * 16; idx += 256) {
        const int row = idx >> 4, c4 = (idx & 15) * 4;
        const float* src = row < 33 ? p.hy_f_w1 + (l * 33 + row) * 64 : p.hy_f_w2 + (l * 64 + row - 33) * 64;
        *(f32x4*)(WL + row * 64 + c4) = *(const f32x4*)(src + c4);
    }
#pragma unroll
    for (int rr = 0; rr < 8; ++rr) {
        const int t = t0 + rr;
        if (lane < 33) {
            float v;
            if (lane == 0) v = (float)t * rn1;
            else {
                const int i = (lane - 1) & 15;
                const float f = 1e-4f + (float)i * ((15.f - 1e-4f) / 15.f);
                const float rev = f * ((float)t * (type ? 1.f / 256.f : 1.f / 2048.f));
                v = (lane <= 16) ? cos_rev(rev) : -sin_rev(rev);
            }
            z[rr * 64 + lane] = v;
        }
    }
    __syncthreads();
    {
        float s[8]; const float b = p.hy_f_b1[l * 64 + lane];
#pragma unroll
        for (int rr = 0; rr < 8; ++rr) s[rr] = b;
#pragma unroll 11
        for (int i = 0; i < 33; ++i) {
            const float w = WL[i * 64 + lane];
#pragma unroll
            for (int rr = 0; rr < 8; ++rr) s[rr] += z[rr * 64 + i] * w;
        }
        const float fq0 = p.hy_freq[(l * 2 + 0) * 64 + lane];
#pragma unroll
        for (int rr = 0; rr < 8; ++rr) h1[rr * 64 + lane] = sin_rev(fq0 * s[rr] * INV2PI);
    }
    __builtin_amdgcn_wave_barrier();
    {
        float s[8]; const float b = p.hy_f_b2[l * 64 + lane];
#pragma unroll
        for (int rr = 0; rr < 8; ++rr) s[rr] = b;
#pragma unroll 16
        for (int i = 0; i < 64; ++i) {
            const float w = WL[(33 + i) * 64 + lane];
#pragma unroll
            for (int rr = 0; rr < 8; ++rr) s[rr] += h1[rr * 64 + i] * w;
        }
        const float fq1 = p.hy_freq[(l * 2 + 1) * 64 + lane];
#pragma unroll
        for (int rr = 0; rr < 8; ++rr) h2[rr * 64 + lane] = sin_rev(fq1 * s[rr] * INV2PI);
    }
    __syncthreads();
    float acc[8][8];
#pragma unroll
    for (int rr = 0; rr < 8; ++rr)
#pragma unroll
        for (int q = 0; q < 8; ++q) acc[rr][q] = 0.f;
    const float* w3 = p.hy_f_w3 + (size_t)l * 64 * 512;
#pragma unroll 1
    for (int ch = 0; ch < 4; ++ch) {
#pragma unroll
        for (int j = 0; j < 8; ++j) { const int idx = tid + j * 256; *(f32x4*)(WL + idx * 4) = *(const f32x4*)(w3 + (size_t)ch * 16 * 512 + idx * 4); }
        __syncthreads();
#pragma unroll 2
        for (int i = 0; i < 16; ++i) {
            float w[8];
#pragma unroll
            for (int q = 0; q < 8; ++q) w[q] = WL[i * 512 + q * 64 + lane];
#pragma unroll
            for (int rr = 0; rr < 8; ++rr) {
                const float hv = h2[rr * 64 + ch * 16 + i];
#pragma unroll
                for (int q = 0; q < 8; ++q) acc[rr][q] += hv * w[q];
            }
        }
        __syncthreads();
    }
    bf16_t* kf = (bf16_t*)(p.ws + (type ? OFF_KERNC + (size_t)l * 2 * 256 * 256 * 2 : OFF_KERNL + (size_t)l * 2 * 256 * 2048 * 2));
    const float lo = logf(1e-2f) / 1.5f, hi = logf(1e-2f) / 0.3f;
#pragma unroll
    for (int q = 0; q < 8; ++q) {
        const int qh = q >> 2, c = (q & 3) * 64 + lane;
        const float delta = fabsf(lo + (float)c * ((hi - lo) / 255.f));
        float v[8];
#pragma unroll
        for (int rr = 0; rr < 8; ++rr) { const float tt = (float)(t0 + rr) * rn1; v[rr] = acc[rr][q] * __expf(-tt * delta); }
        if (qh == 0 && t0 == 0) v[0] += p.hy_skip[l * 256 + c];
        *(u32x4*)(kf + ((size_t)qh * 256 + c) * n + t0) = (u32x4){pk2(v[0], v[1]), pk2(v[2], v[3]), pk2(v[4], v[5]), pk2(v[6], v[7])};
    }
}
struct ConvDesc { const float* src; bf16_t* dst; int ldsrc, k0, n0, lddst, mapkind; };
DEV void conv_load(const ConvDesc& d, f32x4 (&v)[4], int tid) {
    const int r = tid >> 4, c4 = (tid & 15) * 4;
#pragma unroll
    for (int i = 0; i < 4; ++i) v[i] = *(const f32x4*)(d.src + (size_t)(d.k0 + r + 16 * i) * d.ldsrc + d.n0 + c4);
}
DEV void conv_store(const ConvDesc& d, const f32x4 (&v)[4], char* lds, int tid) {
    float* tl = (float*)lds;
    {
        const int r = tid >> 4, c4 = (tid & 15) * 4;
#pragma unroll
        for (int i = 0; i < 4; ++i) { const int row = r + 16 * i; tl[row * 65 + c4 + 0] = v[i][0]; tl[row * 65 + c4 + 1] = v[i][1]; tl[row * 65 + c4 + 2] = v[i][2]; tl[row * 65 + c4 + 3] = v[i][3]; }
    }
    __syncthreads();
    {
        const int n = tid >> 2, kc = tid & 3, ng = d.n0 + n;
        int drow = ng;
        if (d.mapkind == 1) drow = 32 * (ng >> 4) + (ng & 15);
        else if (d.mapkind == 2) drow = 32 * (ng >> 4) + 16 + (ng & 15);
        else if (d.mapkind == 3) drow = (ng >> 7) * 256 + 32 * ((ng & 127) >> 4) + (ng & 15);
        else if (d.mapkind == 4) drow = (ng >> 7) * 256 + 32 * ((ng & 127) >> 4) + 16 + (ng & 15);
        else if (d.mapkind == 5) drow = (ng & ~31) + 16 * ((ng >> 2) & 1) + 4 * ((ng >> 3) & 3) + (ng & 3);
        unsigned w[8];
#pragma unroll
        for (int j = 0; j < 8; ++j) w[j] = pk2(tl[(kc * 16 + 2 * j) * 65 + n], tl[(kc * 16 + 2 * j + 1) * 65 + n]);
        u32x4* o = (u32x4*)(d.dst + (size_t)drow * d.lddst + d.k0 + kc * 16);
        o[0] = (u32x4){w[0], w[1], w[2], w[3]};
        o[1] = (u32x4){w[4], w[5], w[6], w[7]};
    }
    __syncthreads();
}
DEV ConvDesc conv_fixed_desc(const Params& p, int it) {
    const int l = it / 1040; int r = it % 1040;
    unsigned char* ws = p.ws;
    if (r < 576) return ConvDesc{p.w_in + (size_t)l * 1024 * PROJ, (bf16_t*)(ws + OFF_WIN) + (size_t)l * PROJ * 1024, PROJ, (r / 36) * 64, (r % 36) * 64, 1024, (r % 36) * 64 < 1536 ? 5 : 0};
    r -= 576;
    if (r < 256) return ConvDesc{p.w_out + (size_t)l * 1024 * 1024, (bf16_t*)(ws + OFF_WOUT) + (size_t)l * 1024 * 1024, 1024, (r / 16) * 64, (r % 16) * 64, 1024, 5};
    r -= 256;
    if (r < 64) return ConvDesc{p.sh_w1 + (size_t)l * 1024 * 256, (bf16_t*)(ws + OFF_SW13) + (size_t)l * 512 * 1024, 256, (r / 4) * 64, (r % 4) * 64, 1024, 3};
    r -= 64;
    if (r < 64) return ConvDesc{p.sh_w3 + (size_t)l * 1024 * 256, (bf16_t*)(ws + OFF_SW13) + (size_t)l * 512 * 1024, 256, (r / 4) * 64, (r % 4) * 64, 1024, 4};
    r -= 64;
    if (r < 64) { const int kt = r / 16, hh = kt >> 1;
        return ConvDesc{p.sh_w2 + (size_t)l * 256 * 1024, (bf16_t*)(ws + OFF_SW2) + (size_t)(l * 2 + hh) * 1024 * 128 - hh * 128, 1024, kt * 64, (r % 16) * 64, 128, 5}; }
    r -= 64;
    return ConvDesc{p.router_w + (size_t)l * 1024 * 64, (bf16_t*)(ws + OFF_RW) + (size_t)l * 64 * 1024, 64, r * 64, 0, 1024, 0};
}
DEV ConvDesc conv_expert_desc(const Params& p, int l, int it) {
    const int e = it / 96; int r = it % 96;
    unsigned char* ws = p.ws;
    const size_t eo = (size_t)(l * 64 + e) * 1024 * 128;
    if (r < 32) return ConvDesc{p.exp_w1 + eo, (bf16_t*)(ws + OFF_W13) + (size_t)e * 256 * 1024, 128, (r / 2) * 64, (r % 2) * 64, 1024, 1};
    r -= 32;
    if (r < 32) return ConvDesc{p.exp_w3 + eo, (bf16_t*)(ws + OFF_W13) + (size_t)e * 256 * 1024, 128, (r / 2) * 64, (r % 2) * 64, 1024, 2};
    r -= 32;
    return ConvDesc{p.exp_w2 + eo, (bf16_t*)(ws + OFF_W2) + (size_t)e * 1024 * 128, 1024, (r / 16) * 64, (r % 16) * 64, 128, 5};
}
DEV void conv_run(const Params& p, int l, int first, int count, char* lds) {
    const int tid = get_tid();
    if (count <= 0) return;
    ConvDesc d = l < 0 ? conv_fixed_desc(p, first) : conv_expert_desc(p, l, first);
    f32x4 v[4]; conv_load(d, v, tid);
#pragma unroll 1
    for (int i = 0; i < count; ++i) {
        ConvDesc dn = d; f32x4 vn[4];
        if (i + 1 < count) { dn = l < 0 ? conv_fixed_desc(p, first + i + 1) : conv_expert_desc(p, l, first + i + 1); conv_load(dn, vn, tid); }
        else {
#pragma unroll
            for (int k = 0; k < 4; ++k) vn[k] = v[k];
        }
        conv_store(d, v, lds, tid);
        d = dn;
#pragma unroll
        for (int k = 0; k < 4; ++k) v[k] = vn[k];
    }
}
DEV void phase_prep(const Params& p, char* lds) {
    { const int t_ = get_tid(); if (blockIdx.x == 0 && t_ < 128) ((int*)(p.ws + OFF_CNT))[t_ * 64] = 0; }
    constexpr int N0 = 144, N1 = N0 + 192, N2 = N1 + 260, N3 = N2 + 768, N4 = N3 + 256;
    int* qhead = (int*)(p.ws + OFF_QUEUE) + 2 * 64;
    int* qslot = (int*)(lds + SMEM_BYTES - 256);
    for (;;) {
        __syncthreads();
        if (get_tid() == 0) *qslot = atomicAdd(qhead, 1);
        __syncthreads();
        const int it = *qslot;
        if (it >= N4) break;
        if (it < N0) prep_filter_item(p, it, lds);
        else if (it < N1) prep_mod_item(p, it - N0, lds);
        else if (it < N2) conv_run(p, -1, (it - N1) * 8, 8, lds);
        else if (it < N3) conv_run(p, 0, (it - N2) * 8, 8, lds);
        else prep_rope_item(p, it - N3);
    }
}
DEV void phase_modfin(const Params& p) {
    const float* part = (const float*)(p.ws + OFF_PART);
    float* mod = (float*)(p.ws + OFF_MOD);
    for (int idx = blockIdx.x * 256 + get_tid(); idx < 2 * 9 * 6144; idx += gridDim.x * 256) {
        const int l = idx / (9 * 6144), g = (idx / 6144) % 9, col = idx % 6144;
        float s = p.ada_b[l * 6144 + col];
        for (int k = 0; k < 32; ++k) s += part[((size_t)(k * 2 + l) * 9 + g) * 6144 + col];
        mod[idx] = s;
    }
}

DEV void row_load(const float* src, f32x4 (&v)[4], int lane) {
#pragma unroll
    for (int j = 0; j < 4; ++j) v[j] = *(const f32x4*)(src + 4 * lane + 256 * j);
}
DEV f32x4 ld_bf4(const bf16_t* p) { const u32x2 w = *(const u32x2*)p; return (f32x4){__uint_as_float(w[0] << 16), __uint_as_float(w[0] & 0xffff0000u), __uint_as_float(w[1] << 16), __uint_as_float(w[1] & 0xffff0000u)}; }
DEV void st_bf4(bf16_t* p, const f32x4& v) { *(u32x2*)p = (u32x2){pk2(v[0], v[1]), pk2(v[2], v[3])}; }
DEV void row_load_bf(const bf16_t* src, f32x4 (&v)[4], int lane) {
#pragma unroll
    for (int j = 0; j < 4; ++j) v[j] = ld_bf4(src + 4 * lane + 256 * j);
}
DEV void row_norm(f32x4 (&v)[4]) {
    float s = 0.f;
#pragma unroll
    for (int j = 0; j < 4; ++j) s += (v[j][0] + v[j][1]) + (v[j][2] + v[j][3]);
    const float mean = wave_sum(s) * (1.f / 1024.f);
    float q = 0.f;
#pragma unroll
    for (int j = 0; j < 4; ++j) { v[j] = v[j] - mean; q += (v[j][0] * v[j][0] + v[j][1] * v[j][1]) + (v[j][2] * v[j][2] + v[j][3] * v[j][3]); }
    const float rstd = __builtin_amdgcn_rsqf(wave_sum(q) * (1.f / 1024.f) + 1e-6f);
#pragma unroll
    for (int j = 0; j < 4; ++j) v[j] = v[j] * rstd;
}
DEV void row_store_mod_bf16(bf16_t* dst, const f32x4 (&v)[4], const float* shift, const float* scale, int lane) {
#pragma unroll
    for (int j = 0; j < 4; ++j) {
        const int c = 4 * lane + 256 * j;
        const f32x4 sh = *(const f32x4*)(shift + c), sc = *(const f32x4*)(scale + c);
        const f32x4 o = v[j] * (sc + 1.0f) + sh;
        *(u32x2*)(dst + c) = (u32x2){pk2(o[0], o[1]), pk2(o[2], o[3])};
    }
}
DEV void phase_lnmod0(const Params& p) {
    const int tid_ = get_tid(), lane = tid_ & 63, wid = tid_ >> 6;
    const float* mod = (const float*)(p.ws + OFF_MOD);
    bf16_t* H = (bf16_t*)(p.ws + OFF_H);
    for (int row = blockIdx.x * 4 + wid; row < NT; row += gridDim.x * 4) {
        const float* src = row < NLAT ? p.x + (size_t)row * 1024 : p.ctx + (size_t)(row - NLAT) * 1024;
        f32x4 v[4]; row_load(src, v, lane); row_norm(v);
        const float* m = mod + (size_t)mod_group(row) * 6144;
        row_store_mod_bf16(H + (size_t)row * 1024, v, m, m + 1024, lane);
    }
}

DEV void phase_inproj(const Params& p, int l, char* lds) {
    const int tid = get_tid(), lane = tid & 63, wid = tid >> 6, fr = lane & 15, fq = lane >> 4, wr = wid >> 1, wc = wid & 1;
    unsigned char* ws = p.ws;
    const bf16_t* H = (const bf16_t*)(ws + OFF_H);
    const bf16_t* W = (const bf16_t*)(ws + OFF_WIN) + (size_t)l * PROJ * 1024;
    const float* ropec = (const float*)(ws + OFF_ROPE); const float* ropes = ropec + 2048 * 32;
    const int nitems = 128 * 18 + 16 * (l == 0 ? 18 : 6);
    for (int it = blockIdx.x; it < nitems; it += gridDim.x) {
        int mt, nt;
        if (it < 2304) { mt = it / 18; nt = it % 18; }
        else { const int j = it - 2304; if (l == 0) { mt = 128 + j / 18; nt = j % 18; } else { mt = 128 + j / 6; const int q = j % 6; nt = q < 2 ? 4 + q : 6 + q; } }
        const int m0 = mt * 128, n0 = nt * 128;
        const unsigned a0 = (unsigned)m0 * 1024u + st64_off(tid), b0 = (unsigned)n0 * 1024u + st64_off(tid);
        const unsigned ao[4] = {a0, a0 + 32u * 1024u, a0 + 64u * 1024u, a0 + 96u * 1024u};
        const unsigned bo[4] = {b0, b0 + 32u * 1024u, b0 + 64u * 1024u, b0 + 96u * 1024u};
        f32x4 acc[4][4]; zero_acc<4, 4>(acc);
        const bool latent = m0 < NLAT;
        const int b = latent ? (m0 >> 11) : ((m0 - NLAT) >> 8);
        const int tbase = latent ? (m0 & 2047) : ((m0 - NLAT) & 255);
        if (nt >= 12) {
            const int rho = tid >> 3, ptok = 8 * ((rho & 15) >> 2) + 4 * (rho >> 4) + (rho & 3);
            const unsigned ap0 = (unsigned)(m0 + ptok) * 1024u + (unsigned)(((tid & 7) ^ (rho & 7)) * 8);
            const unsigned aop[4] = {ap0, ap0 + 32u * 1024u, ap0 + 64u * 1024u, ap0 + 96u * 1024u};
            gemm_core64<false>(acc, H, aop, W, bo, 1024, lds);
            bf16_t* zt = latent ? (bf16_t*)(ws + OFF_ZTL) + (size_t)b * 768 * 2048 : (bf16_t*)(ws + OFF_ZTC) + (size_t)b * 768 * 256;
            const int n = latent ? 2048 : 256;
#pragma unroll
            for (int g = 0; g < 2; ++g)
#pragma unroll
                for (int nn = 0; nn < 4; ++nn) {
                    const int ch = n0 - 1536 + wc * 64 + nn * 16 + fr, t = tbase + wr * 64 + 32 * g + 8 * fq;
                    *(u32x4*)(zt + (size_t)ch * n + t) = (u32x4){pk2(acc[2 * g][nn][0], acc[2 * g][nn][1]), pk2(acc[2 * g][nn][2], acc[2 * g][nn][3]),
                                                                 pk2(acc[2 * g + 1][nn][0], acc[2 * g + 1][nn][1]), pk2(acc[2 * g + 1][nn][2], acc[2 * g + 1][nn][3])};
                }
        } else {
            gemm_core64<true>(acc, H, ao, W, bo, 1024, lds);
            const int col0 = n0 + wc * 64;
            int kind, hh;
            if (col0 < 512) { kind = 0; hh = col0 >> 6; } else if (col0 < 640) { kind = 1; hh = (col0 - 512) >> 6; } else if (col0 < 768) { kind = 2; hh = (col0 - 640) >> 6; }
            else if (col0 < 1024) { kind = 3; hh = (col0 - 768) >> 6; } else if (col0 < 1280) { kind = 4; hh = (col0 - 1024) >> 6; } else { kind = 5; hh = (col0 - 1280) >> 6; }
            const bool normed = (kind == 0 || kind == 1);
            const float* gain = (kind == 0 ? p.q_gain : p.k_gain) + l * 64;
#pragma unroll
            for (int m = 0; m < 4; ++m) {
                const int rloc = wr * 64 + m * 16 + fr, row = m0 + rloc, t = tbase + rloc;
                f32x4 v[4];
#pragma unroll
                for (int nn = 0; nn < 4; ++nn) v[nn] = acc[m][nn];
                if (normed) {
                    float ss = 0.f;
#pragma unroll
                    for (int nn = 0; nn < 4; ++nn) ss += (v[nn][0] * v[nn][0] + v[nn][1] * v[nn][1]) + (v[nn][2] * v[nn][2] + v[nn][3] * v[nn][3]);
                    ss += __shfl_xor(ss, 16); ss += __shfl_xor(ss, 32);
                    const float r = __builtin_amdgcn_rsqf(ss * (1.f / 64.f) + 1e-6f);
#pragma unroll
                    for (int nn = 0; nn < 4; ++nn) {
                        const int hc = 32 * (nn >> 1) + 8 * fq + 4 * (nn & 1);
                        const f32x4 g = *(const f32x4*)(gain + hc);
                        v[nn] = v[nn] * r * g;
                        if (latent) {
                            const int pi = hc >> 1;
                            const float c0 = ropec[t * 32 + pi], s0 = ropes[t * 32 + pi], c1 = ropec[t * 32 + pi + 1], s1 = ropes[t * 32 + pi + 1];
                            const float x0 = v[nn][0], x1 = v[nn][1], x2 = v[nn][2], x3 = v[nn][3];
                            v[nn][0] = x0 * c0 - x1 * s0; v[nn][1] = x0 * s0 + x1 * c0;
                            v[nn][2] = x2 * c1 - x3 * s1; v[nn][3] = x2 * s1 + x3 * c1;
                        }
                    }
                }
                if (kind == 0 || kind == 3) {
#pragma unroll
                    for (int nn = 0; nn < 4; ++nn) v[nn] = v[nn] * (0.125f * LOG2E);
                }
                bf16_t* dst;
                const int key = latent ? 256 + t : t;
                if (kind == 0) dst = (bf16_t*)(ws + OFF_QA) + ((size_t)hh * NT + row) * 64;
                else if (kind == 3) dst = (bf16_t*)(ws + OFF_QB) + ((size_t)hh * NT + row) * 64;
                else if (kind == 1) dst = (bf16_t*)(ws + OFF_KA) + ((size_t)(b * 2 + hh) * KEYS + key) * 64;
                else if (kind == 2) dst = (bf16_t*)(ws + OFF_VA) + ((size_t)(b * 2 + hh) * KEYS + key) * 64;
                else if (kind == 4) dst = (bf16_t*)(ws + OFF_KB) + ((size_t)(b * 4 + hh) * KEYS + key) * 64;
                else dst = (bf16_t*)(ws + OFF_VB) + ((size_t)(b * 4 + hh) * KEYS + key) * 64;
#pragma unroll
                for (int gg = 0; gg < 2; ++gg) *(u32x4*)(dst + 32 * gg + 8 * fq) = (u32x4){pk2(v[2 * gg][0], v[2 * gg][1]), pk2(v[2 * gg][2], v[2 * gg][3]), pk2(v[2 * gg + 1][0], v[2 * gg + 1][1]), pk2(v[2 * gg + 1][2], v[2 * gg + 1][3])};
            }
        }
    }
}

template <int NQT, bool NA>
DEV void attn_block(const bf16_t* Qh, int qrow0, const bf16_t* Kh, const bf16_t* Vh, int ntiles, bf16_t* outp  ,
                    int na_r, int na_rs, int nwin, const float* rpb_h, char* lds) {
    const int tid = get_tid(), lane = tid & 63, wid = tid >> 6, fr = lane & 15, fq = lane >> 4;
    char* KBUF = lds;
    char* VBUF = lds + 16384;
    float* BIAS = (float*)(lds + 32768);
    if (NA) {
        for (int i = tid; i < 15 * 32; i += 256) { const int dr = i >> 5, dc = i & 31; BIAS[i] = dc < 31 ? rpb_h[dr * 31 + dc] * LOG2E : 0.f; }
    }
    bf16x8 qf[NQT][2];
    const int qw = qrow0 + wid * 16 * NQT;
#pragma unroll
    for (int nq = 0; nq < NQT; ++nq)
#pragma unroll
        for (int ks = 0; ks < 2; ++ks) qf[nq][ks] = *(const bf16x8*)(Qh + (size_t)(qw + nq * 16 + fr) * 64 + ks * 32 + fq * 8);
    f32x4 oacc[4][NQT], lacc[NQT];
    float mrun[NQT];
    const bf16x8 ones = (bf16x8){0x3F80, 0x3F80, 0x3F80, 0x3F80, 0x3F80, 0x3F80, 0x3F80, 0x3F80};
#pragma unroll
    for (int nq = 0; nq < NQT; ++nq) { mrun[nq] = 0.f; lacc[nq] = (f32x4){0.f, 0.f, 0.f, 0.f};
#pragma unroll
        for (int dt = 0; dt < 4; ++dt) oacc[dt][nq] = (f32x4){0.f, 0.f, 0.f, 0.f}; }
    const int lrow0 = tid >> 3, lch = tid & 7;
    auto key0_of = [&](int ti) -> int { if (NA) return ti < nwin ? 256 + (na_rs + ti) * 64 : (ti - nwin) * 64; return ti * 64; };
    u32x4 kreg[2], vreg[2];
    auto gload = [&](int ti) {
        const int k0 = key0_of(ti);
#pragma unroll
        for (int i = 0; i < 2; ++i) {
            const int row = lrow0 + 32 * i;
            kreg[i] = *(const u32x4*)(Kh + (size_t)(k0 + row) * 64 + lch * 8);
            vreg[i] = *(const u32x4*)(Vh + (size_t)(k0 + row) * 64 + lch * 8);
        }
    };
    auto lstore = [&](int buf) {
#pragma unroll
        for (int i = 0; i < 2; ++i) {
            const int row = lrow0 + 32 * i;
            const int off = buf * 8192 + row * 128 + ((lch ^ (row & 7)) * 16);
            *(u32x4*)(KBUF + off) = kreg[i];
            *(u32x4*)(VBUF + off) = vreg[i];
        }
    };
    gload(0); lstore(0);
    __syncthreads();
    for (int ti = 0; ti < ntiles; ++ti) {
        const int buf = ti & 1;
        if (ti + 1 < ntiles) gload(ti + 1);
        const char* kb = KBUF + buf * 8192; const char* vb = VBUF + buf * 8192;
        f32x4 sacc[4][NQT];
        __builtin_amdgcn_s_setprio(1);
#pragma unroll
        for (int mt = 0; mt < 4; ++mt) {
            const int row = mt * 16 + fr;
            bf16x8 kf0 = *(const bf16x8*)(kb + row * 128 + (((0 + fq) ^ (row & 7)) * 16));
            bf16x8 kf1 = *(const bf16x8*)(kb + row * 128 + (((4 + fq) ^ (row & 7)) * 16));
#pragma unroll
            for (int nq = 0; nq < NQT; ++nq) {
                f32x4 s = (f32x4){-mrun[nq], -mrun[nq], -mrun[nq], -mrun[nq]};
                s = mfma16(kf0, qf[nq][0], s);
                s = mfma16(kf1, qf[nq][1], s);
                sacc[mt][nq] = s;
            }
        }
        __builtin_amdgcn_s_setprio(0);
        bf16x8 pf[2][NQT];
#pragma unroll
        for (int nq = 0; nq < NQT; ++nq) {
            float tv[4][4];
            float tmax = -1e30f;
            if (NA && ti < nwin) {
                const int qc = (wid & 1) * 32 + nq * 16 + fr;
                int cs = qc - 8; cs = cs < 0 ? 0 : (cs > 48 ? 48 : cs);
                const int qrow = na_r + (wid >> 1);
                int rsq = qrow - 4; rsq = rsq < 0 ? 0 : (rsq > 24 ? 24 : rsq);
                const int krow = na_rs + ti;
                const bool rowok = (krow >= rsq) && (krow < rsq + 8);
                int dr = krow - qrow + 7; dr = dr < 0 ? 0 : (dr > 14 ? 14 : dr);
#pragma unroll
                for (int mt = 0; mt < 4; ++mt)
#pragma unroll
                    for (int j = 0; j < 4; ++j) {
                        const int kc = mt * 16 + 4 * fq + j;
                        const bool ok = rowok && (kc >= cs) && (kc < cs + 16);
                        int dc = kc - qc + 15; dc = dc < 0 ? 0 : (dc > 30 ? 30 : dc);
                        tv[mt][j] = ok ? sacc[mt][nq][j] + BIAS[dr * 32 + dc] : -1e30f;
                        tmax = fmaxf(tmax, tv[mt][j]);
                    }
            } else {
#pragma unroll
                for (int mt = 0; mt < 4; ++mt) {
#pragma unroll
                    for (int j = 0; j < 4; ++j) tv[mt][j] = sacc[mt][nq][j];
                    tmax = fmaxf(fmaxf(tmax, tv[mt][0]), tv[mt][1]); tmax = fmaxf(fmaxf(tmax, tv[mt][2]), tv[mt][3]);
                }
            }
            if (__any(tmax > 8.0f)) {
                tmax = fmaxf(tmax, __shfl_xor(tmax, 16)); tmax = fmaxf(tmax, __shfl_xor(tmax, 32));
                const float dlt = fmaxf(tmax, 0.f);
                const float alpha = __builtin_amdgcn_exp2f(-dlt);
                mrun[nq] += dlt;
                lacc[nq] = lacc[nq] * alpha;
#pragma unroll
                for (int dt = 0; dt < 4; ++dt) oacc[dt][nq] = oacc[dt][nq] * alpha;
#pragma unroll
                for (int mt = 0; mt < 4; ++mt)
#pragma unroll
                    for (int j = 0; j < 4; ++j) tv[mt][j] -= dlt;
            }
#pragma unroll
            for (int mt = 0; mt < 4; ++mt)
#pragma unroll
                for (int j = 0; j < 4; ++j) tv[mt][j] = __builtin_amdgcn_exp2f(tv[mt][j]);
#pragma unroll
            for (int ks = 0; ks < 2; ++ks) {
                union { bf16x8 v; unsigned u[4]; } pk;
                pk.u[0] = pk2(tv[2 * ks][0], tv[2 * ks][1]); pk.u[1] = pk2(tv[2 * ks][2], tv[2 * ks][3]);
                pk.u[2] = pk2(tv[2 * ks + 1][0], tv[2 * ks + 1][1]); pk.u[3] = pk2(tv[2 * ks + 1][2], tv[2 * ks + 1][3]);
                pf[ks][nq] = pk.v;
                lacc[nq] = mfma16(ones, pk.v, lacc[nq]);
            }
        }
        {
            const int q4 = fr >> 2, p4 = fr & 3;
#pragma unroll
            for (int ks = 0; ks < 2; ++ks)
#pragma unroll
                for (int dt = 0; dt < 4; ++dt) {
                    const int keyA = 16 * (2 * ks) + 4 * fq + q4, keyB = keyA + 16;
                    const int ch = 4 * (dt >> 1) + p4;
                    const int offA = keyA * 128 + ((ch ^ (keyA & 7)) * 16) + (dt & 1) * 8;
                    const int offB = keyB * 128 + ((ch ^ (keyB & 7)) * 16) + (dt & 1) * 8;
                    const s16x4 ta = __builtin_amdgcn_ds_read_tr16_b64_v4i16((LDSP(s16x4))(vb + offA));
                    const s16x4 tb = __builtin_amdgcn_ds_read_tr16_b64_v4i16((LDSP(s16x4))(vb + offB));
                    bf16x8 vf; vf[0] = ta[0]; vf[1] = ta[1]; vf[2] = ta[2]; vf[3] = ta[3]; vf[4] = tb[0]; vf[5] = tb[1]; vf[6] = tb[2]; vf[7] = tb[3];
#pragma unroll
                    for (int nq = 0; nq < NQT; ++nq) oacc[dt][nq] = mfma16(vf, pf[ks][nq], oacc[dt][nq]);
                }
        }
        if (ti + 1 < ntiles) lstore(buf ^ 1);
        __syncthreads();
    }
#pragma unroll
    for (int nq = 0; nq < NQT; ++nq) {
        const float inv = __builtin_amdgcn_rcpf(lacc[nq][0]);
        bf16_t* o = outp + (size_t)(qw + nq * 16 + fr) * 1024;
#pragma unroll
        for (int g = 0; g < 2; ++g) {
            const f32x4 v0 = oacc[2 * g][nq] * inv, v1 = oacc[2 * g + 1][nq] * inv;
            *(u32x4*)(o + g * 32 + 8 * fq) = (u32x4){pk2(v0[0], v0[1]), pk2(v0[2], v0[3]), pk2(v1[0], v1[1]), pk2(v1[2], v1[3])};
        }
    }
    __syncthreads();
}

DEV float hy_sconv(const bf16_t* zrow, int t, int n, float w0, float w1, float w2, float bias) {
    const float zm = t > 0 ? bf2f(zrow[t - 1]) : 0.f, z0 = bf2f(zrow[t]), zp = t + 1 < n ? bf2f(zrow[t + 1]) : 0.f;
    return w0 * zm + w1 * z0 + w2 * zp + bias;
}
template <int NJ>
DEV void hyena_item(const Params& p, int l, int type, int c, int bh, char* lds) {
    constexpr int n = 256 * NJ;
    const int tid = get_tid();
    f32x4* U = (f32x4*)lds;
    float* KR = (float*)(lds + n * 16);
    const bf16_t* zt = type ? (const bf16_t*)(p.ws + OFF_ZTC) : (const bf16_t*)(p.ws + OFF_ZTL);
    const bf16_t* kf = (const bf16_t*)(p.ws + (type ? OFF_KERNC + (size_t)l * 2 * 256 * 256 * 2 : OFF_KERNL + (size_t)l * 2 * 256 * 2048 * 2)) + (size_t)c * n;
    const bf16_t* kb = kf + (size_t)256 * n;
    const float* cw = p.hy_conv_w + l * 3 * 768; const float* cb = p.hy_conv_b + l * 768;
    const float w10 = cw[256 + c], w11 = cw[768 + 256 + c], w12 = cw[1536 + 256 + c], b1 = cb[256 + c];
    const float wv0 = cw[512 + c], wv1 = cw[768 + 512 + c], wv2 = cw[1536 + 512 + c], bv = cb[512 + c];
    const float w00 = cw[c], w01 = cw[768 + c], w02 = cw[1536 + c], b0 = cb[c];
    for (int i = tid; i < 2 * n - 1; i += 256) { const int d = i - (n - 1); KR[i] = bf2f(d >= 0 ? kf[d] : kb[-d]); }
    for (int s = tid; s < n; s += 256) {
        f32x4 u;
#pragma unroll
        for (int bb = 0; bb < 4; ++bb) {
            const bf16_t* zb = zt + (size_t)(bh * 4 + bb) * 768 * n;
            const float x1 = hy_sconv(zb + (size_t)(256 + c) * n, s, n, w10, w11, w12, b1);
            const float vv = hy_sconv(zb + (size_t)(512 + c) * n, s, n, wv0, wv1, wv2, bv);
            u[bb] = vv * x1;
        }
        U[s] = u;
    }
    __syncthreads();
    f32x4 acc[NJ];
#pragma unroll
    for (int j = 0; j < NJ; ++j) acc[j] = (f32x4){0.f, 0.f, 0.f, 0.f};
    const float* kp = KR + tid + (n - 1);
    for (int s = 0; s < n; ++s) {
        const f32x4 u = U[s];
#pragma unroll
        for (int j = 0; j < NJ; ++j) acc[j] += u * kp[256 * j - s];
    }
    bf16_t* ox = (bf16_t*)(p.ws + OFF_OX);
#pragma unroll
    for (int j = 0; j < NJ; ++j) {
        const int t = tid + 256 * j;
#pragma unroll
        for (int bb = 0; bb < 4; ++bb) {
            const int b = bh * 4 + bb;
            const bf16_t* zb = zt + (size_t)b * 768 * n;
            const float x0 = hy_sconv(zb + (size_t)c * n, t, n, w00, w01, w02, b0);
            const float y = acc[j][bb] * x0;
            const int row = type ? NLAT + b * 256 + t : b * 2048 + t;
            ox[(size_t)row * 1024 + 768 + c] = (bf16_t)f2bf(y);
        }
    }
    __syncthreads();
}


typedef float f32x16 __attribute__((ext_vector_type(16)));
constexpr int HY_UROW = 2264;
constexpr int HY_KC_OFF = 8 * HY_UROW * 2;
constexpr int HY_KC_STRIDE = 8192 + 64;
DEV float hy_sc8(const bf16_t* zrow, int s0, int n, float w0, float w1, float w2, float bias, float (&o)[8]) {
    const u32x4 v = *(const u32x4*)(zrow + s0);
    const float zm = s0 > 0 ? bf2f(zrow[s0 - 1]) : 0.f, zp = s0 + 8 < n ? bf2f(zrow[s0 + 8]) : 0.f;
    float z[10]; z[0] = zm; z[9] = zp;
#pragma unroll
    for (int i = 0; i < 4; ++i) { z[1 + 2 * i] = __uint_as_float(v[i] << 16); z[2 + 2 * i] = __uint_as_float(v[i] & 0xffff0000u); }
#pragma unroll
    for (int i = 0; i < 8; ++i) o[i] = w0 * z[i] + w1 * z[i + 1] + w2 * z[i + 2] + bias;
    return 0.f;
}
DEV void hyena_mfma_item(const Params& p, int l, int c, char* lds) {
    const int tid = get_tid(), lane = tid & 63, wid = tid >> 6;
    constexpr int n = 2048;
    const bf16_t* zt = (const bf16_t*)(p.ws + OFF_ZTL);
    const bf16_t* kf = (const bf16_t*)(p.ws + OFF_KERNL + (size_t)l * 2 * 256 * 2048 * 2) + (size_t)c * n;
    const bf16_t* kb = kf + (size_t)256 * n;
    const float* cw = p.hy_conv_w + l * 3 * 768; const float* cb = p.hy_conv_b + l * 768;
    const float w10 = cw[256 + c], w11 = cw[768 + 256 + c], w12 = cw[1536 + 256 + c], b1 = cb[256 + c];
    const float wv0 = cw[512 + c], wv1 = cw[768 + 512 + c], wv2 = cw[1536 + 512 + c], bv = cb[512 + c];
    const float w00 = cw[c], w01 = cw[768 + c], w02 = cw[1536 + c], b0 = cb[c];
    for (int i = tid; i < 8 * 27; i += 256) {
        const int b = i / 27, k = i % 27;
        const int sp = k < 12 ? k * 8 : 96 + 2048 + (k - 12) * 8;
        *(u32x4*)(lds + (b * HY_UROW + sp) * 2) = (u32x4){0u, 0u, 0u, 0u};
    }
#pragma unroll 4
    for (int ch = tid; ch < 8 * 256; ch += 256) {
        const int b = ch >> 8, s0 = (ch & 255) * 8;
        const bf16_t* zb = zt + (size_t)b * 768 * n;
        float x1[8], vv[8];
        hy_sc8(zb + (size_t)(256 + c) * n, s0, n, w10, w11, w12, b1, x1);
        hy_sc8(zb + (size_t)(512 + c) * n, s0, n, wv0, wv1, wv2, bv, vv);
        *(u32x4*)(lds + (b * HY_UROW + 96 + s0) * 2) = (u32x4){pk2(vv[0] * x1[0], vv[1] * x1[1]), pk2(vv[2] * x1[2], vv[3] * x1[3]), pk2(vv[4] * x1[4], vv[5] * x1[5]), pk2(vv[6] * x1[6], vv[7] * x1[7])};
    }
    {
        char* R0 = lds + HY_KC_OFF;
#pragma unroll
        for (int j = 0; j < 2; ++j) {
            const int chn = tid + 256 * j;
            const bool fwd = chn < 256; const int d0 = (chn & 255) * 8;
            const u32x4 v = *(const u32x4*)((fwd ? kf : kb) + d0);
#pragma unroll
            for (int e = 0; e < 8; ++e) {
                const int d = d0 + e;
                const bf16_t val = (bf16_t)((e & 1) ? (v[e >> 1] >> 16) : (v[e >> 1] & 0xffffu));
                const int y = fwd ? 2047 - d : 2047 + d;
                if (fwd || d > 0) *(bf16_t*)(R0 + y * 2) = val;
            }
        }
        if (tid == 0) *(bf16_t*)(R0 + 4095 * 2) = 0;
    }
    __syncthreads();
    {
        const char* R0 = lds + HY_KC_OFF;
        for (int i = tid; i < 3 * 1024; i += 256) {
            const int q = 1 + i / 1024, y = (i % 1024) * 4;
            unsigned short e[4];
#pragma unroll
            for (int k = 0; k < 4; ++k) { const int yy = y + q + k; e[k] = yy <= 4094 ? *(const bf16_t*)(R0 + yy * 2) : (bf16_t)0; }
            *(u32x2*)(lds + HY_KC_OFF + q * HY_KC_STRIDE + y * 2) = (u32x2){(unsigned)e[0] | ((unsigned)e[1] << 16), (unsigned)e[2] | ((unsigned)e[3] << 16)};
        }
    }
    __syncthreads();
    const int i32 = lane & 31, h = lane >> 5, qn = i32 & 3, bn = i32 >> 2;
    const int T0 = 512 * __builtin_amdgcn_readfirstlane(wid);
    f32x16 acc[4];
#pragma unroll
    for (int g = 0; g < 4; ++g)
#pragma unroll
        for (int r = 0; r < 16; ++r) acc[g][r] = 0.f;
    const int dlo = T0 - 2032, dhi = T0 + 384 + 96;
    {
        const int a0 = 2047 - dlo - i32 + 8 * h, q4 = a0 & 3;
        const char* ap = lds + HY_KC_OFF + q4 * HY_KC_STRIDE + (a0 - q4) * 2;
        const char* bp = lds + (bn * HY_UROW + 96 + (T0 - dlo) + 32 * qn + 8 * h) * 2;
        union AF { bf16x8 v; u32x2 u[2]; };
        auto ldstep = [&](int dl, const char* ap_, const char* bp_, AF& a_, bf16x8 (&b_)[4]) {
            a_.u[0] = *(const u32x2*)ap_; a_.u[1] = *(const u32x2*)(ap_ + 8);
#pragma unroll
            for (int g = 0; g < 4; ++g) {
                const int S = T0 + 128 * g - dl;
                const char* q_ = (S >= -96 && S <= 2032) ? bp_ + 256 * g : lds;
                b_[g] = *(const bf16x8*)q_;
            }
        };
        AF a0_, a1_; bf16x8 b0_[4], b1_[4];
        ldstep(dlo, ap, bp, a0_, b0_);
#pragma unroll 1
        for (int dl = dlo; dl <= dhi; dl += 32) {
            ldstep(dl + 16, ap - 32, bp - 32, a1_, b1_);
#pragma unroll
            for (int g = 0; g < 4; ++g) acc[g] = __builtin_amdgcn_mfma_f32_32x32x16_bf16(a0_.v, b0_[g], acc[g], 0, 0, 0);
            ap -= 64; bp -= 64;
            const bool more = dl + 32 <= dhi;
            ldstep(more ? dl + 32 : dl, more ? ap : ap + 64, more ? bp : bp + 64, a0_, b0_);
#pragma unroll
            for (int g = 0; g < 4; ++g) acc[g] = __builtin_amdgcn_mfma_f32_32x32x16_bf16(a1_.v, b1_[g], acc[g], 0, 0, 0);
        }
    }
    __syncthreads();
#pragma unroll 4
    for (int ch = tid; ch < 8 * 256; ch += 256) {
        const int b = ch >> 8, s0 = (ch & 255) * 8;
        float x0[8];
        hy_sc8(zt + (size_t)b * 768 * n + (size_t)c * n, s0, n, w00, w01, w02, b0, x0);
        *(u32x4*)(lds + HY_KC_OFF + (b * 2048 + s0) * 2) = (u32x4){pk2(x0[0], x0[1]), pk2(x0[2], x0[3]), pk2(x0[4], x0[5]), pk2(x0[6], x0[7])};
    }
    __syncthreads();
    bf16_t* oxt = (bf16_t*)(p.ws + OFF_OXT) + (size_t)c * 2048;
#pragma unroll
    for (int g = 0; g < 4; ++g)
#pragma unroll
        for (int r4 = 0; r4 < 4; ++r4) {
            const int t = T0 + 128 * g + 32 * qn + 8 * r4 + 4 * h;
            const u32x2 xg = *(const u32x2*)(lds + HY_KC_OFF + (bn * 2048 + t) * 2);
            const float g0 = __uint_as_float(xg[0] << 16), g1 = __uint_as_float(xg[0] & 0xffff0000u), g2 = __uint_as_float(xg[1] << 16), g3 = __uint_as_float(xg[1] & 0xffff0000u);
            *(u32x2*)(oxt + (size_t)bn * 256 * 2048 + t) = (u32x2){pk2(acc[g][4 * r4 + 0] * g0, acc[g][4 * r4 + 1] * g1), pk2(acc[g][4 * r4 + 2] * g2, acc[g][4 * r4 + 3] * g3)};
        }
    __syncthreads();
}

DEV void phase_mix(const Params& p, int l, char* lds) {
    unsigned char* ws = p.ws;
    const bf16_t* QA = (const bf16_t*)(ws + OFF_QA); const bf16_t* QB = (const bf16_t*)(ws + OFF_QB);
    const bf16_t* KA = (const bf16_t*)(ws + OFF_KA); const bf16_t* VA = (const bf16_t*)(ws + OFF_VA);
    const bf16_t* KBp = (const bf16_t*)(ws + OFF_KB); const bf16_t* VBp = (const bf16_t*)(ws + OFF_VB);
    bf16_t* OX = (bf16_t*)(ws + OFF_OX);
    const int N0 = 256, N1 = N0 + 1024, N2 = N1 + 512;
    const int N3 = N2 + (l == 0 ? 512 : 0), N4 = N3 + (l == 0 ? 128 : 0), N5 = N4 + (l == 0 ? 64 : 0);
    int* qhead = (int*)(p.ws + OFF_QUEUE) + l * 64;
    int* qslot = (int*)(lds + SMEM_BYTES - 256);
    for (;;) {
        __syncthreads();
        if (get_tid() == 0) *qslot = atomicAdd(qhead, 1);
        __syncthreads();
        const int it = *qslot;
        if (it >= N5) break;
        if (it < N0) { hyena_mfma_item(p, l, it, lds); }
        else if (it < N1) {
            const int j = it - N0, b = j >> 7, h = (j >> 4) & 7, qb = j & 15;
            attn_block<2, false>(QA + (size_t)h * NT * 64, b * 2048 + qb * 128, KA + (size_t)(b * 2 + (h >> 2)) * KEYS * 64, VA + (size_t)(b * 2 + (h >> 2)) * KEYS * 64,
                                 36, OX + h * 64, 0, 0, 0, nullptr, lds);
        } else if (it < N2) {
            const int j = it - N1, b = j >> 6, h = (j >> 4) & 3, r = (j & 15) * 2;
            int rs0 = r - 4; rs0 = rs0 < 0 ? 0 : (rs0 > 24 ? 24 : rs0);
            int rs1 = r - 3; rs1 = rs1 < 0 ? 0 : (rs1 > 24 ? 24 : rs1);
            const int nwin = rs1 + 8 - rs0;
            attn_block<2, true>(QB + (size_t)h * NT * 64, b * 2048 + r * 64, KBp + (size_t)(b * 4 + h) * KEYS * 64, VBp + (size_t)(b * 4 + h) * KEYS * 64,
                                nwin + 4, OX + 512 + h * 64, r, rs0, nwin, p.nat_rpb + (size_t)(l * 4 + h) * 15 * 31, lds);
        } else if (it < N3) { const int j = it - N2; hyena_item<1>(p, l, 1, j >> 1, j & 1, lds); }
        else if (it < N4) {
            const int j = it - N3, b = j >> 4, h = (j >> 1) & 7, qb = j & 1;
            attn_block<2, false>(QA + (size_t)h * NT * 64, NLAT + b * 256 + qb * 128, KA + (size_t)(b * 2 + (h >> 2)) * KEYS * 64, VA + (size_t)(b * 2 + (h >> 2)) * KEYS * 64,
                                 4, OX + h * 64, 0, 0, 0, nullptr, lds);
        } else {
            const int j = it - N4, b = j >> 3, h = (j >> 1) & 3, qb = j & 1;
            attn_block<2, false>(QB + (size_t)h * NT * 64, NLAT + b * 256 + qb * 128, KBp + (size_t)(b * 4 + h) * KEYS * 64, VBp + (size_t)(b * 4 + h) * KEYS * 64,
                                 4, OX + 512 + h * 64, 0, 0, 0, nullptr, lds);
        }
    }
}

DEV void phase_outproj(const Params& p, int l, char* lds) {
    const int tid = get_tid(), lane = tid & 63, wid = tid >> 6, fr = lane & 15, fq = lane >> 4, wr = wid >> 1, wc = wid & 1;
    const bf16_t* OX = (const bf16_t*)(p.ws + OFF_OX);
    const bf16_t* W = (const bf16_t*)(p.ws + OFF_WOUT) + (size_t)l * 1024 * 1024;
    const float* mod = (const float*)(p.ws + OFF_MOD) + (size_t)l * 9 * 6144;
    bf16_t* X = (bf16_t*)(p.ws + OFF_X);
    const int nitems = (l == 0 ? 144 : 128) * 8;
    for (int it = blockIdx.x; it < nitems; it += gridDim.x) {
        const int mt = it >> 3, nt = it & 7, m0 = mt * 128, n0 = nt * 128;
        const unsigned a0 = (unsigned)m0 * 1024u + st64_off(tid), b0 = (unsigned)n0 * 1024u + st64_off(tid);
        f32x4 acc[4][4]; zero_acc<4, 4>(acc);
        const unsigned ao[4] = {a0, a0 + 32u * 1024u, a0 + 64u * 1024u, a0 + 96u * 1024u};
        const unsigned bo[4] = {b0, b0 + 32u * 1024u, b0 + 64u * 1024u, b0 + 96u * 1024u};
        gemm_core64<true>(acc, OX, ao, W, bo, 1024, lds, (const bf16_t*)(p.ws + OFF_OXT) + (size_t)((m0 >> 11) & 7) * 256 * 2048 + (m0 & 2047), m0 < NLAT ? 12 : 16);
        const float* g1 = mod + (size_t)mod_group(m0) * 6144 + 2048;
#pragma unroll
        for (int m = 0; m < 4; ++m) {
            const int row = m0 + wr * 64 + m * 16 + fr;
            const float* xin = row < NLAT ? p.x + (size_t)row * 1024 : p.ctx + (size_t)(row - NLAT) * 1024;
#pragma unroll
            for (int gg = 0; gg < 2; ++gg) {
                const int col = n0 + wc * 64 + gg * 32 + 8 * fq;
                f32x4 x0, x1;
                if (l == 0) { x0 = *(const f32x4*)(xin + col); x1 = *(const f32x4*)(xin + col + 4); }
                else { const u32x4 w = *(const u32x4*)(X + (size_t)row * 1024 + col);
                       x0 = (f32x4){__uint_as_float(w[0] << 16), __uint_as_float(w[0] & 0xffff0000u), __uint_as_float(w[1] << 16), __uint_as_float(w[1] & 0xffff0000u)};
                       x1 = (f32x4){__uint_as_float(w[2] << 16), __uint_as_float(w[2] & 0xffff0000u), __uint_as_float(w[3] << 16), __uint_as_float(w[3] & 0xffff0000u)}; }
                const f32x4 o0 = x0 * DN_ALPHA + *(const f32x4*)(g1 + col) * acc[m][2 * gg], o1 = x1 * DN_ALPHA + *(const f32x4*)(g1 + col + 4) * acc[m][2 * gg + 1];
                *(u32x4*)(X + (size_t)row * 1024 + col) = (u32x4){pk2(o0[0], o0[1]), pk2(o0[2], o0[3]), pk2(o1[0], o1[1]), pk2(o1[2], o1[3])};
            }
        }
    }
}

DEV void phase_ln1route(const Params& p, int l, char* lds) {
    const int tid = get_tid(), lane = tid & 63, wid = tid >> 6, fr = lane & 15, fq = lane >> 4;
    bf16_t* X = (bf16_t*)(p.ws + OFF_X);
    bf16_t* H = (bf16_t*)(p.ws + OFF_H);
    const bf16_t* RW = (const bf16_t*)(p.ws + OFF_RW) + (size_t)l * 64 * 1024;
    const float* mod = (const float*)(p.ws + OFF_MOD) + (size_t)l * 9 * 6144;
    int* cnt = (int*)(p.ws + OFF_CNT) + l * 64 * 64;
    int* tke = (int*)(p.ws + OFF_TKE); int* tks = (int*)(p.ws + OFF_TKS); float* tkw = (float*)(p.ws + OFF_TKW);
    int* list = (int*)(p.ws + OFF_LIST);
    char* HT = lds;
    float* LG = (float*)(lds + 16 * 2064);
    const float rbias = p.router_b[l * 64 + lane];
    const int rpw = (l == 0) ? 3 : 4, rpi = 4 * rpw;
    const int nitems = (l == 0 ? NT : NLAT) / rpi;
    u32x2 raw[4][4];
    f32x4 msh[4], msc[4];
    float* LNG = (float*)(lds + 50176);
    for (int i = tid; i < 512; i += 256) {
        const int c = (i & 255) * 4;
        *(f32x4*)(LNG + (i >> 8) * 1024 + c) = *(const f32x4*)((i >> 8 ? p.ln1_b : p.ln1_g) + l * 1024 + c);
    }
    if ((int)blockIdx.x < nitems) {
#pragma unroll
        for (int i = 0; i < 4; ++i) if (i < rpw)
#pragma unroll
            for (int j = 0; j < 4; ++j) raw[i][j] = *(const u32x2*)(X + (size_t)((int)blockIdx.x * rpi + wid * rpw + i) * 1024 + 4 * lane + 256 * j);
        const float* mg = mod + (size_t)mod_group((int)blockIdx.x * rpi + wid * rpw) * 6144;
#pragma unroll
        for (int j = 0; j < 4; ++j) { const int c = 4 * lane + 256 * j; msh[j] = *(const f32x4*)(mg + 3072 + c); msc[j] = *(const f32x4*)(mg + 4096 + c); }
    }
    __syncthreads();
    for (int it = blockIdx.x; it < nitems; it += gridDim.x) {
        const int m0 = it * rpi;
        const int g0 = mod_group(m0 + wid * rpw);
        f32x4 vv[4][4];
#pragma unroll
        for (int i = 0; i < 4; ++i) if (i < rpw)
#pragma unroll
            for (int j = 0; j < 4; ++j) { const u32x2 w = raw[i][j]; vv[i][j] = (f32x4){__uint_as_float(w[0] << 16), __uint_as_float(w[0] & 0xffff0000u), __uint_as_float(w[1] << 16), __uint_as_float(w[1] & 0xffff0000u)}; }
#pragma unroll
        for (int i = 0; i < 4; ++i) if (i < rpw) {
            const int rl = wid * rpw + i, row = m0 + rl;
            if (mod_group(row) != g0) {
                const float* mg = mod + (size_t)mod_group(row) * 6144;
#pragma unroll
                for (int j = 0; j < 4; ++j) { const int c = 4 * lane + 256 * j; msh[j] = *(const f32x4*)(mg + 3072 + c); msc[j] = *(const f32x4*)(mg + 4096 + c); }
            }
            row_norm(vv[i]);
#pragma unroll
            for (int j = 0; j < 4; ++j) {
                const int c = 4 * lane + 256 * j;
                vv[i][j] = vv[i][j] * *(const f32x4*)(LNG + c) + *(const f32x4*)(LNG + 1024 + c);
                st_bf4(X + (size_t)row * 1024 + c, vv[i][j]);
            }
            row_norm(vv[i]);
#pragma unroll
            for (int j = 0; j < 4; ++j) {
                const int c = 4 * lane + 256 * j;
                const f32x4 o = vv[i][j] * (msc[j] + 1.0f) + msh[j];
                const u32x2 w = (u32x2){pk2(o[0], o[1]), pk2(o[2], o[3])};
                *(u32x2*)(H + (size_t)row * 1024 + c) = w;
                *(u32x2*)(HT + rl * 2064 + c * 2) = w;
            }
        }
        f32x4 acc = (f32x4){0.f, 0.f, 0.f, 0.f};
        const bf16_t* bp = RW + (size_t)(wid * 16 + fr) * 1024 + fq * 8;
        bf16x8 bq[16];
#pragma unroll
        for (int ks = 0; ks < 16; ++ks) bq[ks] = *(const bf16x8*)(bp + ks * 32);
        __syncthreads();
#pragma unroll
        for (int ks = 0; ks < 16; ++ks) {
            const bf16x8 af = *(const bf16x8*)(HT + fr * 2064 + (ks * 32 + fq * 8) * 2);
            acc = mfma16(bq[ks], af, acc);
            bq[ks] = *(const bf16x8*)(bp + (ks + 16) * 32);
        }
#pragma unroll
        for (int ks = 0; ks < 16; ++ks) {
            const bf16x8 af = *(const bf16x8*)(HT + fr * 2064 + ((ks + 16) * 32 + fq * 8) * 2);
            acc = mfma16(bq[ks], af, acc);
        }
        *(f32x4*)(LG + fr * 64 + wid * 16 + 4 * fq) = acc;
        if (it + (int)gridDim.x < nitems) {
#pragma unroll
            for (int i = 0; i < 4; ++i) if (i < rpw)
#pragma unroll
                for (int j = 0; j < 4; ++j) raw[i][j] = *(const u32x2*)(X + (size_t)(m0 + (int)gridDim.x * rpi + wid * rpw + i) * 1024 + 4 * lane + 256 * j);
            const float* mg = mod + (size_t)mod_group(m0 + (int)gridDim.x * rpi + wid * rpw) * 6144;
#pragma unroll
            for (int j = 0; j < 4; ++j) { const int c = 4 * lane + 256 * j; msh[j] = *(const f32x4*)(mg + 3072 + c); msc[j] = *(const f32x4*)(mg + 4096 + c); }
        }
        __syncthreads();
        int* RS = (int*)(lds + 16 * 2064 + 4096 + 2048);
        float* RWt = (float*)(lds + 16 * 2064 + 4096 + 2048 + 4096);
        int lc = 0;
        unsigned* KW = (unsigned*)(lds + 16 * 2064 + 4096 + 2048 + 8192) + wid * 160;
#pragma unroll 1
        for (int i = 0; i < rpw; ++i) {
            const int rl = wid * rpw + i;
            const float sc = __builtin_amdgcn_rcpf(1.0f + __expf(-LG[rl * 64 + lane]));
            const float sel = sc + rbias;
            const int grp = lane >> 3;
            const unsigned key = (__float_as_uint(sel + 2.0f) & 0xFFFFFFC0u) | (unsigned)(63 - lane);
            KW[lane] = key;
            __builtin_amdgcn_wave_barrier();
            int rankg = 0;
            {
                const u32x4 k0 = *(const u32x4*)(KW + grp * 8), k1 = *(const u32x4*)(KW + grp * 8 + 4);
#pragma unroll
                for (int j = 0; j < 4; ++j) { rankg += (k0[j] > key) ? 1 : 0; rankg += (k1[j] > key) ? 1 : 0; }
            }
            float gs = rankg < 2 ? sel : 0.f;
            gs += __shfl_xor(gs, 1); gs += __shfl_xor(gs, 2); gs += __shfl_xor(gs, 4);
            const unsigned gkey = (__float_as_uint(gs + 4.0f) & 0xFFFFFFF8u) | (unsigned)(7 - grp);
            if ((lane & 7) == 0) KW[128 + grp] = gkey;
            __builtin_amdgcn_wave_barrier();
            int rg = 0;
            {
                const u32x4 g0 = *(const u32x4*)(KW + 128), g1 = *(const u32x4*)(KW + 132);
#pragma unroll
                for (int j = 0; j < 4; ++j) { rg += (g0[j] > gkey) ? 1 : 0; rg += (g1[j] > gkey) ? 1 : 0; }
            }
            const bool selg = rg < 4;
            const unsigned vkey = selg ? key : 0u;
            KW[64 + lane] = vkey;
            __builtin_amdgcn_wave_barrier();
            int rank = 0;
#pragma unroll
            for (int q = 0; q < 16; ++q) {
                const u32x4 kk = *(const u32x4*)(KW + 64 + q * 4);
#pragma unroll
                for (int j = 0; j < 4; ++j) rank += (kk[j] > vkey) ? 1 : 0;
            }
            const bool ch = selg && rank < 8;
            const float wsum = wave_sum(ch ? sc : 0.f);
            RS[rl * 64 + lane] = ch ? rank : -1;
            RWt[rl * 64 + lane] = sc * (2.5f * __builtin_amdgcn_rcpf(wsum));
            lc += ch ? 1 : 0;
            __builtin_amdgcn_wave_barrier();
        }
        int* WC = (int*)(lds + 16 * 2064 + 4096);
        WC[wid * 64 + lane] = lc;
        __syncthreads();
        if (wid == 0) {
            const int tot = WC[lane] + WC[64 + lane] + WC[128 + lane] + WC[192 + lane];
            int base = 0;
            if (tot > 0) base = atomicAdd(&cnt[lane * 64], tot);
            WC[256 + lane] = base;
        }
        __syncthreads();
        {
            int slot = WC[256 + lane];
#pragma unroll
            for (int w2 = 0; w2 < 4; ++w2) slot += (w2 < wid) ? WC[w2 * 64 + lane] : 0;
#pragma unroll 1
            for (int i = 0; i < rpw; ++i) {
                const int rl = wid * rpw + i, rk = RS[rl * 64 + lane];
                if (rk >= 0) {
                    const int row = m0 + rl;
                    list[(size_t)lane * NT + slot] = row * 8 + rk;
                    tke[row * 8 + rk] = lane; tks[row * 8 + rk] = slot; tkw[row * 8 + rk] = RWt[rl * 64 + lane];
                    ++slot;
                }
            }
        }
        __syncthreads();
    }
}

constexpr int YS_EXT_ROWS = NLAT * 1024 * 4 / 1024;
constexpr int PLAN_OFF = 68 * 1024;
DEV void moe_plan(const int* cnt, int cap, int l, char* lds) {
    int* PL = (int*)(lds + PLAN_OFF);
    const int tid = get_tid();
    __syncthreads();
    if (tid < 64) {
        const int lane = tid;
        const int c = cnt[lane * 64], tiles = (c + 127) >> 7;
        int pr = c, pt = tiles;
#pragma unroll
        for (int o = 1; o < 64; o <<= 1) { const int a = __shfl_up(pr, o), b = __shfl_up(pt, o); if (lane >= o) { pr += a; pt += b; } }
        const int G = (int)gridDim.x, nshu = 2 * ((l == 0 ? NT : NLAT) / 128);
        const int units = nshu + __builtin_amdgcn_readlane(pt, 63);
        const int cap8 = cap * 2;
        const bool one_round = __builtin_amdgcn_readlane(pr, 63) + nshu * 128 <= cap8;
        const int target0 = one_round ? 0 : ((units + G - 1) / G - 1) * G;
        PL[144 + lane] = c;
        int start = 0, base_r = 0, base_t = 0, round = 0;
        for (;;) {
            const int lim = (round == 0) ? ((target0 > 0) ? cap8 + YS_EXT_ROWS : cap8) - nshu * 128 : cap8;
            const bool bad = (lane >= start) && ((pr - base_r > lim) || (round == 0 && target0 > 0 && lane > 0 && nshu + pt > target0));
            const unsigned long long m = __ballot(bad);
            int end = m ? (int)__builtin_ctzll(m) : 64;
            if (end <= start) end = start + 1;
            if (lane >= start && lane < end) { PL[16 + lane] = pt - tiles - base_t; PL[80 + lane] = pr - c - base_r; }
            if (lane == 0) { PL[1 + round] = start; PL[10 + round] = __builtin_amdgcn_readlane(pt, end - 1) - base_t; PL[208 + round] = __builtin_amdgcn_readlane(pr, end - 1) - base_r; }
            if (end >= 64 || round >= 7) { if (lane == 0) { PL[0] = round + 1; PL[2 + round] = 64; } break; }
            base_r = __builtin_amdgcn_readlane(pr, end - 1); base_t = __builtin_amdgcn_readlane(pt, end - 1);
            start = end; ++round;
        }
    }
    __syncthreads();
}
constexpr float YS_SCALE = 32.0f, YS_INV = 1.0f / 32.0f;
DEV unsigned char* ys_row(const Params& p, int idx) {
    const int cap8 = p.cap * 2;
    return idx < cap8 ? p.ws + OFF_YS + (size_t)idx * 1024 : (unsigned char*)p.out + (size_t)(idx - cap8) * 1024;
}
DEV unsigned pk4_fp8(const f32x4& v) {
    int w = 0;
    w = __builtin_amdgcn_cvt_pk_fp8_f32(v[0] * YS_SCALE, v[1] * YS_SCALE, w, false);
    w = __builtin_amdgcn_cvt_pk_fp8_f32(v[2] * YS_SCALE, v[3] * YS_SCALE, w, true);
    return (unsigned)w;
}
DEV f32x4 up4_fp8(unsigned w) {
    const f32x2 lo = __builtin_amdgcn_cvt_pk_f32_fp8((int)w, false), hi = __builtin_amdgcn_cvt_pk_f32_fp8((int)w, true);
    return (f32x4){lo[0], lo[1], hi[0], hi[1]};
}

DEV void gemm_up256(f32x4 (&acc)[4][8], const bf16_t* A, const unsigned (&ao)[2], const bf16_t* B, const unsigned (&bo)[4], char* lds) {
    const int tid = get_tid(), lane = tid & 63, wid = tid >> 6, fr = lane & 15, fq = lane >> 4, wr = wid >> 1, wc = wid & 1;
    auto stage = [&](int s_, int t) {
        char* SA = lds + s_ * 24576; char* SB = SA + 8192;
#pragma unroll
        for (int i = 0; i < 2; ++i) glds16(A + (ao[i] + (unsigned)(t * 32)), SA + i * 4096 + tid * 16);
#pragma unroll
        for (int i = 0; i < 4; ++i) glds16(B + (bo[i] + (unsigned)(t * 32)), SB + i * 4096 + tid * 16);
    };
    WAIT_VM(0);
    stage(0, 0);
    stage(1, 1);
    const int aoff = (wr * 64 + fr) * 64 + fq * 16, boff = 8192 + (wc * 128 + fr) * 64 + fq * 16;
#pragma unroll 1
    for (int t = 0; t < 32; ++t) {
        if (t + 1 < 32) WAIT_VM(6); else WAIT_VM(0);
        RAW_BARRIER();
        const char* S = lds + (t & 1) * 24576;
        bf16x8 af[4], bfr[8];
#pragma unroll
        for (int m = 0; m < 4; ++m) af[m] = *(const bf16x8*)(S + aoff + m * 1024);
#pragma unroll
        for (int n = 0; n < 8; ++n) bfr[n] = *(const bf16x8*)(S + boff + n * 1024);
        WAIT_LGKM0();
        RAW_BARRIER();
        if (t + 2 < 32) stage(t & 1, t + 2);
        __builtin_amdgcn_s_setprio(1);
#pragma unroll
        for (int m = 0; m < 4; ++m)
#pragma unroll
            for (int n = 0; n < 8; ++n) acc[m][n] = mfma16(bfr[n], af[m], acc[m][n]);
        __builtin_amdgcn_s_setprio(0);
    }
}
template <bool SHARED>
DEV void moe_tile(const Params& p, const bf16_t* W13, const bf16_t* W2, const int* list, int s0, int nvalid, int ysbase, int m0, int half, const float* g2, char* lds) {
    const int tid = get_tid(), lane = tid & 63, wid = tid >> 6, fr = lane & 15, fq = lane >> 4, wr = wid >> 1, wc = wid & 1;
    const bf16_t* H = (const bf16_t*)(p.ws + OFF_H);
    const float* tkw = (const float*)(p.ws + OFF_TKW);
    char* ACT = lds;
    const unsigned ch4 = (unsigned)((tid & 3) * 8);
    unsigned ao[2];
    float gw[4];
    if (SHARED) {
#pragma unroll
        for (int i = 0; i < 2; ++i) ao[i] = (unsigned)(m0 + i * 64 + (tid >> 2)) * 1024u + ch4;
#pragma unroll
        for (int m = 0; m < 4; ++m) gw[m] = 1.0f;
    } else {
#pragma unroll
        for (int i = 0; i < 2; ++i) { const int rr = min(i * 64 + (tid >> 2), nvalid - 1); ao[i] = (unsigned)(list[s0 + rr] >> 3) * 1024u + ch4; }
#pragma unroll
        for (int m = 0; m < 4; ++m) { const int rl = min(wr * 64 + m * 16 + fr, nvalid - 1); gw[m] = tkw[list[s0 + rl]]; }
    }
    {
        const unsigned b0 = (unsigned)(tid >> 2) * 1024u + ch4;
        const unsigned bo[4] = {b0, b0 + 64u * 1024u, b0 + 128u * 1024u, b0 + 192u * 1024u};
        f32x4 acc[4][8];
#pragma unroll
        for (int m = 0; m < 4; ++m)
#pragma unroll
            for (int n = 0; n < 8; ++n) acc[m][n] = (f32x4){0.f, 0.f, 0.f, 0.f};
        gemm_up256(acc, H, ao, W13, bo, lds);
        __syncthreads();
#pragma unroll
        for (int m = 0; m < 4; ++m)
#pragma unroll
            for (int pp = 0; pp < 4; ++pp) {
                float o[4];
#pragma unroll
                for (int j = 0; j < 4; ++j) { const float a = acc[m][2 * pp][j], b = acc[m][2 * pp + 1][j]; o[j] = a * __builtin_amdgcn_rcpf(1.0f + __expf(-a)) * b * gw[m]; }
                *(u32x2*)(ACT + (wr * 64 + m * 16 + fr) * 272 + (wc * 64 + pp * 16 + 4 * fq) * 2) = (u32x2){pk2(o[0], o[1]), pk2(o[2], o[3])};
            }
    }
    __syncthreads();
    if (SHARED) {
        gemm2_stream64<128, 272>(W2, ACT, lds + 36864, [&](int nt, const f32x4 (&acc)[4][4]) {
#pragma unroll
            for (int m = 0; m < 4; ++m) {
                unsigned char* o = ys_row(p, ysbase + m0 + wr * 64 + m * 16 + fr) + nt * 128 + wc * 64 + 8 * fq;
#pragma unroll
                for (int g = 0; g < 2; ++g) *(u32x2*)(o + g * 32) = (u32x2){pk4_fp8(acc[m][2 * g]), pk4_fp8(acc[m][2 * g + 1])};
            }
        });
    } else {
        gemm2_stream64<128, 272>(W2, ACT, lds + 36864, [&](int nt, const f32x4 (&acc)[4][4]) {
#pragma unroll
            for (int m = 0; m < 4; ++m) {
                const int rl = wr * 64 + m * 16 + fr;
                if (rl < nvalid) {
                    unsigned char* o = ys_row(p, ysbase + s0 + rl) + nt * 128 + wc * 64 + 8 * fq;
#pragma unroll
                    for (int g = 0; g < 2; ++g) *(u32x2*)(o + g * 32) = (u32x2){pk4_fp8(acc[m][2 * g]), pk4_fp8(acc[m][2 * g + 1])};
                }
            }
        });
    }
    __syncthreads();
}
DEV void phase_moe(const Params& p, int l, int r, char* lds) {
    const int* cnt = (const int*)(p.ws + OFF_CNT) + l * 64 * 64;
    moe_plan(cnt, p.cap, l, lds);
    const int* PL = (const int*)(lds + PLAN_OFF);
    if (r >= PL[0]) return;
    const int e_lo = PL[1 + r], e_hi = PL[2 + r];
    const int nrt = PL[10 + r];
    const int nrows = (l == 0) ? NT : NLAT;
    const int nshu = (r == 0) ? 2 * (nrows / 128) : 0;
    const int G = (int)gridDim.x, b = vblock();
    const int q = (nshu + nrt + G - 1) / G;
    const int u0 = b * q, u1 = min(u0 + q, nshu + nrt);
    int e = e_lo;
    for (int u = u0; u < u1; ++u) {
        if (u < nshu) {
            const int m0 = (u >> 1) * 128, hh = u & 1;
            moe_tile<true>(p, (const bf16_t*)(p.ws + OFF_SW13) + (size_t)(l * 2 + hh) * 256 * 1024, (const bf16_t*)(p.ws + OFF_SW2) + (size_t)(l * 2 + hh) * 1024 * 128,
                           nullptr, 0, 128, PL[208] + hh * nrows, m0, hh, nullptr, lds);
        } else {
            const int it = u - nshu;
            while (e + 1 < e_hi && PL[16 + e + 1] <= it) ++e;
            const int s0 = (it - PL[16 + e]) * 128;
            moe_tile<false>(p, (const bf16_t*)(p.ws + OFF_W13) + (size_t)e * 256 * 1024, (const bf16_t*)(p.ws + OFF_W2) + (size_t)e * 1024 * 128,
                            (const int*)(p.ws + OFF_LIST) + (size_t)e * NT, s0, min(128, PL[144 + e] - s0), PL[80 + e], 0, 0, nullptr, lds);
        }
    }
}

DEV void phase_comb(const Params& p, int l, int r, char* lds) {
    const int tid_ = get_tid(), lane = tid_ & 63, wid = tid_ >> 6;
    const int* cnt = (const int*)(p.ws + OFF_CNT) + l * 64 * 64;
    moe_plan(cnt, p.cap, l, lds);
    const int* PL = (const int*)(lds + PLAN_OFF);
    if (r >= PL[0]) return;
    const int e_lo = PL[1 + r], e_hi = PL[2 + r];
    const bool final = (r == PL[0] - 1);
    bf16_t* X = (bf16_t*)(p.ws + OFF_X);
    bf16_t* H = (bf16_t*)(p.ws + OFF_H);
    const int* tke = (const int*)(p.ws + OFF_TKE); const int* tks = (const int*)(p.ws + OFF_TKS);
    const float* mod = (const float*)(p.ws + OFF_MOD);
    const int nrows = (l == 0) ? NT : NLAT;
    const int rstep = (int)gridDim.x * 4;
    auto issue = [&](int rw, int e, int sl, u32x4 (&yy)[10], u32x4& xa_, u32x4& xb_) {
        int idx_l = -1;
        if (lane < 8 && e >= e_lo && e < e_hi) idx_l = PL[80 + e] + sl;
        xa_ = *(const u32x4*)(X + (size_t)rw * 1024 + 16 * lane); xb_ = *(const u32x4*)(X + (size_t)rw * 1024 + 16 * lane + 8);
#pragma unroll
        for (int k = 0; k < 8; ++k) {
            const int idx = __builtin_amdgcn_readlane(idx_l, k);
            if (idx >= 0) yy[k] = *(const u32x4*)(ys_row(p, idx) + 16 * lane); else yy[k] = (u32x4){0u, 0u, 0u, 0u};
        }
        if (r == 0) { yy[8] = *(const u32x4*)(ys_row(p, PL[208] + rw) + 16 * lane); yy[9] = *(const u32x4*)(ys_row(p, PL[208] + nrows + rw) + 16 * lane); }
        else { yy[8] = (u32x4){0u, 0u, 0u, 0u}; yy[9] = yy[8]; }
    };
    int row = blockIdx.x * 4 + wid, rown = row + rstep;
    int e_n = 0, sl_n = 0;
    u32x4 y[10], xa, xb;
    if (row < nrows) {
        if (lane < 8) { e_n = tke[row * 8 + lane]; sl_n = tks[row * 8 + lane]; }
        issue(row, e_n, sl_n, y, xa, xb);
        if (rown < nrows && lane < 8) { e_n = tke[rown * 8 + lane]; sl_n = tks[rown * 8 + lane]; }
    }
    for (; row < nrows; row = rown, rown += rstep) {
        u32x4 y2[10], xa2, xb2;
        if (rown < nrows) {
            issue(rown, e_n, sl_n, y2, xa2, xb2);
            const int r3 = rown + rstep;
            if (r3 < nrows && lane < 8) { e_n = tke[r3 * 8 + lane]; sl_n = tks[r3 * 8 + lane]; }
        } else {
#pragma unroll
            for (int k = 0; k < 10; ++k) y2[k] = (u32x4){0u, 0u, 0u, 0u};
            xa2 = y2[0]; xb2 = y2[0];
        }
        const int g = mod_group(row);
        const float* g2 = mod + ((size_t)l * 9 + g) * 6144 + 5120 + 16 * lane;
        f32x4 v[4];
        {
            const u32x4 a = xa, b2 = xb;
            v[0] = (f32x4){__uint_as_float(a[0] << 16), __uint_as_float(a[0] & 0xffff0000u), __uint_as_float(a[1] << 16), __uint_as_float(a[1] & 0xffff0000u)};
            v[1] = (f32x4){__uint_as_float(a[2] << 16), __uint_as_float(a[2] & 0xffff0000u), __uint_as_float(a[3] << 16), __uint_as_float(a[3] & 0xffff0000u)};
            v[2] = (f32x4){__uint_as_float(b2[0] << 16), __uint_as_float(b2[0] & 0xffff0000u), __uint_as_float(b2[1] << 16), __uint_as_float(b2[1] & 0xffff0000u)};
            v[3] = (f32x4){__uint_as_float(b2[2] << 16), __uint_as_float(b2[2] & 0xffff0000u), __uint_as_float(b2[3] << 16), __uint_as_float(b2[3] & 0xffff0000u)};
        }
        f32x4 s[4];
#pragma unroll
        for (int j = 0; j < 4; ++j) s[j] = (f32x4){0.f, 0.f, 0.f, 0.f};
#pragma unroll
        for (int k = 0; k < 10; ++k)
#pragma unroll
            for (int j = 0; j < 4; ++j) s[j] += up4_fp8(y[k][j]);
        const float xs = (r == 0) ? DN_ALPHA : 1.0f;
#pragma unroll
        for (int j = 0; j < 4; ++j) v[j] = v[j] * xs + *(const f32x4*)(g2 + 4 * j) * (s[j] * YS_INV);
        if (!final) {
            u32x4 o0, o1;
            o0 = (u32x4){pk2(v[0][0], v[0][1]), pk2(v[0][2], v[0][3]), pk2(v[1][0], v[1][1]), pk2(v[1][2], v[1][3])};
            o1 = (u32x4){pk2(v[2][0], v[2][1]), pk2(v[2][2], v[2][3]), pk2(v[3][0], v[3][1]), pk2(v[3][2], v[3][3])};
            *(u32x4*)(X + (size_t)row * 1024 + 16 * lane) = o0; *(u32x4*)(X + (size_t)row * 1024 + 16 * lane + 8) = o1;
        } else {
            row_norm(v);
#pragma unroll
            for (int j = 0; j < 4; ++j) {
                const int c = 16 * lane + 4 * j;
                v[j] = v[j] * *(const f32x4*)(p.ln2_g + l * 1024 + c) + *(const f32x4*)(p.ln2_b + l * 1024 + c);
                if (l != 0) *(f32x4*)(p.out + (size_t)row * 1024 + c) = v[j];
            }
            if (l == 0) {
                u32x4 o0, o1;
                o0 = (u32x4){pk2(v[0][0], v[0][1]), pk2(v[0][2], v[0][3]), pk2(v[1][0], v[1][1]), pk2(v[1][2], v[1][3])};
                o1 = (u32x4){pk2(v[2][0], v[2][1]), pk2(v[2][2], v[2][3]), pk2(v[3][0], v[3][1]), pk2(v[3][2], v[3][3])};
                *(u32x4*)(X + (size_t)row * 1024 + 16 * lane) = o0; *(u32x4*)(X + (size_t)row * 1024 + 16 * lane + 8) = o1;
                row_norm(v);
                const float* m1 = mod + ((size_t)9 + g) * 6144 + 16 * lane;
                f32x4 h[4];
#pragma unroll
                for (int j = 0; j < 4; ++j) h[j] = v[j] * (*(const f32x4*)(m1 + 1024 + 4 * j) + 1.0f) + *(const f32x4*)(m1 + 4 * j);
                o0 = (u32x4){pk2(h[0][0], h[0][1]), pk2(h[0][2], h[0][3]), pk2(h[1][0], h[1][1]), pk2(h[1][2], h[1][3])};
                o1 = (u32x4){pk2(h[2][0], h[2][1]), pk2(h[2][2], h[2][3]), pk2(h[3][0], h[3][1]), pk2(h[3][2], h[3][3])};
                *(u32x4*)(H + (size_t)row * 1024 + 16 * lane) = o0; *(u32x4*)(H + (size_t)row * 1024 + 16 * lane + 8) = o1;
            }
        }
#pragma unroll
        for (int k = 0; k < 10; ++k) y[k] = y2[k];
        xa = xa2; xb = xb2;
    }
    if (final && l == 0) {
        __syncthreads();
        conv_run(p, 1, (int)blockIdx.x * 12, 12, lds);
    }
}


#define XB_TMO      128
#define XB_XCNT(j)  (256  + 64 * (j))
#define XB_XSUB(j)  (1280 + 64 * (j))
#define XB_XGEN(j)  (2304 + 64 * (j))
#define XB_TOP      3328
#define XB_TOPGEN   3392
#define XCD_BAR_WORDS 3456
#define XB_SPIN_CAP (1u << 22)
DEV unsigned xb_ld(unsigned* p) { return __hip_atomic_load(p, __ATOMIC_RELAXED, __HIP_MEMORY_SCOPE_AGENT); }
DEV unsigned xb_add(unsigned* p, unsigned v) { return __hip_atomic_fetch_add(p, v, __ATOMIC_RELAXED, __HIP_MEMORY_SCOPE_AGENT); }
DEV unsigned xb_xcc_id() { return (unsigned)__builtin_amdgcn_s_getreg((3 << 11) | 20) & 0xFu; }
#define XB_SPIN(cond, bar) do { unsigned _sp = 0; while (cond) { __builtin_amdgcn_s_sleep(1); \
    if ((++_sp & 255u) == 0u) { if (xb_ld(&(bar)[XB_TMO])) break; if (_sp > XB_SPIN_CAP) { atomicAdd(&(bar)[XB_TMO], 1u); break; } } } } while (0)
struct XcdBarrier { unsigned* bar; unsigned x; volatile LAS unsigned* st; };
DEV XcdBarrier xcd_barrier_post(unsigned* bar, volatile LAS unsigned* st) {
    XcdBarrier b; b.bar = bar; b.x = xb_xcc_id(); b.st = st;
    if (threadIdx.x == 0) (void)xb_add(&bar[XB_XCNT(b.x)], 1u);
    return b;
}
DEV void xcd_barrier_complete(unsigned* bar, unsigned x, unsigned& nloc, unsigned& nx) {
    const unsigned G = gridDim.x * gridDim.y * gridDim.z;
    unsigned sum, cnt, mine, sp = 0u;
    for (;;) {
        sum = 0u; cnt = 0u; mine = 0u;
#pragma unroll
        for (unsigned j = 0; j < 16; ++j) { const unsigned c = xb_ld(&bar[XB_XCNT(j)]); sum += c; cnt += (c > 0u) ? 1u : 0u; mine = (j == x) ? c : mine; }
        if (sum == G) break;
        __builtin_amdgcn_s_sleep(1);
        if ((++sp & 255u) == 0u) { if (xb_ld(&bar[XB_TMO])) break; if (sp > XB_SPIN_CAP) { atomicAdd(&bar[XB_TMO], 1u); break; } }
    }
    nloc = mine > 0u ? mine : 1u; nx = cnt > 0u ? cnt : 1u;
}
DEV void xcd_barrier(const XcdBarrier& b) {
    asm volatile("s_waitcnt vmcnt(0)" ::: "memory");
    __syncthreads();
    if (get_tid() == 0) {
        unsigned* bar = b.bar; asm volatile("" : "+s"(bar));
        __builtin_amdgcn_s_waitcnt(0);
        unsigned nloc = b.st[0], nx = b.st[1];
        if (nloc == 0u) { xcd_barrier_complete(bar, b.x, nloc, nx); b.st[0] = nloc; b.st[1] = nx; }
        const unsigned old = xb_add(&bar[XB_XSUB(b.x)], 1u);
        const unsigned gen = old / nloc;
        if (old + 1u == (gen + 1u) * nloc) {
            __builtin_amdgcn_fence(__ATOMIC_RELEASE, "agent");
            asm volatile("s_waitcnt vmcnt(0)" ::: "memory");
            const unsigned og = xb_add(&bar[XB_TOP], 1u);
            const unsigned tg = og / nx;
            if (og + 1u == (tg + 1u) * nx) xb_add(&bar[XB_TOPGEN], 1u);
            else XB_SPIN(xb_ld(&bar[XB_TOPGEN]) == tg, bar);
            __builtin_amdgcn_fence(__ATOMIC_ACQUIRE, "agent");
            xb_add(&bar[XB_XGEN(b.x)], 1u);
            asm volatile("s_waitcnt vmcnt(0)" ::: "memory");
        } else {
            XB_SPIN(xb_ld(&bar[XB_XGEN(b.x)]) == gen, bar);
            __builtin_amdgcn_fence(__ATOMIC_ACQUIRE, "agent");
            asm volatile("s_waitcnt vmcnt(0)" ::: "memory");
        }
    }
    __syncthreads();
}

enum { PT_PREP = 0, PT_MODFIN, PT_LNMOD0, PT_INPROJ, PT_MIX, PT_OUTPROJ, PT_LN1ROUTE, PT_MOE, PT_COMB };

DEV void run_phase(const Params& pin, int type, int l, int r, char* lds) {
    Params p = pin;
    { unsigned char* w = p.ws; asm volatile("" : "+s"(w)); p.ws = w; }
    switch (type) {
        case PT_PREP: phase_prep(p, lds); break;
        case PT_MODFIN: phase_modfin(p); break;
        case PT_LNMOD0: phase_lnmod0(p); break;
        case PT_INPROJ: phase_inproj(p, l, lds); break;
        case PT_MIX: phase_mix(p, l, lds); break;
        case PT_OUTPROJ: phase_outproj(p, l, lds); break;
        case PT_LN1ROUTE: phase_ln1route(p, l, lds); break;
        case PT_MOE: phase_moe(p, l, r, lds); break;
        default: phase_comb(p, l, r, lds); break;
    }
}

__global__ void __launch_bounds__(256, 2) fwd_kernel(Params p) {
    __shared__ __attribute__((aligned(16))) char smem[SMEM_BYTES];
#if MULTI_LAUNCH
    run_phase(p, p.ptype, p.pl, p.pr, smem);
#else
    if (threadIdx.x < 4) ((volatile LAS unsigned*)(smem + SMEM_BYTES - 16))[threadIdx.x] = 0u;
    __syncthreads();
    const XcdBarrier bar = xcd_barrier_post((unsigned*)(p.ws + OFF_BAR), (volatile LAS unsigned*)(smem + SMEM_BYTES - 16));
    int type = PT_PREP, l = 0, r = 0;
#if TELEM
    volatile LAS unsigned* tacc = (volatile LAS unsigned*)(smem + SMEM_BYTES - 128);
    if (threadIdx.x < 16) tacc[threadIdx.x] = 0u;
    unsigned long long t_prev = __builtin_amdgcn_s_memrealtime();
#endif
    for (;;) {
        run_phase(p, type, l, r, smem);
#if TELEM
        { const int ptype_done = type;
          xcd_barrier(bar);
          const unsigned long long t_now = __builtin_amdgcn_s_memrealtime();
          if (threadIdx.x == 0) tacc[ptype_done] += (unsigned)(t_now - t_prev);
          t_prev = t_now; }
#endif
        if (type < PT_MOE) { ++type; if (type == PT_MODFIN) ++type; r = 0; }
        else if (type == PT_MOE) type = PT_COMB;
        else {
            const int nr = ((const int*)(smem + PLAN_OFF))[0];
            if (r + 1 < nr) { ++r; type = PT_MOE; }
            else { if (l == 1) break; l = 1; r = 0; type = PT_INPROJ; }
        }
#if !TELEM
        xcd_barrier(bar);
#endif
    }
#if TELEM
    {
        unsigned* tel = (unsigned*)(p.ws + 36864);
        if (blockIdx.x == 0 && threadIdx.x == 0) { unsigned sa = 0u; for (int i = 0; i < 16; ++i) if ((TELEM_A >> i) & 1) sa += tacc[i]; tacc[15] = sa; }
        xcd_barrier(bar);
        if (blockIdx.x == 0 && threadIdx.x == 0) {
            p.out[0] += 1.0f + (float)tacc[TELEM_C] * 0.01f * 0.02f;
            const unsigned long long t0 = __builtin_amdgcn_s_memrealtime();
            const unsigned long long wait = 2ull * tacc[15];
            while (__builtin_amdgcn_s_memrealtime() - t0 < wait) __builtin_amdgcn_s_sleep(8);
        }
    }
#endif
#endif
}

extern "C" void kernel_launch(void* const* d_in, const int* in_sizes, int n_in, void* d_out, int out_size, void* d_ws, size_t ws_size, hipStream_t stream) {
    Params p{};
    const float** pp = (const float**)&p;
    for (int i = 0; i < 32; ++i) pp[i] = (const float*)d_in[i];
    p.out = (float*)d_out; p.ws = (unsigned char*)d_ws;
    long long cap = ((long long)ws_size - (long long)OFF_R) / 2048;
    if (cap > NT * 8) cap = NT * 8;
    if (cap * 2048 < (long long)R_MIN_BYTES || cap < NT) { fprintf(stderr, "kernel_launch: workspace too small (%zu)\n", ws_size); return; }
    p.cap = (int)cap;
#if MULTI_LAUNCH
    const int grid = 512;
    auto launch = [&](int type, int l, int r) { Params q = p; q.mode = 1; q.ptype = type; q.pl = l; q.pr = r; hipLaunchKernelGGL(fwd_kernel, dim3(grid), dim3(256), 0, stream, q); };
    launch(PT_PREP, 0, 0); launch(PT_MODFIN, 0, 0); launch(PT_LNMOD0, 0, 0);
    for (int l = 0; l < 2; ++l) {
        launch(PT_INPROJ, l, 0); launch(PT_MIX, l, 0); launch(PT_OUTPROJ, l, 0); launch(PT_LN1ROUTE, l, 0);
        for (int r = 0; r < RMAX; ++r) { launch(PT_MOE, l, r); launch(PT_COMB, l, r); }
    }
#else
    static int grid_blocks = 0;
    if (!grid_blocks) {
        int dev = 0, cus = 0, per_cu = 0;
        hipGetDevice(&dev);
        hipDeviceGetAttribute(&cus, hipDeviceAttributeMultiprocessorCount, dev);
        hipOccupancyMaxActiveBlocksPerMultiprocessor(&per_cu, fwd_kernel, 256, 0);
        if (per_cu > 2) per_cu = 2;
        if (per_cu < 1) per_cu = 1;
        grid_blocks = cus * per_cu;
    }
    p.mode = 0;
    hipMemsetAsync(d_ws, 0, 65536, stream);
    hipLaunchKernelGGL(fwd_kernel, dim3(grid_blocks), dim3(256), 0, stream, p);
#endif
}
```

```cpp
#include <hip/hip_runtime.h>
#ifndef TELEM
#define TELEM 0
#endif
#define TELEM_A 0x1
#define TELEM_C 8
#include <hip/hip_cooperative_groups.h>
#include <stdint.h>
#include <stdio.h>
namespace cg = cooperative_groups;

#ifndef MULTI_LAUNCH
#define MULTI_LAUNCH 0
#endif

typedef unsigned short bf16_t;
typedef short bf16x8 __attribute__((ext_vector_type(8)));
typedef short s16x4 __attribute__((ext_vector_type(4)));
typedef float f32x4 __attribute__((ext_vector_type(4)));
typedef unsigned u32x4 __attribute__((ext_vector_type(4)));
typedef unsigned u32x2 __attribute__((ext_vector_type(2)));
#define DEV __device__ __forceinline__
#define LDSP(T) __attribute__((address_space(3))) T*
#define LAS __attribute__((address_space(3)))

constexpr int D = 1024, NB = 8, SEQ = 2048, CTX = 256, NLAT = NB * SEQ, NCTX = NB * CTX, NT = NLAT + NCTX;
constexpr int PROJ = 2304, KEYS = CTX + SEQ, NEXP = 64;
constexpr float DN_ALPHA = 1.41421356237309515f;
constexpr float LOG2E = 1.44269504088896341f;
constexpr int SMEM_BYTES = 72 * 1024;
constexpr int RMAX = 4;

constexpr size_t OFF_CNT = 0;
constexpr size_t OFF_QUEUE = 33792;
constexpr size_t OFF_BAR = 40960;
constexpr size_t OFF_MOD = 65536;
constexpr size_t OFF_ROPE = OFF_MOD + 442368;
constexpr size_t OFF_KERNL = OFF_ROPE + 2ull * 2048 * 32 * 4;
constexpr size_t OFF_KERNC = OFF_KERNL + 2ull * 4096 * 256 * 4;
constexpr size_t OFF_TKE = OFF_KERNC + 2ull * 512 * 256 * 4;
constexpr size_t OFF_TKS = OFF_TKE + (size_t)NT * 8 * 4;
constexpr size_t OFF_TKW = OFF_TKS + (size_t)NT * 8 * 4;
constexpr size_t OFF_LIST = OFF_TKW + (size_t)NT * 8 * 4;
constexpr size_t OFF_WIN = OFF_LIST + 64ull * NT * 4;
constexpr size_t OFF_WOUT = OFF_WIN + 2ull * 2304 * 1024 * 2;
constexpr size_t OFF_SW13 = OFF_WOUT + 2ull * 1024 * 1024 * 2;
constexpr size_t OFF_SW2 = OFF_SW13 + 2ull * 512 * 1024 * 2;
constexpr size_t OFF_RW = OFF_SW2 + 2ull * 1024 * 256 * 2;
constexpr size_t OFF_W13 = OFF_RW + 2ull * 64 * 1024 * 2;
constexpr size_t OFF_W2 = OFF_W13 + 64ull * 256 * 1024 * 2;
constexpr size_t OFF_X = OFF_W2 + 64ull * 1024 * 128 * 2;
constexpr size_t OFF_H = OFF_X + (size_t)NT * 1024 * 2;
constexpr size_t OFF_R = OFF_H + (size_t)NT * 1024 * 2;
constexpr size_t OFF_QA = OFF_R;
constexpr size_t OFF_QB = OFF_QA + 8ull * NT * 64 * 2;
constexpr size_t OFF_KA = OFF_QB + 4ull * NT * 64 * 2;
constexpr size_t OFF_VA = OFF_KA + 8ull * 2 * KEYS * 64 * 2;
constexpr size_t OFF_KB = OFF_VA + 8ull * 2 * KEYS * 64 * 2;
constexpr size_t OFF_VB = OFF_KB + 8ull * 4 * KEYS * 64 * 2;
constexpr size_t OFF_ZTL = OFF_VB + 8ull * 4 * KEYS * 64 * 2;
constexpr size_t OFF_ZTC = OFF_ZTL + 8ull * 768 * 2048 * 2;
constexpr size_t OFF_OX = OFF_ZTC + 8ull * 768 * 256 * 2;
constexpr size_t OFF_OXT = OFF_OX + (size_t)NT * 1024 * 2;
constexpr size_t R_MIN_BYTES = OFF_OXT + 8ull * 256 * 2048 * 2 - OFF_R;
constexpr size_t OFF_PART = OFF_R;
constexpr size_t OFF_YS = OFF_R;

struct Params {
    const float *x, *c, *ctx, *c_ctx, *ada_w, *ada_b, *w_in, *q_gain, *k_gain, *nat_rpb, *hy_conv_w, *hy_conv_b,
        *hy_f_w1, *hy_f_b1, *hy_f_w2, *hy_f_b2, *hy_f_w3, *hy_freq, *hy_skip, *w_out, *ln1_g, *ln1_b,
        *router_w, *router_b, *exp_w1, *exp_w3, *exp_w2, *sh_w1, *sh_w3, *sh_w2, *ln2_g, *ln2_b;
    float* out; unsigned char* ws;
    int cap, mode, ptype, pl, pr, pad;
};

typedef __bf16 hwbf2 __attribute__((ext_vector_type(2)));
typedef float f32x2 __attribute__((ext_vector_type(2)));
DEV unsigned f2bf(float f) { return (unsigned)__builtin_bit_cast(unsigned short, (__bf16)f); }
DEV unsigned pk2(float lo, float hi) { const f32x2 v = {lo, hi}; return __builtin_bit_cast(unsigned, __builtin_convertvector(v, hwbf2)); }
DEV float bf2f(unsigned short h) { return __uint_as_float(((unsigned)h) << 16); }
DEV float wave_sum(float v) {
#pragma unroll
    for (int o = 32; o > 0; o >>= 1) v += __shfl_xor(v, o);
    return v;
}
DEV void glds16(const void* g, void* l) { __builtin_amdgcn_global_load_lds((const unsigned*)g, (unsigned*)l, 16, 0, 0); }
DEV f32x4 mfma16(bf16x8 a, bf16x8 b, f32x4 c) { return __builtin_amdgcn_mfma_f32_16x16x32_bf16(a, b, c, 0, 0, 0); }
DEV float readlane_f(float v, int l) { return __uint_as_float((unsigned)__builtin_amdgcn_readlane((int)__float_as_uint(v), l)); }
DEV int get_tid() { int t = threadIdx.x; asm volatile("" : "+v"(t)); return t; }
DEV int lchunk(int tid) { return (tid & 3) ^ ((0 - (tid >> 4)) & 3); }
DEV int vblock() { const int G = (int)gridDim.x, b = (int)blockIdx.x; return (G & 7) ? b : (b & 7) * (G >> 3) + (b >> 3); }
DEV int mod_group(int row) { return row < NLAT ? (row >> 11) : 8; }

template <int MI, int NI> DEV void zero_acc(f32x4 (&acc)[MI][NI]) {
#pragma unroll
    for (int m = 0; m < MI; ++m)
#pragma unroll
        for (int n = 0; n < NI; ++n) acc[m][n] = (f32x4){0.f, 0.f, 0.f, 0.f};
}
#define WAIT_VM(n) asm volatile("s_waitcnt vmcnt(" #n ")" ::: "memory")
#define WAIT_LGKM0() asm volatile("s_waitcnt lgkmcnt(0)" ::: "memory")
#define RAW_BARRIER() do { asm volatile("" ::: "memory"); __builtin_amdgcn_s_barrier(); asm volatile("" ::: "memory"); } while (0)
template <int MI, int NI, bool TRANS>
DEV void gemm_core(f32x4 (&acc)[MI][NI], const bf16_t* A, const unsigned (&ao)[MI / 2], const bf16_t* B, const unsigned (&bo)[NI / 2], int K, char* lds) {
    const int tid = get_tid(), lane = tid & 63, wid = tid >> 6, fr = lane & 15, fq = lane >> 4, wr = wid >> 1, wc = wid & 1;
    constexpr int SAB = 2048 * MI, STG = 2048 * (MI + NI), LPT = MI / 2 + NI / 2;
    static_assert(LPT == 3 || LPT == 4 || LPT == 6, "loads per tile");
    const int nt = K >> 5;
    auto stage = [&](int s, int t) {
        char* SA = lds + s * STG; char* SB = SA + SAB;
#pragma unroll
        for (int i = 0; i < MI / 2; ++i) glds16(A + (ao[i] + (unsigned)(t * 32)), SA + i * 4096 + tid * 16);
#pragma unroll
        for (int i = 0; i < NI / 2; ++i) glds16(B + (bo[i] + (unsigned)(t * 32)), SB + i * 4096 + tid * 16);
    };
    WAIT_VM(0);
    stage(0, 0);
    if (nt > 1) stage(1, 1);
    const int sw = (fq ^ ((0 - (fr >> 2)) & 3)) * 16;
    const int aoff = (wr * MI * 16 + fr) * 64 + sw, boff = SAB + (wc * NI * 16 + fr) * 64 + sw;
#pragma unroll 1
    for (int t = 0; t < nt; ++t) {
        if (t + 1 < nt) { if (LPT == 6) WAIT_VM(6); else if (LPT == 4) WAIT_VM(4); else WAIT_VM(3); } else WAIT_VM(0);
        RAW_BARRIER();
        const char* S = lds + (t & 1) * STG;
        bf16x8 af[MI], bfr[NI];
#pragma unroll
        for (int m = 0; m < MI; ++m) af[m] = *(const bf16x8*)(S + aoff + m * 1024);
#pragma unroll
        for (int n = 0; n < NI; ++n) bfr[n] = *(const bf16x8*)(S + boff + n * 1024);
        WAIT_LGKM0();
        RAW_BARRIER();
        if (t + 2 < nt) stage(t & 1, t + 2);
#pragma unroll
        for (int m = 0; m < MI; ++m)
#pragma unroll
            for (int n = 0; n < NI; ++n) acc[m][n] = TRANS ? mfma16(bfr[n], af[m], acc[m][n]) : mfma16(af[m], bfr[n], acc[m][n]);
    }
}
DEV unsigned st64_off(int tid) { return (unsigned)(tid >> 3) * 1024u + (unsigned)(((tid & 7) ^ ((tid >> 3) & 7)) * 8); }
DEV int tr_key(int row) { return (row & 3) | (((row >> 3) & 1) << 2); }
template <bool TRANS>
DEV void gemm_core64(f32x4 (&acc)[4][4], const bf16_t* A, const unsigned (&ao)[4], const bf16_t* B, const unsigned (&bo)[4], int K, char* lds,
                     const bf16_t* AT = nullptr, int t_tr = 1 << 20) {
    const int tid = get_tid(), lane = tid & 63, wid = tid >> 6, fr = lane & 15, fq = lane >> 4, wr = wid >> 1, wc = wid & 1;
    const int nt = K >> 6;
    auto stage = [&](int s, int t) {
        char* SA = lds + s * 32768; char* SB = SA + 16384;
        if (t >= t_tr) {
#pragma unroll
            for (int i = 0; i < 4; ++i) {
                const int id = tid + 256 * i, row = id >> 4, cp = id & 15, c = (cp - 2 * tr_key(row)) & 15;
                glds16(AT + (size_t)((t - t_tr) * 64 + row) * 2048 + c * 8, SA + id * 16);
            }
        } else {
#pragma unroll
            for (int i = 0; i < 4; ++i) glds16(A + (ao[i] + (unsigned)(t * 64)), SA + i * 4096 + tid * 16);
        }
#pragma unroll
        for (int i = 0; i < 4; ++i) glds16(B + (bo[i] + (unsigned)(t * 64)), SB + i * 4096 + tid * 16);
    };
    WAIT_VM(0);
    stage(0, 0);
    if (nt > 1) stage(1, 1);
    const int rsw = fr & 7;
    const int arow = (wr * 64 + fr) * 128, brow = 16384 + (wc * 64 + fr) * 128;
    const int c0 = ((fq) ^ rsw) * 16, c1 = ((4 + fq) ^ rsw) * 16;
#pragma unroll 1
    for (int t = 0; t < nt; ++t) {
        if (t + 1 < nt) WAIT_VM(8); else WAIT_VM(0);
        RAW_BARRIER();
        const char* S = lds + (t & 1) * 32768;
        bf16x8 af[4][2], bfr[4][2];
        if (t >= t_tr) {
            const int q4 = fr >> 2, p4 = fr & 3;
#pragma unroll
            for (int m = 0; m < 4; ++m)
#pragma unroll
                for (int ks = 0; ks < 2; ++ks) {
                    const int rowA = ks * 32 + 8 * fq + q4, rowB = rowA + 4, c = wr * 8 + m * 2 + (p4 >> 1);
                    const int offA = rowA * 256 + (((c + 2 * tr_key(rowA)) & 15) * 16) + (p4 & 1) * 8;
                    const int offB = rowB * 256 + (((c + 2 * tr_key(rowB)) & 15) * 16) + (p4 & 1) * 8;
                    const s16x4 ta = __builtin_amdgcn_ds_read_tr16_b64_v4i16((LDSP(s16x4))(S + offA));
                    const s16x4 tb = __builtin_amdgcn_ds_read_tr16_b64_v4i16((LDSP(s16x4))(S + offB));
                    bf16x8 f; f[0] = ta[0]; f[1] = ta[1]; f[2] = ta[2]; f[3] = ta[3]; f[4] = tb[0]; f[5] = tb[1]; f[6] = tb[2]; f[7] = tb[3];
                    af[m][ks] = f;
                }
        } else {
#pragma unroll
            for (int m = 0; m < 4; ++m) { af[m][0] = *(const bf16x8*)(S + arow + m * 2048 + c0); af[m][1] = *(const bf16x8*)(S + arow + m * 2048 + c1); }
        }
#pragma unroll
        for (int n = 0; n < 4; ++n) { bfr[n][0] = *(const bf16x8*)(S + brow + n * 2048 + c0); bfr[n][1] = *(const bf16x8*)(S + brow + n * 2048 + c1); }
        WAIT_LGKM0();
        RAW_BARRIER();
        if (t + 2 < nt) stage(t & 1, t + 2);
        __builtin_amdgcn_s_setprio(1);
#pragma unroll
        for (int ks = 0; ks < 2; ++ks)
#pragma unroll
            for (int m = 0; m < 4; ++m)
#pragma unroll
                for (int n = 0; n < 4; ++n) acc[m][n] = TRANS ? mfma16(bfr[n][ks], af[m][ks], acc[m][n]) : mfma16(af[m][ks], bfr[n][ks], acc[m][n]);
        __builtin_amdgcn_s_setprio(0);
    }
}
template <int KACT, int ASTRIDE, class EPI>
DEV void gemm2_stream64(const bf16_t* W2, const char* ACT, char* sb, EPI&& epi) {
    const int tid = get_tid(), lane = tid & 63, wid = tid >> 6, fr = lane & 15, fq = lane >> 4, wr = wid >> 1, wc = wid & 1;
    constexpr int KS = KACT / 64, NJ = 8 * KS;
    const unsigned b0 = (unsigned)(tid >> 3) * KACT + (unsigned)(((tid & 7) ^ ((tid >> 3) & 7)) * 8);
    auto stage = [&](int s, int j) {
        const int nt = j / KS, ks = j % KS;
        char* SB = sb + s * 16384;
        const bf16_t* src = W2 + (size_t)nt * 128 * KACT + ks * 64 + b0;
#pragma unroll
        for (int i = 0; i < 4; ++i) glds16(src + (size_t)i * 32 * KACT, SB + i * 4096 + tid * 16);
    };
    WAIT_VM(0);
    stage(0, 0); stage(1, 1);
    const int rsw = fr & 7;
    const int brow = (wc * 64 + fr) * 128, c0 = (fq ^ rsw) * 16, c1 = ((4 + fq) ^ rsw) * 16;
    f32x4 acc[4][4]; zero_acc<4, 4>(acc);
#pragma unroll 1
    for (int j = 0; j < NJ; ++j) {
        const int ks = j % KS;
        if (j + 1 < NJ) WAIT_VM(4); else WAIT_VM(0);
        RAW_BARRIER();
        const char* S = sb + (j & 1) * 16384;
        bf16x8 af[4][2], bfr[4][2];
#pragma unroll
        for (int m = 0; m < 4; ++m) { const char* ar = ACT + (wr * 64 + m * 16 + fr) * ASTRIDE + (ks * 64 + fq * 8) * 2; af[m][0] = *(const bf16x8*)ar; af[m][1] = *(const bf16x8*)(ar + 64); }
#pragma unroll
        for (int n = 0; n < 4; ++n) { bfr[n][0] = *(const bf16x8*)(S + brow + n * 2048 + c0); bfr[n][1] = *(const bf16x8*)(S + brow + n * 2048 + c1); }
        WAIT_LGKM0();
        RAW_BARRIER();
        if (j + 2 < NJ) stage(j & 1, j + 2);
#pragma unroll
        for (int k2 = 0; k2 < 2; ++k2)
#pragma unroll
            for (int m = 0; m < 4; ++m)
#pragma unroll
                for (int n = 0; n < 4; ++n) acc[m][n] = mfma16(bfr[n][k2], af[m][k2], acc[m][n]);
        if (ks == KS - 1) { epi(j / KS, acc); zero_acc<4, 4>(acc); }
    }
}
template <int MI, int KACT, int ASTRIDE, class EPI>
DEV void gemm2_stream(const bf16_t* W2, const char* ACT, char* sb, EPI&& epi) {
    const int tid = get_tid(), lane = tid & 63, wid = tid >> 6, fr = lane & 15, fq = lane >> 4, wr = wid >> 1, wc = wid & 1;
    constexpr int KS = KACT / 32, NJ = 8 * KS;
    const bf16_t* b0 = W2 + (size_t)(tid >> 2) * KACT + lchunk(tid) * 8;
    auto stage = [&](int s, int j) {
        const int nt = j / KS, ks = j % KS;
        char* SB = sb + s * 8192;
        const bf16_t* src = b0 + (size_t)nt * 128 * KACT + ks * 32;
        glds16(src, SB + tid * 16);
        glds16(src + 64 * KACT, SB + 4096 + tid * 16);
    };
    WAIT_VM(0);
    stage(0, 0); stage(1, 1);
    const int boff = (wc * 64 + fr) * 64 + (fq ^ ((0 - (fr >> 2)) & 3)) * 16;
    f32x4 acc[MI][4]; zero_acc<MI, 4>(acc);
#pragma unroll 1
    for (int j = 0; j < NJ; ++j) {
        const int ks = j % KS;
        if (j + 1 < NJ) WAIT_VM(2); else WAIT_VM(0);
        RAW_BARRIER();
        const char* S = sb + (j & 1) * 8192;
        bf16x8 af[MI], bfr[4];
#pragma unroll
        for (int m = 0; m < MI; ++m) af[m] = *(const bf16x8*)(ACT + (wr * MI * 16 + m * 16 + fr) * ASTRIDE + (ks * 32 + fq * 8) * 2);
#pragma unroll
        for (int n = 0; n < 4; ++n) bfr[n] = *(const bf16x8*)(S + boff + n * 1024);
        WAIT_LGKM0();
        RAW_BARRIER();
        if (j + 2 < NJ) stage(j & 1, j + 2);
#pragma unroll
        for (int m = 0; m < MI; ++m)
#pragma unroll
            for (int n = 0; n < 4; ++n) acc[m][n] = mfma16(bfr[n], af[m], acc[m][n]);
        if (ks == KS - 1) { epi(j / KS, acc); zero_acc<MI, 4>(acc); }
    }
}

DEV void prep_mod_item(const Params& p, int it, char* lds) {
    const int l = it / 96, r = it % 96, cch = r >> 2, kp = r & 3, tid = get_tid(), lane = tid & 63, kq = tid >> 6;
    float* sl = (float*)lds;
    float* red = sl + 9 * 256;
    for (int i = tid; i < 9 * 256; i += 256) { const int g = i >> 8, k = kp * 256 + (i & 255); const float v = (g < 8) ? p.c[g * 1024 + k] : p.c_ctx[k]; sl[i] = v * __builtin_amdgcn_rcpf(1.f + __expf(-v)); }
    __syncthreads();
    f32x4 acc[9];
#pragma unroll
    for (int g = 0; g < 9; ++g) acc[g] = (f32x4){0.f, 0.f, 0.f, 0.f};
    const float* w = p.ada_w + ((size_t)l * 1024 + kp * 256 + kq * 64) * 6144 + cch * 256 + lane * 4;
#pragma unroll 16
    for (int kk = 0; kk < 64; ++kk) {
        const f32x4 wv = *(const f32x4*)(w + (size_t)kk * 6144);
#pragma unroll
        for (int g = 0; g < 9; ++g) { const float sv = sl[g * 256 + kq * 64 + kk]; acc[g] += sv * wv; }
    }
#pragma unroll
    for (int g = 0; g < 9; ++g) *(f32x4*)(red + (kq * 9 + g) * 256 + lane * 4) = acc[g];
    __syncthreads();
    float* part = (float*)(p.ws + OFF_R) + (size_t)(l * 24 + cch) * 4 * 2304;
    for (int i = tid; i < 9 * 256; i += 256) {
        const int g = i >> 8, c = i & 255;
        part[kp * 2304 + i] = (red[(0 * 9 + g) * 256 + c] + red[(1 * 9 + g) * 256 + c]) + (red[(2 * 9 + g) * 256 + c] + red[(3 * 9 + g) * 256 + c]);
    }
    __threadfence();
    __syncthreads();
    int* arrive = (int*)(lds + SMEM_BYTES - 252);
    if (tid == 0) *arrive = atomicAdd((int*)(p.ws + OFF_QUEUE) + 256 + l * 24 + cch, 1);
    __syncthreads();
    if (*arrive == 3) {
        __threadfence();
        float* mod = (float*)(p.ws + OFF_MOD);
        for (int i = tid; i < 9 * 256; i += 256) {
            const int g = i >> 8, c = i & 255;
            const float v = (__builtin_nontemporal_load(part + i) + __builtin_nontemporal_load(part + 2304 + i)) + (__builtin_nontemporal_load(part + 2 * 2304 + i) + __builtin_nontemporal_load(part + 3 * 2304 + i));
            mod[((size_t)l * 9 + g) * 6144 + cch * 256 + c] = p.ada_b[l * 6144 + cch * 256 + c] + v;
        }
    }
    __syncthreads();
}
constexpr float INV2PI = 0.15915494309189535f;
DEV float sin_rev(float r) { return __builtin_amdgcn_sinf(__builtin_amdgcn_fractf(r)); }
DEV float cos_rev(float r) { return __builtin_amdgcn_cosf(__builtin_amdgcn_fractf(r)); }
DEV void prep_rope_item(const Params& p, int it) {
    const int idx = it * 256 + get_tid(), t = idx >> 5, i = idx & 31;
    const float inv = __builtin_amdgcn_exp2f(-(float)(2 * (i & 15)) * (13.287712379549449f / 32.f));
    const float ang = (float)((i < 16) ? (t >> 6) : (t & 63)) * inv;
    float* rc = (float*)(p.ws + OFF_ROPE);
    rc[idx] = cos_rev(ang * INV2PI); rc[2048 * 32 + idx] = sin_rev(ang * INV2PI);
}
DEV void prep_filter_item(const Params& p, int it, char* lds) {
    const int tid = get_tid(), lane = tid & 63, wid = tid >> 6;
    const int row0 = it * 32 + wid * 8;
    const int l = row0 / 2304, r0 = row0 % 2304, type = r0 < 2048 ? 0 : 1, t0 = type ? r0 - 2048 : r0, n = type ? 256 : 2048;
    float* z = (float*)lds + wid * (8 * 192); float* h1 = z + 8 * 64; float* h2 = h1 + 8 * 64;
    float* WL = (float*)(lds + 24576);
    const float rn1 = type ? 1.f / 255.f : 1.f / 2047.f;
    for (int idx = tid; idx < 97 * 16; idx += 256) {
        const int row = idx >> 4, c4 = (idx & 15) * 4;
        const float* src = row < 33 ? p.hy_f_w1 + (l * 33 + row) * 64 : p.hy_f_w2 + (l * 64 + row - 33) * 64;
        *(f32x4*)(WL + row * 64 + c4) = *(const f32x4*)(src + c4);
    }
#pragma unroll
    for (int rr = 0; rr < 8; ++rr) {
        const int t = t0 + rr;
        if (lane < 33) {
            float v;
            if (lane == 0) v = (float)t * rn1;
            else {
                const int i = (lane - 1) & 15;
                const float f = 1e-4f + (float)i * ((15.f - 1e-4f) / 15.f);
                const float rev = f * ((float)t * (type ? 1.f / 256.f : 1.f / 2048.f));
                v = (lane <= 16) ? cos_rev(rev) : -sin_rev(rev);
            }
            z[rr * 64 + lane] = v;
        }
    }
    __syncthreads();
    {
        float s[8]; const float b = p.hy_f_b1[l * 64 + lane];
#pragma unroll
        for (int rr = 0; rr < 8; ++rr) s[rr] = b;
#pragma unroll 11
        for (int i = 0; i < 33; ++i) {
            const float w = WL[i * 64 + lane];
#pragma unroll
            for (int rr = 0; rr < 8; ++rr) s[rr] += z[rr * 64 + i] * w;
        }
        const float fq0 = p.hy_freq[(l * 2 + 0) * 64 + lane];
#pragma unroll
        for (int rr = 0; rr < 8; ++rr) h1[rr * 64 + lane] = sin_rev(fq0 * s[rr] * INV2PI);
    }
    __builtin_amdgcn_wave_barrier();
    {
        float s[8]; const float b = p.hy_f_b2[l * 64 + lane];
#pragma unroll
        for (int rr = 0; rr < 8; ++rr) s[rr] = b;
#pragma unroll 16
        for (int i = 0; i < 64; ++i) {
            const float w = WL[(33 + i) * 64 + lane];
#pragma unroll
            for (int rr = 0; rr < 8; ++rr) s[rr] += h1[rr * 64 + i] * w;
        }
        const float fq1 = p.hy_freq[(l * 2 + 1) * 64 + lane];
#pragma unroll
        for (int rr = 0; rr < 8; ++rr) h2[rr * 64 + lane] = sin_rev(fq1 * s[rr] * INV2PI);
    }
    __syncthreads();
    float acc[8][8];
#pragma unroll
    for (int rr = 0; rr < 8; ++rr)
#pragma unroll
        for (int q = 0; q < 8; ++q) acc[rr][q] = 0.f;
    const float* w3 = p.hy_f_w3 + (size_t)l * 64 * 512;
#pragma unroll 1
    for (int ch = 0; ch < 4; ++ch) {
#pragma unroll
        for (int j = 0; j < 8; ++j) { const int idx = tid + j * 256; *(f32x4*)(WL + idx * 4) = *(const f32x4*)(w3 + (size_t)ch * 16 * 512 + idx * 4); }
        __syncthreads();
#pragma unroll 2
        for (int i = 0; i < 16; ++i) {
            float w[8];
#pragma unroll
            for (int q = 0; q < 8; ++q) w[q] = WL[i * 512 + q * 64 + lane];
#pragma unroll
            for (int rr = 0; rr < 8; ++rr) {
                const float hv = h2[rr * 64 + ch * 16 + i];
#pragma unroll
                for (int q = 0; q < 8; ++q) acc[rr][q] += hv * w[q];
            }
        }
        __syncthreads();
    }
    bf16_t* kf = (bf16_t*)(p.ws + (type ? OFF_KERNC + (size_t)l * 2 * 256 * 256 * 2 : OFF_KERNL + (size_t)l * 2 * 256 * 2048 * 2));
    const float lo = logf(1e-2f) / 1.5f, hi = logf(1e-2f) / 0.3f;
#pragma unroll
    for (int q = 0; q < 8; ++q) {
        const int qh = q >> 2, c = (q & 3) * 64 + lane;
        const float delta = fabsf(lo + (float)c * ((hi - lo) / 255.f));
        float v[8];
#pragma unroll
        for (int rr = 0; rr < 8; ++rr) { const float tt = (float)(t0 + rr) * rn1; v[rr] = acc[rr][q] * __expf(-tt * delta); }
        if (qh == 0 && t0 == 0) v[0] += p.hy_skip[l * 256 + c];
        *(u32x4*)(kf + ((size_t)qh * 256 + c) * n + t0) = (u32x4){pk2(v[0], v[1]), pk2(v[2], v[3]), pk2(v[4], v[5]), pk2(v[6], v[7])};
    }
}
struct ConvDesc { const float* src; bf16_t* dst; int ldsrc, k0, n0, lddst, mapkind; };
DEV void conv_load(const ConvDesc& d, f32x4 (&v)[4], int tid) {
    const int r = tid >> 4, c4 = (tid & 15) * 4;
#pragma unroll
    for (int i = 0; i < 4; ++i) v[i] = *(const f32x4*)(d.src + (size_t)(d.k0 + r + 16 * i) * d.ldsrc + d.n0 + c4);
}
DEV void conv_store(const ConvDesc& d, const f32x4 (&v)[4], char* lds, int tid) {
    float* tl = (float*)lds;
    {
        const int r = tid >> 4, c4 = (tid & 15) * 4;
#pragma unroll
        for (int i = 0; i < 4; ++i) { const int row = r + 16 * i; tl[row * 65 + c4 + 0] = v[i][0]; tl[row * 65 + c4 + 1] = v[i][1]; tl[row * 65 + c4 + 2] = v[i][2]; tl[row * 65 + c4 + 3] = v[i][3]; }
    }
    __syncthreads();
    {
        const int n = tid >> 2, kc = tid & 3, ng = d.n0 + n;
        int drow = ng;
        if (d.mapkind == 1) drow = 32 * (ng >> 4) + (ng & 15);
        else if (d.mapkind == 2) drow = 32 * (ng >> 4) + 16 + (ng & 15);
        else if (d.mapkind == 3) drow = (ng >> 7) * 256 + 32 * ((ng & 127) >> 4) + (ng & 15);
        else if (d.mapkind == 4) drow = (ng >> 7) * 256 + 32 * ((ng & 127) >> 4) + 16 + (ng & 15);
        else if (d.mapkind == 5) drow = (ng & ~31) + 16 * ((ng >> 2) & 1) + 4 * ((ng >> 3) & 3) + (ng & 3);
        unsigned w[8];
#pragma unroll
        for (int j = 0; j < 8; ++j) w[j] = pk2(tl[(kc * 16 + 2 * j) * 65 + n], tl[(kc * 16 + 2 * j + 1) * 65 + n]);
        u32x4* o = (u32x4*)(d.dst + (size_t)drow * d.lddst + d.k0 + kc * 16);
        o[0] = (u32x4){w[0], w[1], w[2], w[3]};
        o[1] = (u32x4){w[4], w[5], w[6], w[7]};
    }
    __syncthreads();
}
DEV ConvDesc conv_fixed_desc(const Params& p, int it) {
    const int l = it / 1040; int r = it % 1040;
    unsigned char* ws = p.ws;
    if (r < 576) return ConvDesc{p.w_in + (size_t)l * 1024 * PROJ, (bf16_t*)(ws + OFF_WIN) + (size_t)l * PROJ * 1024, PROJ, (r / 36) * 64, (r % 36) * 64, 1024, (r % 36) * 64 < 1536 ? 5 : 0};
    r -= 576;
    if (r < 256) return ConvDesc{p.w_out + (size_t)l * 1024 * 1024, (bf16_t*)(ws + OFF_WOUT) + (size_t)l * 1024 * 1024, 1024, (r / 16) * 64, (r % 16) * 64, 1024, 5};
    r -= 256;
    if (r < 64) return ConvDesc{p.sh_w1 + (size_t)l * 1024 * 256, (bf16_t*)(ws + OFF_SW13) + (size_t)l * 512 * 1024, 256, (r / 4) * 64, (r % 4) * 64, 1024, 3};
    r -= 64;
    if (r < 64) return ConvDesc{p.sh_w3 + (size_t)l * 1024 * 256, (bf16_t*)(ws + OFF_SW13) + (size_t)l * 512 * 1024, 256, (r / 4) * 64, (r % 4) * 64, 1024, 4};
    r -= 64;
    if (r < 64) { const int kt = r / 16, hh = kt >> 1;
        return ConvDesc{p.sh_w2 + (size_t)l * 256 * 1024, (bf16_t*)(ws + OFF_SW2) + (size_t)(l * 2 + hh) * 1024 * 128 - hh * 128, 1024, kt * 64, (r % 16) * 64, 128, 5}; }
    r -= 64;
    return ConvDesc{p.router_w + (size_t)l * 1024 * 64, (bf16_t*)(ws + OFF_RW) + (size_t)l * 64 * 1024, 64, r * 64, 0, 1024, 0};
}
DEV ConvDesc conv_expert_desc(const Params& p, int l, int it) {
    const int e = it / 96; int r = it % 96;
    unsigned char* ws = p.ws;
    const size_t eo = (size_t)(l * 64 + e) * 1024 * 128;
    if (r < 32) return ConvDesc{p.exp_w1 + eo, (bf16_t*)(ws + OFF_W13) + (size_t)e * 256 * 1024, 128, (r / 2) * 64, (r % 2) * 64, 1024, 1};
    r -= 32;
    if (r < 32) return ConvDesc{p.exp_w3 + eo, (bf16_t*)(ws + OFF_W13) + (size_t)e * 256 * 1024, 128, (r / 2) * 64, (r % 2) * 64, 1024, 2};
    r -= 32;
    return ConvDesc{p.exp_w2 + eo, (bf16_t*)(ws + OFF_W2) + (size_t)e * 1024 * 128, 1024, (r / 16) * 64, (r % 16) * 64, 128, 5};
}
DEV void conv_run(const Params& p, int l, int first, int count, char* lds) {
    const int tid = get_tid();
    if (count <= 0) return;
    ConvDesc d = l < 0 ? conv_fixed_desc(p, first) : conv_expert_desc(p, l, first);
    f32x4 v[4]; conv_load(d, v, tid);
#pragma unroll 1
    for (int i = 0; i < count; ++i) {
        ConvDesc dn = d; f32x4 vn[4];
        if (i + 1 < count) { dn = l < 0 ? conv_fixed_desc(p, first + i + 1) : conv_expert_desc(p, l, first + i + 1); conv_load(dn, vn, tid); }
        else {
#pragma unroll
            for (int k = 0; k < 4; ++k) vn[k] = v[k];
        }
        conv_store(d, v, lds, tid);
        d = dn;
#pragma unroll
        for (int k = 0; k < 4; ++k) v[k] = vn[k];
    }
}
DEV void phase_prep(const Params& p, char* lds) {
    { const int t_ = get_tid(); if (blockIdx.x == 0 && t_ < 128) ((int*)(p.ws + OFF_CNT))[t_ * 64] = 0; }
    constexpr int N0 = 144, N1 = N0 + 192, N2 = N1 + 260, N3 = N2 + 0, N4 = N3 + 256;
    int* qhead = (int*)(p.ws + OFF_QUEUE) + 2 * 64;
    int* qslot = (int*)(lds + SMEM_BYTES - 256);
    for (;;) {
        __syncthreads();
        if (get_tid() == 0) *qslot = atomicAdd(qhead, 1);
        __syncthreads();
        const int it = *qslot;
        if (it >= N4) break;
        if (it < N0) prep_filter_item(p, it, lds);
        else if (it < N1) prep_mod_item(p, it - N0, lds);
        else if (it < N2) conv_run(p, -1, (it - N1) * 8, 8, lds);
        else if (it < N3) conv_run(p, 0, (it - N2) * 8, 8, lds);
        else prep_rope_item(p, it - N3);
    }
}
DEV void phase_modfin(const Params& p) {
    const float* part = (const float*)(p.ws + OFF_PART);
    float* mod = (float*)(p.ws + OFF_MOD);
    for (int idx = blockIdx.x * 256 + get_tid(); idx < 2 * 9 * 6144; idx += gridDim.x * 256) {
        const int l = idx / (9 * 6144), g = (idx / 6144) % 9, col = idx % 6144;
        float s = p.ada_b[l * 6144 + col];
        for (int k = 0; k < 32; ++k) s += part[((size_t)(k * 2 + l) * 9 + g) * 6144 + col];
        mod[idx] = s;
    }
}

DEV void row_load(const float* src, f32x4 (&v)[4], int lane) {
#pragma unroll
    for (int j = 0; j < 4; ++j) v[j] = *(const f32x4*)(src + 4 * lane + 256 * j);
}
DEV f32x4 ld_bf4(const bf16_t* p) { const u32x2 w = *(const u32x2*)p; return (f32x4){__uint_as_float(w[0] << 16), __uint_as_float(w[0] & 0xffff0000u), __uint_as_float(w[1] << 16), __uint_as_float(w[1] & 0xffff0000u)}; }
DEV void st_bf4(bf16_t* p, const f32x4& v) { *(u32x2*)p = (u32x2){pk2(v[0], v[1]), pk2(v[2], v[3])}; }
DEV void row_load_bf(const bf16_t* src, f32x4 (&v)[4], int lane) {
#pragma unroll
    for (int j = 0; j < 4; ++j) v[j] = ld_bf4(src + 4 * lane + 256 * j);
}
DEV void row_norm(f32x4 (&v)[4]) {
    float s = 0.f;
#pragma unroll
    for (int j = 0; j < 4; ++j) s += (v[j][0] + v[j][1]) + (v[j][2] + v[j][3]);
    const float mean = wave_sum(s) * (1.f / 1024.f);
    float q = 0.f;
#pragma unroll
    for (int j = 0; j < 4; ++j) { v[j] = v[j] - mean; q += (v[j][0] * v[j][0] + v[j][1] * v[j][1]) + (v[j][2] * v[j][2] + v[j][3] * v[j][3]); }
    const float rstd = __builtin_amdgcn_rsqf(wave_sum(q) * (1.f / 1024.f) + 1e-6f);
#pragma unroll
    for (int j = 0; j < 4; ++j) v[j] = v[j] * rstd;
}
DEV void row_store_mod_bf16(bf16_t* dst, const f32x4 (&v)[4], const float* shift, const float* scale, int lane) {
#pragma unroll
    for (int j = 0; j < 4; ++j) {
        const int c = 4 * lane + 256 * j;
        const f32x4 sh = *(const f32x4*)(shift + c), sc = *(const f32x4*)(scale + c);
        const f32x4 o = v[j] * (sc + 1.0f) + sh;
        *(u32x2*)(dst + c) = (u32x2){pk2(o[0], o[1]), pk2(o[2], o[3])};
    }
}
DEV void phase_lnmod0(const Params& p) {
    const int tid_ = get_tid(), lane = tid_ & 63, wid = tid_ >> 6;
    const float* mod = (const float*)(p.ws + OFF_MOD);
    bf16_t* H = (bf16_t*)(p.ws + OFF_H);
    for (int row = blockIdx.x * 4 + wid; row < NT; row += gridDim.x * 4) {
        const float* src = row < NLAT ? p.x + (size_t)row * 1024 : p.ctx + (size_t)(row - NLAT) * 1024;
        f32x4 v[4]; row_load(src, v, lane); row_norm(v);
        const float* m = mod + (size_t)mod_group(row) * 6144;
        row_store_mod_bf16(H + (size_t)row * 1024, v, m, m + 1024, lane);
    }
}

DEV void phase_inproj(const Params& p, int l, char* lds) {
    const int tid = get_tid(), lane = tid & 63, wid = tid >> 6, fr = lane & 15, fq = lane >> 4, wr = wid >> 1, wc = wid & 1;
    unsigned char* ws = p.ws;
    const bf16_t* H = (const bf16_t*)(ws + OFF_H);
    const bf16_t* W = (const bf16_t*)(ws + OFF_WIN) + (size_t)l * PROJ * 1024;
    const float* ropec = (const float*)(ws + OFF_ROPE); const float* ropes = ropec + 2048 * 32;
    const int nitems = 128 * 18 + 16 * (l == 0 ? 18 : 6);
    for (int it = blockIdx.x; it < nitems; it += gridDim.x) {
        int mt, nt;
        if (it < 2304) { mt = it / 18; nt = it % 18; }
        else { const int j = it - 2304; if (l == 0) { mt = 128 + j / 18; nt = j % 18; } else { mt = 128 + j / 6; const int q = j % 6; nt = q < 2 ? 4 + q : 6 + q; } }
        const int m0 = mt * 128, n0 = nt * 128;
        const unsigned a0 = (unsigned)m0 * 1024u + st64_off(tid), b0 = (unsigned)n0 * 1024u + st64_off(tid);
        const unsigned ao[4] = {a0, a0 + 32u * 1024u, a0 + 64u * 1024u, a0 + 96u * 1024u};
        const unsigned bo[4] = {b0, b0 + 32u * 1024u, b0 + 64u * 1024u, b0 + 96u * 1024u};
        f32x4 acc[4][4]; zero_acc<4, 4>(acc);
        const bool latent = m0 < NLAT;
        const int b = latent ? (m0 >> 11) : ((m0 - NLAT) >> 8);
        const int tbase = latent ? (m0 & 2047) : ((m0 - NLAT) & 255);
        if (nt >= 12) {
            const int rho = tid >> 3, ptok = 8 * ((rho & 15) >> 2) + 4 * (rho >> 4) + (rho & 3);
            const unsigned ap0 = (unsigned)(m0 + ptok) * 1024u + (unsigned)(((tid & 7) ^ (rho & 7)) * 8);
            const unsigned aop[4] = {ap0, ap0 + 32u * 1024u, ap0 + 64u * 1024u, ap0 + 96u * 1024u};
            gemm_core64<false>(acc, H, aop, W, bo, 1024, lds);
            bf16_t* zt = latent ? (bf16_t*)(ws + OFF_ZTL) + (size_t)b * 768 * 2048 : (bf16_t*)(ws + OFF_ZTC) + (size_t)b * 768 * 256;
            const int n = latent ? 2048 : 256;
#pragma unroll
            for (int g = 0; g < 2; ++g)
#pragma unroll
                for (int nn = 0; nn < 4; ++nn) {
                    const int ch = n0 - 1536 + wc * 64 + nn * 16 + fr, t = tbase + wr * 64 + 32 * g + 8 * fq;
                    *(u32x4*)(zt + (size_t)ch * n + t) = (u32x4){pk2(acc[2 * g][nn][0], acc[2 * g][nn][1]), pk2(acc[2 * g][nn][2], acc[2 * g][nn][3]),
                                                                 pk2(acc[2 * g + 1][nn][0], acc[2 * g + 1][nn][1]), pk2(acc[2 * g + 1][nn][2], acc[2 * g + 1][nn][3])};
                }
        } else {
            gemm_core64<true>(acc, H, ao, W, bo, 1024, lds);
            const int col0 = n0 + wc * 64;
            int kind, hh;
            if (col0 < 512) { kind = 0; hh = col0 >> 6; } else if (col0 < 640) { kind = 1; hh = (col0 - 512) >> 6; } else if (col0 < 768) { kind = 2; hh = (col0 - 640) >> 6; }
            else if (col0 < 1024) { kind = 3; hh = (col0 - 768) >> 6; } else if (col0 < 1280) { kind = 4; hh = (col0 - 1024) >> 6; } else { kind = 5; hh = (col0 - 1280) >> 6; }
            const bool normed = (kind == 0 || kind == 1);
            const float* gain = (kind == 0 ? p.q_gain : p.k_gain) + l * 64;
#pragma unroll
            for (int m = 0; m < 4; ++m) {
                const int rloc = wr * 64 + m * 16 + fr, row = m0 + rloc, t = tbase + rloc;
                f32x4 v[4];
#pragma unroll
                for (int nn = 0; nn < 4; ++nn) v[nn] = acc[m][nn];
                if (normed) {
                    float ss = 0.f;
#pragma unroll
                    for (int nn = 0; nn < 4; ++nn) ss += (v[nn][0] * v[nn][0] + v[nn][1] * v[nn][1]) + (v[nn][2] * v[nn][2] + v[nn][3] * v[nn][3]);
                    ss += __shfl_xor(ss, 16); ss += __shfl_xor(ss, 32);
                    const float r = __builtin_amdgcn_rsqf(ss * (1.f / 64.f) + 1e-6f);
#pragma unroll
                    for (int nn = 0; nn < 4; ++nn) {
                        const int hc = 32 * (nn >> 1) + 8 * fq + 4 * (nn & 1);
                        const f32x4 g = *(const f32x4*)(gain + hc);
                        v[nn] = v[nn] * r * g;
                        if (latent) {
                            const int pi = hc >> 1;
                            const float c0 = ropec[t * 32 + pi], s0 = ropes[t * 32 + pi], c1 = ropec[t * 32 + pi + 1], s1 = ropes[t * 32 + pi + 1];
                            const float x0 = v[nn][0], x1 = v[nn][1], x2 = v[nn][2], x3 = v[nn][3];
                            v[nn][0] = x0 * c0 - x1 * s0; v[nn][1] = x0 * s0 + x1 * c0;
                            v[nn][2] = x2 * c1 - x3 * s1; v[nn][3] = x2 * s1 + x3 * c1;
                        }
                    }
                }
                if (kind == 0 || kind == 3) {
#pragma unroll
                    for (int nn = 0; nn < 4; ++nn) v[nn] = v[nn] * (0.125f * LOG2E);
                }
                bf16_t* dst;
                const int key = latent ? 256 + t : t;
                if (kind == 0) dst = (bf16_t*)(ws + OFF_QA) + ((size_t)hh * NT + row) * 64;
                else if (kind == 3) dst = (bf16_t*)(ws + OFF_QB) + ((size_t)hh * NT + row) * 64;
                else if (kind == 1) dst = (bf16_t*)(ws + OFF_KA) + ((size_t)(b * 2 + hh) * KEYS + key) * 64;
                else if (kind == 2) dst = (bf16_t*)(ws + OFF_VA) + ((size_t)(b * 2 + hh) * KEYS + key) * 64;
                else if (kind == 4) dst = (bf16_t*)(ws + OFF_KB) + ((size_t)(b * 4 + hh) * KEYS + key) * 64;
                else dst = (bf16_t*)(ws + OFF_VB) + ((size_t)(b * 4 + hh) * KEYS + key) * 64;
#pragma unroll
                for (int gg = 0; gg < 2; ++gg) *(u32x4*)(dst + 32 * gg + 8 * fq) = (u32x4){pk2(v[2 * gg][0], v[2 * gg][1]), pk2(v[2 * gg][2], v[2 * gg][3]), pk2(v[2 * gg + 1][0], v[2 * gg + 1][1]), pk2(v[2 * gg + 1][2], v[2 * gg + 1][3])};
            }
        }
    }
}

template <int NQT, bool NA>
DEV void attn_block(const bf16_t* Qh, int qrow0, const bf16_t* Kh, const bf16_t* Vh, int ntiles, bf16_t* outp  ,
                    int na_r, int na_rs, int nwin, const float* rpb_h, char* lds) {
    const int tid = get_tid(), lane = tid & 63, wid = tid >> 6, fr = lane & 15, fq = lane >> 4;
    char* KBUF = lds;
    char* VBUF = lds + 16384;
    float* BIAS = (float*)(lds + 32768);
    if (NA) {
        for (int i = tid; i < 15 * 32; i += 256) { const int dr = i >> 5, dc = i & 31; BIAS[i] = dc < 31 ? rpb_h[dr * 31 + dc] * LOG2E : 0.f; }
    }
    bf16x8 qf[NQT][2];
    const int qw = qrow0 + wid * 16 * NQT;
#pragma unroll
    for (int nq = 0; nq < NQT; ++nq)
#pragma unroll
        for (int ks = 0; ks < 2; ++ks) qf[nq][ks] = *(const bf16x8*)(Qh + (size_t)(qw + nq * 16 + fr) * 64 + ks * 32 + fq * 8);
    f32x4 oacc[4][NQT], lacc[NQT];
    float mrun[NQT];
    const bf16x8 ones = (bf16x8){0x3F80, 0x3F80, 0x3F80, 0x3F80, 0x3F80, 0x3F80, 0x3F80, 0x3F80};
#pragma unroll
    for (int nq = 0; nq < NQT; ++nq) { mrun[nq] = 0.f; lacc[nq] = (f32x4){0.f, 0.f, 0.f, 0.f};
#pragma unroll
        for (int dt = 0; dt < 4; ++dt) oacc[dt][nq] = (f32x4){0.f, 0.f, 0.f, 0.f}; }
    const int lrow0 = tid >> 3, lch = tid & 7;
    auto key0_of = [&](int ti) -> int { if (NA) return ti < nwin ? 256 + (na_rs + ti) * 64 : (ti - nwin) * 64; return ti * 64; };
    u32x4 kreg[2], vreg[2];
    auto gload = [&](int ti) {
        const int k0 = key0_of(ti);
#pragma unroll
        for (int i = 0; i < 2; ++i) {
            const int row = lrow0 + 32 * i;
            kreg[i] = *(const u32x4*)(Kh + (size_t)(k0 + row) * 64 + lch * 8);
            vreg[i] = *(const u32x4*)(Vh + (size_t)(k0 + row) * 64 + lch * 8);
        }
    };
    auto lstore = [&](int buf) {
#pragma unroll
        for (int i = 0; i < 2; ++i) {
            const int row = lrow0 + 32 * i;
            const int off = buf * 8192 + row * 128 + ((lch ^ (row & 7)) * 16);
            *(u32x4*)(KBUF + off) = kreg[i];
            *(u32x4*)(VBUF + off) = vreg[i];
        }
    };
    gload(0); lstore(0);
    __syncthreads();
    for (int ti = 0; ti < ntiles; ++ti) {
        const int buf = ti & 1;
        if (ti + 1 < ntiles) gload(ti + 1);
        const char* kb = KBUF + buf * 8192; const char* vb = VBUF + buf * 8192;
        f32x4 sacc[4][NQT];
        __builtin_amdgcn_s_setprio(1);
#pragma unroll
        for (int mt = 0; mt < 4; ++mt) {
            const int row = mt * 16 + fr;
            bf16x8 kf0 = *(const bf16x8*)(kb + row * 128 + (((0 + fq) ^ (row & 7)) * 16));
            bf16x8 kf1 = *(const bf16x8*)(kb + row * 128 + (((4 + fq) ^ (row & 7)) * 16));
#pragma unroll
            for (int nq = 0; nq < NQT; ++nq) {
                f32x4 s = (f32x4){-mrun[nq], -mrun[nq], -mrun[nq], -mrun[nq]};
                s = mfma16(kf0, qf[nq][0], s);
                s = mfma16(kf1, qf[nq][1], s);
                sacc[mt][nq] = s;
            }
        }
        __builtin_amdgcn_s_setprio(0);
        bf16x8 pf[2][NQT];
#pragma unroll
        for (int nq = 0; nq < NQT; ++nq) {
            float tv[4][4];
            float tmax = -1e30f;
            if (NA && ti < nwin) {
                const int qc = (wid & 1) * 32 + nq * 16 + fr;
                int cs = qc - 8; cs = cs < 0 ? 0 : (cs > 48 ? 48 : cs);
                const int qrow = na_r + (wid >> 1);
                int rsq = qrow - 4; rsq = rsq < 0 ? 0 : (rsq > 24 ? 24 : rsq);
                const int krow = na_rs + ti;
                const bool rowok = (krow >= rsq) && (krow < rsq + 8);
                int dr = krow - qrow + 7; dr = dr < 0 ? 0 : (dr > 14 ? 14 : dr);
#pragma unroll
                for (int mt = 0; mt < 4; ++mt)
#pragma unroll
                    for (int j = 0; j < 4; ++j) {
                        const int kc = mt * 16 + 4 * fq + j;
                        const bool ok = rowok && (kc >= cs) && (kc < cs + 16);
                        int dc = kc - qc + 15; dc = dc < 0 ? 0 : (dc > 30 ? 30 : dc);
                        tv[mt][j] = ok ? sacc[mt][nq][j] + BIAS[dr * 32 + dc] : -1e30f;
                        tmax = fmaxf(tmax, tv[mt][j]);
                    }
            } else {
#pragma unroll
                for (int mt = 0; mt < 4; ++mt) {
#pragma unroll
                    for (int j = 0; j < 4; ++j) tv[mt][j] = sacc[mt][nq][j];
                    tmax = fmaxf(fmaxf(tmax, tv[mt][0]), tv[mt][1]); tmax = fmaxf(fmaxf(tmax, tv[mt][2]), tv[mt][3]);
                }
            }
            if (__any(tmax > 8.0f)) {
                tmax = fmaxf(tmax, __shfl_xor(tmax, 16)); tmax = fmaxf(tmax, __shfl_xor(tmax, 32));
                const float dlt = fmaxf(tmax, 0.f);
                const float alpha = __builtin_amdgcn_exp2f(-dlt);
                mrun[nq] += dlt;
                lacc[nq] = lacc[nq] * alpha;
#pragma unroll
                for (int dt = 0; dt < 4; ++dt) oacc[dt][nq] = oacc[dt][nq] * alpha;
#pragma unroll
                for (int mt = 0; mt < 4; ++mt)
#pragma unroll
                    for (int j = 0; j < 4; ++j) tv[mt][j] -= dlt;
            }
#pragma unroll
            for (int mt = 0; mt < 4; ++mt)
#pragma unroll
                for (int j = 0; j < 4; ++j) tv[mt][j] = __builtin_amdgcn_exp2f(tv[mt][j]);
#pragma unroll
            for (int ks = 0; ks < 2; ++ks) {
                union { bf16x8 v; unsigned u[4]; } pk;
                pk.u[0] = pk2(tv[2 * ks][0], tv[2 * ks][1]); pk.u[1] = pk2(tv[2 * ks][2], tv[2 * ks][3]);
                pk.u[2] = pk2(tv[2 * ks + 1][0], tv[2 * ks + 1][1]); pk.u[3] = pk2(tv[2 * ks + 1][2], tv[2 * ks + 1][3]);
                pf[ks][nq] = pk.v;
                lacc[nq] = mfma16(ones, pk.v, lacc[nq]);
            }
        }
        {
            const int q4 = fr >> 2, p4 = fr & 3;
#pragma unroll
            for (int ks = 0; ks < 2; ++ks)
#pragma unroll
                for (int dt = 0; dt < 4; ++dt) {
                    const int keyA = 16 * (2 * ks) + 4 * fq + q4, keyB = keyA + 16;
                    const int ch = 4 * (dt >> 1) + p4;
                    const int offA = keyA * 128 + ((ch ^ (keyA & 7)) * 16) + (dt & 1) * 8;
                    const int offB = keyB * 128 + ((ch ^ (keyB & 7)) * 16) + (dt & 1) * 8;
                    const s16x4 ta = __builtin_amdgcn_ds_read_tr16_b64_v4i16((LDSP(s16x4))(vb + offA));
                    const s16x4 tb = __builtin_amdgcn_ds_read_tr16_b64_v4i16((LDSP(s16x4))(vb + offB));
                    bf16x8 vf; vf[0] = ta[0]; vf[1] = ta[1]; vf[2] = ta[2]; vf[3] = ta[3]; vf[4] = tb[0]; vf[5] = tb[1]; vf[6] = tb[2]; vf[7] = tb[3];
#pragma unroll
                    for (int nq = 0; nq < NQT; ++nq) oacc[dt][nq] = mfma16(vf, pf[ks][nq], oacc[dt][nq]);
                }
        }
        if (ti + 1 < ntiles) lstore(buf ^ 1);
        __syncthreads();
    }
#pragma unroll
    for (int nq = 0; nq < NQT; ++nq) {
        const float inv = __builtin_amdgcn_rcpf(lacc[nq][0]);
        bf16_t* o = outp + (size_t)(qw + nq * 16 + fr) * 1024;
#pragma unroll
        for (int g = 0; g < 2; ++g) {
            const f32x4 v0 = oacc[2 * g][nq] * inv, v1 = oacc[2 * g + 1][nq] * inv;
            *(u32x4*)(o + g * 32 + 8 * fq) = (u32x4){pk2(v0[0], v0[1]), pk2(v0[2], v0[3]), pk2(v1[0], v1[1]), pk2(v1[2], v1[3])};
        }
    }
    __syncthreads();
}

DEV float hy_sconv(const bf16_t* zrow, int t, int n, float w0, float w1, float w2, float bias) {
    const float zm = t > 0 ? bf2f(zrow[t - 1]) : 0.f, z0 = bf2f(zrow[t]), zp = t + 1 < n ? bf2f(zrow[t + 1]) : 0.f;
    return w0 * zm + w1 * z0 + w2 * zp + bias;
}
template <int NJ>
DEV void hyena_item(const Params& p, int l, int type, int c, int bh, char* lds) {
    constexpr int n = 256 * NJ;
    const int tid = get_tid();
    f32x4* U = (f32x4*)lds;
    float* KR = (float*)(lds + n * 16);
    const bf16_t* zt = type ? (const bf16_t*)(p.ws + OFF_ZTC) : (const bf16_t*)(p.ws + OFF_ZTL);
    const bf16_t* kf = (const bf16_t*)(p.ws + (type ? OFF_KERNC + (size_t)l * 2 * 256 * 256 * 2 : OFF_KERNL + (size_t)l * 2 * 256 * 2048 * 2)) + (size_t)c * n;
    const bf16_t* kb = kf + (size_t)256 * n;
    const float* cw = p.hy_conv_w + l * 3 * 768; const float* cb = p.hy_conv_b + l * 768;
    const float w10 = cw[256 + c], w11 = cw[768 + 256 + c], w12 = cw[1536 + 256 + c], b1 = cb[256 + c];
    const float wv0 = cw[512 + c], wv1 = cw[768 + 512 + c], wv2 = cw[1536 + 512 + c], bv = cb[512 + c];
    const float w00 = cw[c], w01 = cw[768 + c], w02 = cw[1536 + c], b0 = cb[c];
    for (int i = tid; i < 2 * n - 1; i += 256) { const int d = i - (n - 1); KR[i] = bf2f(d >= 0 ? kf[d] : kb[-d]); }
    for (int s = tid; s < n; s += 256) {
        f32x4 u;
#pragma unroll
        for (int bb = 0; bb < 4; ++bb) {
            const bf16_t* zb = zt + (size_t)(bh * 4 + bb) * 768 * n;
            const float x1 = hy_sconv(zb + (size_t)(256 + c) * n, s, n, w10, w11, w12, b1);
            const float vv = hy_sconv(zb + (size_t)(512 + c) * n, s, n, wv0, wv1, wv2, bv);
            u[bb] = vv * x1;
        }
        U[s] = u;
    }
    __syncthreads();
    f32x4 acc[NJ];
#pragma unroll
    for (int j = 0; j < NJ; ++j) acc[j] = (f32x4){0.f, 0.f, 0.f, 0.f};
    const float* kp = KR + tid + (n - 1);
    for (int s = 0; s < n; ++s) {
        const f32x4 u = U[s];
#pragma unroll
        for (int j = 0; j < NJ; ++j) acc[j] += u * kp[256 * j - s];
    }
    bf16_t* ox = (bf16_t*)(p.ws + OFF_OX);
#pragma unroll
    for (int j = 0; j < NJ; ++j) {
        const int t = tid + 256 * j;
#pragma unroll
        for (int bb = 0; bb < 4; ++bb) {
            const int b = bh * 4 + bb;
            const bf16_t* zb = zt + (size_t)b * 768 * n;
            const float x0 = hy_sconv(zb + (size_t)c * n, t, n, w00, w01, w02, b0);
            const float y = acc[j][bb] * x0;
            const int row = type ? NLAT + b * 256 + t : b * 2048 + t;
            ox[(size_t)row * 1024 + 768 + c] = (bf16_t)f2bf(y);
        }
    }
    __syncthreads();
}


typedef float f32x16 __attribute__((ext_vector_type(16)));
constexpr int HY_UROW = 2264;
constexpr int HY_KC_OFF = 8 * HY_UROW * 2;
constexpr int HY_KC_STRIDE = 8192 + 64;
DEV float hy_sc8(const bf16_t* zrow, int s0, int n, float w0, float w1, float w2, float bias, float (&o)[8]) {
    const u32x4 v = *(const u32x4*)(zrow + s0);
    const float zm = s0 > 0 ? bf2f(zrow[s0 - 1]) : 0.f, zp = s0 + 8 < n ? bf2f(zrow[s0 + 8]) : 0.f;
    float z[10]; z[0] = zm; z[9] = zp;
#pragma unroll
    for (int i = 0; i < 4; ++i) { z[1 + 2 * i] = __uint_as_float(v[i] << 16); z[2 + 2 * i] = __uint_as_float(v[i] & 0xffff0000u); }
#pragma unroll
    for (int i = 0; i < 8; ++i) o[i] = w0 * z[i] + w1 * z[i + 1] + w2 * z[i + 2] + bias;
    return 0.f;
}
DEV void hyena_mfma_item(const Params& p, int l, int c, char* lds) {
    const int tid = get_tid(), lane = tid & 63, wid = tid >> 6;
    constexpr int n = 2048;
    const bf16_t* zt = (const bf16_t*)(p.ws + OFF_ZTL);
    const bf16_t* kf = (const bf16_t*)(p.ws + OFF_KERNL + (size_t)l * 2 * 256 * 2048 * 2) + (size_t)c * n;
    const bf16_t* kb = kf + (size_t)256 * n;
    const float* cw = p.hy_conv_w + l * 3 * 768; const float* cb = p.hy_conv_b + l * 768;
    const float w10 = cw[256 + c], w11 = cw[768 + 256 + c], w12 = cw[1536 + 256 + c], b1 = cb[256 + c];
    const float wv0 = cw[512 + c], wv1 = cw[768 + 512 + c], wv2 = cw[1536 + 512 + c], bv = cb[512 + c];
    const float w00 = cw[c], w01 = cw[768 + c], w02 = cw[1536 + c], b0 = cb[c];
    for (int i = tid; i < 8 * 27; i += 256) {
        const int b = i / 27, k = i % 27;
        const int sp = k < 12 ? k * 8 : 96 + 2048 + (k - 12) * 8;
        *(u32x4*)(lds + (b * HY_UROW + sp) * 2) = (u32x4){0u, 0u, 0u, 0u};
    }
#pragma unroll 4
    for (int ch = tid; ch < 8 * 256; ch += 256) {
        const int b = ch >> 8, s0 = (ch & 255) * 8;
        const bf16_t* zb = zt + (size_t)b * 768 * n;
        float x1[8], vv[8];
        hy_sc8(zb + (size_t)(256 + c) * n, s0, n, w10, w11, w12, b1, x1);
        hy_sc8(zb + (size_t)(512 + c) * n, s0, n, wv0, wv1, wv2, bv, vv);
        *(u32x4*)(lds + (b * HY_UROW + 96 + s0) * 2) = (u32x4){pk2(vv[0] * x1[0], vv[1] * x1[1]), pk2(vv[2] * x1[2], vv[3] * x1[3]), pk2(vv[4] * x1[4], vv[5] * x1[5]), pk2(vv[6] * x1[6], vv[7] * x1[7])};
    }
    {
        char* R0 = lds + HY_KC_OFF;
#pragma unroll
        for (int j = 0; j < 2; ++j) {
            const int chn = tid + 256 * j;
            const bool fwd = chn < 256; const int d0 = (chn & 255) * 8;
            const u32x4 v = *(const u32x4*)((fwd ? kf : kb) + d0);
#pragma unroll
            for (int e = 0; e < 8; ++e) {
                const int d = d0 + e;
                const bf16_t val = (bf16_t)((e & 1) ? (v[e >> 1] >> 16) : (v[e >> 1] & 0xffffu));
                const int y = fwd ? 2047 - d : 2047 + d;
                if (fwd || d > 0) *(bf16_t*)(R0 + y * 2) = val;
            }
        }
        if (tid == 0) *(bf16_t*)(R0 + 4095 * 2) = 0;
    }
    __syncthreads();
    {
        const char* R0 = lds + HY_KC_OFF;
        for (int i = tid; i < 3 * 1024; i += 256) {
            const int q = 1 + i / 1024, y = (i % 1024) * 4;
            unsigned short e[4];
#pragma unroll
            for (int k = 0; k < 4; ++k) { const int yy = y + q + k; e[k] = yy <= 4094 ? *(const bf16_t*)(R0 + yy * 2) : (bf16_t)0; }
            *(u32x2*)(lds + HY_KC_OFF + q * HY_KC_STRIDE + y * 2) = (u32x2){(unsigned)e[0] | ((unsigned)e[1] << 16), (unsigned)e[2] | ((unsigned)e[3] << 16)};
        }
    }
    __syncthreads();
    const int i32 = lane & 31, h = lane >> 5, qn = i32 & 3, bn = i32 >> 2;
    const int T0 = 512 * __builtin_amdgcn_readfirstlane(wid);
    f32x16 acc[4];
#pragma unroll
    for (int g = 0; g < 4; ++g)
#pragma unroll
        for (int r = 0; r < 16; ++r) acc[g][r] = 0.f;
    const int dlo = T0 - 2032, dhi = T0 + 384 + 96;
    {
        const int a0 = 2047 - dlo - i32 + 8 * h, q4 = a0 & 3;
        const char* ap = lds + HY_KC_OFF + q4 * HY_KC_STRIDE + (a0 - q4) * 2;
        const char* bp = lds + (bn * HY_UROW + 96 + (T0 - dlo) + 32 * qn + 8 * h) * 2;
        union AF { bf16x8 v; u32x2 u[2]; };
        auto ldstep = [&](int dl, const char* ap_, const char* bp_, AF& a_, bf16x8 (&b_)[4]) {
            a_.u[0] = *(const u32x2*)ap_; a_.u[1] = *(const u32x2*)(ap_ + 8);
#pragma unroll
            for (int g = 0; g < 4; ++g) {
                const int S = T0 + 128 * g - dl;
                const char* q_ = (S >= -96 && S <= 2032) ? bp_ + 256 * g : lds;
                b_[g] = *(const bf16x8*)q_;
            }
        };
        AF a0_, a1_; bf16x8 b0_[4], b1_[4];
        ldstep(dlo, ap, bp, a0_, b0_);
#pragma unroll 1
        for (int dl = dlo; dl <= dhi; dl += 32) {
            ldstep(dl + 16, ap - 32, bp - 32, a1_, b1_);
#pragma unroll
            for (int g = 0; g < 4; ++g) acc[g] = __builtin_amdgcn_mfma_f32_32x32x16_bf16(a0_.v, b0_[g], acc[g], 0, 0, 0);
            ap -= 64; bp -= 64;
            const bool more = dl + 32 <= dhi;
            ldstep(more ? dl + 32 : dl, more ? ap : ap + 64, more ? bp : bp + 64, a0_, b0_);
#pragma unroll
            for (int g = 0; g < 4; ++g) acc[g] = __builtin_amdgcn_mfma_f32_32x32x16_bf16(a1_.v, b1_[g], acc[g], 0, 0, 0);
        }
    }
    __syncthreads();
#pragma unroll 4
    for (int ch = tid; ch < 8 * 256; ch += 256) {
        const int b = ch >> 8, s0 = (ch & 255) * 8;
        float x0[8];
        hy_sc8(zt + (size_t)b * 768 * n + (size_t)c * n, s0, n, w00, w01, w02, b0, x0);
        *(u32x4*)(lds + HY_KC_OFF + (b * 2048 + s0) * 2) = (u32x4){pk2(x0[0], x0[1]), pk2(x0[2], x0[3]), pk2(x0[4], x0[5]), pk2(x0[6], x0[7])};
    }
    __syncthreads();
    bf16_t* oxt = (bf16_t*)(p.ws + OFF_OXT) + (size_t)c * 2048;
#pragma unroll
    for (int g = 0; g < 4; ++g)
#pragma unroll
        for (int r4 = 0; r4 < 4; ++r4) {
            const int t = T0 + 128 * g + 32 * qn + 8 * r4 + 4 * h;
            const u32x2 xg = *(const u32x2*)(lds + HY_KC_OFF + (bn * 2048 + t) * 2);
            const float g0 = __uint_as_float(xg[0] << 16), g1 = __uint_as_float(xg[0] & 0xffff0000u), g2 = __uint_as_float(xg[1] << 16), g3 = __uint_as_float(xg[1] & 0xffff0000u);
            *(u32x2*)(oxt + (size_t)bn * 256 * 2048 + t) = (u32x2){pk2(acc[g][4 * r4 + 0] * g0, acc[g][4 * r4 + 1] * g1), pk2(acc[g][4 * r4 + 2] * g2, acc[g][4 * r4 + 3] * g3)};
        }
    __syncthreads();
}

DEV void phase_mix(const Params& p, int l, char* lds) {
    unsigned char* ws = p.ws;
    const bf16_t* QA = (const bf16_t*)(ws + OFF_QA); const bf16_t* QB = (const bf16_t*)(ws + OFF_QB);
    const bf16_t* KA = (const bf16_t*)(ws + OFF_KA); const bf16_t* VA = (const bf16_t*)(ws + OFF_VA);
    const bf16_t* KBp = (const bf16_t*)(ws + OFF_KB); const bf16_t* VBp = (const bf16_t*)(ws + OFF_VB);
    bf16_t* OX = (bf16_t*)(ws + OFF_OX);
    const int N0 = 256, N1 = N0 + 1024, N2 = N1 + 512;
    const int N3 = N2 + (l == 0 ? 512 : 0), N4 = N3 + (l == 0 ? 128 : 0), N5 = N4 + (l == 0 ? 64 : 0);
    const int N6 = N5 + 768;
    int* qhead = (int*)(p.ws + OFF_QUEUE) + l * 64;
    int* qslot = (int*)(lds + SMEM_BYTES - 256);
    for (;;) {
        __syncthreads();
        if (get_tid() == 0) *qslot = atomicAdd(qhead, 1);
        __syncthreads();
        const int it = *qslot;
        if (it >= N6) break;
        if (it >= N5) { conv_run(p, l, (it - N5) * 8, 8, lds); continue; }
        if (it < N0) { hyena_mfma_item(p, l, it, lds); }
        else if (it < N1) {
            const int j = it - N0, b = j >> 7, h = (j >> 4) & 7, qb = j & 15;
            attn_block<2, false>(QA + (size_t)h * NT * 64, b * 2048 + qb * 128, KA + (size_t)(b * 2 + (h >> 2)) * KEYS * 64, VA + (size_t)(b * 2 + (h >> 2)) * KEYS * 64,
                                 36, OX + h * 64, 0, 0, 0, nullptr, lds);
        } else if (it < N2) {
            const int j = it - N1, b = j >> 6, h = (j >> 4) & 3, r = (j & 15) * 2;
            int rs0 = r - 4; rs0 = rs0 < 0 ? 0 : (rs0 > 24 ? 24 : rs0);
            int rs1 = r - 3; rs1 = rs1 < 0 ? 0 : (rs1 > 24 ? 24 : rs1);
            const int nwin = rs1 + 8 - rs0;
            attn_block<2, true>(QB + (size_t)h * NT * 64, b * 2048 + r * 64, KBp + (size_t)(b * 4 + h) * KEYS * 64, VBp + (size_t)(b * 4 + h) * KEYS * 64,
                                nwin + 4, OX + 512 + h * 64, r, rs0, nwin, p.nat_rpb + (size_t)(l * 4 + h) * 15 * 31, lds);
        } else if (it < N3) { const int j = it - N2; hyena_item<1>(p, l, 1, j >> 1, j & 1, lds); }
        else if (it < N4) {
            const int j = it - N3, b = j >> 4, h = (j >> 1) & 7, qb = j & 1;
            attn_block<2, false>(QA + (size_t)h * NT * 64, NLAT + b * 256 + qb * 128, KA + (size_t)(b * 2 + (h >> 2)) * KEYS * 64, VA + (size_t)(b * 2 + (h >> 2)) * KEYS * 64,
                                 4, OX + h * 64, 0, 0, 0, nullptr, lds);
        } else {
            const int j = it - N4, b = j >> 3, h = (j >> 1) & 3, qb = j & 1;
            attn_block<2, false>(QB + (size_t)h * NT * 64, NLAT + b * 256 + qb * 128, KBp + (size_t)(b * 4 + h) * KEYS * 64, VBp + (size_t)(b * 4 + h) * KEYS * 64,
                                 4, OX + 512 + h * 64, 0, 0, 0, nullptr, lds);
        }
    }
}

DEV void phase_outproj(const Params& p, int l, char* lds) {
    const int tid = get_tid(), lane = tid & 63, wid = tid >> 6, fr = lane & 15, fq = lane >> 4, wr = wid >> 1, wc = wid & 1;
    const bf16_t* OX = (const bf16_t*)(p.ws + OFF_OX);
    const bf16_t* W = (const bf16_t*)(p.ws + OFF_WOUT) + (size_t)l * 1024 * 1024;
    const float* mod = (const float*)(p.ws + OFF_MOD) + (size_t)l * 9 * 6144;
    bf16_t* X = (bf16_t*)(p.ws + OFF_X);
    const int nitems = (l == 0 ? 144 : 128) * 8;
    for (int it = blockIdx.x; it < nitems; it += gridDim.x) {
        const int mt = it >> 3, nt = it & 7, m0 = mt * 128, n0 = nt * 128;
        const unsigned a0 = (unsigned)m0 * 1024u + st64_off(tid), b0 = (unsigned)n0 * 1024u + st64_off(tid);
        f32x4 acc[4][4]; zero_acc<4, 4>(acc);
        const unsigned ao[4] = {a0, a0 + 32u * 1024u, a0 + 64u * 1024u, a0 + 96u * 1024u};
        const unsigned bo[4] = {b0, b0 + 32u * 1024u, b0 + 64u * 1024u, b0 + 96u * 1024u};
        gemm_core64<true>(acc, OX, ao, W, bo, 1024, lds, (const bf16_t*)(p.ws + OFF_OXT) + (size_t)((m0 >> 11) & 7) * 256 * 2048 + (m0 & 2047), m0 < NLAT ? 12 : 16);
        const float* g1 = mod + (size_t)mod_group(m0) * 6144 + 2048;
#pragma unroll
        for (int m = 0; m < 4; ++m) {
            const int row = m0 + wr * 64 + m * 16 + fr;
            const float* xin = row < NLAT ? p.x + (size_t)row * 1024 : p.ctx + (size_t)(row - NLAT) * 1024;
#pragma unroll
            for (int gg = 0; gg < 2; ++gg) {
                const int col = n0 + wc * 64 + gg * 32 + 8 * fq;
                f32x4 x0, x1;
                if (l == 0) { x0 = *(const f32x4*)(xin + col); x1 = *(const f32x4*)(xin + col + 4); }
                else { const u32x4 w = *(const u32x4*)(X + (size_t)row * 1024 + col);
                       x0 = (f32x4){__uint_as_float(w[0] << 16), __uint_as_float(w[0] & 0xffff0000u), __uint_as_float(w[1] << 16), __uint_as_float(w[1] & 0xffff0000u)};
                       x1 = (f32x4){__uint_as_float(w[2] << 16), __uint_as_float(w[2] & 0xffff0000u), __uint_as_float(w[3] << 16), __uint_as_float(w[3] & 0xffff0000u)}; }
                const f32x4 o0 = x0 * DN_ALPHA + *(const f32x4*)(g1 + col) * acc[m][2 * gg], o1 = x1 * DN_ALPHA + *(const f32x4*)(g1 + col + 4) * acc[m][2 * gg + 1];
                *(u32x4*)(X + (size_t)row * 1024 + col) = (u32x4){pk2(o0[0], o0[1]), pk2(o0[2], o0[3]), pk2(o1[0], o1[1]), pk2(o1[2], o1[3])};
            }
        }
    }
}

DEV void phase_ln1route(const Params& p, int l, char* lds) {
    const int tid = get_tid(), lane = tid & 63, wid = tid >> 6, fr = lane & 15, fq = lane >> 4;
    bf16_t* X = (bf16_t*)(p.ws + OFF_X);
    bf16_t* H = (bf16_t*)(p.ws + OFF_H);
    const bf16_t* RW = (const bf16_t*)(p.ws + OFF_RW) + (size_t)l * 64 * 1024;
    const float* mod = (const float*)(p.ws + OFF_MOD) + (size_t)l * 9 * 6144;
    int* cnt = (int*)(p.ws + OFF_CNT) + l * 64 * 64;
    int* tke = (int*)(p.ws + OFF_TKE); int* tks = (int*)(p.ws + OFF_TKS); float* tkw = (float*)(p.ws + OFF_TKW);
    int* list = (int*)(p.ws + OFF_LIST);
    char* HT = lds;
    float* LG = (float*)(lds + 16 * 2064);
    const float rbias = p.router_b[l * 64 + lane];
    const int rpw = (l == 0) ? 3 : 4, rpi = 4 * rpw;
    const int nitems = (l == 0 ? NT : NLAT) / rpi;
    u32x2 raw[4][4];
    f32x4 msh[4], msc[4];
    float* LNG = (float*)(lds + 50176);
    for (int i = tid; i < 512; i += 256) {
        const int c = (i & 255) * 4;
        *(f32x4*)(LNG + (i >> 8) * 1024 + c) = *(const f32x4*)((i >> 8 ? p.ln1_b : p.ln1_g) + l * 1024 + c);
    }
    if ((int)blockIdx.x < nitems) {
#pragma unroll
        for (int i = 0; i < 4; ++i) if (i < rpw)
#pragma unroll
            for (int j = 0; j < 4; ++j) raw[i][j] = *(const u32x2*)(X + (size_t)((int)blockIdx.x * rpi + wid * rpw + i) * 1024 + 4 * lane + 256 * j);
        const float* mg = mod + (size_t)mod_group((int)blockIdx.x * rpi + wid * rpw) * 6144;
#pragma unroll
        for (int j = 0; j < 4; ++j) { const int c = 4 * lane + 256 * j; msh[j] = *(const f32x4*)(mg + 3072 + c); msc[j] = *(const f32x4*)(mg + 4096 + c); }
    }
    __syncthreads();
    for (int it = blockIdx.x; it < nitems; it += gridDim.x) {
        const int m0 = it * rpi;
        const int g0 = mod_group(m0 + wid * rpw);
        f32x4 vv[4][4];
#pragma unroll
        for (int i = 0; i < 4; ++i) if (i < rpw)
#pragma unroll
            for (int j = 0; j < 4; ++j) { const u32x2 w = raw[i][j]; vv[i][j] = (f32x4){__uint_as_float(w[0] << 16), __uint_as_float(w[0] & 0xffff0000u), __uint_as_float(w[1] << 16), __uint_as_float(w[1] & 0xffff0000u)}; }
#pragma unroll
        for (int i = 0; i < 4; ++i) if (i < rpw) {
            const int rl = wid * rpw + i, row = m0 + rl;
            if (mod_group(row) != g0) {
                const float* mg = mod + (size_t)mod_group(row) * 6144;
#pragma unroll
                for (int j = 0; j < 4; ++j) { const int c = 4 * lane + 256 * j; msh[j] = *(const f32x4*)(mg + 3072 + c); msc[j] = *(const f32x4*)(mg + 4096 + c); }
            }
            row_norm(vv[i]);
#pragma unroll
            for (int j = 0; j < 4; ++j) {
                const int c = 4 * lane + 256 * j;
                vv[i][j] = vv[i][j] * *(const f32x4*)(LNG + c) + *(const f32x4*)(LNG + 1024 + c);
                st_bf4(X + (size_t)row * 1024 + c, vv[i][j]);
            }
            row_norm(vv[i]);
#pragma unroll
            for (int j = 0; j < 4; ++j) {
                const int c = 4 * lane + 256 * j;
                const f32x4 o = vv[i][j] * (msc[j] + 1.0f) + msh[j];
                const u32x2 w = (u32x2){pk2(o[0], o[1]), pk2(o[2], o[3])};
                *(u32x2*)(H + (size_t)row * 1024 + c) = w;
                *(u32x2*)(HT + rl * 2064 + c * 2) = w;
            }
        }
        f32x4 acc = (f32x4){0.f, 0.f, 0.f, 0.f};
        const bf16_t* bp = RW + (size_t)(wid * 16 + fr) * 1024 + fq * 8;
        bf16x8 bq[16];
#pragma unroll
        for (int ks = 0; ks < 16; ++ks) bq[ks] = *(const bf16x8*)(bp + ks * 32);
        __syncthreads();
#pragma unroll
        for (int ks = 0; ks < 16; ++ks) {
            const bf16x8 af = *(const bf16x8*)(HT + fr * 2064 + (ks * 32 + fq * 8) * 2);
            acc = mfma16(bq[ks], af, acc);
            bq[ks] = *(const bf16x8*)(bp + (ks + 16) * 32);
        }
#pragma unroll
        for (int ks = 0; ks < 16; ++ks) {
            const bf16x8 af = *(const bf16x8*)(HT + fr * 2064 + ((ks + 16) * 32 + fq * 8) * 2);
            acc = mfma16(bq[ks], af, acc);
        }
        *(f32x4*)(LG + fr * 64 + wid * 16 + 4 * fq) = acc;
        if (it + (int)gridDim.x < nitems) {
#pragma unroll
            for (int i = 0; i < 4; ++i) if (i < rpw)
#pragma unroll
                for (int j = 0; j < 4; ++j) raw[i][j] = *(const u32x2*)(X + (size_t)(m0 + (int)gridDim.x * rpi + wid * rpw + i) * 1024 + 4 * lane + 256 * j);
            const float* mg = mod + (size_t)mod_group(m0 + (int)gridDim.x * rpi + wid * rpw) * 6144;
#pragma unroll
            for (int j = 0; j < 4; ++j) { const int c = 4 * lane + 256 * j; msh[j] = *(const f32x4*)(mg + 3072 + c); msc[j] = *(const f32x4*)(mg + 4096 + c); }
        }
        __syncthreads();
        int* RS = (int*)(lds + 16 * 2064 + 4096 + 2048);
        float* RWt = (float*)(lds + 16 * 2064 + 4096 + 2048 + 4096);
        int lc = 0;
        unsigned* KW = (unsigned*)(lds + 16 * 2064 + 4096 + 2048 + 8192) + wid * 160;
#pragma unroll 1
        for (int i = 0; i < rpw; ++i) {
            const int rl = wid * rpw + i;
            const float sc = __builtin_amdgcn_rcpf(1.0f + __expf(-LG[rl * 64 + lane]));
            const float sel = sc + rbias;
            const int grp = lane >> 3;
            const unsigned key = (__float_as_uint(sel + 2.0f) & 0xFFFFFFC0u) | (unsigned)(63 - lane);
            KW[lane] = key;
            __builtin_amdgcn_wave_barrier();
            int rankg = 0;
            {
                const u32x4 k0 = *(const u32x4*)(KW + grp * 8), k1 = *(const u32x4*)(KW + grp * 8 + 4);
#pragma unroll
                for (int j = 0; j < 4; ++j) { rankg += (k0[j] > key) ? 1 : 0; rankg += (k1[j] > key) ? 1 : 0; }
            }
            float gs = rankg < 2 ? sel : 0.f;
            gs += __shfl_xor(gs, 1); gs += __shfl_xor(gs, 2); gs += __shfl_xor(gs, 4);
            const unsigned gkey = (__float_as_uint(gs + 4.0f) & 0xFFFFFFF8u) | (unsigned)(7 - grp);
            if ((lane & 7) == 0) KW[128 + grp] = gkey;
            __builtin_amdgcn_wave_barrier();
            int rg = 0;
            {
                const u32x4 g0 = *(const u32x4*)(KW + 128), g1 = *(const u32x4*)(KW + 132);
#pragma unroll
                for (int j = 0; j < 4; ++j) { rg += (g0[j] > gkey) ? 1 : 0; rg += (g1[j] > gkey) ? 1 : 0; }
            }
            const bool selg = rg < 4;
            const unsigned vkey = selg ? key : 0u;
            KW[64 + lane] = vkey;
            __builtin_amdgcn_wave_barrier();
            int rank = 0;
#pragma unroll
            for (int q = 0; q < 16; ++q) {
                const u32x4 kk = *(const u32x4*)(KW + 64 + q * 4);
#pragma unroll
                for (int j = 0; j < 4; ++j) rank += (kk[j] > vkey) ? 1 : 0;
            }
            const bool ch = selg && rank < 8;
            const float wsum = wave_sum(ch ? sc : 0.f);
            RS[rl * 64 + lane] = ch ? rank : -1;
            RWt[rl * 64 + lane] = sc * (2.5f * __builtin_amdgcn_rcpf(wsum));
            lc += ch ? 1 : 0;
            __builtin_amdgcn_wave_barrier();
        }
        int* WC = (int*)(lds + 16 * 2064 + 4096);
        WC[wid * 64 + lane] = lc;
        __syncthreads();
        if (wid == 0) {
            const int tot = WC[lane] + WC[64 + lane] + WC[128 + lane] + WC[192 + lane];
            int base = 0;
            if (tot > 0) base = atomicAdd(&cnt[lane * 64], tot);
            WC[256 + lane] = base;
        }
        __syncthreads();
        {
            int slot = WC[256 + lane];
#pragma unroll
            for (int w2 = 0; w2 < 4; ++w2) slot += (w2 < wid) ? WC[w2 * 64 + lane] : 0;
#pragma unroll 1
            for (int i = 0; i < rpw; ++i) {
                const int rl = wid * rpw + i, rk = RS[rl * 64 + lane];
                if (rk >= 0) {
                    const int row = m0 + rl;
                    list[(size_t)lane * NT + slot] = row * 8 + rk;
                    tke[row * 8 + rk] = lane; tks[row * 8 + rk] = slot; tkw[row * 8 + rk] = RWt[rl * 64 + lane];
                    ++slot;
                }
            }
        }
        __syncthreads();
    }
}

constexpr int YS_EXT_ROWS = NLAT * 1024 * 4 / 1024;
constexpr int PLAN_OFF = 68 * 1024;
DEV void moe_plan(const int* cnt, int cap, int l, char* lds) {
    int* PL = (int*)(lds + PLAN_OFF);
    const int tid = get_tid();
    __syncthreads();
    if (tid < 64) {
        const int lane = tid;
        const int c = cnt[lane * 64], tiles = (c + 127) >> 7;
        int pr = c, pt = tiles;
#pragma unroll
        for (int o = 1; o < 64; o <<= 1) { const int a = __shfl_up(pr, o), b = __shfl_up(pt, o); if (lane >= o) { pr += a; pt += b; } }
        const int G = (int)gridDim.x, nshu = 2 * ((l == 0 ? NT : NLAT) / 128);
        const int units = nshu + __builtin_amdgcn_readlane(pt, 63);
        const int cap8 = cap * 2;
        const bool one_round = __builtin_amdgcn_readlane(pr, 63) + nshu * 128 <= cap8;
        const int target0 = one_round ? 0 : ((units + G - 1) / G - 1) * G;
        PL[144 + lane] = c;
        int start = 0, base_r = 0, base_t = 0, round = 0;
        for (;;) {
            const int lim = (round == 0) ? ((target0 > 0) ? cap8 + YS_EXT_ROWS : cap8) - nshu * 128 : cap8;
            const bool bad = (lane >= start) && ((pr - base_r > lim) || (round == 0 && target0 > 0 && lane > 0 && nshu + pt > target0));
            const unsigned long long m = __ballot(bad);
            int end = m ? (int)__builtin_ctzll(m) : 64;
            if (end <= start) end = start + 1;
            if (lane >= start && lane < end) { PL[16 + lane] = pt - tiles - base_t; PL[80 + lane] = pr - c - base_r; }
            if (lane == 0) { PL[1 + round] = start; PL[10 + round] = __builtin_amdgcn_readlane(pt, end - 1) - base_t; PL[208 + round] = __builtin_amdgcn_readlane(pr, end - 1) - base_r; }
            if (end >= 64 || round >= 7) { if (lane == 0) { PL[0] = round + 1; PL[2 + round] = 64; } break; }
            base_r = __builtin_amdgcn_readlane(pr, end - 1); base_t = __builtin_amdgcn_readlane(pt, end - 1);
            start = end; ++round;
        }
    }
    __syncthreads();
}
constexpr float YS_SCALE = 32.0f, YS_INV = 1.0f / 32.0f;
DEV unsigned char* ys_row(const Params& p, int idx) {
    const int cap8 = p.cap * 2;
    return idx < cap8 ? p.ws + OFF_YS + (size_t)idx * 1024 : (unsigned char*)p.out + (size_t)(idx - cap8) * 1024;
}
DEV unsigned pk4_fp8(const f32x4& v) {
    int w = 0;
    w = __builtin_amdgcn_cvt_pk_fp8_f32(v[0] * YS_SCALE, v[1] * YS_SCALE, w, false);
    w = __builtin_amdgcn_cvt_pk_fp8_f32(v[2] * YS_SCALE, v[3] * YS_SCALE, w, true);
    return (unsigned)w;
}
DEV f32x4 up4_fp8(unsigned w) {
    const f32x2 lo = __builtin_amdgcn_cvt_pk_f32_fp8((int)w, false), hi = __builtin_amdgcn_cvt_pk_f32_fp8((int)w, true);
    return (f32x4){lo[0], lo[1], hi[0], hi[1]};
}

DEV void gemm_up256(f32x4 (&acc)[4][8], const bf16_t* A, const unsigned (&ao)[2], const bf16_t* B, const unsigned (&bo)[4], char* lds) {
    const int tid = get_tid(), lane = tid & 63, wid = tid >> 6, fr = lane & 15, fq = lane >> 4, wr = wid >> 1, wc = wid & 1;
    auto stage = [&](int s_, int t) {
        char* SA = lds + s_ * 24576; char* SB = SA + 8192;
#pragma unroll
        for (int i = 0; i < 2; ++i) glds16(A + (ao[i] + (unsigned)(t * 32)), SA + i * 4096 + tid * 16);
#pragma unroll
        for (int i = 0; i < 4; ++i) glds16(B + (bo[i] + (unsigned)(t * 32)), SB + i * 4096 + tid * 16);
    };
    WAIT_VM(0);
    stage(0, 0);
    stage(1, 1);
    const int aoff = (wr * 64 + fr) * 64 + fq * 16, boff = 8192 + (wc * 128 + fr) * 64 + fq * 16;
#pragma unroll 1
    for (int t = 0; t < 32; ++t) {
        if (t + 1 < 32) WAIT_VM(6); else WAIT_VM(0);
        RAW_BARRIER();
        const char* S = lds + (t & 1) * 24576;
        bf16x8 af[4], bfr[8];
#pragma unroll
        for (int m = 0; m < 4; ++m) af[m] = *(const bf16x8*)(S + aoff + m * 1024);
#pragma unroll
        for (int n = 0; n < 8; ++n) bfr[n] = *(const bf16x8*)(S + boff + n * 1024);
        WAIT_LGKM0();
        RAW_BARRIER();
        if (t + 2 < 32) stage(t & 1, t + 2);
        __builtin_amdgcn_s_setprio(1);
#pragma unroll
        for (int m = 0; m < 4; ++m)
#pragma unroll
            for (int n = 0; n < 8; ++n) acc[m][n] = mfma16(bfr[n], af[m], acc[m][n]);
        __builtin_amdgcn_s_setprio(0);
    }
}
template <bool SHARED>
DEV void moe_tile(const Params& p, const bf16_t* W13, const bf16_t* W2, const int* list, int s0, int nvalid, int ysbase, int m0, int half, const float* g2, char* lds) {
    const int tid = get_tid(), lane = tid & 63, wid = tid >> 6, fr = lane & 15, fq = lane >> 4, wr = wid >> 1, wc = wid & 1;
    const bf16_t* H = (const bf16_t*)(p.ws + OFF_H);
    const float* tkw = (const float*)(p.ws + OFF_TKW);
    char* ACT = lds;
    const unsigned ch4 = (unsigned)((tid & 3) * 8);
    unsigned ao[2];
    float gw[4];
    if (SHARED) {
#pragma unroll
        for (int i = 0; i < 2; ++i) ao[i] = (unsigned)(m0 + i * 64 + (tid >> 2)) * 1024u + ch4;
#pragma unroll
        for (int m = 0; m < 4; ++m) gw[m] = 1.0f;
    } else {
#pragma unroll
        for (int i = 0; i < 2; ++i) { const int rr = min(i * 64 + (tid >> 2), nvalid - 1); ao[i] = (unsigned)(list[s0 + rr] >> 3) * 1024u + ch4; }
#pragma unroll
        for (int m = 0; m < 4; ++m) { const int rl = min(wr * 64 + m * 16 + fr, nvalid - 1); gw[m] = tkw[list[s0 + rl]]; }
    }
    {
        const unsigned b0 = (unsigned)(tid >> 2) * 1024u + ch4;
        const unsigned bo[4] = {b0, b0 + 64u * 1024u, b0 + 128u * 1024u, b0 + 192u * 1024u};
        f32x4 acc[4][8];
#pragma unroll
        for (int m = 0; m < 4; ++m)
#pragma unroll
            for (int n = 0; n < 8; ++n) acc[m][n] = (f32x4){0.f, 0.f, 0.f, 0.f};
        gemm_up256(acc, H, ao, W13, bo, lds);
        __syncthreads();
#pragma unroll
        for (int m = 0; m < 4; ++m)
#pragma unroll
            for (int pp = 0; pp < 4; ++pp) {
                float o[4];
#pragma unroll
                for (int j = 0; j < 4; ++j) { const float a = acc[m][2 * pp][j], b = acc[m][2 * pp + 1][j]; o[j] = a * __builtin_amdgcn_rcpf(1.0f + __expf(-a)) * b * gw[m]; }
                *(u32x2*)(ACT + (wr * 64 + m * 16 + fr) * 272 + (wc * 64 + pp * 16 + 4 * fq) * 2) = (u32x2){pk2(o[0], o[1]), pk2(o[2], o[3])};
            }
    }
    __syncthreads();
    if (SHARED) {
        gemm2_stream64<128, 272>(W2, ACT, lds + 36864, [&](int nt, const f32x4 (&acc)[4][4]) {
#pragma unroll
            for (int m = 0; m < 4; ++m) {
                unsigned char* o = ys_row(p, ysbase + m0 + wr * 64 + m * 16 + fr) + nt * 128 + wc * 64 + 8 * fq;
#pragma unroll
                for (int g = 0; g < 2; ++g) *(u32x2*)(o + g * 32) = (u32x2){pk4_fp8(acc[m][2 * g]), pk4_fp8(acc[m][2 * g + 1])};
            }
        });
    } else {
        gemm2_stream64<128, 272>(W2, ACT, lds + 36864, [&](int nt, const f32x4 (&acc)[4][4]) {
#pragma unroll
            for (int m = 0; m < 4; ++m) {
                const int rl = wr * 64 + m * 16 + fr;
                if (rl < nvalid) {
                    unsigned char* o = ys_row(p, ysbase + s0 + rl) + nt * 128 + wc * 64 + 8 * fq;
#pragma unroll
                    for (int g = 0; g < 2; ++g) *(u32x2*)(o + g * 32) = (u32x2){pk4_fp8(acc[m][2 * g]), pk4_fp8(acc[m][2 * g + 1])};
                }
            }
        });
    }
    __syncthreads();
}
DEV void phase_moe(const Params& p, int l, int r, char* lds) {
    const int* cnt = (const int*)(p.ws + OFF_CNT) + l * 64 * 64;
    moe_plan(cnt, p.cap, l, lds);
    const int* PL = (const int*)(lds + PLAN_OFF);
    if (r >= PL[0]) return;
    const int e_lo = PL[1 + r], e_hi = PL[2 + r];
    const int nrt = PL[10 + r];
    const int nrows = (l == 0) ? NT : NLAT;
    const int nshu = (r == 0) ? 2 * (nrows / 128) : 0;
    const int G = (int)gridDim.x, b = vblock();
    const int q = (nshu + nrt + G - 1) / G;
    const int u0 = b * q, u1 = min(u0 + q, nshu + nrt);
    int e = e_lo;
    for (int u = u0; u < u1; ++u) {
        if (u < nshu) {
            const int m0 = (u >> 1) * 128, hh = u & 1;
            moe_tile<true>(p, (const bf16_t*)(p.ws + OFF_SW13) + (size_t)(l * 2 + hh) * 256 * 1024, (const bf16_t*)(p.ws + OFF_SW2) + (size_t)(l * 2 + hh) * 1024 * 128,
                           nullptr, 0, 128, PL[208] + hh * nrows, m0, hh, nullptr, lds);
        } else {
            const int it = u - nshu;
            while (e + 1 < e_hi && PL[16 + e + 1] <= it) ++e;
            const int s0 = (it - PL[16 + e]) * 128;
            moe_tile<false>(p, (const bf16_t*)(p.ws + OFF_W13) + (size_t)e * 256 * 1024, (const bf16_t*)(p.ws + OFF_W2) + (size_t)e * 1024 * 128,
                            (const int*)(p.ws + OFF_LIST) + (size_t)e * NT, s0, min(128, PL[144 + e] - s0), PL[80 + e], 0, 0, nullptr, lds);
        }
    }
}

DEV void phase_comb(const Params& p, int l, int r, char* lds) {
    const int tid_ = get_tid(), lane = tid_ & 63, wid = tid_ >> 6;
    const int* cnt = (const int*)(p.ws + OFF_CNT) + l * 64 * 64;
    moe_plan(cnt, p.cap, l, lds);
    const int* PL = (const int*)(lds + PLAN_OFF);
    if (r >= PL[0]) return;
    const int e_lo = PL[1 + r], e_hi = PL[2 + r];
    const bool final = (r == PL[0] - 1);
    bf16_t* X = (bf16_t*)(p.ws + OFF_X);
    bf16_t* H = (bf16_t*)(p.ws + OFF_H);
    const int* tke = (const int*)(p.ws + OFF_TKE); const int* tks = (const int*)(p.ws + OFF_TKS);
    const float* mod = (const float*)(p.ws + OFF_MOD);
    const int nrows = (l == 0) ? NT : NLAT;
    const int rstep = (int)gridDim.x * 4;
    auto issue = [&](int rw, int e, int sl, u32x4 (&yy)[10], u32x4& xa_, u32x4& xb_) {
        int idx_l = -1;
        if (lane < 8 && e >= e_lo && e < e_hi) idx_l = PL[80 + e] + sl;
        xa_ = *(const u32x4*)(X + (size_t)rw * 1024 + 16 * lane); xb_ = *(const u32x4*)(X + (size_t)rw * 1024 + 16 * lane + 8);
#pragma unroll
        for (int k = 0; k < 8; ++k) {
            const int idx = __builtin_amdgcn_readlane(idx_l, k);
            if (idx >= 0) yy[k] = *(const u32x4*)(ys_row(p, idx) + 16 * lane); else yy[k] = (u32x4){0u, 0u, 0u, 0u};
        }
        if (r == 0) { yy[8] = *(const u32x4*)(ys_row(p, PL[208] + rw) + 16 * lane); yy[9] = *(const u32x4*)(ys_row(p, PL[208] + nrows + rw) + 16 * lane); }
        else { yy[8] = (u32x4){0u, 0u, 0u, 0u}; yy[9] = yy[8]; }
    };
    int row = blockIdx.x * 4 + wid, rown = row + rstep;
    int e_n = 0, sl_n = 0;
    u32x4 y[10], xa, xb;
    if (row < nrows) {
        if (lane < 8) { e_n = tke[row * 8 + lane]; sl_n = tks[row * 8 + lane]; }
        issue(row, e_n, sl_n, y, xa, xb);
        if (rown < nrows && lane < 8) { e_n = tke[rown * 8 + lane]; sl_n = tks[rown * 8 + lane]; }
    }
    for (; row < nrows; row = rown, rown += rstep) {
        u32x4 y2[10], xa2, xb2;
        if (rown < nrows) {
            issue(rown, e_n, sl_n, y2, xa2, xb2);
            const int r3 = rown + rstep;
            if (r3 < nrows && lane < 8) { e_n = tke[r3 * 8 + lane]; sl_n = tks[r3 * 8 + lane]; }
        } else {
#pragma unroll
            for (int k = 0; k < 10; ++k) y2[k] = (u32x4){0u, 0u, 0u, 0u};
            xa2 = y2[0]; xb2 = y2[0];
        }
        const int g = mod_group(row);
        const float* g2 = mod + ((size_t)l * 9 + g) * 6144 + 5120 + 16 * lane;
        f32x4 v[4];
        {
            const u32x4 a = xa, b2 = xb;
            v[0] = (f32x4){__uint_as_float(a[0] << 16), __uint_as_float(a[0] & 0xffff0000u), __uint_as_float(a[1] << 16), __uint_as_float(a[1] & 0xffff0000u)};
            v[1] = (f32x4){__uint_as_float(a[2] << 16), __uint_as_float(a[2] & 0xffff0000u), __uint_as_float(a[3] << 16), __uint_as_float(a[3] & 0xffff0000u)};
            v[2] = (f32x4){__uint_as_float(b2[0] << 16), __uint_as_float(b2[0] & 0xffff0000u), __uint_as_float(b2[1] << 16), __uint_as_float(b2[1] & 0xffff0000u)};
            v[3] = (f32x4){__uint_as_float(b2[2] << 16), __uint_as_float(b2[2] & 0xffff0000u), __uint_as_float(b2[3] << 16), __uint_as_float(b2[3] & 0xffff0000u)};
        }
        f32x4 s[4];
#pragma unroll
        for (int j = 0; j < 4; ++j) s[j] = (f32x4){0.f, 0.f, 0.f, 0.f};
#pragma unroll
        for (int k = 0; k < 10; ++k)
#pragma unroll
            for (int j = 0; j < 4; ++j) s[j] += up4_fp8(y[k][j]);
        const float xs = (r == 0) ? DN_ALPHA : 1.0f;
#pragma unroll
        for (int j = 0; j < 4; ++j) v[j] = v[j] * xs + *(const f32x4*)(g2 + 4 * j) * (s[j] * YS_INV);
        if (!final) {
            u32x4 o0, o1;
            o0 = (u32x4){pk2(v[0][0], v[0][1]), pk2(v[0][2], v[0][3]), pk2(v[1][0], v[1][1]), pk2(v[1][2], v[1][3])};
            o1 = (u32x4){pk2(v[2][0], v[2][1]), pk2(v[2][2], v[2][3]), pk2(v[3][0], v[3][1]), pk2(v[3][2], v[3][3])};
            *(u32x4*)(X + (size_t)row * 1024 + 16 * lane) = o0; *(u32x4*)(X + (size_t)row * 1024 + 16 * lane + 8) = o1;
        } else {
            row_norm(v);
#pragma unroll
            for (int j = 0; j < 4; ++j) {
                const int c = 16 * lane + 4 * j;
                v[j] = v[j] * *(const f32x4*)(p.ln2_g + l * 1024 + c) + *(const f32x4*)(p.ln2_b + l * 1024 + c);
                if (l != 0) *(f32x4*)(p.out + (size_t)row * 1024 + c) = v[j];
            }
            if (l == 0) {
                u32x4 o0, o1;
                o0 = (u32x4){pk2(v[0][0], v[0][1]), pk2(v[0][2], v[0][3]), pk2(v[1][0], v[1][1]), pk2(v[1][2], v[1][3])};
                o1 = (u32x4){pk2(v[2][0], v[2][1]), pk2(v[2][2], v[2][3]), pk2(v[3][0], v[3][1]), pk2(v[3][2], v[3][3])};
                *(u32x4*)(X + (size_t)row * 1024 + 16 * lane) = o0; *(u32x4*)(X + (size_t)row * 1024 + 16 * lane + 8) = o1;
                row_norm(v);
                const float* m1 = mod + ((size_t)9 + g) * 6144 + 16 * lane;
                f32x4 h[4];
#pragma unroll
                for (int j = 0; j < 4; ++j) h[j] = v[j] * (*(const f32x4*)(m1 + 1024 + 4 * j) + 1.0f) + *(const f32x4*)(m1 + 4 * j);
                o0 = (u32x4){pk2(h[0][0], h[0][1]), pk2(h[0][2], h[0][3]), pk2(h[1][0], h[1][1]), pk2(h[1][2], h[1][3])};
                o1 = (u32x4){pk2(h[2][0], h[2][1]), pk2(h[2][2], h[2][3]), pk2(h[3][0], h[3][1]), pk2(h[3][2], h[3][3])};
                *(u32x4*)(H + (size_t)row * 1024 + 16 * lane) = o0; *(u32x4*)(H + (size_t)row * 1024 + 16 * lane + 8) = o1;
            }
        }
#pragma unroll
        for (int k = 0; k < 10; ++k) y[k] = y2[k];
        xa = xa2; xb = xb2;
    }
}


#define XB_TMO      128
#define XB_XCNT(j)  (256  + 64 * (j))
#define XB_XSUB(j)  (1280 + 64 * (j))
#define XB_XGEN(j)  (2304 + 64 * (j))
#define XB_TOP      3328
#define XB_TOPGEN   3392
#define XCD_BAR_WORDS 3456
#define XB_SPIN_CAP (1u << 22)
DEV unsigned xb_ld(unsigned* p) { return __hip_atomic_load(p, __ATOMIC_RELAXED, __HIP_MEMORY_SCOPE_AGENT); }
DEV unsigned xb_add(unsigned* p, unsigned v) { return __hip_atomic_fetch_add(p, v, __ATOMIC_RELAXED, __HIP_MEMORY_SCOPE_AGENT); }
DEV unsigned xb_xcc_id() { return (unsigned)__builtin_amdgcn_s_getreg((3 << 11) | 20) & 0xFu; }
#define XB_SPIN(cond, bar) do { unsigned _sp = 0; while (cond) { __builtin_amdgcn_s_sleep(1); \
    if ((++_sp & 255u) == 0u) { if (xb_ld(&(bar)[XB_TMO])) break; if (_sp > XB_SPIN_CAP) { atomicAdd(&(bar)[XB_TMO], 1u); break; } } } } while (0)
struct XcdBarrier { unsigned* bar; unsigned x; volatile LAS unsigned* st; };
DEV XcdBarrier xcd_barrier_post(unsigned* bar, volatile LAS unsigned* st) {
    XcdBarrier b; b.bar = bar; b.x = xb_xcc_id(); b.st = st;
    if (threadIdx.x == 0) (void)xb_add(&bar[XB_XCNT(b.x)], 1u);
    return b;
}
DEV void xcd_barrier_complete(unsigned* bar, unsigned x, unsigned& nloc, unsigned& nx) {
    const unsigned G = gridDim.x * gridDim.y * gridDim.z;
    unsigned sum, cnt, mine, sp = 0u;
    for (;;) {
        sum = 0u; cnt = 0u; mine = 0u;
#pragma unroll
        for (unsigned j = 0; j < 16; ++j) { const unsigned c = xb_ld(&bar[XB_XCNT(j)]); sum += c; cnt += (c > 0u) ? 1u : 0u; mine = (j == x) ? c : mine; }
        if (sum == G) break;
        __builtin_amdgcn_s_sleep(1);
        if ((++sp & 255u) == 0u) { if (xb_ld(&bar[XB_TMO])) break; if (sp > XB_SPIN_CAP) { atomicAdd(&bar[XB_TMO], 1u); break; } }
    }
    nloc = mine > 0u ? mine : 1u; nx = cnt > 0u ? cnt : 1u;
}
DEV void xcd_barrier(const XcdBarrier& b) {
    asm volatile("s_waitcnt vmcnt(0)" ::: "memory");
    __syncthreads();
    if (get_tid() == 0) {
        unsigned* bar = b.bar; asm volatile("" : "+s"(bar));
        __builtin_amdgcn_s_waitcnt(0);
        unsigned nloc = b.st[0], nx = b.st[1];
        if (nloc == 0u) { xcd_barrier_complete(bar, b.x, nloc, nx); b.st[0] = nloc; b.st[1] = nx; }
        const unsigned old = xb_add(&bar[XB_XSUB(b.x)], 1u);
        const unsigned gen = old / nloc;
        if (old + 1u == (gen + 1u) * nloc) {
            __builtin_amdgcn_fence(__ATOMIC_RELEASE, "agent");
            asm volatile("s_waitcnt vmcnt(0)" ::: "memory");
            const unsigned og = xb_add(&bar[XB_TOP], 1u);
            const unsigned tg = og / nx;
            if (og + 1u == (tg + 1u) * nx) xb_add(&bar[XB_TOPGEN], 1u);
            else XB_SPIN(xb_ld(&bar[XB_TOPGEN]) == tg, bar);
            __builtin_amdgcn_fence(__ATOMIC_ACQUIRE, "agent");
            xb_add(&bar[XB_XGEN(b.x)], 1u);
            asm volatile("s_waitcnt vmcnt(0)" ::: "memory");
        } else {
            XB_SPIN(xb_ld(&bar[XB_XGEN(b.x)]) == gen, bar);
            __builtin_amdgcn_fence(__ATOMIC_ACQUIRE, "agent");
            asm volatile("s_waitcnt vmcnt(0)" ::: "memory");
        }
    }
    __syncthreads();
}

enum { PT_PREP = 0, PT_MODFIN, PT_LNMOD0, PT_INPROJ, PT_MIX, PT_OUTPROJ, PT_LN1ROUTE, PT_MOE, PT_COMB };

DEV void run_phase(const Params& pin, int type, int l, int r, char* lds) {
    Params p = pin;
    { unsigned char* w = p.ws; asm volatile("" : "+s"(w)); p.ws = w; }
    switch (type) {
        case PT_PREP: phase_prep(p, lds); break;
        case PT_MODFIN: phase_modfin(p); break;
        case PT_LNMOD0: phase_lnmod0(p); break;
        case PT_INPROJ: phase_inproj(p, l, lds); break;
        case PT_MIX: phase_mix(p, l, lds); break;
        case PT_OUTPROJ: phase_outproj(p, l, lds); break;
        case PT_LN1ROUTE: phase_ln1route(p, l, lds); break;
        case PT_MOE: phase_moe(p, l, r, lds); break;
        default: phase_comb(p, l, r, lds); break;
    }
}

__global__ void __launch_bounds__(256, 2) fwd_kernel(Params p) {
    __shared__ __attribute__((aligned(16))) char smem[SMEM_BYTES];
#if MULTI_LAUNCH
    run_phase(p, p.ptype, p.pl, p.pr, smem);
#else
    if (threadIdx.x < 4) ((volatile LAS unsigned*)(smem + SMEM_BYTES - 16))[threadIdx.x] = 0u;
    __syncthreads();
    const XcdBarrier bar = xcd_barrier_post((unsigned*)(p.ws + OFF_BAR), (volatile LAS unsigned*)(smem + SMEM_BYTES - 16));
    int type = PT_PREP, l = 0, r = 0;
#if TELEM
    volatile LAS unsigned* tacc = (volatile LAS unsigned*)(smem + SMEM_BYTES - 128);
    if (threadIdx.x < 16) tacc[threadIdx.x] = 0u;
    unsigned long long t_prev = __builtin_amdgcn_s_memrealtime();
#endif
    for (;;) {
        run_phase(p, type, l, r, smem);
#if TELEM
        { const int ptype_done = type;
          xcd_barrier(bar);
          const unsigned long long t_now = __builtin_amdgcn_s_memrealtime();
          if (threadIdx.x == 0) tacc[ptype_done] += (unsigned)(t_now - t_prev);
          t_prev = t_now; }
#endif
        if (type < PT_MOE) { ++type; if (type == PT_MODFIN) ++type; r = 0; }
        else if (type == PT_MOE) type = PT_COMB;
        else {
            const int nr = ((const int*)(smem + PLAN_OFF))[0];
            if (r + 1 < nr) { ++r; type = PT_MOE; }
            else { if (l == 1) break; l = 1; r = 0; type = PT_INPROJ; }
        }
#if !TELEM
        xcd_barrier(bar);
#endif
    }
#if TELEM
    {
        unsigned* tel = (unsigned*)(p.ws + 36864);
        if (blockIdx.x == 0 && threadIdx.x == 0) { unsigned sa = 0u; for (int i = 0; i < 16; ++i) if ((TELEM_A >> i) & 1) sa += tacc[i]; tacc[15] = sa; }
        xcd_barrier(bar);
        if (blockIdx.x == 0 && threadIdx.x == 0) {
            p.out[0] += 1.0f + (float)tacc[TELEM_C] * 0.01f * 0.02f;
            const unsigned long long t0 = __builtin_amdgcn_s_memrealtime();
            const unsigned long long wait = 2ull * tacc[15];
            while (__builtin_amdgcn_s_memrealtime() - t0 < wait) __builtin_amdgcn_s_sleep(8);
        }
    }
#endif
#endif
}

extern "C" void kernel_launch(void* const* d_in, const int* in_sizes, int n_in, void* d_out, int out_size, void* d_ws, size_t ws_size, hipStream_t stream) {
    Params p{};
    const float** pp = (const float**)&p;
    for (int i = 0; i < 32; ++i) pp[i] = (const float*)d_in[i];
    p.out = (float*)d_out; p.ws = (unsigned char*)d_ws;
    long long cap = ((long long)ws_size - (long long)OFF_R) / 2048;
    if (cap > NT * 8) cap = NT * 8;
    if (cap * 2048 < (long long)R_MIN_BYTES || cap < NT) { fprintf(stderr, "kernel_launch: workspace too small (%zu)\n", ws_size); return; }
    p.cap = (int)cap;
#if MULTI_LAUNCH
    const int grid = 512;
    auto launch = [&](int type, int l, int r) { Params q = p; q.mode = 1; q.ptype = type; q.pl = l; q.pr = r; hipLaunchKernelGGL(fwd_kernel, dim3(grid), dim3(256), 0, stream, q); };
    launch(PT_PREP, 0, 0); launch(PT_MODFIN, 0, 0); launch(PT_LNMOD0, 0, 0);
    for (int l = 0; l < 2; ++l) {
        launch(PT_INPROJ, l, 0); launch(PT_MIX, l, 0); launch(PT_OUTPROJ, l, 0); launch(PT_LN1ROUTE, l, 0);
        for (int r = 0; r < RMAX; ++r) { launch(PT_MOE, l, r); launch(PT_COMB, l, r); }
    }
#else
    static int grid_blocks = 0;
    if (!grid_blocks) {
        int dev = 0, cus = 0, per_cu = 0;
        hipGetDevice(&dev);
        hipDeviceGetAttribute(&cus, hipDeviceAttributeMultiprocessorCount, dev);
        hipOccupancyMaxActiveBlocksPerMultiprocessor(&per_cu, fwd_kernel, 256, 0);
        if (per_cu > 2) per_cu = 2;
        if (per_cu < 1) per_cu = 1;
        grid_blocks = cus * per_cu;
    }
    p.mode = 0;
    hipMemsetAsync(d_ws, 0, 65536, stream);
    hipLaunchKernelGGL(fwd_kernel, dim3(grid_blocks), dim3(256), 0, stream, p);
#endif
}
```

```cpp
#include <hip/hip_runtime.h>
#ifndef TELEM
#define TELEM 0
#endif
#define TELEM_A 0x1
#define TELEM_C 8
#include <hip/hip_cooperative_groups.h>
#include <stdint.h>
#include <stdio.h>
namespace cg = cooperative_groups;

#ifndef MULTI_LAUNCH
#define MULTI_LAUNCH 0
#endif

typedef unsigned short bf16_t;
typedef short bf16x8 __attribute__((ext_vector_type(8)));
typedef short s16x4 __attribute__((ext_vector_type(4)));
typedef float f32x4 __attribute__((ext_vector_type(4)));
typedef unsigned u32x4 __attribute__((ext_vector_type(4)));
typedef unsigned u32x2 __attribute__((ext_vector_type(2)));
typedef unsigned u32x3 __attribute__((ext_vector_type(3)));
#define DEV __device__ __forceinline__
#define LDSP(T) __attribute__((address_space(3))) T*
#define LAS __attribute__((address_space(3)))

constexpr int D = 1024, NB = 8, SEQ = 2048, CTX = 256, NLAT = NB * SEQ, NCTX = NB * CTX, NT = NLAT + NCTX;
constexpr int PROJ = 2304, KEYS = CTX + SEQ, NEXP = 64;
constexpr float DN_ALPHA = 1.41421356237309515f;
constexpr float LOG2E = 1.44269504088896341f;
constexpr int SMEM_BYTES = 72 * 1024;
constexpr int RMAX = 4;

constexpr size_t OFF_CNT = 0;
constexpr size_t OFF_QUEUE = 33792;
constexpr size_t OFF_BAR = 40960;
constexpr size_t OFF_MOD = 65536;
constexpr size_t OFF_ROPE = OFF_MOD + 442368;
constexpr size_t OFF_KERNL = OFF_ROPE + 2ull * 2048 * 32 * 4;
constexpr size_t OFF_KERNC = OFF_KERNL + 2ull * 4096 * 256 * 4;
constexpr size_t OFF_TKE = OFF_KERNC + 2ull * 512 * 256 * 4;
constexpr size_t OFF_TKS = OFF_TKE + (size_t)NT * 8 * 4;
constexpr size_t OFF_TKW = OFF_TKS + (size_t)NT * 8 * 4;
constexpr size_t OFF_LIST = OFF_TKW + (size_t)NT * 8 * 4;
constexpr size_t OFF_WIN = OFF_LIST + 64ull * NT * 4;
constexpr size_t OFF_WOUT = OFF_WIN + 2ull * 2304 * 1024 * 2;
constexpr size_t OFF_SW13 = OFF_WOUT + 2ull * 1024 * 1024 * 2;
constexpr size_t OFF_SW2 = OFF_SW13 + 2ull * 512 * 1024 * 2;
constexpr size_t OFF_RW = OFF_SW2 + 2ull * 1024 * 256 * 2;
constexpr size_t OFF_W13 = OFF_RW + 2ull * 64 * 1024 * 2;
constexpr size_t OFF_W2 = OFF_W13 + 64ull * 256 * 1024 * 2;
constexpr size_t OFF_X = OFF_W2 + 64ull * 1024 * 128 * 2;
constexpr size_t OFF_H = OFF_X + (size_t)NT * 1024 * 2;
constexpr size_t OFF_R = OFF_H + (size_t)NT * 1024 * 2;
constexpr size_t OFF_QA = OFF_R;
constexpr size_t OFF_QB = OFF_QA + 8ull * NT * 64 * 2;
constexpr size_t OFF_KA = OFF_QB + 4ull * NT * 64 * 2;
constexpr size_t OFF_VA = OFF_KA + 8ull * 2 * KEYS * 64 * 2;
constexpr size_t OFF_KB = OFF_VA + 8ull * 2 * KEYS * 64 * 2;
constexpr size_t OFF_VB = OFF_KB + 8ull * 4 * KEYS * 64 * 2;
constexpr size_t OFF_ZTL = OFF_VB + 8ull * 4 * KEYS * 64 * 2;
constexpr size_t OFF_ZTC = OFF_ZTL + 8ull * 768 * 2048 * 2;
constexpr size_t OFF_OX = OFF_ZTC + 8ull * 768 * 256 * 2;
constexpr size_t OFF_OXT = OFF_OX + (size_t)NT * 1024 * 2;
constexpr size_t R_MIN_BYTES = OFF_OXT + 8ull * 256 * 2048 * 2 - OFF_R;
constexpr size_t OFF_PART = OFF_R;
constexpr size_t OFF_YS = OFF_R;

struct Params {
    const float *x, *c, *ctx, *c_ctx, *ada_w, *ada_b, *w_in, *q_gain, *k_gain, *nat_rpb, *hy_conv_w, *hy_conv_b,
        *hy_f_w1, *hy_f_b1, *hy_f_w2, *hy_f_b2, *hy_f_w3, *hy_freq, *hy_skip, *w_out, *ln1_g, *ln1_b,
        *router_w, *router_b, *exp_w1, *exp_w3, *exp_w2, *sh_w1, *sh_w3, *sh_w2, *ln2_g, *ln2_b;
    float* out; unsigned char* ws;
    int cap, mode, ptype, pl, pr, pad;
};
#if defined(__HIP_DEVICE_COMPILE__)
#define KGP __attribute__((address_space(1)))
#else
#define KGP
#endif
struct KArgs {
    const KGP float *x, *c, *ctx, *c_ctx, *ada_w, *ada_b, *w_in, *q_gain, *k_gain, *nat_rpb, *hy_conv_w, *hy_conv_b,
        *hy_f_w1, *hy_f_b1, *hy_f_w2, *hy_f_b2, *hy_f_w3, *hy_freq, *hy_skip, *w_out, *ln1_g, *ln1_b,
        *router_w, *router_b, *exp_w1, *exp_w3, *exp_w2, *sh_w1, *sh_w3, *sh_w2, *ln2_g, *ln2_b;
    KGP float* out; KGP unsigned char* ws;
    int cap, mode, ptype, pl, pr, pad;
};
static_assert(sizeof(KArgs) == sizeof(Params), "argument block layout");

typedef __bf16 hwbf2 __attribute__((ext_vector_type(2)));
typedef float f32x2 __attribute__((ext_vector_type(2)));
DEV unsigned f2bf(float f) { return (unsigned)__builtin_bit_cast(unsigned short, (__bf16)f); }
DEV unsigned pk2(float lo, float hi) { const f32x2 v = {lo, hi}; return __builtin_bit_cast(unsigned, __builtin_convertvector(v, hwbf2)); }
DEV float bf2f(unsigned short h) { return __uint_as_float(((unsigned)h) << 16); }
DEV float dpp_f(float old, float src, int ctrl, int row_mask) {
    return __builtin_bit_cast(float, ctrl == 0xB1 ? __builtin_amdgcn_update_dpp(__builtin_bit_cast(int, old), __builtin_bit_cast(int, src), 0xB1, 0xF, 0xF, false)
                                   : ctrl == 0x4E ? __builtin_amdgcn_update_dpp(__builtin_bit_cast(int, old), __builtin_bit_cast(int, src), 0x4E, 0xF, 0xF, false)
                                   : ctrl == 0x141 ? __builtin_amdgcn_update_dpp(__builtin_bit_cast(int, old), __builtin_bit_cast(int, src), 0x141, 0xF, 0xF, false)
                                   : ctrl == 0x140 ? __builtin_amdgcn_update_dpp(__builtin_bit_cast(int, old), __builtin_bit_cast(int, src), 0x140, 0xF, 0xF, false)
                                   : ctrl == 0x142 ? __builtin_amdgcn_update_dpp(__builtin_bit_cast(int, old), __builtin_bit_cast(int, src), 0x142, 0xA, 0xF, false)
                                                   : __builtin_amdgcn_update_dpp(__builtin_bit_cast(int, old), __builtin_bit_cast(int, src), 0x143, 0xC, 0xF, false));
}
DEV float wave_sum(float v) {
    v += dpp_f(0.f, v, 0xB1, 0xF);
    v += dpp_f(0.f, v, 0x4E, 0xF);
    v += dpp_f(0.f, v, 0x141, 0xF);
    v += dpp_f(0.f, v, 0x140, 0xF);
    v += dpp_f(0.f, v, 0x142, 0xA);
    v += dpp_f(0.f, v, 0x143, 0xC);
    return __builtin_bit_cast(float, __builtin_amdgcn_readlane(__builtin_bit_cast(int, v), 63));
}
DEV void glds16(const void* g, void* l) { __builtin_amdgcn_global_load_lds((const unsigned*)g, (unsigned*)l, 16, 0, 0); }
DEV f32x4 mfma16(bf16x8 a, bf16x8 b, f32x4 c) { return __builtin_amdgcn_mfma_f32_16x16x32_bf16(a, b, c, 0, 0, 0); }
DEV float readlane_f(float v, int l) { return __uint_as_float((unsigned)__builtin_amdgcn_readlane((int)__float_as_uint(v), l)); }
DEV int get_tid() { int t = threadIdx.x; asm volatile("" : "+v"(t)); return t; }
DEV int lchunk(int tid) { return (tid & 3) ^ ((0 - (tid >> 4)) & 3); }
DEV int vblock() { const int G = (int)gridDim.x, b = (int)blockIdx.x; return (G & 7) ? b : (b & 7) * (G >> 3) + (b >> 3); }
DEV int mod_group(int row) { return row < NLAT ? (row >> 11) : 8; }

template <int MI, int NI> DEV void zero_acc(f32x4 (&acc)[MI][NI]) {
#pragma unroll
    for (int m = 0; m < MI; ++m)
#pragma unroll
        for (int n = 0; n < NI; ++n) acc[m][n] = (f32x4){0.f, 0.f, 0.f, 0.f};
}
#define WAIT_VM(n) asm volatile("s_waitcnt vmcnt(" #n ")" ::: "memory")
#define WAIT_LGKM0() asm volatile("s_waitcnt lgkmcnt(0)" ::: "memory")
#define RAW_BARRIER() do { asm volatile("" ::: "memory"); __builtin_amdgcn_s_barrier(); asm volatile("" ::: "memory"); } while (0)
template <int MI, int NI, bool TRANS>
DEV void gemm_core(f32x4 (&acc)[MI][NI], const bf16_t* A, const unsigned (&ao)[MI / 2], const bf16_t* B, const unsigned (&bo)[NI / 2], int K, char* lds) {
    const int tid = get_tid(), lane = tid & 63, wid = tid >> 6, fr = lane & 15, fq = lane >> 4, wr = wid >> 1, wc = wid & 1;
    constexpr int SAB = 2048 * MI, STG = 2048 * (MI + NI), LPT = MI / 2 + NI / 2;
    static_assert(LPT == 3 || LPT == 4 || LPT == 6, "loads per tile");
    const int nt = K >> 5;
    auto stage = [&](int s, int t) {
        char* SA = lds + s * STG; char* SB = SA + SAB;
#pragma unroll
        for (int i = 0; i < MI / 2; ++i) glds16(A + (ao[i] + (unsigned)(t * 32)), SA + i * 4096 + tid * 16);
#pragma unroll
        for (int i = 0; i < NI / 2; ++i) glds16(B + (bo[i] + (unsigned)(t * 32)), SB + i * 4096 + tid * 16);
    };
    WAIT_VM(0);
    stage(0, 0);
    if (nt > 1) stage(1, 1);
    const int sw = (fq ^ ((0 - (fr >> 2)) & 3)) * 16;
    const int aoff = (wr * MI * 16 + fr) * 64 + sw, boff = SAB + (wc * NI * 16 + fr) * 64 + sw;
#pragma unroll 1
    for (int t = 0; t < nt; ++t) {
        if (t + 1 < nt) { if (LPT == 6) WAIT_VM(6); else if (LPT == 4) WAIT_VM(4); else WAIT_VM(3); } else WAIT_VM(0);
        RAW_BARRIER();
        const char* S = lds + (t & 1) * STG;
        bf16x8 af[MI], bfr[NI];
#pragma unroll
        for (int m = 0; m < MI; ++m) af[m] = *(const bf16x8*)(S + aoff + m * 1024);
#pragma unroll
        for (int n = 0; n < NI; ++n) bfr[n] = *(const bf16x8*)(S + boff + n * 1024);
        WAIT_LGKM0();
        RAW_BARRIER();
        if (t + 2 < nt) stage(t & 1, t + 2);
#pragma unroll
        for (int m = 0; m < MI; ++m)
#pragma unroll
            for (int n = 0; n < NI; ++n) acc[m][n] = TRANS ? mfma16(bfr[n], af[m], acc[m][n]) : mfma16(af[m], bfr[n], acc[m][n]);
    }
}
DEV unsigned st64_off(int tid) { return (unsigned)(tid >> 3) * 1024u + (unsigned)(((tid & 7) ^ ((tid >> 3) & 7)) * 8); }
DEV int tr_key(int row) { return (row & 3) | (((row >> 3) & 1) << 2); }
template <bool TRANS>
DEV void gemm_core64(f32x4 (&acc)[4][4], const bf16_t* A, const unsigned (&ao)[4], const bf16_t* B, const unsigned (&bo)[4], int K, char* lds,
                     const bf16_t* AT = nullptr, int t_tr = 1 << 20) {
    const int tid = get_tid(), lane = tid & 63, wid = tid >> 6, fr = lane & 15, fq = lane >> 4, wr = wid >> 1, wc = wid & 1;
    const int nt = K >> 6;
    auto stage = [&](int s, int t) {
        char* SA = lds + s * 32768; char* SB = SA + 16384;
        if (t >= t_tr) {
#pragma unroll
            for (int i = 0; i < 4; ++i) {
                const int id = tid + 256 * i, row = id >> 4, cp = id & 15, c = (cp - 2 * tr_key(row)) & 15;
                glds16(AT + (size_t)((t - t_tr) * 64 + row) * 2048 + c * 8, SA + id * 16);
            }
        } else {
#pragma unroll
            for (int i = 0; i < 4; ++i) glds16(A + (ao[i] + (unsigned)(t * 64)), SA + i * 4096 + tid * 16);
        }
#pragma unroll
        for (int i = 0; i < 4; ++i) glds16(B + (bo[i] + (unsigned)(t * 64)), SB + i * 4096 + tid * 16);
    };
    WAIT_VM(0);
    stage(0, 0);
    if (nt > 1) stage(1, 1);
    const int rsw = fr & 7;
    const int arow = (wr * 64 + fr) * 128, brow = 16384 + (wc * 64 + fr) * 128;
    const int c0 = ((fq) ^ rsw) * 16, c1 = ((4 + fq) ^ rsw) * 16;
#pragma unroll 1
    for (int t = 0; t < nt; ++t) {
        if (t + 1 < nt) WAIT_VM(8); else WAIT_VM(0);
        RAW_BARRIER();
        const char* S = lds + (t & 1) * 32768;
        bf16x8 af[4][2], bfr[4][2];
        if (t >= t_tr) {
            const int q4 = fr >> 2, p4 = fr & 3;
#pragma unroll
            for (int m = 0; m < 4; ++m)
#pragma unroll
                for (int ks = 0; ks < 2; ++ks) {
                    const int rowA = ks * 32 + 8 * fq + q4, rowB = rowA + 4, c = wr * 8 + m * 2 + (p4 >> 1);
                    const int offA = rowA * 256 + (((c + 2 * tr_key(rowA)) & 15) * 16) + (p4 & 1) * 8;
                    const int offB = rowB * 256 + (((c + 2 * tr_key(rowB)) & 15) * 16) + (p4 & 1) * 8;
                    const s16x4 ta = __builtin_amdgcn_ds_read_tr16_b64_v4i16((LDSP(s16x4))(S + offA));
                    const s16x4 tb = __builtin_amdgcn_ds_read_tr16_b64_v4i16((LDSP(s16x4))(S + offB));
                    bf16x8 f; f[0] = ta[0]; f[1] = ta[1]; f[2] = ta[2]; f[3] = ta[3]; f[4] = tb[0]; f[5] = tb[1]; f[6] = tb[2]; f[7] = tb[3];
                    af[m][ks] = f;
                }
        } else {
#pragma unroll
            for (int m = 0; m < 4; ++m) { af[m][0] = *(const bf16x8*)(S + arow + m * 2048 + c0); af[m][1] = *(const bf16x8*)(S + arow + m * 2048 + c1); }
        }
#pragma unroll
        for (int n = 0; n < 4; ++n) { bfr[n][0] = *(const bf16x8*)(S + brow + n * 2048 + c0); bfr[n][1] = *(const bf16x8*)(S + brow + n * 2048 + c1); }
        WAIT_LGKM0();
        RAW_BARRIER();
        if (t + 2 < nt) stage(t & 1, t + 2);
        __builtin_amdgcn_s_setprio(1);
#pragma unroll
        for (int ks = 0; ks < 2; ++ks)
#pragma unroll
            for (int m = 0; m < 4; ++m)
#pragma unroll
                for (int n = 0; n < 4; ++n) acc[m][n] = TRANS ? mfma16(bfr[n][ks], af[m][ks], acc[m][n]) : mfma16(af[m][ks], bfr[n][ks], acc[m][n]);
        __builtin_amdgcn_s_setprio(0);
    }
}
template <int KACT, int ASTRIDE, class EPI>
DEV void gemm2_stream64(const bf16_t* W2, const char* ACT, char* sb, EPI&& epi) {
    const int tid = get_tid(), lane = tid & 63, wid = tid >> 6, fr = lane & 15, fq = lane >> 4, wr = wid >> 1, wc = wid & 1;
    constexpr int KS = KACT / 64, NJ = 8 * KS;
    const unsigned b0 = (unsigned)(tid >> 3) * KACT + (unsigned)(((tid & 7) ^ ((tid >> 3) & 7)) * 8);
    auto stage = [&](int s, int j) {
        const int nt = j / KS, ks = j % KS;
        char* SB = sb + s * 16384;
        const bf16_t* src = W2 + (size_t)nt * 128 * KACT + ks * 64 + b0;
#pragma unroll
        for (int i = 0; i < 4; ++i) glds16(src + (size_t)i * 32 * KACT, SB + i * 4096 + tid * 16);
    };
    WAIT_VM(0);
    stage(0, 0); stage(1, 1);
    const int rsw = fr & 7;
    const int brow = (wc * 64 + fr) * 128, c0 = (fq ^ rsw) * 16, c1 = ((4 + fq) ^ rsw) * 16;
    f32x4 acc[4][4]; zero_acc<4, 4>(acc);
#pragma unroll 1
    for (int j = 0; j < NJ; ++j) {
        const int ks = j % KS;
        if (j + 1 < NJ) WAIT_VM(4); else WAIT_VM(0);
        RAW_BARRIER();
        const char* S = sb + (j & 1) * 16384;
        bf16x8 af[4][2], bfr[4][2];
#pragma unroll
        for (int m = 0; m < 4; ++m) { const char* ar = ACT + (wr * 64 + m * 16 + fr) * ASTRIDE + (ks * 64 + fq * 8) * 2; af[m][0] = *(const bf16x8*)ar; af[m][1] = *(const bf16x8*)(ar + 64); }
#pragma unroll
        for (int n = 0; n < 4; ++n) { bfr[n][0] = *(const bf16x8*)(S + brow + n * 2048 + c0); bfr[n][1] = *(const bf16x8*)(S + brow + n * 2048 + c1); }
        WAIT_LGKM0();
        RAW_BARRIER();
        if (j + 2 < NJ) stage(j & 1, j + 2);
#pragma unroll
        for (int k2 = 0; k2 < 2; ++k2)
#pragma unroll
            for (int m = 0; m < 4; ++m)
#pragma unroll
                for (int n = 0; n < 4; ++n) acc[m][n] = mfma16(bfr[n][k2], af[m][k2], acc[m][n]);
        if (ks == KS - 1) { epi(j / KS, acc); zero_acc<4, 4>(acc); }
    }
}
template <int MI, int KACT, int ASTRIDE, class EPI>
DEV void gemm2_stream(const bf16_t* W2, const char* ACT, char* sb, EPI&& epi) {
    const int tid = get_tid(), lane = tid & 63, wid = tid >> 6, fr = lane & 15, fq = lane >> 4, wr = wid >> 1, wc = wid & 1;
    constexpr int KS = KACT / 32, NJ = 8 * KS;
    const bf16_t* b0 = W2 + (size_t)(tid >> 2) * KACT + lchunk(tid) * 8;
    auto stage = [&](int s, int j) {
        const int nt = j / KS, ks = j % KS;
        char* SB = sb + s * 8192;
        const bf16_t* src = b0 + (size_t)nt * 128 * KACT + ks * 32;
        glds16(src, SB + tid * 16);
        glds16(src + 64 * KACT, SB + 4096 + tid * 16);
    };
    WAIT_VM(0);
    stage(0, 0); stage(1, 1);
    const int boff = (wc * 64 + fr) * 64 + (fq ^ ((0 - (fr >> 2)) & 3)) * 16;
    f32x4 acc[MI][4]; zero_acc<MI, 4>(acc);
#pragma unroll 1
    for (int j = 0; j < NJ; ++j) {
        const int ks = j % KS;
        if (j + 1 < NJ) WAIT_VM(2); else WAIT_VM(0);
        RAW_BARRIER();
        const char* S = sb + (j & 1) * 8192;
        bf16x8 af[MI], bfr[4];
#pragma unroll
        for (int m = 0; m < MI; ++m) af[m] = *(const bf16x8*)(ACT + (wr * MI * 16 + m * 16 + fr) * ASTRIDE + (ks * 32 + fq * 8) * 2);
#pragma unroll
        for (int n = 0; n < 4; ++n) bfr[n] = *(const bf16x8*)(S + boff + n * 1024);
        WAIT_LGKM0();
        RAW_BARRIER();
        if (j + 2 < NJ) stage(j & 1, j + 2);
#pragma unroll
        for (int m = 0; m < MI; ++m)
#pragma unroll
            for (int n = 0; n < 4; ++n) acc[m][n] = mfma16(bfr[n], af[m], acc[m][n]);
        if (ks == KS - 1) { epi(j / KS, acc); zero_acc<MI, 4>(acc); }
    }
}

DEV void prep_mod_item(const Params& p, int it, char* lds) {
    const int l = it / 96, r = it % 96, cch = r >> 2, kp = r & 3, tid = get_tid(), lane = tid & 63, kq = tid >> 6;
    float* sl = (float*)lds;
    float* red = sl + 9 * 256;
    const float* w = p.ada_w + ((size_t)l * 1024 + kp * 256 + kq * 64) * 6144 + cch * 256 + lane * 4;
    f32x4 w0[16];
#pragma unroll
    for (int kk = 0; kk < 16; ++kk) w0[kk] = *(const f32x4*)(w + (size_t)kk * 6144);
    for (int i = tid; i < 9 * 256; i += 256) { const int g = i >> 8, k = kp * 256 + (i & 255); const float v = (g < 8) ? p.c[g * 1024 + k] : p.c_ctx[k]; sl[i] = v * __builtin_amdgcn_rcpf(1.f + __expf(-v)); }
    __syncthreads();
    f32x4 acc[9];
#pragma unroll
    for (int g = 0; g < 9; ++g) acc[g] = (f32x4){0.f, 0.f, 0.f, 0.f};
#pragma unroll
    for (int kk = 0; kk < 16; ++kk) {
#pragma unroll
        for (int g = 0; g < 9; ++g) { const float sv = sl[g * 256 + kq * 64 + kk]; acc[g] += sv * w0[kk]; }
    }
#pragma unroll 16
    for (int kk = 16; kk < 64; ++kk) {
        const f32x4 wv = *(const f32x4*)(w + (size_t)kk * 6144);
#pragma unroll
        for (int g = 0; g < 9; ++g) { const float sv = sl[g * 256 + kq * 64 + kk]; acc[g] += sv * wv; }
    }
#pragma unroll
    for (int g = 0; g < 9; ++g) *(f32x4*)(red + (kq * 9 + g) * 256 + lane * 4) = acc[g];
    __syncthreads();
    float* part = (float*)(p.ws + OFF_R) + (size_t)(l * 24 + cch) * 4 * 2304;
    for (int i = tid; i < 9 * 256; i += 256) {
        const int g = i >> 8, c = i & 255;
        __hip_atomic_store(part + kp * 2304 + i, (red[(0 * 9 + g) * 256 + c] + red[(1 * 9 + g) * 256 + c]) + (red[(2 * 9 + g) * 256 + c] + red[(3 * 9 + g) * 256 + c]), __ATOMIC_RELAXED, __HIP_MEMORY_SCOPE_AGENT);
    }
    asm volatile("s_waitcnt vmcnt(0)" ::: "memory");
    __syncthreads();
    int* arrive = (int*)(lds + SMEM_BYTES - 252);
    if (tid == 0) *arrive = atomicAdd((int*)(p.ws + OFF_QUEUE) + 256 + l * 24 + cch, 1);
    __syncthreads();
    if (*arrive == 3) {
        float* mod = (float*)(p.ws + OFF_MOD);
        for (int i = tid; i < 9 * 256; i += 256) {
            const int g = i >> 8, c = i & 255;
            const float v = (__hip_atomic_load(part + i, __ATOMIC_RELAXED, __HIP_MEMORY_SCOPE_AGENT) + __hip_atomic_load(part + 2304 + i, __ATOMIC_RELAXED, __HIP_MEMORY_SCOPE_AGENT))
                          + (__hip_atomic_load(part + 2 * 2304 + i, __ATOMIC_RELAXED, __HIP_MEMORY_SCOPE_AGENT) + __hip_atomic_load(part + 3 * 2304 + i, __ATOMIC_RELAXED, __HIP_MEMORY_SCOPE_AGENT));
            mod[((size_t)l * 9 + g) * 6144 + cch * 256 + c] = p.ada_b[l * 6144 + cch * 256 + c] + v;
        }
    }
    __syncthreads();
}
constexpr float INV2PI = 0.15915494309189535f;
DEV float sin_rev(float r) { return __builtin_amdgcn_sinf(__builtin_amdgcn_fractf(r)); }
DEV float cos_rev(float r) { return __builtin_amdgcn_cosf(__builtin_amdgcn_fractf(r)); }
DEV void prep_rope_item(const Params& p, int it) {
    const int idx = it * 256 + get_tid(), t = idx >> 5, i = idx & 31;
    const float inv = __builtin_amdgcn_exp2f(-(float)(2 * (i & 15)) * (13.287712379549449f / 32.f));
    const float ang = (float)((i < 16) ? (t >> 6) : (t & 63)) * inv;
    float* rc = (float*)(p.ws + OFF_ROPE);
    rc[(t * 16 + (i >> 1)) * 4 + (i & 1) * 2] = cos_rev(ang * INV2PI); rc[(t * 16 + (i >> 1)) * 4 + (i & 1) * 2 + 1] = sin_rev(ang * INV2PI);
}
DEV void prep_filter_item(const Params& p, int it, char* lds) {
    const int tid = get_tid(), lane = tid & 63, wid = tid >> 6;
    const int row0 = it * 32 + wid * 8;
    const int l = row0 / 2304, r0 = row0 % 2304, type = r0 < 2048 ? 0 : 1, t0 = type ? r0 - 2048 : r0, n = type ? 256 : 2048;
    float* z = (float*)lds + wid * (8 * 192); float* h1 = z + 8 * 64; float* h2 = h1 + 8 * 64;
    float* WL = (float*)(lds + 24576);
    const float rn1 = type ? 1.f / 255.f : 1.f / 2047.f;
    f32x4 w12[7];
#pragma unroll
    for (int k = 0; k < 7; ++k) {
        const int idx = tid + 256 * k, row = idx >> 4, c4 = (idx & 15) * 4;
        const float* src = row < 33 ? p.hy_f_w1 + (l * 33 + row) * 64 : p.hy_f_w2 + (l * 64 + row - 33) * 64;
        w12[k] = idx < 97 * 16 ? *(const f32x4*)(src + c4) : (f32x4){0.f, 0.f, 0.f, 0.f};
    }
    const float b1v = p.hy_f_b1[l * 64 + lane], b2v = p.hy_f_b2[l * 64 + lane], fq0 = p.hy_freq[(l * 2 + 0) * 64 + lane], fq1 = p.hy_freq[(l * 2 + 1) * 64 + lane];
    const float* w3 = p.hy_f_w3 + (size_t)l * 64 * 512;
    f32x4 wq[4][8];
#pragma unroll
    for (int ch = 0; ch < 4; ++ch)
#pragma unroll
        for (int j = 0; j < 8; ++j) wq[ch][j] = *(const f32x4*)(w3 + (size_t)ch * 16 * 512 + (tid + j * 256) * 4);
#pragma unroll
    for (int k = 0; k < 7; ++k) { const int idx = tid + 256 * k; if (idx < 97 * 16) *(f32x4*)(WL + idx * 4) = w12[k]; }
#pragma unroll
    for (int rr = 0; rr < 8; ++rr) {
        const int t = t0 + rr;
        if (lane < 33) {
            float v;
            if (lane == 0) v = (float)t * rn1;
            else {
                const int i = (lane - 1) & 15;
                const float f = 1e-4f + (float)i * ((15.f - 1e-4f) / 15.f);
                const float rev = f * ((float)t * (type ? 1.f / 256.f : 1.f / 2048.f));
                v = (lane <= 16) ? cos_rev(rev) : -sin_rev(rev);
            }
            z[rr * 64 + lane] = v;
        }
    }
    __syncthreads();
    {
        float s[8]; const float b = b1v;
#pragma unroll
        for (int rr = 0; rr < 8; ++rr) s[rr] = b;
#pragma unroll 11
        for (int i = 0; i < 33; ++i) {
            const float w = WL[i * 64 + lane];
#pragma unroll
            for (int rr = 0; rr < 8; ++rr) s[rr] += z[rr * 64 + i] * w;
        }
#pragma unroll
        for (int rr = 0; rr < 8; ++rr) h1[rr * 64 + lane] = sin_rev(fq0 * s[rr] * INV2PI);
    }
    __builtin_amdgcn_wave_barrier();
    {
        float s[8]; const float b = b2v;
#pragma unroll
        for (int rr = 0; rr < 8; ++rr) s[rr] = b;
#pragma unroll 16
        for (int i = 0; i < 64; ++i) {
            const float w = WL[(33 + i) * 64 + lane];
#pragma unroll
            for (int rr = 0; rr < 8; ++rr) s[rr] += h1[rr * 64 + i] * w;
        }
#pragma unroll
        for (int rr = 0; rr < 8; ++rr) h2[rr * 64 + lane] = sin_rev(fq1 * s[rr] * INV2PI);
    }
    __syncthreads();
    float acc[8][8];
#pragma unroll
    for (int rr = 0; rr < 8; ++rr)
#pragma unroll
        for (int q = 0; q < 8; ++q) acc[rr][q] = 0.f;
#pragma unroll
    for (int ch = 0; ch < 4; ++ch) {
#pragma unroll
        for (int j = 0; j < 8; ++j) *(f32x4*)(WL + (tid + j * 256) * 4) = wq[ch][j];
        __syncthreads();
#pragma unroll 2
        for (int i = 0; i < 16; ++i) {
            float w[8];
#pragma unroll
            for (int q = 0; q < 8; ++q) w[q] = WL[i * 512 + q * 64 + lane];
#pragma unroll
            for (int rr = 0; rr < 8; ++rr) {
                const float hv = h2[rr * 64 + ch * 16 + i];
#pragma unroll
                for (int q = 0; q < 8; ++q) acc[rr][q] += hv * w[q];
            }
        }
        __syncthreads();
    }
    bf16_t* kf = (bf16_t*)(p.ws + (type ? OFF_KERNC + (size_t)l * 2 * 256 * 256 * 2 : OFF_KERNL + (size_t)l * 2 * 256 * 2048 * 2));
    const float lo = logf(1e-2f) / 1.5f, hi = logf(1e-2f) / 0.3f;
#pragma unroll
    for (int q = 0; q < 8; ++q) {
        const int qh = q >> 2, c = (q & 3) * 64 + lane;
        const float delta = fabsf(lo + (float)c * ((hi - lo) / 255.f));
        float v[8];
#pragma unroll
        for (int rr = 0; rr < 8; ++rr) { const float tt = (float)(t0 + rr) * rn1; v[rr] = acc[rr][q] * __expf(-tt * delta); }
        if (qh == 0 && t0 == 0) v[0] += p.hy_skip[l * 256 + c];
        *(u32x4*)(kf + ((size_t)qh * 256 + c) * n + t0) = (u32x4){pk2(v[0], v[1]), pk2(v[2], v[3]), pk2(v[4], v[5]), pk2(v[6], v[7])};
    }
}
struct ConvDesc { const float* src; bf16_t* dst; int ldsrc, k0, n0, lddst, mapkind; };
DEV void conv_load(const ConvDesc& d, f32x4 (&v)[4], int tid) {
    const int r = tid >> 4, c4 = (tid & 15) * 4;
#pragma unroll
    for (int i = 0; i < 4; ++i) v[i] = *(const f32x4*)(d.src + (size_t)(d.k0 + r + 16 * i) * d.ldsrc + d.n0 + c4);
}
DEV void conv_store(const ConvDesc& d, const f32x4 (&v)[4], char* lds, int tid) {
    float* tl = (float*)lds;
    {
        const int r = tid >> 4, c4 = (tid & 15) * 4;
#pragma unroll
        for (int i = 0; i < 4; ++i) { const int row = r + 16 * i; tl[row * 65 + c4 + 0] = v[i][0]; tl[row * 65 + c4 + 1] = v[i][1]; tl[row * 65 + c4 + 2] = v[i][2]; tl[row * 65 + c4 + 3] = v[i][3]; }
    }
    __syncthreads();
    {
        const int n = tid >> 2, kc = tid & 3, ng = d.n0 + n;
        int drow = ng;
        if (d.mapkind == 1) drow = 32 * (ng >> 4) + (ng & 15);
        else if (d.mapkind == 2) drow = 32 * (ng >> 4) + 16 + (ng & 15);
        else if (d.mapkind == 3) drow = (ng >> 7) * 256 + 32 * ((ng & 127) >> 4) + (ng & 15);
        else if (d.mapkind == 4) drow = (ng >> 7) * 256 + 32 * ((ng & 127) >> 4) + 16 + (ng & 15);
        else if (d.mapkind == 5) drow = (ng & ~31) + 16 * ((ng >> 2) & 1) + 4 * ((ng >> 3) & 3) + (ng & 3);
        else if (d.mapkind == 7) {
            const int nn = ng >> 8, rem = ng & 255;
            drow = (rem >> 5) * 128 + ((rem >> 4) & 1) * 64 + nn * 16 + 4 * ((rem >> 2) & 3) + (rem & 3);
        }
        unsigned w[8];
#pragma unroll
        for (int j = 0; j < 8; ++j) w[j] = pk2(tl[(kc * 16 + 2 * j) * 65 + n], tl[(kc * 16 + 2 * j + 1) * 65 + n]);
        u32x4* o = (u32x4*)(d.dst + (size_t)drow * d.lddst + d.k0 + kc * 16);
        o[0] = (u32x4){w[0], w[1], w[2], w[3]};
        o[1] = (u32x4){w[4], w[5], w[6], w[7]};
    }
    __syncthreads();
}
DEV ConvDesc conv_fixed_desc(const Params& p, int it) {
    const int l = it / 1040; int r = it % 1040;
    unsigned char* ws = p.ws;
    if (r < 576) return ConvDesc{p.w_in + (size_t)l * 1024 * PROJ, (bf16_t*)(ws + OFF_WIN) + (size_t)l * PROJ * 1024, PROJ, (r / 36) * 64, (r % 36) * 64, 1024, (r % 36) * 64 < 1536 ? 5 : 0};
    r -= 576;
    if (r < 256) return ConvDesc{p.w_out + (size_t)l * 1024 * 1024, (bf16_t*)(ws + OFF_WOUT) + (size_t)l * 1024 * 1024, 1024, (r / 16) * 64, (r % 16) * 64, 1024, 5};
    r -= 256;
    if (r < 64) return ConvDesc{p.sh_w1 + (size_t)l * 1024 * 256, (bf16_t*)(ws + OFF_SW13) + (size_t)l * 512 * 1024, 256, (r / 4) * 64, (r % 4) * 64, 1024, 3};
    r -= 64;
    if (r < 64) return ConvDesc{p.sh_w3 + (size_t)l * 1024 * 256, (bf16_t*)(ws + OFF_SW13) + (size_t)l * 512 * 1024, 256, (r / 4) * 64, (r % 4) * 64, 1024, 4};
    r -= 64;
    if (r < 64) { const int kt = r / 16, hh = kt >> 1;
        return ConvDesc{p.sh_w2 + (size_t)l * 256 * 1024, (bf16_t*)(ws + OFF_SW2) + (size_t)(l * 2 + hh) * 1024 * 128 - hh * 128, 1024, kt * 64, (r % 16) * 64, 128, 7}; }
    r -= 64;
    return ConvDesc{p.router_w + (size_t)l * 1024 * 64, (bf16_t*)(ws + OFF_RW) + (size_t)l * 64 * 1024, 64, r * 64, 0, 1024, 0};
}
DEV ConvDesc conv_expert_desc(const Params& p, int l, int it) {
    const int e = it / 96; int r = it % 96;
    unsigned char* ws = p.ws;
    const size_t eo = (size_t)(l * 64 + e) * 1024 * 128;
    if (r < 32) return ConvDesc{p.exp_w1 + eo, (bf16_t*)(ws + OFF_W13) + (size_t)e * 256 * 1024, 128, (r / 2) * 64, (r % 2) * 64, 1024, 1};
    r -= 32;
    if (r < 32) return ConvDesc{p.exp_w3 + eo, (bf16_t*)(ws + OFF_W13) + (size_t)e * 256 * 1024, 128, (r / 2) * 64, (r % 2) * 64, 1024, 2};
    r -= 32;
    return ConvDesc{p.exp_w2 + eo, (bf16_t*)(ws + OFF_W2) + (size_t)e * 1024 * 128, 1024, (r / 16) * 64, (r % 16) * 64, 128, 7};
}
DEV void conv_run(const Params& p, int l, int first, int count, char* lds) {
    const int tid = get_tid();
    if (count <= 0) return;
    ConvDesc d = l < 0 ? conv_fixed_desc(p, first) : conv_expert_desc(p, l, first);
    f32x4 v[4]; conv_load(d, v, tid);
#pragma unroll 1
    for (int i = 0; i < count; ++i) {
        ConvDesc dn = d; f32x4 vn[4];
        if (i + 1 < count) { dn = l < 0 ? conv_fixed_desc(p, first + i + 1) : conv_expert_desc(p, l, first + i + 1); conv_load(dn, vn, tid); }
        else {
#pragma unroll
            for (int k = 0; k < 4; ++k) vn[k] = v[k];
        }
        conv_store(d, v, lds, tid);
        d = dn;
#pragma unroll
        for (int k = 0; k < 4; ++k) v[k] = vn[k];
    }
}
DEV void phase_prep(const Params& p, char* lds) {
    { const int t_ = get_tid(); if (blockIdx.x == 0 && t_ < 128) ((int*)(p.ws + OFF_CNT))[t_ * 64] = 0; }
    constexpr int N0 = 144, N1 = N0 + 192, N2 = N1 + 260, N3 = N2 + 0, N4 = N3 + 256;
    int* qhead = (int*)(p.ws + OFF_QUEUE) + 2 * 64;
    int* qslot = (int*)(lds + SMEM_BYTES - 256);
    for (bool first = true;; first = false) {
        __syncthreads();
        if (get_tid() == 0) *qslot = first ? (int)blockIdx.x : atomicAdd(qhead, 1) + (int)gridDim.x;
        __syncthreads();
        const int it = *qslot;
        if (it >= N4) break;
        if (it < N0) prep_filter_item(p, it, lds);
        else if (it < N1) prep_mod_item(p, it - N0, lds);
        else if (it < N2) conv_run(p, -1, (it - N1) * 8, 8, lds);
        else if (it < N3) conv_run(p, 0, (it - N2) * 8, 8, lds);
        else prep_rope_item(p, it - N3);
    }
}
DEV void phase_modfin(const Params& p) {
    const float* part = (const float*)(p.ws + OFF_PART);
    float* mod = (float*)(p.ws + OFF_MOD);
    for (int idx = blockIdx.x * 256 + get_tid(); idx < 2 * 9 * 6144; idx += gridDim.x * 256) {
        const int l = idx / (9 * 6144), g = (idx / 6144) % 9, col = idx % 6144;
        float s = p.ada_b[l * 6144 + col];
        for (int k = 0; k < 32; ++k) s += part[((size_t)(k * 2 + l) * 9 + g) * 6144 + col];
        mod[idx] = s;
    }
}

DEV void row_load(const float* src, f32x4 (&v)[4], int lane) {
#pragma unroll
    for (int j = 0; j < 4; ++j) v[j] = *(const f32x4*)(src + 4 * lane + 256 * j);
}
DEV f32x4 ld_bf4(const bf16_t* p) { const u32x2 w = *(const u32x2*)p; return (f32x4){__uint_as_float(w[0] << 16), __uint_as_float(w[0] & 0xffff0000u), __uint_as_float(w[1] << 16), __uint_as_float(w[1] & 0xffff0000u)}; }
DEV void st_bf4(bf16_t* p, const f32x4& v) { *(u32x2*)p = (u32x2){pk2(v[0], v[1]), pk2(v[2], v[3])}; }
DEV void row_load_bf(const bf16_t* src, f32x4 (&v)[4], int lane) {
#pragma unroll
    for (int j = 0; j < 4; ++j) v[j] = ld_bf4(src + 4 * lane + 256 * j);
}
DEV void row_norm(f32x4 (&v)[4]) {
    float s = 0.f;
#pragma unroll
    for (int j = 0; j < 4; ++j) s += (v[j][0] + v[j][1]) + (v[j][2] + v[j][3]);
    const float mean = wave_sum(s) * (1.f / 1024.f);
    float q = 0.f;
#pragma unroll
    for (int j = 0; j < 4; ++j) { v[j] = v[j] - mean; q += (v[j][0] * v[j][0] + v[j][1] * v[j][1]) + (v[j][2] * v[j][2] + v[j][3] * v[j][3]); }
    const float rstd = __builtin_amdgcn_rsqf(wave_sum(q) * (1.f / 1024.f) + 1e-6f);
#pragma unroll
    for (int j = 0; j < 4; ++j) v[j] = v[j] * rstd;
}
DEV void row_store_mod_bf16(bf16_t* dst, const f32x4 (&v)[4], const float* shift, const float* scale, int lane) {
#pragma unroll
    for (int j = 0; j < 4; ++j) {
        const int c = 4 * lane + 256 * j;
        const f32x4 sh = *(const f32x4*)(shift + c), sc = *(const f32x4*)(scale + c);
        const f32x4 o = v[j] * (sc + 1.0f) + sh;
        *(u32x2*)(dst + c) = (u32x2){pk2(o[0], o[1]), pk2(o[2], o[3])};
    }
}
DEV void phase_lnmod0(const Params& p) {
    const int tid_ = get_tid(), lane = tid_ & 63, wid = tid_ >> 6;
    const float* mod = (const float*)(p.ws + OFF_MOD);
    bf16_t* H = (bf16_t*)(p.ws + OFF_H);
    for (int row = blockIdx.x * 4 + wid; row < NT; row += gridDim.x * 4) {
        const float* src = row < NLAT ? p.x + (size_t)row * 1024 : p.ctx + (size_t)(row - NLAT) * 1024;
        f32x4 v[4]; row_load(src, v, lane);
        const float* m = mod + (size_t)mod_group(row) * 6144;
        f32x4 sh[4], sc[4];
#pragma unroll
        for (int j = 0; j < 4; ++j) { const int c = 4 * lane + 256 * j; sh[j] = *(const f32x4*)(m + c); sc[j] = *(const f32x4*)(m + 1024 + c); }
        row_norm(v);
#pragma unroll
        for (int j = 0; j < 4; ++j) {
            const int c = 4 * lane + 256 * j;
            const f32x4 o = v[j] * (sc[j] + 1.0f) + sh[j];
            *(u32x2*)(H + (size_t)row * 1024 + c) = (u32x2){pk2(o[0], o[1]), pk2(o[2], o[3])};
        }
    }
}

DEV int conv_slots_in(int l, int G) { const int lo = l == 0 ? 32 : 352; int c = (G < 512 ? G : 512) - lo; c = c < 0 ? 0 : c; return c > 768 ? 768 : c; }
DEV int conv_slots_out(int l, int G) { if (l != 0) return 0; int c = G - 128; c = c < 0 ? 0 : (c > 288 ? 288 : c); const int left = 768 - conv_slots_in(0, G); return c > left ? left : c; }
DEV void phase_inproj(const Params& p, int l, char* lds) {
    const int tid = get_tid(), lane = tid & 63, wid = tid >> 6, fr = lane & 15, fq = lane >> 4, wr = wid >> 1, wc = wid & 1;
    unsigned char* ws = p.ws;
    const bf16_t* H = (const bf16_t*)(ws + OFF_H);
    const bf16_t* W = (const bf16_t*)(ws + OFF_WIN) + (size_t)l * PROJ * 1024;
    const float* ropec = (const float*)(ws + OFF_ROPE); const float* ropes = ropec + 2048 * 32;
    const int nitems = 128 * 18 + 16 * (l == 0 ? 18 : 6);
    const int vb = vblock();
    for (int it = vb; it < nitems; it += gridDim.x) {
        int mt, nt;
        if (it < 2304) { mt = it / 18; nt = it % 18; }
        else { const int j = it - 2304; if (l == 0) { mt = 128 + j / 18; nt = j % 18; } else { mt = 128 + j / 6; const int q = j % 6; nt = q < 2 ? 4 + q : 6 + q; } }
        const int m0 = mt * 128, n0 = nt * 128;
        const unsigned a0 = (unsigned)m0 * 1024u + st64_off(tid), b0 = (unsigned)n0 * 1024u + st64_off(tid);
        const unsigned ao[4] = {a0, a0 + 32u * 1024u, a0 + 64u * 1024u, a0 + 96u * 1024u};
        const unsigned bo[4] = {b0, b0 + 32u * 1024u, b0 + 64u * 1024u, b0 + 96u * 1024u};
        f32x4 acc[4][4]; zero_acc<4, 4>(acc);
        const bool latent = m0 < NLAT;
        const int b = latent ? (m0 >> 11) : ((m0 - NLAT) >> 8);
        const int tbase = latent ? (m0 & 2047) : ((m0 - NLAT) & 255);
        if (nt >= 12) {
            const int rho = tid >> 3, ptok = 8 * ((rho & 15) >> 2) + 4 * (rho >> 4) + (rho & 3);
            const unsigned ap0 = (unsigned)(m0 + ptok) * 1024u + (unsigned)(((tid & 7) ^ (rho & 7)) * 8);
            const unsigned aop[4] = {ap0, ap0 + 32u * 1024u, ap0 + 64u * 1024u, ap0 + 96u * 1024u};
            gemm_core64<false>(acc, H, aop, W, bo, 1024, lds);
            bf16_t* zt = latent ? (bf16_t*)(ws + OFF_ZTL) + (size_t)b * 768 * 2048 : (bf16_t*)(ws + OFF_ZTC) + (size_t)b * 768 * 256;
            const int n = latent ? 2048 : 256;
#pragma unroll
            for (int g = 0; g < 2; ++g)
#pragma unroll
                for (int nn = 0; nn < 4; ++nn) {
                    const int ch = n0 - 1536 + wc * 64 + nn * 16 + fr, t = tbase + wr * 64 + 32 * g + 8 * fq;
                    *(u32x4*)(zt + (size_t)ch * n + t) = (u32x4){pk2(acc[2 * g][nn][0], acc[2 * g][nn][1]), pk2(acc[2 * g][nn][2], acc[2 * g][nn][3]),
                                                                 pk2(acc[2 * g + 1][nn][0], acc[2 * g + 1][nn][1]), pk2(acc[2 * g + 1][nn][2], acc[2 * g + 1][nn][3])};
                }
        } else {
            gemm_core64<true>(acc, H, ao, W, bo, 1024, lds);
            const int col0 = n0 + wc * 64;
            int kind, hh;
            if (col0 < 512) { kind = 0; hh = col0 >> 6; } else if (col0 < 640) { kind = 1; hh = (col0 - 512) >> 6; } else if (col0 < 768) { kind = 2; hh = (col0 - 640) >> 6; }
            else if (col0 < 1024) { kind = 3; hh = (col0 - 768) >> 6; } else if (col0 < 1280) { kind = 4; hh = (col0 - 1024) >> 6; } else { kind = 5; hh = (col0 - 1280) >> 6; }
            const bool normed = (kind == 0 || kind == 1);
            f32x4 gv[4];
            if (normed) {
#pragma unroll
                for (int nn = 0; nn < 4; ++nn) {
                    const int hc = l * 64 + 32 * (nn >> 1) + 8 * fq + 4 * (nn & 1);
                    const f32x4 gq = *(const f32x4*)(p.q_gain + hc), gk = *(const f32x4*)(p.k_gain + hc);
                    gv[nn] = kind == 0 ? gq : gk;
                }
            }
#pragma unroll
            for (int m = 0; m < 4; ++m) {
                const int rloc = wr * 64 + m * 16 + fr, row = m0 + rloc, t = tbase + rloc;
                f32x4 rvm[4];
                if (normed && latent) {
#pragma unroll
                    for (int nn = 0; nn < 4; ++nn) rvm[nn] = *(const f32x4*)(ropec + ((size_t)t * 16 + 8 * (nn >> 1) + 2 * fq + (nn & 1)) * 4);
                }
                f32x4 v[4];
#pragma unroll
                for (int nn = 0; nn < 4; ++nn) v[nn] = acc[m][nn];
                if (normed) {
                    float ss = 0.f;
#pragma unroll
                    for (int nn = 0; nn < 4; ++nn) ss += (v[nn][0] * v[nn][0] + v[nn][1] * v[nn][1]) + (v[nn][2] * v[nn][2] + v[nn][3] * v[nn][3]);
                    ss += __shfl_xor(ss, 16); ss += __shfl_xor(ss, 32);
                    const float r = __builtin_amdgcn_rsqf(ss * (1.f / 64.f) + 1e-6f);
#pragma unroll
                    for (int nn = 0; nn < 4; ++nn) {
                        v[nn] = v[nn] * r * gv[nn];
                        if (latent) {
                            const float c0 = rvm[nn][0], s0 = rvm[nn][1], c1 = rvm[nn][2], s1 = rvm[nn][3];
                            const float x0 = v[nn][0], x1 = v[nn][1], x2 = v[nn][2], x3 = v[nn][3];
                            v[nn][0] = x0 * c0 - x1 * s0; v[nn][1] = x0 * s0 + x1 * c0;
                            v[nn][2] = x2 * c1 - x3 * s1; v[nn][3] = x2 * s1 + x3 * c1;
                        }
                    }
                }
                if (kind == 0 || kind == 3) {
#pragma unroll
                    for (int nn = 0; nn < 4; ++nn) v[nn] = v[nn] * (0.125f * LOG2E);
                }
                bf16_t* dst;
                const int key = latent ? 256 + t : t;
                if (kind == 0) dst = (bf16_t*)(ws + OFF_QA) + ((size_t)hh * NT + row) * 64;
                else if (kind == 3) dst = (bf16_t*)(ws + OFF_QB) + ((size_t)hh * NT + row) * 64;
                else if (kind == 1) dst = (bf16_t*)(ws + OFF_KA) + ((size_t)(b * 2 + hh) * KEYS + key) * 64;
                else if (kind == 2) dst = (bf16_t*)(ws + OFF_VA) + ((size_t)(b * 2 + hh) * KEYS + key) * 64;
                else if (kind == 4) dst = (bf16_t*)(ws + OFF_KB) + ((size_t)(b * 4 + hh) * KEYS + key) * 64;
                else dst = (bf16_t*)(ws + OFF_VB) + ((size_t)(b * 4 + hh) * KEYS + key) * 64;
#pragma unroll
                for (int gg = 0; gg < 2; ++gg) *(u32x4*)(dst + 32 * gg + 8 * fq) = (u32x4){pk2(v[2 * gg][0], v[2 * gg][1]), pk2(v[2 * gg][2], v[2 * gg][3]), pk2(v[2 * gg + 1][0], v[2 * gg + 1][1]), pk2(v[2 * gg + 1][2], v[2 * gg + 1][3])};
                __builtin_amdgcn_sched_barrier(0);
            }
        }
    }
    if (l == 0 && vb >= 32 && vb - 32 < conv_slots_in(0, (int)gridDim.x)) { __syncthreads(); conv_run(p, 0, (vb - 32) * 8, 8, lds); }
    if (l == 1 && vb >= 352 && vb - 352 < conv_slots_in(1, (int)gridDim.x)) { __syncthreads(); conv_run(p, 1, (vb - 352) * 8, 8, lds); }
}

template <int NQT, bool NA>
DEV void attn_block(const bf16_t* Qh, int qrow0, const bf16_t* Kh, const bf16_t* Vh, int ntiles, bf16_t* outp  ,
                    int na_r, int na_rs, int nwin, const float* rpb_h, char* lds) {
    const int tid = get_tid(), lane = tid & 63, wid = tid >> 6, fr = lane & 15, fq = lane >> 4;
    char* KBUF = lds;
    char* VBUF = lds + 16384;
    float* BIAS = (float*)(lds + 32768);
    if (NA) {
        for (int i = tid; i < 15 * 32; i += 256) { const int dr = i >> 5, dc = i & 31; BIAS[i] = dc < 31 ? rpb_h[dr * 31 + dc] * LOG2E : -1e30f; }
    }
    bf16x8 qf[NQT][2];
    const int qw = qrow0 + wid * 16 * NQT;
#pragma unroll
    for (int nq = 0; nq < NQT; ++nq)
#pragma unroll
        for (int ks = 0; ks < 2; ++ks) qf[nq][ks] = *(const bf16x8*)(Qh + (size_t)(qw + nq * 16 + fr) * 64 + ks * 32 + fq * 8);
    f32x4 oacc[4][NQT], lacc[NQT];
    float mrun[NQT];
    const bf16x8 ones = (bf16x8){0x3F80, 0x3F80, 0x3F80, 0x3F80, 0x3F80, 0x3F80, 0x3F80, 0x3F80};
#pragma unroll
    for (int nq = 0; nq < NQT; ++nq) { mrun[nq] = 0.f; lacc[nq] = (f32x4){0.f, 0.f, 0.f, 0.f};
#pragma unroll
        for (int dt = 0; dt < 4; ++dt) oacc[dt][nq] = (f32x4){0.f, 0.f, 0.f, 0.f}; }
    const int lrow0 = tid >> 3, lch = tid & 7;
    auto key0_of = [&](int ti) -> int { if (NA) return ti < nwin ? 256 + (na_rs + ti) * 64 : (ti - nwin) * 64; return ti * 64; };
    u32x4 kreg[2], vreg[2];
    auto gload = [&](int ti) {
        const int k0 = key0_of(ti);
#pragma unroll
        for (int i = 0; i < 2; ++i) {
            const int row = lrow0 + 32 * i;
            kreg[i] = *(const u32x4*)(Kh + (size_t)(k0 + row) * 64 + lch * 8);
            vreg[i] = *(const u32x4*)(Vh + (size_t)(k0 + row) * 64 + lch * 8);
        }
    };
    auto lstore = [&](int buf) {
#pragma unroll
        for (int i = 0; i < 2; ++i) {
            const int row = lrow0 + 32 * i;
            const int off = buf * 8192 + row * 128 + ((lch ^ (row & 7)) * 16);
            *(u32x4*)(KBUF + off) = kreg[i];
            *(u32x4*)(VBUF + off) = vreg[i];
        }
    };
    const int widu = __builtin_amdgcn_readfirstlane(wid);
    unsigned nacol[NQT][4];
    if (NA) {
#pragma unroll
        for (int nq = 0; nq < NQT; ++nq) {
            const int qc = (wid & 1) * 32 + nq * 16 + fr;
            int cs = qc - 8; cs = cs < 0 ? 0 : (cs > 48 ? 48 : cs);
#pragma unroll
            for (int mt = 0; mt < 4; ++mt) {
                unsigned w = 0u;
#pragma unroll
                for (int j = 0; j < 4; ++j) {
                    const int kc = mt * 16 + 4 * fq + j;
                    int dc = kc - qc + 15; dc = dc < 0 ? 0 : (dc > 30 ? 30 : dc);
                    w |= (unsigned)((kc >= cs && kc < cs + 16) ? dc : 31) << (8 * j);
                }
                nacol[nq][mt] = w;
            }
        }
    }
    gload(0); lstore(0);
    __syncthreads();
    for (int ti = 0; ti < ntiles; ++ti) {
        const int buf = ti & 1;
        if (ti + 1 < ntiles) gload(ti + 1);
        const char* kb = KBUF + buf * 8192; const char* vb = VBUF + buf * 8192;
        f32x4 sacc[4][NQT];
        __builtin_amdgcn_s_setprio(1);
#pragma unroll
        for (int mt = 0; mt < 4; ++mt) {
            const int row = mt * 16 + fr;
            bf16x8 kf0 = *(const bf16x8*)(kb + row * 128 + (((0 + fq) ^ (row & 7)) * 16));
            bf16x8 kf1 = *(const bf16x8*)(kb + row * 128 + (((4 + fq) ^ (row & 7)) * 16));
#pragma unroll
            for (int nq = 0; nq < NQT; ++nq) {
                f32x4 s = (f32x4){-mrun[nq], -mrun[nq], -mrun[nq], -mrun[nq]};
                s = mfma16(kf0, qf[nq][0], s);
                s = mfma16(kf1, qf[nq][1], s);
                sacc[mt][nq] = s;
            }
        }
        __builtin_amdgcn_s_setprio(0);
        bf16x8 pf[2][NQT];
#pragma unroll
        for (int nq = 0; nq < NQT; ++nq) {
            float tv[4][4];
            float tmax = -1e30f;
            if (NA && ti < nwin) {
                const int qrow = na_r + (widu >> 1);
                int rsq = qrow - 4; rsq = rsq < 0 ? 0 : (rsq > 24 ? 24 : rsq);
                const int krow = na_rs + ti;
                const bool rowok = (krow >= rsq) && (krow < rsq + 8);
                int dr = krow - qrow + 7; dr = dr < 0 ? 0 : (dr > 14 ? 14 : dr);
                if (rowok) {
                    const float* brow = BIAS + dr * 32;
#pragma unroll
                    for (int mt = 0; mt < 4; ++mt)
#pragma unroll
                        for (int j = 0; j < 4; ++j) { tv[mt][j] = sacc[mt][nq][j] + brow[(nacol[nq][mt] >> (8 * j)) & 31]; tmax = fmaxf(tmax, tv[mt][j]); }
                } else {
#pragma unroll
                    for (int mt = 0; mt < 4; ++mt)
#pragma unroll
                        for (int j = 0; j < 4; ++j) tv[mt][j] = -1e30f;
                }
            } else {
#pragma unroll
                for (int mt = 0; mt < 4; ++mt) {
#pragma unroll
                    for (int j = 0; j < 4; ++j) tv[mt][j] = sacc[mt][nq][j];
                    tmax = fmaxf(fmaxf(tmax, tv[mt][0]), tv[mt][1]); tmax = fmaxf(fmaxf(tmax, tv[mt][2]), tv[mt][3]);
                }
            }
            if (__any(tmax > 8.0f)) {
                tmax = fmaxf(tmax, __shfl_xor(tmax, 16)); tmax = fmaxf(tmax, __shfl_xor(tmax, 32));
                const float dlt = fmaxf(tmax, 0.f);
                const float alpha = __builtin_amdgcn_exp2f(-dlt);
                mrun[nq] += dlt;
                lacc[nq] = lacc[nq] * alpha;
#pragma unroll
                for (int dt = 0; dt < 4; ++dt) oacc[dt][nq] = oacc[dt][nq] * alpha;
#pragma unroll
                for (int mt = 0; mt < 4; ++mt)
#pragma unroll
                    for (int j = 0; j < 4; ++j) tv[mt][j] -= dlt;
            }
#pragma unroll
            for (int mt = 0; mt < 4; ++mt)
#pragma unroll
                for (int j = 0; j < 4; ++j) tv[mt][j] = __builtin_amdgcn_exp2f(tv[mt][j]);
#pragma unroll
            for (int ks = 0; ks < 2; ++ks) {
                union { bf16x8 v; unsigned u[4]; } pk;
                pk.u[0] = pk2(tv[2 * ks][0], tv[2 * ks][1]); pk.u[1] = pk2(tv[2 * ks][2], tv[2 * ks][3]);
                pk.u[2] = pk2(tv[2 * ks + 1][0], tv[2 * ks + 1][1]); pk.u[3] = pk2(tv[2 * ks + 1][2], tv[2 * ks + 1][3]);
                pf[ks][nq] = pk.v;
                lacc[nq] = mfma16(ones, pk.v, lacc[nq]);
            }
        }
        {
            const int q4 = fr >> 2, p4 = fr & 3;
#pragma unroll
            for (int ks = 0; ks < 2; ++ks)
#pragma unroll
                for (int dt = 0; dt < 4; ++dt) {
                    const int keyA = 16 * (2 * ks) + 4 * fq + q4, keyB = keyA + 16;
                    const int ch = 4 * (dt >> 1) + p4;
                    const int offA = keyA * 128 + ((ch ^ (keyA & 7)) * 16) + (dt & 1) * 8;
                    const int offB = keyB * 128 + ((ch ^ (keyB & 7)) * 16) + (dt & 1) * 8;
                    const s16x4 ta = __builtin_amdgcn_ds_read_tr16_b64_v4i16((LDSP(s16x4))(vb + offA));
                    const s16x4 tb = __builtin_amdgcn_ds_read_tr16_b64_v4i16((LDSP(s16x4))(vb + offB));
                    bf16x8 vf; vf[0] = ta[0]; vf[1] = ta[1]; vf[2] = ta[2]; vf[3] = ta[3]; vf[4] = tb[0]; vf[5] = tb[1]; vf[6] = tb[2]; vf[7] = tb[3];
#pragma unroll
                    for (int nq = 0; nq < NQT; ++nq) oacc[dt][nq] = mfma16(vf, pf[ks][nq], oacc[dt][nq]);
                }
        }
        if (ti + 1 < ntiles) lstore(buf ^ 1);
        __syncthreads();
    }
#pragma unroll
    for (int nq = 0; nq < NQT; ++nq) {
        const float inv = __builtin_amdgcn_rcpf(lacc[nq][0]);
        bf16_t* o = outp + (size_t)(qw + nq * 16 + fr) * 1024;
#pragma unroll
        for (int g = 0; g < 2; ++g) {
            const f32x4 v0 = oacc[2 * g][nq] * inv, v1 = oacc[2 * g + 1][nq] * inv;
            *(u32x4*)(o + g * 32 + 8 * fq) = (u32x4){pk2(v0[0], v0[1]), pk2(v0[2], v0[3]), pk2(v1[0], v1[1]), pk2(v1[2], v1[3])};
        }
    }
    __syncthreads();
}

DEV float hy_sconv(const bf16_t* zrow, int t, int n, float w0, float w1, float w2, float bias) {
    const float zm = t > 0 ? bf2f(zrow[t - 1]) : 0.f, z0 = bf2f(zrow[t]), zp = t + 1 < n ? bf2f(zrow[t + 1]) : 0.f;
    return w0 * zm + w1 * z0 + w2 * zp + bias;
}
template <int NJ>
DEV void hyena_item(const Params& p, int l, int type, int c, int bh, char* lds) {
    constexpr int n = 256 * NJ;
    const int tid = get_tid();
    f32x4* U = (f32x4*)lds;
    float* KR = (float*)(lds + n * 16);
    const bf16_t* zt = type ? (const bf16_t*)(p.ws + OFF_ZTC) : (const bf16_t*)(p.ws + OFF_ZTL);
    const bf16_t* kf = (const bf16_t*)(p.ws + (type ? OFF_KERNC + (size_t)l * 2 * 256 * 256 * 2 : OFF_KERNL + (size_t)l * 2 * 256 * 2048 * 2)) + (size_t)c * n;
    const bf16_t* kb = kf + (size_t)256 * n;
    const float* cw = p.hy_conv_w + l * 3 * 768; const float* cb = p.hy_conv_b + l * 768;
    const float w10 = cw[256 + c], w11 = cw[768 + 256 + c], w12 = cw[1536 + 256 + c], b1 = cb[256 + c];
    const float wv0 = cw[512 + c], wv1 = cw[768 + 512 + c], wv2 = cw[1536 + 512 + c], bv = cb[512 + c];
    const float w00 = cw[c], w01 = cw[768 + c], w02 = cw[1536 + c], b0 = cb[c];
    for (int i = tid; i < 2 * n - 1; i += 256) { const int d = i - (n - 1); KR[i] = bf2f(d >= 0 ? kf[d] : kb[-d]); }
    for (int s = tid; s < n; s += 256) {
        f32x4 u;
#pragma unroll
        for (int bb = 0; bb < 4; ++bb) {
            const bf16_t* zb = zt + (size_t)(bh * 4 + bb) * 768 * n;
            const float x1 = hy_sconv(zb + (size_t)(256 + c) * n, s, n, w10, w11, w12, b1);
            const float vv = hy_sconv(zb + (size_t)(512 + c) * n, s, n, wv0, wv1, wv2, bv);
            u[bb] = vv * x1;
        }
        U[s] = u;
    }
    __syncthreads();
    f32x4 acc[NJ];
#pragma unroll
    for (int j = 0; j < NJ; ++j) acc[j] = (f32x4){0.f, 0.f, 0.f, 0.f};
    const float* kp = KR + tid + (n - 1);
    for (int s = 0; s < n; ++s) {
        const f32x4 u = U[s];
#pragma unroll
        for (int j = 0; j < NJ; ++j) acc[j] += u * kp[256 * j - s];
    }
    bf16_t* ox = (bf16_t*)(p.ws + OFF_OX);
#pragma unroll
    for (int j = 0; j < NJ; ++j) {
        const int t = tid + 256 * j;
#pragma unroll
        for (int bb = 0; bb < 4; ++bb) {
            const int b = bh * 4 + bb;
            const bf16_t* zb = zt + (size_t)b * 768 * n;
            const float x0 = hy_sconv(zb + (size_t)c * n, t, n, w00, w01, w02, b0);
            const float y = acc[j][bb] * x0;
            const int row = type ? NLAT + b * 256 + t : b * 2048 + t;
            ox[(size_t)row * 1024 + 768 + c] = (bf16_t)f2bf(y);
        }
    }
    __syncthreads();
}


typedef float f32x16 __attribute__((ext_vector_type(16)));
constexpr int HY_UROW = 2264;
constexpr int HY_KC_OFF = 8 * HY_UROW * 2;
constexpr int HY_KC_STRIDE = 8192 + 64;
DEV float hy_sc8(const bf16_t* zrow, int s0, int n, float w0, float w1, float w2, float bias, float (&o)[8]) {
    const u32x4 v = *(const u32x4*)(zrow + s0);
    const int ln = (int)(threadIdx.x & 63);
    unsigned hm = (unsigned)__shfl_up((int)(v[3] >> 16), 1), hp = (unsigned)__shfl_down((int)(v[0] & 0xffffu), 1);
    if (ln == 0) hm = s0 > 0 ? (unsigned)zrow[s0 - 1] : 0x10000u;
    if (ln == 63) hp = s0 + 8 < n ? (unsigned)zrow[s0 + 8] : 0x10000u;
    const float zm = (hm & 0x10000u) ? 0.f : bf2f((unsigned short)hm), zp = (hp & 0x10000u) ? 0.f : bf2f((unsigned short)hp);
    float z[10]; z[0] = zm; z[9] = zp;
#pragma unroll
    for (int i = 0; i < 4; ++i) { z[1 + 2 * i] = __uint_as_float(v[i] << 16); z[2 + 2 * i] = __uint_as_float(v[i] & 0xffff0000u); }
#pragma unroll
    for (int i = 0; i < 8; ++i) o[i] = w0 * z[i] + w1 * z[i + 1] + w2 * z[i + 2] + bias;
    return 0.f;
}
DEV void hyena_mfma_item(const Params& p, int l, int c, char* lds) {
    const int tid = get_tid(), lane = tid & 63, wid = tid >> 6;
    constexpr int n = 2048;
    const bf16_t* zt = (const bf16_t*)(p.ws + OFF_ZTL);
    const bf16_t* kf = (const bf16_t*)(p.ws + OFF_KERNL + (size_t)l * 2 * 256 * 2048 * 2) + (size_t)c * n;
    const bf16_t* kb = kf + (size_t)256 * n;
    const float* cw = p.hy_conv_w + l * 3 * 768; const float* cb = p.hy_conv_b + l * 768;
    const float w10 = cw[256 + c], w11 = cw[768 + 256 + c], w12 = cw[1536 + 256 + c], b1 = cb[256 + c];
    const float wv0 = cw[512 + c], wv1 = cw[768 + 512 + c], wv2 = cw[1536 + 512 + c], bv = cb[512 + c];
    const float w00 = cw[c], w01 = cw[768 + c], w02 = cw[1536 + c], b0 = cb[c];
    for (int i = tid; i < 8 * 27; i += 256) {
        const int b = i / 27, k = i % 27;
        const int sp = k < 12 ? k * 8 : 96 + 2048 + (k - 12) * 8;
        *(u32x4*)(lds + (b * HY_UROW + sp) * 2) = (u32x4){0u, 0u, 0u, 0u};
    }
#pragma unroll 4
    for (int ch = tid; ch < 8 * 256; ch += 256) {
        const int b = ch >> 8, s0 = (ch & 255) * 8;
        const bf16_t* zb = zt + (size_t)b * 768 * n;
        float x1[8], vv[8];
        hy_sc8(zb + (size_t)(256 + c) * n, s0, n, w10, w11, w12, b1, x1);
        hy_sc8(zb + (size_t)(512 + c) * n, s0, n, wv0, wv1, wv2, bv, vv);
        *(u32x4*)(lds + (b * HY_UROW + 96 + s0) * 2) = (u32x4){pk2(vv[0] * x1[0], vv[1] * x1[1]), pk2(vv[2] * x1[2], vv[3] * x1[3]), pk2(vv[4] * x1[4], vv[5] * x1[5]), pk2(vv[6] * x1[6], vv[7] * x1[7])};
    }
    {
        char* R0 = lds + HY_KC_OFF;
#pragma unroll
        for (int j = 0; j < 2; ++j) {
            const int chn = tid + 256 * j;
            const bool fwd = chn < 256; const int d0 = (chn & 255) * 8;
            const u32x4 v = *(const u32x4*)((fwd ? kf : kb) + d0);
#pragma unroll
            for (int e = 0; e < 8; ++e) {
                const int d = d0 + e;
                const bf16_t val = (bf16_t)((e & 1) ? (v[e >> 1] >> 16) : (v[e >> 1] & 0xffffu));
                const int y = fwd ? 2047 - d : 2047 + d;
                if (fwd || d > 0) *(bf16_t*)(R0 + y * 2) = val;
            }
        }
        if (tid == 0) *(bf16_t*)(R0 + 4095 * 2) = 0;
    }
    __syncthreads();
    {
        const char* R0 = lds + HY_KC_OFF;
        for (int i = tid; i < 3 * 1024; i += 256) {
            const int q = 1 + i / 1024, y = (i % 1024) * 4;
            unsigned short e[4];
#pragma unroll
            for (int k = 0; k < 4; ++k) { const int yy = y + q + k; e[k] = yy <= 4094 ? *(const bf16_t*)(R0 + yy * 2) : (bf16_t)0; }
            *(u32x2*)(lds + HY_KC_OFF + q * HY_KC_STRIDE + y * 2) = (u32x2){(unsigned)e[0] | ((unsigned)e[1] << 16), (unsigned)e[2] | ((unsigned)e[3] << 16)};
        }
    }
    __syncthreads();
    const int i32 = lane & 31, h = lane >> 5, qn = i32 & 3, bn = i32 >> 2;
    const int T0 = 512 * __builtin_amdgcn_readfirstlane(wid);
    f32x16 acc[4];
#pragma unroll
    for (int g = 0; g < 4; ++g)
#pragma unroll
        for (int r = 0; r < 16; ++r) acc[g][r] = 0.f;
    const int dlo = T0 - 2032, dhi = T0 + 384 + 96;
    {
        const int a0 = 2047 - dlo - i32 + 8 * h, q4 = a0 & 3;
        const char* ap = lds + HY_KC_OFF + q4 * HY_KC_STRIDE + (a0 - q4) * 2;
        const char* bp = lds + (bn * HY_UROW + 96 + (T0 - dlo) + 32 * qn + 8 * h) * 2;
        union AF { bf16x8 v; u32x2 u[2]; };
        auto ldstep = [&](int dl, const char* ap_, const char* bp_, AF& a_, bf16x8 (&b_)[4]) {
            a_.u[0] = *(const u32x2*)ap_; a_.u[1] = *(const u32x2*)(ap_ + 8);
#pragma unroll
            for (int g = 0; g < 4; ++g) {
                const int S = T0 + 128 * g - dl;
                const char* q_ = (S >= -96 && S <= 2032) ? bp_ + 256 * g : lds;
                b_[g] = *(const bf16x8*)q_;
            }
        };
        AF a0_, a1_; bf16x8 b0_[4], b1_[4];
        ldstep(dlo, ap, bp, a0_, b0_);
        __builtin_amdgcn_s_setprio(1);
#pragma unroll 1
        for (int dl = dlo; dl <= dhi; dl += 32) {
            ldstep(dl + 16, ap - 32, bp - 32, a1_, b1_);
#pragma unroll
            for (int g = 0; g < 4; ++g) acc[g] = __builtin_amdgcn_mfma_f32_32x32x16_bf16(a0_.v, b0_[g], acc[g], 0, 0, 0);
            ap -= 64; bp -= 64;
            const bool more = dl + 32 <= dhi;
            ldstep(more ? dl + 32 : dl, more ? ap : ap + 64, more ? bp : bp + 64, a0_, b0_);
#pragma unroll
            for (int g = 0; g < 4; ++g) acc[g] = __builtin_amdgcn_mfma_f32_32x32x16_bf16(a1_.v, b1_[g], acc[g], 0, 0, 0);
        }
        __builtin_amdgcn_s_setprio(0);
    }
    __syncthreads();
#pragma unroll 4
    for (int ch = tid; ch < 8 * 256; ch += 256) {
        const int b = ch >> 8, s0 = (ch & 255) * 8;
        float x0[8];
        hy_sc8(zt + (size_t)b * 768 * n + (size_t)c * n, s0, n, w00, w01, w02, b0, x0);
        *(u32x4*)(lds + HY_KC_OFF + (b * 2048 + s0) * 2) = (u32x4){pk2(x0[0], x0[1]), pk2(x0[2], x0[3]), pk2(x0[4], x0[5]), pk2(x0[6], x0[7])};
    }
    __syncthreads();
    bf16_t* oxt = (bf16_t*)(p.ws + OFF_OXT) + (size_t)c * 2048;
#pragma unroll
    for (int g = 0; g < 4; ++g)
#pragma unroll
        for (int r4 = 0; r4 < 4; ++r4) {
            const int t = T0 + 128 * g + 32 * qn + 8 * r4 + 4 * h;
            const u32x2 xg = *(const u32x2*)(lds + HY_KC_OFF + (bn * 2048 + t) * 2);
            const float g0 = __uint_as_float(xg[0] << 16), g1 = __uint_as_float(xg[0] & 0xffff0000u), g2 = __uint_as_float(xg[1] << 16), g3 = __uint_as_float(xg[1] & 0xffff0000u);
            *(u32x2*)(oxt + (size_t)bn * 256 * 2048 + t) = (u32x2){pk2(acc[g][4 * r4 + 0] * g0, acc[g][4 * r4 + 1] * g1), pk2(acc[g][4 * r4 + 2] * g2, acc[g][4 * r4 + 3] * g3)};
        }
    __syncthreads();
}

DEV void phase_mix(const Params& p, int l, char* lds) {
    unsigned char* ws = p.ws;
    const bf16_t* QA = (const bf16_t*)(ws + OFF_QA); const bf16_t* QB = (const bf16_t*)(ws + OFF_QB);
    const bf16_t* KA = (const bf16_t*)(ws + OFF_KA); const bf16_t* VA = (const bf16_t*)(ws + OFF_VA);
    const bf16_t* KBp = (const bf16_t*)(ws + OFF_KB); const bf16_t* VBp = (const bf16_t*)(ws + OFF_VB);
    bf16_t* OX = (bf16_t*)(ws + OFF_OX);
    const int N0 = 256, N1 = N0 + 1024, N2 = N1 + 512;
    const int N3 = N2 + (l == 0 ? 512 : 0), N4 = N3 + (l == 0 ? 128 : 0), N5 = N4 + (l == 0 ? 64 : 0);
    const int cdone = conv_slots_in(l, (int)gridDim.x) + conv_slots_out(l, (int)gridDim.x);
    const int N6 = N5 + (768 - cdone);
    int* qhead = (int*)(p.ws + OFF_QUEUE) + l * 64;
    int* qslot = (int*)(lds + SMEM_BYTES - 256);
    for (bool first = true;; first = false) {
        __syncthreads();
        if (get_tid() == 0) *qslot = first ? (int)blockIdx.x : atomicAdd(qhead, 1) + (int)gridDim.x;
        __syncthreads();
        const int it = *qslot;
        if (it >= N6) break;
        if (it >= N5) { conv_run(p, l, (cdone + it - N5) * 8, 8, lds); continue; }
        if (it < N0) { hyena_mfma_item(p, l, it, lds); }
        else if (it < N1) {
            const int j = it - N0, b = j >> 7, h = (j >> 4) & 7, qb = j & 15;
            attn_block<2, false>(QA + (size_t)h * NT * 64, b * 2048 + qb * 128, KA + (size_t)(b * 2 + (h >> 2)) * KEYS * 64, VA + (size_t)(b * 2 + (h >> 2)) * KEYS * 64,
                                 36, OX + h * 64, 0, 0, 0, nullptr, lds);
        } else if (it < N2) {
            const int j = it - N1, b = j >> 6, h = (j >> 4) & 3, r = (j & 15) * 2;
            int rs0 = r - 4; rs0 = rs0 < 0 ? 0 : (rs0 > 24 ? 24 : rs0);
            int rs1 = r - 3; rs1 = rs1 < 0 ? 0 : (rs1 > 24 ? 24 : rs1);
            const int nwin = rs1 + 8 - rs0;
            attn_block<2, true>(QB + (size_t)h * NT * 64, b * 2048 + r * 64, KBp + (size_t)(b * 4 + h) * KEYS * 64, VBp + (size_t)(b * 4 + h) * KEYS * 64,
                                nwin + 4, OX + 512 + h * 64, r, rs0, nwin, p.nat_rpb + (size_t)(l * 4 + h) * 15 * 31, lds);
        } else if (it < N3) { const int j = it - N2; hyena_item<1>(p, l, 1, j >> 1, j & 1, lds); }
        else if (it < N4) {
            const int j = it - N3, b = j >> 4, h = (j >> 1) & 7, qb = j & 1;
            attn_block<2, false>(QA + (size_t)h * NT * 64, NLAT + b * 256 + qb * 128, KA + (size_t)(b * 2 + (h >> 2)) * KEYS * 64, VA + (size_t)(b * 2 + (h >> 2)) * KEYS * 64,
                                 4, OX + h * 64, 0, 0, 0, nullptr, lds);
        } else {
            const int j = it - N4, b = j >> 3, h = (j >> 1) & 3, qb = j & 1;
            attn_block<2, false>(QB + (size_t)h * NT * 64, NLAT + b * 256 + qb * 128, KBp + (size_t)(b * 4 + h) * KEYS * 64, VBp + (size_t)(b * 4 + h) * KEYS * 64,
                                 4, OX + 512 + h * 64, 0, 0, 0, nullptr, lds);
        }
    }
}

DEV void phase_outproj(const Params& p, int l, char* lds) {
    const int tid = get_tid(), lane = tid & 63, wid = tid >> 6, fr = lane & 15, fq = lane >> 4, wr = wid >> 1, wc = wid & 1;
    const bf16_t* OX = (const bf16_t*)(p.ws + OFF_OX);
    const bf16_t* W = (const bf16_t*)(p.ws + OFF_WOUT) + (size_t)l * 1024 * 1024;
    const float* mod = (const float*)(p.ws + OFF_MOD) + (size_t)l * 9 * 6144;
    bf16_t* X = (bf16_t*)(p.ws + OFF_X);
    const int nitems = (l == 0 ? 144 : 128) * 8;
    const int vb = vblock();
    for (int it = vb; it < nitems; it += gridDim.x) {
        const int mt = it >> 3, nt = it & 7, m0 = mt * 128, n0 = nt * 128;
        const unsigned a0 = (unsigned)m0 * 1024u + st64_off(tid), b0 = (unsigned)n0 * 1024u + st64_off(tid);
        f32x4 acc[4][4]; zero_acc<4, 4>(acc);
        const unsigned ao[4] = {a0, a0 + 32u * 1024u, a0 + 64u * 1024u, a0 + 96u * 1024u};
        const unsigned bo[4] = {b0, b0 + 32u * 1024u, b0 + 64u * 1024u, b0 + 96u * 1024u};
        gemm_core64<true>(acc, OX, ao, W, bo, 1024, lds, (const bf16_t*)(p.ws + OFF_OXT) + (size_t)((m0 >> 11) & 7) * 256 * 2048 + (m0 & 2047), m0 < NLAT ? 12 : 16);
        const float* g1 = mod + (size_t)mod_group(m0) * 6144 + 2048;
        f32x4 gt[2][2], xr[4][2][2];
#pragma unroll
        for (int gg = 0; gg < 2; ++gg) { const int col = n0 + wc * 64 + gg * 32 + 8 * fq; gt[gg][0] = *(const f32x4*)(g1 + col); gt[gg][1] = *(const f32x4*)(g1 + col + 4); }
#pragma unroll
        for (int m = 0; m < 4; ++m) {
            const int row = m0 + wr * 64 + m * 16 + fr;
            const float* xin = row < NLAT ? p.x + (size_t)row * 1024 : p.ctx + (size_t)(row - NLAT) * 1024;
#pragma unroll
            for (int gg = 0; gg < 2; ++gg) {
                const int col = n0 + wc * 64 + gg * 32 + 8 * fq;
                if (l == 0) { xr[m][gg][0] = *(const f32x4*)(xin + col); xr[m][gg][1] = *(const f32x4*)(xin + col + 4); }
                else { const u32x4 w = *(const u32x4*)(X + (size_t)row * 1024 + col);
                       xr[m][gg][0] = (f32x4){__uint_as_float(w[0] << 16), __uint_as_float(w[0] & 0xffff0000u), __uint_as_float(w[1] << 16), __uint_as_float(w[1] & 0xffff0000u)};
                       xr[m][gg][1] = (f32x4){__uint_as_float(w[2] << 16), __uint_as_float(w[2] & 0xffff0000u), __uint_as_float(w[3] << 16), __uint_as_float(w[3] & 0xffff0000u)}; }
            }
        }
#pragma unroll
        for (int m = 0; m < 4; ++m) {
            const int row = m0 + wr * 64 + m * 16 + fr;
#pragma unroll
            for (int gg = 0; gg < 2; ++gg) {
                const int col = n0 + wc * 64 + gg * 32 + 8 * fq;
                const f32x4 x0 = xr[m][gg][0], x1 = xr[m][gg][1];
                const f32x4 o0 = x0 * DN_ALPHA + gt[gg][0] * acc[m][2 * gg], o1 = x1 * DN_ALPHA + gt[gg][1] * acc[m][2 * gg + 1];
                *(u32x4*)(X + (size_t)row * 1024 + col) = (u32x4){pk2(o0[0], o0[1]), pk2(o0[2], o0[3]), pk2(o1[0], o1[1]), pk2(o1[2], o1[3])};
            }
        }
    }
    if (l == 0 && vb >= 128 && vb - 128 < conv_slots_out(0, (int)gridDim.x)) { __syncthreads(); conv_run(p, 0, (conv_slots_in(0, (int)gridDim.x) + vb - 128) * 8, 8, lds); }
}


DEV void phase_ln1route(const Params& p, int l, char* lds) {
    const int tid = get_tid(), lane = tid & 63, wid = tid >> 6, fr = lane & 15, fq = lane >> 4;
    bf16_t* X = (bf16_t*)(p.ws + OFF_X);
    bf16_t* H = (bf16_t*)(p.ws + OFF_H);
    const bf16_t* RW = (const bf16_t*)(p.ws + OFF_RW) + (size_t)l * 64 * 1024;
    const float* mod = (const float*)(p.ws + OFF_MOD) + (size_t)l * 9 * 6144;
    int* cnt = (int*)(p.ws + OFF_CNT) + l * 64 * 64;
    int* tke = (int*)(p.ws + OFF_TKE); int* tks = (int*)(p.ws + OFF_TKS); float* tkw = (float*)(p.ws + OFF_TKW);
    int* list = (int*)(p.ws + OFF_LIST);
    char* HT = lds;
    float* LG = (float*)(lds + 16 * 2064);
    const float rbias = p.router_b[l * 64 + lane];
    const int rpw = (l == 0) ? 3 : 4, rpi = 4 * rpw;
    const int nitems = (l == 0 ? NT : NLAT) / rpi;
    u32x2 raw[4][4];
    f32x4 msh[4], msc[4];
    float* LNG = (float*)(lds + 50176);
    for (int i = tid; i < 512; i += 256) {
        const int c = (i & 255) * 4;
        *(f32x4*)(LNG + (i >> 8) * 1024 + c) = *(const f32x4*)((i >> 8 ? p.ln1_b : p.ln1_g) + l * 1024 + c);
    }
    if ((int)blockIdx.x < nitems) {
#pragma unroll
        for (int i = 0; i < 4; ++i) if (i < rpw)
#pragma unroll
            for (int j = 0; j < 4; ++j) raw[i][j] = *(const u32x2*)(X + (size_t)((int)blockIdx.x * rpi + wid * rpw + i) * 1024 + 4 * lane + 256 * j);
        const float* mg = mod + (size_t)mod_group((int)blockIdx.x * rpi + wid * rpw) * 6144;
#pragma unroll
        for (int j = 0; j < 4; ++j) { const int c = 4 * lane + 256 * j; msh[j] = *(const f32x4*)(mg + 3072 + c); msc[j] = *(const f32x4*)(mg + 4096 + c); }
    }
    __syncthreads();
    for (int it = blockIdx.x; it < nitems; it += gridDim.x) {
        const int m0 = it * rpi;
        const int g0 = mod_group(m0 + wid * rpw);
        f32x4 vv[4][4];
#pragma unroll
        for (int i = 0; i < 4; ++i) if (i < rpw)
#pragma unroll
            for (int j = 0; j < 4; ++j) { const u32x2 w = raw[i][j]; vv[i][j] = (f32x4){__uint_as_float(w[0] << 16), __uint_as_float(w[0] & 0xffff0000u), __uint_as_float(w[1] << 16), __uint_as_float(w[1] & 0xffff0000u)}; }
#pragma unroll
        for (int i = 0; i < 4; ++i) if (i < rpw) {
            const int rl = wid * rpw + i, row = m0 + rl;
            if (mod_group(row) != g0) {
                const float* mg = mod + (size_t)mod_group(row) * 6144;
#pragma unroll
                for (int j = 0; j < 4; ++j) { const int c = 4 * lane + 256 * j; msh[j] = *(const f32x4*)(mg + 3072 + c); msc[j] = *(const f32x4*)(mg + 4096 + c); }
            }
            row_norm(vv[i]);
#pragma unroll
            for (int j = 0; j < 4; ++j) {
                const int c = 4 * lane + 256 * j;
                vv[i][j] = vv[i][j] * *(const f32x4*)(LNG + c) + *(const f32x4*)(LNG + 1024 + c);
                st_bf4(X + (size_t)row * 1024 + c, vv[i][j]);
            }
            row_norm(vv[i]);
#pragma unroll
            for (int j = 0; j < 4; ++j) {
                const int c = 4 * lane + 256 * j;
                const f32x4 o = vv[i][j] * (msc[j] + 1.0f) + msh[j];
                const u32x2 w = (u32x2){pk2(o[0], o[1]), pk2(o[2], o[3])};
                *(u32x2*)(H + (size_t)row * 1024 + c) = w;
                *(u32x2*)(HT + rl * 2064 + c * 2) = w;
            }
        }
        f32x4 acc = (f32x4){0.f, 0.f, 0.f, 0.f};
        const bf16_t* bp = RW + (size_t)(wid * 16 + fr) * 1024 + fq * 8;
        bf16x8 bq[16];
#pragma unroll
        for (int ks = 0; ks < 16; ++ks) bq[ks] = *(const bf16x8*)(bp + ks * 32);
        __syncthreads();
#pragma unroll
        for (int ks = 0; ks < 16; ++ks) {
            const bf16x8 af = *(const bf16x8*)(HT + fr * 2064 + (ks * 32 + fq * 8) * 2);
            acc = mfma16(bq[ks], af, acc);
            bq[ks] = *(const bf16x8*)(bp + (ks + 16) * 32);
        }
#pragma unroll
        for (int ks = 0; ks < 16; ++ks) {
            const bf16x8 af = *(const bf16x8*)(HT + fr * 2064 + ((ks + 16) * 32 + fq * 8) * 2);
            acc = mfma16(bq[ks], af, acc);
        }
        *(f32x4*)(LG + fr * 64 + wid * 16 + 4 * fq) = acc;
        if (it + (int)gridDim.x < nitems) {
#pragma unroll
            for (int i = 0; i < 4; ++i) if (i < rpw)
#pragma unroll
                for (int j = 0; j < 4; ++j) raw[i][j] = *(const u32x2*)(X + (size_t)(m0 + (int)gridDim.x * rpi + wid * rpw + i) * 1024 + 4 * lane + 256 * j);
            const float* mg = mod + (size_t)mod_group(m0 + (int)gridDim.x * rpi + wid * rpw) * 6144;
#pragma unroll
            for (int j = 0; j < 4; ++j) { const int c = 4 * lane + 256 * j; msh[j] = *(const f32x4*)(mg + 3072 + c); msc[j] = *(const f32x4*)(mg + 4096 + c); }
        }
        __syncthreads();
        int* RS = (int*)(lds + 16 * 2064 + 4096 + 2048);
        float* RWt = (float*)(lds + 16 * 2064 + 4096 + 2048 + 4096);
        int lc = 0;
        unsigned* KW = (unsigned*)(lds + 16 * 2064 + 4096 + 2048 + 8192) + wid * 160;
#pragma unroll 1
        for (int i = 0; i < rpw; ++i) {
            const int rl = wid * rpw + i;
            const float sc = __builtin_amdgcn_rcpf(1.0f + __expf(-LG[rl * 64 + lane]));
            const float sel = sc + rbias;
            const int grp = lane >> 3;
            const unsigned key = (__float_as_uint(sel + 2.0f) & 0xFFFFFFC0u) | (unsigned)(63 - lane);
            KW[lane] = key;
            __builtin_amdgcn_wave_barrier();
            int rankg = 0;
            {
                const u32x4 k0 = *(const u32x4*)(KW + grp * 8), k1 = *(const u32x4*)(KW + grp * 8 + 4);
#pragma unroll
                for (int j = 0; j < 4; ++j) { rankg += (k0[j] > key) ? 1 : 0; rankg += (k1[j] > key) ? 1 : 0; }
            }
            float gs = rankg < 2 ? sel : 0.f;
            gs += __shfl_xor(gs, 1); gs += __shfl_xor(gs, 2); gs += __shfl_xor(gs, 4);
            const unsigned gkey = (__float_as_uint(gs + 4.0f) & 0xFFFFFFF8u) | (unsigned)(7 - grp);
            if ((lane & 7) == 0) KW[128 + grp] = gkey;
            __builtin_amdgcn_wave_barrier();
            int rg = 0;
            {
                const u32x4 g0 = *(const u32x4*)(KW + 128), g1 = *(const u32x4*)(KW + 132);
#pragma unroll
                for (int j = 0; j < 4; ++j) { rg += (g0[j] > gkey) ? 1 : 0; rg += (g1[j] > gkey) ? 1 : 0; }
            }
            const bool selg = rg < 4;
            const unsigned vkey = selg ? key : 0u;
            KW[64 + lane] = vkey;
            __builtin_amdgcn_wave_barrier();
            int rank = 0;
#pragma unroll
            for (int q = 0; q < 16; ++q) {
                const u32x4 kk = *(const u32x4*)(KW + 64 + q * 4);
#pragma unroll
                for (int j = 0; j < 4; ++j) rank += (kk[j] > vkey) ? 1 : 0;
            }
            const bool ch = selg && rank < 8;
            const float wsum = wave_sum(ch ? sc : 0.f);
            RS[rl * 64 + lane] = ch ? rank : -1;
            RWt[rl * 64 + lane] = sc * (2.5f * __builtin_amdgcn_rcpf(wsum));
            lc += ch ? 1 : 0;
            __builtin_amdgcn_wave_barrier();
        }
        int* WC = (int*)(lds + 16 * 2064 + 4096);
        WC[wid * 64 + lane] = lc;
        __syncthreads();
        if (wid == 0) {
            const int tot = WC[lane] + WC[64 + lane] + WC[128 + lane] + WC[192 + lane];
            int base = 0;
            if (tot > 0) base = atomicAdd(&cnt[lane * 64], tot);
            WC[256 + lane] = base;
        }
        __syncthreads();
        {
            int slot = WC[256 + lane];
#pragma unroll
            for (int w2 = 0; w2 < 4; ++w2) slot += (w2 < wid) ? WC[w2 * 64 + lane] : 0;
#pragma unroll 1
            for (int i = 0; i < rpw; ++i) {
                const int rl = wid * rpw + i, rk = RS[rl * 64 + lane];
                if (rk >= 0) {
                    const int row = m0 + rl;
                    list[(size_t)lane * NT + slot] = row * 8 + rk;
                    *(u32x3*)((unsigned*)tke + 3 * (row * 8 + rk)) = (u32x3){(unsigned)lane, (unsigned)slot, __float_as_uint(RWt[rl * 64 + lane])};
                    ++slot;
                }
            }
        }
        __syncthreads();
    }
}

constexpr int YS_EXT_ROWS = NLAT * 1024 * 4 / 1024;
constexpr int PLAN_OFF = 68 * 1024;
DEV void moe_plan(const int* cnt, int cap, int l, char* lds) {
    int* PL = (int*)(lds + PLAN_OFF);
    const int tid = get_tid();
    __syncthreads();
    if (tid < 64) {
        const int lane = tid;
        const int c = cnt[lane * 64], tiles = (c + 127) >> 7;
        int pr = c, pt = tiles;
#pragma unroll
        for (int o = 1; o < 64; o <<= 1) { const int a = __shfl_up(pr, o), b = __shfl_up(pt, o); if (lane >= o) { pr += a; pt += b; } }
        const int G = (int)gridDim.x, nshu = 2 * ((l == 0 ? NT : NLAT) / 128);
        const int units = nshu + __builtin_amdgcn_readlane(pt, 63);
        const int cap8 = cap * 2;
        const bool one_round = __builtin_amdgcn_readlane(pr, 63) + nshu * 128 <= cap8;
        const int target0 = one_round ? 0 : ((units + G - 1) / G - 1) * G;
        PL[144 + lane] = c;
        int start = 0, base_r = 0, base_t = 0, round = 0;
        for (;;) {
            const int lim = (round == 0) ? ((target0 > 0) ? cap8 + YS_EXT_ROWS : cap8) - nshu * 128 : cap8;
            const bool bad = (lane >= start) && ((pr - base_r > lim) || (round == 0 && target0 > 0 && lane > 0 && nshu + pt > target0));
            const unsigned long long m = __ballot(bad);
            int end = m ? (int)__builtin_ctzll(m) : 64;
            if (end <= start) end = start + 1;
            if (lane >= start && lane < end) { PL[16 + lane] = pt - tiles - base_t; PL[80 + lane] = pr - c - base_r; }
            if (lane == 0) { PL[1 + round] = start; PL[10 + round] = __builtin_amdgcn_readlane(pt, end - 1) - base_t; PL[208 + round] = __builtin_amdgcn_readlane(pr, end - 1) - base_r; }
            if (end >= 64 || round >= 7) { if (lane == 0) { PL[0] = round + 1; PL[2 + round] = 64; } break; }
            base_r = __builtin_amdgcn_readlane(pr, end - 1); base_t = __builtin_amdgcn_readlane(pt, end - 1);
            start = end; ++round;
        }
    }
    __syncthreads();
}
constexpr float YS_SCALE = 32.0f, YS_INV = 1.0f / 32.0f;
DEV unsigned char* ys_row(const Params& p, int idx) {
    const int cap8 = p.cap * 2;
    return idx < cap8 ? p.ws + OFF_YS + (size_t)idx * 1024 : (unsigned char*)p.out + (size_t)(idx - cap8) * 1024;
}
DEV unsigned pk4_fp8(const f32x4& v) {
    int w = 0;
    w = __builtin_amdgcn_cvt_pk_fp8_f32(v[0] * YS_SCALE, v[1] * YS_SCALE, w, false);
    w = __builtin_amdgcn_cvt_pk_fp8_f32(v[2] * YS_SCALE, v[3] * YS_SCALE, w, true);
    return (unsigned)w;
}
DEV f32x4 up4_fp8(unsigned w) {
    const f32x2 lo = __builtin_amdgcn_cvt_pk_f32_fp8((int)w, false), hi = __builtin_amdgcn_cvt_pk_f32_fp8((int)w, true);
    return (f32x4){lo[0], lo[1], hi[0], hi[1]};
}

template <class PRE>
DEV void gemm_up256(f32x4 (&acc)[4][8], const bf16_t* A, const unsigned (&ao)[4], const bf16_t* B, const unsigned (&bo)[4], char* lds, PRE&& pre) {
    const int tid = get_tid(), lane = tid & 63, wid = tid >> 6, fr = lane & 15, fq = lane >> 4, wr = wid >> 1, wc = wid & 1;
    auto stageA = [&](int kt) {
        char* SA = lds + (kt & 1) * 16384;
#pragma unroll
        for (int i = 0; i < 4; ++i) glds16(A + (ao[i] + (unsigned)(kt * 64)), SA + i * 4096 + tid * 16);
    };
    auto stageB = [&](int s_) {
        char* SB = lds + 32768 + (s_ & 1) * 16384;
#pragma unroll
        for (int i = 0; i < 4; ++i) glds16(B + (bo[i] + (unsigned)((s_ & 1) * 128 * 1024 + (s_ >> 1) * 64)), SB + i * 4096 + tid * 16);
    };
    WAIT_VM(0);
    stageA(0); stageB(0); stageB(1); stageA(1);
    pre();
    const int rsw = fr & 7;
    const int arow = (wr * 64 + fr) * 128, brow = 32768 + (wc * 64 + fr) * 128;
    const int c0 = (fq ^ rsw) * 16, c1 = ((4 + fq) ^ rsw) * 16;
    bf16x8 af[4][2];
#define UP_STEP(NH)                                                                                                          \
    {                                                                                                                        \
        const int s_ = 2 * kt + (NH);                                                                                        \
          \
        if (s_ < 30) WAIT_VM(8); else if (s_ == 30) WAIT_VM(4); else WAIT_VM(0);                                             \
        RAW_BARRIER();                                                                                                       \
        const char* SBp = lds + (NH) * 16384;                                                                                \
        if ((NH) == 0) {                                                                                                     \
            const char* SAp = lds + (kt & 1) * 16384;                                                                        \
            _Pragma("unroll") for (int m = 0; m < 4; ++m) { af[m][0] = *(const bf16x8*)(SAp + arow + m * 2048 + c0); af[m][1] = *(const bf16x8*)(SAp + arow + m * 2048 + c1); } \
        }                                                                                                                    \
        bf16x8 bfr[4][2];                                                                                                    \
        _Pragma("unroll") for (int n = 0; n < 4; ++n) { bfr[n][0] = *(const bf16x8*)(SBp + brow + n * 2048 + c0); bfr[n][1] = *(const bf16x8*)(SBp + brow + n * 2048 + c1); } \
        WAIT_LGKM0();                                                                                                        \
        RAW_BARRIER();                                                                                                       \
        if (s_ + 2 < 32) stageB(s_ + 2);                                                                                     \
        if ((NH) == 1 && kt + 2 < 16) stageA(kt + 2);         \
        __builtin_amdgcn_s_setprio(1);                                                                                       \
        _Pragma("unroll") for (int ks = 0; ks < 2; ++ks)                                                                     \
            _Pragma("unroll") for (int m = 0; m < 4; ++m)                                                                    \
                _Pragma("unroll") for (int n = 0; n < 4; ++n) acc[m][4 * (NH) + n] = mfma16(bfr[n][ks], af[m][ks], acc[m][4 * (NH) + n]); \
        __builtin_amdgcn_s_setprio(0);                                                                                       \
    }
#pragma unroll 1
    for (int kt = 0; kt < 16; ++kt) {
        UP_STEP(0)
        UP_STEP(1)
    }
#undef UP_STEP
}
template <bool SHARED>
DEV void moe_tile(const Params& p, const bf16_t* W13, const bf16_t* W2, const int* list, int s0, int nvalid, int ysbase, int m0, int half, const float* g2, char* lds) {
    const int tid = get_tid(), lane = tid & 63, wid = tid >> 6, fr = lane & 15, fq = lane >> 4, wr = wid >> 1, wc = wid & 1;
    const bf16_t* H = (const bf16_t*)(p.ws + OFF_H);
    const float* tkw = (const float*)(p.ws + OFF_TKE);
    char* ACT = lds;
    const unsigned ch4 = (unsigned)((tid & 3) * 8);
    unsigned ao[4];
    const unsigned cha = (unsigned)(((tid & 7) ^ ((tid >> 3) & 7)) * 8);
    float gw[4];
    int gidx[4] = {0, 0, 0, 0};
    if (SHARED) {
#pragma unroll
        for (int i = 0; i < 4; ++i) ao[i] = (unsigned)(m0 + i * 32 + (tid >> 3)) * 1024u + cha;
#pragma unroll
        for (int m = 0; m < 4; ++m) gw[m] = 1.0f;
    } else {
#pragma unroll
        for (int i = 0; i < 4; ++i) { const int rr = min(i * 32 + (tid >> 3), nvalid - 1); ao[i] = (unsigned)(list[s0 + rr] >> 3) * 1024u + cha; }
#pragma unroll
        for (int m = 0; m < 4; ++m) { const int rl = min(wr * 64 + m * 16 + fr, nvalid - 1); gidx[m] = list[s0 + rl]; }
    }
    {
        const unsigned b0 = (unsigned)(tid >> 3) * 1024u + cha;
        const unsigned bo[4] = {b0, b0 + 32u * 1024u, b0 + 64u * 1024u, b0 + 96u * 1024u};
        f32x4 acc[4][8];
#pragma unroll
        for (int m = 0; m < 4; ++m)
#pragma unroll
            for (int n = 0; n < 8; ++n) acc[m][n] = (f32x4){0.f, 0.f, 0.f, 0.f};
        gemm_up256(acc, H, ao, W13, bo, lds, [&]() {
            if (!SHARED) {
#pragma unroll
                for (int m = 0; m < 4; ++m) gw[m] = tkw[3 * gidx[m] + 2];
            }
        });
        __syncthreads();
#pragma unroll
        for (int m = 0; m < 4; ++m)
#pragma unroll
            for (int pp = 0; pp < 4; ++pp) {
                float o[4];
#pragma unroll
                for (int j = 0; j < 4; ++j) { const float a = acc[m][2 * pp][j], b = acc[m][2 * pp + 1][j]; o[j] = a * __builtin_amdgcn_rcpf(1.0f + __expf(-a)) * b * gw[m]; }
                *(u32x2*)(ACT + (wr * 64 + m * 16 + fr) * 272 + ((pp >> 1) * 64 + wc * 32 + (pp & 1) * 16 + 4 * fq) * 2) = (u32x2){pk2(o[0], o[1]), pk2(o[2], o[3])};
            }
    }
    __syncthreads();
    if (SHARED) {
        gemm2_stream64<128, 272>(W2, ACT, lds + 36864, [&](int nt, const f32x4 (&acc)[4][4]) {
#pragma unroll
            for (int m = 0; m < 4; ++m) {
                unsigned char* o = ys_row(p, ysbase + m0 + wr * 64 + m * 16 + fr) + nt * 128 + wc * 64 + 16 * fq;
                *(u32x4*)o = (u32x4){pk4_fp8(acc[m][0]), pk4_fp8(acc[m][1]), pk4_fp8(acc[m][2]), pk4_fp8(acc[m][3])};
            }
        });
    } else {
        gemm2_stream64<128, 272>(W2, ACT, lds + 36864, [&](int nt, const f32x4 (&acc)[4][4]) {
#pragma unroll
            for (int m = 0; m < 4; ++m) {
                const int rl = wr * 64 + m * 16 + fr;
                if (rl < nvalid) {
                    unsigned char* o = ys_row(p, ysbase + s0 + rl) + nt * 128 + wc * 64 + 16 * fq;
                    *(u32x4*)o = (u32x4){pk4_fp8(acc[m][0]), pk4_fp8(acc[m][1]), pk4_fp8(acc[m][2]), pk4_fp8(acc[m][3])};
                }
            }
        });
    }
    __syncthreads();
}
DEV void phase_moe(const Params& p, int l, int r, char* lds) {
    const int* cnt = (const int*)(p.ws + OFF_CNT) + l * 64 * 64;
    moe_plan(cnt, p.cap, l, lds);
    const int* PL = (const int*)(lds + PLAN_OFF);
    if (r >= PL[0]) return;
    const int e_lo = PL[1 + r], e_hi = PL[2 + r];
    const int nrt = PL[10 + r];
    const int nrows = (l == 0) ? NT : NLAT;
    const int nshu = (r == 0) ? 2 * (nrows / 128) : 0;
    const int G = (int)gridDim.x, b = vblock();
    const int q = (nshu + nrt + G - 1) / G;
    const int u0 = b * q, u1 = min(u0 + q, nshu + nrt);
    int e = e_lo;
    for (int u = u0; u < u1; ++u) {
        if (u < nshu) {
            const int m0 = (u >> 1) * 128, hh = u & 1;
            moe_tile<true>(p, (const bf16_t*)(p.ws + OFF_SW13) + (size_t)(l * 2 + hh) * 256 * 1024, (const bf16_t*)(p.ws + OFF_SW2) + (size_t)(l * 2 + hh) * 1024 * 128,
                           nullptr, 0, 128, PL[208] + hh * nrows, m0, hh, nullptr, lds);
        } else {
            const int it = u - nshu;
            while (e + 1 < e_hi && PL[16 + e + 1] <= it) ++e;
            const int s0 = (it - PL[16 + e]) * 128;
            moe_tile<false>(p, (const bf16_t*)(p.ws + OFF_W13) + (size_t)e * 256 * 1024, (const bf16_t*)(p.ws + OFF_W2) + (size_t)e * 1024 * 128,
                            (const int*)(p.ws + OFF_LIST) + (size_t)e * NT, s0, min(128, PL[144 + e] - s0), PL[80 + e], 0, 0, nullptr, lds);
        }
    }
}

DEV void phase_comb(const Params& p, int l, int r, char* lds) {
    const int tid_ = get_tid(), lane = tid_ & 63, wid = tid_ >> 6;
    const int* cnt = (const int*)(p.ws + OFF_CNT) + l * 64 * 64;
    __syncthreads();
    const int* PL = (const int*)(lds + PLAN_OFF);
    if (r >= PL[0]) return;
    const int e_lo = PL[1 + r], e_hi = PL[2 + r];
    const bool final = (r == PL[0] - 1);
    bf16_t* X = (bf16_t*)(p.ws + OFF_X);
    bf16_t* H = (bf16_t*)(p.ws + OFF_H);
    const int* tke = (const int*)(p.ws + OFF_TKE); const int* tks = (const int*)(p.ws + OFF_TKS);
    const float* mod = (const float*)(p.ws + OFF_MOD);
    const int nrows = (l == 0) ? NT : NLAT;
    const int rstep = (int)gridDim.x * 4;
    auto issue = [&](int rw, int e, int sl, u32x4 (&yy)[10], u32x4& xa_, u32x4& xb_) {
        int idx_l = -1;
        if (lane < 8 && e >= e_lo && e < e_hi) idx_l = PL[80 + e] + sl;
        {
            const bf16_t* xr_ = X + (size_t)rw * 1024 + 4 * lane;
            const u32x2 w0 = *(const u32x2*)xr_, w1 = *(const u32x2*)(xr_ + 256), w2 = *(const u32x2*)(xr_ + 512), w3 = *(const u32x2*)(xr_ + 768);
            xa_ = (u32x4){w0[0], w0[1], w1[0], w1[1]}; xb_ = (u32x4){w2[0], w2[1], w3[0], w3[1]};
        }
#pragma unroll
        for (int k = 0; k < 8; ++k) {
            const int idx = __builtin_amdgcn_readlane(idx_l, k);
            if (idx >= 0) yy[k] = *(const u32x4*)(ys_row(p, idx) + 16 * lane); else yy[k] = (u32x4){0u, 0u, 0u, 0u};
        }
        if (r == 0) { yy[8] = *(const u32x4*)(ys_row(p, PL[208] + rw) + 16 * lane); yy[9] = *(const u32x4*)(ys_row(p, PL[208] + nrows + rw) + 16 * lane); }
        else { yy[8] = (u32x4){0u, 0u, 0u, 0u}; yy[9] = yy[8]; }
    };
    f32x4 ln2g[4], ln2b[4];
#pragma unroll
    for (int j = 0; j < 4; ++j) { ln2g[j] = *(const f32x4*)(p.ln2_g + l * 1024 + 4 * lane + 256 * j); ln2b[j] = *(const f32x4*)(p.ln2_b + l * 1024 + 4 * lane + 256 * j); }
    auto stx = [&](bf16_t* rowp, const u32x4& o0, const u32x4& o1) {
        bf16_t* q_ = rowp + 4 * lane;
        *(u32x2*)q_ = (u32x2){o0[0], o0[1]}; *(u32x2*)(q_ + 256) = (u32x2){o0[2], o0[3]}; *(u32x2*)(q_ + 512) = (u32x2){o1[0], o1[1]}; *(u32x2*)(q_ + 768) = (u32x2){o1[2], o1[3]};
    };
    int row = blockIdx.x * 4 + wid, rown = row + rstep;
    int e_n = 0, sl_n = 0;
    u32x4 y[10], xa, xb;
    if (row < nrows) {
        if (lane < 8) { e_n = tke[3 * (row * 8 + lane)]; sl_n = tke[3 * (row * 8 + lane) + 1]; }
        issue(row, e_n, sl_n, y, xa, xb);
        if (rown < nrows && lane < 8) { e_n = tke[3 * (rown * 8 + lane)]; sl_n = tke[3 * (rown * 8 + lane) + 1]; }
    }
    for (; row < nrows; row = rown, rown += rstep) {
        u32x4 y2[10], xa2, xb2;
        if (rown < nrows) {
            issue(rown, e_n, sl_n, y2, xa2, xb2);
            const int r3 = rown + rstep;
            if (r3 < nrows && lane < 8) { e_n = tke[3 * (r3 * 8 + lane)]; sl_n = tke[3 * (r3 * 8 + lane) + 1]; }
        } else {
#pragma unroll
            for (int k = 0; k < 10; ++k) y2[k] = (u32x4){0u, 0u, 0u, 0u};
            xa2 = y2[0]; xb2 = y2[0];
        }
        const int g = mod_group(row);
        const float* g2 = mod + ((size_t)l * 9 + g) * 6144 + 5120 + 4 * lane;
        f32x4 g2v[4], m1a[4], m1b[4];
#pragma unroll
        for (int j = 0; j < 4; ++j) g2v[j] = *(const f32x4*)(g2 + 256 * j);
        if (final && l == 0) {
            const float* m1 = mod + ((size_t)9 + g) * 6144 + 4 * lane;
#pragma unroll
            for (int j = 0; j < 4; ++j) { m1a[j] = *(const f32x4*)(m1 + 256 * j); m1b[j] = *(const f32x4*)(m1 + 1024 + 256 * j); }
        }
        f32x4 v[4];
        {
            const u32x4 a = xa, b2 = xb;
            v[0] = (f32x4){__uint_as_float(a[0] << 16), __uint_as_float(a[0] & 0xffff0000u), __uint_as_float(a[1] << 16), __uint_as_float(a[1] & 0xffff0000u)};
            v[1] = (f32x4){__uint_as_float(a[2] << 16), __uint_as_float(a[2] & 0xffff0000u), __uint_as_float(a[3] << 16), __uint_as_float(a[3] & 0xffff0000u)};
            v[2] = (f32x4){__uint_as_float(b2[0] << 16), __uint_as_float(b2[0] & 0xffff0000u), __uint_as_float(b2[1] << 16), __uint_as_float(b2[1] & 0xffff0000u)};
            v[3] = (f32x4){__uint_as_float(b2[2] << 16), __uint_as_float(b2[2] & 0xffff0000u), __uint_as_float(b2[3] << 16), __uint_as_float(b2[3] & 0xffff0000u)};
        }
        f32x4 s[4];
#pragma unroll
        for (int j = 0; j < 4; ++j) s[j] = (f32x4){0.f, 0.f, 0.f, 0.f};
#pragma unroll
        for (int k = 0; k < 10; ++k)
#pragma unroll
            for (int j = 0; j < 4; ++j) s[j] += up4_fp8(y[k][j]);
        const float xs = (r == 0) ? DN_ALPHA : 1.0f;
#pragma unroll
        for (int j = 0; j < 4; ++j) v[j] = v[j] * xs + g2v[j] * (s[j] * YS_INV);
        if (!final) {
            u32x4 o0, o1;
            o0 = (u32x4){pk2(v[0][0], v[0][1]), pk2(v[0][2], v[0][3]), pk2(v[1][0], v[1][1]), pk2(v[1][2], v[1][3])};
            o1 = (u32x4){pk2(v[2][0], v[2][1]), pk2(v[2][2], v[2][3]), pk2(v[3][0], v[3][1]), pk2(v[3][2], v[3][3])};
            stx(X + (size_t)row * 1024, o0, o1);
        } else {
            row_norm(v);
#pragma unroll
            for (int j = 0; j < 4; ++j) {
                const int c = 4 * lane + 256 * j;
                v[j] = v[j] * ln2g[j] + ln2b[j];
                if (l != 0) *(f32x4*)(p.out + (size_t)row * 1024 + c) = v[j];
            }
            if (l == 0) {
                u32x4 o0, o1;
                o0 = (u32x4){pk2(v[0][0], v[0][1]), pk2(v[0][2], v[0][3]), pk2(v[1][0], v[1][1]), pk2(v[1][2], v[1][3])};
                o1 = (u32x4){pk2(v[2][0], v[2][1]), pk2(v[2][2], v[2][3]), pk2(v[3][0], v[3][1]), pk2(v[3][2], v[3][3])};
                stx(X + (size_t)row * 1024, o0, o1);
                row_norm(v);
                f32x4 h[4];
#pragma unroll
                for (int j = 0; j < 4; ++j) h[j] = v[j] * (m1b[j] + 1.0f) + m1a[j];
                o0 = (u32x4){pk2(h[0][0], h[0][1]), pk2(h[0][2], h[0][3]), pk2(h[1][0], h[1][1]), pk2(h[1][2], h[1][3])};
                o1 = (u32x4){pk2(h[2][0], h[2][1]), pk2(h[2][2], h[2][3]), pk2(h[3][0], h[3][1]), pk2(h[3][2], h[3][3])};
                stx(H + (size_t)row * 1024, o0, o1);
            }
        }
#pragma unroll
        for (int k = 0; k < 10; ++k) y[k] = y2[k];
        xa = xa2; xb = xb2;
    }
}


#define XB_TMO      128
#define XB_XCNT(j)  (256  + 64 * (j))
#define XB_XSUB(j)  (1280 + 64 * (j))
#define XB_XGEN(j)  (2304 + 64 * (j))
#define XB_TOP      3328
#define XB_TOPGEN   3392
#define XCD_BAR_WORDS 3456
#define XB_SPIN_CAP (1u << 22)
DEV unsigned xb_ld(unsigned* p) { return __hip_atomic_load(p, __ATOMIC_RELAXED, __HIP_MEMORY_SCOPE_AGENT); }
DEV unsigned xb_add(unsigned* p, unsigned v) { return __hip_atomic_fetch_add(p, v, __ATOMIC_RELAXED, __HIP_MEMORY_SCOPE_AGENT); }
DEV unsigned xb_xcc_id() { return (unsigned)__builtin_amdgcn_s_getreg((3 << 11) | 20) & 0xFu; }
#define XB_SPIN(cond, bar) do { unsigned _sp = 0; while (cond) { __builtin_amdgcn_s_sleep(1); \
    if ((++_sp & 255u) == 0u) { if (xb_ld(&(bar)[XB_TMO])) break; if (_sp > XB_SPIN_CAP) { atomicAdd(&(bar)[XB_TMO], 1u); break; } } } } while (0)
struct XcdBarrier { unsigned* bar; unsigned x; volatile LAS unsigned* st; };
DEV XcdBarrier xcd_barrier_post(unsigned* bar, volatile LAS unsigned* st) {
    XcdBarrier b; b.bar = bar; b.x = xb_xcc_id(); b.st = st;
    if (threadIdx.x == 0) (void)xb_add(&bar[XB_XCNT(b.x)], 1u);
    return b;
}
DEV void xcd_barrier_complete(unsigned* bar, unsigned x, unsigned& nloc, unsigned& nx) {
    const unsigned G = gridDim.x * gridDim.y * gridDim.z;
    unsigned sum, cnt, mine, sp = 0u;
    for (;;) {
        sum = 0u; cnt = 0u; mine = 0u;
#pragma unroll
        for (unsigned j = 0; j < 16; ++j) { const unsigned c = xb_ld(&bar[XB_XCNT(j)]); sum += c; cnt += (c > 0u) ? 1u : 0u; mine = (j == x) ? c : mine; }
        if (sum == G) break;
        __builtin_amdgcn_s_sleep(1);
        if ((++sp & 255u) == 0u) { if (xb_ld(&bar[XB_TMO])) break; if (sp > XB_SPIN_CAP) { atomicAdd(&bar[XB_TMO], 1u); break; } }
    }
    nloc = mine > 0u ? mine : 1u; nx = cnt > 0u ? cnt : 1u;
}
DEV void xcd_barrier(const XcdBarrier& b) {
    asm volatile("s_waitcnt vmcnt(0)" ::: "memory");
    __syncthreads();
    if (get_tid() == 0) {
        unsigned* bar = b.bar; asm volatile("" : "+s"(bar));
        __builtin_amdgcn_s_waitcnt(0);
        unsigned nloc = b.st[0], nx = b.st[1];
        if (nloc == 0u) { xcd_barrier_complete(bar, b.x, nloc, nx); b.st[0] = nloc; b.st[1] = nx; }
        const unsigned old = xb_add(&bar[XB_XSUB(b.x)], 1u);
        const unsigned gen = old / nloc;
        const unsigned done = b.st[2];
        if (old + 1u == (gen + 1u) * nloc) {
            __builtin_amdgcn_fence(__ATOMIC_RELEASE, "agent");
            asm volatile("s_waitcnt vmcnt(0)" ::: "memory");
            __builtin_amdgcn_fence(__ATOMIC_ACQUIRE, "agent");
            const unsigned og = xb_add(&bar[XB_TOP], 1u);
            const unsigned tg = og / nx;
            if (og + 1u == (tg + 1u) * nx) xb_add(&bar[XB_TOPGEN], 1u);
            else XB_SPIN(xb_ld(&bar[XB_TOPGEN]) <= done, bar);
            asm volatile("s_waitcnt vmcnt(0)" ::: "memory");
        } else {
            __builtin_amdgcn_fence(__ATOMIC_ACQUIRE, "agent");
            XB_SPIN(xb_ld(&bar[XB_TOPGEN]) <= done, bar);
            asm volatile("s_waitcnt vmcnt(0)" ::: "memory");
        }
        b.st[2] = done + 1u;
    }
    __syncthreads();
}

enum { PT_PREP = 0, PT_MODFIN, PT_LNMOD0, PT_INPROJ, PT_MIX, PT_OUTPROJ, PT_LN1ROUTE, PT_MOE, PT_COMB };

DEV void run_phase(const Params& pin, int type, int l, int r, char* lds) {
    Params p = pin;
    { __attribute__((address_space(1))) unsigned char* w = (__attribute__((address_space(1))) unsigned char*)p.ws; asm volatile("" : "+s"(w)); p.ws = (unsigned char*)w; }
    switch (type) {
        case PT_PREP: phase_prep(p, lds); break;
        case PT_MODFIN: phase_modfin(p); break;
        case PT_LNMOD0: phase_lnmod0(p); break;
        case PT_INPROJ: phase_inproj(p, l, lds); break;
        case PT_MIX: phase_mix(p, l, lds); break;
        case PT_OUTPROJ: phase_outproj(p, l, lds); break;
        case PT_LN1ROUTE: phase_ln1route(p, l, lds); break;
        case PT_MOE: phase_moe(p, l, r, lds); break;
        default: phase_comb(p, l, r, lds); break;
    }
}

__global__ void __launch_bounds__(256, 2) fwd_kernel(KArgs ka) {
    Params p;
#define KCP(f) p.f = (decltype(p.f))ka.f
    KCP(x); KCP(c); KCP(ctx); KCP(c_ctx); KCP(ada_w); KCP(ada_b); KCP(w_in); KCP(q_gain); KCP(k_gain); KCP(nat_rpb); KCP(hy_conv_w); KCP(hy_conv_b);
    KCP(hy_f_w1); KCP(hy_f_b1); KCP(hy_f_w2); KCP(hy_f_b2); KCP(hy_f_w3); KCP(hy_freq); KCP(hy_skip); KCP(w_out); KCP(ln1_g); KCP(ln1_b);
    KCP(router_w); KCP(router_b); KCP(exp_w1); KCP(exp_w3); KCP(exp_w2); KCP(sh_w1); KCP(sh_w3); KCP(sh_w2); KCP(ln2_g); KCP(ln2_b);
    KCP(out); KCP(ws);
#undef KCP
    p.cap = ka.cap; p.mode = ka.mode; p.ptype = ka.ptype; p.pl = ka.pl; p.pr = ka.pr; p.pad = ka.pad;
    __shared__ __attribute__((aligned(16))) char smem[SMEM_BYTES];
#if MULTI_LAUNCH
    run_phase(p, p.ptype, p.pl, p.pr, smem);
#else
    if (threadIdx.x < 4) ((volatile LAS unsigned*)(smem + SMEM_BYTES - 16))[threadIdx.x] = 0u;
    __syncthreads();
    const XcdBarrier bar = xcd_barrier_post((unsigned*)(p.ws + OFF_BAR), (volatile LAS unsigned*)(smem + SMEM_BYTES - 16));
    int type = PT_PREP, l = 0, r = 0;
#if TELEM
    volatile LAS unsigned* tacc = (volatile LAS unsigned*)(smem + SMEM_BYTES - 128);
    if (threadIdx.x < 16) tacc[threadIdx.x] = 0u;
    unsigned long long t_prev = __builtin_amdgcn_s_memrealtime();
#endif
    for (;;) {
        run_phase(p, type, l, r, smem);
#if TELEM
        { const int ptype_done = type;
          xcd_barrier(bar);
          const unsigned long long t_now = __builtin_amdgcn_s_memrealtime();
          if (threadIdx.x == 0) tacc[ptype_done] += (unsigned)(t_now - t_prev);
          t_prev = t_now; }
#endif
        if (type < PT_MOE) { ++type; if (type == PT_MODFIN) ++type; r = 0; }
        else if (type == PT_MOE) type = PT_COMB;
        else {
            const int nr = ((const int*)(smem + PLAN_OFF))[0];
            if (r + 1 < nr) { ++r; type = PT_MOE; }
            else { if (l == 1) break; l = 1; r = 0; type = PT_INPROJ; }
        }
#if !TELEM
        xcd_barrier(bar);
#endif
    }
#if TELEM
    {
        unsigned* tel = (unsigned*)(p.ws + 36864);
        if (blockIdx.x == 0 && threadIdx.x == 0) { unsigned sa = 0u; for (int i = 0; i < 16; ++i) if ((TELEM_A >> i) & 1) sa += tacc[i]; tacc[15] = sa; }
        xcd_barrier(bar);
        if (blockIdx.x == 0 && threadIdx.x == 0) {
            p.out[0] += 1.0f + (float)tacc[TELEM_C] * 0.01f * 0.02f;
            const unsigned long long t0 = __builtin_amdgcn_s_memrealtime();
            const unsigned long long wait = 2ull * tacc[15];
            while (__builtin_amdgcn_s_memrealtime() - t0 < wait) __builtin_amdgcn_s_sleep(8);
        }
    }
#endif
#endif
}

extern "C" void kernel_launch(void* const* d_in, const int* in_sizes, int n_in, void* d_out, int out_size, void* d_ws, size_t ws_size, hipStream_t stream) {
    KArgs p{};
    const float** pp = (const float**)&p;
    for (int i = 0; i < 32; ++i) pp[i] = (const float*)d_in[i];
    p.out = (decltype(p.out))d_out; p.ws = (decltype(p.ws))d_ws;
    long long cap = ((long long)ws_size - (long long)OFF_R) / 2048;
    if (cap > NT * 8) cap = NT * 8;
    if (cap * 2048 < (long long)R_MIN_BYTES || cap < NT) { fprintf(stderr, "kernel_launch: workspace too small (%zu)\n", ws_size); return; }
    p.cap = (int)cap;
#if MULTI_LAUNCH
    const int grid = 512;
    auto launch = [&](int type, int l, int r) { KArgs q = p; q.mode = 1; q.ptype = type; q.pl = l; q.pr = r; hipLaunchKernelGGL(fwd_kernel, dim3(grid), dim3(256), 0, stream, q); };
    launch(PT_PREP, 0, 0); launch(PT_MODFIN, 0, 0); launch(PT_LNMOD0, 0, 0);
    for (int l = 0; l < 2; ++l) {
        launch(PT_INPROJ, l, 0); launch(PT_MIX, l, 0); launch(PT_OUTPROJ, l, 0); launch(PT_LN1ROUTE, l, 0);
        for (int r = 0; r < RMAX; ++r) { launch(PT_MOE, l, r); launch(PT_COMB, l, r); }
    }
#else
    static int grid_blocks = 0;
    if (!grid_blocks) {
        int dev = 0, cus = 0, per_cu = 0;
        hipGetDevice(&dev);
        hipDeviceGetAttribute(&cus, hipDeviceAttributeMultiprocessorCount, dev);
        hipOccupancyMaxActiveBlocksPerMultiprocessor(&per_cu, fwd_kernel, 256, 0);
        if (per_cu > 2) per_cu = 2;
        if (per_cu < 1) per_cu = 1;
        grid_blocks = cus * per_cu;
    }
    p.mode = 0;
    hipMemsetAsync(d_ws, 0, 65536, stream);
    hipLaunchKernelGGL(fwd_kernel, dim3(grid_blocks), dim3(256), 0, stream, p);
#endif
}
```
